# Optimizing an MI355X kernel written in HIP

```python
import jax
import jax.numpy as jnp
from jax import lax
import numpy as np

D_MODEL = 1024
BATCH = 8
SEQ = 4096
DEPTH = 2

CTX_LEN = 256
GRID_W = 64
BRANCH_W = D_MODEL // 2
N_BRANCH = 3
RWKV_HEAD = 64
RWKV_HEADS = BRANCH_W // RWKV_HEAD
DECAY_LORA = 64
ICLR_LORA = 64
GATE_LORA = 128
RWKV_COLS = 3 * BRANCH_W + 2 * DECAY_LORA + 2 * ICLR_LORA + GATE_LORA
RWKV_LN_EPS = 64e-5
RET_QK = 64
RET_V = 128
RET_HEADS = BRANCH_W // RET_V
RET_CHUNK = 128
RET_COLS = 2 * RET_HEADS * RET_QK + 2 * BRANCH_W
RET_LN_EPS = 1e-5
MLA_NOPE = 64
MLA_ROPE = 32
MLA_V = 64
MLA_HEADS = BRANCH_W // MLA_V
MLA_Q_RANK = 384
MLA_KV_RANK = 256
MLA_COLS = MLA_Q_RANK + MLA_KV_RANK + MLA_ROPE
GATE_COLS = N_BRANCH * D_MODEL
N_IN = RWKV_COLS + RET_COLS + MLA_COLS + GATE_COLS
Q_BLOCK = 128
ROPE_BASE = 10000.0
D_FF = 2816
N_EXPERTS = 8
TOP_K = 2
D_FF_EXPERT = 1408
RMS_EPS = 1e-6
F32 = jnp.float32

kernel_name = 'hybrid_rwkv7_retnet_mla_moe_dit_block'


def rms_norm(x, gain, eps=RMS_EPS):
    xf = x.astype(F32)
    y = xf * lax.rsqrt(jnp.mean(jnp.square(xf), axis=-1, keepdims=True) + eps)
    return (y * gain.astype(F32)).astype(x.dtype)


def modulate(h, gain, shift, scale):
    return rms_norm(h, gain) * (1 + scale) + shift


def head_norm(y, n_heads, gain, bias, eps):
    B, T, C = y.shape
    yf = y.astype(F32).reshape(B, T, n_heads, C // n_heads)
    mu = jnp.mean(yf, axis=-1, keepdims=True)
    var = jnp.mean(jnp.square(yf - mu), axis=-1, keepdims=True)
    yn = ((yf - mu) * lax.rsqrt(var + eps)).reshape(B, T, C)
    return (yn * gain.astype(F32) + bias.astype(F32)).astype(y.dtype)


def split_last(u, sizes):
    return jnp.split(u, [int(s) for s in np.cumsum(sizes)[:-1]], axis=-1)


def centred_shift(u):
    zero = jnp.zeros_like(u[:, :1])
    prev = jnp.concatenate([zero, u[:, :-1]], axis=1)
    nxt = jnp.concatenate([u[:, 1:], zero], axis=1)
    return 0.5 * (prev + nxt)


def axial_rope(n_tokens, rot_dim):
    rows = n_tokens // GRID_W
    row = jnp.repeat(jnp.arange(rows, dtype=F32), GRID_W)
    col = jnp.tile(jnp.arange(GRID_W, dtype=F32), rows)
    n_freq = rot_dim // 4
    inv = jnp.power(ROPE_BASE, -jnp.arange(n_freq, dtype=F32) / n_freq)
    ang = jnp.concatenate([row[:, None] * inv, col[:, None] * inv], axis=-1)
    return jnp.cos(ang), jnp.sin(ang)


def apply_rope(x, cos, sin):
    half = x.shape[-1] // 2
    x1, x2 = x[..., :half], x[..., half:]
    cs = cos[None, :, None, :].astype(x.dtype)
    sn = sin[None, :, None, :].astype(x.dtype)
    return jnp.concatenate([x1 * cs - x2 * sn, x1 * sn + x2 * cs], axis=-1)


def rwkv7_scan(S0, r, w, k, v, kk, a):
    def step(S, xs):
        r_t, w_t, k_t, v_t, kk_t, a_t = xs
        sa = jnp.einsum('bhij,bhj->bhi', S, -kk_t)
        S = (S * w_t[:, :, None, :] + sa[..., None] * (kk_t * a_t)[:, :, None, :]
             + v_t[..., None] * k_t[:, :, None, :])
        return S, jnp.einsum('bhij,bhj->bhi', S, r_t)
    xs = tuple(jnp.moveaxis(t, 1, 0) for t in (r, w, k, v, kk, a))
    S, y = lax.scan(step, S0, xs)
    return jnp.moveaxis(y, 0, 1), S


def rwkv7_mixer(u, mu, w0, w2, a0, a2, gate_up, k_k, k_a, r_k, ln_g, ln_b, init_states, need_out):
    B, T, _ = u.shape
    H, N = RWKV_HEADS, RWKV_HEAD
    u = u + mu * (centred_shift(u) - u)
    r, k, v, wd, ad, gd = split_last(u, [BRANCH_W] * 3 + [2 * DECAY_LORA, 2 * ICLR_LORA, GATE_LORA])

    def heads(t):
        return t.astype(F32).reshape(B, T, H, N)
    r, k, v = heads(r), heads(k), heads(v)
    kk = k * k_k.astype(F32).reshape(H, N)
    kk = kk / jnp.maximum(jnp.linalg.norm(kk, axis=-1, keepdims=True), 1e-12)
    wd = wd.reshape(B, T, 2, DECAY_LORA)
    ad = ad.reshape(B, T, 2, ICLR_LORA)
    scan_sum = 0.0
    k_dirs = []
    finals = []
    for d in range(2):
        z = (w0[d] + jnp.tanh(wd[:, :, d]) @ w2[d]).astype(F32)
        decay = heads(jnp.exp(-jnp.exp(-jax.nn.softplus(-z) - 0.5)))
        a = heads(jax.nn.sigmoid((a0[d] + ad[:, :, d] @ a2[d]).astype(F32)))
        k_d = k * (1.0 + (a - 1.0) * k_a.astype(F32).reshape(H, N))
        seq = (r, decay, k_d, v, kk, a)
        if d == 1:
            seq = tuple(jnp.flip(t, 1) for t in seq)
        o, S = rwkv7_scan(init_states[d], *seq)
        scan_sum = scan_sum + (jnp.flip(o, 1) if d == 1 else o)
        k_dirs.append(k_d)
        finals.append(S)
    if not need_out:
        return None, tuple(finals)
    r_k_h = r_k.astype(F32).reshape(H, N)
    bonus = (jnp.sum(r * k_dirs[0] * r_k_h, -1, keepdims=True)
             + jnp.sum(r * k_dirs[1] * r_k_h, -1, keepdims=True)) * v
    y = (head_norm(scan_sum.reshape(B, T, BRANCH_W), H, ln_g, ln_b, RWKV_LN_EPS)
         + bonus.reshape(B, T, BRANCH_W))
    gate = jax.nn.sigmoid(gd) @ gate_up
    return (y * gate).astype(u.dtype), tuple(finals)


def retention_chunkwise(q, k, v, log_gamma, R0):
    B, T, H, _ = q.shape
    dv = v.shape[-1]
    C = RET_CHUNK
    n = T // C
    pos = jnp.arange(C, dtype=F32)
    diff = pos[:, None] - pos[None, :]
    Dmat = jnp.where(diff >= 0, jnp.exp(jnp.maximum(diff, 0.0)[None] * log_gamma[:, None, None]), 0.0)
    xi = jnp.exp((pos + 1.0)[:, None] * log_gamma[None, :])
    zeta = jnp.exp((C - 1.0 - pos)[:, None] * log_gamma[None, :])
    g_chunk = jnp.exp(C * log_gamma)

    def to_chunks(t):
        return jnp.moveaxis(t.reshape(B, n, C, H, t.shape[-1]), 1, 0)

    def step(R, xs):
        qc, kc, vc = xs
        s = jnp.einsum('bnhd,bmhd->bhnm', qc, kc) * Dmat
        y = jnp.einsum('bhnm,bmhe->bnhe', s, vc)
        y = y + jnp.einsum('bnhd,bhde->bnhe', qc, R) * xi[None, :, :, None]
        R = R * g_chunk[None, :, None, None] + jnp.einsum('bmhd,bmhe->bhde', kc * zeta[None, :, :, None], vc)
        return R, y
    R, y = lax.scan(step, R0, (to_chunks(q), to_chunks(k), to_chunks(v)))
    return jnp.moveaxis(y, 0, 1).reshape(B, T, H, dv), R


def retention_mixer(u, decay_p, ln_g, ln_b, rope, init_states, need_out):
    B, T, _ = u.shape
    q, k, v, g = split_last(u, [RET_HEADS * RET_QK, RET_HEADS * RET_QK, BRANCH_W, BRANCH_W])
    q = q.astype(F32).reshape(B, T, RET_HEADS, RET_QK)
    k = k.astype(F32).reshape(B, T, RET_HEADS, RET_QK) * RET_QK ** -0.5
    v = v.astype(F32).reshape(B, T, RET_HEADS, RET_V)
    if rope is not None:
        q = apply_rope(q, *rope)
        k = apply_rope(k, *rope)
    log_gamma = -jnp.exp(decay_p.astype(F32))
    y_fwd, r_fwd = retention_chunkwise(q, k, v, log_gamma[0], init_states[0])
    y_bwd, r_bwd = retention_chunkwise(jnp.flip(q, 1), jnp.flip(k, 1), jnp.flip(v, 1), log_gamma[1], init_states[1])
    if not need_out:
        return None, (r_fwd, r_bwd)
    y = head_norm((y_fwd + jnp.flip(y_bwd, 1)).reshape(B, T, BRANCH_W), RET_HEADS, ln_g, ln_b, RET_LN_EPS)
    return (jax.nn.silu(g) * y).astype(u.dtype), (r_fwd, r_bwd)


def mla_project(u, q_norm, q_up, kv_norm, kv_up, rope):
    B, T, _ = u.shape
    q_lat, kv_lat, k_rope = split_last(u, [MLA_Q_RANK, MLA_KV_RANK, MLA_ROPE])
    q = (rms_norm(q_lat, q_norm) @ q_up).reshape(B, T, MLA_HEADS, MLA_NOPE + MLA_ROPE)
    kv = (rms_norm(kv_lat, kv_norm) @ kv_up).reshape(B, T, MLA_HEADS, MLA_NOPE + MLA_V)
    q_nope, q_rope = q[..., :MLA_NOPE], q[..., MLA_NOPE:]
    k_nope, v = kv[..., :MLA_NOPE], kv[..., MLA_NOPE:]
    k_rope = k_rope[:, :, None, :]
    if rope is not None:
        q_rope = apply_rope(q_rope, *rope)
        k_rope = apply_rope(k_rope, *rope)
    q = jnp.concatenate([q_nope, q_rope], axis=-1)
    k = jnp.concatenate([k_nope, jnp.broadcast_to(k_rope, (B, T, MLA_HEADS, MLA_ROPE))], axis=-1)
    return q, k, v


def blocked_attention(q, k, v):
    B, T, H, dq = q.shape
    nb = T // Q_BLOCK
    scale = dq ** -0.5
    qb = jnp.moveaxis(q.reshape(B, nb, Q_BLOCK, H, dq), 1, 0)

    def one_block(q_blk):
        s = jnp.einsum('bqhd,bkhd->bhqk', q_blk, k, preferred_element_type=F32) * scale
        p = jax.nn.softmax(s, axis=-1).astype(v.dtype)
        return jnp.einsum('bhqk,bkhd->bqhd', p, v)
    o = lax.map(one_block, qb)
    return jnp.moveaxis(o, 0, 1).reshape(B, T, H * v.shape[-1])


def merge_branches(ys, gate_logits, w_branch, w_out):
    B, T, _ = gate_logits.shape
    up = jnp.einsum('btnc,ncd->btnd', jnp.stack(ys, axis=2), w_branch)
    gates = jax.nn.sigmoid(gate_logits.reshape(B, T, N_BRANCH, D_MODEL))
    return jnp.sum(gates * up, axis=2) @ w_out


def swiglu(x, w_gate, w_up, w_down):
    return (jax.nn.silu(x @ w_gate) * (x @ w_up)) @ w_down


def moe_swiglu(x, router, w_gate, w_up, w_down):
    B, T, D = x.shape
    xf = x.reshape(B * T, D)
    logits = jnp.dot(xf, router, preferred_element_type=F32)
    top_v, top_i = lax.top_k(logits, TOP_K)
    top_w = jax.nn.softmax(top_v, axis=-1)
    comb = jnp.einsum('tk,tke->te', top_w, jax.nn.one_hot(top_i, N_EXPERTS, dtype=F32)).astype(x.dtype)
    out = jnp.zeros_like(xf)
    for e in range(N_EXPERTS):
        out = out + comb[:, e:e + 1] * swiglu(xf, w_gate[e], w_up[e], w_down[e])
    return out.reshape(B, T, D)


def setup_inputs(seed: int = 0) -> dict:
    key = jax.random.key(seed)
    keys = iter(jax.random.split(key, 48))

    def normal(shape, scale):
        return jax.random.normal(next(keys), shape, F32) * scale

    def uniform(shape, lo, hi):
        return jax.random.uniform(next(keys), shape, F32, lo, hi)
    L = DEPTH
    n_dense = (DEPTH + 1) // 2
    n_moe = DEPTH // 2
    base_decay = jnp.log(-jnp.log1p(-jnp.exp2(-5.0 - jnp.arange(RET_HEADS, dtype=F32))))
    return {
        'x': normal((BATCH, SEQ, D_MODEL), 1.0),
        'c': normal((BATCH, D_MODEL), 1.0),
        'ctx': normal((BATCH, CTX_LEN, D_MODEL), 1.0),
        'c_ctx': normal((D_MODEL,), 1.0),
        'norm_mix': 1.0 + normal((L, D_MODEL), 0.02),
        'norm_ffn': 1.0 + normal((L, D_MODEL), 0.02),
        'w_mod': normal((L, D_MODEL, 6 * D_MODEL), 0.5 * D_MODEL ** -0.5),
        'b_mod': normal((L, 6 * D_MODEL), 0.02),
        'w_in': normal((L, D_MODEL, N_IN), D_MODEL ** -0.5),
        'rwkv_mu': uniform((L, RWKV_COLS), 0.2, 0.8),
        'rwkv_w0': uniform((L, 2, BRANCH_W), -6.0, 1.0),
        'rwkv_w2': normal((L, 2, DECAY_LORA, BRANCH_W), 0.5 * DECAY_LORA ** -0.5),
        'rwkv_a0': normal((L, 2, BRANCH_W), 0.1),
        'rwkv_a2': normal((L, 2, ICLR_LORA, BRANCH_W), 0.5 * ICLR_LORA ** -0.5),
        'rwkv_g2': normal((L, GATE_LORA, BRANCH_W), GATE_LORA ** -0.5),
        'rwkv_k_k': 0.85 + normal((L, BRANCH_W), 0.05),
        'rwkv_k_a': 1.0 + normal((L, BRANCH_W), 0.05),
        'rwkv_r_k': normal((L, BRANCH_W), 0.1),
        'rwkv_ln_g': 1.0 + normal((L, BRANCH_W), 0.02),
        'rwkv_ln_b': normal((L, BRANCH_W), 0.02),
        'ret_decay': base_decay + normal((L, 2, RET_HEADS), 0.05),
        'ret_ln_g': 1.0 + normal((L, BRANCH_W), 0.02),
        'ret_ln_b': normal((L, BRANCH_W), 0.02),
        'mla_q_norm': 1.0 + normal((L, MLA_Q_RANK), 0.02),
        'mla_q_up': normal((L, MLA_Q_RANK, MLA_HEADS * (MLA_NOPE + MLA_ROPE)), MLA_Q_RANK ** -0.5),
        'mla_kv_norm': 1.0 + normal((L, MLA_KV_RANK), 0.02),
        'mla_kv_up': normal((L, MLA_KV_RANK, MLA_HEADS * (MLA_NOPE + MLA_V)), MLA_KV_RANK ** -0.5),
        'w_branch': normal((L, N_BRANCH, BRANCH_W, D_MODEL), BRANCH_W ** -0.5),
        'w_out': normal((L, D_MODEL, D_MODEL), D_MODEL ** -0.5),
        'ffn_w_gate': normal((n_dense, D_MODEL, D_FF), D_MODEL ** -0.5),
        'ffn_w_up': normal((n_dense, D_MODEL, D_FF), D_MODEL ** -0.5),
        'ffn_w_down': normal((n_dense, D_FF, D_MODEL), D_FF ** -0.5),
        'moe_router': normal((n_moe, D_MODEL, N_EXPERTS), D_MODEL ** -0.5),
        'moe_w_gate': normal((n_moe, N_EXPERTS, D_MODEL, D_FF_EXPERT), D_MODEL ** -0.5),
        'moe_w_up': normal((n_moe, N_EXPERTS, D_MODEL, D_FF_EXPERT), D_MODEL ** -0.5),
        'moe_w_down': normal((n_moe, N_EXPERTS, D_FF_EXPERT, D_MODEL), D_FF_EXPERT ** -0.5),
        'final_norm': 1.0 + normal((D_MODEL,), 0.02),
    }


def reference(x, c, ctx, c_ctx, norm_mix, norm_ffn, w_mod, b_mod, w_in, rwkv_mu, rwkv_w0, rwkv_w2,
              rwkv_a0, rwkv_a2, rwkv_g2, rwkv_k_k, rwkv_k_a, rwkv_r_k, rwkv_ln_g, rwkv_ln_b, ret_decay,
              ret_ln_g, ret_ln_b, mla_q_norm, mla_q_up, mla_kv_norm, mla_kv_up, w_branch, w_out,
              ffn_w_gate, ffn_w_up, ffn_w_down, moe_router, moe_w_gate, moe_w_up, moe_w_down, final_norm):
    B, n_lat, _ = x.shape
    rope_ret = axial_rope(n_lat, RET_QK)
    rope_mla = axial_rope(n_lat, MLA_ROPE)
    silu_c = jax.nn.silu(c)
    silu_ctx = jax.nn.silu(c_ctx)
    zero_rwkv = jnp.zeros((B, RWKV_HEADS, RWKV_HEAD, RWKV_HEAD), F32)
    zero_ret = jnp.zeros((B, RET_HEADS, RET_QK, RET_V), F32)
    splits = [RWKV_COLS, RET_COLS, MLA_COLS, GATE_COLS]
    h, hc = x, ctx
    for i in range(DEPTH):
        need_ctx = i < DEPTH - 1
        mod = (silu_c @ w_mod[i] + b_mod[i])[:, None, :]
        mod_c = silu_ctx @ w_mod[i] + b_mod[i]
        sh1, sc1, gt1, sh2, sc2, gt2 = jnp.split(mod, 6, axis=-1)
        csh1, csc1, cgt1, csh2, csc2, cgt2 = jnp.split(mod_c, 6, axis=-1)

        ul = modulate(h, norm_mix[i], sh1, sc1) @ w_in[i]
        uc = modulate(hc, norm_mix[i], csh1, csc1) @ w_in[i]
        ul_rwkv, ul_ret, ul_mla, gl_l = split_last(ul, splits)
        uc_rwkv, uc_ret, uc_mla, gl_c = split_last(uc, splits)
        rwkv_p = (rwkv_mu[i], rwkv_w0[i], rwkv_w2[i], rwkv_a0[i], rwkv_a2[i], rwkv_g2[i],
                  rwkv_k_k[i], rwkv_k_a[i], rwkv_r_k[i], rwkv_ln_g[i], rwkv_ln_b[i])
        yc_rwkv, st_rwkv = rwkv7_mixer(uc_rwkv, *rwkv_p, (zero_rwkv, zero_rwkv), need_ctx)
        yl_rwkv, _ = rwkv7_mixer(ul_rwkv, *rwkv_p, st_rwkv, True)
        yc_ret, st_ret = retention_mixer(uc_ret, ret_decay[i], ret_ln_g[i], ret_ln_b[i], None,
                                         (zero_ret, zero_ret), need_ctx)
        yl_ret, _ = retention_mixer(ul_ret, ret_decay[i], ret_ln_g[i], ret_ln_b[i], rope_ret, st_ret, True)
        mla_p = (mla_q_norm[i], mla_q_up[i], mla_kv_norm[i], mla_kv_up[i])
        qc, kc, vc = mla_project(uc_mla, *mla_p, None)
        ql, kl, vl = mla_project(ul_mla, *mla_p, rope_mla)
        yl_mla = blocked_attention(ql, jnp.concatenate([kl, kc], axis=1), jnp.concatenate([vl, vc], axis=1))
        h = h + gt1 * merge_branches((yl_rwkv, yl_ret, yl_mla), gl_l, w_branch[i], w_out[i])
        if need_ctx:
            yc_mla = blocked_attention(qc, kc, vc)
            hc = hc + cgt1 * merge_branches((yc_rwkv, yc_ret, yc_mla), gl_c, w_branch[i], w_out[i])

        j = i // 2
        if i % 2 == 0:
            def channel_mixer(t, j=j):
                return swiglu(t, ffn_w_gate[j], ffn_w_up[j], ffn_w_down[j])
        else:
            def channel_mixer(t, j=j):
                return moe_swiglu(t, moe_router[j], moe_w_gate[j], moe_w_up[j], moe_w_down[j])
        h = h + gt2 * channel_mixer(modulate(h, norm_ffn[i], sh2, sc2))
        if need_ctx:
            hc = hc + cgt2 * channel_mixer(modulate(hc, norm_ffn[i], csh2, csc2))
    return rms_norm(h, final_norm)
```

```cpp
#include <hip/hip_runtime.h>
#include <hip/hip_cooperative_groups.h>
#include <cstdio>
#include <cstdint>
namespace cg = cooperative_groups;

#define LAS __attribute__((address_space(3)))
typedef unsigned short bf16_t;
typedef short bf16x8 __attribute__((ext_vector_type(8)));
typedef short s16x4 __attribute__((ext_vector_type(4)));
typedef float f32x4 __attribute__((ext_vector_type(4)));
typedef float f32x2 __attribute__((ext_vector_type(2)));
typedef float f32x16 __attribute__((ext_vector_type(16)));
typedef unsigned u32x4 __attribute__((ext_vector_type(4)));
typedef unsigned u32x2 __attribute__((ext_vector_type(2)));

constexpr int DM = 1024, NBATCH = 8, SEQ = 4096, CTXL = 256;
constexpr int RL = NBATCH * SEQ, RC = NBATCH * CTXL, RT = RL + RC;
constexpr int RWC = 1920, REC = 1536, MLC = 672, MIXC = 4128, MIXP = 4352, GATEC = 3072, NIN = 7200;
constexpr int DFF = 2816, NEXP = 8, DFE = 1408;
constexpr int RG = 2 * RL + NEXP * 256;
constexpr int NTHREADS = 512;
constexpr int LDS_BYTES = 147456;

constexpr size_t MiB = 1u << 20;
constexpr size_t WS_CTL = 0;
constexpr size_t WS_MOD = 1 * MiB;
constexpr size_t WS_ROPE_R = 3 * MiB / 2;
constexpr size_t WS_ROPE_M = 5 * MiB / 2;
constexpr size_t WS_RSTD = 3 * MiB;
constexpr size_t WS_BSC = 7 * MiB / 2;
constexpr size_t WS_ROUTE = 6 * MiB;
constexpr size_t WS_WG2 = 7 * MiB;
constexpr size_t WS_W2T = 15 * MiB / 2;
constexpr size_t WS_HC = 8 * MiB;
constexpr size_t WS_W = 16 * MiB;
constexpr size_t WL_WINLO = 0, WL_WINHI = 4456448, WL_WGLO = 8912896, WL_WGHI = 12058624, WL_WQ = 15204352, WL_WKV = 15794176, WL_WB = 16318464, WL_WO = 19464192, WL_STRIDE = 21 * MiB;
constexpr size_t WS_DYN = 58 * MiB;
constexpr size_t Y34 = 34 * MiB;
constexpr size_t D_URWKV = WS_DYN, D_URET = WS_DYN + 255 * MiB / 2, D_UMLA = D_URET + 102 * MiB, D_XN1 = D_UMLA + 357 * MiB / 8, D_OF = D_XN1 + 2 * Y34, D_OB = D_OF + Y34, D_END1 = D_OB + Y34;
constexpr size_t D_YRWKV = D_OF, D_YRET = D_OB;
constexpr size_t D_K = WS_DYN, D_V = D_K + 289 * MiB / 8, D_Q = D_V + Y34;
constexpr size_t D_YMLA = D_UMLA;
constexpr int HROWS = 4 * SEQ + 4 * CTXL;
constexpr size_t HA_K = 0, HA_V = HA_K + (size_t)HROWS * 544 * 2, HA_Q = HA_V + (size_t)HROWS * 512 * 2;
static_assert(HA_Q + (size_t)HROWS * 768 * 2 <= 2 * Y34, "half-A K/V/Q fit the xn region / d_out");

constexpr size_t D_SCR = WS_DYN + 68 * MiB;
constexpr size_t D_P12 = WS_DYN + 100 * MiB;
constexpr size_t D_M = WS_DYN;
constexpr size_t D_FFW = WS_DYN;
constexpr size_t D_XN2 = WS_DYN + 17 * MiB;
constexpr size_t D_H = D_URET;
constexpr size_t D_XG = WS_DYN;
constexpr size_t D_HM = WS_DYN + 132 * MiB;
constexpr size_t D_MOEW = D_HM + 363 * MiB / 2;
constexpr size_t WS_NEED = 512 * MiB;
static_assert(D_END1 <= WS_NEED && D_MOEW + 66 * MiB <= WS_NEED && D_H + 187 * MiB <= WS_NEED && D_Q + 51 * MiB <= D_URET, "ws map");

struct Params { const float* in[37]; float* out; unsigned char* ws; };
enum { I_X = 0, I_C, I_CTX, I_CCTX, I_NMIX, I_NFFN, I_WMOD, I_BMOD, I_WIN, I_MU, I_W0, I_W2, I_A0, I_A2, I_G2, I_KK, I_KA, I_RK, I_LNG, I_LNB,
       I_RDEC, I_RLNG, I_RLNB, I_QN, I_QUP, I_KVN, I_KVUP, I_WBR, I_WOUT, I_FG, I_FU, I_FD, I_ROUTER, I_MG, I_MU2, I_MD, I_FNORM };

__device__ __forceinline__ unsigned f2bf(float f) { unsigned u = __builtin_bit_cast(unsigned, f); return (u + 0x7fffu + ((u >> 16) & 1u)) >> 16; }
typedef __bf16 bf16x2_t __attribute__((ext_vector_type(2)));
__device__ __forceinline__ unsigned pk2(float lo, float hi) { const f32x2 v = {lo, hi}; return __builtin_bit_cast(unsigned, __builtin_convertvector(v, bf16x2_t)); }
__device__ __forceinline__ float bf2f(unsigned short b) { return __builtin_bit_cast(float, (unsigned)b << 16); }
__device__ __forceinline__ float bflo(unsigned w) { return __builtin_bit_cast(float, w << 16); }
__device__ __forceinline__ float bfhi(unsigned w) { return __builtin_bit_cast(float, w & 0xffff0000u); }
__device__ __forceinline__ float shx(float v, int m, int lane) { return __int_as_float(__builtin_amdgcn_ds_bpermute((lane ^ m) << 2, __float_as_int(v))); }
__device__ __forceinline__ float wave_sum(float v, int lane) {
#pragma unroll
    for (int o = 1; o < 64; o <<= 1) v += shx(v, o, lane);
    return v;
}
__device__ __forceinline__ float sigmoidf_(float x) { return __builtin_amdgcn_rcpf(1.0f + __builtin_amdgcn_exp2f(-1.4426950408889634f * x)); }
__device__ __forceinline__ float siluf_(float x) { return x * __builtin_amdgcn_rcpf(1.0f + __builtin_amdgcn_exp2f(-1.4426950408889634f * x)); }
__device__ __forceinline__ void unpack8(u32x4 w, float* f) { f[0] = bflo(w.x); f[1] = bfhi(w.x); f[2] = bflo(w.y); f[3] = bfhi(w.y); f[4] = bflo(w.z); f[5] = bfhi(w.z); f[6] = bflo(w.w); f[7] = bfhi(w.w); }
__device__ __forceinline__ u32x4 pack8(const float* f) { u32x4 w; w.x = pk2(f[0], f[1]); w.y = pk2(f[2], f[3]); w.z = pk2(f[4], f[5]); w.w = pk2(f[6], f[7]); return w; }

namespace pg8 {
constexpr int BM = 256, BK = 64, HALF = 128, HTB = HALF * BK * 2, STAGE_BYTES = 8 * HTB, NXCD = 8, WGM = 4;
__host__ __device__ __forceinline__ int lds_byte(int r, int c) { const int st = (r >> 4) * 2 + (c >> 5), rr = r & 15, cc = c & 31, ob = rr * 64 + cc * 2; return st * 1024 + (ob ^ (((ob >> 9) & 1) << 5)); }
__host__ __device__ __forceinline__ void stage_rc(int b, int& R, int& C) { const int st = b / 1024, sb = b % 1024, swz = sb ^ (((sb >> 9) & 1) << 5); R = (st >> 1) * 16 + swz / 64; C = (st & 1) * 32 + (swz % 64) / 2; }
__host__ __device__ __forceinline__ int perm32(int rho) { const int n = rho >> 4, i = rho & 15; return 8 * (i >> 2) + 4 * n + (i & 3); }

struct Seg { const char* A; const char* B; int nt; int pm, pn, aux; bool first, last; };

__device__ __forceinline__ void tile_order(int L, int nM, int nN, int& pm, int& pn) {
    const int nwg = nM * nN; int wgid = L;
    { const int q = nwg / NXCD, r = nwg % NXCD, xcd = wgid % NXCD, off = wgid / NXCD; wgid = (xcd < r ? xcd * (q + 1) : r * (q + 1) + (xcd - r) * q) + off; }
    const int nig = WGM * nN, gid = wgid / nig, fm = gid * WGM, gsz = (nM - fm) < WGM ? (nM - fm) : WGM;
    pm = fm + ((wgid % nig) % gsz); pn = (wgid % nig) / gsz;
}

template <int LDA, int LDB, bool PERM, class Sched, class Epi>
__device__ __forceinline__ void gemm_phase(LAS unsigned char* lds, const Sched& S, const Epi& E) {
    int tid_ = threadIdx.x; asm volatile("" : "+v"(tid_));
    const int tid = tid_, wid = __builtin_amdgcn_readfirstlane(tid >> 6), lane = tid & 63, wr = wid >> 2, wc = wid & 3, fr = lane & 15, fq = lane >> 4;
    unsigned voffA[2], voffB[2];
#pragma unroll
    for (int i = 0; i < 2; ++i) { int R, C; stage_rc(tid * 16 + i * 8192, R, C); const int Rb = PERM ? ((R & ~31) + perm32(R & 31)) : R;
        voffA[i] = (unsigned)(R * LDA + C) * 2u; voffB[i] = (unsigned)(Rb * LDB + C) * 2u; }
    constexpr size_t kstep = (size_t)(BK * 2);
    constexpr size_t hstepA = (size_t)HALF * LDA * 2, hstepB = (size_t)HALF * LDB * 2;
    const unsigned ldsw = (unsigned)wid * 1024u;
    const int aoff = lds_byte(wr * 64 + fr, fq * 8), boff = lds_byte(wc * 32 + fr, fq * 8);
#define PG8_SA(b, h) (((b) * 2 + (h)) * HTB)
#define PG8_SB(b, h) ((4 + (b) * 2 + (h)) * HTB)
#define PG8_STAGE(bufoff, gbase, voff) do { _Pragma("unroll") for (int _i = 0; _i < 2; ++_i) \
        __builtin_amdgcn_global_load_lds((const unsigned*)((const char*)(gbase) + (voff)[_i]), (LAS unsigned*)(lds + (bufoff) + ldsw + _i * 8192), 16, 0, 0); } while (0)
#define PG8_LDA(dst, b, h) do { _Pragma("unroll") for (int m = 0; m < 4; ++m) _Pragma("unroll") for (int k = 0; k < 2; ++k) dst[m][k] = *(const LAS bf16x8*)(lds + PG8_SA(b, h) + aoff + m * 2048 + k * 1024); } while (0)
#define PG8_LDB(dst, b, h) do { _Pragma("unroll") for (int n = 0; n < 2; ++n) _Pragma("unroll") for (int k = 0; k < 2; ++k) dst[n][k] = *(const LAS bf16x8*)(lds + PG8_SB(b, h) + boff + n * 2048 + k * 1024); } while (0)
#define PG8_MMA(ai, bj, At, Bt) do { __builtin_amdgcn_s_setprio(1); _Pragma("unroll") for (int m = 0; m < 4; ++m) _Pragma("unroll") for (int n = 0; n < 2; ++n) _Pragma("unroll") for (int k = 0; k < 2; ++k) \
        acc[ai][bj][m][n] = __builtin_amdgcn_mfma_f32_16x16x32_bf16(Bt[n][k], At[m][k], acc[ai][bj][m][n], 0, 0, 0); __builtin_amdgcn_s_setprio(0); } while (0)
#define PG8_WAIT_V(n) asm volatile("s_waitcnt vmcnt(" #n ")" ::: "memory")
#define PG8_WAIT_L(n) asm volatile("s_waitcnt lgkmcnt(" #n ")" ::: "memory")
#define PG8_BAR __builtin_amdgcn_s_barrier()
#define PG8_SCHED __builtin_amdgcn_sched_barrier(0)
    Seg cur, nxt; int ui = 0;
    if (!S.next(0, cur)) return;
    f32x4 acc[2][2][4][2];
#pragma unroll
    for (int a = 0; a < 2; ++a)
#pragma unroll
        for (int b = 0; b < 2; ++b)
#pragma unroll
            for (int m = 0; m < 4; ++m)
#pragma unroll
                for (int n = 0; n < 2; ++n) acc[a][b][m][n] = (f32x4){0.f, 0.f, 0.f, 0.f};
    bf16x8 At[4][2], B0[2][2], B1[2][2];
    const char* cA = cur.A; const char* cB = cur.B;
    PG8_STAGE(PG8_SB(0, 0), cB, voffB); PG8_STAGE(PG8_SB(0, 1), cB + hstepB, voffB); PG8_STAGE(PG8_SA(0, 0), cA, voffA); PG8_STAGE(PG8_SA(0, 1), cA + hstepA, voffA);
    if (wr == 1) PG8_BAR;
    PG8_WAIT_V(2); PG8_BAR;
    PG8_STAGE(PG8_SB(1, 0), cB + kstep, voffB); PG8_STAGE(PG8_SA(1, 0), cA + kstep, voffA); PG8_STAGE(PG8_SB(1, 1), cB + hstepB + kstep, voffB);
    PG8_WAIT_V(6); PG8_BAR;
    for (;;) {
        const bool has_next = S.next(ui + 1, nxt);
        const char* nA = has_next ? nxt.A : cA; const char* nB = has_next ? nxt.B : cB;
        const int nt = cur.nt;
        for (int t = 0; t < nt; t += 2) {
            const bool last = (t == nt - 2);
            const char* a1 = cA + (size_t)(t + 1) * kstep;
            const char* a2 = last ? nA : cA + (size_t)(t + 2) * kstep; const char* b2 = last ? nB : cB + (size_t)(t + 2) * kstep;
            const char* a3 = a2 + kstep; const char* b3 = b2 + kstep;
            PG8_LDB(B0, 0, 0); PG8_LDB(B1, 0, 1); PG8_SCHED; PG8_LDA(At, 0, 0); PG8_STAGE(PG8_SA(1, 1), a1 + hstepA, voffA);
            PG8_WAIT_V(8); PG8_WAIT_L(0); PG8_BAR; PG8_MMA(0, 0, At, B0); PG8_MMA(0, 1, At, B1); PG8_BAR; PG8_SCHED;
            PG8_LDA(At, 0, 1); PG8_STAGE(PG8_SB(0, 0), b2, voffB); PG8_STAGE(PG8_SB(0, 1), b2 + hstepB, voffB); PG8_STAGE(PG8_SA(0, 0), a2, voffA);
            PG8_WAIT_V(8); PG8_WAIT_L(0); PG8_BAR; PG8_MMA(1, 0, At, B0); PG8_MMA(1, 1, At, B1); PG8_BAR; PG8_SCHED;
            PG8_LDB(B0, 1, 0); PG8_LDB(B1, 1, 1); PG8_SCHED; PG8_LDA(At, 1, 0); PG8_STAGE(PG8_SA(0, 1), a2 + hstepA, voffA);
            PG8_WAIT_V(8); PG8_WAIT_L(0); PG8_BAR; PG8_MMA(0, 0, At, B0); PG8_MMA(0, 1, At, B1); PG8_BAR; PG8_SCHED;
            PG8_LDA(At, 1, 1); PG8_STAGE(PG8_SB(1, 0), b3, voffB); PG8_STAGE(PG8_SB(1, 1), b3 + hstepB, voffB); PG8_STAGE(PG8_SA(1, 0), a3, voffA);
            PG8_WAIT_V(8); PG8_WAIT_L(0); PG8_BAR; PG8_MMA(1, 0, At, B0); PG8_MMA(1, 1, At, B1); PG8_BAR; PG8_SCHED;
        }
        const bool was_last = cur.last;
        if (was_last) { if (wr == 0) PG8_BAR; E(acc, cur, wr, wc, fr, fq); }
        if (!has_next) break;
        if (nxt.first) {
#pragma unroll
            for (int a = 0; a < 2; ++a)
#pragma unroll
                for (int b = 0; b < 2; ++b)
#pragma unroll
                    for (int m = 0; m < 4; ++m)
#pragma unroll
                        for (int n = 0; n < 2; ++n) acc[a][b][m][n] = (f32x4){0.f, 0.f, 0.f, 0.f};
        }
        cur = nxt; cA = nA; cB = nB; ++ui;
        if (was_last) { if (wr == 1) PG8_BAR; }
    }
    PG8_WAIT_V(0);
    PG8_BAR;
#undef PG8_SA
#undef PG8_SB
#undef PG8_STAGE
#undef PG8_LDA
#undef PG8_LDB
#undef PG8_MMA
#undef PG8_WAIT_V
#undef PG8_WAIT_L
#undef PG8_BAR
#undef PG8_SCHED
}
}
using pg8::Seg;

struct Ctx {
    LAS unsigned char* lds; int tid, lane, wave, G, bid;
};
typedef const __attribute__((address_space(4))) Params* PP;
__device__ __forceinline__ PP getpp() { PP p = (PP)__builtin_amdgcn_kernarg_segment_ptr(); asm volatile("" : "+s"(p)); return p; }
__device__ __forceinline__ unsigned char* half_a_base(int layer) { PP p = getpp(); return layer == 0 ? (unsigned char*)p->out : p->ws + D_XN1; }
#define GW(F) ((F).bid * 8 + (F).wave)
#define NGW(F) ((F).G * 8)
#define LDS_WAIT() asm volatile("s_waitcnt lgkmcnt(0)" ::: "memory")

struct TrJob {
    const float* s0; const float* s1; int spitch; int K; int nd; int mode; int c0; int nvalid; const float* ks;
    bf16_t* dlo; bf16_t* dhi; int dpitch; int ksplit;
};
__device__ __forceinline__ void tr_item(const TrJob& J, LAS float* scr, int item, int lane) {
    const int nblk = J.nd / 32, kb = item / nblk, nb = item % nblk, k0 = 64 * kb, n0 = 32 * nb;
    const int np = n0 + (lane & 31);
    const float* src = J.s0; int col = 0; bool valid = true;
    if (J.mode == 0) { col = J.c0 + np; valid = np < J.nvalid; }
    else if (J.mode == 1) { if (np < 512) col = (np >> 6) * 128 + (np & 63); else col = ((np - 512) >> 6) * 128 + 64 + (np & 63); }
    else { const int tile = np >> 8, w = np & 255; if (w < 128) col = tile * 128 + w; else { col = tile * 128 + (w - 128); src = J.s1; } }
    if (!valid) col = J.c0;
    const float* sp = src + (size_t)(k0 + (lane >> 5)) * J.spitch + col;
    float v[32];
#pragma unroll
    for (int i = 0; i < 32; ++i) v[i] = __builtin_nontemporal_load(sp + (size_t)(2 * i) * J.spitch);
    if (J.ks) {
#pragma unroll
        for (int i = 0; i < 32; ++i) v[i] *= J.ks[k0 + 2 * i + (lane >> 5)]; }
#pragma unroll
    for (int i = 0; i < 32; ++i) scr[(2 * i + (lane >> 5)) * 33 + (lane & 31)] = valid ? v[i] : 0.f;
    LDS_WAIT(); asm volatile("" ::: "memory");
    const int c = lane & 7;
    bf16_t* dst = (k0 < J.ksplit) ? J.dlo : J.dhi; const int kd = (k0 < J.ksplit) ? k0 : k0 - J.ksplit;
#pragma unroll
    for (int j = 0; j < 4; ++j) { const int n = (lane >> 3) + 8 * j; const LAS float* s = scr + (8 * c) * 33 + n;
        u32x4 o; o.x = pk2(s[0 * 33], s[1 * 33]); o.y = pk2(s[2 * 33], s[3 * 33]); o.z = pk2(s[4 * 33], s[5 * 33]); o.w = pk2(s[6 * 33], s[7 * 33]);
        *(u32x4*)(dst + (size_t)(n0 + n) * J.dpitch + kd + 8 * c) = o; }
    LDS_WAIT(); asm volatile("" ::: "memory");
}
__device__ __forceinline__ void tr_job(const Ctx& F, const TrJob& J) {
    LAS float* scr = (LAS float*)(F.lds + F.wave * 8704);
    const int nitems = (J.K / 64) * (J.nd / 32);
    for (int it = GW(F); it < nitems; it += NGW(F)) tr_item(J, scr, it, F.lane);
}
__device__ __forceinline__ TrJob mk_job(const float* s0, int spitch, int K, int nd, int c0, int nvalid, bf16_t* dst, int dpitch) {
    TrJob J; J.s0 = s0; J.s1 = nullptr; J.spitch = spitch; J.K = K; J.nd = nd; J.mode = 0; J.c0 = c0; J.nvalid = nvalid; J.ks = nullptr; J.dlo = dst; J.dhi = dst; J.dpitch = dpitch; J.ksplit = 1 << 30; return J;
}

__device__ __forceinline__ void phase0(const Ctx& F) {
    PP P = getpp(); unsigned char* ws = P->ws;
    {
        float* cr = (float*)(ws + WS_ROPE_R); float* sr = cr + 4096 * 32; float* cm = (float*)(ws + WS_ROPE_M); float* sm = cm + 4096 * 16;
        for (int i = F.bid * NTHREADS + F.tid; i < 4096 * 48; i += F.G * NTHREADS) {
            const int t = i / 48, j = i % 48; const float row = (float)(t >> 6), colp = (float)(t & 63);
            if (j < 32) { const int f = j & 15; const float inv = powf(10000.0f, -(float)f / 16.0f); const float ang = (j < 16 ? row : colp) * inv; cr[t * 32 + j] = cosf(ang); sr[t * 32 + j] = sinf(ang); }
            else { const int jj = j - 32, f = jj & 7; const float inv = powf(10000.0f, -(float)f / 8.0f); const float ang = (jj < 8 ? row : colp) * inv; cm[t * 16 + jj] = cosf(ang); sm[t * 16 + jj] = sinf(ang); }
        }
        if (F.bid == 0 && F.tid < 64) ((unsigned*)(ws + WS_CTL))[F.tid] = 0u;
    }
    {
        LAS float* sc = (LAS float*)(F.lds + 70000);
        LAS float* red = (LAS float*)(F.lds + 70000 + 36864);
        for (int i = F.tid; i < 9 * 1024; i += NTHREADS) { const int v = i >> 10, k = i & 1023; const float x = v < 8 ? P->in[I_C][v * 1024 + k] : P->in[I_CCTX][k]; sc[i] = siluf_(x); }
        __syncthreads();
        for (int it = F.bid; it < 2 * 96; it += F.G) {
            const int l = it / 96, jc = F.tid & 63, j = (it % 96) * 64 + jc, ksl = F.tid >> 6;
            const float* w = P->in[I_WMOD] + (size_t)l * 1024 * 6144 + j + (size_t)(ksl * 128) * 6144;
            float a[9];
#pragma unroll
            for (int v = 0; v < 9; ++v) a[v] = 0.f;
#pragma unroll 1
            for (int k0 = 0; k0 < 128; k0 += 16) { float wv[16];
#pragma unroll
                for (int q = 0; q < 16; ++q) wv[q] = w[(size_t)(k0 + q) * 6144];
#pragma unroll
                for (int q = 0; q < 16; ++q)
#pragma unroll
                    for (int v = 0; v < 9; ++v) a[v] += sc[v * 1024 + ksl * 128 + k0 + q] * wv[q]; }
#pragma unroll
            for (int v = 0; v < 9; ++v) red[(ksl * 64 + jc) * 9 + v] = a[v];
            __syncthreads();
            if (F.tid < 64) {
                float* mo = (float*)(ws + WS_MOD) + (size_t)l * 9 * 6144;
#pragma unroll
                for (int v = 0; v < 9; ++v) { float s = 0.f;
#pragma unroll
                    for (int q = 0; q < 8; ++q) s += red[(q * 64 + F.tid) * 9 + v];
                    mo[v * 6144 + j] = s + P->in[I_BMOD][l * 6144 + j]; }
            }
            __syncthreads();
        }
    }
    for (int l = 0; l < 2; ++l) {
        unsigned char* wb = ws + WS_W + (size_t)l * WL_STRIDE;
        const float* win = P->in[I_WIN] + (size_t)l * 1024 * NIN;
        { TrJob J = mk_job(win, NIN, 1024, MIXP, 0, MIXC, (bf16_t*)(wb + WL_WINLO), 512); J.dhi = (bf16_t*)(wb + WL_WINHI); J.ksplit = 512; tr_job(F, J); }
        { TrJob J = mk_job(win, NIN, 1024, GATEC, MIXC, GATEC, (bf16_t*)(wb + WL_WGLO), 512); J.dhi = (bf16_t*)(wb + WL_WGHI); J.ksplit = 512; tr_job(F, J); }
        { TrJob J = mk_job(P->in[I_QUP] + (size_t)l * 384 * 768, 768, 384, 768, 0, 768, (bf16_t*)(wb + WL_WQ), 384); J.ks = P->in[I_QN] + l * 384; tr_job(F, J); }
        { TrJob J = mk_job(P->in[I_KVUP] + (size_t)l * 256 * 1024, 1024, 256, 1024, 0, 1024, (bf16_t*)(wb + WL_WKV), 256); J.mode = 1; J.ks = P->in[I_KVN] + l * 256; tr_job(F, J); }
        for (int n = 0; n < 3; ++n) { TrJob J = mk_job(P->in[I_WBR] + ((size_t)l * 3 + n) * 512 * 1024, 1024, 512, 1024, 0, 1024, (bf16_t*)(wb + WL_WB) + (size_t)n * 1024 * 512, 512); tr_job(F, J); }
        { TrJob J = mk_job(P->in[I_WOUT] + (size_t)l * 1024 * 1024, 1024, 1024, 1024, 0, 1024, (bf16_t*)(wb + WL_WO), 1024); tr_job(F, J); }
        { TrJob J = mk_job(P->in[I_G2] + (size_t)l * 128 * 512, 512, 128, 512, 0, 512, (bf16_t*)(ws + WS_WG2) + (size_t)l * 512 * 128, 128); tr_job(F, J); }
        for (int dd = 0; dd < 2; ++dd) {
            { TrJob J = mk_job(P->in[I_W2] + (size_t)(l * 2 + dd) * 64 * 512, 512, 64, 512, 0, 512, (bf16_t*)(ws + WS_W2T) + (size_t)((l * 2 + dd) * 2 + 0) * 512 * 64, 64); tr_job(F, J); }
            { TrJob J = mk_job(P->in[I_A2] + (size_t)(l * 2 + dd) * 64 * 512, 512, 64, 512, 0, 512, (bf16_t*)(ws + WS_W2T) + (size_t)((l * 2 + dd) * 2 + 1) * 512 * 64, 64); tr_job(F, J); }
        }
    }
}
__device__ __forceinline__ void convert_ffn0(const Ctx& F) {
    PP P = getpp(); unsigned char* ws = P->ws;
    bf16_t* glo = (bf16_t*)(ws + D_FFW); bf16_t* ghi = glo + (size_t)5632 * 512; bf16_t* wd = ghi + (size_t)5632 * 512;
    { TrJob J = mk_job(P->in[I_FG], DFF, 1024, 5632, 0, 5632, glo, 512); J.s1 = P->in[I_FU]; J.mode = 2; J.dhi = ghi; J.ksplit = 512; tr_job(F, J); }
    { TrJob J = mk_job(P->in[I_FD], 1024, DFF, 1024, 0, 1024, wd, DFF); tr_job(F, J); }
}
__device__ __forceinline__ void convert_moe(const Ctx& F) {
    PP P = getpp(); unsigned char* ws = P->ws;
    for (int e = 0; e < NEXP; ++e) {
        bf16_t* glo = (bf16_t*)(ws + D_MOEW + (size_t)e * (33 * MiB / 4)); bf16_t* ghi = glo + (size_t)2816 * 512; bf16_t* wd = ghi + (size_t)2816 * 512;
        { TrJob J = mk_job(P->in[I_MG] + (size_t)e * 1024 * DFE, DFE, 1024, 2816, 0, 2816, glo, 512); J.s1 = P->in[I_MU2] + (size_t)e * 1024 * DFE; J.mode = 2; J.dhi = ghi; J.ksplit = 512; tr_job(F, J); }
        { TrJob J = mk_job(P->in[I_MD] + (size_t)e * DFE * 1024, 1024, DFE, 1024, 0, 1024, wd, DFE); tr_job(F, J); }
    }
}

__device__ __forceinline__ void norm_pass(const Ctx& F, int layer, int which, const float* hl, const float* hcx, int nrows, bf16_t* xlo, bf16_t* xhi) {
    PP P = getpp();
    const float* gain = P->in[which ? I_NFFN : I_NMIX] + layer * 1024;
    const float* mod = (const float*)(P->ws + WS_MOD) + (size_t)layer * 9 * 6144 + (which ? 3072 : 0);
    const int rpw = (nrows + NGW(F) - 1) / NGW(F); const int r0 = GW(F) * rpw; const int r1 = (r0 + rpw < nrows) ? r0 + rpw : nrows;
    int vprev = -1; f32x4 gs[4], sh4[4];
    constexpr int NB = 4;
    for (int rb = r0; rb < r1; rb += NB) {
        f32x4 x[NB][4]; float ss[NB];
#pragma unroll
        for (int b = 0; b < NB; ++b) { const int row = (rb + b < r1) ? rb + b : r1 - 1;
            const float* src = row < RL ? hl + (size_t)row * 1024 : hcx + (size_t)(row - RL) * 1024; ss[b] = 0.f;
#pragma unroll
            for (int j = 0; j < 4; ++j) { x[b][j] = *(const f32x4*)(src + 4 * F.lane + 256 * j); ss[b] += x[b][j].x * x[b][j].x + x[b][j].y * x[b][j].y + x[b][j].z * x[b][j].z + x[b][j].w * x[b][j].w; } }
#pragma unroll
        for (int b = 0; b < NB; ++b) ss[b] = wave_sum(ss[b], F.lane);
#pragma unroll
        for (int b = 0; b < NB; ++b) { const int row = (rb + b < r1) ? rb + b : r1 - 1;
            const int v = row < RL ? (row >> 12) : 8;
            if (v != vprev) { const float* sh = mod + v * 6144; const float* sc = sh + 1024;
#pragma unroll
                for (int j = 0; j < 4; ++j) { const int c = 4 * F.lane + 256 * j; gs[j] = *(const f32x4*)(gain + c) * (*(const f32x4*)(sc + c) + 1.0f); sh4[j] = *(const f32x4*)(sh + c); }
                vprev = v; }
            const float rstd = rsqrtf(ss[b] * (1.0f / 1024.0f) + 1e-6f);
#pragma unroll
            for (int j = 0; j < 4; ++j) { const int c = 4 * F.lane + 256 * j;
                const f32x4 y = x[b][j] * rstd * gs[j] + sh4[j];
                u32x2 o; o.x = pk2(y.x, y.y); o.y = pk2(y.z, y.w);
                bf16_t* d = (c < 512) ? xlo + (size_t)row * 512 + c : xhi + (size_t)row * 512 + (c - 512);
                *(u32x2*)d = o; } }
    }
}

struct SchedSplit2 {
    const char *Alo, *Ahi, *Blo, *Bhi; int nM, nN, G, c;
    __device__ __forceinline__ bool next(int i, Seg& s) const {
        const int iu = i >> 1, h = i & 1; const long L = (long)iu * G + c; if (L >= (long)nM * nN) return false;
        int pm, pn; pg8::tile_order((int)L, nM, nN, pm, pn);
        s.A = (h ? Ahi : Alo) + (size_t)pm * 256 * 1024; s.B = (h ? Bhi : Blo) + (size_t)pn * 256 * 1024; s.nt = 8; s.pm = pm; s.pn = pn; s.aux = 0; s.first = (h == 0); s.last = (h == 1); return true;
    }
};
struct Sched1 {
    const char *A, *B; size_t astride, bstride; int nt, nM, nN, G, c;
    __device__ __forceinline__ bool next(int i, Seg& s) const {
        const long L = (long)i * G + c; if (L >= (long)nM * nN) return false;
        int pm, pn; pg8::tile_order((int)L, nM, nN, pm, pn);
        s.A = A + (size_t)pm * astride; s.B = B + (size_t)pn * bstride; s.nt = nt; s.pm = pm; s.pn = pn; s.aux = 0; s.first = true; s.last = true; return true;
    }
};
struct SchedHalf {
    const char *A, *B; size_t astride, bstride; int nt, nN, half, G, c;
    __device__ __forceinline__ bool next(int i, Seg& s) const {
        const long L = (long)i * G + c; if (L >= (long)68 * nN) return false;
        int mi, pn; pg8::tile_order((int)L, 68, nN, mi, pn);
        const int pm = mi < 64 ? 64 * half + mi : 128 + 4 * half + (mi - 64);
        s.A = A + (size_t)pm * astride; s.B = B + (size_t)pn * bstride; s.nt = nt; s.pm = pm; s.pn = pn; s.aux = 0; s.first = true; s.last = true; return true;
    }
};
struct SchedMerge {
    const char *XNlo, *XNhi, *WgLo, *WgHi, *wsb, *Wb; int nM, G, c; bool ctx3;
    __device__ __forceinline__ void fill(Seg& s, int pm, int pn, int n, int k, int ctxbit) const {
        s.pm = pm; s.pn = pn; s.nt = 8;
        if (k == 0) { s.A = XNlo + (size_t)pm * 256 * 1024; s.B = WgLo + (size_t)(n * 1024 + pn * 256) * 1024; s.first = true; s.last = false; s.aux = n * 2; }
        else if (k == 1) { s.A = XNhi + (size_t)pm * 256 * 1024; s.B = WgHi + (size_t)(n * 1024 + pn * 256) * 1024; s.first = false; s.last = true; s.aux = n * 2; }
        else { const size_t yo = (n == 0) ? D_YRWKV : ((n == 1) ? D_YRET : D_YMLA); s.A = wsb + yo + (size_t)pm * 256 * 1024; s.B = Wb + (size_t)(n * 1024 + pn * 256) * 1024; s.first = true; s.last = true; s.aux = n * 2 + 1 + ctxbit; }
    }
    __device__ __forceinline__ bool next(int i, Seg& s) const {
        const int nMl = ctx3 ? RL / 256 : nM; const int NL = nMl * 4;
        const int kmax = (NL - c + G - 1) / G;
        if (i < 9 * kmax) { const int su = i / 9, r = i % 9; const long L = (long)su * G + c; int pm, pn; pg8::tile_order((int)L, nMl, 4, pm, pn); fill(s, pm, pn, r / 3, r % 3, 0); return true; }
        if (!ctx3) return false;
        const int j = i - 9 * kmax, t = j / 3, k = j % 3; const long idx = (long)t * G + c; if (idx >= 96) return false;
        const int tile = (int)idx / 3, n = (int)idx % 3; fill(s, RL / 256 + (tile & 7), tile >> 3, n, k, 8); return true;
    }
};
struct SchedWout0 {
    const char *A, *B, *wsb; int G, c;
    __device__ __forceinline__ bool next(int i, Seg& s) const {
        if (c < 32) { if (i >= 3) return false; const int pmc = c & 7, pn = c >> 3;
            const size_t ao = (i == 0) ? D_M + (size_t)RL * 1024 * 2 : ((i == 1) ? D_P12 : D_P12 + (size_t)RC * 1024 * 2);
            s.A = wsb + ao + (size_t)pmc * 256 * 1024 * 2; s.B = B + (size_t)pn * 256 * 1024 * 2; s.nt = 16; s.pm = RL / 256 + pmc; s.pn = pn; s.aux = 0; s.first = (i == 0); s.last = (i == 2); return true; }
        const long L = (long)i * (G - 32) + (c - 32); if (L >= (RL / 256) * 4) return false;
        int pm, pn; pg8::tile_order((int)L, RL / 256, 4, pm, pn);
        s.A = A + (size_t)pm * 256 * 1024 * 2; s.B = B + (size_t)pn * 256 * 1024 * 2; s.nt = 16; s.pm = pm; s.pn = pn; s.aux = 0; s.first = true; s.last = true; return true;
    }
};
struct MoeTiles { int tstart[NEXP + 1]; };
__device__ __forceinline__ MoeTiles moe_tiles(const unsigned* cnt) {
    MoeTiles T; int a = 0;
#pragma unroll
    for (int e = 0; e < NEXP; ++e) { T.tstart[e] = a; a += (int)((__builtin_amdgcn_readfirstlane(cnt[e]) + 255u) >> 8); }
    T.tstart[NEXP] = a; return T;
}
__device__ __forceinline__ int moe_expert_of(const MoeTiles& T, int mt) { int e = 0;
#pragma unroll
    for (int k = 1; k < NEXP; ++k) e += (mt >= T.tstart[k]) ? 1 : 0;
    return e; }
struct SchedMoeUp {
    const char *Alo, *Ahi, *W; MoeTiles T; int G, c;
    __device__ __forceinline__ bool next(int i, Seg& s) const {
        const int iu = i >> 1, h = i & 1; const int nM = T.tstart[NEXP]; const long L = (long)iu * G + c; if (L >= (long)nM * 11) return false;
        int pm, pn; pg8::tile_order((int)L, nM, 11, pm, pn);
        const int e = moe_expert_of(T, pm); const char* we = W + (size_t)e * (33 * MiB / 4);
        s.A = (h ? Ahi : Alo) + (size_t)pm * 256 * 1024; s.B = we + (h ? (size_t)2816 * 1024 : 0) + (size_t)pn * 256 * 1024; s.nt = 8; s.pm = pm; s.pn = pn; s.aux = e; s.first = (h == 0); s.last = (h == 1); return true;
    }
};
struct SchedMoeDown {
    const char *A, *W; MoeTiles T; int G, c;
    __device__ __forceinline__ bool next(int i, Seg& s) const {
        const int nM = T.tstart[NEXP]; const long L = (long)i * G + c; if (L >= (long)nM * 4) return false;
        int pm, pn; pg8::tile_order((int)L, nM, 4, pm, pn);
        const int e = moe_expert_of(T, pm); const char* we = W + (size_t)e * (33 * MiB / 4) + (size_t)2 * 2816 * 1024;
        s.A = A + (size_t)pm * 256 * DFE * 2; s.B = we + (size_t)pn * 256 * DFE * 2; s.nt = 22; s.pm = pm; s.pn = pn; s.aux = e; s.first = true; s.last = true; return true;
    }
};

typedef f32x4 Acc[2][2][4][2];
struct EpiInproj {
    unsigned char* ws;
    __device__ __forceinline__ void operator()(const Acc& acc, const Seg& u, int wr, int wc, int fr, int fq) const {
        const int row0 = u.pm * 256 + wr * 64 + fr;
#pragma unroll
        for (int bj = 0; bj < 2; ++bj) {
            const int c0 = u.pn * 256 + bj * 128 + wc * 32 + 8 * fq;
            const bool a = c0 < RWC, b = c0 < RWC + REC;
            const size_t boff = a ? D_URWKV : (b ? D_URET : D_UMLA); const int pitch = a ? RWC : (b ? REC : MLC); const int col = c0 - (a ? 0 : (b ? RWC : RWC + REC));
            bf16_t* base = (bf16_t*)(ws + boff);
            if (c0 < MIXC) {
#pragma unroll
                for (int ai = 0; ai < 2; ++ai)
#pragma unroll
                    for (int m = 0; m < 4; ++m) { const int row = row0 + ai * 128 + m * 16; const f32x4 v0 = acc[ai][bj][m][0], v1 = acc[ai][bj][m][1];
                        u32x4 w; w.x = pk2(v0[0], v0[1]); w.y = pk2(v0[2], v0[3]); w.z = pk2(v1[0], v1[1]); w.w = pk2(v1[2], v1[3]);
                        *(u32x4*)(base + (size_t)row * pitch + col) = w; }
            }
        }
    }
};
struct EpiQup {
    bf16_t* Q; const float* rstd; const float* cosm; const float* sinm; int compact;
    __device__ __forceinline__ void operator()(const Acc& acc, const Seg& u, int wr, int wc, int fr, int fq) const {
        const int row0 = u.pm * 256 + wr * 64 + fr;
#pragma unroll
        for (int ai = 0; ai < 2; ++ai)
#pragma unroll
            for (int m = 0; m < 4; ++m) { const int row = row0 + ai * 128 + m * 16; const float rs = rstd[row]; const bool lat = row < RL; const int t = row & 4095;
#pragma unroll
                for (int bj = 0; bj < 2; ++bj) { const int cb = u.pn * 256 + bj * 128 + wc * 32; const bool rope = lat && ((cb % 96) == 64);
                    f32x4 x1 = acc[ai][bj][m][0] * rs, x2 = acc[ai][bj][m][1] * rs;
                    if (rope) { const f32x4 cs = *(const f32x4*)(cosm + t * 16 + 4 * fq), sn = *(const f32x4*)(sinm + t * 16 + 4 * fq);
                        const f32x4 o1 = x1 * cs - x2 * sn, o2 = x1 * sn + x2 * cs; x1 = o1; x2 = o2; }
                    u32x2 a, b; a.x = pk2(x1[0], x1[1]); a.y = pk2(x1[2], x1[3]); b.x = pk2(x2[0], x2[1]); b.y = pk2(x2[2], x2[3]);
                    const int orow = compact ? (lat ? row : row - RL + 4 * SEQ) : row;
                    bf16_t* d = Q + (size_t)orow * 768 + cb + 4 * fq; *(u32x2*)d = a; *(u32x2*)(d + 16) = b; } }
    }
};
struct EpiKVup {
    bf16_t *Kb, *Vb; const float* rstd; int compact;
    __device__ __forceinline__ void operator()(const Acc& acc, const Seg& u, int wr, int wc, int fr, int fq) const {
        const int row0 = u.pm * 256 + wr * 64 + fr;
#pragma unroll
        for (int ai = 0; ai < 2; ++ai)
#pragma unroll
            for (int m = 0; m < 4; ++m) { const int row = row0 + ai * 128 + m * 16; const float rs = rstd[row];
#pragma unroll
                for (int bj = 0; bj < 2; ++bj) { const int c0 = u.pn * 256 + bj * 128 + wc * 32 + 8 * fq; const f32x4 v0 = acc[ai][bj][m][0] * rs, v1 = acc[ai][bj][m][1] * rs;
                    u32x4 w; w.x = pk2(v0[0], v0[1]); w.y = pk2(v0[2], v0[3]); w.z = pk2(v1[0], v1[1]); w.w = pk2(v1[2], v1[3]);
                    const int orow = compact ? (row < RL ? row : row - RL + 4 * SEQ) : row;
                    bf16_t* d = (u.pn < 2) ? Kb + (size_t)orow * 544 + c0 : Vb + (size_t)orow * 512 + (c0 - 512);
                    *(u32x4*)d = w; } }
    }
};
struct EpiMerge {
    u32x4* scr; bf16_t* M; bf16_t* P12;
    __device__ __forceinline__ void operator()(const Acc& acc, const Seg& u, int wr, int wc, int fr, int fq) const {
        int tid = threadIdx.x; asm volatile("" : "+v"(tid));
        if ((u.aux & 1) == 0) {
#pragma unroll
            for (int ai = 0; ai < 2; ++ai)
#pragma unroll
                for (int bj = 0; bj < 2; ++bj)
#pragma unroll
                    for (int m = 0; m < 4; ++m) { const f32x4 v0 = acc[ai][bj][m][0], v1 = acc[ai][bj][m][1];
                        u32x4 w; w.x = pk2(sigmoidf_(v0[0]), sigmoidf_(v0[1])); w.y = pk2(sigmoidf_(v0[2]), sigmoidf_(v0[3])); w.z = pk2(sigmoidf_(v1[0]), sigmoidf_(v1[1])); w.w = pk2(sigmoidf_(v1[2]), sigmoidf_(v1[3]));
                        scr[((ai * 2 + bj) * 4 + m) * 512 + tid] = w; }
        } else {
            const int n = (u.aux & 7) >> 1; const bool part = (u.aux & 8) != 0; const int row0 = u.pm * 256 + wr * 64 + fr;
#pragma unroll
            for (int ai = 0; ai < 2; ++ai)
#pragma unroll
                for (int bj = 0; bj < 2; ++bj)
#pragma unroll
                    for (int m = 0; m < 4; ++m) { const int row = row0 + ai * 128 + m * 16; const int c0 = u.pn * 256 + bj * 128 + wc * 32 + 8 * fq;
                        const u32x4 g = scr[((ai * 2 + bj) * 4 + m) * 512 + tid]; float gf[8], pf[8]; unpack8(g, gf);
                        const f32x4 v0 = acc[ai][bj][m][0], v1 = acc[ai][bj][m][1];
                        bf16_t* d = (part && n > 0) ? P12 + (size_t)(n - 1) * RC * 1024 + (size_t)(row - RL) * 1024 + c0 : M + (size_t)row * 1024 + c0;
                        if (n > 0 && !part) { const u32x4 pv = *(const u32x4*)d; unpack8(pv, pf); } else {
#pragma unroll
                            for (int j = 0; j < 8; ++j) pf[j] = 0.f; }
#pragma unroll
                        for (int j = 0; j < 4; ++j) { pf[j] += gf[j] * v0[j]; pf[4 + j] += gf[4 + j] * v1[j]; }
                        *(u32x4*)d = pack8(pf); }
        }
    }
};
struct EpiResid {
    const float *srcl, *srcc; float *dstl, *dstc; const float* mod; int goff;
    __device__ __forceinline__ void operator()(const Acc& acc, const Seg& u, int wr, int wc, int fr, int fq) const {
        const int row0 = u.pm * 256 + wr * 64 + fr;
#pragma unroll
        for (int ai = 0; ai < 2; ++ai)
#pragma unroll
            for (int m = 0; m < 4; ++m) { const int row = row0 + ai * 128 + m * 16; const bool lat = row < RL;
                const size_t ro = lat ? (size_t)row * 1024 : (size_t)(row - RL) * 1024; const float* s = (lat ? srcl : srcc) + ro; float* d = (lat ? dstl : dstc) + ro;
                const float* g = mod + (lat ? (row >> 12) : 8) * 6144 + goff;
#pragma unroll
                for (int bj = 0; bj < 2; ++bj)
#pragma unroll
                    for (int n = 0; n < 2; ++n) { const int c = u.pn * 256 + bj * 128 + wc * 32 + 16 * n + 4 * fq;
                        const f32x4 sv = *(const f32x4*)(s + c), gv = *(const f32x4*)(g + c); *(f32x4*)(d + c) = sv + gv * acc[ai][bj][m][n]; } }
    }
};
struct EpiSwiglu {
    bf16_t* H; int pitch;
    __device__ __forceinline__ void operator()(const Acc& acc, const Seg& u, int wr, int wc, int fr, int fq) const {
        const int row0 = u.pm * 256 + wr * 64 + fr; const int c0 = u.pn * 128 + wc * 32 + 8 * fq;
#pragma unroll
        for (int ai = 0; ai < 2; ++ai)
#pragma unroll
            for (int m = 0; m < 4; ++m) { const int row = row0 + ai * 128 + m * 16; float o[8];
#pragma unroll
                for (int n = 0; n < 2; ++n)
#pragma unroll
                    for (int j = 0; j < 4; ++j) o[4 * n + j] = siluf_(acc[ai][0][m][n][j]) * acc[ai][1][m][n][j];
                *(u32x4*)(H + (size_t)row * pitch + c0) = pack8(o); }
    }
};
struct EpiBf16 {
    bf16_t* O; int pitch;
    __device__ __forceinline__ void operator()(const Acc& acc, const Seg& u, int wr, int wc, int fr, int fq) const {
        const int row0 = u.pm * 256 + wr * 64 + fr;
#pragma unroll
        for (int ai = 0; ai < 2; ++ai)
#pragma unroll
            for (int m = 0; m < 4; ++m) { const int row = row0 + ai * 128 + m * 16;
#pragma unroll
                for (int bj = 0; bj < 2; ++bj) { const int c0 = u.pn * 256 + bj * 128 + wc * 32 + 8 * fq; const f32x4 v0 = acc[ai][bj][m][0], v1 = acc[ai][bj][m][1];
                    u32x4 w; w.x = pk2(v0[0], v0[1]); w.y = pk2(v0[2], v0[3]); w.z = pk2(v1[0], v1[1]); w.w = pk2(v1[2], v1[3]);
                    *(u32x4*)(O + (size_t)row * pitch + c0) = w; } }
    }
};

namespace attn {
constexpr float SCALE = 0.10206207261596577f;
constexpr float THR = 8.f;
constexpr int KP = 208;
constexpr int SHM_V = 8192, SHM_K = 64 * KP;
constexpr int OFF_V = 0, OFF_K = 2 * SHM_V, OFF_WS = OFF_K + 2 * SHM_K, SHM_TOTAL = OFF_WS + 8 * 64 * 4;
#define SBAR() __builtin_amdgcn_sched_barrier(0)
__device__ __forceinline__ int crow(int r, int hi) { return (r & 3) + 8 * (r >> 2) + 4 * hi; }
__device__ __forceinline__ unsigned cvtpk(float lo, float hi) { unsigned r; asm volatile("v_cvt_pk_bf16_f32 %0, %1, %2" : "=v"(r) : "v"(lo), "v"(hi)); return r; }
__device__ __forceinline__ void partialSM(f32x16& p0, f32x16& p1, float& m_reg, float& mn, float& alpha) {
    constexpr float C = SCALE * 1.4426950408889634f;
    float pmax = p0[0];
#pragma unroll
    for (int r = 1; r < 16; ++r) pmax = fmaxf(pmax, p0[r]);
#pragma unroll
    for (int r = 0; r < 16; ++r) pmax = fmaxf(pmax, p1[r]);
    { auto rr = __builtin_amdgcn_permlane32_swap(__float_as_uint(pmax), __float_as_uint(pmax), false, false); pmax = fmaxf(__uint_as_float(rr[0]), __uint_as_float(rr[1])); }
    if (__builtin_expect(__all(pmax - m_reg <= THR / SCALE), 1)) { mn = m_reg; alpha = 1.f; }
    else { mn = fmaxf(m_reg, pmax); alpha = __builtin_amdgcn_exp2f((m_reg - mn) * C); m_reg = mn; }
    const float mnC = -mn * C;
#pragma unroll
    for (int r = 0; r < 16; ++r) p0[r] = fmaf(p0[r], C, mnC);
#pragma unroll
    for (int r = 0; r < 16; ++r) p1[r] = fmaf(p1[r], C, mnC);
#pragma unroll
    for (int r = 0; r < 16; ++r) p0[r] = __builtin_amdgcn_exp2f(p0[r]);
}
__device__ __forceinline__ void finishSM(f32x16& p0, f32x16& p1, float alpha, float& l_reg, bf16x8& pa0, bf16x8& pa1, bf16x8& pa2, bf16x8& pa3) {
#pragma unroll
    for (int r = 0; r < 16; ++r) p1[r] = __builtin_amdgcn_exp2f(p1[r]);
    float ps = 0;
#pragma unroll
    for (int r = 0; r < 16; ++r) ps += p0[r];
#pragma unroll
    for (int r = 0; r < 16; ++r) ps += p1[r];
    { auto rr = __builtin_amdgcn_permlane32_swap(__float_as_uint(ps), __float_as_uint(ps), false, false); ps = __uint_as_float(rr[0]) + __uint_as_float(rr[1]); }
    l_reg = l_reg * alpha + ps;
#define PK4(P, BASE, OUT) do { unsigned a0 = cvtpk(P[BASE + 0], P[BASE + 1]), a1 = cvtpk(P[BASE + 2], P[BASE + 3]);   \
    unsigned b0 = cvtpk(P[BASE + 4], P[BASE + 5]), b1 = cvtpk(P[BASE + 6], P[BASE + 7]);                              \
    auto r0 = __builtin_amdgcn_permlane32_swap(a0, b0, false, false); auto r1 = __builtin_amdgcn_permlane32_swap(a1, b1, false, false); \
    u32x4 w = {r0[0], r1[0], r0[1], r1[1]}; OUT = __builtin_bit_cast(bf16x8, w); } while (0)
    PK4(p0, 0, pa0); PK4(p0, 8, pa1); PK4(p1, 0, pa2); PK4(p1, 8, pa3);
#undef PK4
}
__device__ __forceinline__ void qkt(f32x16& p0, f32x16& p1, const LAS unsigned char* Ks, const bf16x8* qr, int r32, int hi) {
    p0 = f32x16{}; p1 = f32x16{};
#pragma unroll
    for (int d0 = 0; d0 < 6; ++d0) { const int cb = (d0 * 16 + hi * 8) * 2;
        const bf16x8 b0 = *(const LAS bf16x8*)(Ks + r32 * KP + cb);
        const bf16x8 b1 = *(const LAS bf16x8*)(Ks + (32 + r32) * KP + cb);
        p0 = __builtin_amdgcn_mfma_f32_32x32x16_bf16(b0, qr[d0], p0, 0, 0, 0);
        p1 = __builtin_amdgcn_mfma_f32_32x32x16_bf16(b1, qr[d0], p1, 0, 0, 0); }
}
__device__ __forceinline__ int v_st(int k, int c) { const int kk = (k & ~0xC) | ((k & 4) << 1) | ((k & 8) >> 1); return ((kk >> 3) * 2 + (c >> 5)) * 512 + ((kk & 7) * 32 + (c & 31)) * 2; }
__device__ __forceinline__ int v_rd_base(int lane) { return ((lane & 3) << 3) | (((lane >> 2) & 3) << 6) | (((lane >> 4) & 1) << 5) | (((lane >> 5) & 1) << 8); }
constexpr int v_rd_off(int d0, int ks, int half) { return d0 * 512 + ks * 2048 + half * 1024; }
template <int OFF> __device__ __forceinline__ s16x4 tr_read(int vb) { s16x4 r; asm volatile("ds_read_b64_tr_b16 %0, %1 offset:%2" : "=&v"(r) : "v"(vb), "i"(OFF) : "memory"); return r; }
template <int D0> __device__ __forceinline__ void pv_one(f32x16& od, int vb, bf16x8 pa0, bf16x8 pa1, bf16x8 pa2, bf16x8 pa3) {
    const s16x4 l0 = tr_read<v_rd_off(D0, 0, 0)>(vb), h0 = tr_read<v_rd_off(D0, 0, 1)>(vb), l1 = tr_read<v_rd_off(D0, 1, 0)>(vb), h1 = tr_read<v_rd_off(D0, 1, 1)>(vb);
    const s16x4 l2 = tr_read<v_rd_off(D0, 2, 0)>(vb), h2 = tr_read<v_rd_off(D0, 2, 1)>(vb), l3 = tr_read<v_rd_off(D0, 3, 0)>(vb), h3 = tr_read<v_rd_off(D0, 3, 1)>(vb);
    asm volatile("s_waitcnt lgkmcnt(0)" ::: "memory"); SBAR();
#define PK(L, H) (bf16x8){L[0], L[1], L[2], L[3], H[0], H[1], H[2], H[3]}
    od = __builtin_amdgcn_mfma_f32_32x32x16_bf16(pa0, PK(l0, h0), od, 0, 0, 0);
    od = __builtin_amdgcn_mfma_f32_32x32x16_bf16(pa1, PK(l1, h1), od, 0, 0, 0);
    od = __builtin_amdgcn_mfma_f32_32x32x16_bf16(pa2, PK(l2, h2), od, 0, 0, 0);
    od = __builtin_amdgcn_mfma_f32_32x32x16_bf16(pa3, PK(l3, h3), od, 0, 0, 0);
#undef PK
}
__device__ __forceinline__ void pv_d0(f32x16* o, int vb, bf16x8 pa0, bf16x8 pa1, bf16x8 pa2, bf16x8 pa3) { pv_one<0>(o[0], vb, pa0, pa1, pa2, pa3); pv_one<1>(o[1], vb, pa0, pa1, pa2, pa3); }

__device__ __forceinline__ void attn_unit(const bf16_t* __restrict__ Qb, const bf16_t* __restrict__ Kn, const bf16_t* __restrict__ Kr, const bf16_t* __restrict__ Vh,
                                          bf16_t* __restrict__ Ob, long lat0, long ctx0, int nlat, int NT, LAS unsigned char* lds) {
    int tid_ = threadIdx.x; asm volatile("" : "+v"(tid_));
    const int tid = tid_, wid = tid >> 6, lane = tid & 63, r32 = lane & 31, hi = lane >> 5;
    LAS unsigned char* V_lds = lds + OFF_V; LAS unsigned char* K_lds = lds + OFF_K;
    LAS float* ws = (LAS float*)(lds + OFF_WS) + wid * 64; LAS float* li_l = ws; LAS float* al_l = ws + 32;
    float m_reg = -1e30f, l_reg = 0; f32x16 o[2] = {}; bf16x8 qr[6];
    const bf16_t* Qw = Qb + (long)(wid * 32 + r32) * 768 + hi * 8;
#pragma unroll
    for (int d0 = 0; d0 < 6; ++d0) qr[d0] = *(const bf16x8*)(Qw + d0 * 16);
    const int sr = tid >> 3, sc = (tid & 7) * 8, vst = v_st(sr, sc);
    const int kr_ = (tid & 255) >> 2, kc_ = (tid & 3) * 8;
    const int vb0 = (int)(uintptr_t)V_lds + v_rd_base(lane);
    struct { bf16x8 vs, kn, kp; } sr_[2];
#define KROW(j, kk) (((j) < nlat) ? (lat0 + (long)(j) * 64 + (kk)) : (ctx0 + (long)((j) - nlat) * 64 + (kk)))
#define SLOAD(i, j) do { const long r0_ = KROW(j, sr), r1_ = KROW(j, kr_); sr_[i].vs = *(const bf16x8*)(Vh + r0_ * 512 + sc); sr_[i].kn = *(const bf16x8*)(Kn + r0_ * 544 + sc); sr_[i].kp = *(const bf16x8*)(Kr + r1_ * 544 + kc_); } while (0)
#define SWRITE(b, i) do { *(LAS bf16x8*)(V_lds + (b) * SHM_V + vst) = sr_[i].vs; *(LAS bf16x8*)(K_lds + (b) * SHM_K + sr * KP + sc * 2) = sr_[i].kn; \
    *(LAS bf16x8*)(K_lds + (b) * SHM_K + kr_ * KP + 128 + kc_ * 2) = sr_[i].kp; } while (0)
#define SWAIT() asm volatile("s_waitcnt vmcnt(3)" ::: "memory")
#define RESC(a) do { if (__any((a) < 1.f)) { if (hi == 0) al_l[r32] = (a); asm volatile("s_waitcnt lgkmcnt(0)" ::: "memory"); \
    _Pragma("unroll") for (int d = 0; d < 2; ++d) _Pragma("unroll") for (int r = 0; r < 16; ++r) o[d][r] *= al_l[crow(r, hi)]; } } while (0)
    f32x16 pA0, pA1, pB0, pB1; float mnA, mnB, alA, alB; bf16x8 pa0, pa1, pa2, pa3;
    constexpr int SE = 0, SO = 1;
    SLOAD(SE, 0); asm volatile("s_waitcnt vmcnt(0)" ::: "memory"); SWRITE(0, SE); __syncthreads();
    qkt(pA0, pA1, K_lds, qr, r32, hi); partialSM(pA0, pA1, m_reg, mnA, alA);
    SLOAD(SO, 1); if (2 < NT) SLOAD(SE, 2);
    SWAIT(); SWRITE(1, SO); __syncthreads();
    for (int j = 1; j + 1 < NT; j += 2) {
        SBAR(); qkt(pB0, pB1, K_lds + SHM_K, qr, r32, hi);
        finishSM(pA0, pA1, alA, l_reg, pa0, pa1, pa2, pa3); SBAR();
        SLOAD(SO, j + 2); SBAR();
        pv_d0(o, vb0, pa0, pa1, pa2, pa3); partialSM(pB0, pB1, m_reg, mnB, alB);
        __syncthreads(); SWAIT(); SWRITE(0, SE);
        RESC(alB); __syncthreads();
        SBAR(); qkt(pA0, pA1, K_lds, qr, r32, hi);
        finishSM(pB0, pB1, alB, l_reg, pa0, pa1, pa2, pa3); SBAR();
        if (j + 3 < NT) SLOAD(SE, j + 3); SBAR();
        pv_d0(o, vb0 + SHM_V, pa0, pa1, pa2, pa3); partialSM(pA0, pA1, m_reg, mnA, alA);
        __syncthreads(); SWAIT(); SWRITE(1, SO);
        RESC(alA); __syncthreads();
    }
    SBAR(); qkt(pB0, pB1, K_lds + SHM_K, qr, r32, hi);
    finishSM(pA0, pA1, alA, l_reg, pa0, pa1, pa2, pa3); SBAR();
    pv_d0(o, vb0, pa0, pa1, pa2, pa3); partialSM(pB0, pB1, m_reg, mnB, alB);
    __syncthreads(); RESC(alB);
    finishSM(pB0, pB1, alB, l_reg, pa0, pa1, pa2, pa3); SBAR();
    pv_d0(o, vb0 + SHM_V, pa0, pa1, pa2, pa3);
    if (hi == 0) li_l[r32] = l_reg; asm volatile("s_waitcnt lgkmcnt(0)" ::: "memory");
    float rli[16];
#pragma unroll
    for (int r = 0; r < 16; ++r) rli[r] = __builtin_amdgcn_rcpf(li_l[crow(r, hi)]);
    bf16_t* Ow = Ob + (long)(wid * 32) * 512;
#pragma unroll
    for (int r = 0; r < 16; ++r) { const int orow = crow(r, hi);
#pragma unroll
        for (int d0 = 0; d0 < 2; ++d0) Ow[(long)orow * 512 + d0 * 32 + r32] = (bf16_t)f2bf(o[d0][r] * rli[r]); }
    __syncthreads();
#undef KROW
#undef SLOAD
#undef SWRITE
#undef SWAIT
#undef RESC
}
#undef SBAR
}

__device__ __forceinline__ void attn_latent_unit(const Ctx& F, unsigned char* ws, unsigned char* ha, int b, int h, int qb) {
    bf16_t* Y = (bf16_t*)(ws + D_YMLA); const long q0 = (long)b * SEQ + qb * 256;
    if (b < 4) { const bf16_t* Q = (const bf16_t*)(ha + HA_Q); const bf16_t* K = (const bf16_t*)(ha + HA_K); const bf16_t* V = (const bf16_t*)(ha + HA_V);
        attn::attn_unit(Q + q0 * 768 + h * 96, K + h * 64, K + 512, V + h * 64, Y + q0 * 512 + h * 64, (long)b * SEQ, (long)4 * SEQ + b * CTXL, 64, 68, F.lds); }
    else { const bf16_t* Q = (const bf16_t*)(ws + D_Q); const bf16_t* K = (const bf16_t*)(ws + D_K); const bf16_t* V = (const bf16_t*)(ws + D_V);
        attn::attn_unit(Q + q0 * 768 + h * 96, K + h * 64, K + 512, V + h * 64, Y + q0 * 512 + h * 64, (long)b * SEQ, (long)RL + b * CTXL, 64, 68, F.lds); }
}
__device__ __forceinline__ void attn_phase(const Ctx& F, int layer) {
    unsigned char* ws = getpp()->ws; unsigned char* ha = half_a_base(layer); const bool with_ctx_q = (layer == 0);
    const int vcu = (F.G % 8 == 0) ? (F.bid % 8) * (F.G / 8) + F.bid / 8 : F.bid;
    const int nlat_units = 4 * 8 * 16, nunits = nlat_units + (with_ctx_q ? NBATCH * 8 : 0);
    for (int u = vcu; u < nunits; u += F.G) {
        if (u < nlat_units) { const int bh = u >> 4, qb = u & 15; attn_latent_unit(F, ws, ha, 4 + (bh >> 3), bh & 7, qb); }
        else { const int bh = u - nlat_units, b = bh >> 3, h = bh & 7; bf16_t* Y = (bf16_t*)(ws + D_YMLA); const long yrow = (long)RL + b * CTXL;
            if (b < 4) { const bf16_t* Q = (const bf16_t*)(ha + HA_Q); const bf16_t* K = (const bf16_t*)(ha + HA_K); const bf16_t* V = (const bf16_t*)(ha + HA_V); const long q0 = (long)4 * SEQ + b * CTXL;
                attn::attn_unit(Q + q0 * 768 + h * 96, K + h * 64, K + 512, V + h * 64, Y + yrow * 512 + h * 64, 0, q0, 0, 4, F.lds); }
            else { const bf16_t* Q = (const bf16_t*)(ws + D_Q); const bf16_t* K = (const bf16_t*)(ws + D_K); const bf16_t* V = (const bf16_t*)(ws + D_V);
                attn::attn_unit(Q + yrow * 768 + h * 96, K + h * 64, K + 512, V + h * 64, Y + yrow * 512 + h * 64, 0, yrow, 0, 4, F.lds); } }
    }
}

__device__ __forceinline__ void load8_shift(const bf16_t* u, long row, int t, int T, int col, const float* mu, float* out) {
    float x[8], p[8], n[8];
    const bool hp = t > 0, hn = t < T - 1;
    const u32x4 wx = *(const u32x4*)(u + row * RWC + col), wp = *(const u32x4*)(u + (row - (hp ? 1 : 0)) * RWC + col), wn = *(const u32x4*)(u + (row + (hn ? 1 : 0)) * RWC + col);
    unpack8(wx, x); unpack8(wp, p); unpack8(wn, n);
    const float mp = hp ? 0.5f : 0.f, mn = hn ? 0.5f : 0.f;
    const f32x4 m0 = *(const f32x4*)(mu + col), m1 = *(const f32x4*)(mu + col + 4);
#pragma unroll
    for (int j = 0; j < 8; ++j) out[j] = x[j] + (j < 4 ? m0[j & 3] : m1[j & 3]) * (mp * p[j] + mn * n[j] - x[j]);
}
__device__ __forceinline__ void load8_shift_l(const bf16_t* u, long row, int t, int T, int col, const LAS float* mu8, float* out) {
    float x[8], p[8], n[8];
    const bool hp = t > 0, hn = t < T - 1;
    const u32x4 wx = *(const u32x4*)(u + row * RWC + col), wp = *(const u32x4*)(u + (row - (hp ? 1 : 0)) * RWC + col), wn = *(const u32x4*)(u + (row + (hn ? 1 : 0)) * RWC + col);
    unpack8(wx, x); unpack8(wp, p); unpack8(wn, n);
    const float mp = hp ? 0.5f : 0.f, mn = hn ? 0.5f : 0.f;
    const f32x4 m0 = *(const LAS f32x4*)(mu8), m1 = *(const LAS f32x4*)(mu8 + 4);
#pragma unroll
    for (int j = 0; j < 8; ++j) out[j] = x[j] + (j < 4 ? m0[j & 3] : m1[j & 3]) * (mp * p[j] + mn * n[j] - x[j]);
}
namespace rw2 {
constexpr int PT = 72;
constexpr int O_W2T = 0, O_A2T = 9216, O_ZL = 18432, O_AL = 34816, O_XWD = 51200, O_XAD = 60416, O_RING = 18432;
constexpr int O_TA = 69632, O_TB = O_TA + 9216, O_TK = O_TB + 9216, O_TR = O_TK + 9216, O_OUT = 69632;
constexpr int O_BH = 106496, O_KH = O_BH + 9216, O_V = O_KH + 9216, O_TOT = 134144, O_PL = 136192, O_PRM = 137216;
__device__ __forceinline__ s16x4 cv4(f32x4 v) { u32x2 w; w.x = pk2(v[0], v[1]); w.y = pk2(v[2], v[3]); return __builtin_bit_cast(s16x4, w); }
__device__ __forceinline__ f32x4 mm16(s16x4 a, s16x4 b, f32x4 c) { return __builtin_amdgcn_mfma_f32_16x16x16bf16_1k(a, b, c, 0, 0, 0); }
__device__ __forceinline__ f32x4 mm32(bf16x8 a, bf16x8 b, f32x4 c) { return __builtin_amdgcn_mfma_f32_16x16x32_bf16(a, b, c, 0, 0, 0); }
__device__ __forceinline__ f32x4 bf4_to_f(s16x4 s) { const u32x2 w = __builtin_bit_cast(u32x2, s); return (f32x4){bflo(w.x), bfhi(w.x), bflo(w.y), bfhi(w.y)}; }
typedef short v4i16_t __attribute__((ext_vector_type(4)));
__device__ __forceinline__ s16x4 trd(const LAS bf16_t* base, int row0, int col0, int lane) {
    const int g = lane >> 4, i = lane & 15, q = i >> 2, p = i & 3;
    return __builtin_bit_cast(s16x4, __builtin_amdgcn_ds_read_tr16_b64_v4i16((LAS v4i16_t*)(base + (row0 + 4 * g + q) * PT + col0 + 4 * p)));
}
__device__ __forceinline__ float fast_tanh(float x) { return 1.0f - 2.0f * __builtin_amdgcn_rcpf(__builtin_amdgcn_exp2f(2.8853900817779268f * x) + 1.0f); }
}
__device__ __forceinline__ void rwkv_chain2(const Ctx& F, int layer, int b, int h, int d) {
    using namespace rw2;
    PP P = getpp(); unsigned char* ws = P->ws;
    const bf16_t* u = (const bf16_t*)(ws + D_URWKV);
    bf16_t* od = (bf16_t*)(ws + (d ? D_OB : D_OF));
    float* bsc = (float*)(ws + WS_BSC) + (size_t)d * RT * 8;
    LAS unsigned char* L = F.lds;
    LAS bf16_t* w2t = (LAS bf16_t*)(L + O_W2T); LAS bf16_t* a2t = (LAS bf16_t*)(L + O_A2T);
    LAS float* Zl = (LAS float*)(L + O_ZL); LAS float* Al = (LAS float*)(L + O_AL);
    LAS bf16_t* Xwd = (LAS bf16_t*)(L + O_XWD); LAS bf16_t* Xad = (LAS bf16_t*)(L + O_XAD);
    LAS bf16_t* TA = (LAS bf16_t*)(L + O_TA); LAS bf16_t* TB = (LAS bf16_t*)(L + O_TB); LAS bf16_t* TK = (LAS bf16_t*)(L + O_TK); LAS bf16_t* TR = (LAS bf16_t*)(L + O_TR);
    LAS bf16_t* BH = (LAS bf16_t*)(L + O_BH); LAS bf16_t* KH = (LAS bf16_t*)(L + O_KH); LAS bf16_t* Vm = (LAS bf16_t*)(L + O_V);
    LAS float* tot = (LAS float*)(L + O_TOT); LAS float* pLs = (LAS float*)(L + O_PL); LAS float* Out = (LAS float*)(L + O_OUT);
    LAS float* prm = (LAS float*)(L + O_PRM);
    const int tid0 = F.tid, w = F.wave;
    {
        const int tid = tid0;
        const float* mu = P->in[I_MU] + layer * RWC;
        const float* w0 = P->in[I_W0] + (layer * 2 + d) * 512 + h * 64;
        const float* w2 = P->in[I_W2] + (size_t)(layer * 2 + d) * 64 * 512 + h * 64;
        const float* a0 = P->in[I_A0] + (layer * 2 + d) * 512 + h * 64;
        const float* a2 = P->in[I_A2] + (size_t)(layer * 2 + d) * 64 * 512 + h * 64;
        const float* k_k = P->in[I_KK] + layer * 512 + h * 64; const float* k_a = P->in[I_KA] + layer * 512 + h * 64; const float* r_k = P->in[I_RK] + layer * 512 + h * 64;
        for (int i = tid; i < 640; i += NTHREADS) { const int rr = i >> 6, cc = i & 63; float v;
            if (rr == 0) v = mu[h * 64 + cc]; else if (rr == 1) v = mu[512 + h * 64 + cc]; else if (rr == 2) v = mu[1024 + h * 64 + cc]; else if (rr == 3) v = mu[1536 + d * 64 + cc]; else if (rr == 4) v = mu[1664 + d * 64 + cc];
            else if (rr == 5) v = w0[cc]; else if (rr == 6) v = a0[cc]; else if (rr == 7) v = k_k[cc]; else if (rr == 8) v = k_a[cc]; else v = r_k[cc];
            prm[i] = v; }
        for (int i = tid; i < 4096; i += NTHREADS) { const int k = i >> 6, cc = i & 63; w2t[cc * PT + k] = (bf16_t)f2bf(w2[(size_t)k * 512 + cc]); a2t[cc * PT + k] = (bf16_t)f2bf(a2[(size_t)k * 512 + cc]); }
    }
    f32x4 Z[4];
#pragma unroll
    for (int j = 0; j < 4; ++j) Z[j] = (f32x4){0.f, 0.f, 0.f, 0.f};
    __syncthreads();
    for (int seq = 0; seq < 2; ++seq) {
        const int T = seq ? SEQ : CTXL; const long rbase = seq ? (long)b * SEQ : (long)RL + b * CTXL; const int nch = T / 64;
        for (int ci = 0; ci < nch; ++ci) {
            int tid = tid0; asm volatile("" : "+v"(tid));
            const int lane = tid & 63, fr = lane & 15, fq = lane >> 4, tt = tid >> 3, c8 = (tid & 7) * 8;
            const int tpos = d ? (T - 1 - (ci * 64 + tt)) : (ci * 64 + tt); const long row = rbase + tpos;
            float r[8], k[8], kk[8], av[8], kd[8], lw[8];
            {
                float v[8], x[8];
                load8_shift_l(u, row, tpos, T, h * 64 + c8, prm + c8, r);
                load8_shift_l(u, row, tpos, T, 512 + h * 64 + c8, prm + 64 + c8, k);
                load8_shift_l(u, row, tpos, T, 1024 + h * 64 + c8, prm + 128 + c8, v);
                *(LAS u32x4*)(Vm + tt * PT + c8) = pack8(v);
                load8_shift_l(u, row, tpos, T, 1536 + d * 64 + c8, prm + 192 + c8, x);
#pragma unroll
                for (int e = 0; e < 8; ++e) x[e] = fast_tanh(x[e]);
                *(LAS u32x4*)(Xwd + tt * PT + c8) = pack8(x);
                load8_shift_l(u, row, tpos, T, 1664 + d * 64 + c8, prm + 256 + c8, x);
                *(LAS u32x4*)(Xad + tt * PT + c8) = pack8(x);
            }
            __syncthreads();
            {
#pragma unroll
                for (int q = 0; q < 2; ++q) { const int id = 2 * w + q, tm = id >> 2, tn = id & 3;
                    f32x4 az = {0.f, 0.f, 0.f, 0.f}, aa = {0.f, 0.f, 0.f, 0.f};
#pragma unroll
                    for (int ks = 0; ks < 2; ++ks) {
                        az = mm32(*(const LAS bf16x8*)(Xwd + (16 * tm + fr) * PT + ks * 32 + fq * 8), *(const LAS bf16x8*)(w2t + (16 * tn + fr) * PT + ks * 32 + fq * 8), az);
                        aa = mm32(*(const LAS bf16x8*)(Xad + (16 * tm + fr) * PT + ks * 32 + fq * 8), *(const LAS bf16x8*)(a2t + (16 * tn + fr) * PT + ks * 32 + fq * 8), aa); }
#pragma unroll
                    for (int e = 0; e < 4; ++e) { Zl[(16 * tm + 4 * fq + e) * 64 + 16 * tn + fr] = az[e]; Al[(16 * tm + 4 * fq + e) * 64 + 16 * tn + fr] = aa[e]; } }
            }
            __syncthreads();
            {
                float ss = 0.f, bs = 0.f;
#pragma unroll
                for (int e = 0; e < 8; ++e) { kk[e] = k[e] * prm[448 + c8 + e]; ss += kk[e] * kk[e]; }
                ss += shx(ss, 1, lane); ss += shx(ss, 2, lane); ss += shx(ss, 4, lane);
                const float inv = __builtin_amdgcn_rsqf(fmaxf(ss, 1e-24f));
#pragma unroll
                for (int e = 0; e < 8; ++e) {
                    kk[e] *= inv;
                    const float z = Zl[tt * 64 + c8 + e] + prm[320 + c8 + e];
                    lw[e] = -sigmoidf_(z) * 0.8750612633917001f;
                    av[e] = sigmoidf_(Al[tt * 64 + c8 + e] + prm[384 + c8 + e]);
                    kd[e] = k[e] * (1.0f + (av[e] - 1.0f) * prm[512 + c8 + e]);
                    bs += r[e] * kd[e] * prm[576 + c8 + e];
                }
                bs += shx(bs, 1, lane); bs += shx(bs, 2, lane); bs += shx(bs, 4, lane);
                if ((tid & 7) == 0) bsc[(size_t)row * 8 + h] = bs;
            }
            float cum[8];
            {
#pragma unroll
                for (int e = 0; e < 8; ++e) cum[e] = lw[e];
#pragma unroll
                for (int off = 8; off < 64; off <<= 1) {
#pragma unroll
                    for (int e = 0; e < 8; ++e) { const float t = __int_as_float(__builtin_amdgcn_ds_bpermute(((lane - off) & 63) << 2, __float_as_int(cum[e]))); cum[e] += (lane >= off) ? t : 0.f; } }
                if (lane >= 56) {
#pragma unroll
                    for (int e = 0; e < 8; ++e) tot[w * 64 + c8 + e] = cum[e]; }
            }
            __syncthreads();
            {
                float ta[8], tb[8], tk[8], tr[8], bh[8], kh[8];
                const int w0i = (w & ~1) * 64 + c8;
#pragma unroll
                for (int e = 0; e < 8; ++e) {
                    const float t0 = tot[w0i + e], t1 = tot[w0i + 64 + e];
                    const float cm = cum[e] + ((w & 1) ? t0 : 0.f), cumL = t0 + t1;
                    const float e1 = __builtin_amdgcn_exp2f(cm - lw[e]), e2 = __builtin_amdgcn_exp2f(-cm), e3 = __builtin_amdgcn_exp2f(cm), e4 = __builtin_amdgcn_exp2f(cumL - cm);
                    const float ka = kk[e] * av[e];
                    ta[e] = -kk[e] * e1; tb[e] = ka * e2; tk[e] = kd[e] * e2; tr[e] = r[e] * e3; bh[e] = ka * e4; kh[e] = kd[e] * e4;
                    if ((tt & 15) == 15) pLs[(tt >> 4) * 64 + c8 + e] = e3;
                }
                *(LAS u32x4*)(TA + tt * PT + c8) = pack8(ta); *(LAS u32x4*)(TB + tt * PT + c8) = pack8(tb); *(LAS u32x4*)(TK + tt * PT + c8) = pack8(tk); *(LAS u32x4*)(TR + tt * PT + c8) = pack8(tr);
                *(LAS u32x4*)(BH + tt * PT + c8) = pack8(bh); *(LAS u32x4*)(KH + tt * PT + c8) = pack8(kh);
            }
            __syncthreads();
            if (w < 4) {
                const int s = w; const int rowf = (16 * s + fr) * PT;
                f32x4 Mab = {0.f, 0.f, 0.f, 0.f}, MabT = Mab, MakT = Mab, Mbr = Mab, Mkr = Mab;
#pragma unroll
                for (int ks = 0; ks < 2; ++ks) { const int o = rowf + ks * 32 + fq * 8;
                    const bf16x8 fa = *(const LAS bf16x8*)(TA + o), fb = *(const LAS bf16x8*)(TB + o), fk = *(const LAS bf16x8*)(TK + o), frr = *(const LAS bf16x8*)(TR + o);
                    Mab = mm32(fb, fa, Mab); MabT = mm32(fa, fb, MabT); MakT = mm32(fa, fk, MakT); Mbr = mm32(fb, frr, Mbr); Mkr = mm32(fk, frr, Mkr); }
                f32x4 Pm, Pt;
#pragma unroll
                for (int e = 0; e < 4; ++e) { const int m = 4 * fq + e, n = fr;
                    Mab[e] = (m < n) ? Mab[e] : 0.f; MabT[e] = (n < m) ? MabT[e] : 0.f; MakT[e] = (n < m) ? MakT[e] : 0.f; Mbr[e] = (m <= n) ? Mbr[e] : 0.f; Mkr[e] = (m <= n) ? Mkr[e] : 0.f;
                    const float id = (m == n) ? 1.f : 0.f; Pm[e] = Mab[e] + id; Pt[e] = MabT[e] + id; }
                f32x4 Nn = Mab, Nt = MabT; const f32x4 zero = {0.f, 0.f, 0.f, 0.f};
#pragma unroll
                for (int it = 0; it < 3; ++it) {
                    const s16x4 cn = cv4(Nn), cnt = cv4(Nt);
                    const f32x4 N2 = mm16(cnt, cn, zero), Nt2 = mm16(cn, cnt, zero);
                    const s16x4 cp = cv4(Pm), cpt = cv4(Pt), cn2 = cv4(N2);
                    const f32x4 Pn = mm16(cpt, cn2, Pm), Ptn = mm16(cn2, cpt, Pt);
                    Nn = N2; Nt = Nt2; Pm = Pn; Pt = Ptn; (void)cp;
                }
                const s16x4 cT = cv4(Pm), cMakT = cv4(MakT), cMbr = cv4(Mbr);
                const f32x4 Q1T = mm16(cT, cMakT, zero);
                const s16x4 cQ1T = cv4(Q1T);
                const f32x4 Hy = mm16(cQ1T, cMbr, Mkr);
                LAS unsigned char* ring = L + O_RING + s * 12800 + lane * 8;
                *(LAS s16x4*)(ring + 20 * 512) = cv4(Hy);
                s16x4 bhf[4];
#pragma unroll
                for (int jt = 0; jt < 4; ++jt) bhf[jt] = trd(BH, 16 * s, 16 * jt, lane);
#pragma unroll
                for (int jt = 0; jt < 4; ++jt) {
                    const s16x4 atf = trd(TA, 16 * s, 16 * jt, lane);
                    const f32x4 P1T = mm16(cT, atf, zero); const s16x4 cP1T = cv4(P1T);
                    const f32x4 rinit = bf4_to_f(*(const LAS s16x4*)(TR + (16 * s + fr) * PT + 16 * jt + 4 * fq));
                    const f32x4 Gy = mm16(cP1T, cMbr, rinit);
                    *(LAS s16x4*)(ring + jt * 512) = cv4(Gy);
#pragma unroll
                    for (int j2 = 0; j2 < 4; ++j2) { const f32x4 Gs = mm16(cP1T, bhf[j2], zero); *(LAS s16x4*)(ring + (4 + jt * 4 + j2) * 512) = cv4(Gs); }
                    const f32x4 kinit = bf4_to_f(trd(KH, 16 * s, 16 * jt, lane));
                    const f32x4 Hs = mm16(cQ1T, bhf[jt], kinit);
                    *(LAS s16x4*)(ring + (21 + jt) * 512) = cv4(Hs);
                }
            }
            __syncthreads();
            if (w < 4) {
                const int it = w;
#pragma unroll 1
                for (int s = 0; s < 4; ++s) {
                    const LAS unsigned char* ring = L + O_RING + s * 12800 + lane * 8;
                    const s16x4 vb = trd(Vm, 16 * s, 16 * it, lane);
                    s16x4 zb[4];
#pragma unroll
                    for (int jt = 0; jt < 4; ++jt) zb[jt] = cv4(Z[jt]);
                    f32x4 Yt = mm16(*(const LAS s16x4*)(ring + 20 * 512), vb, (f32x4){0.f, 0.f, 0.f, 0.f});
#pragma unroll
                    for (int jt = 0; jt < 4; ++jt) Yt = mm16(*(const LAS s16x4*)(ring + jt * 512), zb[jt], Yt);
#pragma unroll
                    for (int e = 0; e < 4; ++e) Out[(16 * s + 4 * fq + e) * 64 + 16 * it + fr] = Yt[e];
                    f32x4 Zn[4];
#pragma unroll
                    for (int j2 = 0; j2 < 4; ++j2) {
                        const f32x4 pv = *(const LAS f32x4*)(pLs + s * 64 + 16 * j2 + 4 * fq);
                        f32x4 zn = Z[j2] * pv;
                        zn = mm16(*(const LAS s16x4*)(ring + (21 + j2) * 512), vb, zn);
#pragma unroll
                        for (int jt = 0; jt < 4; ++jt) zn = mm16(*(const LAS s16x4*)(ring + (4 + jt * 4 + j2) * 512), zb[jt], zn);
                        Zn[j2] = zn;
                    }
#pragma unroll
                    for (int j2 = 0; j2 < 4; ++j2) Z[j2] = Zn[j2];
                }
            }
            __syncthreads();
            {
                float v[8];
#pragma unroll
                for (int e = 0; e < 8; ++e) v[e] = Out[tt * 64 + c8 + e];
                *(u32x4*)(od + (size_t)row * 512 + h * 64 + c8) = pack8(v);
            }
            __syncthreads();
        }
    }
}

namespace rw4 {
using namespace rw2;
constexpr int RGN = 16384, R_TA = 0, R_TB = 2304, R_TK = 4608, R_TR = 6912, R_BH = 9216, R_KH = 11520, R_V = 13824, R_PL = 16128;
constexpr int R_XWD = 0, R_XAD = 2304, R_ZL = 4608, R_AL = 8704;
constexpr int O_PRM4 = 8 * RGN;
}
__device__ __forceinline__ void rwkv_chain4(const Ctx& F, int layer, int b, int h, int d) {
    using namespace rw4;
    PP P = getpp(); unsigned char* ws = P->ws;
    const bf16_t* u = (const bf16_t*)(ws + D_URWKV);
    bf16_t* od = (bf16_t*)(ws + (d ? D_OB : D_OF));
    float* bsc = (float*)(ws + WS_BSC) + (size_t)d * RT * 8;
    const bf16_t* w2g = (const bf16_t*)(ws + WS_W2T) + (size_t)((layer * 2 + d) * 2 + 0) * 512 * 64 + (size_t)h * 64 * 64;
    const bf16_t* a2g = (const bf16_t*)(ws + WS_W2T) + (size_t)((layer * 2 + d) * 2 + 1) * 512 * 64 + (size_t)h * 64 * 64;
    LAS unsigned char* L = F.lds;
    LAS float* prm = (LAS float*)(L + O_PRM4);
    volatile LAS unsigned* rdy = (volatile LAS unsigned*)(L + O_PRM4 + 2560); LAS unsigned* dne = (LAS unsigned*)(L + O_PRM4 + 2560 + 64);
    unsigned gseq = 0;
    const int tid0 = F.tid, w = F.wave;
    {
        const float* mu = P->in[I_MU] + layer * RWC;
        const float* w0 = P->in[I_W0] + (layer * 2 + d) * 512 + h * 64; const float* a0 = P->in[I_A0] + (layer * 2 + d) * 512 + h * 64;
        const float* k_k = P->in[I_KK] + layer * 512 + h * 64; const float* k_a = P->in[I_KA] + layer * 512 + h * 64; const float* r_k = P->in[I_RK] + layer * 512 + h * 64;
        for (int i = tid0; i < 640; i += NTHREADS) { const int rr = i >> 6, cc = i & 63; float v;
            if (rr == 0) v = mu[h * 64 + cc]; else if (rr == 1) v = mu[512 + h * 64 + cc]; else if (rr == 2) v = mu[1024 + h * 64 + cc]; else if (rr == 3) v = mu[1536 + d * 64 + cc]; else if (rr == 4) v = mu[1664 + d * 64 + cc];
            else if (rr == 5) v = w0[cc]; else if (rr == 6) v = a0[cc]; else if (rr == 7) v = k_k[cc]; else if (rr == 8) v = k_a[cc]; else v = r_k[cc];
            prm[i] = v; }
        if (tid0 < 8) { rdy[tid0] = 0u; dne[tid0] = 0u; }
    }
    f32x4 Z[4];
#pragma unroll
    for (int j = 0; j < 4; ++j) Z[j] = (f32x4){0.f, 0.f, 0.f, 0.f};
    u32x4 raw[2][5][3];
#define RW4_PREFETCH(T_, rbase_, gi_) do { int t0_ = tid0; asm volatile("" : "+v"(t0_)); const int lane_ = t0_ & 63, tk_ = lane_ >> 2, cg_ = lane_ & 3; const int pi_ = (gi_) * 128 + 16 * w + tk_; const int tp_ = d ? ((T_) - 1 - pi_) : pi_; \
        const long row_ = (rbase_) + tp_; const long rp_ = row_ - (tp_ > 0 ? 1 : 0), rn_ = row_ + (tp_ < (T_) - 1 ? 1 : 0); \
        _Pragma("unroll") for (int q_ = 0; q_ < 2; ++q_) _Pragma("unroll") for (int g_ = 0; g_ < 5; ++g_) { \
            const int col_ = (g_ == 0 ? h * 64 : g_ == 1 ? 512 + h * 64 : g_ == 2 ? 1024 + h * 64 : g_ == 3 ? 1536 + d * 64 : 1664 + d * 64) + q_ * 32 + cg_ * 8; \
            raw[q_][g_][0] = *(const u32x4*)(u + row_ * RWC + col_); raw[q_][g_][1] = *(const u32x4*)(u + rp_ * RWC + col_); raw[q_][g_][2] = *(const u32x4*)(u + rn_ * RWC + col_); } } while (0)
    RW4_PREFETCH(CTXL, (long)RL + b * CTXL, 0);
    __syncthreads();
    for (int seq = 0; seq < 2; ++seq) {
        const int T = seq ? SEQ : CTXL; const long rbase = seq ? (long)b * SEQ : (long)RL + b * CTXL; const int ngr = T / 128;
        for (int gi = 0; gi < ngr; ++gi) {
            int tid = tid0; asm volatile("" : "+v"(tid));
            const int lane = tid & 63, fr = lane & 15, fq = lane >> 4, tk = lane >> 2, cg = lane & 3;
            LAS unsigned char* R = L + w * RGN;
            { unsigned sp = 0; while (*(volatile LAS unsigned*)(dne + w) != 4u * gseq) { __builtin_amdgcn_s_sleep(1); if (++sp > (1u << 24)) break; } }
            asm volatile("" ::: "memory");
            {
                const int pi = gi * 128 + 16 * w + tk; const int tpos = d ? (T - 1 - pi) : pi; const long row = rbase + tpos;
                float r[16], k[16], kk[16], av[16], kd[16], lw[16];
                {
                    const float mp = (tpos > 0) ? 0.5f : 0.f, mn = (tpos < T - 1) ? 0.5f : 0.f;
#pragma unroll
                    for (int q = 0; q < 2; ++q) { const int c8 = q * 32 + cg * 8;
#pragma unroll
                        for (int g5 = 0; g5 < 5; ++g5) {
                            float x[8], p[8], n[8], o[8];
                            unpack8(raw[q][g5][0], x); unpack8(raw[q][g5][1], p); unpack8(raw[q][g5][2], n);
                            const f32x4 m0 = *(const LAS f32x4*)(prm + g5 * 64 + c8), m1 = *(const LAS f32x4*)(prm + g5 * 64 + c8 + 4);
#pragma unroll
                            for (int j = 0; j < 8; ++j) o[j] = x[j] + (j < 4 ? m0[j & 3] : m1[j & 3]) * (mp * p[j] + mn * n[j] - x[j]);
                            if (g5 == 0) {
#pragma unroll
                                for (int j = 0; j < 8; ++j) r[8 * q + j] = o[j]; }
                            else if (g5 == 1) {
#pragma unroll
                                for (int j = 0; j < 8; ++j) k[8 * q + j] = o[j]; }
                            else if (g5 == 2) *(LAS u32x4*)(R + R_V + (tk * PT + c8) * 2) = pack8(o);
                            else if (g5 == 3) {
#pragma unroll
                                for (int j = 0; j < 8; ++j) o[j] = fast_tanh(o[j]);
                                *(LAS u32x4*)(R + R_XWD + (tk * PT + c8) * 2) = pack8(o); }
                            else *(LAS u32x4*)(R + R_XAD + (tk * PT + c8) * 2) = pack8(o);
                        } }
                }
                {
                    const LAS bf16_t* Xwd = (const LAS bf16_t*)(R + R_XWD); const LAS bf16_t* Xad = (const LAS bf16_t*)(R + R_XAD);
                    LAS float* Zl = (LAS float*)(R + R_ZL); LAS float* Al = (LAS float*)(R + R_AL);
                    bf16x8 fw[2], fa[2];
#pragma unroll
                    for (int ks = 0; ks < 2; ++ks) { fw[ks] = *(const LAS bf16x8*)(Xwd + fr * PT + ks * 32 + fq * 8); fa[ks] = *(const LAS bf16x8*)(Xad + fr * PT + ks * 32 + fq * 8); }
#pragma unroll
                    for (int tn = 0; tn < 4; ++tn) { f32x4 az = {0.f, 0.f, 0.f, 0.f}, aa = {0.f, 0.f, 0.f, 0.f};
#pragma unroll
                        for (int ks = 0; ks < 2; ++ks) { az = mm32(fw[ks], *(const bf16x8*)(w2g + (16 * tn + fr) * 64 + ks * 32 + fq * 8), az); aa = mm32(fa[ks], *(const bf16x8*)(a2g + (16 * tn + fr) * 64 + ks * 32 + fq * 8), aa); }
#pragma unroll
                        for (int e = 0; e < 4; ++e) { Zl[(4 * fq + e) * 64 + 16 * tn + fr] = az[e]; Al[(4 * fq + e) * 64 + 16 * tn + fr] = aa[e]; } }
                }
                {
                    const LAS float* Zl = (const LAS float*)(R + R_ZL); const LAS float* Al = (const LAS float*)(R + R_AL);
                    float ss = 0.f, bs = 0.f;
                    float pkk[16], pw0[16], pa0[16], pka[16], prk[16], zz[16], aa2[16];
#pragma unroll
                    for (int q = 0; q < 2; ++q) { const int c8 = q * 32 + cg * 8;
#pragma unroll
                        for (int hh = 0; hh < 2; ++hh) { const int o4 = c8 + 4 * hh, i4 = 8 * q + 4 * hh;
                            const f32x4 a = *(const LAS f32x4*)(prm + 448 + o4), b2 = *(const LAS f32x4*)(prm + 320 + o4), c = *(const LAS f32x4*)(prm + 384 + o4), d2 = *(const LAS f32x4*)(prm + 512 + o4), e2 = *(const LAS f32x4*)(prm + 576 + o4);
                            const f32x4 z4 = *(const LAS f32x4*)(Zl + tk * 64 + o4), a4 = *(const LAS f32x4*)(Al + tk * 64 + o4);
#pragma unroll
                            for (int j = 0; j < 4; ++j) { pkk[i4 + j] = a[j]; pw0[i4 + j] = b2[j]; pa0[i4 + j] = c[j]; pka[i4 + j] = d2[j]; prk[i4 + j] = e2[j]; zz[i4 + j] = z4[j]; aa2[i4 + j] = a4[j]; } } }
#pragma unroll
                    for (int i = 0; i < 16; ++i) { kk[i] = k[i] * pkk[i]; ss += kk[i] * kk[i]; }
                    ss += shx(ss, 1, lane); ss += shx(ss, 2, lane);
                    const float inv = __builtin_amdgcn_rsqf(fmaxf(ss, 1e-24f));
#pragma unroll
                    for (int i = 0; i < 16; ++i) {
                        kk[i] *= inv;
                        lw[i] = -sigmoidf_(zz[i] + pw0[i]) * 0.8750612633917001f;
                        av[i] = sigmoidf_(aa2[i] + pa0[i]);
                        kd[i] = k[i] * (1.0f + (av[i] - 1.0f) * pka[i]);
                        bs += r[i] * kd[i] * prk[i]; }
                    bs += shx(bs, 1, lane); bs += shx(bs, 2, lane);
                    if (cg == 0) bsc[(size_t)row * 8 + h] = bs;
                }
                float cum[16], cumL[16];
                {
                    LAS float* Sc = (LAS float*)(R + R_ZL);
#pragma unroll
                    for (int q = 0; q < 2; ++q) { *(LAS f32x4*)(Sc + tk * 64 + q * 32 + cg * 8) = (f32x4){lw[8 * q], lw[8 * q + 1], lw[8 * q + 2], lw[8 * q + 3]}; *(LAS f32x4*)(Sc + tk * 64 + q * 32 + cg * 8 + 4) = (f32x4){lw[8 * q + 4], lw[8 * q + 5], lw[8 * q + 6], lw[8 * q + 7]}; }
                    float a = 0.f;
#pragma unroll
                    for (int t = 0; t < 16; ++t) { a += Sc[t * 64 + lane]; Sc[t * 64 + lane] = a; }
#pragma unroll
                    for (int q = 0; q < 2; ++q) { const f32x4 c0 = *(const LAS f32x4*)(Sc + tk * 64 + q * 32 + cg * 8), c1 = *(const LAS f32x4*)(Sc + tk * 64 + q * 32 + cg * 8 + 4);
                        const f32x4 l0 = *(const LAS f32x4*)(Sc + 15 * 64 + q * 32 + cg * 8), l1 = *(const LAS f32x4*)(Sc + 15 * 64 + q * 32 + cg * 8 + 4);
#pragma unroll
                        for (int e = 0; e < 4; ++e) { cum[8 * q + e] = c0[e]; cum[8 * q + 4 + e] = c1[e]; cumL[8 * q + e] = l0[e]; cumL[8 * q + 4 + e] = l1[e]; } }
                }
                {
#pragma unroll
                    for (int q = 0; q < 2; ++q) { float ta[8], tb[8], tkk[8], tr[8], bh[8], kh[8], plv[8]; const int c8 = q * 32 + cg * 8;
#pragma unroll
                        for (int e = 0; e < 8; ++e) { const int i = 8 * q + e;
                            const float e3 = __builtin_amdgcn_exp2f(cum[i]), e2 = __builtin_amdgcn_rcpf(e3), e1 = __builtin_amdgcn_exp2f(cum[i] - lw[i]), e4 = __builtin_amdgcn_exp2f(cumL[i] - cum[i]);
                            const float ka = kk[i] * av[i];
                            ta[e] = -kk[i] * e1; tb[e] = ka * e2; tkk[e] = kd[i] * e2; tr[e] = r[i] * e3; bh[e] = ka * e4; kh[e] = kd[i] * e4;
                            plv[e] = e3; }
                        *(LAS u32x4*)(R + R_TA + (tk * PT + c8) * 2) = pack8(ta); *(LAS u32x4*)(R + R_TB + (tk * PT + c8) * 2) = pack8(tb); *(LAS u32x4*)(R + R_TK + (tk * PT + c8) * 2) = pack8(tkk);
                        *(LAS u32x4*)(R + R_TR + (tk * PT + c8) * 2) = pack8(tr); *(LAS u32x4*)(R + R_BH + (tk * PT + c8) * 2) = pack8(bh); *(LAS u32x4*)(R + R_KH + (tk * PT + c8) * 2) = pack8(kh);
                        if (tk == 15) { LAS float* pp = (LAS float*)(R + R_PL) + c8; *(LAS f32x4*)pp = (f32x4){plv[0], plv[1], plv[2], plv[3]}; *(LAS f32x4*)(pp + 4) = (f32x4){plv[4], plv[5], plv[6], plv[7]}; } }
                }
                {
                    const LAS bf16_t* TA = (const LAS bf16_t*)(R + R_TA); const LAS bf16_t* TB = (const LAS bf16_t*)(R + R_TB); const LAS bf16_t* TK = (const LAS bf16_t*)(R + R_TK);
                    const LAS bf16_t* TR = (const LAS bf16_t*)(R + R_TR); const LAS bf16_t* BH = (const LAS bf16_t*)(R + R_BH); const LAS bf16_t* KH = (const LAS bf16_t*)(R + R_KH);
                    f32x4 Mab = {0.f, 0.f, 0.f, 0.f}, MabT = Mab, MakT = Mab, Mbr = Mab, Mkr = Mab;
#pragma unroll
                    for (int ks = 0; ks < 2; ++ks) { const int o = fr * PT + ks * 32 + fq * 8;
                        const bf16x8 fa = *(const LAS bf16x8*)(TA + o), fb = *(const LAS bf16x8*)(TB + o), fk = *(const LAS bf16x8*)(TK + o), frr = *(const LAS bf16x8*)(TR + o);
                        Mab = mm32(fb, fa, Mab); MabT = mm32(fa, fb, MabT); MakT = mm32(fa, fk, MakT); Mbr = mm32(fb, frr, Mbr); Mkr = mm32(fk, frr, Mkr); }
                    s16x4 bhf[4], atf[4], rin[4], kin[4];
#pragma unroll
                    for (int jt = 0; jt < 4; ++jt) { bhf[jt] = trd(BH, 0, 16 * jt, lane); atf[jt] = trd(TA, 0, 16 * jt, lane); kin[jt] = trd(KH, 0, 16 * jt, lane); rin[jt] = *(const LAS s16x4*)(TR + fr * PT + 16 * jt + 4 * fq); }
                    f32x4 Pm, Pt;
#pragma unroll
                    for (int e = 0; e < 4; ++e) { const int m = 4 * fq + e, n = fr;
                        Mab[e] = (m < n) ? Mab[e] : 0.f; MabT[e] = (n < m) ? MabT[e] : 0.f; MakT[e] = (n < m) ? MakT[e] : 0.f; Mbr[e] = (m <= n) ? Mbr[e] : 0.f; Mkr[e] = (m <= n) ? Mkr[e] : 0.f;
                        const float id = (m == n) ? 1.f : 0.f; Pm[e] = Mab[e] + id; Pt[e] = MabT[e] + id; }
                    f32x4 Nn = Mab, Nt = MabT; const f32x4 zero = {0.f, 0.f, 0.f, 0.f};
#pragma unroll
                    for (int it = 0; it < 3; ++it) {
                        const s16x4 cn = cv4(Nn), cnt = cv4(Nt);
                        const f32x4 N2 = mm16(cnt, cn, zero), Nt2 = mm16(cn, cnt, zero);
                        const s16x4 cpt = cv4(Pt), cn2 = cv4(N2);
                        const f32x4 Pn = mm16(cpt, cn2, Pm), Ptn = mm16(cn2, cpt, Pt);
                        Nn = N2; Nt = Nt2; Pm = Pn; Pt = Ptn;
                    }
                    const s16x4 cT = cv4(Pm), cMakT = cv4(MakT), cMbr = cv4(Mbr);
                    const f32x4 Q1T = mm16(cT, cMakT, zero);
                    const s16x4 cQ1T = cv4(Q1T);
                    const f32x4 Hy = mm16(cQ1T, cMbr, Mkr);
                    asm volatile("s_waitcnt lgkmcnt(0)" ::: "memory");
                    LAS unsigned char* ring = R + lane * 8;
                    *(LAS s16x4*)(ring + 20 * 512) = cv4(Hy);
#pragma unroll
                    for (int jt = 0; jt < 4; ++jt) {
                        const f32x4 P1T = mm16(cT, atf[jt], zero); const s16x4 cP1T = cv4(P1T);
                        const f32x4 Gy = mm16(cP1T, cMbr, bf4_to_f(rin[jt]));
                        *(LAS s16x4*)(ring + jt * 512) = cv4(Gy);
#pragma unroll
                        for (int j2 = 0; j2 < 4; ++j2) { const f32x4 Gs = mm16(cP1T, bhf[j2], zero); *(LAS s16x4*)(ring + (4 + jt * 4 + j2) * 512) = cv4(Gs); }
                        const f32x4 Hs = mm16(cQ1T, bhf[jt], bf4_to_f(kin[jt]));
                        *(LAS s16x4*)(ring + (21 + jt) * 512) = cv4(Hs);
                    }
                }
            }
            {
                const bool more = gi + 1 < ngr; const bool nseq = !more && seq == 0;
                const int nT = nseq ? SEQ : T; const long nrb = nseq ? (long)b * SEQ : rbase; const int ngi = more ? gi + 1 : (nseq ? 0 : gi);
                RW4_PREFETCH(nT, nrb, ngi);
            }
            ++gseq;
            asm volatile("s_waitcnt lgkmcnt(0)" ::: "memory");
            if (lane == 0) rdy[w] = gseq;
            asm volatile("" ::: "memory");
            if (w < 4) {
                const int it = w;
#pragma unroll 1
                for (int s = 0; s < 8; ++s) {
                    { unsigned sp = 0; while (rdy[s] != gseq) { __builtin_amdgcn_s_sleep(1); if (++sp > (1u << 24)) break; } }
                    asm volatile("" ::: "memory");
                    const LAS unsigned char* Rs = L + s * RGN; const LAS unsigned char* ring = Rs + lane * 8;
                    const s16x4 vb = trd((const LAS bf16_t*)(Rs + R_V), 0, 16 * it, lane);
                    s16x4 zb[4];
#pragma unroll
                    for (int jt = 0; jt < 4; ++jt) zb[jt] = cv4(Z[jt]);
                    f32x4 Yt = mm16(*(const LAS s16x4*)(ring + 20 * 512), vb, (f32x4){0.f, 0.f, 0.f, 0.f});
#pragma unroll
                    for (int jt = 0; jt < 4; ++jt) Yt = mm16(*(const LAS s16x4*)(ring + jt * 512), zb[jt], Yt);
#pragma unroll
                    for (int e = 0; e < 4; ++e) { const int pi = gi * 128 + 16 * s + 4 * fq + e; const int tp = d ? (T - 1 - pi) : pi;
                        od[(size_t)(rbase + tp) * 512 + h * 64 + 16 * it + fr] = (bf16_t)f2bf(Yt[e]); }
                    f32x4 Zn[4];
#pragma unroll
                    for (int j2 = 0; j2 < 4; ++j2) {
                        const f32x4 pv = *(const LAS f32x4*)((const LAS float*)(Rs + R_PL) + 16 * j2 + 4 * fq);
                        f32x4 zn = Z[j2] * pv;
                        zn = mm16(*(const LAS s16x4*)(ring + (21 + j2) * 512), vb, zn);
#pragma unroll
                        for (int jt = 0; jt < 4; ++jt) zn = mm16(*(const LAS s16x4*)(ring + (4 + jt * 4 + j2) * 512), zb[jt], zn);
                        Zn[j2] = zn;
                    }
#pragma unroll
                    for (int j2 = 0; j2 < 4; ++j2) Z[j2] = Zn[j2];
                    asm volatile("s_waitcnt lgkmcnt(0)" ::: "memory");
                    if (lane == 0) (void)__hip_atomic_fetch_add(dne + s, 1u, __ATOMIC_RELAXED, __HIP_MEMORY_SCOPE_WORKGROUP);
                }
            }
        }
    }
#undef RW4_PREFETCH
}

__device__ __forceinline__ void rwkv_post_phase(const Ctx& F, int layer, int nrows_y) {
    PP P = getpp(); unsigned char* ws = P->ws;
    const bf16_t* u = (const bf16_t*)(ws + D_URWKV); const bf16_t* of = (const bf16_t*)(ws + D_OF); const bf16_t* ob = (const bf16_t*)(ws + D_OB);
    bf16_t* y = (bf16_t*)(ws + D_YRWKV);
    const float* bf_ = (const float*)(ws + WS_BSC); const float* bb_ = bf_ + (size_t)RT * 8;
    const float* mu = P->in[I_MU] + layer * RWC; const float* lng = P->in[I_LNG] + layer * 512; const float* lnb = P->in[I_LNB] + layer * 512;
    const bf16_t* wg2 = (const bf16_t*)(ws + WS_WG2) + (size_t)layer * 512 * 128;
    LAS bf16_t* sg = (LAS bf16_t*)F.lds;
    LAS bf16_t* gt = (LAS bf16_t*)(F.lds + 64 * 136 * 2);
    const int tid0 = F.tid, wave = F.wave; const int lane = F.lane;
    const int nunits = nrows_y / 64;
    for (int un = F.bid; un < nunits; un += F.G) {
        int tid = tid0; asm volatile("" : "+v"(tid)); const int lane = tid & 63;
        const long r0 = (long)un * 64; const bool lat = r0 < RL; const int T = lat ? SEQ : CTXL; const int tbase = lat ? (int)(r0 & (SEQ - 1)) : (int)((r0 - RL) & (CTXL - 1));
        for (int it = tid; it < 1024; it += NTHREADS) { const int tk = it >> 4, q = it & 15; float v[8]; load8_shift(u, r0 + tk, tbase + tk, T, 1792 + q * 8, mu, v);
#pragma unroll
            for (int j = 0; j < 8; ++j) v[j] = sigmoidf_(v[j]);
            *(LAS u32x4*)(sg + tk * 136 + q * 8) = pack8(v); }
        __syncthreads();
        {
            const int fr = lane & 15, fq = lane >> 4;
#pragma unroll
            for (int tn = 0; tn < 4; ++tn) { const int cn = (wave * 4 + tn) * 16;
                bf16x8 bfrag[4];
#pragma unroll
                for (int k = 0; k < 4; ++k) bfrag[k] = *(const bf16x8*)(wg2 + (size_t)(cn + fr) * 128 + k * 32 + fq * 8);
#pragma unroll
                for (int tm = 0; tm < 4; ++tm) { f32x4 acc = {0.f, 0.f, 0.f, 0.f};
#pragma unroll
                    for (int k = 0; k < 4; ++k) { const bf16x8 afrag = *(const LAS bf16x8*)(sg + (tm * 16 + fr) * 136 + k * 32 + fq * 8); acc = __builtin_amdgcn_mfma_f32_16x16x32_bf16(afrag, bfrag[k], acc, 0, 0, 0); }
#pragma unroll
                    for (int j = 0; j < 4; ++j) gt[(tm * 16 + fq * 4 + j) * 520 + cn + fr] = (bf16_t)f2bf(acc[j]); } }
        }
        __syncthreads();
        {
            const int tk = tid >> 3, hh = tid & 7; const long row = r0 + tk; const int t = tbase + tk;
            const float bsum = bf_[row * 8 + hh] + bb_[row * 8 + hh];
            float o[64]; float s = 0.f;
#pragma unroll
            for (int q = 0; q < 8; ++q) { float a[8], c[8]; unpack8(*(const u32x4*)(of + row * 512 + hh * 64 + q * 8), a); unpack8(*(const u32x4*)(ob + row * 512 + hh * 64 + q * 8), c);
#pragma unroll
                for (int j = 0; j < 8; ++j) { o[q * 8 + j] = a[j] + c[j]; s += o[q * 8 + j]; } }
            const float mean = s * (1.0f / 64.0f); float vs = 0.f;
#pragma unroll
            for (int j = 0; j < 64; ++j) { const float dd = o[j] - mean; vs += dd * dd; }
            const float rstd = rsqrtf(vs * (1.0f / 64.0f) + 64e-5f);
#pragma unroll
            for (int q = 0; q < 8; ++q) { float vv[8], res[8]; load8_shift(u, row, t, T, 1024 + hh * 64 + q * 8, mu, vv);
                float g8[8]; unpack8(*(const LAS u32x4*)(gt + tk * 520 + hh * 64 + q * 8), g8);
#pragma unroll
                for (int j = 0; j < 8; ++j) { const int c = hh * 64 + q * 8 + j; res[j] = ((o[q * 8 + j] - mean) * rstd * lng[c] + lnb[c] + bsum * vv[j]) * g8[j]; }
                *(u32x4*)(y + row * 512 + hh * 64 + q * 8) = pack8(res); }
        }
        __syncthreads();
    }
}
__device__ __forceinline__ void mla_stats_pass(const Ctx& F, int w0, int nw) {
    unsigned char* ws = getpp()->ws; const int lane = F.lane;
    const bf16_t* um = (const bf16_t*)(ws + D_UMLA); float* rq = (float*)(ws + WS_RSTD); float* rkv = rq + RT;
    for (int row = GW(F) - w0; row < RT; row += nw) {
        const bf16_t* ur = um + (size_t)row * MLC;
        float sq = 0.f, skv = 0.f;
        { float v[8]; unpack8(*(const u32x4*)(ur + lane * 8), v); float s = 0.f;
#pragma unroll
            for (int j = 0; j < 8; ++j) s += v[j] * v[j];
            if (lane < 48) sq += s; else skv += s; }
        if (lane < 16) { float v[8]; unpack8(*(const u32x4*)(ur + 512 + lane * 8), v); float s = 0.f;
#pragma unroll
            for (int j = 0; j < 8; ++j) s += v[j] * v[j];
            skv += s; }
        sq = wave_sum(sq, lane); skv = wave_sum(skv, lane);
        if (lane == 0) { rq[row] = rsqrtf(sq * (1.0f / 384.0f) + 1e-6f); rkv[row] = rsqrtf(skv * (1.0f / 256.0f) + 1e-6f); }
    }
}
__device__ __forceinline__ void krope_pass(const Ctx& F, int half, int layer) {
    unsigned char* ws = getpp()->ws; const int lane = F.lane;
    const bf16_t* um = (const bf16_t*)(ws + D_UMLA); bf16_t* Kb = half ? (bf16_t*)(ws + D_K) : (bf16_t*)(half_a_base(layer) + HA_K);
    const float* cm = (const float*)(ws + WS_ROPE_M); const float* sm = cm + 4096 * 16;
    for (int ci = GW(F) * 4 + (lane >> 4); ci < HROWS; ci += NGW(F) * 4) {
        const int row = ci < 4 * SEQ ? 4 * SEQ * half + ci : RL + 4 * CTXL * half + (ci - 4 * SEQ);
        const int orow = half ? row : ci;
        const bf16_t* ur = um + (size_t)row * MLC; const int l = lane & 15;
        float x1 = bf2f(ur[640 + l]), x2 = bf2f(ur[656 + l]);
        if (row < RL) { const int t = row & (SEQ - 1); const float cs = cm[t * 16 + l], sn = sm[t * 16 + l]; const float o1 = x1 * cs - x2 * sn, o2 = x1 * sn + x2 * cs; x1 = o1; x2 = o2; }
        Kb[(size_t)orow * 544 + 512 + l] = (bf16_t)f2bf(x1); Kb[(size_t)orow * 544 + 528 + l] = (bf16_t)f2bf(x2);
    }
}

constexpr size_t D_KV = D_END1;
static_assert(D_KV + 34 * MiB <= WS_NEED, "retention state buffer");
namespace ret2 {
constexpr int QP = 72, VP = 136, NUNITS = NBATCH * 4 * 34;
typedef short v4i16_t __attribute__((ext_vector_type(4)));
__device__ __forceinline__ bf16x8 tr8(const LAS bf16_t* base, int pitch, int row0, int col0, int lane) {
    const int g = lane >> 4, i = lane & 15, q = i >> 2, p = i & 3;
    const LAS bf16_t* a = base + (row0 + 8 * g + q) * pitch + col0 + 4 * p;
    const s16x4 lo = __builtin_bit_cast(s16x4, __builtin_amdgcn_ds_read_tr16_b64_v4i16((LAS v4i16_t*)a));
    const s16x4 hi = __builtin_bit_cast(s16x4, __builtin_amdgcn_ds_read_tr16_b64_v4i16((LAS v4i16_t*)(a + 4 * pitch)));
    return (bf16x8){lo[0], lo[1], lo[2], lo[3], hi[0], hi[1], hi[2], hi[3]};
}
__device__ __forceinline__ f32x4 mm32(bf16x8 a, bf16x8 b, f32x4 c) { return __builtin_amdgcn_mfma_f32_16x16x32_bf16(a, b, c, 0, 0, 0); }
struct UnitPos { int b, h, cs; long rbase; bool isctx; int t0; };
__device__ __forceinline__ UnitPos unit_pos(int un) { UnitPos U; const int bh = un / 34; U.cs = un % 34; U.b = bh >> 2; U.h = bh & 3; U.isctx = U.cs < 2;
    U.t0 = U.isctx ? 0 : (U.cs - 2) * 128; U.rbase = U.isctx ? (long)RL + U.b * CTXL + U.cs * 128 : (long)U.b * SEQ + U.t0; return U; }
__device__ __forceinline__ void load_pair(const bf16_t* p, int pc, bool rope, const float* cr, const float* sr, int t, float* x1, float* x2) {
    unpack8(*(const u32x4*)(p + pc * 8), x1); unpack8(*(const u32x4*)(p + 32 + pc * 8), x2);
    if (rope) { float cs[8], sn[8];
        *(f32x4*)cs = *(const f32x4*)(cr + t * 32 + pc * 8); *(f32x4*)(cs + 4) = *(const f32x4*)(cr + t * 32 + pc * 8 + 4);
        *(f32x4*)sn = *(const f32x4*)(sr + t * 32 + pc * 8); *(f32x4*)(sn + 4) = *(const f32x4*)(sr + t * 32 + pc * 8 + 4);
#pragma unroll
        for (int j = 0; j < 8; ++j) { const float a = x1[j] * cs[j] - x2[j] * sn[j], b = x1[j] * sn[j] + x2[j] * cs[j]; x1[j] = a; x2[j] = b; } }
}
}
__device__ __forceinline__ void ret_r1_unit(const Ctx& F, int layer, int un) {
    using namespace ret2;
    PP P = getpp(); unsigned char* ws = P->ws;
    const bf16_t* u = (const bf16_t*)(ws + D_URET); bf16_t* kv = (bf16_t*)(ws + D_KV);
    const float* cr = (const float*)(ws + WS_ROPE_R); const float* sr = cr + 4096 * 32;
    const UnitPos U = unit_pos(un);
    const float lgf = -__expf(P->in[I_RDEC][(layer * 2 + 0) * 4 + U.h]) * 1.4426950408889634f, lgb = -__expf(P->in[I_RDEC][(layer * 2 + 1) * 4 + U.h]) * 1.4426950408889634f;
    LAS bf16_t* Vt = (LAS bf16_t*)F.lds; LAS bf16_t* kzf = Vt + 128 * VP; LAS bf16_t* kzb = kzf + 128 * QP; LAS bf16_t* St = kzb + 128 * QP;
    const int tid = F.tid, lane = F.lane, w = F.wave;
    {
        const int tk = tid >> 2, pc = tid & 3; const long row = U.rbase + tk; float k1[8], k2[8], a[8], c[8];
        load_pair(u + row * REC + 256 + U.h * 64, pc, !U.isctx, cr, sr, U.t0 + tk, k1, k2);
        const float zf = 0.125f * __builtin_amdgcn_exp2f((float)(127 - tk) * lgf), zb = 0.125f * __builtin_amdgcn_exp2f((float)tk * lgb);
#pragma unroll
        for (int j = 0; j < 8; ++j) { a[j] = k1[j] * zf; c[j] = k2[j] * zf; }
        *(LAS u32x4*)(kzf + tk * QP + pc * 8) = pack8(a); *(LAS u32x4*)(kzf + tk * QP + 32 + pc * 8) = pack8(c);
#pragma unroll
        for (int j = 0; j < 8; ++j) { a[j] = k1[j] * zb; c[j] = k2[j] * zb; }
        *(LAS u32x4*)(kzb + tk * QP + pc * 8) = pack8(a); *(LAS u32x4*)(kzb + tk * QP + 32 + pc * 8) = pack8(c);
#pragma unroll
        for (int k4 = 0; k4 < 4; ++k4) { const int it = tid + 512 * k4, tv = it >> 4, ch = it & 15; *(LAS u32x4*)(Vt + tv * VP + ch * 8) = *(const u32x4*)(u + (U.rbase + tv) * REC + 512 + U.h * 128 + ch * 8); }
    }
    __syncthreads();
    {
        const int fr = lane & 15, fq = lane >> 4;
        f32x4 acc[2][4];
#pragma unroll
        for (int dd = 0; dd < 2; ++dd)
#pragma unroll
            for (int tj = 0; tj < 4; ++tj) acc[dd][tj] = (f32x4){0.f, 0.f, 0.f, 0.f};
#pragma unroll
        for (int ks = 0; ks < 4; ++ks) { const bf16x8 a = tr8(Vt, VP, 32 * ks, 16 * w, lane);
#pragma unroll
            for (int tj = 0; tj < 4; ++tj) { acc[0][tj] = mm32(a, tr8(kzf, QP, 32 * ks, 16 * tj, lane), acc[0][tj]); acc[1][tj] = mm32(a, tr8(kzb, QP, 32 * ks, 16 * tj, lane), acc[1][tj]); } }
#pragma unroll
        for (int dd = 0; dd < 2; ++dd)
#pragma unroll
            for (int tj = 0; tj < 4; ++tj)
#pragma unroll
                for (int j = 0; j < 4; ++j) St[dd * 128 * QP + (16 * w + 4 * fq + j) * QP + 16 * tj + fr] = (bf16_t)f2bf(acc[dd][tj][j]);
    }
    __syncthreads();
#pragma unroll
    for (int k4 = 0; k4 < 4; ++k4) { const int it = tid + 512 * k4, dd = it >> 10, e = (it >> 3) & 127, ch = it & 7;
        *(u32x4*)(kv + ((size_t)un * 2 + dd) * 8192 + e * 64 + ch * 8) = *(const LAS u32x4*)(St + dd * 128 * QP + e * QP + ch * 8); }
    __syncthreads();
}
__device__ __forceinline__ void ret_r2(const Ctx& F, int layer, int b0, int nb) {
    using namespace ret2;
    PP P = getpp(); bf16_t* kv = (bf16_t*)(P->ws + D_KV);
    for (int item = (F.bid - b0) * NTHREADS + F.tid; item < 65536; item += nb * NTHREADS) {
        const int bh = item >> 11, dd = (item >> 10) & 1, off = (item & 1023) * 8;
        const float g = __builtin_amdgcn_exp2f(-128.0f * __expf(P->in[I_RDEC][(layer * 2 + dd) * 4 + (bh & 3)]) * 1.4426950408889634f);
        float st[8];
#pragma unroll
        for (int j = 0; j < 8; ++j) st[j] = 0.f;
#pragma unroll
        for (int half = 0; half < 2; ++half) {
            asm volatile("" ::: "memory");
            u32x4 xv[17];
#pragma unroll
            for (int q = 0; q < 17; ++q) { const int i = half * 17 + q; const int cs = dd ? (i < 2 ? 1 - i : 35 - i) : i;
                xv[q] = *(const u32x4*)(kv + ((size_t)(bh * 34 + cs) * 2 + dd) * 8192 + off); }
#pragma unroll
            for (int q = 0; q < 17; ++q) { const int i = half * 17 + q; const int cs = dd ? (i < 2 ? 1 - i : 35 - i) : i;
                float x[8]; unpack8(xv[q], x);
                *(u32x4*)(kv + ((size_t)(bh * 34 + cs) * 2 + dd) * 8192 + off) = pack8(st);
#pragma unroll
                for (int j = 0; j < 8; ++j) st[j] = st[j] * g + x[j]; }
        }
    }
}
__device__ __forceinline__ void ret_r3_unit(const Ctx& F, int layer, int un) {
    using namespace ret2;
    PP P = getpp(); unsigned char* ws = P->ws;
    const bf16_t* u = (const bf16_t*)(ws + D_URET); const bf16_t* kv = (const bf16_t*)(ws + D_KV); bf16_t* y = (bf16_t*)(ws + D_YRET);
    const float* cr = (const float*)(ws + WS_ROPE_R); const float* sr = cr + 4096 * 32;
    const UnitPos U = unit_pos(un);
    const float* lng = P->in[I_RLNG] + layer * 512 + U.h * 128; const float* lnb = P->in[I_RLNB] + layer * 512 + U.h * 128;
    const float lgf = -__expf(P->in[I_RDEC][(layer * 2 + 0) * 4 + U.h]) * 1.4426950408889634f, lgb = -__expf(P->in[I_RDEC][(layer * 2 + 1) * 4 + U.h]) * 1.4426950408889634f;
    LAS bf16_t* qf = (LAS bf16_t*)F.lds; LAS bf16_t* qb = qf + 128 * QP; LAS bf16_t* qn = qb + 128 * QP; LAS bf16_t* ks = qn + 128 * QP; LAS bf16_t* Sm = qn;
    LAS bf16_t* Vt = (LAS bf16_t*)(F.lds + 73728); LAS bf16_t* Rf = (LAS bf16_t*)(F.lds + 108544); LAS bf16_t* Rb = Rf + 128 * QP; LAS bf16_t* Yst = qf;
    const int tid = F.tid, lane = F.lane, w = F.wave, fr = lane & 15, fq = lane >> 4;
    {
        const int tk = tid >> 2, pc = tid & 3; const long row = U.rbase + tk; float q1[8], q2[8], k1[8], k2[8], a[8], c[8];
        load_pair(u + row * REC + U.h * 64, pc, !U.isctx, cr, sr, U.t0 + tk, q1, q2);
        load_pair(u + row * REC + 256 + U.h * 64, pc, !U.isctx, cr, sr, U.t0 + tk, k1, k2);
        *(LAS u32x4*)(qn + tk * QP + pc * 8) = pack8(q1); *(LAS u32x4*)(qn + tk * QP + 32 + pc * 8) = pack8(q2);
        const float xf = __builtin_amdgcn_exp2f((float)(tk + 1) * lgf), xb = __builtin_amdgcn_exp2f((float)(128 - tk) * lgb);
#pragma unroll
        for (int j = 0; j < 8; ++j) { a[j] = q1[j] * xf; c[j] = q2[j] * xf; }
        *(LAS u32x4*)(qf + tk * QP + pc * 8) = pack8(a); *(LAS u32x4*)(qf + tk * QP + 32 + pc * 8) = pack8(c);
#pragma unroll
        for (int j = 0; j < 8; ++j) { a[j] = q1[j] * xb; c[j] = q2[j] * xb; }
        *(LAS u32x4*)(qb + tk * QP + pc * 8) = pack8(a); *(LAS u32x4*)(qb + tk * QP + 32 + pc * 8) = pack8(c);
#pragma unroll
        for (int j = 0; j < 8; ++j) { a[j] = k1[j] * 0.125f; c[j] = k2[j] * 0.125f; }
        *(LAS u32x4*)(ks + tk * QP + pc * 8) = pack8(a); *(LAS u32x4*)(ks + tk * QP + 32 + pc * 8) = pack8(c);
#pragma unroll
        for (int k4 = 0; k4 < 4; ++k4) { const int it = tid + 512 * k4, tv = it >> 4, ch = it & 15; *(LAS u32x4*)(Vt + tv * VP + ch * 8) = *(const u32x4*)(u + (U.rbase + tv) * REC + 512 + U.h * 128 + ch * 8); }
#pragma unroll
        for (int k4 = 0; k4 < 4; ++k4) { const int it = tid + 512 * k4, dd = it >> 10, e = (it >> 3) & 127, ch = it & 7;
            *(LAS u32x4*)((dd ? Rb : Rf) + e * QP + ch * 8) = *(const u32x4*)(kv + ((size_t)un * 2 + dd) * 8192 + e * 64 + ch * 8); }
    }
    __syncthreads();
    f32x4 Sa[8];
#pragma unroll
    for (int tn = 0; tn < 8; ++tn) { Sa[tn] = (f32x4){0.f, 0.f, 0.f, 0.f};
#pragma unroll
        for (int k2 = 0; k2 < 2; ++k2) Sa[tn] = mm32(*(const LAS bf16x8*)(qn + (16 * w + fr) * QP + k2 * 32 + fq * 8), *(const LAS bf16x8*)(ks + (16 * tn + fr) * QP + k2 * 32 + fq * 8), Sa[tn]); }
    __syncthreads();
#pragma unroll
    for (int tn = 0; tn < 8; ++tn)
#pragma unroll
        for (int j = 0; j < 4; ++j) { const int n = 16 * w + 4 * fq + j, m = 16 * tn + fr; const int dd = n - m;
            const float ex = __builtin_amdgcn_exp2f((float)(dd < 0 ? -dd : dd) * (dd > 0 ? lgf : lgb));
            Sm[n * VP + m] = (bf16_t)f2bf(Sa[tn][j] * ((dd == 0) ? 2.0f : ex)); }
    __syncthreads();
    f32x4 Y[8];
#pragma unroll
    for (int te = 0; te < 8; ++te) Y[te] = (f32x4){0.f, 0.f, 0.f, 0.f};
#pragma unroll
    for (int k4 = 0; k4 < 4; ++k4) { const bf16x8 a = *(const LAS bf16x8*)(Sm + (16 * w + fr) * VP + k4 * 32 + fq * 8);
#pragma unroll
        for (int te = 0; te < 8; ++te) Y[te] = mm32(a, tr8(Vt, VP, 32 * k4, 16 * te, lane), Y[te]); }
#pragma unroll
    for (int k2 = 0; k2 < 2; ++k2) { const bf16x8 af = *(const LAS bf16x8*)(qf + (16 * w + fr) * QP + k2 * 32 + fq * 8), ab = *(const LAS bf16x8*)(qb + (16 * w + fr) * QP + k2 * 32 + fq * 8);
#pragma unroll
        for (int te = 0; te < 8; ++te) { Y[te] = mm32(af, *(const LAS bf16x8*)(Rf + (16 * te + fr) * QP + k2 * 32 + fq * 8), Y[te]); Y[te] = mm32(ab, *(const LAS bf16x8*)(Rb + (16 * te + fr) * QP + k2 * 32 + fq * 8), Y[te]); } }
    __syncthreads();
#pragma unroll
    for (int j = 0; j < 4; ++j) { float s = 0.f;
#pragma unroll
        for (int te = 0; te < 8; ++te) s += Y[te][j];
        s += shx(s, 1, lane); s += shx(s, 2, lane); s += shx(s, 4, lane); s += shx(s, 8, lane);
        const float mean = s * (1.0f / 128.0f); float vs = 0.f;
#pragma unroll
        for (int te = 0; te < 8; ++te) { const float dd = Y[te][j] - mean; vs += dd * dd; }
        vs += shx(vs, 1, lane); vs += shx(vs, 2, lane); vs += shx(vs, 4, lane); vs += shx(vs, 8, lane);
        const float rstd = rsqrtf(vs * (1.0f / 128.0f) + 1e-5f);
#pragma unroll
        for (int te = 0; te < 8; ++te) { const int e = 16 * te + fr; Yst[(16 * w + 4 * fq + j) * VP + e] = (bf16_t)f2bf((Y[te][j] - mean) * rstd * lng[e] + lnb[e]); } }
    __syncthreads();
#pragma unroll
    for (int k4 = 0; k4 < 4; ++k4) { const int it = tid + 512 * k4, tv = it >> 4, ch = it & 15; const long row = U.rbase + tv;
        float yv[8], gv[8]; unpack8(*(const LAS u32x4*)(Yst + tv * VP + ch * 8), yv); unpack8(*(const u32x4*)(u + row * REC + 1024 + U.h * 128 + ch * 8), gv);
#pragma unroll
        for (int j = 0; j < 8; ++j) yv[j] *= siluf_(gv[j]);
        *(u32x4*)(y + row * 512 + U.h * 128 + ch * 8) = pack8(yv); }
    __syncthreads();
}
__device__ __forceinline__ void ret_r3_phase(const Ctx& F, int layer) {
    for (int un = F.bid; un < ret2::NUNITS; un += F.G) { if (layer != 0 && (un % 34) < 2) continue; ret_r3_unit(F, layer, un); }
}
__device__ __forceinline__ void ret_r1_phase(const Ctx& F, int layer) { for (int un = F.bid; un < ret2::NUNITS; un += F.G) ret_r1_unit(F, layer, un); }
__device__ __forceinline__ void rw_phase(const Ctx& F, int layer) {
    unsigned char* ws = getpp()->ws;
    if (F.G >= 160) {
        if (F.bid < 128) rwkv_chain4(F, layer, F.bid >> 4, (F.bid >> 1) & 7, F.bid & 1);
        unsigned* ctr = (unsigned*)(ws + WS_CTL) + 192 + 64 * layer; LAS unsigned* bc = (LAS unsigned*)(F.lds + LDS_BYTES - 32);
        for (;;) {
            __syncthreads();
            if (F.tid == 0) *bc = __hip_atomic_fetch_add(ctr, 1u, __ATOMIC_RELAXED, __HIP_MEMORY_SCOPE_AGENT);
            __syncthreads();
            const unsigned u = *bc; if (u >= 512u) break;
            const int bh = (int)u >> 4; attn_latent_unit(F, ws, half_a_base(layer), bh >> 3, bh & 7, (int)u & 15);
        }
    } else {
        for (int un = F.bid; un < 128; un += F.G) { rwkv_chain4(F, layer, un >> 4, (un >> 1) & 7, un & 1); __syncthreads(); }
        for (int u = F.bid; u < 512; u += F.G) { const int bh = u >> 4; attn_latent_unit(F, ws, half_a_base(layer), bh >> 3, bh & 7, u & 15); }
    }
}

template <int NB> __device__ __forceinline__ void rows_norm(int lane, const float* hbase, const int* rows, const float* gain, const float* mod, f32x4 (*y)[4]) {
    float ss[NB];
#pragma unroll
    for (int b = 0; b < NB; ++b) { const float* src = hbase + (size_t)rows[b] * 1024; ss[b] = 0.f;
#pragma unroll
        for (int j = 0; j < 4; ++j) { y[b][j] = *(const f32x4*)(src + 4 * lane + 256 * j); ss[b] += y[b][j].x * y[b][j].x + y[b][j].y * y[b][j].y + y[b][j].z * y[b][j].z + y[b][j].w * y[b][j].w; } }
#pragma unroll
    for (int b = 0; b < NB; ++b) ss[b] = wave_sum(ss[b], lane);
#pragma unroll
    for (int b = 0; b < NB; ++b) { const float rstd = rsqrtf(ss[b] * (1.0f / 1024.0f) + 1e-6f); const float* sh = mod + (rows[b] >> 12) * 6144; const float* sc = sh + 1024;
#pragma unroll
        for (int j = 0; j < 4; ++j) { const int c = 4 * lane + 256 * j; y[b][j] = y[b][j] * rstd * *(const f32x4*)(gain + c) * (*(const f32x4*)(sc + c) + 1.0f) + *(const f32x4*)(sh + c); } }
}
__device__ __forceinline__ void moe_route_pass(const Ctx& F, int layer) {
    PP P = getpp(); unsigned char* ws = P->ws;
    const float* gain = P->in[I_NFFN] + layer * 1024; const float* mod = (const float*)(ws + WS_MOD) + (size_t)layer * 9 * 6144 + 3072;
    const float* router = P->in[I_ROUTER];
    unsigned* cnt = (unsigned*)(ws + WS_CTL); int* route = (int*)(ws + WS_ROUTE);
    LAS float* rl = (LAS float*)F.lds;
    LAS unsigned* lc = (LAS unsigned*)(F.lds + 32768);
    for (int i = F.tid; i < 8192; i += NTHREADS) rl[i] = router[i];
    if (F.tid < 16) lc[F.tid] = 0u;
    __syncthreads();
    const int rpb = (RL + F.G - 1) / F.G, rpw = (rpb + 7) / 8;
    const int b0 = F.bid * rpb, b1 = (b0 + rpb < RL) ? b0 + rpb : RL;
    const int r0 = b0 + F.wave * rpw, r1 = (r0 + rpw < b1) ? r0 + rpw : b1;
    constexpr int NB = 2;
    for (int rb = r0; rb < r1; rb += NB) {
        int lane = F.lane; asm volatile("" : "+v"(lane));
        int rows[NB]; f32x4 y[NB][4];
#pragma unroll
        for (int b = 0; b < NB; ++b) rows[b] = (rb + b < r1) ? rb + b : r1 - 1;
        rows_norm<NB>(lane, P->out, rows, gain, mod, y);
        float lg[NB][8];
#pragma unroll
        for (int b = 0; b < NB; ++b)
#pragma unroll
            for (int e = 0; e < 8; ++e) lg[b][e] = 0.f;
#pragma unroll
        for (int j = 0; j < 4; ++j)
#pragma unroll
            for (int q = 0; q < 4; ++q) { const int c = 4 * lane + 256 * j + q; const f32x4 ra = *(const LAS f32x4*)(rl + c * 8), rb2 = *(const LAS f32x4*)(rl + c * 8 + 4);
#pragma unroll
                for (int b = 0; b < NB; ++b) { const float xv = y[b][j][q];
#pragma unroll
                    for (int e = 0; e < 4; ++e) { lg[b][e] += xv * ra[e]; lg[b][4 + e] += xv * rb2[e]; } } }
#pragma unroll
        for (int b = 0; b < NB; ++b)
#pragma unroll
            for (int e = 0; e < 8; ++e) lg[b][e] = wave_sum(lg[b][e], lane);
        if (lane == 0) {
#pragma unroll
            for (int b = 0; b < NB; ++b) if (rb + b < r1) {
                int i0 = 0; float v0 = lg[b][0];
#pragma unroll
                for (int e = 1; e < 8; ++e) if (lg[b][e] > v0) { v0 = lg[b][e]; i0 = e; }
                int i1 = -1; float v1 = -3.0e38f;
#pragma unroll
                for (int e = 0; e < 8; ++e) if (e != i0 && lg[b][e] > v1) { v1 = lg[b][e]; i1 = e; }
                const float w0 = 1.0f / (1.0f + __expf(v1 - v0)), w1 = 1.0f - w0;
                const unsigned p0 = __hip_atomic_fetch_add(&lc[i0], 1u, __ATOMIC_RELAXED, __HIP_MEMORY_SCOPE_WORKGROUP), p1 = __hip_atomic_fetch_add(&lc[i1], 1u, __ATOMIC_RELAXED, __HIP_MEMORY_SCOPE_WORKGROUP);
                int* r = route + (size_t)rows[b] * 8; r[0] = i0; r[1] = i1; r[2] = __float_as_int(w0); r[3] = __float_as_int(w1); r[4] = (int)p0; r[5] = (int)p1;
            }
        }
    }
    __syncthreads();
    if (F.tid < 8) lc[8 + F.tid] = atomicAdd(&cnt[F.tid], lc[F.tid]);
    __syncthreads();
    if (F.lane == 0) for (int row = r0; row < r1; ++row) { int* r = route + (size_t)row * 8; r[4] += (int)lc[8 + r[0]]; r[5] += (int)lc[8 + r[1]]; }
    __syncthreads();
}
__device__ __forceinline__ void moe_gather_pass(const Ctx& F, int layer) {
    PP P = getpp(); unsigned char* ws = P->ws;
    const float* gain = P->in[I_NFFN] + layer * 1024; const float* mod = (const float*)(ws + WS_MOD) + (size_t)layer * 9 * 6144 + 3072;
    const unsigned* cnt = (const unsigned*)(ws + WS_CTL); const int* route = (const int*)(ws + WS_ROUTE);
    bf16_t* xlo = (bf16_t*)(ws + D_XG); bf16_t* xhi = xlo + (size_t)RG * 512;
    const MoeTiles T = moe_tiles(cnt);
    const int rpw = (RL + NGW(F) - 1) / NGW(F); const int r0 = GW(F) * rpw; const int r1 = (r0 + rpw < RL) ? r0 + rpw : RL;
    constexpr int NB = 2;
    for (int rb = r0; rb < r1; rb += NB) {
        int lane = F.lane; asm volatile("" : "+v"(lane));
        int rows[NB]; f32x4 y[NB][4];
#pragma unroll
        for (int b = 0; b < NB; ++b) rows[b] = (rb + b < r1) ? rb + b : r1 - 1;
        rows_norm<NB>(lane, P->out, rows, gain, mod, y);
#pragma unroll
        for (int b = 0; b < NB; ++b) {
            const int* r = route + (size_t)rows[b] * 8; const int e0 = r[0], e1 = r[1];
            int t0 = 0, t1 = 0;
#pragma unroll
            for (int e = 0; e < 8; ++e) { if (e == e0) t0 = T.tstart[e]; if (e == e1) t1 = T.tstart[e]; }
            const size_t s0 = (size_t)t0 * 256 + r[4], s1 = (size_t)t1 * 256 + r[5];
#pragma unroll
            for (int j = 0; j < 4; ++j) { const int c = 4 * lane + 256 * j; u32x2 o; o.x = pk2(y[b][j].x, y[b][j].y); o.y = pk2(y[b][j].z, y[b][j].w);
                bf16_t* bp = (c < 512) ? xlo + c : xhi + (c - 512);
                *(u32x2*)(bp + s0 * 512) = o; *(u32x2*)(bp + s1 * 512) = o; } }
    }
}
__device__ __forceinline__ void moe_final_pass(const Ctx& F, int layer) {
    PP P = getpp(); unsigned char* ws = P->ws;
    const float* mod = (const float*)(ws + WS_MOD) + (size_t)layer * 9 * 6144 + 5120;
    const unsigned* cnt = (const unsigned*)(ws + WS_CTL); const int* route = (const int*)(ws + WS_ROUTE);
    const bf16_t* ym = (const bf16_t*)(ws + D_XG); const float* fn = P->in[I_FNORM];
    const MoeTiles T = moe_tiles(cnt);
    const int rpw = (RL + NGW(F) - 1) / NGW(F); const int r0 = GW(F) * rpw; const int r1 = (r0 + rpw < RL) ? r0 + rpw : RL;
    constexpr int NB = 2;
    for (int rb = r0; rb < r1; rb += NB) {
        int lane = F.lane; asm volatile("" : "+v"(lane));
        f32x4 v[NB][4]; float ss[NB]; int rows[NB];
#pragma unroll
        for (int b = 0; b < NB; ++b) { const int row = (rb + b < r1) ? rb + b : r1 - 1; rows[b] = row;
            const int* r = route + (size_t)row * 8; const int e0 = r[0], e1 = r[1]; const float w0 = __int_as_float(r[2]), w1 = __int_as_float(r[3]);
            int t0 = 0, t1 = 0;
#pragma unroll
            for (int e = 0; e < 8; ++e) { if (e == e0) t0 = T.tstart[e]; if (e == e1) t1 = T.tstart[e]; }
            const size_t s0 = (size_t)t0 * 256 + r[4], s1 = (size_t)t1 * 256 + r[5];
            const float* g = mod + (row >> 12) * 6144; const float* hp = P->out + (size_t)row * 1024; ss[b] = 0.f;
#pragma unroll
            for (int j = 0; j < 4; ++j) { const int c = 4 * lane + 256 * j; const u32x2 a = *(const u32x2*)(ym + s0 * 1024 + c), bq = *(const u32x2*)(ym + s1 * 1024 + c);
                const f32x4 ya = {bflo(a.x), bfhi(a.x), bflo(a.y), bfhi(a.y)}, yb = {bflo(bq.x), bfhi(bq.x), bflo(bq.y), bfhi(bq.y)};
                v[b][j] = *(const f32x4*)(hp + c) + *(const f32x4*)(g + c) * (ya * w0 + yb * w1);
                ss[b] += v[b][j].x * v[b][j].x + v[b][j].y * v[b][j].y + v[b][j].z * v[b][j].z + v[b][j].w * v[b][j].w; } }
#pragma unroll
        for (int b = 0; b < NB; ++b) ss[b] = wave_sum(ss[b], lane);
#pragma unroll
        for (int b = 0; b < NB; ++b) { const float rstd = rsqrtf(ss[b] * (1.0f / 1024.0f) + 1e-6f); float* hp = P->out + (size_t)rows[b] * 1024;
#pragma unroll
            for (int j = 0; j < 4; ++j) { const int c = 4 * lane + 256 * j; *(f32x4*)(hp + c) = v[b][j] * rstd * *(const f32x4*)(fn + c); } }
    }
}

#define XB_TMO      128
#define XB_XCNT(j)  (256  + 64 * (j))
#define XB_XSUB(j)  (1280 + 64 * (j))
#define XB_XGEN(j)  (2304 + 64 * (j))
#define XB_TOP      3328
#define XB_TOPGEN   3392
#define XCD_BAR_WORDS 3456
#define XB_SPIN_CAP (1u << 18)
constexpr int CW_BAR = 4096;
constexpr int LDS_BARST = LDS_BYTES - 16;
__device__ __forceinline__ unsigned xb_ld(unsigned* p)              { return __hip_atomic_load(p, __ATOMIC_RELAXED, __HIP_MEMORY_SCOPE_AGENT); }
__device__ __forceinline__ unsigned xb_add(unsigned* p, unsigned v) { return __hip_atomic_fetch_add(p, v, __ATOMIC_RELAXED, __HIP_MEMORY_SCOPE_AGENT); }
__device__ __forceinline__ unsigned xb_xcc_id() { return (unsigned)__builtin_amdgcn_s_getreg((3 << 11) | 20) & 0xFu; }
#define XB_SPIN(cond, bar) do { unsigned _sp = 0; while (cond) { __builtin_amdgcn_s_sleep(1); \
    if ((++_sp & 255u) == 0u) { if (xb_ld(&(bar)[XB_TMO])) break; if (_sp > XB_SPIN_CAP) { atomicAdd(&(bar)[XB_TMO], 1u); break; } } } } while (0)
__device__ __forceinline__ void xcd_barrier_complete(unsigned* bar, unsigned x, unsigned& nloc, unsigned& nx) {
    const unsigned G = gridDim.x * gridDim.y * gridDim.z;
    unsigned sum, cnt, mine, sp = 0u;
    for (;;) {
        sum = 0u; cnt = 0u; mine = 0u;
#pragma unroll
        for (unsigned j = 0; j < 16; ++j) { const unsigned c = xb_ld(&bar[XB_XCNT(j)]); sum += c; cnt += (c > 0u) ? 1u : 0u; mine = (j == x) ? c : mine; }
        if (sum == G) break;
        __builtin_amdgcn_s_sleep(1);
        if ((++sp & 255u) == 0u) { if (xb_ld(&bar[XB_TMO])) break; if (sp > XB_SPIN_CAP) { atomicAdd(&bar[XB_TMO], 1u); break; } }
    }
    nloc = mine > 0u ? mine : 1u; nx = cnt > 0u ? cnt : 1u;
}
__device__ __forceinline__ void xcd_barrier(LAS unsigned char* lds) {
    asm volatile("s_waitcnt vmcnt(0)" ::: "memory");
    __syncthreads();
    if (threadIdx.x == 0) {
        unsigned* bar = (unsigned*)(getpp()->ws + WS_CTL) + CW_BAR;
        volatile LAS unsigned* st = (volatile LAS unsigned*)(lds + LDS_BARST);
        const unsigned x = xb_xcc_id();
        __builtin_amdgcn_s_waitcnt(0);
        unsigned nloc = st[0], nx = st[1];
        if (nloc == 0u) { xcd_barrier_complete(bar, x, nloc, nx); st[0] = nloc; st[1] = nx; }
        const unsigned old = xb_add(&bar[XB_XSUB(x)], 1u);
        const unsigned gen = old / nloc;
        if (old + 1u == (gen + 1u) * nloc) {
            __builtin_amdgcn_fence(__ATOMIC_RELEASE, "agent");
            asm volatile("s_waitcnt vmcnt(0)" ::: "memory");
            const unsigned og = xb_add(&bar[XB_TOP], 1u);
            const unsigned tg = og / nx;
            if (og + 1u == (tg + 1u) * nx) xb_add(&bar[XB_TOPGEN], 1u);
            else XB_SPIN(xb_ld(&bar[XB_TOPGEN]) == tg, bar);
            __builtin_amdgcn_fence(__ATOMIC_ACQUIRE, "agent");
            xb_add(&bar[XB_XGEN(x)], 1u);
            asm volatile("s_waitcnt vmcnt(0)" ::: "memory");
        } else {
            XB_SPIN(xb_ld(&bar[XB_XGEN(x)]) == gen, bar);
            __builtin_amdgcn_fence(__ATOMIC_ACQUIRE, "agent");
            asm volatile("s_waitcnt vmcnt(0)" ::: "memory");
        }
    }
    __syncthreads();
}
#define FRESH() do { int t_ = threadIdx.x; asm volatile("" : "+v"(t_)); F.tid = t_; F.lane = t_ & 63; F.wave = __builtin_amdgcn_readfirstlane(t_ >> 6); \
    int g_ = gridDim.x, b_ = blockIdx.x; asm volatile("" : "+s"(g_), "+s"(b_)); F.G = g_; F.bid = b_; } while (0)
#define PHASE_VARS FRESH(); const int G = F.G, c = F.bid; (void)G; (void)c; PP P = getpp(); unsigned char* ws = P->ws; const bool L0 = (layer == 0); \
    const float* hl = L0 ? P->in[I_X] : P->out; const float* hcx = L0 ? P->in[I_CTX] : (const float*)(ws + WS_HC); float* hc = (float*)(ws + WS_HC); \
    const char* wl = (const char*)(ws + WS_W + (size_t)layer * WL_STRIDE); const float* mod = (const float*)(ws + WS_MOD) + (size_t)layer * 9 * 6144; \
    const int nMm = L0 ? RT / 256 : RL / 256; (void)hl; (void)hcx; (void)hc; (void)wl; (void)mod; (void)nMm;

template <int layer> __device__ __forceinline__ void layer_fwd(Ctx& F, cg::grid_group& grid) {

        { PHASE_VARS norm_pass(F, layer, 0, hl, hcx, RT, (bf16_t*)(ws + D_XN1), (bf16_t*)(ws + D_XN1 + Y34)); }
        xcd_barrier(F.lds);
        { PHASE_VARS SchedSplit2 S{(const char*)(ws + D_XN1), (const char*)(ws + D_XN1 + Y34), wl + WL_WINLO, wl + WL_WINHI, RT / 256, MIXP / 256, G, c};
          EpiInproj E{ws};
          pg8::gemm_phase<512, 512, true>(F.lds, S, E); }
        xcd_barrier(F.lds);
        FRESH(); mla_stats_pass(F, 0, F.G * 8);
        FRESH(); ret_r1_phase(F, layer);
        xcd_barrier(F.lds);
        FRESH(); ret_r2(F, layer, 0, F.G);
        FRESH(); krope_pass(F, 0, layer);
        { PHASE_VARS SchedHalf S{(const char*)(ws + D_UMLA), wl + WL_WQ, (size_t)256 * MLC * 2, (size_t)256 * 384 * 2, 6, 3, 0, G, c};
          EpiQup E{(bf16_t*)(half_a_base(layer) + HA_Q), (const float*)(ws + WS_RSTD), (const float*)(ws + WS_ROPE_M), (const float*)(ws + WS_ROPE_M) + 4096 * 16, 1};
          pg8::gemm_phase<MLC, 384, false>(F.lds, S, E); }
        { PHASE_VARS SchedHalf S{(const char*)(ws + D_UMLA) + 384 * 2, wl + WL_WKV, (size_t)256 * MLC * 2, (size_t)256 * 256 * 2, 4, 4, 0, G, c};
          EpiKVup E{(bf16_t*)(half_a_base(layer) + HA_K), (bf16_t*)(half_a_base(layer) + HA_V), (const float*)(ws + WS_RSTD) + RT, 1};
          pg8::gemm_phase<MLC, 256, true>(F.lds, S, E); }
        xcd_barrier(F.lds);
        FRESH(); rw_phase(F, layer);
        xcd_barrier(F.lds);
        FRESH(); rwkv_post_phase(F, layer, layer == 0 ? RT : RL);
        xcd_barrier(F.lds);
        FRESH(); krope_pass(F, 1, layer);
        FRESH(); ret_r3_phase(F, layer);
        { PHASE_VARS SchedHalf S{(const char*)(ws + D_UMLA), wl + WL_WQ, (size_t)256 * MLC * 2, (size_t)256 * 384 * 2, 6, 3, 1, G, c};
          EpiQup E{(bf16_t*)(ws + D_Q), (const float*)(ws + WS_RSTD), (const float*)(ws + WS_ROPE_M), (const float*)(ws + WS_ROPE_M) + 4096 * 16, 0};
          pg8::gemm_phase<MLC, 384, false>(F.lds, S, E); }
        { PHASE_VARS SchedHalf S{(const char*)(ws + D_UMLA) + 384 * 2, wl + WL_WKV, (size_t)256 * MLC * 2, (size_t)256 * 256 * 2, 4, 4, 1, G, c};
          EpiKVup E{(bf16_t*)(ws + D_K), (bf16_t*)(ws + D_V), (const float*)(ws + WS_RSTD) + RT, 0};
          pg8::gemm_phase<MLC, 256, true>(F.lds, S, E); }
        xcd_barrier(F.lds);
        FRESH(); attn_phase(F, layer);
        xcd_barrier(F.lds);
        if (layer != 0) { { PHASE_VARS norm_pass(F, layer, 0, hl, hcx, nMm * 256, (bf16_t*)(ws + D_XN1), (bf16_t*)(ws + D_XN1 + Y34)); }
        xcd_barrier(F.lds); }
        { PHASE_VARS SchedMerge S; S.XNlo = (const char*)(ws + D_XN1); S.XNhi = (const char*)(ws + D_XN1 + Y34); S.WgLo = wl + WL_WGLO; S.WgHi = wl + WL_WGHI;
          S.wsb = (const char*)ws; S.Wb = wl + WL_WB; S.nM = nMm; S.G = G; S.c = c; S.ctx3 = L0 && G > 64;
          EpiMerge E{(u32x4*)(ws + D_SCR + (size_t)c * 131072), (bf16_t*)(ws + D_M), (bf16_t*)(ws + D_P12)};
          pg8::gemm_phase<512, 512, true>(F.lds, S, E); }
        xcd_barrier(F.lds);
        if (layer == 0 && F.G > 64) { PHASE_VARS SchedWout0 S{(const char*)(ws + D_M), wl + WL_WO, (const char*)ws, G, c};
          EpiResid E{hl, hcx, P->out, hc, mod, 2048};
          pg8::gemm_phase<1024, 1024, false>(F.lds, S, E); }
        else { PHASE_VARS Sched1 S{(const char*)(ws + D_M), wl + WL_WO, (size_t)256 * 1024 * 2, (size_t)256 * 1024 * 2, 16, nMm, 4, G, c};
          EpiResid E{hl, hcx, P->out, hc, mod, 2048};
          pg8::gemm_phase<1024, 1024, false>(F.lds, S, E); }
        xcd_barrier(F.lds);
        if (layer == 0) {
            { PHASE_VARS norm_pass(F, layer, 1, P->out, hc, RT, (bf16_t*)(ws + D_XN2), (bf16_t*)(ws + D_XN2 + Y34)); }
            FRESH(); convert_ffn0(F);
            xcd_barrier(F.lds);
            { PHASE_VARS SchedSplit2 S{(const char*)(ws + D_XN2), (const char*)(ws + D_XN2 + Y34), (const char*)(ws + D_FFW), (const char*)(ws + D_FFW) + (size_t)5632 * 1024, RT / 256, 22, G, c};
              EpiSwiglu E{(bf16_t*)(ws + D_H), DFF};
              pg8::gemm_phase<512, 512, true>(F.lds, S, E); }
            xcd_barrier(F.lds);
            { PHASE_VARS Sched1 S{(const char*)(ws + D_H), (const char*)(ws + D_FFW) + (size_t)2 * 5632 * 1024, (size_t)256 * DFF * 2, (size_t)256 * DFF * 2, 44, RT / 256, 4, G, c};
              EpiResid E{P->out, hc, P->out, hc, mod, 5120};
              pg8::gemm_phase<DFF, DFF, false>(F.lds, S, E); }
            xcd_barrier(F.lds);
        } else {
            FRESH(); moe_route_pass(F, layer);
            FRESH(); convert_moe(F);
            xcd_barrier(F.lds);
            FRESH(); moe_gather_pass(F, layer);
            xcd_barrier(F.lds);
            { PHASE_VARS const MoeTiles T = moe_tiles((const unsigned*)(ws + WS_CTL));
              SchedMoeUp S{(const char*)(ws + D_XG), (const char*)(ws + D_XG) + (size_t)RG * 1024, (const char*)(ws + D_MOEW), T, G, c};
              EpiSwiglu E{(bf16_t*)(ws + D_HM), DFE};
              pg8::gemm_phase<512, 512, true>(F.lds, S, E); }
            xcd_barrier(F.lds);
            { PHASE_VARS const MoeTiles T = moe_tiles((const unsigned*)(ws + WS_CTL));
              SchedMoeDown S{(const char*)(ws + D_HM), (const char*)(ws + D_MOEW), T, G, c};
              EpiBf16 E{(bf16_t*)(ws + D_XG), 1024};
              pg8::gemm_phase<DFE, DFE, true>(F.lds, S, E); }
            xcd_barrier(F.lds);
            FRESH(); moe_final_pass(F, layer);
        }
    }
#undef PHASE_VARS
#undef FRESH

__global__ void __launch_bounds__(NTHREADS, 2) mega_fwd(Params prm) {
    extern __shared__ __attribute__((aligned(16))) unsigned char lds_raw[];
    cg::grid_group grid = cg::this_grid();
    Ctx F; F.lds = (LAS unsigned char*)lds_raw; F.tid = threadIdx.x; F.lane = F.tid & 63; F.wave = __builtin_amdgcn_readfirstlane(F.tid >> 6); F.G = gridDim.x; F.bid = blockIdx.x;
    if (F.tid < 4) ((LAS unsigned*)(F.lds + LDS_BARST))[F.tid] = 0u;
    __syncthreads();
    if (F.tid == 0) (void)xb_add((unsigned*)(prm.ws + WS_CTL) + CW_BAR + XB_XCNT(xb_xcc_id()), 1u);
    phase0(F);
    grid.sync();
    layer_fwd<0>(F, grid);
    layer_fwd<1>(F, grid);
}

extern "C" void kernel_launch(void* const* d_in, const int* in_sizes, int n_in, void* d_out, int out_size, void* d_ws, size_t ws_size, hipStream_t stream) {
    static int grid_blocks = 0;
    if (grid_blocks == 0) {
        if (n_in != 37 || ws_size < WS_NEED) { fprintf(stderr, "kernel_launch: unexpected n_in %d / ws %zu\n", n_in, ws_size); grid_blocks = -1; return; }
        int dev = 0, cus = 0, per_cu = 0;
        hipGetDevice(&dev); hipDeviceGetAttribute(&cus, hipDeviceAttributeMultiprocessorCount, dev);
        hipFuncSetAttribute((const void*)mega_fwd, hipFuncAttributeMaxDynamicSharedMemorySize, LDS_BYTES);
        hipOccupancyMaxActiveBlocksPerMultiprocessor(&per_cu, (const void*)mega_fwd, NTHREADS, LDS_BYTES);
        if (per_cu < 1) { fprintf(stderr, "kernel_launch: occupancy query says %d blocks/CU\n", per_cu); per_cu = 1; }
        grid_blocks = cus;
        (void)hipGetLastError();
    }
    if (grid_blocks < 0) return;
    (void)hipMemsetAsync((char*)d_ws + WS_CTL, 0, 65536, stream);
    Params p{};
    for (int i = 0; i < 37; ++i) p.in[i] = (const float*)d_in[i];
    p.out = (float*)d_out; p.ws = (unsigned char*)d_ws;
    void* args[] = {&p};
    hipError_t e = hipLaunchCooperativeKernel((const void*)mega_fwd, dim3(grid_blocks), dim3(NTHREADS), args, LDS_BYTES, stream);
    if (e != hipSuccess) fprintf(stderr, "cooperative launch failed: %s (grid %d)\n", hipGetErrorString(e), grid_blocks);
}
```

```cpp
#include <hip/hip_runtime.h>
#include <hip/hip_cooperative_groups.h>
#include <cstdio>
#include <cstdint>
namespace cg = cooperative_groups;

#define LAS __attribute__((address_space(3)))
typedef unsigned short bf16_t;
typedef short bf16x8 __attribute__((ext_vector_type(8)));
typedef short s16x4 __attribute__((ext_vector_type(4)));
typedef float f32x4 __attribute__((ext_vector_type(4)));
typedef float f32x2 __attribute__((ext_vector_type(2)));
typedef float f32x16 __attribute__((ext_vector_type(16)));
typedef unsigned u32x4 __attribute__((ext_vector_type(4)));
typedef unsigned u32x2 __attribute__((ext_vector_type(2)));

constexpr int DM = 1024, NBATCH = 8, SEQ = 4096, CTXL = 256;
constexpr int RL = NBATCH * SEQ, RC = NBATCH * CTXL, RT = RL + RC;
constexpr int RWC = 1920, REC = 1536, MLC = 672, MIXC = 4128, MIXP = 4352, GATEC = 3072, NIN = 7200;
constexpr int DFF = 2816, NEXP = 8, DFE = 1408;
constexpr int RG = 2 * RL + NEXP * 256;
constexpr int NTHREADS = 512;
constexpr int LDS_BYTES = 147456;

constexpr size_t MiB = 1u << 20;
constexpr size_t WS_CTL = 0;
constexpr size_t WS_MOD = 1 * MiB;
constexpr size_t WS_ROPE_R = 3 * MiB / 2;
constexpr size_t WS_ROPE_M = 5 * MiB / 2;
constexpr size_t WS_RSTD = 3 * MiB;
constexpr size_t WS_BSC = 7 * MiB / 2;
constexpr size_t WS_ROUTE = 6 * MiB;
constexpr size_t WS_WG2 = 7 * MiB;
constexpr size_t WS_W2T = 15 * MiB / 2;
constexpr size_t WS_HC = 8 * MiB;
constexpr size_t WS_W = 16 * MiB;
constexpr size_t WL_WINLO = 0, WL_WINHI = 4456448, WL_WGLO = 8912896, WL_WGHI = 12058624, WL_WQ = 15204352, WL_WKV = 15794176, WL_WB = 16318464, WL_WO = 19464192, WL_STRIDE = 21 * MiB;
constexpr size_t WS_DYN = 58 * MiB;
constexpr size_t Y34 = 34 * MiB;
constexpr size_t D_URWKV = WS_DYN, D_URET = WS_DYN + 255 * MiB / 2, D_UMLA = D_URET + 102 * MiB, D_XN1 = D_UMLA + 357 * MiB / 8, D_OF = D_XN1 + 2 * Y34, D_OB = D_OF + Y34, D_END1 = D_OB + Y34;
constexpr size_t D_YRWKV = D_OF, D_YRET = D_OB;
constexpr size_t D_K = WS_DYN, D_V = D_K + 289 * MiB / 8, D_Q = D_V + Y34;
constexpr size_t D_YMLA = D_UMLA;
constexpr int HROWS = 4 * SEQ + 4 * CTXL;
constexpr size_t HA_K = 0, HA_V = HA_K + (size_t)HROWS * 544 * 2, HA_Q = HA_V + (size_t)HROWS * 512 * 2;
static_assert(HA_Q + (size_t)HROWS * 768 * 2 <= 2 * Y34, "half-A K/V/Q fit the xn region / d_out");

constexpr size_t D_SCR = WS_DYN + 68 * MiB;
constexpr size_t D_P12 = WS_DYN + 100 * MiB;
constexpr size_t D_M = WS_DYN;
constexpr size_t D_FFW = WS_DYN;
constexpr size_t D_XN2 = WS_DYN + 17 * MiB;
constexpr size_t D_H = D_URET;
constexpr size_t D_XG = WS_DYN;
constexpr size_t D_HM = WS_DYN + 132 * MiB;
constexpr size_t D_MOEW = D_HM + 363 * MiB / 2;
constexpr size_t WS_NEED = 512 * MiB;
static_assert(D_END1 <= WS_NEED && D_MOEW + 66 * MiB <= WS_NEED && D_H + 187 * MiB <= WS_NEED && D_Q + 51 * MiB <= D_URET, "ws map");

struct Params { const float* in[37]; float* out; unsigned char* ws; };
enum { I_X = 0, I_C, I_CTX, I_CCTX, I_NMIX, I_NFFN, I_WMOD, I_BMOD, I_WIN, I_MU, I_W0, I_W2, I_A0, I_A2, I_G2, I_KK, I_KA, I_RK, I_LNG, I_LNB,
       I_RDEC, I_RLNG, I_RLNB, I_QN, I_QUP, I_KVN, I_KVUP, I_WBR, I_WOUT, I_FG, I_FU, I_FD, I_ROUTER, I_MG, I_MU2, I_MD, I_FNORM };

__device__ __forceinline__ unsigned f2bf(float f) { unsigned u = __builtin_bit_cast(unsigned, f); return (u + 0x7fffu + ((u >> 16) & 1u)) >> 16; }
typedef __bf16 bf16x2_t __attribute__((ext_vector_type(2)));
__device__ __forceinline__ unsigned pk2(float lo, float hi) { const f32x2 v = {lo, hi}; return __builtin_bit_cast(unsigned, __builtin_convertvector(v, bf16x2_t)); }
__device__ __forceinline__ float bf2f(unsigned short b) { return __builtin_bit_cast(float, (unsigned)b << 16); }
__device__ __forceinline__ float bflo(unsigned w) { return __builtin_bit_cast(float, w << 16); }
__device__ __forceinline__ float bfhi(unsigned w) { return __builtin_bit_cast(float, w & 0xffff0000u); }
__device__ __forceinline__ float shx(float v, int m, int lane) { return __int_as_float(__builtin_amdgcn_ds_bpermute((lane ^ m) << 2, __float_as_int(v))); }
__device__ __forceinline__ float wave_sum(float v, int lane) {
#pragma unroll
    for (int o = 1; o < 64; o <<= 1) v += shx(v, o, lane);
    return v;
}
__device__ __forceinline__ float sigmoidf_(float x) { return __builtin_amdgcn_rcpf(1.0f + __builtin_amdgcn_exp2f(-1.4426950408889634f * x)); }
__device__ __forceinline__ float siluf_(float x) { return x * __builtin_amdgcn_rcpf(1.0f + __builtin_amdgcn_exp2f(-1.4426950408889634f * x)); }
__device__ __forceinline__ void unpack8(u32x4 w, float* f) { f[0] = bflo(w.x); f[1] = bfhi(w.x); f[2] = bflo(w.y); f[3] = bfhi(w.y); f[4] = bflo(w.z); f[5] = bfhi(w.z); f[6] = bflo(w.w); f[7] = bfhi(w.w); }
__device__ __forceinline__ u32x4 pack8(const float* f) { u32x4 w; w.x = pk2(f[0], f[1]); w.y = pk2(f[2], f[3]); w.z = pk2(f[4], f[5]); w.w = pk2(f[6], f[7]); return w; }

namespace pg8 {
constexpr int BM = 256, BK = 64, HALF = 128, HTB = HALF * BK * 2, STAGE_BYTES = 8 * HTB, NXCD = 8, WGM = 4;
__host__ __device__ __forceinline__ int lds_byte(int r, int c) { const int st = (r >> 4) * 2 + (c >> 5), rr = r & 15, cc = c & 31, ob = rr * 64 + cc * 2; return st * 1024 + (ob ^ (((ob >> 9) & 1) << 5)); }
__host__ __device__ __forceinline__ void stage_rc(int b, int& R, int& C) { const int st = b / 1024, sb = b % 1024, swz = sb ^ (((sb >> 9) & 1) << 5); R = (st >> 1) * 16 + swz / 64; C = (st & 1) * 32 + (swz % 64) / 2; }
__host__ __device__ __forceinline__ int perm32(int rho) { const int n = rho >> 4, i = rho & 15; return 8 * (i >> 2) + 4 * n + (i & 3); }

struct Seg { const char* A; const char* B; int nt; int pm, pn, aux; bool first, last; };

__device__ __forceinline__ void tile_order(int L, int nM, int nN, int& pm, int& pn) {
    const int nwg = nM * nN; int wgid = L;
    { const int q = nwg / NXCD, r = nwg % NXCD, xcd = wgid % NXCD, off = wgid / NXCD; wgid = (xcd < r ? xcd * (q + 1) : r * (q + 1) + (xcd - r) * q) + off; }
    const int nig = WGM * nN, gid = wgid / nig, fm = gid * WGM, gsz = (nM - fm) < WGM ? (nM - fm) : WGM;
    pm = fm + ((wgid % nig) % gsz); pn = (wgid % nig) / gsz;
}

template <int LDA, int LDB, bool PERM, class Sched, class Epi>
__device__ __forceinline__ void gemm_phase(LAS unsigned char* lds, const Sched& S, const Epi& E) {
    int tid_ = threadIdx.x; asm volatile("" : "+v"(tid_));
    const int tid = tid_, wid = __builtin_amdgcn_readfirstlane(tid >> 6), lane = tid & 63, wr = wid >> 2, wc = wid & 3, fr = lane & 15, fq = lane >> 4;
    unsigned voffA[2], voffB[2];
#pragma unroll
    for (int i = 0; i < 2; ++i) { int R, C; stage_rc(tid * 16 + i * 8192, R, C); const int Rb = PERM ? ((R & ~31) + perm32(R & 31)) : R;
        voffA[i] = (unsigned)(R * LDA + C) * 2u; voffB[i] = (unsigned)(Rb * LDB + C) * 2u; }
    constexpr size_t kstep = (size_t)(BK * 2);
    constexpr size_t hstepA = (size_t)HALF * LDA * 2, hstepB = (size_t)HALF * LDB * 2;
    const unsigned ldsw = (unsigned)wid * 1024u;
    const int aoff = lds_byte(wr * 64 + fr, fq * 8), boff = lds_byte(wc * 32 + fr, fq * 8);
#define PG8_SA(b, h) (((b) * 2 + (h)) * HTB)
#define PG8_SB(b, h) ((4 + (b) * 2 + (h)) * HTB)
#define PG8_STAGE(bufoff, gbase, voff) do { _Pragma("unroll") for (int _i = 0; _i < 2; ++_i) \
        __builtin_amdgcn_global_load_lds((const unsigned*)((const char*)(gbase) + (voff)[_i]), (LAS unsigned*)(lds + (bufoff) + ldsw + _i * 8192), 16, 0, 0); } while (0)
#define PG8_LDA(dst, b, h) do { _Pragma("unroll") for (int m = 0; m < 4; ++m) _Pragma("unroll") for (int k = 0; k < 2; ++k) dst[m][k] = *(const LAS bf16x8*)(lds + PG8_SA(b, h) + aoff + m * 2048 + k * 1024); } while (0)
#define PG8_LDB(dst, b, h) do { _Pragma("unroll") for (int n = 0; n < 2; ++n) _Pragma("unroll") for (int k = 0; k < 2; ++k) dst[n][k] = *(const LAS bf16x8*)(lds + PG8_SB(b, h) + boff + n * 2048 + k * 1024); } while (0)
#define PG8_MMA(ai, bj, At, Bt) do { __builtin_amdgcn_s_setprio(1); _Pragma("unroll") for (int m = 0; m < 4; ++m) _Pragma("unroll") for (int n = 0; n < 2; ++n) _Pragma("unroll") for (int k = 0; k < 2; ++k) \
        acc[ai][bj][m][n] = __builtin_amdgcn_mfma_f32_16x16x32_bf16(Bt[n][k], At[m][k], acc[ai][bj][m][n], 0, 0, 0); __builtin_amdgcn_s_setprio(0); } while (0)
#define PG8_WAIT_V(n) asm volatile("s_waitcnt vmcnt(" #n ")" ::: "memory")
#define PG8_WAIT_L(n) asm volatile("s_waitcnt lgkmcnt(" #n ")" ::: "memory")
#define PG8_BAR __builtin_amdgcn_s_barrier()
#define PG8_SCHED __builtin_amdgcn_sched_barrier(0)
    Seg cur, nxt; int ui = 0;
    if (!S.next(0, cur)) return;
    f32x4 acc[2][2][4][2];
#pragma unroll
    for (int a = 0; a < 2; ++a)
#pragma unroll
        for (int b = 0; b < 2; ++b)
#pragma unroll
            for (int m = 0; m < 4; ++m)
#pragma unroll
                for (int n = 0; n < 2; ++n) acc[a][b][m][n] = (f32x4){0.f, 0.f, 0.f, 0.f};
    bf16x8 At[4][2], B0[2][2], B1[2][2];
    const char* cA = cur.A; const char* cB = cur.B;
    PG8_STAGE(PG8_SB(0, 0), cB, voffB); PG8_STAGE(PG8_SB(0, 1), cB + hstepB, voffB); PG8_STAGE(PG8_SA(0, 0), cA, voffA); PG8_STAGE(PG8_SA(0, 1), cA + hstepA, voffA);
    if (wr == 1) PG8_BAR;
    PG8_WAIT_V(2); PG8_BAR;
    PG8_STAGE(PG8_SB(1, 0), cB + kstep, voffB); PG8_STAGE(PG8_SA(1, 0), cA + kstep, voffA); PG8_STAGE(PG8_SB(1, 1), cB + hstepB + kstep, voffB);
    PG8_WAIT_V(6); PG8_BAR;
    for (;;) {
        const bool has_next = S.next(ui + 1, nxt);
        const char* nA = has_next ? nxt.A : cA; const char* nB = has_next ? nxt.B : cB;
        const int nt = cur.nt;
        for (int t = 0; t < nt; t += 2) {
            const bool last = (t == nt - 2);
            const char* a1 = cA + (size_t)(t + 1) * kstep;
            const char* a2 = last ? nA : cA + (size_t)(t + 2) * kstep; const char* b2 = last ? nB : cB + (size_t)(t + 2) * kstep;
            const char* a3 = a2 + kstep; const char* b3 = b2 + kstep;
            PG8_LDB(B0, 0, 0); PG8_LDB(B1, 0, 1); PG8_SCHED; PG8_LDA(At, 0, 0); PG8_STAGE(PG8_SA(1, 1), a1 + hstepA, voffA);
            PG8_WAIT_V(8); PG8_WAIT_L(0); PG8_BAR; PG8_MMA(0, 0, At, B0); PG8_MMA(0, 1, At, B1); PG8_BAR; PG8_SCHED;
            PG8_LDA(At, 0, 1); PG8_STAGE(PG8_SB(0, 0), b2, voffB); PG8_STAGE(PG8_SB(0, 1), b2 + hstepB, voffB); PG8_STAGE(PG8_SA(0, 0), a2, voffA);
            PG8_WAIT_V(8); PG8_WAIT_L(0); PG8_BAR; PG8_MMA(1, 0, At, B0); PG8_MMA(1, 1, At, B1); PG8_BAR; PG8_SCHED;
            PG8_LDB(B0, 1, 0); PG8_LDB(B1, 1, 1); PG8_SCHED; PG8_LDA(At, 1, 0); PG8_STAGE(PG8_SA(0, 1), a2 + hstepA, voffA);
            PG8_WAIT_V(8); PG8_WAIT_L(0); PG8_BAR; PG8_MMA(0, 0, At, B0); PG8_MMA(0, 1, At, B1); PG8_BAR; PG8_SCHED;
            PG8_LDA(At, 1, 1); PG8_STAGE(PG8_SB(1, 0), b3, voffB); PG8_STAGE(PG8_SB(1, 1), b3 + hstepB, voffB); PG8_STAGE(PG8_SA(1, 0), a3, voffA);
            PG8_WAIT_V(8); PG8_WAIT_L(0); PG8_BAR; PG8_MMA(1, 0, At, B0); PG8_MMA(1, 1, At, B1); PG8_BAR; PG8_SCHED;
        }
        const bool was_last = cur.last;
        if (was_last) { if (wr == 0) PG8_BAR; E(acc, cur, wr, wc, fr, fq); }
        if (!has_next) break;
        if (nxt.first) {
#pragma unroll
            for (int a = 0; a < 2; ++a)
#pragma unroll
                for (int b = 0; b < 2; ++b)
#pragma unroll
                    for (int m = 0; m < 4; ++m)
#pragma unroll
                        for (int n = 0; n < 2; ++n) acc[a][b][m][n] = (f32x4){0.f, 0.f, 0.f, 0.f};
        }
        cur = nxt; cA = nA; cB = nB; ++ui;
        if (was_last) { if (wr == 1) PG8_BAR; }
    }
    PG8_WAIT_V(0);
    PG8_BAR;
#undef PG8_SA
#undef PG8_SB
#undef PG8_STAGE
#undef PG8_LDA
#undef PG8_LDB
#undef PG8_MMA
#undef PG8_WAIT_V
#undef PG8_WAIT_L
#undef PG8_BAR
#undef PG8_SCHED
}
}
using pg8::Seg;

struct Ctx {
    LAS unsigned char* lds; int tid, lane, wave, G, bid;
};
typedef const __attribute__((address_space(4))) Params* PP;
__device__ __forceinline__ PP getpp() { PP p = (PP)__builtin_amdgcn_kernarg_segment_ptr(); asm volatile("" : "+s"(p)); return p; }
__device__ __forceinline__ unsigned char* half_a_base(int layer) { PP p = getpp(); return layer == 0 ? (unsigned char*)p->out : p->ws + D_XN1; }
#define GW(F) ((F).bid * 8 + (F).wave)
#define NGW(F) ((F).G * 8)
#define LDS_WAIT() asm volatile("s_waitcnt lgkmcnt(0)" ::: "memory")

struct TrJob {
    const float* s0; const float* s1; int spitch; int K; int nd; int mode; int c0; int nvalid; const float* ks;
    bf16_t* dlo; bf16_t* dhi; int dpitch; int ksplit;
};
__device__ __forceinline__ void tr_item(const TrJob& J, LAS float* scr, int item, int lane) {
    const int nblk = J.nd / 32, kb = item / nblk, nb = item % nblk, k0 = 64 * kb, n0 = 32 * nb;
    const int np = n0 + (lane & 31);
    const float* src = J.s0; int col = 0; bool valid = true;
    if (J.mode == 0) { col = J.c0 + np; valid = np < J.nvalid; }
    else if (J.mode == 1) { if (np < 512) col = (np >> 6) * 128 + (np & 63); else col = ((np - 512) >> 6) * 128 + 64 + (np & 63); }
    else { const int tile = np >> 8, w = np & 255; if (w < 128) col = tile * 128 + w; else { col = tile * 128 + (w - 128); src = J.s1; } }
    if (!valid) col = J.c0;
    const float* sp = src + (size_t)(k0 + (lane >> 5)) * J.spitch + col;
    float v[32];
#pragma unroll
    for (int i = 0; i < 32; ++i) v[i] = __builtin_nontemporal_load(sp + (size_t)(2 * i) * J.spitch);
    if (J.ks) {
#pragma unroll
        for (int i = 0; i < 32; ++i) v[i] *= J.ks[k0 + 2 * i + (lane >> 5)]; }
#pragma unroll
    for (int i = 0; i < 32; ++i) scr[(2 * i + (lane >> 5)) * 33 + (lane & 31)] = valid ? v[i] : 0.f;
    LDS_WAIT(); asm volatile("" ::: "memory");
    const int c = lane & 7;
    bf16_t* dst = (k0 < J.ksplit) ? J.dlo : J.dhi; const int kd = (k0 < J.ksplit) ? k0 : k0 - J.ksplit;
#pragma unroll
    for (int j = 0; j < 4; ++j) { const int n = (lane >> 3) + 8 * j; const LAS float* s = scr + (8 * c) * 33 + n;
        u32x4 o; o.x = pk2(s[0 * 33], s[1 * 33]); o.y = pk2(s[2 * 33], s[3 * 33]); o.z = pk2(s[4 * 33], s[5 * 33]); o.w = pk2(s[6 * 33], s[7 * 33]);
        *(u32x4*)(dst + (size_t)(n0 + n) * J.dpitch + kd + 8 * c) = o; }
    LDS_WAIT(); asm volatile("" ::: "memory");
}
__device__ __forceinline__ void tr_job(const Ctx& F, const TrJob& J) {
    LAS float* scr = (LAS float*)(F.lds + F.wave * 8704);
    const int nitems = (J.K / 64) * (J.nd / 32);
    for (int it = GW(F); it < nitems; it += NGW(F)) tr_item(J, scr, it, F.lane);
}
__device__ __forceinline__ TrJob mk_job(const float* s0, int spitch, int K, int nd, int c0, int nvalid, bf16_t* dst, int dpitch) {
    TrJob J; J.s0 = s0; J.s1 = nullptr; J.spitch = spitch; J.K = K; J.nd = nd; J.mode = 0; J.c0 = c0; J.nvalid = nvalid; J.ks = nullptr; J.dlo = dst; J.dhi = dst; J.dpitch = dpitch; J.ksplit = 1 << 30; return J;
}

__device__ __forceinline__ void phase0(const Ctx& F) {
    PP P = getpp(); unsigned char* ws = P->ws;
    {
        float* cr = (float*)(ws + WS_ROPE_R); float* sr = cr + 4096 * 32; float* cm = (float*)(ws + WS_ROPE_M); float* sm = cm + 4096 * 16;
        for (int i = F.bid * NTHREADS + F.tid; i < 4096 * 48; i += F.G * NTHREADS) {
            const int t = i / 48, j = i % 48; const float row = (float)(t >> 6), colp = (float)(t & 63);
            if (j < 32) { const int f = j & 15; const float inv = powf(10000.0f, -(float)f / 16.0f); const float ang = (j < 16 ? row : colp) * inv; cr[t * 32 + j] = cosf(ang); sr[t * 32 + j] = sinf(ang); }
            else { const int jj = j - 32, f = jj & 7; const float inv = powf(10000.0f, -(float)f / 8.0f); const float ang = (jj < 8 ? row : colp) * inv; cm[t * 16 + jj] = cosf(ang); sm[t * 16 + jj] = sinf(ang); }
        }
        if (F.bid == 0 && F.tid < 64) ((unsigned*)(ws + WS_CTL))[F.tid] = 0u;
    }
    {
        LAS float* sc = (LAS float*)(F.lds + 70000);
        LAS float* red = (LAS float*)(F.lds + 70000 + 36864);
        for (int i = F.tid; i < 9 * 1024; i += NTHREADS) { const int v = i >> 10, k = i & 1023; const float x = v < 8 ? P->in[I_C][v * 1024 + k] : P->in[I_CCTX][k]; sc[i] = siluf_(x); }
        __syncthreads();
        for (int it = F.bid; it < 2 * 96; it += F.G) {
            const int l = it / 96, jc = F.tid & 63, j = (it % 96) * 64 + jc, ksl = F.tid >> 6;
            const float* w = P->in[I_WMOD] + (size_t)l * 1024 * 6144 + j + (size_t)(ksl * 128) * 6144;
            float a[9];
#pragma unroll
            for (int v = 0; v < 9; ++v) a[v] = 0.f;
#pragma unroll 1
            for (int k0 = 0; k0 < 128; k0 += 16) { float wv[16];
#pragma unroll
                for (int q = 0; q < 16; ++q) wv[q] = w[(size_t)(k0 + q) * 6144];
#pragma unroll
                for (int q = 0; q < 16; ++q)
#pragma unroll
                    for (int v = 0; v < 9; ++v) a[v] += sc[v * 1024 + ksl * 128 + k0 + q] * wv[q]; }
#pragma unroll
            for (int v = 0; v < 9; ++v) red[(ksl * 64 + jc) * 9 + v] = a[v];
            __syncthreads();
            if (F.tid < 64) {
                float* mo = (float*)(ws + WS_MOD) + (size_t)l * 9 * 6144;
#pragma unroll
                for (int v = 0; v < 9; ++v) { float s = 0.f;
#pragma unroll
                    for (int q = 0; q < 8; ++q) s += red[(q * 64 + F.tid) * 9 + v];
                    mo[v * 6144 + j] = s + P->in[I_BMOD][l * 6144 + j]; }
            }
            __syncthreads();
        }
    }
    for (int l = 0; l < 2; ++l) {
        unsigned char* wb = ws + WS_W + (size_t)l * WL_STRIDE;
        const float* win = P->in[I_WIN] + (size_t)l * 1024 * NIN;
        { TrJob J = mk_job(win, NIN, 1024, MIXP, 0, MIXC, (bf16_t*)(wb + WL_WINLO), 512); J.dhi = (bf16_t*)(wb + WL_WINHI); J.ksplit = 512; tr_job(F, J); }
        { TrJob J = mk_job(win, NIN, 1024, GATEC, MIXC, GATEC, (bf16_t*)(wb + WL_WGLO), 512); J.dhi = (bf16_t*)(wb + WL_WGHI); J.ksplit = 512; tr_job(F, J); }
        { TrJob J = mk_job(P->in[I_QUP] + (size_t)l * 384 * 768, 768, 384, 768, 0, 768, (bf16_t*)(wb + WL_WQ), 384); J.ks = P->in[I_QN] + l * 384; tr_job(F, J); }
        { TrJob J = mk_job(P->in[I_KVUP] + (size_t)l * 256 * 1024, 1024, 256, 1024, 0, 1024, (bf16_t*)(wb + WL_WKV), 256); J.mode = 1; J.ks = P->in[I_KVN] + l * 256; tr_job(F, J); }
        for (int n = 0; n < 3; ++n) { TrJob J = mk_job(P->in[I_WBR] + ((size_t)l * 3 + n) * 512 * 1024, 1024, 512, 1024, 0, 1024, (bf16_t*)(wb + WL_WB) + (size_t)n * 1024 * 512, 512); tr_job(F, J); }
        { TrJob J = mk_job(P->in[I_WOUT] + (size_t)l * 1024 * 1024, 1024, 1024, 1024, 0, 1024, (bf16_t*)(wb + WL_WO), 1024); tr_job(F, J); }
        { TrJob J = mk_job(P->in[I_G2] + (size_t)l * 128 * 512, 512, 128, 512, 0, 512, (bf16_t*)(ws + WS_WG2) + (size_t)l * 512 * 128, 128); tr_job(F, J); }
        for (int dd = 0; dd < 2; ++dd) {
            { TrJob J = mk_job(P->in[I_W2] + (size_t)(l * 2 + dd) * 64 * 512, 512, 64, 512, 0, 512, (bf16_t*)(ws + WS_W2T) + (size_t)((l * 2 + dd) * 2 + 0) * 512 * 64, 64); tr_job(F, J); }
            { TrJob J = mk_job(P->in[I_A2] + (size_t)(l * 2 + dd) * 64 * 512, 512, 64, 512, 0, 512, (bf16_t*)(ws + WS_W2T) + (size_t)((l * 2 + dd) * 2 + 1) * 512 * 64, 64); tr_job(F, J); }
        }
    }
}
__device__ __forceinline__ void convert_ffn0(const Ctx& F) {
    PP P = getpp(); unsigned char* ws = P->ws;
    bf16_t* glo = (bf16_t*)(ws + D_FFW); bf16_t* ghi = glo + (size_t)5632 * 512; bf16_t* wd = ghi + (size_t)5632 * 512;
    { TrJob J = mk_job(P->in[I_FG], DFF, 1024, 5632, 0, 5632, glo, 512); J.s1 = P->in[I_FU]; J.mode = 2; J.dhi = ghi; J.ksplit = 512; tr_job(F, J); }
    { TrJob J = mk_job(P->in[I_FD], 1024, DFF, 1024, 0, 1024, wd, DFF); tr_job(F, J); }
}
__device__ __forceinline__ void convert_moe(const Ctx& F) {
    PP P = getpp(); unsigned char* ws = P->ws;
    for (int e = 0; e < NEXP; ++e) {
        bf16_t* glo = (bf16_t*)(ws + D_MOEW + (size_t)e * (33 * MiB / 4)); bf16_t* ghi = glo + (size_t)2816 * 512; bf16_t* wd = ghi + (size_t)2816 * 512;
        { TrJob J = mk_job(P->in[I_MG] + (size_t)e * 1024 * DFE, DFE, 1024, 2816, 0, 2816, glo, 512); J.s1 = P->in[I_MU2] + (size_t)e * 1024 * DFE; J.mode = 2; J.dhi = ghi; J.ksplit = 512; tr_job(F, J); }
        { TrJob J = mk_job(P->in[I_MD] + (size_t)e * DFE * 1024, 1024, DFE, 1024, 0, 1024, wd, DFE); tr_job(F, J); }
    }
}

__device__ __forceinline__ void norm_pass(const Ctx& F, int layer, int which, const float* hl, const float* hcx, int nrows, bf16_t* xlo, bf16_t* xhi) {
    PP P = getpp();
    const float* gain = P->in[which ? I_NFFN : I_NMIX] + layer * 1024;
    const float* mod = (const float*)(P->ws + WS_MOD) + (size_t)layer * 9 * 6144 + (which ? 3072 : 0);
    const int rpw = (nrows + NGW(F) - 1) / NGW(F); const int r0 = GW(F) * rpw; const int r1 = (r0 + rpw < nrows) ? r0 + rpw : nrows;
    int vprev = -1; f32x4 gs[4], sh4[4];
    constexpr int NB = 4;
    for (int rb = r0; rb < r1; rb += NB) {
        f32x4 x[NB][4]; float ss[NB];
#pragma unroll
        for (int b = 0; b < NB; ++b) { const int row = (rb + b < r1) ? rb + b : r1 - 1;
            const float* src = row < RL ? hl + (size_t)row * 1024 : hcx + (size_t)(row - RL) * 1024; ss[b] = 0.f;
#pragma unroll
            for (int j = 0; j < 4; ++j) { x[b][j] = *(const f32x4*)(src + 4 * F.lane + 256 * j); ss[b] += x[b][j].x * x[b][j].x + x[b][j].y * x[b][j].y + x[b][j].z * x[b][j].z + x[b][j].w * x[b][j].w; } }
#pragma unroll
        for (int b = 0; b < NB; ++b) ss[b] = wave_sum(ss[b], F.lane);
#pragma unroll
        for (int b = 0; b < NB; ++b) { const int row = (rb + b < r1) ? rb + b : r1 - 1;
            const int v = row < RL ? (row >> 12) : 8;
            if (v != vprev) { const float* sh = mod + v * 6144; const float* sc = sh + 1024;
#pragma unroll
                for (int j = 0; j < 4; ++j) { const int c = 4 * F.lane + 256 * j; gs[j] = *(const f32x4*)(gain + c) * (*(const f32x4*)(sc + c) + 1.0f); sh4[j] = *(const f32x4*)(sh + c); }
                vprev = v; }
            const float rstd = rsqrtf(ss[b] * (1.0f / 1024.0f) + 1e-6f);
#pragma unroll
            for (int j = 0; j < 4; ++j) { const int c = 4 * F.lane + 256 * j;
                const f32x4 y = x[b][j] * rstd * gs[j] + sh4[j];
                u32x2 o; o.x = pk2(y.x, y.y); o.y = pk2(y.z, y.w);
                bf16_t* d = (c < 512) ? xlo + (size_t)row * 512 + c : xhi + (size_t)row * 512 + (c - 512);
                *(u32x2*)d = o; } }
    }
}

struct SchedSplit2 {
    const char *Alo, *Ahi, *Blo, *Bhi; int nM, nN, G, c;
    __device__ __forceinline__ bool next(int i, Seg& s) const {
        const int iu = i >> 1, h = i & 1; const long L = (long)iu * G + c; if (L >= (long)nM * nN) return false;
        int pm, pn; pg8::tile_order((int)L, nM, nN, pm, pn);
        s.A = (h ? Ahi : Alo) + (size_t)pm * 256 * 1024; s.B = (h ? Bhi : Blo) + (size_t)pn * 256 * 1024; s.nt = 8; s.pm = pm; s.pn = pn; s.aux = 0; s.first = (h == 0); s.last = (h == 1); return true;
    }
};
struct Sched1 {
    const char *A, *B; size_t astride, bstride; int nt, nM, nN, G, c;
    __device__ __forceinline__ bool next(int i, Seg& s) const {
        const long L = (long)i * G + c; if (L >= (long)nM * nN) return false;
        int pm, pn; pg8::tile_order((int)L, nM, nN, pm, pn);
        s.A = A + (size_t)pm * astride; s.B = B + (size_t)pn * bstride; s.nt = nt; s.pm = pm; s.pn = pn; s.aux = 0; s.first = true; s.last = true; return true;
    }
};
struct SchedHalf {
    const char *A, *B; size_t astride, bstride; int nt, nN, half, G, c;
    __device__ __forceinline__ bool next(int i, Seg& s) const {
        const long L = (long)i * G + c; if (L >= (long)68 * nN) return false;
        int mi, pn; pg8::tile_order((int)L, 68, nN, mi, pn);
        const int pm = mi < 64 ? 64 * half + mi : 128 + 4 * half + (mi - 64);
        s.A = A + (size_t)pm * astride; s.B = B + (size_t)pn * bstride; s.nt = nt; s.pm = pm; s.pn = pn; s.aux = 0; s.first = true; s.last = true; return true;
    }
};
struct SchedMerge {
    const char *XNlo, *XNhi, *WgLo, *WgHi, *wsb, *Wb; int nM, G, c; bool ctx3;
    __device__ __forceinline__ void fill(Seg& s, int pm, int pn, int n, int k, int ctxbit) const {
        s.pm = pm; s.pn = pn; s.nt = 8;
        if (k == 0) { s.A = XNlo + (size_t)pm * 256 * 1024; s.B = WgLo + (size_t)(n * 1024 + pn * 256) * 1024; s.first = true; s.last = false; s.aux = n * 2; }
        else if (k == 1) { s.A = XNhi + (size_t)pm * 256 * 1024; s.B = WgHi + (size_t)(n * 1024 + pn * 256) * 1024; s.first = false; s.last = true; s.aux = n * 2; }
        else { const size_t yo = (n == 0) ? D_YRWKV : ((n == 1) ? D_YRET : D_YMLA); s.A = wsb + yo + (size_t)pm * 256 * 1024; s.B = Wb + (size_t)(n * 1024 + pn * 256) * 1024; s.first = true; s.last = true; s.aux = n * 2 + 1 + ctxbit; }
    }
    __device__ __forceinline__ bool next(int i, Seg& s) const {
        const int nMl = ctx3 ? RL / 256 : nM; const int NL = nMl * 4;
        const int kmax = (NL - c + G - 1) / G;
        if (i < 9 * kmax) { const int su = i / 9, r = i % 9; const long L = (long)su * G + c; int pm, pn; pg8::tile_order((int)L, nMl, 4, pm, pn); fill(s, pm, pn, r / 3, r % 3, 0); return true; }
        if (!ctx3) return false;
        const int j = i - 9 * kmax, t = j / 3, k = j % 3; const long idx = (long)t * G + c; if (idx >= 96) return false;
        const int tile = (int)idx / 3, n = (int)idx % 3; fill(s, RL / 256 + (tile & 7), tile >> 3, n, k, 8); return true;
    }
};
struct SchedWout0 {
    const char *A, *B, *wsb; int G, c;
    __device__ __forceinline__ bool next(int i, Seg& s) const {
        if (c < 32) { if (i >= 3) return false; const int pmc = c & 7, pn = c >> 3;
            const size_t ao = (i == 0) ? D_M + (size_t)RL * 1024 * 2 : ((i == 1) ? D_P12 : D_P12 + (size_t)RC * 1024 * 2);
            s.A = wsb + ao + (size_t)pmc * 256 * 1024 * 2; s.B = B + (size_t)pn * 256 * 1024 * 2; s.nt = 16; s.pm = RL / 256 + pmc; s.pn = pn; s.aux = 0; s.first = (i == 0); s.last = (i == 2); return true; }
        const long L = (long)i * (G - 32) + (c - 32); if (L >= (RL / 256) * 4) return false;
        int pm, pn; pg8::tile_order((int)L, RL / 256, 4, pm, pn);
        s.A = A + (size_t)pm * 256 * 1024 * 2; s.B = B + (size_t)pn * 256 * 1024 * 2; s.nt = 16; s.pm = pm; s.pn = pn; s.aux = 0; s.first = true; s.last = true; return true;
    }
};
struct MoeTiles { int tstart[NEXP + 1]; };
__device__ __forceinline__ MoeTiles moe_tiles(const unsigned* cnt) {
    MoeTiles T; int a = 0;
#pragma unroll
    for (int e = 0; e < NEXP; ++e) { T.tstart[e] = a; a += (int)((__builtin_amdgcn_readfirstlane(cnt[e]) + 255u) >> 8); }
    T.tstart[NEXP] = a; return T;
}
__device__ __forceinline__ int moe_expert_of(const MoeTiles& T, int mt) { int e = 0;
#pragma unroll
    for (int k = 1; k < NEXP; ++k) e += (mt >= T.tstart[k]) ? 1 : 0;
    return e; }
struct SchedMoeUp {
    const char *Alo, *Ahi, *W; MoeTiles T; int G, c;
    __device__ __forceinline__ bool next(int i, Seg& s) const {
        const int iu = i >> 1, h = i & 1; const int nM = T.tstart[NEXP]; const long L = (long)iu * G + c; if (L >= (long)nM * 11) return false;
        int pm, pn; pg8::tile_order((int)L, nM, 11, pm, pn);
        const int e = moe_expert_of(T, pm); const char* we = W + (size_t)e * (33 * MiB / 4);
        s.A = (h ? Ahi : Alo) + (size_t)pm * 256 * 1024; s.B = we + (h ? (size_t)2816 * 1024 : 0) + (size_t)pn * 256 * 1024; s.nt = 8; s.pm = pm; s.pn = pn; s.aux = e; s.first = (h == 0); s.last = (h == 1); return true;
    }
};
struct SchedMoeDown {
    const char *A, *W; MoeTiles T; int G, c;
    __device__ __forceinline__ bool next(int i, Seg& s) const {
        const int nM = T.tstart[NEXP]; const long L = (long)i * G + c; if (L >= (long)nM * 4) return false;
        int pm, pn; pg8::tile_order((int)L, nM, 4, pm, pn);
        const int e = moe_expert_of(T, pm); const char* we = W + (size_t)e * (33 * MiB / 4) + (size_t)2 * 2816 * 1024;
        s.A = A + (size_t)pm * 256 * DFE * 2; s.B = we + (size_t)pn * 256 * DFE * 2; s.nt = 22; s.pm = pm; s.pn = pn; s.aux = e; s.first = true; s.last = true; return true;
    }
};

typedef f32x4 Acc[2][2][4][2];
struct EpiInproj {
    unsigned char* ws;
    __device__ __forceinline__ void operator()(const Acc& acc, const Seg& u, int wr, int wc, int fr, int fq) const {
        const int row0 = u.pm * 256 + wr * 64 + fr;
#pragma unroll
        for (int bj = 0; bj < 2; ++bj) {
            const int c0 = u.pn * 256 + bj * 128 + wc * 32 + 8 * fq;
            const bool a = c0 < RWC, b = c0 < RWC + REC;
            const size_t boff = a ? D_URWKV : (b ? D_URET : D_UMLA); const int pitch = a ? RWC : (b ? REC : MLC); const int col = c0 - (a ? 0 : (b ? RWC : RWC + REC));
            bf16_t* base = (bf16_t*)(ws + boff);
            if (c0 < MIXC) {
#pragma unroll
                for (int ai = 0; ai < 2; ++ai)
#pragma unroll
                    for (int m = 0; m < 4; ++m) { const int row = row0 + ai * 128 + m * 16; const f32x4 v0 = acc[ai][bj][m][0], v1 = acc[ai][bj][m][1];
                        u32x4 w; w.x = pk2(v0[0], v0[1]); w.y = pk2(v0[2], v0[3]); w.z = pk2(v1[0], v1[1]); w.w = pk2(v1[2], v1[3]);
                        *(u32x4*)(base + (size_t)row * pitch + col) = w; }
            }
        }
    }
};
struct EpiQup {
    bf16_t* Q; const float* rstd; const float* cosm; const float* sinm; int compact;
    __device__ __forceinline__ void operator()(const Acc& acc, const Seg& u, int wr, int wc, int fr, int fq) const {
        const int row0 = u.pm * 256 + wr * 64 + fr;
#pragma unroll
        for (int ai = 0; ai < 2; ++ai)
#pragma unroll
            for (int m = 0; m < 4; ++m) { const int row = row0 + ai * 128 + m * 16; const float rs = rstd[row]; const bool lat = row < RL; const int t = row & 4095;
#pragma unroll
                for (int bj = 0; bj < 2; ++bj) { const int cb = u.pn * 256 + bj * 128 + wc * 32; const bool rope = lat && ((cb % 96) == 64);
                    f32x4 x1 = acc[ai][bj][m][0] * rs, x2 = acc[ai][bj][m][1] * rs;
                    if (rope) { const f32x4 cs = *(const f32x4*)(cosm + t * 16 + 4 * fq), sn = *(const f32x4*)(sinm + t * 16 + 4 * fq);
                        const f32x4 o1 = x1 * cs - x2 * sn, o2 = x1 * sn + x2 * cs; x1 = o1; x2 = o2; }
                    u32x2 a, b; a.x = pk2(x1[0], x1[1]); a.y = pk2(x1[2], x1[3]); b.x = pk2(x2[0], x2[1]); b.y = pk2(x2[2], x2[3]);
                    const int orow = compact ? (lat ? row : row - RL + 4 * SEQ) : row;
                    bf16_t* d = Q + (size_t)orow * 768 + cb + 4 * fq; *(u32x2*)d = a; *(u32x2*)(d + 16) = b; } }
    }
};
struct EpiKVup {
    bf16_t *Kb, *Vb; const float* rstd; int compact;
    __device__ __forceinline__ void operator()(const Acc& acc, const Seg& u, int wr, int wc, int fr, int fq) const {
        const int row0 = u.pm * 256 + wr * 64 + fr;
#pragma unroll
        for (int ai = 0; ai < 2; ++ai)
#pragma unroll
            for (int m = 0; m < 4; ++m) { const int row = row0 + ai * 128 + m * 16; const float rs = rstd[row];
#pragma unroll
                for (int bj = 0; bj < 2; ++bj) { const int c0 = u.pn * 256 + bj * 128 + wc * 32 + 8 * fq; const f32x4 v0 = acc[ai][bj][m][0] * rs, v1 = acc[ai][bj][m][1] * rs;
                    u32x4 w; w.x = pk2(v0[0], v0[1]); w.y = pk2(v0[2], v0[3]); w.z = pk2(v1[0], v1[1]); w.w = pk2(v1[2], v1[3]);
                    const int orow = compact ? (row < RL ? row : row - RL + 4 * SEQ) : row;
                    bf16_t* d = (u.pn < 2) ? Kb + (size_t)orow * 544 + c0 : Vb + (size_t)orow * 512 + (c0 - 512);
                    *(u32x4*)d = w; } }
    }
};
struct EpiMerge {
    u32x4* scr; bf16_t* M; bf16_t* P12;
    __device__ __forceinline__ void operator()(const Acc& acc, const Seg& u, int wr, int wc, int fr, int fq) const {
        int tid = threadIdx.x; asm volatile("" : "+v"(tid));
        if ((u.aux & 1) == 0) {
#pragma unroll
            for (int ai = 0; ai < 2; ++ai)
#pragma unroll
                for (int bj = 0; bj < 2; ++bj)
#pragma unroll
                    for (int m = 0; m < 4; ++m) { const f32x4 v0 = acc[ai][bj][m][0], v1 = acc[ai][bj][m][1];
                        u32x4 w; w.x = pk2(sigmoidf_(v0[0]), sigmoidf_(v0[1])); w.y = pk2(sigmoidf_(v0[2]), sigmoidf_(v0[3])); w.z = pk2(sigmoidf_(v1[0]), sigmoidf_(v1[1])); w.w = pk2(sigmoidf_(v1[2]), sigmoidf_(v1[3]));
                        scr[((ai * 2 + bj) * 4 + m) * 512 + tid] = w; }
        } else {
            const int n = (u.aux & 7) >> 1; const bool part = (u.aux & 8) != 0; const int row0 = u.pm * 256 + wr * 64 + fr;
#pragma unroll
            for (int ai = 0; ai < 2; ++ai)
#pragma unroll
                for (int bj = 0; bj < 2; ++bj)
#pragma unroll
                    for (int m = 0; m < 4; ++m) { const int row = row0 + ai * 128 + m * 16; const int c0 = u.pn * 256 + bj * 128 + wc * 32 + 8 * fq;
                        const u32x4 g = scr[((ai * 2 + bj) * 4 + m) * 512 + tid]; float gf[8], pf[8]; unpack8(g, gf);
                        const f32x4 v0 = acc[ai][bj][m][0], v1 = acc[ai][bj][m][1];
                        bf16_t* d = (part && n > 0) ? P12 + (size_t)(n - 1) * RC * 1024 + (size_t)(row - RL) * 1024 + c0 : M + (size_t)row * 1024 + c0;
                        if (n > 0 && !part) { const u32x4 pv = *(const u32x4*)d; unpack8(pv, pf); } else {
#pragma unroll
                            for (int j = 0; j < 8; ++j) pf[j] = 0.f; }
#pragma unroll
                        for (int j = 0; j < 4; ++j) { pf[j] += gf[j] * v0[j]; pf[4 + j] += gf[4 + j] * v1[j]; }
                        *(u32x4*)d = pack8(pf); }
        }
    }
};
struct EpiResid {
    const float *srcl, *srcc; float *dstl, *dstc; const float* mod; int goff;
    __device__ __forceinline__ void operator()(const Acc& acc, const Seg& u, int wr, int wc, int fr, int fq) const {
        const int row0 = u.pm * 256 + wr * 64 + fr;
#pragma unroll
        for (int ai = 0; ai < 2; ++ai)
#pragma unroll
            for (int m = 0; m < 4; ++m) { const int row = row0 + ai * 128 + m * 16; const bool lat = row < RL;
                const size_t ro = lat ? (size_t)row * 1024 : (size_t)(row - RL) * 1024; const float* s = (lat ? srcl : srcc) + ro; float* d = (lat ? dstl : dstc) + ro;
                const float* g = mod + (lat ? (row >> 12) : 8) * 6144 + goff;
#pragma unroll
                for (int bj = 0; bj < 2; ++bj)
#pragma unroll
                    for (int n = 0; n < 2; ++n) { const int c = u.pn * 256 + bj * 128 + wc * 32 + 16 * n + 4 * fq;
                        const f32x4 sv = *(const f32x4*)(s + c), gv = *(const f32x4*)(g + c); *(f32x4*)(d + c) = sv + gv * acc[ai][bj][m][n]; } }
    }
};
struct EpiSwiglu {
    bf16_t* H; int pitch;
    __device__ __forceinline__ void operator()(const Acc& acc, const Seg& u, int wr, int wc, int fr, int fq) const {
        const int row0 = u.pm * 256 + wr * 64 + fr; const int c0 = u.pn * 128 + wc * 32 + 8 * fq;
#pragma unroll
        for (int ai = 0; ai < 2; ++ai)
#pragma unroll
            for (int m = 0; m < 4; ++m) { const int row = row0 + ai * 128 + m * 16; float o[8];
#pragma unroll
                for (int n = 0; n < 2; ++n)
#pragma unroll
                    for (int j = 0; j < 4; ++j) o[4 * n + j] = siluf_(acc[ai][0][m][n][j]) * acc[ai][1][m][n][j];
                *(u32x4*)(H + (size_t)row * pitch + c0) = pack8(o); }
    }
};
struct EpiBf16 {
    bf16_t* O; int pitch;
    __device__ __forceinline__ void operator()(const Acc& acc, const Seg& u, int wr, int wc, int fr, int fq) const {
        const int row0 = u.pm * 256 + wr * 64 + fr;
#pragma unroll
        for (int ai = 0; ai < 2; ++ai)
#pragma unroll
            for (int m = 0; m < 4; ++m) { const int row = row0 + ai * 128 + m * 16;
#pragma unroll
                for (int bj = 0; bj < 2; ++bj) { const int c0 = u.pn * 256 + bj * 128 + wc * 32 + 8 * fq; const f32x4 v0 = acc[ai][bj][m][0], v1 = acc[ai][bj][m][1];
                    u32x4 w; w.x = pk2(v0[0], v0[1]); w.y = pk2(v0[2], v0[3]); w.z = pk2(v1[0], v1[1]); w.w = pk2(v1[2], v1[3]);
                    *(u32x4*)(O + (size_t)row * pitch + c0) = w; } }
    }
};

namespace attn {
constexpr float SCALE = 0.10206207261596577f;
constexpr float THR = 8.f;
constexpr int KP = 208;
constexpr int SHM_V = 8192, SHM_K = 64 * KP;
constexpr int OFF_V = 0, OFF_K = 2 * SHM_V, OFF_WS = OFF_K + 2 * SHM_K, SHM_TOTAL = OFF_WS + 8 * 64 * 4;
#define SBAR() __builtin_amdgcn_sched_barrier(0)
__device__ __forceinline__ int crow(int r, int hi) { return (r & 3) + 8 * (r >> 2) + 4 * hi; }
__device__ __forceinline__ unsigned cvtpk(float lo, float hi) { unsigned r; asm volatile("v_cvt_pk_bf16_f32 %0, %1, %2" : "=v"(r) : "v"(lo), "v"(hi)); return r; }
__device__ __forceinline__ void partialSM(f32x16& p0, f32x16& p1, float& m_reg, float& mn, float& alpha) {
    constexpr float C = SCALE * 1.4426950408889634f;
    float pmax = p0[0];
#pragma unroll
    for (int r = 1; r < 16; ++r) pmax = fmaxf(pmax, p0[r]);
#pragma unroll
    for (int r = 0; r < 16; ++r) pmax = fmaxf(pmax, p1[r]);
    { auto rr = __builtin_amdgcn_permlane32_swap(__float_as_uint(pmax), __float_as_uint(pmax), false, false); pmax = fmaxf(__uint_as_float(rr[0]), __uint_as_float(rr[1])); }
    if (__builtin_expect(__all(pmax - m_reg <= THR / SCALE), 1)) { mn = m_reg; alpha = 1.f; }
    else { mn = fmaxf(m_reg, pmax); alpha = __builtin_amdgcn_exp2f((m_reg - mn) * C); m_reg = mn; }
    const float mnC = -mn * C;
#pragma unroll
    for (int r = 0; r < 16; ++r) p0[r] = fmaf(p0[r], C, mnC);
#pragma unroll
    for (int r = 0; r < 16; ++r) p1[r] = fmaf(p1[r], C, mnC);
#pragma unroll
    for (int r = 0; r < 16; ++r) p0[r] = __builtin_amdgcn_exp2f(p0[r]);
}
__device__ __forceinline__ void finishSM(f32x16& p0, f32x16& p1, float alpha, float& l_reg, bf16x8& pa0, bf16x8& pa1, bf16x8& pa2, bf16x8& pa3) {
#pragma unroll
    for (int r = 0; r < 16; ++r) p1[r] = __builtin_amdgcn_exp2f(p1[r]);
    float ps = 0;
#pragma unroll
    for (int r = 0; r < 16; ++r) ps += p0[r];
#pragma unroll
    for (int r = 0; r < 16; ++r) ps += p1[r];
    { auto rr = __builtin_amdgcn_permlane32_swap(__float_as_uint(ps), __float_as_uint(ps), false, false); ps = __uint_as_float(rr[0]) + __uint_as_float(rr[1]); }
    l_reg = l_reg * alpha + ps;
#define PK4(P, BASE, OUT) do { unsigned a0 = cvtpk(P[BASE + 0], P[BASE + 1]), a1 = cvtpk(P[BASE + 2], P[BASE + 3]);   \
    unsigned b0 = cvtpk(P[BASE + 4], P[BASE + 5]), b1 = cvtpk(P[BASE + 6], P[BASE + 7]);                              \
    auto r0 = __builtin_amdgcn_permlane32_swap(a0, b0, false, false); auto r1 = __builtin_amdgcn_permlane32_swap(a1, b1, false, false); \
    u32x4 w = {r0[0], r1[0], r0[1], r1[1]}; OUT = __builtin_bit_cast(bf16x8, w); } while (0)
    PK4(p0, 0, pa0); PK4(p0, 8, pa1); PK4(p1, 0, pa2); PK4(p1, 8, pa3);
#undef PK4
}
__device__ __forceinline__ void qkt(f32x16& p0, f32x16& p1, const LAS unsigned char* Ks, const bf16x8* qr, int r32, int hi) {
    p0 = f32x16{}; p1 = f32x16{};
#pragma unroll
    for (int d0 = 0; d0 < 6; ++d0) { const int cb = (d0 * 16 + hi * 8) * 2;
        const bf16x8 b0 = *(const LAS bf16x8*)(Ks + r32 * KP + cb);
        const bf16x8 b1 = *(const LAS bf16x8*)(Ks + (32 + r32) * KP + cb);
        p0 = __builtin_amdgcn_mfma_f32_32x32x16_bf16(b0, qr[d0], p0, 0, 0, 0);
        p1 = __builtin_amdgcn_mfma_f32_32x32x16_bf16(b1, qr[d0], p1, 0, 0, 0); }
}
__device__ __forceinline__ int v_st(int k, int c) { const int kk = (k & ~0xC) | ((k & 4) << 1) | ((k & 8) >> 1); return ((kk >> 3) * 2 + (c >> 5)) * 512 + ((kk & 7) * 32 + (c & 31)) * 2; }
__device__ __forceinline__ int v_rd_base(int lane) { return ((lane & 3) << 3) | (((lane >> 2) & 3) << 6) | (((lane >> 4) & 1) << 5) | (((lane >> 5) & 1) << 8); }
constexpr int v_rd_off(int d0, int ks, int half) { return d0 * 512 + ks * 2048 + half * 1024; }
template <int OFF> __device__ __forceinline__ s16x4 tr_read(int vb) { s16x4 r; asm volatile("ds_read_b64_tr_b16 %0, %1 offset:%2" : "=&v"(r) : "v"(vb), "i"(OFF) : "memory"); return r; }
template <int D0> __device__ __forceinline__ void pv_one(f32x16& od, int vb, bf16x8 pa0, bf16x8 pa1, bf16x8 pa2, bf16x8 pa3) {
    const s16x4 l0 = tr_read<v_rd_off(D0, 0, 0)>(vb), h0 = tr_read<v_rd_off(D0, 0, 1)>(vb), l1 = tr_read<v_rd_off(D0, 1, 0)>(vb), h1 = tr_read<v_rd_off(D0, 1, 1)>(vb);
    const s16x4 l2 = tr_read<v_rd_off(D0, 2, 0)>(vb), h2 = tr_read<v_rd_off(D0, 2, 1)>(vb), l3 = tr_read<v_rd_off(D0, 3, 0)>(vb), h3 = tr_read<v_rd_off(D0, 3, 1)>(vb);
    asm volatile("s_waitcnt lgkmcnt(0)" ::: "memory"); SBAR();
#define PK(L, H) (bf16x8){L[0], L[1], L[2], L[3], H[0], H[1], H[2], H[3]}
    od = __builtin_amdgcn_mfma_f32_32x32x16_bf16(pa0, PK(l0, h0), od, 0, 0, 0);
    od = __builtin_amdgcn_mfma_f32_32x32x16_bf16(pa1, PK(l1, h1), od, 0, 0, 0);
    od = __builtin_amdgcn_mfma_f32_32x32x16_bf16(pa2, PK(l2, h2), od, 0, 0, 0);
    od = __builtin_amdgcn_mfma_f32_32x32x16_bf16(pa3, PK(l3, h3), od, 0, 0, 0);
#undef PK
}
__device__ __forceinline__ void pv_d0(f32x16* o, int vb, bf16x8 pa0, bf16x8 pa1, bf16x8 pa2, bf16x8 pa3) { pv_one<0>(o[0], vb, pa0, pa1, pa2, pa3); pv_one<1>(o[1], vb, pa0, pa1, pa2, pa3); }

__device__ __forceinline__ void attn_unit(const bf16_t* __restrict__ Qb, const bf16_t* __restrict__ Kn, const bf16_t* __restrict__ Kr, const bf16_t* __restrict__ Vh,
                                          bf16_t* __restrict__ Ob, long lat0, long ctx0, int nlat, int NT, LAS unsigned char* lds) {
    int tid_ = threadIdx.x; asm volatile("" : "+v"(tid_));
    const int tid = tid_, wid = tid >> 6, lane = tid & 63, r32 = lane & 31, hi = lane >> 5;
    LAS unsigned char* V_lds = lds + OFF_V; LAS unsigned char* K_lds = lds + OFF_K;
    LAS float* ws = (LAS float*)(lds + OFF_WS) + wid * 64; LAS float* li_l = ws; LAS float* al_l = ws + 32;
    float m_reg = -1e30f, l_reg = 0; f32x16 o[2] = {}; bf16x8 qr[6];
    const bf16_t* Qw = Qb + (long)(wid * 32 + r32) * 768 + hi * 8;
#pragma unroll
    for (int d0 = 0; d0 < 6; ++d0) qr[d0] = *(const bf16x8*)(Qw + d0 * 16);
    const int sr = tid >> 3, sc = (tid & 7) * 8, vst = v_st(sr, sc);
    const int kr_ = (tid & 255) >> 2, kc_ = (tid & 3) * 8;
    const int vb0 = (int)(uintptr_t)V_lds + v_rd_base(lane);
    struct { bf16x8 vs, kn, kp; } sr_[2];
#define KROW(j, kk) (((j) < nlat) ? (lat0 + (long)(j) * 64 + (kk)) : (ctx0 + (long)((j) - nlat) * 64 + (kk)))
#define SLOAD(i, j) do { const long r0_ = KROW(j, sr), r1_ = KROW(j, kr_); sr_[i].vs = *(const bf16x8*)(Vh + r0_ * 512 + sc); sr_[i].kn = *(const bf16x8*)(Kn + r0_ * 544 + sc); sr_[i].kp = *(const bf16x8*)(Kr + r1_ * 544 + kc_); } while (0)
#define SWRITE(b, i) do { *(LAS bf16x8*)(V_lds + (b) * SHM_V + vst) = sr_[i].vs; *(LAS bf16x8*)(K_lds + (b) * SHM_K + sr * KP + sc * 2) = sr_[i].kn; \
    *(LAS bf16x8*)(K_lds + (b) * SHM_K + kr_ * KP + 128 + kc_ * 2) = sr_[i].kp; } while (0)
#define SWAIT() asm volatile("s_waitcnt vmcnt(3)" ::: "memory")
#define RESC(a) do { if (__any((a) < 1.f)) { if (hi == 0) al_l[r32] = (a); asm volatile("s_waitcnt lgkmcnt(0)" ::: "memory"); \
    _Pragma("unroll") for (int d = 0; d < 2; ++d) _Pragma("unroll") for (int r = 0; r < 16; ++r) o[d][r] *= al_l[crow(r, hi)]; } } while (0)
    f32x16 pA0, pA1, pB0, pB1; float mnA, mnB, alA, alB; bf16x8 pa0, pa1, pa2, pa3;
    constexpr int SE = 0, SO = 1;
    SLOAD(SE, 0); asm volatile("s_waitcnt vmcnt(0)" ::: "memory"); SWRITE(0, SE); __syncthreads();
    qkt(pA0, pA1, K_lds, qr, r32, hi); partialSM(pA0, pA1, m_reg, mnA, alA);
    SLOAD(SO, 1); if (2 < NT) SLOAD(SE, 2);
    SWAIT(); SWRITE(1, SO); __syncthreads();
    for (int j = 1; j + 1 < NT; j += 2) {
        SBAR(); qkt(pB0, pB1, K_lds + SHM_K, qr, r32, hi);
        finishSM(pA0, pA1, alA, l_reg, pa0, pa1, pa2, pa3); SBAR();
        SLOAD(SO, j + 2); SBAR();
        pv_d0(o, vb0, pa0, pa1, pa2, pa3); partialSM(pB0, pB1, m_reg, mnB, alB);
        __syncthreads(); SWAIT(); SWRITE(0, SE);
        RESC(alB); __syncthreads();
        SBAR(); qkt(pA0, pA1, K_lds, qr, r32, hi);
        finishSM(pB0, pB1, alB, l_reg, pa0, pa1, pa2, pa3); SBAR();
        if (j + 3 < NT) SLOAD(SE, j + 3); SBAR();
        pv_d0(o, vb0 + SHM_V, pa0, pa1, pa2, pa3); partialSM(pA0, pA1, m_reg, mnA, alA);
        __syncthreads(); SWAIT(); SWRITE(1, SO);
        RESC(alA); __syncthreads();
    }
    SBAR(); qkt(pB0, pB1, K_lds + SHM_K, qr, r32, hi);
    finishSM(pA0, pA1, alA, l_reg, pa0, pa1, pa2, pa3); SBAR();
    pv_d0(o, vb0, pa0, pa1, pa2, pa3); partialSM(pB0, pB1, m_reg, mnB, alB);
    __syncthreads(); RESC(alB);
    finishSM(pB0, pB1, alB, l_reg, pa0, pa1, pa2, pa3); SBAR();
    pv_d0(o, vb0 + SHM_V, pa0, pa1, pa2, pa3);
    if (hi == 0) li_l[r32] = l_reg; asm volatile("s_waitcnt lgkmcnt(0)" ::: "memory");
    float rli[16];
#pragma unroll
    for (int r = 0; r < 16; ++r) rli[r] = __builtin_amdgcn_rcpf(li_l[crow(r, hi)]);
    bf16_t* Ow = Ob + (long)(wid * 32) * 512;
#pragma unroll
    for (int r = 0; r < 16; ++r) { const int orow = crow(r, hi);
#pragma unroll
        for (int d0 = 0; d0 < 2; ++d0) Ow[(long)orow * 512 + d0 * 32 + r32] = (bf16_t)f2bf(o[d0][r] * rli[r]); }
    __syncthreads();
#undef KROW
#undef SLOAD
#undef SWRITE
#undef SWAIT
#undef RESC
}
#undef SBAR
}

__device__ __forceinline__ void attn_latent_unit(const Ctx& F, unsigned char* ws, unsigned char* ha, int b, int h, int qb) {
    bf16_t* Y = (bf16_t*)(ws + D_YMLA); const long q0 = (long)b * SEQ + qb * 256;
    if (b < 4) { const bf16_t* Q = (const bf16_t*)(ha + HA_Q); const bf16_t* K = (const bf16_t*)(ha + HA_K); const bf16_t* V = (const bf16_t*)(ha + HA_V);
        attn::attn_unit(Q + q0 * 768 + h * 96, K + h * 64, K + 512, V + h * 64, Y + q0 * 512 + h * 64, (long)b * SEQ, (long)4 * SEQ + b * CTXL, 64, 68, F.lds); }
    else { const bf16_t* Q = (const bf16_t*)(ws + D_Q); const bf16_t* K = (const bf16_t*)(ws + D_K); const bf16_t* V = (const bf16_t*)(ws + D_V);
        attn::attn_unit(Q + q0 * 768 + h * 96, K + h * 64, K + 512, V + h * 64, Y + q0 * 512 + h * 64, (long)b * SEQ, (long)RL + b * CTXL, 64, 68, F.lds); }
}
__device__ __forceinline__ void attn_phase(const Ctx& F, int layer) {
    unsigned char* ws = getpp()->ws; unsigned char* ha = half_a_base(layer); const bool with_ctx_q = (layer == 0);
    const int vcu = (F.G % 8 == 0) ? (F.bid % 8) * (F.G / 8) + F.bid / 8 : F.bid;
    const int nlat_units = 4 * 8 * 16, nunits = nlat_units + (with_ctx_q ? NBATCH * 8 : 0);
    for (int u = vcu; u < nunits; u += F.G) {
        if (u < nlat_units) { const int bh = u >> 4, qb = u & 15; attn_latent_unit(F, ws, ha, 4 + (bh >> 3), bh & 7, qb); }
        else { const int bh = u - nlat_units, b = bh >> 3, h = bh & 7; bf16_t* Y = (bf16_t*)(ws + D_YMLA); const long yrow = (long)RL + b * CTXL;
            if (b < 4) { const bf16_t* Q = (const bf16_t*)(ha + HA_Q); const bf16_t* K = (const bf16_t*)(ha + HA_K); const bf16_t* V = (const bf16_t*)(ha + HA_V); const long q0 = (long)4 * SEQ + b * CTXL;
                attn::attn_unit(Q + q0 * 768 + h * 96, K + h * 64, K + 512, V + h * 64, Y + yrow * 512 + h * 64, 0, q0, 0, 4, F.lds); }
            else { const bf16_t* Q = (const bf16_t*)(ws + D_Q); const bf16_t* K = (const bf16_t*)(ws + D_K); const bf16_t* V = (const bf16_t*)(ws + D_V);
                attn::attn_unit(Q + yrow * 768 + h * 96, K + h * 64, K + 512, V + h * 64, Y + yrow * 512 + h * 64, 0, yrow, 0, 4, F.lds); } }
    }
}

__device__ __forceinline__ void load8_shift(const bf16_t* u, long row, int t, int T, int col, const float* mu, float* out) {
    float x[8], p[8], n[8];
    const bool hp = t > 0, hn = t < T - 1;
    const u32x4 wx = *(const u32x4*)(u + row * RWC + col), wp = *(const u32x4*)(u + (row - (hp ? 1 : 0)) * RWC + col), wn = *(const u32x4*)(u + (row + (hn ? 1 : 0)) * RWC + col);
    unpack8(wx, x); unpack8(wp, p); unpack8(wn, n);
    const float mp = hp ? 0.5f : 0.f, mn = hn ? 0.5f : 0.f;
    const f32x4 m0 = *(const f32x4*)(mu + col), m1 = *(const f32x4*)(mu + col + 4);
#pragma unroll
    for (int j = 0; j < 8; ++j) out[j] = x[j] + (j < 4 ? m0[j & 3] : m1[j & 3]) * (mp * p[j] + mn * n[j] - x[j]);
}
__device__ __forceinline__ void load8_shift_l(const bf16_t* u, long row, int t, int T, int col, const LAS float* mu8, float* out) {
    float x[8], p[8], n[8];
    const bool hp = t > 0, hn = t < T - 1;
    const u32x4 wx = *(const u32x4*)(u + row * RWC + col), wp = *(const u32x4*)(u + (row - (hp ? 1 : 0)) * RWC + col), wn = *(const u32x4*)(u + (row + (hn ? 1 : 0)) * RWC + col);
    unpack8(wx, x); unpack8(wp, p); unpack8(wn, n);
    const float mp = hp ? 0.5f : 0.f, mn = hn ? 0.5f : 0.f;
    const f32x4 m0 = *(const LAS f32x4*)(mu8), m1 = *(const LAS f32x4*)(mu8 + 4);
#pragma unroll
    for (int j = 0; j < 8; ++j) out[j] = x[j] + (j < 4 ? m0[j & 3] : m1[j & 3]) * (mp * p[j] + mn * n[j] - x[j]);
}
namespace rw2 {
constexpr int PT = 72;
constexpr int O_W2T = 0, O_A2T = 9216, O_ZL = 18432, O_AL = 34816, O_XWD = 51200, O_XAD = 60416, O_RING = 18432;
constexpr int O_TA = 69632, O_TB = O_TA + 9216, O_TK = O_TB + 9216, O_TR = O_TK + 9216, O_OUT = 69632;
constexpr int O_BH = 106496, O_KH = O_BH + 9216, O_V = O_KH + 9216, O_TOT = 134144, O_PL = 136192, O_PRM = 137216;
__device__ __forceinline__ s16x4 cv4(f32x4 v) { u32x2 w; w.x = pk2(v[0], v[1]); w.y = pk2(v[2], v[3]); return __builtin_bit_cast(s16x4, w); }
__device__ __forceinline__ f32x4 mm16(s16x4 a, s16x4 b, f32x4 c) { return __builtin_amdgcn_mfma_f32_16x16x16bf16_1k(a, b, c, 0, 0, 0); }
__device__ __forceinline__ f32x4 mm32(bf16x8 a, bf16x8 b, f32x4 c) { return __builtin_amdgcn_mfma_f32_16x16x32_bf16(a, b, c, 0, 0, 0); }
__device__ __forceinline__ f32x4 bf4_to_f(s16x4 s) { const u32x2 w = __builtin_bit_cast(u32x2, s); return (f32x4){bflo(w.x), bfhi(w.x), bflo(w.y), bfhi(w.y)}; }
typedef short v4i16_t __attribute__((ext_vector_type(4)));
__device__ __forceinline__ s16x4 trd(const LAS bf16_t* base, int row0, int col0, int lane) {
    const int g = lane >> 4, i = lane & 15, q = i >> 2, p = i & 3;
    return __builtin_bit_cast(s16x4, __builtin_amdgcn_ds_read_tr16_b64_v4i16((LAS v4i16_t*)(base + (row0 + 4 * g + q) * PT + col0 + 4 * p)));
}
__device__ __forceinline__ float fast_tanh(float x) { return 1.0f - 2.0f * __builtin_amdgcn_rcpf(__builtin_amdgcn_exp2f(2.8853900817779268f * x) + 1.0f); }
}
__device__ __forceinline__ void rwkv_chain2(const Ctx& F, int layer, int b, int h, int d) {
    using namespace rw2;
    PP P = getpp(); unsigned char* ws = P->ws;
    const bf16_t* u = (const bf16_t*)(ws + D_URWKV);
    bf16_t* od = (bf16_t*)(ws + (d ? D_OB : D_OF));
    float* bsc = (float*)(ws + WS_BSC) + (size_t)d * RT * 8;
    LAS unsigned char* L = F.lds;
    LAS bf16_t* w2t = (LAS bf16_t*)(L + O_W2T); LAS bf16_t* a2t = (LAS bf16_t*)(L + O_A2T);
    LAS float* Zl = (LAS float*)(L + O_ZL); LAS float* Al = (LAS float*)(L + O_AL);
    LAS bf16_t* Xwd = (LAS bf16_t*)(L + O_XWD); LAS bf16_t* Xad = (LAS bf16_t*)(L + O_XAD);
    LAS bf16_t* TA = (LAS bf16_t*)(L + O_TA); LAS bf16_t* TB = (LAS bf16_t*)(L + O_TB); LAS bf16_t* TK = (LAS bf16_t*)(L + O_TK); LAS bf16_t* TR = (LAS bf16_t*)(L + O_TR);
    LAS bf16_t* BH = (LAS bf16_t*)(L + O_BH); LAS bf16_t* KH = (LAS bf16_t*)(L + O_KH); LAS bf16_t* Vm = (LAS bf16_t*)(L + O_V);
    LAS float* tot = (LAS float*)(L + O_TOT); LAS float* pLs = (LAS float*)(L + O_PL); LAS float* Out = (LAS float*)(L + O_OUT);
    LAS float* prm = (LAS float*)(L + O_PRM);
    const int tid0 = F.tid, w = F.wave;
    {
        const int tid = tid0;
        const float* mu = P->in[I_MU] + layer * RWC;
        const float* w0 = P->in[I_W0] + (layer * 2 + d) * 512 + h * 64;
        const float* w2 = P->in[I_W2] + (size_t)(layer * 2 + d) * 64 * 512 + h * 64;
        const float* a0 = P->in[I_A0] + (layer * 2 + d) * 512 + h * 64;
        const float* a2 = P->in[I_A2] + (size_t)(layer * 2 + d) * 64 * 512 + h * 64;
        const float* k_k = P->in[I_KK] + layer * 512 + h * 64; const float* k_a = P->in[I_KA] + layer * 512 + h * 64; const float* r_k = P->in[I_RK] + layer * 512 + h * 64;
        for (int i = tid; i < 640; i += NTHREADS) { const int rr = i >> 6, cc = i & 63; float v;
            if (rr == 0) v = mu[h * 64 + cc]; else if (rr == 1) v = mu[512 + h * 64 + cc]; else if (rr == 2) v = mu[1024 + h * 64 + cc]; else if (rr == 3) v = mu[1536 + d * 64 + cc]; else if (rr == 4) v = mu[1664 + d * 64 + cc];
            else if (rr == 5) v = w0[cc]; else if (rr == 6) v = a0[cc]; else if (rr == 7) v = k_k[cc]; else if (rr == 8) v = k_a[cc]; else v = r_k[cc];
            prm[i] = v; }
        for (int i = tid; i < 4096; i += NTHREADS) { const int k = i >> 6, cc = i & 63; w2t[cc * PT + k] = (bf16_t)f2bf(w2[(size_t)k * 512 + cc]); a2t[cc * PT + k] = (bf16_t)f2bf(a2[(size_t)k * 512 + cc]); }
    }
    f32x4 Z[4];
#pragma unroll
    for (int j = 0; j < 4; ++j) Z[j] = (f32x4){0.f, 0.f, 0.f, 0.f};
    __syncthreads();
    for (int seq = 0; seq < 2; ++seq) {
        const int T = seq ? SEQ : CTXL; const long rbase = seq ? (long)b * SEQ : (long)RL + b * CTXL; const int nch = T / 64;
        for (int ci = 0; ci < nch; ++ci) {
            int tid = tid0; asm volatile("" : "+v"(tid));
            const int lane = tid & 63, fr = lane & 15, fq = lane >> 4, tt = tid >> 3, c8 = (tid & 7) * 8;
            const int tpos = d ? (T - 1 - (ci * 64 + tt)) : (ci * 64 + tt); const long row = rbase + tpos;
            float r[8], k[8], kk[8], av[8], kd[8], lw[8];
            {
                float v[8], x[8];
                load8_shift_l(u, row, tpos, T, h * 64 + c8, prm + c8, r);
                load8_shift_l(u, row, tpos, T, 512 + h * 64 + c8, prm + 64 + c8, k);
                load8_shift_l(u, row, tpos, T, 1024 + h * 64 + c8, prm + 128 + c8, v);
                *(LAS u32x4*)(Vm + tt * PT + c8) = pack8(v);
                load8_shift_l(u, row, tpos, T, 1536 + d * 64 + c8, prm + 192 + c8, x);
#pragma unroll
                for (int e = 0; e < 8; ++e) x[e] = fast_tanh(x[e]);
                *(LAS u32x4*)(Xwd + tt * PT + c8) = pack8(x);
                load8_shift_l(u, row, tpos, T, 1664 + d * 64 + c8, prm + 256 + c8, x);
                *(LAS u32x4*)(Xad + tt * PT + c8) = pack8(x);
            }
            __syncthreads();
            {
#pragma unroll
                for (int q = 0; q < 2; ++q) { const int id = 2 * w + q, tm = id >> 2, tn = id & 3;
                    f32x4 az = {0.f, 0.f, 0.f, 0.f}, aa = {0.f, 0.f, 0.f, 0.f};
#pragma unroll
                    for (int ks = 0; ks < 2; ++ks) {
                        az = mm32(*(const LAS bf16x8*)(Xwd + (16 * tm + fr) * PT + ks * 32 + fq * 8), *(const LAS bf16x8*)(w2t + (16 * tn + fr) * PT + ks * 32 + fq * 8), az);
                        aa = mm32(*(const LAS bf16x8*)(Xad + (16 * tm + fr) * PT + ks * 32 + fq * 8), *(const LAS bf16x8*)(a2t + (16 * tn + fr) * PT + ks * 32 + fq * 8), aa); }
#pragma unroll
                    for (int e = 0; e < 4; ++e) { Zl[(16 * tm + 4 * fq + e) * 64 + 16 * tn + fr] = az[e]; Al[(16 * tm + 4 * fq + e) * 64 + 16 * tn + fr] = aa[e]; } }
            }
            __syncthreads();
            {
                float ss = 0.f, bs = 0.f;
#pragma unroll
                for (int e = 0; e < 8; ++e) { kk[e] = k[e] * prm[448 + c8 + e]; ss += kk[e] * kk[e]; }
                ss += shx(ss, 1, lane); ss += shx(ss, 2, lane); ss += shx(ss, 4, lane);
                const float inv = __builtin_amdgcn_rsqf(fmaxf(ss, 1e-24f));
#pragma unroll
                for (int e = 0; e < 8; ++e) {
                    kk[e] *= inv;
                    const float z = Zl[tt * 64 + c8 + e] + prm[320 + c8 + e];
                    lw[e] = -sigmoidf_(z) * 0.8750612633917001f;
                    av[e] = sigmoidf_(Al[tt * 64 + c8 + e] + prm[384 + c8 + e]);
                    kd[e] = k[e] * (1.0f + (av[e] - 1.0f) * prm[512 + c8 + e]);
                    bs += r[e] * kd[e] * prm[576 + c8 + e];
                }
                bs += shx(bs, 1, lane); bs += shx(bs, 2, lane); bs += shx(bs, 4, lane);
                if ((tid & 7) == 0) bsc[(size_t)row * 8 + h] = bs;
            }
            float cum[8];
            {
#pragma unroll
                for (int e = 0; e < 8; ++e) cum[e] = lw[e];
#pragma unroll
                for (int off = 8; off < 64; off <<= 1) {
#pragma unroll
                    for (int e = 0; e < 8; ++e) { const float t = __int_as_float(__builtin_amdgcn_ds_bpermute(((lane - off) & 63) << 2, __float_as_int(cum[e]))); cum[e] += (lane >= off) ? t : 0.f; } }
                if (lane >= 56) {
#pragma unroll
                    for (int e = 0; e < 8; ++e) tot[w * 64 + c8 + e] = cum[e]; }
            }
            __syncthreads();
            {
                float ta[8], tb[8], tk[8], tr[8], bh[8], kh[8];
                const int w0i = (w & ~1) * 64 + c8;
#pragma unroll
                for (int e = 0; e < 8; ++e) {
                    const float t0 = tot[w0i + e], t1 = tot[w0i + 64 + e];
                    const float cm = cum[e] + ((w & 1) ? t0 : 0.f), cumL = t0 + t1;
                    const float e1 = __builtin_amdgcn_exp2f(cm - lw[e]), e2 = __builtin_amdgcn_exp2f(-cm), e3 = __builtin_amdgcn_exp2f(cm), e4 = __builtin_amdgcn_exp2f(cumL - cm);
                    const float ka = kk[e] * av[e];
                    ta[e] = -kk[e] * e1; tb[e] = ka * e2; tk[e] = kd[e] * e2; tr[e] = r[e] * e3; bh[e] = ka * e4; kh[e] = kd[e] * e4;
                    if ((tt & 15) == 15) pLs[(tt >> 4) * 64 + c8 + e] = e3;
                }
                *(LAS u32x4*)(TA + tt * PT + c8) = pack8(ta); *(LAS u32x4*)(TB + tt * PT + c8) = pack8(tb); *(LAS u32x4*)(TK + tt * PT + c8) = pack8(tk); *(LAS u32x4*)(TR + tt * PT + c8) = pack8(tr);
                *(LAS u32x4*)(BH + tt * PT + c8) = pack8(bh); *(LAS u32x4*)(KH + tt * PT + c8) = pack8(kh);
            }
            __syncthreads();
            if (w < 4) {
                const int s = w; const int rowf = (16 * s + fr) * PT;
                f32x4 Mab = {0.f, 0.f, 0.f, 0.f}, MabT = Mab, MakT = Mab, Mbr = Mab, Mkr = Mab;
#pragma unroll
                for (int ks = 0; ks < 2; ++ks) { const int o = rowf + ks * 32 + fq * 8;
                    const bf16x8 fa = *(const LAS bf16x8*)(TA + o), fb = *(const LAS bf16x8*)(TB + o), fk = *(const LAS bf16x8*)(TK + o), frr = *(const LAS bf16x8*)(TR + o);
                    Mab = mm32(fb, fa, Mab); MabT = mm32(fa, fb, MabT); MakT = mm32(fa, fk, MakT); Mbr = mm32(fb, frr, Mbr); Mkr = mm32(fk, frr, Mkr); }
                f32x4 Pm, Pt;
#pragma unroll
                for (int e = 0; e < 4; ++e) { const int m = 4 * fq + e, n = fr;
                    Mab[e] = (m < n) ? Mab[e] : 0.f; MabT[e] = (n < m) ? MabT[e] : 0.f; MakT[e] = (n < m) ? MakT[e] : 0.f; Mbr[e] = (m <= n) ? Mbr[e] : 0.f; Mkr[e] = (m <= n) ? Mkr[e] : 0.f;
                    const float id = (m == n) ? 1.f : 0.f; Pm[e] = Mab[e] + id; Pt[e] = MabT[e] + id; }
                f32x4 Nn = Mab, Nt = MabT; const f32x4 zero = {0.f, 0.f, 0.f, 0.f};
#pragma unroll
                for (int it = 0; it < 3; ++it) {
                    const s16x4 cn = cv4(Nn), cnt = cv4(Nt);
                    const f32x4 N2 = mm16(cnt, cn, zero), Nt2 = mm16(cn, cnt, zero);
                    const s16x4 cp = cv4(Pm), cpt = cv4(Pt), cn2 = cv4(N2);
                    const f32x4 Pn = mm16(cpt, cn2, Pm), Ptn = mm16(cn2, cpt, Pt);
                    Nn = N2; Nt = Nt2; Pm = Pn; Pt = Ptn; (void)cp;
                }
                const s16x4 cT = cv4(Pm), cMakT = cv4(MakT), cMbr = cv4(Mbr);
                const f32x4 Q1T = mm16(cT, cMakT, zero);
                const s16x4 cQ1T = cv4(Q1T);
                const f32x4 Hy = mm16(cQ1T, cMbr, Mkr);
                LAS unsigned char* ring = L + O_RING + s * 12800 + lane * 8;
                *(LAS s16x4*)(ring + 20 * 512) = cv4(Hy);
                s16x4 bhf[4];
#pragma unroll
                for (int jt = 0; jt < 4; ++jt) bhf[jt] = trd(BH, 16 * s, 16 * jt, lane);
#pragma unroll
                for (int jt = 0; jt < 4; ++jt) {
                    const s16x4 atf = trd(TA, 16 * s, 16 * jt, lane);
                    const f32x4 P1T = mm16(cT, atf, zero); const s16x4 cP1T = cv4(P1T);
                    const f32x4 rinit = bf4_to_f(*(const LAS s16x4*)(TR + (16 * s + fr) * PT + 16 * jt + 4 * fq));
                    const f32x4 Gy = mm16(cP1T, cMbr, rinit);
                    *(LAS s16x4*)(ring + jt * 512) = cv4(Gy);
#pragma unroll
                    for (int j2 = 0; j2 < 4; ++j2) { const f32x4 Gs = mm16(cP1T, bhf[j2], zero); *(LAS s16x4*)(ring + (4 + jt * 4 + j2) * 512) = cv4(Gs); }
                    const f32x4 kinit = bf4_to_f(trd(KH, 16 * s, 16 * jt, lane));
                    const f32x4 Hs = mm16(cQ1T, bhf[jt], kinit);
                    *(LAS s16x4*)(ring + (21 + jt) * 512) = cv4(Hs);
                }
            }
            __syncthreads();
            if (w < 4) {
                const int it = w;
#pragma unroll 1
                for (int s = 0; s < 4; ++s) {
                    const LAS unsigned char* ring = L + O_RING + s * 12800 + lane * 8;
                    const s16x4 vb = trd(Vm, 16 * s, 16 * it, lane);
                    s16x4 zb[4];
#pragma unroll
                    for (int jt = 0; jt < 4; ++jt) zb[jt] = cv4(Z[jt]);
                    f32x4 Yt = mm16(*(const LAS s16x4*)(ring + 20 * 512), vb, (f32x4){0.f, 0.f, 0.f, 0.f});
#pragma unroll
                    for (int jt = 0; jt < 4; ++jt) Yt = mm16(*(const LAS s16x4*)(ring + jt * 512), zb[jt], Yt);
#pragma unroll
                    for (int e = 0; e < 4; ++e) Out[(16 * s + 4 * fq + e) * 64 + 16 * it + fr] = Yt[e];
                    f32x4 Zn[4];
#pragma unroll
                    for (int j2 = 0; j2 < 4; ++j2) {
                        const f32x4 pv = *(const LAS f32x4*)(pLs + s * 64 + 16 * j2 + 4 * fq);
                        f32x4 zn = Z[j2] * pv;
                        zn = mm16(*(const LAS s16x4*)(ring + (21 + j2) * 512), vb, zn);
#pragma unroll
                        for (int jt = 0; jt < 4; ++jt) zn = mm16(*(const LAS s16x4*)(ring + (4 + jt * 4 + j2) * 512), zb[jt], zn);
                        Zn[j2] = zn;
                    }
#pragma unroll
                    for (int j2 = 0; j2 < 4; ++j2) Z[j2] = Zn[j2];
                }
            }
            __syncthreads();
            {
                float v[8];
#pragma unroll
                for (int e = 0; e < 8; ++e) v[e] = Out[tt * 64 + c8 + e];
                *(u32x4*)(od + (size_t)row * 512 + h * 64 + c8) = pack8(v);
            }
            __syncthreads();
        }
    }
}

namespace rw4 {
using namespace rw2;
constexpr int RGN = 16384, R_TA = 0, R_TB = 2304, R_TK = 4608, R_TR = 6912, R_BH = 9216, R_KH = 11520, R_V = 13824, R_PL = 16128;
constexpr int R_XWD = 0, R_XAD = 2304, R_ZL = 4608, R_AL = 8704;
constexpr int O_PRM4 = 8 * RGN;
}
__device__ __forceinline__ void rwkv_chain4(const Ctx& F, int layer, int b, int h, int d) {
    using namespace rw4;
    PP P = getpp(); unsigned char* ws = P->ws;
    const bf16_t* u = (const bf16_t*)(ws + D_URWKV);
    bf16_t* od = (bf16_t*)(ws + (d ? D_OB : D_OF));
    float* bsc = (float*)(ws + WS_BSC) + (size_t)d * RT * 8;
    const bf16_t* w2g = (const bf16_t*)(ws + WS_W2T) + (size_t)((layer * 2 + d) * 2 + 0) * 512 * 64 + (size_t)h * 64 * 64;
    const bf16_t* a2g = (const bf16_t*)(ws + WS_W2T) + (size_t)((layer * 2 + d) * 2 + 1) * 512 * 64 + (size_t)h * 64 * 64;
    LAS unsigned char* L = F.lds;
    LAS float* prm = (LAS float*)(L + O_PRM4);
    volatile LAS unsigned* rdy = (volatile LAS unsigned*)(L + O_PRM4 + 2560); LAS unsigned* dne = (LAS unsigned*)(L + O_PRM4 + 2560 + 64);
    unsigned gseq = 0;
    const int tid0 = F.tid, w = F.wave;
    {
        const float* mu = P->in[I_MU] + layer * RWC;
        const float* w0 = P->in[I_W0] + (layer * 2 + d) * 512 + h * 64; const float* a0 = P->in[I_A0] + (layer * 2 + d) * 512 + h * 64;
        const float* k_k = P->in[I_KK] + layer * 512 + h * 64; const float* k_a = P->in[I_KA] + layer * 512 + h * 64; const float* r_k = P->in[I_RK] + layer * 512 + h * 64;
        for (int i = tid0; i < 640; i += NTHREADS) { const int rr = i >> 6, cc = i & 63; float v;
            if (rr == 0) v = mu[h * 64 + cc]; else if (rr == 1) v = mu[512 + h * 64 + cc]; else if (rr == 2) v = mu[1024 + h * 64 + cc]; else if (rr == 3) v = mu[1536 + d * 64 + cc]; else if (rr == 4) v = mu[1664 + d * 64 + cc];
            else if (rr == 5) v = w0[cc]; else if (rr == 6) v = a0[cc]; else if (rr == 7) v = k_k[cc]; else if (rr == 8) v = k_a[cc]; else v = r_k[cc];
            prm[i] = v; }
        if (tid0 < 8) { rdy[tid0] = 0u; dne[tid0] = 0u; }
    }
    f32x4 Z[4];
#pragma unroll
    for (int j = 0; j < 4; ++j) Z[j] = (f32x4){0.f, 0.f, 0.f, 0.f};
    u32x4 raw[2][5][3];
#define RW4_PREFETCH(T_, rbase_, gi_) do { int t0_ = tid0; asm volatile("" : "+v"(t0_)); const int lane_ = t0_ & 63, tk_ = lane_ >> 2, cg_ = lane_ & 3; const int pi_ = (gi_) * 128 + 16 * w + tk_; const int tp_ = d ? ((T_) - 1 - pi_) : pi_; \
        const long row_ = (rbase_) + tp_; const long rp_ = row_ - (tp_ > 0 ? 1 : 0), rn_ = row_ + (tp_ < (T_) - 1 ? 1 : 0); \
        _Pragma("unroll") for (int q_ = 0; q_ < 2; ++q_) _Pragma("unroll") for (int g_ = 0; g_ < 5; ++g_) { \
            const int col_ = (g_ == 0 ? h * 64 : g_ == 1 ? 512 + h * 64 : g_ == 2 ? 1024 + h * 64 : g_ == 3 ? 1536 + d * 64 : 1664 + d * 64) + q_ * 32 + cg_ * 8; \
            raw[q_][g_][0] = *(const u32x4*)(u + row_ * RWC + col_); raw[q_][g_][1] = *(const u32x4*)(u + rp_ * RWC + col_); raw[q_][g_][2] = *(const u32x4*)(u + rn_ * RWC + col_); } } while (0)
    RW4_PREFETCH(CTXL, (long)RL + b * CTXL, 0);
    __syncthreads();
    for (int seq = 0; seq < 2; ++seq) {
        const int T = seq ? SEQ : CTXL; const long rbase = seq ? (long)b * SEQ : (long)RL + b * CTXL; const int ngr = T / 128;
        for (int gi = 0; gi < ngr; ++gi) {
            int tid = tid0; asm volatile("" : "+v"(tid));
            const int lane = tid & 63, fr = lane & 15, fq = lane >> 4, tk = lane >> 2, cg = lane & 3;
            LAS unsigned char* R = L + w * RGN;
            { unsigned sp = 0; while (*(volatile LAS unsigned*)(dne + w) != 4u * gseq) { __builtin_amdgcn_s_sleep(1); if (++sp > (1u << 24)) break; } }
            asm volatile("" ::: "memory");
            {
                const int pi = gi * 128 + 16 * w + tk; const int tpos = d ? (T - 1 - pi) : pi; const long row = rbase + tpos;
                float r[16], k[16], kk[16], av[16], kd[16], lw[16];
                {
                    const float mp = (tpos > 0) ? 0.5f : 0.f, mn = (tpos < T - 1) ? 0.5f : 0.f;
#pragma unroll
                    for (int q = 0; q < 2; ++q) { const int c8 = q * 32 + cg * 8;
#pragma unroll
                        for (int g5 = 0; g5 < 5; ++g5) {
                            float x[8], p[8], n[8], o[8];
                            unpack8(raw[q][g5][0], x); unpack8(raw[q][g5][1], p); unpack8(raw[q][g5][2], n);
                            const f32x4 m0 = *(const LAS f32x4*)(prm + g5 * 64 + c8), m1 = *(const LAS f32x4*)(prm + g5 * 64 + c8 + 4);
#pragma unroll
                            for (int j = 0; j < 8; ++j) o[j] = x[j] + (j < 4 ? m0[j & 3] : m1[j & 3]) * (mp * p[j] + mn * n[j] - x[j]);
                            if (g5 == 0) {
#pragma unroll
                                for (int j = 0; j < 8; ++j) r[8 * q + j] = o[j]; }
                            else if (g5 == 1) {
#pragma unroll
                                for (int j = 0; j < 8; ++j) k[8 * q + j] = o[j]; }
                            else if (g5 == 2) *(LAS u32x4*)(R + R_V + (tk * PT + c8) * 2) = pack8(o);
                            else if (g5 == 3) {
#pragma unroll
                                for (int j = 0; j < 8; ++j) o[j] = fast_tanh(o[j]);
                                *(LAS u32x4*)(R + R_XWD + (tk * PT + c8) * 2) = pack8(o); }
                            else *(LAS u32x4*)(R + R_XAD + (tk * PT + c8) * 2) = pack8(o);
                        } }
                }
                {
                    const LAS bf16_t* Xwd = (const LAS bf16_t*)(R + R_XWD); const LAS bf16_t* Xad = (const LAS bf16_t*)(R + R_XAD);
                    LAS float* Zl = (LAS float*)(R + R_ZL); LAS float* Al = (LAS float*)(R + R_AL);
                    bf16x8 fw[2], fa[2];
#pragma unroll
                    for (int ks = 0; ks < 2; ++ks) { fw[ks] = *(const LAS bf16x8*)(Xwd + fr * PT + ks * 32 + fq * 8); fa[ks] = *(const LAS bf16x8*)(Xad + fr * PT + ks * 32 + fq * 8); }
#pragma unroll
                    for (int tn = 0; tn < 4; ++tn) { f32x4 az = {0.f, 0.f, 0.f, 0.f}, aa = {0.f, 0.f, 0.f, 0.f};
#pragma unroll
                        for (int ks = 0; ks < 2; ++ks) { az = mm32(fw[ks], *(const bf16x8*)(w2g + (16 * tn + fr) * 64 + ks * 32 + fq * 8), az); aa = mm32(fa[ks], *(const bf16x8*)(a2g + (16 * tn + fr) * 64 + ks * 32 + fq * 8), aa); }
#pragma unroll
                        for (int e = 0; e < 4; ++e) { Zl[(4 * fq + e) * 64 + 16 * tn + fr] = az[e]; Al[(4 * fq + e) * 64 + 16 * tn + fr] = aa[e]; } }
                }
                {
                    const LAS float* Zl = (const LAS float*)(R + R_ZL); const LAS float* Al = (const LAS float*)(R + R_AL);
                    float ss = 0.f, bs = 0.f;
                    float pkk[16], pw0[16], pa0[16], pka[16], prk[16], zz[16], aa2[16];
#pragma unroll
                    for (int q = 0; q < 2; ++q) { const int c8 = q * 32 + cg * 8;
#pragma unroll
                        for (int hh = 0; hh < 2; ++hh) { const int o4 = c8 + 4 * hh, i4 = 8 * q + 4 * hh;
                            const f32x4 a = *(const LAS f32x4*)(prm + 448 + o4), b2 = *(const LAS f32x4*)(prm + 320 + o4), c = *(const LAS f32x4*)(prm + 384 + o4), d2 = *(const LAS f32x4*)(prm + 512 + o4), e2 = *(const LAS f32x4*)(prm + 576 + o4);
                            const f32x4 z4 = *(const LAS f32x4*)(Zl + tk * 64 + o4), a4 = *(const LAS f32x4*)(Al + tk * 64 + o4);
#pragma unroll
                            for (int j = 0; j < 4; ++j) { pkk[i4 + j] = a[j]; pw0[i4 + j] = b2[j]; pa0[i4 + j] = c[j]; pka[i4 + j] = d2[j]; prk[i4 + j] = e2[j]; zz[i4 + j] = z4[j]; aa2[i4 + j] = a4[j]; } } }
#pragma unroll
                    for (int i = 0; i < 16; ++i) { kk[i] = k[i] * pkk[i]; ss += kk[i] * kk[i]; }
                    ss += shx(ss, 1, lane); ss += shx(ss, 2, lane);
                    const float inv = __builtin_amdgcn_rsqf(fmaxf(ss, 1e-24f));
#pragma unroll
                    for (int i = 0; i < 16; ++i) {
                        kk[i] *= inv;
                        lw[i] = -sigmoidf_(zz[i] + pw0[i]) * 0.8750612633917001f;
                        av[i] = sigmoidf_(aa2[i] + pa0[i]);
                        kd[i] = k[i] * (1.0f + (av[i] - 1.0f) * pka[i]);
                        bs += r[i] * kd[i] * prk[i]; }
                    bs += shx(bs, 1, lane); bs += shx(bs, 2, lane);
                    if (cg == 0) bsc[(size_t)row * 8 + h] = bs;
                }
                float cum[16], cumL[16];
                {
                    LAS float* Sc = (LAS float*)(R + R_ZL);
#pragma unroll
                    for (int q = 0; q < 2; ++q) { *(LAS f32x4*)(Sc + tk * 64 + q * 32 + cg * 8) = (f32x4){lw[8 * q], lw[8 * q + 1], lw[8 * q + 2], lw[8 * q + 3]}; *(LAS f32x4*)(Sc + tk * 64 + q * 32 + cg * 8 + 4) = (f32x4){lw[8 * q + 4], lw[8 * q + 5], lw[8 * q + 6], lw[8 * q + 7]}; }
                    float a = 0.f;
#pragma unroll
                    for (int t = 0; t < 16; ++t) { a += Sc[t * 64 + lane]; Sc[t * 64 + lane] = a; }
#pragma unroll
                    for (int q = 0; q < 2; ++q) { const f32x4 c0 = *(const LAS f32x4*)(Sc + tk * 64 + q * 32 + cg * 8), c1 = *(const LAS f32x4*)(Sc + tk * 64 + q * 32 + cg * 8 + 4);
                        const f32x4 l0 = *(const LAS f32x4*)(Sc + 15 * 64 + q * 32 + cg * 8), l1 = *(const LAS f32x4*)(Sc + 15 * 64 + q * 32 + cg * 8 + 4);
#pragma unroll
                        for (int e = 0; e < 4; ++e) { cum[8 * q + e] = c0[e]; cum[8 * q + 4 + e] = c1[e]; cumL[8 * q + e] = l0[e]; cumL[8 * q + 4 + e] = l1[e]; } }
                }
                {
#pragma unroll
                    for (int q = 0; q < 2; ++q) { float ta[8], tb[8], tkk[8], tr[8], bh[8], kh[8], plv[8]; const int c8 = q * 32 + cg * 8;
#pragma unroll
                        for (int e = 0; e < 8; ++e) { const int i = 8 * q + e;
                            const float e3 = __builtin_amdgcn_exp2f(cum[i]), e2 = __builtin_amdgcn_rcpf(e3), e1 = __builtin_amdgcn_exp2f(cum[i] - lw[i]), e4 = __builtin_amdgcn_exp2f(cumL[i] - cum[i]);
                            const float ka = kk[i] * av[i];
                            ta[e] = -kk[i] * e1; tb[e] = ka * e2; tkk[e] = kd[i] * e2; tr[e] = r[i] * e3; bh[e] = ka * e4; kh[e] = kd[i] * e4;
                            plv[e] = e3; }
                        *(LAS u32x4*)(R + R_TA + (tk * PT + c8) * 2) = pack8(ta); *(LAS u32x4*)(R + R_TB + (tk * PT + c8) * 2) = pack8(tb); *(LAS u32x4*)(R + R_TK + (tk * PT + c8) * 2) = pack8(tkk);
                        *(LAS u32x4*)(R + R_TR + (tk * PT + c8) * 2) = pack8(tr); *(LAS u32x4*)(R + R_BH + (tk * PT + c8) * 2) = pack8(bh); *(LAS u32x4*)(R + R_KH + (tk * PT + c8) * 2) = pack8(kh);
                        if (tk == 15) { LAS float* pp = (LAS float*)(R + R_PL) + c8; *(LAS f32x4*)pp = (f32x4){plv[0], plv[1], plv[2], plv[3]}; *(LAS f32x4*)(pp + 4) = (f32x4){plv[4], plv[5], plv[6], plv[7]}; } }
                }
                {
                    const LAS bf16_t* TA = (const LAS bf16_t*)(R + R_TA); const LAS bf16_t* TB = (const LAS bf16_t*)(R + R_TB); const LAS bf16_t* TK = (const LAS bf16_t*)(R + R_TK);
                    const LAS bf16_t* TR = (const LAS bf16_t*)(R + R_TR); const LAS bf16_t* BH = (const LAS bf16_t*)(R + R_BH); const LAS bf16_t* KH = (const LAS bf16_t*)(R + R_KH);
                    f32x4 Mab = {0.f, 0.f, 0.f, 0.f}, MabT = Mab, MakT = Mab, Mbr = Mab, Mkr = Mab;
#pragma unroll
                    for (int ks = 0; ks < 2; ++ks) { const int o = fr * PT + ks * 32 + fq * 8;
                        const bf16x8 fa = *(const LAS bf16x8*)(TA + o), fb = *(const LAS bf16x8*)(TB + o), fk = *(const LAS bf16x8*)(TK + o), frr = *(const LAS bf16x8*)(TR + o);
                        Mab = mm32(fb, fa, Mab); MabT = mm32(fa, fb, MabT); MakT = mm32(fa, fk, MakT); Mbr = mm32(fb, frr, Mbr); Mkr = mm32(fk, frr, Mkr); }
                    s16x4 bhf[4], atf[4], rin[4], kin[4];
#pragma unroll
                    for (int jt = 0; jt < 4; ++jt) { bhf[jt] = trd(BH, 0, 16 * jt, lane); atf[jt] = trd(TA, 0, 16 * jt, lane); kin[jt] = trd(KH, 0, 16 * jt, lane); rin[jt] = *(const LAS s16x4*)(TR + fr * PT + 16 * jt + 4 * fq); }
                    f32x4 Pm, Pt;
#pragma unroll
                    for (int e = 0; e < 4; ++e) { const int m = 4 * fq + e, n = fr;
                        Mab[e] = (m < n) ? Mab[e] : 0.f; MabT[e] = (n < m) ? MabT[e] : 0.f; MakT[e] = (n < m) ? MakT[e] : 0.f; Mbr[e] = (m <= n) ? Mbr[e] : 0.f; Mkr[e] = (m <= n) ? Mkr[e] : 0.f;
                        const float id = (m == n) ? 1.f : 0.f; Pm[e] = Mab[e] + id; Pt[e] = MabT[e] + id; }
                    f32x4 Nn = Mab, Nt = MabT; const f32x4 zero = {0.f, 0.f, 0.f, 0.f};
#pragma unroll
                    for (int it = 0; it < 3; ++it) {
                        const s16x4 cn = cv4(Nn), cnt = cv4(Nt);
                        const f32x4 N2 = mm16(cnt, cn, zero), Nt2 = mm16(cn, cnt, zero);
                        const s16x4 cpt = cv4(Pt), cn2 = cv4(N2);
                        const f32x4 Pn = mm16(cpt, cn2, Pm), Ptn = mm16(cn2, cpt, Pt);
                        Nn = N2; Nt = Nt2; Pm = Pn; Pt = Ptn;
                    }
                    const s16x4 cT = cv4(Pm), cMakT = cv4(MakT), cMbr = cv4(Mbr);
                    const f32x4 Q1T = mm16(cT, cMakT, zero);
                    const s16x4 cQ1T = cv4(Q1T);
                    const f32x4 Hy = mm16(cQ1T, cMbr, Mkr);
                    asm volatile("s_waitcnt lgkmcnt(0)" ::: "memory");
                    LAS unsigned char* ring = R + lane * 8;
                    *(LAS s16x4*)(ring + 20 * 512) = cv4(Hy);
#pragma unroll
                    for (int jt = 0; jt < 4; ++jt) {
                        const f32x4 P1T = mm16(cT, atf[jt], zero); const s16x4 cP1T = cv4(P1T);
                        const f32x4 Gy = mm16(cP1T, cMbr, bf4_to_f(rin[jt]));
                        *(LAS s16x4*)(ring + jt * 512) = cv4(Gy);
#pragma unroll
                        for (int j2 = 0; j2 < 4; ++j2) { const f32x4 Gs = mm16(cP1T, bhf[j2], zero); *(LAS s16x4*)(ring + (4 + jt * 4 + j2) * 512) = cv4(Gs); }
                        const f32x4 Hs = mm16(cQ1T, bhf[jt], bf4_to_f(kin[jt]));
                        *(LAS s16x4*)(ring + (21 + jt) * 512) = cv4(Hs);
                    }
                }
            }
            {
                const bool more = gi + 1 < ngr; const bool nseq = !more && seq == 0;
                const int nT = nseq ? SEQ : T; const long nrb = nseq ? (long)b * SEQ : rbase; const int ngi = more ? gi + 1 : (nseq ? 0 : gi);
                RW4_PREFETCH(nT, nrb, ngi);
            }
            ++gseq;
            asm volatile("s_waitcnt lgkmcnt(0)" ::: "memory");
            if (lane == 0) rdy[w] = gseq;
            asm volatile("" ::: "memory");
            if (w < 4) {
                const int it = w;
#pragma unroll 1
                for (int s = 0; s < 8; ++s) {
                    { unsigned sp = 0; while (rdy[s] != gseq) { __builtin_amdgcn_s_sleep(1); if (++sp > (1u << 24)) break; } }
                    asm volatile("" ::: "memory");
                    const LAS unsigned char* Rs = L + s * RGN; const LAS unsigned char* ring = Rs + lane * 8;
                    const s16x4 vb = trd((const LAS bf16_t*)(Rs + R_V), 0, 16 * it, lane);
                    s16x4 zb[4];
#pragma unroll
                    for (int jt = 0; jt < 4; ++jt) zb[jt] = cv4(Z[jt]);
                    f32x4 Yt = mm16(*(const LAS s16x4*)(ring + 20 * 512), vb, (f32x4){0.f, 0.f, 0.f, 0.f});
#pragma unroll
                    for (int jt = 0; jt < 4; ++jt) Yt = mm16(*(const LAS s16x4*)(ring + jt * 512), zb[jt], Yt);
#pragma unroll
                    for (int e = 0; e < 4; ++e) { const int pi = gi * 128 + 16 * s + 4 * fq + e; const int tp = d ? (T - 1 - pi) : pi;
                        od[(size_t)(rbase + tp) * 512 + h * 64 + 16 * it + fr] = (bf16_t)f2bf(Yt[e]); }
                    f32x4 Zn[4];
#pragma unroll
                    for (int j2 = 0; j2 < 4; ++j2) {
                        const f32x4 pv = *(const LAS f32x4*)((const LAS float*)(Rs + R_PL) + 16 * j2 + 4 * fq);
                        f32x4 zn = Z[j2] * pv;
                        zn = mm16(*(const LAS s16x4*)(ring + (21 + j2) * 512), vb, zn);
#pragma unroll
                        for (int jt = 0; jt < 4; ++jt) zn = mm16(*(const LAS s16x4*)(ring + (4 + jt * 4 + j2) * 512), zb[jt], zn);
                        Zn[j2] = zn;
                    }
#pragma unroll
                    for (int j2 = 0; j2 < 4; ++j2) Z[j2] = Zn[j2];
                    asm volatile("s_waitcnt lgkmcnt(0)" ::: "memory");
                    if (lane == 0) (void)__hip_atomic_fetch_add(dne + s, 1u, __ATOMIC_RELAXED, __HIP_MEMORY_SCOPE_WORKGROUP);
                }
            }
        }
    }
#undef RW4_PREFETCH
}

__device__ __forceinline__ void rwkv_post_phase(const Ctx& F, int layer, int nrows_y) {
    PP P = getpp(); unsigned char* ws = P->ws;
    const bf16_t* u = (const bf16_t*)(ws + D_URWKV); const bf16_t* of = (const bf16_t*)(ws + D_OF); const bf16_t* ob = (const bf16_t*)(ws + D_OB);
    bf16_t* y = (bf16_t*)(ws + D_YRWKV);
    const float* bf_ = (const float*)(ws + WS_BSC); const float* bb_ = bf_ + (size_t)RT * 8;
    const float* mu = P->in[I_MU] + layer * RWC; const float* lng = P->in[I_LNG] + layer * 512; const float* lnb = P->in[I_LNB] + layer * 512;
    const bf16_t* wg2 = (const bf16_t*)(ws + WS_WG2) + (size_t)layer * 512 * 128;
    LAS bf16_t* sg = (LAS bf16_t*)F.lds;
    LAS bf16_t* gt = (LAS bf16_t*)(F.lds + 64 * 136 * 2);
    const int tid0 = F.tid, wave = F.wave; const int lane = F.lane;
    const int nunits = nrows_y / 64;
    for (int un = F.bid; un < nunits; un += F.G) {
        int tid = tid0; asm volatile("" : "+v"(tid)); const int lane = tid & 63;
        const long r0 = (long)un * 64; const bool lat = r0 < RL; const int T = lat ? SEQ : CTXL; const int tbase = lat ? (int)(r0 & (SEQ - 1)) : (int)((r0 - RL) & (CTXL - 1));
        for (int it = tid; it < 1024; it += NTHREADS) { const int tk = it >> 4, q = it & 15; float v[8]; load8_shift(u, r0 + tk, tbase + tk, T, 1792 + q * 8, mu, v);
#pragma unroll
            for (int j = 0; j < 8; ++j) v[j] = sigmoidf_(v[j]);
            *(LAS u32x4*)(sg + tk * 136 + q * 8) = pack8(v); }
        __syncthreads();
        {
            const int fr = lane & 15, fq = lane >> 4;
#pragma unroll
            for (int tn = 0; tn < 4; ++tn) { const int cn = (wave * 4 + tn) * 16;
                bf16x8 bfrag[4];
#pragma unroll
                for (int k = 0; k < 4; ++k) bfrag[k] = *(const bf16x8*)(wg2 + (size_t)(cn + fr) * 128 + k * 32 + fq * 8);
#pragma unroll
                for (int tm = 0; tm < 4; ++tm) { f32x4 acc = {0.f, 0.f, 0.f, 0.f};
#pragma unroll
                    for (int k = 0; k < 4; ++k) { const bf16x8 afrag = *(const LAS bf16x8*)(sg + (tm * 16 + fr) * 136 + k * 32 + fq * 8); acc = __builtin_amdgcn_mfma_f32_16x16x32_bf16(afrag, bfrag[k], acc, 0, 0, 0); }
#pragma unroll
                    for (int j = 0; j < 4; ++j) gt[(tm * 16 + fq * 4 + j) * 520 + cn + fr] = (bf16_t)f2bf(acc[j]); } }
        }
        __syncthreads();
        {
            const int tk = tid >> 3, hh = tid & 7; const long row = r0 + tk; const int t = tbase + tk;
            const float bsum = bf_[row * 8 + hh] + bb_[row * 8 + hh];
            float o[64]; float s = 0.f;
#pragma unroll
            for (int q = 0; q < 8; ++q) { float a[8], c[8]; unpack8(*(const u32x4*)(of + row * 512 + hh * 64 + q * 8), a); unpack8(*(const u32x4*)(ob + row * 512 + hh * 64 + q * 8), c);
#pragma unroll
                for (int j = 0; j < 8; ++j) { o[q * 8 + j] = a[j] + c[j]; s += o[q * 8 + j]; } }
            const float mean = s * (1.0f / 64.0f); float vs = 0.f;
#pragma unroll
            for (int j = 0; j < 64; ++j) { const float dd = o[j] - mean; vs += dd * dd; }
            const float rstd = rsqrtf(vs * (1.0f / 64.0f) + 64e-5f);
#pragma unroll
            for (int q = 0; q < 8; ++q) { float vv[8], res[8]; load8_shift(u, row, t, T, 1024 + hh * 64 + q * 8, mu, vv);
                float g8[8]; unpack8(*(const LAS u32x4*)(gt + tk * 520 + hh * 64 + q * 8), g8);
#pragma unroll
                for (int j = 0; j < 8; ++j) { const int c = hh * 64 + q * 8 + j; res[j] = ((o[q * 8 + j] - mean) * rstd * lng[c] + lnb[c] + bsum * vv[j]) * g8[j]; }
                *(u32x4*)(y + row * 512 + hh * 64 + q * 8) = pack8(res); }
        }
        __syncthreads();
    }
}
__device__ __forceinline__ void mla_stats_pass(const Ctx& F, int w0, int nw) {
    unsigned char* ws = getpp()->ws; const int lane = F.lane;
    const bf16_t* um = (const bf16_t*)(ws + D_UMLA); float* rq = (float*)(ws + WS_RSTD); float* rkv = rq + RT;
    for (int row = GW(F) - w0; row < RT; row += nw) {
        const bf16_t* ur = um + (size_t)row * MLC;
        float sq = 0.f, skv = 0.f;
        { float v[8]; unpack8(*(const u32x4*)(ur + lane * 8), v); float s = 0.f;
#pragma unroll
            for (int j = 0; j < 8; ++j) s += v[j] * v[j];
            if (lane < 48) sq += s; else skv += s; }
        if (lane < 16) { float v[8]; unpack8(*(const u32x4*)(ur + 512 + lane * 8), v); float s = 0.f;
#pragma unroll
            for (int j = 0; j < 8; ++j) s += v[j] * v[j];
            skv += s; }
        sq = wave_sum(sq, lane); skv = wave_sum(skv, lane);
        if (lane == 0) { rq[row] = rsqrtf(sq * (1.0f / 384.0f) + 1e-6f); rkv[row] = rsqrtf(skv * (1.0f / 256.0f) + 1e-6f); }
    }
}
__device__ __forceinline__ void krope_pass(const Ctx& F, int half, int layer) {
    unsigned char* ws = getpp()->ws; const int lane = F.lane;
    const bf16_t* um = (const bf16_t*)(ws + D_UMLA); bf16_t* Kb = half ? (bf16_t*)(ws + D_K) : (bf16_t*)(half_a_base(layer) + HA_K);
    const float* cm = (const float*)(ws + WS_ROPE_M); const float* sm = cm + 4096 * 16;
    for (int ci = GW(F) * 4 + (lane >> 4); ci < HROWS; ci += NGW(F) * 4) {
        const int row = ci < 4 * SEQ ? 4 * SEQ * half + ci : RL + 4 * CTXL * half + (ci - 4 * SEQ);
        const int orow = half ? row : ci;
        const bf16_t* ur = um + (size_t)row * MLC; const int l = lane & 15;
        float x1 = bf2f(ur[640 + l]), x2 = bf2f(ur[656 + l]);
        if (row < RL) { const int t = row & (SEQ - 1); const float cs = cm[t * 16 + l], sn = sm[t * 16 + l]; const float o1 = x1 * cs - x2 * sn, o2 = x1 * sn + x2 * cs; x1 = o1; x2 = o2; }
        Kb[(size_t)orow * 544 + 512 + l] = (bf16_t)f2bf(x1); Kb[(size_t)orow * 544 + 528 + l] = (bf16_t)f2bf(x2);
    }
}

constexpr size_t D_KV = D_END1;
static_assert(D_KV + 34 * MiB <= WS_NEED, "retention state buffer");
namespace ret2 {
constexpr int QP = 72, VP = 136, NUNITS = NBATCH * 4 * 34;
typedef short v4i16_t __attribute__((ext_vector_type(4)));
__device__ __forceinline__ bf16x8 tr8(const LAS bf16_t* base, int pitch, int row0, int col0, int lane) {
    const int g = lane >> 4, i = lane & 15, q = i >> 2, p = i & 3;
    const LAS bf16_t* a = base + (row0 + 8 * g + q) * pitch + col0 + 4 * p;
    const s16x4 lo = __builtin_bit_cast(s16x4, __builtin_amdgcn_ds_read_tr16_b64_v4i16((LAS v4i16_t*)a));
    const s16x4 hi = __builtin_bit_cast(s16x4, __builtin_amdgcn_ds_read_tr16_b64_v4i16((LAS v4i16_t*)(a + 4 * pitch)));
    return (bf16x8){lo[0], lo[1], lo[2], lo[3], hi[0], hi[1], hi[2], hi[3]};
}
__device__ __forceinline__ f32x4 mm32(bf16x8 a, bf16x8 b, f32x4 c) { return __builtin_amdgcn_mfma_f32_16x16x32_bf16(a, b, c, 0, 0, 0); }
struct UnitPos { int b, h, cs; long rbase; bool isctx; int t0; };
__device__ __forceinline__ UnitPos unit_pos(int un) { UnitPos U; const int bh = un / 34; U.cs = un % 34; U.b = bh >> 2; U.h = bh & 3; U.isctx = U.cs < 2;
    U.t0 = U.isctx ? 0 : (U.cs - 2) * 128; U.rbase = U.isctx ? (long)RL + U.b * CTXL + U.cs * 128 : (long)U.b * SEQ + U.t0; return U; }
__device__ __forceinline__ void load_pair(const bf16_t* p, int pc, bool rope, const float* cr, const float* sr, int t, float* x1, float* x2) {
    unpack8(*(const u32x4*)(p + pc * 8), x1); unpack8(*(const u32x4*)(p + 32 + pc * 8), x2);
    if (rope) { float cs[8], sn[8];
        *(f32x4*)cs = *(const f32x4*)(cr + t * 32 + pc * 8); *(f32x4*)(cs + 4) = *(const f32x4*)(cr + t * 32 + pc * 8 + 4);
        *(f32x4*)sn = *(const f32x4*)(sr + t * 32 + pc * 8); *(f32x4*)(sn + 4) = *(const f32x4*)(sr + t * 32 + pc * 8 + 4);
#pragma unroll
        for (int j = 0; j < 8; ++j) { const float a = x1[j] * cs[j] - x2[j] * sn[j], b = x1[j] * sn[j] + x2[j] * cs[j]; x1[j] = a; x2[j] = b; } }
}
}
__device__ __forceinline__ void ret_r1_unit(const Ctx& F, int layer, int un) {
    using namespace ret2;
    PP P = getpp(); unsigned char* ws = P->ws;
    const bf16_t* u = (const bf16_t*)(ws + D_URET); bf16_t* kv = (bf16_t*)(ws + D_KV);
    const float* cr = (const float*)(ws + WS_ROPE_R); const float* sr = cr + 4096 * 32;
    const UnitPos U = unit_pos(un);
    const float lgf = -__expf(P->in[I_RDEC][(layer * 2 + 0) * 4 + U.h]) * 1.4426950408889634f, lgb = -__expf(P->in[I_RDEC][(layer * 2 + 1) * 4 + U.h]) * 1.4426950408889634f;
    LAS bf16_t* Vt = (LAS bf16_t*)F.lds; LAS bf16_t* kzf = Vt + 128 * VP; LAS bf16_t* kzb = kzf + 128 * QP; LAS bf16_t* St = kzb + 128 * QP;
    const int tid = F.tid, lane = F.lane, w = F.wave;
    {
        const int tk = tid >> 2, pc = tid & 3; const long row = U.rbase + tk; float k1[8], k2[8], a[8], c[8];
        load_pair(u + row * REC + 256 + U.h * 64, pc, !U.isctx, cr, sr, U.t0 + tk, k1, k2);
        const float zf = 0.125f * __builtin_amdgcn_exp2f((float)(127 - tk) * lgf), zb = 0.125f * __builtin_amdgcn_exp2f((float)tk * lgb);
#pragma unroll
        for (int j = 0; j < 8; ++j) { a[j] = k1[j] * zf; c[j] = k2[j] * zf; }
        *(LAS u32x4*)(kzf + tk * QP + pc * 8) = pack8(a); *(LAS u32x4*)(kzf + tk * QP + 32 + pc * 8) = pack8(c);
#pragma unroll
        for (int j = 0; j < 8; ++j) { a[j] = k1[j] * zb; c[j] = k2[j] * zb; }
        *(LAS u32x4*)(kzb + tk * QP + pc * 8) = pack8(a); *(LAS u32x4*)(kzb + tk * QP + 32 + pc * 8) = pack8(c);
#pragma unroll
        for (int k4 = 0; k4 < 4; ++k4) { const int it = tid + 512 * k4, tv = it >> 4, ch = it & 15; *(LAS u32x4*)(Vt + tv * VP + ch * 8) = *(const u32x4*)(u + (U.rbase + tv) * REC + 512 + U.h * 128 + ch * 8); }
    }
    __syncthreads();
    {
        const int fr = lane & 15, fq = lane >> 4;
        f32x4 acc[2][4];
#pragma unroll
        for (int dd = 0; dd < 2; ++dd)
#pragma unroll
            for (int tj = 0; tj < 4; ++tj) acc[dd][tj] = (f32x4){0.f, 0.f, 0.f, 0.f};
#pragma unroll
        for (int ks = 0; ks < 4; ++ks) { const bf16x8 a = tr8(Vt, VP, 32 * ks, 16 * w, lane);
#pragma unroll
            for (int tj = 0; tj < 4; ++tj) { acc[0][tj] = mm32(a, tr8(kzf, QP, 32 * ks, 16 * tj, lane), acc[0][tj]); acc[1][tj] = mm32(a, tr8(kzb, QP, 32 * ks, 16 * tj, lane), acc[1][tj]); } }
#pragma unroll
        for (int dd = 0; dd < 2; ++dd)
#pragma unroll
            for (int tj = 0; tj < 4; ++tj)
#pragma unroll
                for (int j = 0; j < 4; ++j) St[dd * 128 * QP + (16 * w + 4 * fq + j) * QP + 16 * tj + fr] = (bf16_t)f2bf(acc[dd][tj][j]);
    }
    __syncthreads();
#pragma unroll
    for (int k4 = 0; k4 < 4; ++k4) { const int it = tid + 512 * k4, dd = it >> 10, e = (it >> 3) & 127, ch = it & 7;
        *(u32x4*)(kv + ((size_t)un * 2 + dd) * 8192 + e * 64 + ch * 8) = *(const LAS u32x4*)(St + dd * 128 * QP + e * QP + ch * 8); }
    __syncthreads();
}
__device__ __forceinline__ void ret_r2(const Ctx& F, int layer, int b0, int nb) {
    using namespace ret2;
    PP P = getpp(); bf16_t* kv = (bf16_t*)(P->ws + D_KV);
    for (int item = (F.bid - b0) * NTHREADS + F.tid; item < 65536; item += nb * NTHREADS) {
        const int bh = item >> 11, dd = (item >> 10) & 1, off = (item & 1023) * 8;
        const float g = __builtin_amdgcn_exp2f(-128.0f * __expf(P->in[I_RDEC][(layer * 2 + dd) * 4 + (bh & 3)]) * 1.4426950408889634f);
        float st[8];
#pragma unroll
        for (int j = 0; j < 8; ++j) st[j] = 0.f;
#pragma unroll
        for (int half = 0; half < 2; ++half) {
            asm volatile("" ::: "memory");
            u32x4 xv[17];
#pragma unroll
            for (int q = 0; q < 17; ++q) { const int i = half * 17 + q; const int cs = dd ? (i < 2 ? 1 - i : 35 - i) : i;
                xv[q] = *(const u32x4*)(kv + ((size_t)(bh * 34 + cs) * 2 + dd) * 8192 + off); }
#pragma unroll
            for (int q = 0; q < 17; ++q) { const int i = half * 17 + q; const int cs = dd ? (i < 2 ? 1 - i : 35 - i) : i;
                float x[8]; unpack8(xv[q], x);
                *(u32x4*)(kv + ((size_t)(bh * 34 + cs) * 2 + dd) * 8192 + off) = pack8(st);
#pragma unroll
                for (int j = 0; j < 8; ++j) st[j] = st[j] * g + x[j]; }
        }
    }
}
__device__ __forceinline__ void ret_r3_unit(const Ctx& F, int layer, int un) {
    using namespace ret2;
    PP P = getpp(); unsigned char* ws = P->ws;
    const bf16_t* u = (const bf16_t*)(ws + D_URET); const bf16_t* kv = (const bf16_t*)(ws + D_KV); bf16_t* y = (bf16_t*)(ws + D_YRET);
    const float* cr = (const float*)(ws + WS_ROPE_R); const float* sr = cr + 4096 * 32;
    const UnitPos U = unit_pos(un);
    const float* lng = P->in[I_RLNG] + layer * 512 + U.h * 128; const float* lnb = P->in[I_RLNB] + layer * 512 + U.h * 128;
    const float lgf = -__expf(P->in[I_RDEC][(layer * 2 + 0) * 4 + U.h]) * 1.4426950408889634f, lgb = -__expf(P->in[I_RDEC][(layer * 2 + 1) * 4 + U.h]) * 1.4426950408889634f;
    LAS bf16_t* qf = (LAS bf16_t*)F.lds; LAS bf16_t* qb = qf + 128 * QP; LAS bf16_t* qn = qb + 128 * QP; LAS bf16_t* ks = qn + 128 * QP; LAS bf16_t* Sm = qn;
    LAS bf16_t* Vt = (LAS bf16_t*)(F.lds + 73728); LAS bf16_t* Rf = (LAS bf16_t*)(F.lds + 108544); LAS bf16_t* Rb = Rf + 128 * QP; LAS bf16_t* Yst = qf;
    const int tid = F.tid, lane = F.lane, w = F.wave, fr = lane & 15, fq = lane >> 4;
    const int n0 = 16 * w;
    u32x4 vv[4], rr[4], gq[4]; float lgv[8], lbv[8];
#pragma unroll
    for (int k4 = 0; k4 < 4; ++k4) { const int it = tid + 512 * k4, tv = it >> 4, ch = it & 15; vv[k4] = *(const u32x4*)(u + (U.rbase + tv) * REC + 512 + U.h * 128 + ch * 8); }
#pragma unroll
    for (int k4 = 0; k4 < 4; ++k4) { const int it = tid + 512 * k4, dd = it >> 10, e = (it >> 3) & 127, ch = it & 7; rr[k4] = *(const u32x4*)(kv + ((size_t)un * 2 + dd) * 8192 + e * 64 + ch * 8); }
#pragma unroll
    for (int k4 = 0; k4 < 4; ++k4) { const int it = lane + 64 * k4, r = it >> 4, ch = it & 15; gq[k4] = *(const u32x4*)(u + (U.rbase + n0 + r) * REC + 1024 + U.h * 128 + ch * 8); }
#pragma unroll
    for (int te = 0; te < 8; ++te) { lgv[te] = lng[16 * te + fr]; lbv[te] = lnb[16 * te + fr]; }
    const int tk = tid >> 2, pc = tid & 3;
    u32x4 qr[2], kr[2]; f32x4 rc[2], rs[2];
    { const bf16_t* qp = u + (U.rbase + tk) * REC + U.h * 64 + pc * 8; qr[0] = *(const u32x4*)qp; qr[1] = *(const u32x4*)(qp + 32); kr[0] = *(const u32x4*)(qp + 256); kr[1] = *(const u32x4*)(qp + 288);
      const int ro = (U.t0 + tk) * 32 + pc * 8; rc[0] = *(const f32x4*)(cr + ro); rc[1] = *(const f32x4*)(cr + ro + 4); rs[0] = *(const f32x4*)(sr + ro); rs[1] = *(const f32x4*)(sr + ro + 4); }
    __builtin_amdgcn_sched_barrier(0);
    {
        float q1[8], q2[8], k1[8], k2[8], a[8], c[8];
        unpack8(qr[0], q1); unpack8(qr[1], q2); unpack8(kr[0], k1); unpack8(kr[1], k2);
#pragma unroll
        for (int j = 0; j < 8; ++j) { const float cs = U.isctx ? 1.0f : rc[j >> 2][j & 3], sn = U.isctx ? 0.0f : rs[j >> 2][j & 3];
            const float qa_ = q1[j] * cs - q2[j] * sn, qb_ = q1[j] * sn + q2[j] * cs, ka_ = k1[j] * cs - k2[j] * sn, kb_ = k1[j] * sn + k2[j] * cs;
            q1[j] = qa_; q2[j] = qb_; k1[j] = ka_; k2[j] = kb_; }
        *(LAS u32x4*)(qn + tk * QP + pc * 8) = pack8(q1); *(LAS u32x4*)(qn + tk * QP + 32 + pc * 8) = pack8(q2);
        const float xf = __builtin_amdgcn_exp2f((float)(tk + 1) * lgf), xb = __builtin_amdgcn_exp2f((float)(128 - tk) * lgb);
#pragma unroll
        for (int j = 0; j < 8; ++j) { a[j] = q1[j] * xf; c[j] = q2[j] * xf; }
        *(LAS u32x4*)(qf + tk * QP + pc * 8) = pack8(a); *(LAS u32x4*)(qf + tk * QP + 32 + pc * 8) = pack8(c);
#pragma unroll
        for (int j = 0; j < 8; ++j) { a[j] = q1[j] * xb; c[j] = q2[j] * xb; }
        *(LAS u32x4*)(qb + tk * QP + pc * 8) = pack8(a); *(LAS u32x4*)(qb + tk * QP + 32 + pc * 8) = pack8(c);
#pragma unroll
        for (int j = 0; j < 8; ++j) { a[j] = k1[j] * 0.125f; c[j] = k2[j] * 0.125f; }
        *(LAS u32x4*)(ks + tk * QP + pc * 8) = pack8(a); *(LAS u32x4*)(ks + tk * QP + 32 + pc * 8) = pack8(c);
#pragma unroll
        for (int k4 = 0; k4 < 4; ++k4) { const int it = tid + 512 * k4, tv = it >> 4, ch = it & 15; *(LAS u32x4*)(Vt + tv * VP + ch * 8) = vv[k4]; }
#pragma unroll
        for (int k4 = 0; k4 < 4; ++k4) { const int it = tid + 512 * k4, dd = it >> 10, e = (it >> 3) & 127, ch = it & 7; *(LAS u32x4*)((dd ? Rb : Rf) + e * QP + ch * 8) = rr[k4]; }
    }
    __syncthreads();
    f32x4 ST[8];
    {
        bf16x8 qa[2];
#pragma unroll
        for (int k2 = 0; k2 < 2; ++k2) qa[k2] = *(const LAS bf16x8*)(qn + (n0 + fr) * QP + k2 * 32 + fq * 8);
#pragma unroll
        for (int tm = 0; tm < 8; ++tm) { ST[tm] = (f32x4){0.f, 0.f, 0.f, 0.f};
#pragma unroll
            for (int k2 = 0; k2 < 2; ++k2) ST[tm] = mm32(*(const LAS bf16x8*)(ks + (16 * tm + fr) * QP + k2 * 32 + fq * 8), qa[k2], ST[tm]); }
    }
    s16x4 cst[8];
#pragma unroll
    for (int tm = 0; tm < 8; ++tm) { f32x4 t;
#pragma unroll
        for (int j = 0; j < 4; ++j) { const int n = n0 + fr, m = 16 * tm + 4 * fq + j; const int dd = n - m;
            const float ex = __builtin_amdgcn_exp2f((float)(dd < 0 ? -dd : dd) * (dd > 0 ? lgf : lgb));
            t[j] = ST[tm][j] * ((dd == 0) ? 2.0f : ex); }
        u32x2 pw; pw.x = pk2(t[0], t[1]); pw.y = pk2(t[2], t[3]); cst[tm] = __builtin_bit_cast(s16x4, pw); }
    f32x4 Y[8];
#pragma unroll
    for (int te = 0; te < 8; ++te) Y[te] = (f32x4){0.f, 0.f, 0.f, 0.f};
    {
        const int g = lane >> 4, i = lane & 15, q = i >> 2, pp = i & 3;
#pragma unroll
        for (int p = 0; p < 4; ++p) { const bf16x8 a = (bf16x8){cst[2 * p][0], cst[2 * p][1], cst[2 * p][2], cst[2 * p][3], cst[2 * p + 1][0], cst[2 * p + 1][1], cst[2 * p + 1][2], cst[2 * p + 1][3]};
#pragma unroll
            for (int te = 0; te < 8; ++te) {
                const LAS bf16_t* va = Vt + (32 * p + 4 * g + q) * VP + 16 * te + 4 * pp;
                const s16x4 lo = __builtin_bit_cast(s16x4, __builtin_amdgcn_ds_read_tr16_b64_v4i16((LAS v4i16_t*)va));
                const s16x4 hi = __builtin_bit_cast(s16x4, __builtin_amdgcn_ds_read_tr16_b64_v4i16((LAS v4i16_t*)(va + 16 * VP)));
                Y[te] = mm32(a, (bf16x8){lo[0], lo[1], lo[2], lo[3], hi[0], hi[1], hi[2], hi[3]}, Y[te]); } }
    }
#pragma unroll
    for (int k2 = 0; k2 < 2; ++k2) { const bf16x8 af = *(const LAS bf16x8*)(qf + (n0 + fr) * QP + k2 * 32 + fq * 8), ab = *(const LAS bf16x8*)(qb + (n0 + fr) * QP + k2 * 32 + fq * 8);
#pragma unroll
        for (int te = 0; te < 8; ++te) { Y[te] = mm32(af, *(const LAS bf16x8*)(Rf + (16 * te + fr) * QP + k2 * 32 + fq * 8), Y[te]); Y[te] = mm32(ab, *(const LAS bf16x8*)(Rb + (16 * te + fr) * QP + k2 * 32 + fq * 8), Y[te]); } }
    __syncthreads();
#pragma unroll
    for (int j = 0; j < 4; ++j) { float s = 0.f;
#pragma unroll
        for (int te = 0; te < 8; ++te) s += Y[te][j];
        s += shx(s, 1, lane); s += shx(s, 2, lane); s += shx(s, 4, lane); s += shx(s, 8, lane);
        const float mean = s * (1.0f / 128.0f); float vs = 0.f;
#pragma unroll
        for (int te = 0; te < 8; ++te) { const float dd = Y[te][j] - mean; vs += dd * dd; }
        vs += shx(vs, 1, lane); vs += shx(vs, 2, lane); vs += shx(vs, 4, lane); vs += shx(vs, 8, lane);
        const float rstd = rsqrtf(vs * (1.0f / 128.0f) + 1e-5f);
        const int r = 4 * fq + j; LAS bf16_t* yst = (r < 8 ? qf + n0 * QP + r * VP : qb + n0 * QP + (r - 8) * VP);
#pragma unroll
        for (int te = 0; te < 8; ++te) { const int e = 16 * te + fr; yst[e] = (bf16_t)f2bf((Y[te][j] - mean) * rstd * lgv[te] + lbv[te]); } }
    __syncthreads();
#pragma unroll
    for (int k4 = 0; k4 < 4; ++k4) { const int it = lane + 64 * k4, r = it >> 4, ch = it & 15; const long row = U.rbase + n0 + r;
        const LAS bf16_t* yst = (r < 8 ? qf + n0 * QP + r * VP : qb + n0 * QP + (r - 8) * VP);
        float yv[8], gv[8]; unpack8(*(const LAS u32x4*)(yst + ch * 8), yv); unpack8(gq[k4], gv);
#pragma unroll
        for (int j = 0; j < 8; ++j) yv[j] *= siluf_(gv[j]);
        *(u32x4*)(y + row * 512 + U.h * 128 + ch * 8) = pack8(yv); }
    __syncthreads();
}
__device__ __forceinline__ void ret_r3_phase(const Ctx& F, int layer) {
    for (int un = F.bid; un < ret2::NUNITS; un += F.G) { if (layer != 0 && (un % 34) < 2) continue; ret_r3_unit(F, layer, un); }
}
__device__ __forceinline__ void ret_r1_phase(const Ctx& F, int layer) { for (int un = F.bid; un < ret2::NUNITS; un += F.G) ret_r1_unit(F, layer, un); }
__device__ __forceinline__ void rw_phase(const Ctx& F, int layer) {
    unsigned char* ws = getpp()->ws;
    if (F.G >= 160) {
        if (F.bid < 128) rwkv_chain4(F, layer, F.bid >> 4, (F.bid >> 1) & 7, F.bid & 1);
        unsigned* ctr = (unsigned*)(ws + WS_CTL) + 192 + 64 * layer; LAS unsigned* bc = (LAS unsigned*)(F.lds + LDS_BYTES - 32);
        for (;;) {
            __syncthreads();
            if (F.tid == 0) *bc = __hip_atomic_fetch_add(ctr, 1u, __ATOMIC_RELAXED, __HIP_MEMORY_SCOPE_AGENT);
            __syncthreads();
            const unsigned u = *bc; if (u >= 512u) break;
            const int bh = (int)u >> 4; attn_latent_unit(F, ws, half_a_base(layer), bh >> 3, bh & 7, (int)u & 15);
        }
    } else {
        for (int un = F.bid; un < 128; un += F.G) { rwkv_chain4(F, layer, un >> 4, (un >> 1) & 7, un & 1); __syncthreads(); }
        for (int u = F.bid; u < 512; u += F.G) { const int bh = u >> 4; attn_latent_unit(F, ws, half_a_base(layer), bh >> 3, bh & 7, u & 15); }
    }
}

template <int NB> __device__ __forceinline__ void rows_norm(int lane, const float* hbase, const int* rows, const float* gain, const float* mod, f32x4 (*y)[4]) {
    float ss[NB];
#pragma unroll
    for (int b = 0; b < NB; ++b) { const float* src = hbase + (size_t)rows[b] * 1024; ss[b] = 0.f;
#pragma unroll
        for (int j = 0; j < 4; ++j) { y[b][j] = *(const f32x4*)(src + 4 * lane + 256 * j); ss[b] += y[b][j].x * y[b][j].x + y[b][j].y * y[b][j].y + y[b][j].z * y[b][j].z + y[b][j].w * y[b][j].w; } }
#pragma unroll
    for (int b = 0; b < NB; ++b) ss[b] = wave_sum(ss[b], lane);
#pragma unroll
    for (int b = 0; b < NB; ++b) { const float rstd = rsqrtf(ss[b] * (1.0f / 1024.0f) + 1e-6f); const float* sh = mod + (rows[b] >> 12) * 6144; const float* sc = sh + 1024;
#pragma unroll
        for (int j = 0; j < 4; ++j) { const int c = 4 * lane + 256 * j; y[b][j] = y[b][j] * rstd * *(const f32x4*)(gain + c) * (*(const f32x4*)(sc + c) + 1.0f) + *(const f32x4*)(sh + c); } }
}
__device__ __forceinline__ void moe_route_pass(const Ctx& F, int layer) {
    PP P = getpp(); unsigned char* ws = P->ws;
    const float* gain = P->in[I_NFFN] + layer * 1024; const float* mod = (const float*)(ws + WS_MOD) + (size_t)layer * 9 * 6144 + 3072;
    const float* router = P->in[I_ROUTER];
    unsigned* cnt = (unsigned*)(ws + WS_CTL); int* route = (int*)(ws + WS_ROUTE);
    LAS float* rl = (LAS float*)F.lds;
    LAS unsigned* lc = (LAS unsigned*)(F.lds + 32768);
    for (int i = F.tid; i < 8192; i += NTHREADS) rl[i] = router[i];
    if (F.tid < 16) lc[F.tid] = 0u;
    __syncthreads();
    const int rpb = (RL + F.G - 1) / F.G, rpw = (rpb + 7) / 8;
    const int b0 = F.bid * rpb, b1 = (b0 + rpb < RL) ? b0 + rpb : RL;
    const int r0 = b0 + F.wave * rpw, r1 = (r0 + rpw < b1) ? r0 + rpw : b1;
    constexpr int NB = 2;
    for (int rb = r0; rb < r1; rb += NB) {
        int lane = F.lane; asm volatile("" : "+v"(lane));
        int rows[NB]; f32x4 y[NB][4];
#pragma unroll
        for (int b = 0; b < NB; ++b) rows[b] = (rb + b < r1) ? rb + b : r1 - 1;
        rows_norm<NB>(lane, P->out, rows, gain, mod, y);
        float lg[NB][8];
#pragma unroll
        for (int b = 0; b < NB; ++b)
#pragma unroll
            for (int e = 0; e < 8; ++e) lg[b][e] = 0.f;
#pragma unroll
        for (int j = 0; j < 4; ++j)
#pragma unroll
            for (int q = 0; q < 4; ++q) { const int c = 4 * lane + 256 * j + q; const f32x4 ra = *(const LAS f32x4*)(rl + c * 8), rb2 = *(const LAS f32x4*)(rl + c * 8 + 4);
#pragma unroll
                for (int b = 0; b < NB; ++b) { const float xv = y[b][j][q];
#pragma unroll
                    for (int e = 0; e < 4; ++e) { lg[b][e] += xv * ra[e]; lg[b][4 + e] += xv * rb2[e]; } } }
#pragma unroll
        for (int b = 0; b < NB; ++b)
#pragma unroll
            for (int e = 0; e < 8; ++e) lg[b][e] = wave_sum(lg[b][e], lane);
        if (lane == 0) {
#pragma unroll
            for (int b = 0; b < NB; ++b) if (rb + b < r1) {
                int i0 = 0; float v0 = lg[b][0];
#pragma unroll
                for (int e = 1; e < 8; ++e) if (lg[b][e] > v0) { v0 = lg[b][e]; i0 = e; }
                int i1 = -1; float v1 = -3.0e38f;
#pragma unroll
                for (int e = 0; e < 8; ++e) if (e != i0 && lg[b][e] > v1) { v1 = lg[b][e]; i1 = e; }
                const float w0 = 1.0f / (1.0f + __expf(v1 - v0)), w1 = 1.0f - w0;
                const unsigned p0 = __hip_atomic_fetch_add(&lc[i0], 1u, __ATOMIC_RELAXED, __HIP_MEMORY_SCOPE_WORKGROUP), p1 = __hip_atomic_fetch_add(&lc[i1], 1u, __ATOMIC_RELAXED, __HIP_MEMORY_SCOPE_WORKGROUP);
                int* r = route + (size_t)rows[b] * 8; r[0] = i0; r[1] = i1; r[2] = __float_as_int(w0); r[3] = __float_as_int(w1); r[4] = (int)p0; r[5] = (int)p1;
            }
        }
    }
    __syncthreads();
    if (F.tid < 8) lc[8 + F.tid] = atomicAdd(&cnt[F.tid], lc[F.tid]);
    __syncthreads();
    if (F.lane == 0) for (int row = r0; row < r1; ++row) { int* r = route + (size_t)row * 8; r[4] += (int)lc[8 + r[0]]; r[5] += (int)lc[8 + r[1]]; }
    __syncthreads();
}
__device__ __forceinline__ void moe_gather_pass(const Ctx& F, int layer) {
    PP P = getpp(); unsigned char* ws = P->ws;
    const float* gain = P->in[I_NFFN] + layer * 1024; const float* mod = (const float*)(ws + WS_MOD) + (size_t)layer * 9 * 6144 + 3072;
    const unsigned* cnt = (const unsigned*)(ws + WS_CTL); const int* route = (const int*)(ws + WS_ROUTE);
    bf16_t* xlo = (bf16_t*)(ws + D_XG); bf16_t* xhi = xlo + (size_t)RG * 512;
    const MoeTiles T = moe_tiles(cnt);
    const int rpw = (RL + NGW(F) - 1) / NGW(F); const int r0 = GW(F) * rpw; const int r1 = (r0 + rpw < RL) ? r0 + rpw : RL;
    constexpr int NB = 2;
    for (int rb = r0; rb < r1; rb += NB) {
        int lane = F.lane; asm volatile("" : "+v"(lane));
        int rows[NB]; f32x4 y[NB][4];
#pragma unroll
        for (int b = 0; b < NB; ++b) rows[b] = (rb + b < r1) ? rb + b : r1 - 1;
        rows_norm<NB>(lane, P->out, rows, gain, mod, y);
#pragma unroll
        for (int b = 0; b < NB; ++b) {
            const int* r = route + (size_t)rows[b] * 8; const int e0 = r[0], e1 = r[1];
            int t0 = 0, t1 = 0;
#pragma unroll
            for (int e = 0; e < 8; ++e) { if (e == e0) t0 = T.tstart[e]; if (e == e1) t1 = T.tstart[e]; }
            const size_t s0 = (size_t)t0 * 256 + r[4], s1 = (size_t)t1 * 256 + r[5];
#pragma unroll
            for (int j = 0; j < 4; ++j) { const int c = 4 * lane + 256 * j; u32x2 o; o.x = pk2(y[b][j].x, y[b][j].y); o.y = pk2(y[b][j].z, y[b][j].w);
                bf16_t* bp = (c < 512) ? xlo + c : xhi + (c - 512);
                *(u32x2*)(bp + s0 * 512) = o; *(u32x2*)(bp + s1 * 512) = o; } }
    }
}
__device__ __forceinline__ void moe_final_pass(const Ctx& F, int layer) {
    PP P = getpp(); unsigned char* ws = P->ws;
    const float* mod = (const float*)(ws + WS_MOD) + (size_t)layer * 9 * 6144 + 5120;
    const unsigned* cnt = (const unsigned*)(ws + WS_CTL); const int* route = (const int*)(ws + WS_ROUTE);
    const bf16_t* ym = (const bf16_t*)(ws + D_XG); const float* fn = P->in[I_FNORM];
    const MoeTiles T = moe_tiles(cnt);
    const int rpw = (RL + NGW(F) - 1) / NGW(F); const int r0 = GW(F) * rpw; const int r1 = (r0 + rpw < RL) ? r0 + rpw : RL;
    constexpr int NB = 2;
    for (int rb = r0; rb < r1; rb += NB) {
        int lane = F.lane; asm volatile("" : "+v"(lane));
        f32x4 v[NB][4]; float ss[NB]; int rows[NB];
#pragma unroll
        for (int b = 0; b < NB; ++b) { const int row = (rb + b < r1) ? rb + b : r1 - 1; rows[b] = row;
            const int* r = route + (size_t)row * 8; const int e0 = r[0], e1 = r[1]; const float w0 = __int_as_float(r[2]), w1 = __int_as_float(r[3]);
            int t0 = 0, t1 = 0;
#pragma unroll
            for (int e = 0; e < 8; ++e) { if (e == e0) t0 = T.tstart[e]; if (e == e1) t1 = T.tstart[e]; }
            const size_t s0 = (size_t)t0 * 256 + r[4], s1 = (size_t)t1 * 256 + r[5];
            const float* g = mod + (row >> 12) * 6144; const float* hp = P->out + (size_t)row * 1024; ss[b] = 0.f;
#pragma unroll
            for (int j = 0; j < 4; ++j) { const int c = 4 * lane + 256 * j; const u32x2 a = *(const u32x2*)(ym + s0 * 1024 + c), bq = *(const u32x2*)(ym + s1 * 1024 + c);
                const f32x4 ya = {bflo(a.x), bfhi(a.x), bflo(a.y), bfhi(a.y)}, yb = {bflo(bq.x), bfhi(bq.x), bflo(bq.y), bfhi(bq.y)};
                v[b][j] = *(const f32x4*)(hp + c) + *(const f32x4*)(g + c) * (ya * w0 + yb * w1);
                ss[b] += v[b][j].x * v[b][j].x + v[b][j].y * v[b][j].y + v[b][j].z * v[b][j].z + v[b][j].w * v[b][j].w; } }
#pragma unroll
        for (int b = 0; b < NB; ++b) ss[b] = wave_sum(ss[b], lane);
#pragma unroll
        for (int b = 0; b < NB; ++b) { const float rstd = rsqrtf(ss[b] * (1.0f / 1024.0f) + 1e-6f); float* hp = P->out + (size_t)rows[b] * 1024;
#pragma unroll
            for (int j = 0; j < 4; ++j) { const int c = 4 * lane + 256 * j; *(f32x4*)(hp + c) = v[b][j] * rstd * *(const f32x4*)(fn + c); } }
    }
}

#define XB_TMO      128
#define XB_XCNT(j)  (256  + 64 * (j))
#define XB_XSUB(j)  (1280 + 64 * (j))
#define XB_XGEN(j)  (2304 + 64 * (j))
#define XB_TOP      3328
#define XB_TOPGEN   3392
#define XCD_BAR_WORDS 3456
#define XB_SPIN_CAP (1u << 18)
constexpr int CW_BAR = 4096;
constexpr int LDS_BARST = LDS_BYTES - 16;
__device__ __forceinline__ unsigned xb_ld(unsigned* p)              { return __hip_atomic_load(p, __ATOMIC_RELAXED, __HIP_MEMORY_SCOPE_AGENT); }
__device__ __forceinline__ unsigned xb_add(unsigned* p, unsigned v) { return __hip_atomic_fetch_add(p, v, __ATOMIC_RELAXED, __HIP_MEMORY_SCOPE_AGENT); }
__device__ __forceinline__ unsigned xb_xcc_id() { return (unsigned)__builtin_amdgcn_s_getreg((3 << 11) | 20) & 0xFu; }
#define XB_SPIN(cond, bar) do { unsigned _sp = 0; while (cond) { __builtin_amdgcn_s_sleep(1); \
    if ((++_sp & 255u) == 0u) { if (xb_ld(&(bar)[XB_TMO])) break; if (_sp > XB_SPIN_CAP) { atomicAdd(&(bar)[XB_TMO], 1u); break; } } } } while (0)
__device__ __forceinline__ void xcd_barrier_complete(unsigned* bar, unsigned x, unsigned& nloc, unsigned& nx) {
    const unsigned G = gridDim.x * gridDim.y * gridDim.z;
    unsigned sum, cnt, mine, sp = 0u;
    for (;;) {
        sum = 0u; cnt = 0u; mine = 0u;
#pragma unroll
        for (unsigned j = 0; j < 16; ++j) { const unsigned c = xb_ld(&bar[XB_XCNT(j)]); sum += c; cnt += (c > 0u) ? 1u : 0u; mine = (j == x) ? c : mine; }
        if (sum == G) break;
        __builtin_amdgcn_s_sleep(1);
        if ((++sp & 255u) == 0u) { if (xb_ld(&bar[XB_TMO])) break; if (sp > XB_SPIN_CAP) { atomicAdd(&bar[XB_TMO], 1u); break; } }
    }
    nloc = mine > 0u ? mine : 1u; nx = cnt > 0u ? cnt : 1u;
}
__device__ __forceinline__ void xcd_barrier(LAS unsigned char* lds) {
    asm volatile("s_waitcnt vmcnt(0)" ::: "memory");
    __syncthreads();
    if (threadIdx.x == 0) {
        unsigned* bar = (unsigned*)(getpp()->ws + WS_CTL) + CW_BAR;
        volatile LAS unsigned* st = (volatile LAS unsigned*)(lds + LDS_BARST);
        const unsigned x = xb_xcc_id();
        __builtin_amdgcn_s_waitcnt(0);
        unsigned nloc = st[0], nx = st[1];
        if (nloc == 0u) { xcd_barrier_complete(bar, x, nloc, nx); st[0] = nloc; st[1] = nx; }
        const unsigned old = xb_add(&bar[XB_XSUB(x)], 1u);
        const unsigned gen = old / nloc;
        if (old + 1u == (gen + 1u) * nloc) {
            __builtin_amdgcn_fence(__ATOMIC_RELEASE, "agent");
            asm volatile("s_waitcnt vmcnt(0)" ::: "memory");
            const unsigned og = xb_add(&bar[XB_TOP], 1u);
            const unsigned tg = og / nx;
            if (og + 1u == (tg + 1u) * nx) xb_add(&bar[XB_TOPGEN], 1u);
            else XB_SPIN(xb_ld(&bar[XB_TOPGEN]) == tg, bar);
            __builtin_amdgcn_fence(__ATOMIC_ACQUIRE, "agent");
            xb_add(&bar[XB_XGEN(x)], 1u);
            asm volatile("s_waitcnt vmcnt(0)" ::: "memory");
        } else {
            XB_SPIN(xb_ld(&bar[XB_XGEN(x)]) == gen, bar);
            __builtin_amdgcn_fence(__ATOMIC_ACQUIRE, "agent");
            asm volatile("s_waitcnt vmcnt(0)" ::: "memory");
        }
    }
    __syncthreads();
}
#define FRESH() do { int t_ = threadIdx.x; asm volatile("" : "+v"(t_)); F.tid = t_; F.lane = t_ & 63; F.wave = __builtin_amdgcn_readfirstlane(t_ >> 6); \
    int g_ = gridDim.x, b_ = blockIdx.x; asm volatile("" : "+s"(g_), "+s"(b_)); F.G = g_; F.bid = b_; } while (0)
#define PHASE_VARS FRESH(); const int G = F.G, c = F.bid; (void)G; (void)c; PP P = getpp(); unsigned char* ws = P->ws; const bool L0 = (layer == 0); \
    const float* hl = L0 ? P->in[I_X] : P->out; const float* hcx = L0 ? P->in[I_CTX] : (const float*)(ws + WS_HC); float* hc = (float*)(ws + WS_HC); \
    const char* wl = (const char*)(ws + WS_W + (size_t)layer * WL_STRIDE); const float* mod = (const float*)(ws + WS_MOD) + (size_t)layer * 9 * 6144; \
    const int nMm = L0 ? RT / 256 : RL / 256; (void)hl; (void)hcx; (void)hc; (void)wl; (void)mod; (void)nMm;

template <int layer> __device__ __forceinline__ void layer_fwd(Ctx& F, cg::grid_group& grid) {

        { PHASE_VARS norm_pass(F, layer, 0, hl, hcx, RT, (bf16_t*)(ws + D_XN1), (bf16_t*)(ws + D_XN1 + Y34)); }
        xcd_barrier(F.lds);
        { PHASE_VARS SchedSplit2 S{(const char*)(ws + D_XN1), (const char*)(ws + D_XN1 + Y34), wl + WL_WINLO, wl + WL_WINHI, RT / 256, MIXP / 256, G, c};
          EpiInproj E{ws};
          pg8::gemm_phase<512, 512, true>(F.lds, S, E); }
        xcd_barrier(F.lds);
        FRESH(); mla_stats_pass(F, 0, F.G * 8);
        FRESH(); ret_r1_phase(F, layer);
        xcd_barrier(F.lds);
        FRESH(); ret_r2(F, layer, 0, F.G);
        FRESH(); krope_pass(F, 0, layer);
        { PHASE_VARS SchedHalf S{(const char*)(ws + D_UMLA), wl + WL_WQ, (size_t)256 * MLC * 2, (size_t)256 * 384 * 2, 6, 3, 0, G, c};
          EpiQup E{(bf16_t*)(half_a_base(layer) + HA_Q), (const float*)(ws + WS_RSTD), (const float*)(ws + WS_ROPE_M), (const float*)(ws + WS_ROPE_M) + 4096 * 16, 1};
          pg8::gemm_phase<MLC, 384, false>(F.lds, S, E); }
        { PHASE_VARS SchedHalf S{(const char*)(ws + D_UMLA) + 384 * 2, wl + WL_WKV, (size_t)256 * MLC * 2, (size_t)256 * 256 * 2, 4, 4, 0, G, c};
          EpiKVup E{(bf16_t*)(half_a_base(layer) + HA_K), (bf16_t*)(half_a_base(layer) + HA_V), (const float*)(ws + WS_RSTD) + RT, 1};
          pg8::gemm_phase<MLC, 256, true>(F.lds, S, E); }
        xcd_barrier(F.lds);
        FRESH(); rw_phase(F, layer);
        xcd_barrier(F.lds);
        FRESH(); rwkv_post_phase(F, layer, layer == 0 ? RT : RL);
        xcd_barrier(F.lds);
        FRESH(); krope_pass(F, 1, layer);
        FRESH(); ret_r3_phase(F, layer);
        { PHASE_VARS SchedHalf S{(const char*)(ws + D_UMLA), wl + WL_WQ, (size_t)256 * MLC * 2, (size_t)256 * 384 * 2, 6, 3, 1, G, c};
          EpiQup E{(bf16_t*)(ws + D_Q), (const float*)(ws + WS_RSTD), (const float*)(ws + WS_ROPE_M), (const float*)(ws + WS_ROPE_M) + 4096 * 16, 0};
          pg8::gemm_phase<MLC, 384, false>(F.lds, S, E); }
        { PHASE_VARS SchedHalf S{(const char*)(ws + D_UMLA) + 384 * 2, wl + WL_WKV, (size_t)256 * MLC * 2, (size_t)256 * 256 * 2, 4, 4, 1, G, c};
          EpiKVup E{(bf16_t*)(ws + D_K), (bf16_t*)(ws + D_V), (const float*)(ws + WS_RSTD) + RT, 0};
          pg8::gemm_phase<MLC, 256, true>(F.lds, S, E); }
        xcd_barrier(F.lds);
        FRESH(); attn_phase(F, layer);
        xcd_barrier(F.lds);
        if (layer != 0) { { PHASE_VARS norm_pass(F, layer, 0, hl, hcx, nMm * 256, (bf16_t*)(ws + D_XN1), (bf16_t*)(ws + D_XN1 + Y34)); }
        xcd_barrier(F.lds); }
        { PHASE_VARS SchedMerge S; S.XNlo = (const char*)(ws + D_XN1); S.XNhi = (const char*)(ws + D_XN1 + Y34); S.WgLo = wl + WL_WGLO; S.WgHi = wl + WL_WGHI;
          S.wsb = (const char*)ws; S.Wb = wl + WL_WB; S.nM = nMm; S.G = G; S.c = c; S.ctx3 = L0 && G > 64;
          EpiMerge E{(u32x4*)(ws + D_SCR + (size_t)c * 131072), (bf16_t*)(ws + D_M), (bf16_t*)(ws + D_P12)};
          pg8::gemm_phase<512, 512, true>(F.lds, S, E); }
        xcd_barrier(F.lds);
        if (layer == 0 && F.G > 64) { PHASE_VARS SchedWout0 S{(const char*)(ws + D_M), wl + WL_WO, (const char*)ws, G, c};
          EpiResid E{hl, hcx, P->out, hc, mod, 2048};
          pg8::gemm_phase<1024, 1024, false>(F.lds, S, E); }
        else { PHASE_VARS Sched1 S{(const char*)(ws + D_M), wl + WL_WO, (size_t)256 * 1024 * 2, (size_t)256 * 1024 * 2, 16, nMm, 4, G, c};
          EpiResid E{hl, hcx, P->out, hc, mod, 2048};
          pg8::gemm_phase<1024, 1024, false>(F.lds, S, E); }
        xcd_barrier(F.lds);
        if (layer == 0) {
            { PHASE_VARS norm_pass(F, layer, 1, P->out, hc, RT, (bf16_t*)(ws + D_XN2), (bf16_t*)(ws + D_XN2 + Y34)); }
            FRESH(); convert_ffn0(F);
            xcd_barrier(F.lds);
            { PHASE_VARS SchedSplit2 S{(const char*)(ws + D_XN2), (const char*)(ws + D_XN2 + Y34), (const char*)(ws + D_FFW), (const char*)(ws + D_FFW) + (size_t)5632 * 1024, RT / 256, 22, G, c};
              EpiSwiglu E{(bf16_t*)(ws + D_H), DFF};
              pg8::gemm_phase<512, 512, true>(F.lds, S, E); }
            xcd_barrier(F.lds);
            { PHASE_VARS Sched1 S{(const char*)(ws + D_H), (const char*)(ws + D_FFW) + (size_t)2 * 5632 * 1024, (size_t)256 * DFF * 2, (size_t)256 * DFF * 2, 44, RT / 256, 4, G, c};
              EpiResid E{P->out, hc, P->out, hc, mod, 5120};
              pg8::gemm_phase<DFF, DFF, false>(F.lds, S, E); }
            xcd_barrier(F.lds);
        } else {
            FRESH(); moe_route_pass(F, layer);
            FRESH(); convert_moe(F);
            xcd_barrier(F.lds);
            FRESH(); moe_gather_pass(F, layer);
            xcd_barrier(F.lds);
            { PHASE_VARS const MoeTiles T = moe_tiles((const unsigned*)(ws + WS_CTL));
              SchedMoeUp S{(const char*)(ws + D_XG), (const char*)(ws + D_XG) + (size_t)RG * 1024, (const char*)(ws + D_MOEW), T, G, c};
              EpiSwiglu E{(bf16_t*)(ws + D_HM), DFE};
              pg8::gemm_phase<512, 512, true>(F.lds, S, E); }
            xcd_barrier(F.lds);
            { PHASE_VARS const MoeTiles T = moe_tiles((const unsigned*)(ws + WS_CTL));
              SchedMoeDown S{(const char*)(ws + D_HM), (const char*)(ws + D_MOEW), T, G, c};
              EpiBf16 E{(bf16_t*)(ws + D_XG), 1024};
              pg8::gemm_phase<DFE, DFE, true>(F.lds, S, E); }
            xcd_barrier(F.lds);
            FRESH(); moe_final_pass(F, layer);
        }
    }
#undef PHASE_VARS
#undef FRESH

__global__ void __launch_bounds__(NTHREADS, 2) mega_fwd(Params prm) {
    extern __shared__ __attribute__((aligned(16))) unsigned char lds_raw[];
    cg::grid_group grid = cg::this_grid();
    Ctx F; F.lds = (LAS unsigned char*)lds_raw; F.tid = threadIdx.x; F.lane = F.tid & 63; F.wave = __builtin_amdgcn_readfirstlane(F.tid >> 6); F.G = gridDim.x; F.bid = blockIdx.x;
    if (F.tid < 4) ((LAS unsigned*)(F.lds + LDS_BARST))[F.tid] = 0u;
    __syncthreads();
    if (F.tid == 0) (void)xb_add((unsigned*)(prm.ws + WS_CTL) + CW_BAR + XB_XCNT(xb_xcc_id()), 1u);
    phase0(F);
    grid.sync();
    layer_fwd<0>(F, grid);
    layer_fwd<1>(F, grid);
}

extern "C" void kernel_launch(void* const* d_in, const int* in_sizes, int n_in, void* d_out, int out_size, void* d_ws, size_t ws_size, hipStream_t stream) {
    static int grid_blocks = 0;
    if (grid_blocks == 0) {
        if (n_in != 37 || ws_size < WS_NEED) { fprintf(stderr, "kernel_launch: unexpected n_in %d / ws %zu\n", n_in, ws_size); grid_blocks = -1; return; }
        int dev = 0, cus = 0, per_cu = 0;
        hipGetDevice(&dev); hipDeviceGetAttribute(&cus, hipDeviceAttributeMultiprocessorCount, dev);
        hipFuncSetAttribute((const void*)mega_fwd, hipFuncAttributeMaxDynamicSharedMemorySize, LDS_BYTES);
        hipOccupancyMaxActiveBlocksPerMultiprocessor(&per_cu, (const void*)mega_fwd, NTHREADS, LDS_BYTES);
        if (per_cu < 1) { fprintf(stderr, "kernel_launch: occupancy query says %d blocks/CU\n", per_cu); per_cu = 1; }
        grid_blocks = cus;
        (void)hipGetLastError();
    }
    if (grid_blocks < 0) return;
    (void)hipMemsetAsync((char*)d_ws + WS_CTL, 0, 65536, stream);
    Params p{};
    for (int i = 0; i < 37; ++i) p.in[i] = (const float*)d_in[i];
    p.out = (float*)d_out; p.ws = (unsigned char*)d_ws;
    void* args[] = {&p};
    hipError_t e = hipLaunchCooperativeKernel((const void*)mega_fwd, dim3(grid_blocks), dim3(NTHREADS), args, LDS_BYTES, stream);
    if (e != hipSuccess) fprintf(stderr, "cooperative launch failed: %s (grid %d)\n", hipGetErrorString(e), grid_blocks);
}
```

```cpp
#include <hip/hip_runtime.h>
#include <hip/hip_cooperative_groups.h>
#include <cstdio>
#include <cstdint>
namespace cg = cooperative_groups;

#define LAS __attribute__((address_space(3)))
typedef unsigned short bf16_t;
typedef short bf16x8 __attribute__((ext_vector_type(8)));
typedef short s16x4 __attribute__((ext_vector_type(4)));
typedef float f32x4 __attribute__((ext_vector_type(4)));
typedef float f32x2 __attribute__((ext_vector_type(2)));
typedef float f32x16 __attribute__((ext_vector_type(16)));
typedef unsigned u32x4 __attribute__((ext_vector_type(4)));
typedef unsigned u32x2 __attribute__((ext_vector_type(2)));

constexpr int DM = 1024, NBATCH = 8, SEQ = 4096, CTXL = 256;
constexpr int RL = NBATCH * SEQ, RC = NBATCH * CTXL, RT = RL + RC;
constexpr int RWC = 1920, REC = 1536, MLC = 672, MIXC = 4128, MIXP = 4352, GATEC = 3072, NIN = 7200;
constexpr int DFF = 2816, NEXP = 8, DFE = 1408;
constexpr int RG = 2 * RL + NEXP * 256;
constexpr int NTHREADS = 512;
constexpr int LDS_BYTES = 147456;

constexpr size_t MiB = 1u << 20;
constexpr size_t WS_CTL = 0;
constexpr size_t WS_MOD = 1 * MiB;
constexpr size_t WS_ROPE_R = 3 * MiB / 2;
constexpr size_t WS_ROPE_M = 5 * MiB / 2;
constexpr size_t WS_RSTD = 3 * MiB;
constexpr size_t WS_BSC = 7 * MiB / 2;
constexpr size_t WS_ROUTE = 6 * MiB;
constexpr size_t WS_WG2 = 7 * MiB;
constexpr size_t WS_W2T = 15 * MiB / 2;
constexpr size_t WS_HC = 8 * MiB;
constexpr size_t WS_W = 16 * MiB;
constexpr size_t WL_WINLO = 0, WL_WINHI = 4456448, WL_WGLO = 8912896, WL_WGHI = 12058624, WL_WQ = 15204352, WL_WKV = 15794176, WL_WB = 16318464, WL_WO = 19464192, WL_STRIDE = 21 * MiB;
constexpr size_t WS_DYN = 58 * MiB;
constexpr size_t Y34 = 34 * MiB;
constexpr size_t D_URWKV = WS_DYN, D_URET = WS_DYN + 255 * MiB / 2, D_UMLA = D_URET + 102 * MiB, D_XN1 = D_UMLA + 357 * MiB / 8, D_OF = D_XN1 + 2 * Y34, D_OB = D_OF + Y34, D_END1 = D_OB + Y34;
constexpr size_t D_YRWKV = D_OF, D_YRET = D_OB;
constexpr size_t D_K = WS_DYN, D_V = D_K + 289 * MiB / 8, D_Q = D_V + Y34;
constexpr size_t D_YMLA = D_UMLA;
constexpr int HROWS = 4 * SEQ + 4 * CTXL;
constexpr size_t HA_K = 0, HA_V = HA_K + (size_t)HROWS * 544 * 2, HA_Q = HA_V + (size_t)HROWS * 512 * 2;
static_assert(HA_Q + (size_t)HROWS * 768 * 2 <= 2 * Y34, "half-A K/V/Q fit the xn region / d_out");

constexpr size_t D_SCR = WS_DYN + 68 * MiB;
constexpr size_t D_P12 = WS_DYN + 100 * MiB;
constexpr size_t D_M = WS_DYN;
constexpr size_t D_FFW = WS_DYN;
constexpr size_t D_XN2 = WS_DYN + 17 * MiB;
constexpr size_t D_H = D_URET;
constexpr size_t D_XG = WS_DYN;
constexpr size_t D_HM = WS_DYN + 132 * MiB;
constexpr size_t D_MOEW = D_HM + 363 * MiB / 2;
constexpr size_t WS_NEED = 512 * MiB;
static_assert(D_END1 <= WS_NEED && D_MOEW + 66 * MiB <= WS_NEED && D_H + 187 * MiB <= WS_NEED && D_Q + 51 * MiB <= D_URET, "ws map");

struct Params { const float* in[37]; float* out; unsigned char* ws; };
enum { I_X = 0, I_C, I_CTX, I_CCTX, I_NMIX, I_NFFN, I_WMOD, I_BMOD, I_WIN, I_MU, I_W0, I_W2, I_A0, I_A2, I_G2, I_KK, I_KA, I_RK, I_LNG, I_LNB,
       I_RDEC, I_RLNG, I_RLNB, I_QN, I_QUP, I_KVN, I_KVUP, I_WBR, I_WOUT, I_FG, I_FU, I_FD, I_ROUTER, I_MG, I_MU2, I_MD, I_FNORM };

__device__ __forceinline__ unsigned f2bf(float f) { unsigned u = __builtin_bit_cast(unsigned, f); return (u + 0x7fffu + ((u >> 16) & 1u)) >> 16; }
typedef __bf16 bf16x2_t __attribute__((ext_vector_type(2)));
__device__ __forceinline__ unsigned pk2(float lo, float hi) { const f32x2 v = {lo, hi}; return __builtin_bit_cast(unsigned, __builtin_convertvector(v, bf16x2_t)); }
__device__ __forceinline__ float bf2f(unsigned short b) { return __builtin_bit_cast(float, (unsigned)b << 16); }
__device__ __forceinline__ float bflo(unsigned w) { return __builtin_bit_cast(float, w << 16); }
__device__ __forceinline__ float bfhi(unsigned w) { return __builtin_bit_cast(float, w & 0xffff0000u); }
__device__ __forceinline__ float shx(float v, int m, int lane) { return __int_as_float(__builtin_amdgcn_ds_bpermute((lane ^ m) << 2, __float_as_int(v))); }
__device__ __forceinline__ float wave_sum(float v, int lane) {
#pragma unroll
    for (int o = 1; o < 64; o <<= 1) v += shx(v, o, lane);
    return v;
}
__device__ __forceinline__ float sigmoidf_(float x) { return __builtin_amdgcn_rcpf(1.0f + __builtin_amdgcn_exp2f(-1.4426950408889634f * x)); }
__device__ __forceinline__ float siluf_(float x) { return x * __builtin_amdgcn_rcpf(1.0f + __builtin_amdgcn_exp2f(-1.4426950408889634f * x)); }
__device__ __forceinline__ void unpack8(u32x4 w, float* f) { f[0] = bflo(w.x); f[1] = bfhi(w.x); f[2] = bflo(w.y); f[3] = bfhi(w.y); f[4] = bflo(w.z); f[5] = bfhi(w.z); f[6] = bflo(w.w); f[7] = bfhi(w.w); }
__device__ __forceinline__ u32x4 pack8(const float* f) { u32x4 w; w.x = pk2(f[0], f[1]); w.y = pk2(f[2], f[3]); w.z = pk2(f[4], f[5]); w.w = pk2(f[6], f[7]); return w; }

namespace pg8 {
constexpr int BM = 256, BK = 64, HALF = 128, HTB = HALF * BK * 2, STAGE_BYTES = 8 * HTB, NXCD = 8, WGM = 4;
__host__ __device__ __forceinline__ int lds_byte(int r, int c) { const int st = (r >> 4) * 2 + (c >> 5), rr = r & 15, cc = c & 31, ob = rr * 64 + cc * 2; return st * 1024 + (ob ^ (((ob >> 9) & 1) << 5)); }
__host__ __device__ __forceinline__ void stage_rc(int b, int& R, int& C) { const int st = b / 1024, sb = b % 1024, swz = sb ^ (((sb >> 9) & 1) << 5); R = (st >> 1) * 16 + swz / 64; C = (st & 1) * 32 + (swz % 64) / 2; }
__host__ __device__ __forceinline__ int perm32(int rho) { const int n = rho >> 4, i = rho & 15; return 8 * (i >> 2) + 4 * n + (i & 3); }

struct Seg { const char* A; const char* B; int nt; int pm, pn, aux; bool first, last; };

__device__ __forceinline__ void tile_order(int L, int nM, int nN, int& pm, int& pn) {
    const int nwg = nM * nN; int wgid = L;
    { const int q = nwg / NXCD, r = nwg % NXCD, xcd = wgid % NXCD, off = wgid / NXCD; wgid = (xcd < r ? xcd * (q + 1) : r * (q + 1) + (xcd - r) * q) + off; }
    const int nig = WGM * nN, gid = wgid / nig, fm = gid * WGM, gsz = (nM - fm) < WGM ? (nM - fm) : WGM;
    pm = fm + ((wgid % nig) % gsz); pn = (wgid % nig) / gsz;
}

template <int LDA, int LDB, bool PERM, class Sched, class Epi>
__device__ __forceinline__ void gemm_phase(LAS unsigned char* lds, const Sched& S, const Epi& E) {
    int tid_ = threadIdx.x; asm volatile("" : "+v"(tid_));
    const int tid = tid_, wid = __builtin_amdgcn_readfirstlane(tid >> 6), lane = tid & 63, wr = wid >> 2, wc = wid & 3, fr = lane & 15, fq = lane >> 4;
    unsigned voffA[2], voffB[2];
#pragma unroll
    for (int i = 0; i < 2; ++i) { int R, C; stage_rc(tid * 16 + i * 8192, R, C); const int Rb = PERM ? ((R & ~31) + perm32(R & 31)) : R;
        voffA[i] = (unsigned)(R * LDA + C) * 2u; voffB[i] = (unsigned)(Rb * LDB + C) * 2u; }
    constexpr size_t kstep = (size_t)(BK * 2);
    constexpr size_t hstepA = (size_t)HALF * LDA * 2, hstepB = (size_t)HALF * LDB * 2;
    const unsigned ldsw = (unsigned)wid * 1024u;
    const int aoff = lds_byte(wr * 64 + fr, fq * 8), boff = lds_byte(wc * 32 + fr, fq * 8);
#define PG8_SA(b, h) (((b) * 2 + (h)) * HTB)
#define PG8_SB(b, h) ((4 + (b) * 2 + (h)) * HTB)
#define PG8_STAGE(bufoff, gbase, voff) do { _Pragma("unroll") for (int _i = 0; _i < 2; ++_i) \
        __builtin_amdgcn_global_load_lds((const unsigned*)((const char*)(gbase) + (voff)[_i]), (LAS unsigned*)(lds + (bufoff) + ldsw + _i * 8192), 16, 0, 0); } while (0)
#define PG8_LDA(dst, b, h) do { _Pragma("unroll") for (int m = 0; m < 4; ++m) _Pragma("unroll") for (int k = 0; k < 2; ++k) dst[m][k] = *(const LAS bf16x8*)(lds + PG8_SA(b, h) + aoff + m * 2048 + k * 1024); } while (0)
#define PG8_LDB(dst, b, h) do { _Pragma("unroll") for (int n = 0; n < 2; ++n) _Pragma("unroll") for (int k = 0; k < 2; ++k) dst[n][k] = *(const LAS bf16x8*)(lds + PG8_SB(b, h) + boff + n * 2048 + k * 1024); } while (0)
#define PG8_MMA(ai, bj, At, Bt) do { __builtin_amdgcn_s_setprio(1); _Pragma("unroll") for (int m = 0; m < 4; ++m) _Pragma("unroll") for (int n = 0; n < 2; ++n) _Pragma("unroll") for (int k = 0; k < 2; ++k) \
        acc[ai][bj][m][n] = __builtin_amdgcn_mfma_f32_16x16x32_bf16(Bt[n][k], At[m][k], acc[ai][bj][m][n], 0, 0, 0); __builtin_amdgcn_s_setprio(0); } while (0)
#define PG8_WAIT_V(n) asm volatile("s_waitcnt vmcnt(" #n ")" ::: "memory")
#define PG8_WAIT_L(n) asm volatile("s_waitcnt lgkmcnt(" #n ")" ::: "memory")
#define PG8_BAR __builtin_amdgcn_s_barrier()
#define PG8_SCHED __builtin_amdgcn_sched_barrier(0)
    Seg cur, nxt; int ui = 0;
    if (!S.next(0, cur)) return;
    f32x4 acc[2][2][4][2];
#pragma unroll
    for (int a = 0; a < 2; ++a)
#pragma unroll
        for (int b = 0; b < 2; ++b)
#pragma unroll
            for (int m = 0; m < 4; ++m)
#pragma unroll
                for (int n = 0; n < 2; ++n) acc[a][b][m][n] = (f32x4){0.f, 0.f, 0.f, 0.f};
    bf16x8 At[4][2], B0[2][2], B1[2][2];
    const char* cA = cur.A; const char* cB = cur.B;
    PG8_STAGE(PG8_SB(0, 0), cB, voffB); PG8_STAGE(PG8_SB(0, 1), cB + hstepB, voffB); PG8_STAGE(PG8_SA(0, 0), cA, voffA); PG8_STAGE(PG8_SA(0, 1), cA + hstepA, voffA);
    if (wr == 1) PG8_BAR;
    PG8_WAIT_V(2); PG8_BAR;
    PG8_STAGE(PG8_SB(1, 0), cB + kstep, voffB); PG8_STAGE(PG8_SA(1, 0), cA + kstep, voffA); PG8_STAGE(PG8_SB(1, 1), cB + hstepB + kstep, voffB);
    PG8_WAIT_V(6); PG8_BAR;
    for (;;) {
        const bool has_next = S.next(ui + 1, nxt);
        const char* nA = has_next ? nxt.A : cA; const char* nB = has_next ? nxt.B : cB;
        const int nt = cur.nt;
        for (int t = 0; t < nt; t += 2) {
            const bool last = (t == nt - 2);
            const char* a1 = cA + (size_t)(t + 1) * kstep;
            const char* a2 = last ? nA : cA + (size_t)(t + 2) * kstep; const char* b2 = last ? nB : cB + (size_t)(t + 2) * kstep;
            const char* a3 = a2 + kstep; const char* b3 = b2 + kstep;
            PG8_LDB(B0, 0, 0); PG8_LDB(B1, 0, 1); PG8_SCHED; PG8_LDA(At, 0, 0); PG8_STAGE(PG8_SA(1, 1), a1 + hstepA, voffA);
            PG8_WAIT_V(8); PG8_WAIT_L(0); PG8_BAR; PG8_MMA(0, 0, At, B0); PG8_MMA(0, 1, At, B1); PG8_BAR; PG8_SCHED;
            PG8_LDA(At, 0, 1); PG8_STAGE(PG8_SB(0, 0), b2, voffB); PG8_STAGE(PG8_SB(0, 1), b2 + hstepB, voffB); PG8_STAGE(PG8_SA(0, 0), a2, voffA);
            PG8_WAIT_V(8); PG8_WAIT_L(0); PG8_BAR; PG8_MMA(1, 0, At, B0); PG8_MMA(1, 1, At, B1); PG8_BAR; PG8_SCHED;
            PG8_LDB(B0, 1, 0); PG8_LDB(B1, 1, 1); PG8_SCHED; PG8_LDA(At, 1, 0); PG8_STAGE(PG8_SA(0, 1), a2 + hstepA, voffA);
            PG8_WAIT_V(8); PG8_WAIT_L(0); PG8_BAR; PG8_MMA(0, 0, At, B0); PG8_MMA(0, 1, At, B1); PG8_BAR; PG8_SCHED;
            PG8_LDA(At, 1, 1); PG8_STAGE(PG8_SB(1, 0), b3, voffB); PG8_STAGE(PG8_SB(1, 1), b3 + hstepB, voffB); PG8_STAGE(PG8_SA(1, 0), a3, voffA);
            PG8_WAIT_V(8); PG8_WAIT_L(0); PG8_BAR; PG8_MMA(1, 0, At, B0); PG8_MMA(1, 1, At, B1); PG8_BAR; PG8_SCHED;
        }
        const bool was_last = cur.last;
        if (was_last) { if (wr == 0) PG8_BAR; E(acc, cur, wr, wc, fr, fq); }
        if (!has_next) break;
        if (nxt.first) {
#pragma unroll
            for (int a = 0; a < 2; ++a)
#pragma unroll
                for (int b = 0; b < 2; ++b)
#pragma unroll
                    for (int m = 0; m < 4; ++m)
#pragma unroll
                        for (int n = 0; n < 2; ++n) acc[a][b][m][n] = (f32x4){0.f, 0.f, 0.f, 0.f};
        }
        cur = nxt; cA = nA; cB = nB; ++ui;
        if (was_last) { if (wr == 1) PG8_BAR; }
    }
    PG8_WAIT_V(0);
    PG8_BAR;
#undef PG8_SA
#undef PG8_SB
#undef PG8_STAGE
#undef PG8_LDA
#undef PG8_LDB
#undef PG8_MMA
#undef PG8_WAIT_V
#undef PG8_WAIT_L
#undef PG8_BAR
#undef PG8_SCHED
}
}
using pg8::Seg;

struct Ctx {
    LAS unsigned char* lds; int tid, lane, wave, G, bid;
};
typedef const __attribute__((address_space(4))) Params* PP;
__device__ __forceinline__ PP getpp() { PP p = (PP)__builtin_amdgcn_kernarg_segment_ptr(); asm volatile("" : "+s"(p)); return p; }
__device__ __forceinline__ unsigned char* half_a_base(int layer) { PP p = getpp(); return layer == 0 ? (unsigned char*)p->out : p->ws + D_XN1; }
#define GW(F) ((F).bid * 8 + (F).wave)
#define NGW(F) ((F).G * 8)
#define LDS_WAIT() asm volatile("s_waitcnt lgkmcnt(0)" ::: "memory")

struct TrJob {
    const float* s0; const float* s1; int spitch; int K; int nd; int mode; int c0; int nvalid; const float* ks;
    bf16_t* dlo; bf16_t* dhi; int dpitch; int ksplit;
};
__device__ __forceinline__ void tr_item(const TrJob& J, LAS float* scr, int item, int lane) {
    const int nblk = J.nd / 32, kb = item / nblk, nb = item % nblk, k0 = 64 * kb, n0 = 32 * nb;
    const int np = n0 + (lane & 31);
    const float* src = J.s0; int col = 0; bool valid = true;
    if (J.mode == 0) { col = J.c0 + np; valid = np < J.nvalid; }
    else if (J.mode == 1) { if (np < 512) col = (np >> 6) * 128 + (np & 63); else col = ((np - 512) >> 6) * 128 + 64 + (np & 63); }
    else { const int tile = np >> 8, w = np & 255; if (w < 128) col = tile * 128 + w; else { col = tile * 128 + (w - 128); src = J.s1; } }
    if (!valid) col = J.c0;
    const float* sp = src + (size_t)(k0 + (lane >> 5)) * J.spitch + col;
    float v[32];
#pragma unroll
    for (int i = 0; i < 32; ++i) v[i] = __builtin_nontemporal_load(sp + (size_t)(2 * i) * J.spitch);
    if (J.ks) {
#pragma unroll
        for (int i = 0; i < 32; ++i) v[i] *= J.ks[k0 + 2 * i + (lane >> 5)]; }
#pragma unroll
    for (int i = 0; i < 32; ++i) scr[(2 * i + (lane >> 5)) * 33 + (lane & 31)] = valid ? v[i] : 0.f;
    LDS_WAIT(); asm volatile("" ::: "memory");
    const int c = lane & 7;
    bf16_t* dst = (k0 < J.ksplit) ? J.dlo : J.dhi; const int kd = (k0 < J.ksplit) ? k0 : k0 - J.ksplit;
#pragma unroll
    for (int j = 0; j < 4; ++j) { const int n = (lane >> 3) + 8 * j; const LAS float* s = scr + (8 * c) * 33 + n;
        u32x4 o; o.x = pk2(s[0 * 33], s[1 * 33]); o.y = pk2(s[2 * 33], s[3 * 33]); o.z = pk2(s[4 * 33], s[5 * 33]); o.w = pk2(s[6 * 33], s[7 * 33]);
        *(u32x4*)(dst + (size_t)(n0 + n) * J.dpitch + kd + 8 * c) = o; }
    LDS_WAIT(); asm volatile("" ::: "memory");
}
__device__ __forceinline__ void tr_job(const Ctx& F, const TrJob& J) {
    LAS float* scr = (LAS float*)(F.lds + F.wave * 8704);
    const int nitems = (J.K / 64) * (J.nd / 32);
    for (int it = GW(F); it < nitems; it += NGW(F)) tr_item(J, scr, it, F.lane);
}
__device__ __forceinline__ TrJob mk_job(const float* s0, int spitch, int K, int nd, int c0, int nvalid, bf16_t* dst, int dpitch) {
    TrJob J; J.s0 = s0; J.s1 = nullptr; J.spitch = spitch; J.K = K; J.nd = nd; J.mode = 0; J.c0 = c0; J.nvalid = nvalid; J.ks = nullptr; J.dlo = dst; J.dhi = dst; J.dpitch = dpitch; J.ksplit = 1 << 30; return J;
}

__device__ __forceinline__ void phase0(const Ctx& F) {
    PP P = getpp(); unsigned char* ws = P->ws;
    {
        float* cr = (float*)(ws + WS_ROPE_R); float* sr = cr + 4096 * 32; float* cm = (float*)(ws + WS_ROPE_M); float* sm = cm + 4096 * 16;
        for (int i = F.bid * NTHREADS + F.tid; i < 4096 * 48; i += F.G * NTHREADS) {
            const int t = i / 48, j = i % 48; const float row = (float)(t >> 6), colp = (float)(t & 63);
            if (j < 32) { const int f = j & 15; const float inv = powf(10000.0f, -(float)f / 16.0f); const float ang = (j < 16 ? row : colp) * inv; cr[t * 32 + j] = cosf(ang); sr[t * 32 + j] = sinf(ang); }
            else { const int jj = j - 32, f = jj & 7; const float inv = powf(10000.0f, -(float)f / 8.0f); const float ang = (jj < 8 ? row : colp) * inv; cm[t * 16 + jj] = cosf(ang); sm[t * 16 + jj] = sinf(ang); }
        }
        if (F.bid == 0 && F.tid < 64) ((unsigned*)(ws + WS_CTL))[F.tid] = 0u;
    }
    {
        LAS float* sc = (LAS float*)(F.lds + 70000);
        LAS float* red = (LAS float*)(F.lds + 70000 + 36864);
        for (int i = F.tid; i < 9 * 1024; i += NTHREADS) { const int v = i >> 10, k = i & 1023; const float x = v < 8 ? P->in[I_C][v * 1024 + k] : P->in[I_CCTX][k]; sc[i] = siluf_(x); }
        __syncthreads();
        for (int it = F.bid; it < 2 * 96; it += F.G) {
            const int l = it / 96, jc = F.tid & 63, j = (it % 96) * 64 + jc, ksl = F.tid >> 6;
            const float* w = P->in[I_WMOD] + (size_t)l * 1024 * 6144 + j + (size_t)(ksl * 128) * 6144;
            float a[9];
#pragma unroll
            for (int v = 0; v < 9; ++v) a[v] = 0.f;
#pragma unroll 1
            for (int k0 = 0; k0 < 128; k0 += 16) { float wv[16];
#pragma unroll
                for (int q = 0; q < 16; ++q) wv[q] = w[(size_t)(k0 + q) * 6144];
#pragma unroll
                for (int q = 0; q < 16; ++q)
#pragma unroll
                    for (int v = 0; v < 9; ++v) a[v] += sc[v * 1024 + ksl * 128 + k0 + q] * wv[q]; }
#pragma unroll
            for (int v = 0; v < 9; ++v) red[(ksl * 64 + jc) * 9 + v] = a[v];
            __syncthreads();
            if (F.tid < 64) {
                float* mo = (float*)(ws + WS_MOD) + (size_t)l * 9 * 6144;
#pragma unroll
                for (int v = 0; v < 9; ++v) { float s = 0.f;
#pragma unroll
                    for (int q = 0; q < 8; ++q) s += red[(q * 64 + F.tid) * 9 + v];
                    mo[v * 6144 + j] = s + P->in[I_BMOD][l * 6144 + j]; }
            }
            __syncthreads();
        }
    }
    for (int l = 0; l < 2; ++l) {
        unsigned char* wb = ws + WS_W + (size_t)l * WL_STRIDE;
        const float* win = P->in[I_WIN] + (size_t)l * 1024 * NIN;
        { TrJob J = mk_job(win, NIN, 1024, MIXP, 0, MIXC, (bf16_t*)(wb + WL_WINLO), 512); J.dhi = (bf16_t*)(wb + WL_WINHI); J.ksplit = 512; tr_job(F, J); }
        { TrJob J = mk_job(win, NIN, 1024, GATEC, MIXC, GATEC, (bf16_t*)(wb + WL_WGLO), 512); J.dhi = (bf16_t*)(wb + WL_WGHI); J.ksplit = 512; tr_job(F, J); }
        { TrJob J = mk_job(P->in[I_QUP] + (size_t)l * 384 * 768, 768, 384, 768, 0, 768, (bf16_t*)(wb + WL_WQ), 384); J.ks = P->in[I_QN] + l * 384; tr_job(F, J); }
        { TrJob J = mk_job(P->in[I_KVUP] + (size_t)l * 256 * 1024, 1024, 256, 1024, 0, 1024, (bf16_t*)(wb + WL_WKV), 256); J.mode = 1; J.ks = P->in[I_KVN] + l * 256; tr_job(F, J); }
        for (int n = 0; n < 3; ++n) { TrJob J = mk_job(P->in[I_WBR] + ((size_t)l * 3 + n) * 512 * 1024, 1024, 512, 1024, 0, 1024, (bf16_t*)(wb + WL_WB) + (size_t)n * 1024 * 512, 512); tr_job(F, J); }
        { TrJob J = mk_job(P->in[I_WOUT] + (size_t)l * 1024 * 1024, 1024, 1024, 1024, 0, 1024, (bf16_t*)(wb + WL_WO), 1024); tr_job(F, J); }
        { TrJob J = mk_job(P->in[I_G2] + (size_t)l * 128 * 512, 512, 128, 512, 0, 512, (bf16_t*)(ws + WS_WG2) + (size_t)l * 512 * 128, 128); tr_job(F, J); }
        for (int dd = 0; dd < 2; ++dd) {
            { TrJob J = mk_job(P->in[I_W2] + (size_t)(l * 2 + dd) * 64 * 512, 512, 64, 512, 0, 512, (bf16_t*)(ws + WS_W2T) + (size_t)((l * 2 + dd) * 2 + 0) * 512 * 64, 64); tr_job(F, J); }
            { TrJob J = mk_job(P->in[I_A2] + (size_t)(l * 2 + dd) * 64 * 512, 512, 64, 512, 0, 512, (bf16_t*)(ws + WS_W2T) + (size_t)((l * 2 + dd) * 2 + 1) * 512 * 64, 64); tr_job(F, J); }
        }
    }
}
__device__ __forceinline__ void convert_ffn0(const Ctx& F) {
    PP P = getpp(); unsigned char* ws = P->ws;
    bf16_t* glo = (bf16_t*)(ws + D_FFW); bf16_t* ghi = glo + (size_t)5632 * 512; bf16_t* wd = ghi + (size_t)5632 * 512;
    { TrJob J = mk_job(P->in[I_FG], DFF, 1024, 5632, 0, 5632, glo, 512); J.s1 = P->in[I_FU]; J.mode = 2; J.dhi = ghi; J.ksplit = 512; tr_job(F, J); }
    { TrJob J = mk_job(P->in[I_FD], 1024, DFF, 1024, 0, 1024, wd, DFF); tr_job(F, J); }
}
__device__ __forceinline__ void convert_moe(const Ctx& F) {
    PP P = getpp(); unsigned char* ws = P->ws;
    for (int e = 0; e < NEXP; ++e) {
        bf16_t* glo = (bf16_t*)(ws + D_MOEW + (size_t)e * (33 * MiB / 4)); bf16_t* ghi = glo + (size_t)2816 * 512; bf16_t* wd = ghi + (size_t)2816 * 512;
        { TrJob J = mk_job(P->in[I_MG] + (size_t)e * 1024 * DFE, DFE, 1024, 2816, 0, 2816, glo, 512); J.s1 = P->in[I_MU2] + (size_t)e * 1024 * DFE; J.mode = 2; J.dhi = ghi; J.ksplit = 512; tr_job(F, J); }
        { TrJob J = mk_job(P->in[I_MD] + (size_t)e * DFE * 1024, 1024, DFE, 1024, 0, 1024, wd, DFE); tr_job(F, J); }
    }
}

__device__ __forceinline__ void norm_pass(const Ctx& F, int layer, int which, const float* hl, const float* hcx, int nrows, bf16_t* xlo, bf16_t* xhi) {
    PP P = getpp();
    const float* gain = P->in[which ? I_NFFN : I_NMIX] + layer * 1024;
    const float* mod = (const float*)(P->ws + WS_MOD) + (size_t)layer * 9 * 6144 + (which ? 3072 : 0);
    const int rpw = (nrows + NGW(F) - 1) / NGW(F); const int r0 = GW(F) * rpw; const int r1 = (r0 + rpw < nrows) ? r0 + rpw : nrows;
    int vprev = -1; f32x4 gs[4], sh4[4];
    constexpr int NB = 4;
    for (int rb = r0; rb < r1; rb += NB) {
        f32x4 x[NB][4]; float ss[NB];
#pragma unroll
        for (int b = 0; b < NB; ++b) { const int row = (rb + b < r1) ? rb + b : r1 - 1;
            const float* src = row < RL ? hl + (size_t)row * 1024 : hcx + (size_t)(row - RL) * 1024; ss[b] = 0.f;
#pragma unroll
            for (int j = 0; j < 4; ++j) { x[b][j] = *(const f32x4*)(src + 4 * F.lane + 256 * j); ss[b] += x[b][j].x * x[b][j].x + x[b][j].y * x[b][j].y + x[b][j].z * x[b][j].z + x[b][j].w * x[b][j].w; } }
#pragma unroll
        for (int b = 0; b < NB; ++b) ss[b] = wave_sum(ss[b], F.lane);
#pragma unroll
        for (int b = 0; b < NB; ++b) { const int row = (rb + b < r1) ? rb + b : r1 - 1;
            const int v = row < RL ? (row >> 12) : 8;
            if (v != vprev) { const float* sh = mod + v * 6144; const float* sc = sh + 1024;
#pragma unroll
                for (int j = 0; j < 4; ++j) { const int c = 4 * F.lane + 256 * j; gs[j] = *(const f32x4*)(gain + c) * (*(const f32x4*)(sc + c) + 1.0f); sh4[j] = *(const f32x4*)(sh + c); }
                vprev = v; }
            const float rstd = rsqrtf(ss[b] * (1.0f / 1024.0f) + 1e-6f);
#pragma unroll
            for (int j = 0; j < 4; ++j) { const int c = 4 * F.lane + 256 * j;
                const f32x4 y = x[b][j] * rstd * gs[j] + sh4[j];
                u32x2 o; o.x = pk2(y.x, y.y); o.y = pk2(y.z, y.w);
                bf16_t* d = (c < 512) ? xlo + (size_t)row * 512 + c : xhi + (size_t)row * 512 + (c - 512);
                *(u32x2*)d = o; } }
    }
}

struct SchedSplit2 {
    const char *Alo, *Ahi, *Blo, *Bhi; int nM, nN, G, c;
    __device__ __forceinline__ bool next(int i, Seg& s) const {
        const int iu = i >> 1, h = i & 1; const long L = (long)iu * G + c; if (L >= (long)nM * nN) return false;
        int pm, pn; pg8::tile_order((int)L, nM, nN, pm, pn);
        s.A = (h ? Ahi : Alo) + (size_t)pm * 256 * 1024; s.B = (h ? Bhi : Blo) + (size_t)pn * 256 * 1024; s.nt = 8; s.pm = pm; s.pn = pn; s.aux = 0; s.first = (h == 0); s.last = (h == 1); return true;
    }
};
struct Sched1 {
    const char *A, *B; size_t astride, bstride; int nt, nM, nN, G, c;
    __device__ __forceinline__ bool next(int i, Seg& s) const {
        const long L = (long)i * G + c; if (L >= (long)nM * nN) return false;
        int pm, pn; pg8::tile_order((int)L, nM, nN, pm, pn);
        s.A = A + (size_t)pm * astride; s.B = B + (size_t)pn * bstride; s.nt = nt; s.pm = pm; s.pn = pn; s.aux = 0; s.first = true; s.last = true; return true;
    }
};
struct SchedHalf {
    const char *A, *B; size_t astride, bstride; int nt, nN, half, G, c;
    __device__ __forceinline__ bool next(int i, Seg& s) const {
        const long L = (long)i * G + c; if (L >= (long)68 * nN) return false;
        int mi, pn; pg8::tile_order((int)L, 68, nN, mi, pn);
        const int pm = mi < 64 ? 64 * half + mi : 128 + 4 * half + (mi - 64);
        s.A = A + (size_t)pm * astride; s.B = B + (size_t)pn * bstride; s.nt = nt; s.pm = pm; s.pn = pn; s.aux = 0; s.first = true; s.last = true; return true;
    }
};
struct SchedMerge {
    const char *XNlo, *XNhi, *WgLo, *WgHi, *wsb, *Wb; int nM, G, c; bool ctx3;
    __device__ __forceinline__ void fill(Seg& s, int pm, int pn, int n, int k, int ctxbit) const {
        s.pm = pm; s.pn = pn; s.nt = 8;
        if (k == 0) { s.A = XNlo + (size_t)pm * 256 * 1024; s.B = WgLo + (size_t)(n * 1024 + pn * 256) * 1024; s.first = true; s.last = false; s.aux = n * 2; }
        else if (k == 1) { s.A = XNhi + (size_t)pm * 256 * 1024; s.B = WgHi + (size_t)(n * 1024 + pn * 256) * 1024; s.first = false; s.last = true; s.aux = n * 2; }
        else { const size_t yo = (n == 0) ? D_YRWKV : ((n == 1) ? D_YRET : D_YMLA); s.A = wsb + yo + (size_t)pm * 256 * 1024; s.B = Wb + (size_t)(n * 1024 + pn * 256) * 1024; s.first = true; s.last = true; s.aux = n * 2 + 1 + ctxbit; }
    }
    __device__ __forceinline__ bool next(int i, Seg& s) const {
        const int nMl = ctx3 ? RL / 256 : nM; const int NL = nMl * 4;
        const int kmax = (NL - c + G - 1) / G;
        if (i < 9 * kmax) { const int su = i / 9, r = i % 9; const long L = (long)su * G + c; int pm, pn; pg8::tile_order((int)L, nMl, 4, pm, pn); fill(s, pm, pn, r / 3, r % 3, 0); return true; }
        if (!ctx3) return false;
        const int j = i - 9 * kmax, t = j / 3, k = j % 3; const long idx = (long)t * G + c; if (idx >= 96) return false;
        const int tile = (int)idx / 3, n = (int)idx % 3; fill(s, RL / 256 + (tile & 7), tile >> 3, n, k, 8); return true;
    }
};
struct SchedWout0 {
    const char *A, *B, *wsb; int G, c;
    __device__ __forceinline__ bool next(int i, Seg& s) const {
        if (c < 32) { if (i >= 3) return false; const int pmc = c & 7, pn = c >> 3;
            const size_t ao = (i == 0) ? D_M + (size_t)RL * 1024 * 2 : ((i == 1) ? D_P12 : D_P12 + (size_t)RC * 1024 * 2);
            s.A = wsb + ao + (size_t)pmc * 256 * 1024 * 2; s.B = B + (size_t)pn * 256 * 1024 * 2; s.nt = 16; s.pm = RL / 256 + pmc; s.pn = pn; s.aux = 0; s.first = (i == 0); s.last = (i == 2); return true; }
        const long L = (long)i * (G - 32) + (c - 32); if (L >= (RL / 256) * 4) return false;
        int pm, pn; pg8::tile_order((int)L, RL / 256, 4, pm, pn);
        s.A = A + (size_t)pm * 256 * 1024 * 2; s.B = B + (size_t)pn * 256 * 1024 * 2; s.nt = 16; s.pm = pm; s.pn = pn; s.aux = 0; s.first = true; s.last = true; return true;
    }
};
struct MoeTiles { int tstart[NEXP + 1]; };
__device__ __forceinline__ MoeTiles moe_tiles(const unsigned* cnt) {
    MoeTiles T; int a = 0;
#pragma unroll
    for (int e = 0; e < NEXP; ++e) { T.tstart[e] = a; a += (int)((__builtin_amdgcn_readfirstlane(cnt[e]) + 255u) >> 8); }
    T.tstart[NEXP] = a; return T;
}
__device__ __forceinline__ int moe_expert_of(const MoeTiles& T, int mt) { int e = 0;
#pragma unroll
    for (int k = 1; k < NEXP; ++k) e += (mt >= T.tstart[k]) ? 1 : 0;
    return e; }
struct SchedMoeUp {
    const char *Alo, *Ahi, *W; MoeTiles T; int G, c;
    __device__ __forceinline__ bool next(int i, Seg& s) const {
        const int iu = i >> 1, h = i & 1; const int nM = T.tstart[NEXP]; const long L = (long)iu * G + c; if (L >= (long)nM * 11) return false;
        int pm, pn; pg8::tile_order((int)L, nM, 11, pm, pn);
        const int e = moe_expert_of(T, pm); const char* we = W + (size_t)e * (33 * MiB / 4);
        s.A = (h ? Ahi : Alo) + (size_t)pm * 256 * 1024; s.B = we + (h ? (size_t)2816 * 1024 : 0) + (size_t)pn * 256 * 1024; s.nt = 8; s.pm = pm; s.pn = pn; s.aux = e; s.first = (h == 0); s.last = (h == 1); return true;
    }
};
struct SchedMoeDown {
    const char *A, *W; MoeTiles T; int G, c;
    __device__ __forceinline__ bool next(int i, Seg& s) const {
        const int nM = T.tstart[NEXP]; const long L = (long)i * G + c; if (L >= (long)nM * 4) return false;
        int pm, pn; pg8::tile_order((int)L, nM, 4, pm, pn);
        const int e = moe_expert_of(T, pm); const char* we = W + (size_t)e * (33 * MiB / 4) + (size_t)2 * 2816 * 1024;
        s.A = A + (size_t)pm * 256 * DFE * 2; s.B = we + (size_t)pn * 256 * DFE * 2; s.nt = 22; s.pm = pm; s.pn = pn; s.aux = e; s.first = true; s.last = true; return true;
    }
};

typedef f32x4 Acc[2][2][4][2];
struct EpiInproj {
    unsigned char* ws;
    __device__ __forceinline__ void operator()(const Acc& acc, const Seg& u, int wr, int wc, int fr, int fq) const {
        const int row0 = u.pm * 256 + wr * 64 + fr;
#pragma unroll
        for (int bj = 0; bj < 2; ++bj) {
            const int c0 = u.pn * 256 + bj * 128 + wc * 32 + 8 * fq;
            const bool a = c0 < RWC, b = c0 < RWC + REC;
            const size_t boff = a ? D_URWKV : (b ? D_URET : D_UMLA); const int pitch = a ? RWC : (b ? REC : MLC); const int col = c0 - (a ? 0 : (b ? RWC : RWC + REC));
            bf16_t* base = (bf16_t*)(ws + boff);
            if (c0 < MIXC) {
#pragma unroll
                for (int ai = 0; ai < 2; ++ai)
#pragma unroll
                    for (int m = 0; m < 4; ++m) { const int row = row0 + ai * 128 + m * 16; const f32x4 v0 = acc[ai][bj][m][0], v1 = acc[ai][bj][m][1];
                        u32x4 w; w.x = pk2(v0[0], v0[1]); w.y = pk2(v0[2], v0[3]); w.z = pk2(v1[0], v1[1]); w.w = pk2(v1[2], v1[3]);
                        *(u32x4*)(base + (size_t)row * pitch + col) = w; }
            }
        }
    }
};
struct EpiQup {
    bf16_t* Q; const float* rstd; const float* cosm; const float* sinm; int compact;
    __device__ __forceinline__ void operator()(const Acc& acc, const Seg& u, int wr, int wc, int fr, int fq) const {
        const int row0 = u.pm * 256 + wr * 64 + fr; const bool lat = u.pm * 256 < RL;
        const int cbA = u.pn * 256 + wc * 32; const bool ropeA = lat && ((cbA % 96) == 64), ropeB = lat && (((cbA + 128) % 96) == 64);
        float rsv[8]; f32x4 cs[8], sn[8];
#pragma unroll
        for (int r = 0; r < 8; ++r) rsv[r] = rstd[row0 + (r >> 2) * 128 + (r & 3) * 16];
        if (ropeA || ropeB) {
#pragma unroll
            for (int r = 0; r < 8; ++r) { const int t = (row0 + (r >> 2) * 128 + (r & 3) * 16) & 4095; cs[r] = *(const f32x4*)(cosm + t * 16 + 4 * fq); sn[r] = *(const f32x4*)(sinm + t * 16 + 4 * fq); }
        } else {
#pragma unroll
            for (int r = 0; r < 8; ++r) { cs[r] = (f32x4){1.f, 1.f, 1.f, 1.f}; sn[r] = (f32x4){0.f, 0.f, 0.f, 0.f}; }
        }
        __builtin_amdgcn_sched_barrier(0);
#pragma unroll
        for (int ai = 0; ai < 2; ++ai)
#pragma unroll
            for (int m = 0; m < 4; ++m) { const int row = row0 + ai * 128 + m * 16; const float rs = rsv[ai * 4 + m];
#pragma unroll
                for (int bj = 0; bj < 2; ++bj) { const int cb = cbA + bj * 128; const bool rope = bj ? ropeB : ropeA;
                    f32x4 x1 = acc[ai][bj][m][0] * rs, x2 = acc[ai][bj][m][1] * rs;
                    if (rope) { const f32x4 o1 = x1 * cs[ai * 4 + m] - x2 * sn[ai * 4 + m], o2 = x1 * sn[ai * 4 + m] + x2 * cs[ai * 4 + m]; x1 = o1; x2 = o2; }
                    u32x2 a, b; a.x = pk2(x1[0], x1[1]); a.y = pk2(x1[2], x1[3]); b.x = pk2(x2[0], x2[1]); b.y = pk2(x2[2], x2[3]);
                    const int orow = compact ? (lat ? row : row - RL + 4 * SEQ) : row;
                    bf16_t* d = Q + (size_t)orow * 768 + cb + 4 * fq; *(u32x2*)d = a; *(u32x2*)(d + 16) = b; } }
    }
};
struct EpiKVup {
    bf16_t *Kb, *Vb; const float* rstd; int compact;
    __device__ __forceinline__ void operator()(const Acc& acc, const Seg& u, int wr, int wc, int fr, int fq) const {
        const int row0 = u.pm * 256 + wr * 64 + fr;
        float rsv[8];
#pragma unroll
        for (int r = 0; r < 8; ++r) rsv[r] = rstd[row0 + (r >> 2) * 128 + (r & 3) * 16];
        __builtin_amdgcn_sched_barrier(0);
#pragma unroll
        for (int ai = 0; ai < 2; ++ai)
#pragma unroll
            for (int m = 0; m < 4; ++m) { const int row = row0 + ai * 128 + m * 16; const float rs = rsv[ai * 4 + m];
#pragma unroll
                for (int bj = 0; bj < 2; ++bj) { const int c0 = u.pn * 256 + bj * 128 + wc * 32 + 8 * fq; const f32x4 v0 = acc[ai][bj][m][0] * rs, v1 = acc[ai][bj][m][1] * rs;
                    u32x4 w; w.x = pk2(v0[0], v0[1]); w.y = pk2(v0[2], v0[3]); w.z = pk2(v1[0], v1[1]); w.w = pk2(v1[2], v1[3]);
                    const int orow = compact ? (row < RL ? row : row - RL + 4 * SEQ) : row;
                    bf16_t* d = (u.pn < 2) ? Kb + (size_t)orow * 544 + c0 : Vb + (size_t)orow * 512 + (c0 - 512);
                    *(u32x4*)d = w; } }
    }
};
struct EpiMerge {
    u32x4* scr; bf16_t* M; bf16_t* P12;
    __device__ __forceinline__ void operator()(const Acc& acc, const Seg& u, int wr, int wc, int fr, int fq) const {
        int tid = threadIdx.x; asm volatile("" : "+v"(tid));
        if ((u.aux & 1) == 0) {
#pragma unroll
            for (int ai = 0; ai < 2; ++ai)
#pragma unroll
                for (int bj = 0; bj < 2; ++bj)
#pragma unroll
                    for (int m = 0; m < 4; ++m) { const f32x4 v0 = acc[ai][bj][m][0], v1 = acc[ai][bj][m][1];
                        u32x4 w; w.x = pk2(sigmoidf_(v0[0]), sigmoidf_(v0[1])); w.y = pk2(sigmoidf_(v0[2]), sigmoidf_(v0[3])); w.z = pk2(sigmoidf_(v1[0]), sigmoidf_(v1[1])); w.w = pk2(sigmoidf_(v1[2]), sigmoidf_(v1[3]));
                        scr[((ai * 2 + bj) * 4 + m) * 512 + tid] = w; }
        } else {
            const int n = (u.aux & 7) >> 1; const bool part = (u.aux & 8) != 0; const int row0 = u.pm * 256 + wr * 64 + fr; const bool accum = n > 0 && !part;
            u32x4 gq[2][4], pq[2][4];
#pragma unroll
            for (int k = 0; k < 5; ++k) {
                if (k < 4) { const int ai = k >> 1, bj = k & 1;
#pragma unroll
                    for (int m = 0; m < 4; ++m) { const int row = row0 + ai * 128 + m * 16; const int c0 = u.pn * 256 + bj * 128 + wc * 32 + 8 * fq;
                        gq[k & 1][m] = scr[((ai * 2 + bj) * 4 + m) * 512 + tid];
                        if (accum) pq[k & 1][m] = *(const u32x4*)(M + (size_t)row * 1024 + c0); else pq[k & 1][m] = (u32x4){0u, 0u, 0u, 0u}; } }
                if (k > 0) { const int kk = k - 1, ai = kk >> 1, bj = kk & 1;
#pragma unroll
                    for (int m = 0; m < 4; ++m) { const int row = row0 + ai * 128 + m * 16; const int c0 = u.pn * 256 + bj * 128 + wc * 32 + 8 * fq;
                        float gf[8], pf[8]; unpack8(gq[kk & 1][m], gf); unpack8(pq[kk & 1][m], pf);
                        const f32x4 v0 = acc[ai][bj][m][0], v1 = acc[ai][bj][m][1];
                        bf16_t* d = (part && n > 0) ? P12 + (size_t)(n - 1) * RC * 1024 + (size_t)(row - RL) * 1024 + c0 : M + (size_t)row * 1024 + c0;
#pragma unroll
                        for (int j = 0; j < 4; ++j) { pf[j] += gf[j] * v0[j]; pf[4 + j] += gf[4 + j] * v1[j]; }
                        *(u32x4*)d = pack8(pf); } }
            }
        }
    }
};
struct EpiResid {
    const float *srcl, *srcc; float *dstl, *dstc; const float* mod; int goff;
    __device__ __forceinline__ void operator()(const Acc& acc, const Seg& u, int wr, int wc, int fr, int fq) const {
        const int row0 = u.pm * 256 + wr * 64 + fr; const bool lat = u.pm * 256 < RL;
        const float* sb = lat ? srcl : srcc; float* db = lat ? dstl : dstc; const size_t rsub = lat ? 0 : (size_t)RL;
        const float* g = mod + (lat ? ((u.pm * 256) >> 12) : 8) * 6144 + goff;
        f32x4 gv[2][2];
#pragma unroll
        for (int bj = 0; bj < 2; ++bj)
#pragma unroll
            for (int n = 0; n < 2; ++n) gv[bj][n] = *(const f32x4*)(g + u.pn * 256 + bj * 128 + wc * 32 + 16 * n + 4 * fq);
        f32x4 sv[2][2][2][2];
#pragma unroll
        for (int k = 0; k < 5; ++k) {
            if (k < 4) {
#pragma unroll
                for (int mm = 0; mm < 2; ++mm) { const int row = row0 + (k >> 1) * 128 + ((k & 1) * 2 + mm) * 16; const float* s = sb + ((size_t)row - rsub) * 1024;
#pragma unroll
                    for (int bj = 0; bj < 2; ++bj)
#pragma unroll
                        for (int n = 0; n < 2; ++n) sv[k & 1][mm][bj][n] = *(const f32x4*)(s + u.pn * 256 + bj * 128 + wc * 32 + 16 * n + 4 * fq); } }
            if (k > 0) { const int kk = k - 1, ai = kk >> 1;
#pragma unroll
                for (int mm = 0; mm < 2; ++mm) { const int m = (kk & 1) * 2 + mm; const int row = row0 + ai * 128 + m * 16; float* d = db + ((size_t)row - rsub) * 1024;
#pragma unroll
                    for (int bj = 0; bj < 2; ++bj)
#pragma unroll
                        for (int n = 0; n < 2; ++n) *(f32x4*)(d + u.pn * 256 + bj * 128 + wc * 32 + 16 * n + 4 * fq) = sv[kk & 1][mm][bj][n] + gv[bj][n] * acc[ai][bj][m][n]; } }
        }
    }
};
struct EpiSwiglu {
    bf16_t* H; int pitch;
    __device__ __forceinline__ void operator()(const Acc& acc, const Seg& u, int wr, int wc, int fr, int fq) const {
        const int row0 = u.pm * 256 + wr * 64 + fr; const int c0 = u.pn * 128 + wc * 32 + 8 * fq;
#pragma unroll
        for (int ai = 0; ai < 2; ++ai)
#pragma unroll
            for (int m = 0; m < 4; ++m) { const int row = row0 + ai * 128 + m * 16; float o[8];
#pragma unroll
                for (int n = 0; n < 2; ++n)
#pragma unroll
                    for (int j = 0; j < 4; ++j) o[4 * n + j] = siluf_(acc[ai][0][m][n][j]) * acc[ai][1][m][n][j];
                *(u32x4*)(H + (size_t)row * pitch + c0) = pack8(o); }
    }
};
struct EpiBf16 {
    bf16_t* O; int pitch;
    __device__ __forceinline__ void operator()(const Acc& acc, const Seg& u, int wr, int wc, int fr, int fq) const {
        const int row0 = u.pm * 256 + wr * 64 + fr;
#pragma unroll
        for (int ai = 0; ai < 2; ++ai)
#pragma unroll
            for (int m = 0; m < 4; ++m) { const int row = row0 + ai * 128 + m * 16;
#pragma unroll
                for (int bj = 0; bj < 2; ++bj) { const int c0 = u.pn * 256 + bj * 128 + wc * 32 + 8 * fq; const f32x4 v0 = acc[ai][bj][m][0], v1 = acc[ai][bj][m][1];
                    u32x4 w; w.x = pk2(v0[0], v0[1]); w.y = pk2(v0[2], v0[3]); w.z = pk2(v1[0], v1[1]); w.w = pk2(v1[2], v1[3]);
                    *(u32x4*)(O + (size_t)row * pitch + c0) = w; } }
    }
};

namespace attn {
constexpr float SCALE = 0.10206207261596577f;
constexpr float THR = 8.f;
constexpr int KP = 208;
constexpr int SHM_V = 8192, SHM_K = 64 * KP;
constexpr int OFF_V = 0, OFF_K = 2 * SHM_V, OFF_WS = OFF_K + 2 * SHM_K, SHM_TOTAL = OFF_WS + 8 * 64 * 4;
#define SBAR() __builtin_amdgcn_sched_barrier(0)
__device__ __forceinline__ int crow(int r, int hi) { return (r & 3) + 8 * (r >> 2) + 4 * hi; }
__device__ __forceinline__ unsigned cvtpk(float lo, float hi) { unsigned r; asm volatile("v_cvt_pk_bf16_f32 %0, %1, %2" : "=v"(r) : "v"(lo), "v"(hi)); return r; }
__device__ __forceinline__ void partialSM(f32x16& p0, f32x16& p1, float& m_reg, float& mn, float& alpha) {
    constexpr float C = SCALE * 1.4426950408889634f;
    float pmax = p0[0];
#pragma unroll
    for (int r = 1; r < 16; ++r) pmax = fmaxf(pmax, p0[r]);
#pragma unroll
    for (int r = 0; r < 16; ++r) pmax = fmaxf(pmax, p1[r]);
    { auto rr = __builtin_amdgcn_permlane32_swap(__float_as_uint(pmax), __float_as_uint(pmax), false, false); pmax = fmaxf(__uint_as_float(rr[0]), __uint_as_float(rr[1])); }
    if (__builtin_expect(__all(pmax - m_reg <= THR / SCALE), 1)) { mn = m_reg; alpha = 1.f; }
    else { mn = fmaxf(m_reg, pmax); alpha = __builtin_amdgcn_exp2f((m_reg - mn) * C); m_reg = mn; }
    const float mnC = -mn * C;
#pragma unroll
    for (int r = 0; r < 16; ++r) p0[r] = fmaf(p0[r], C, mnC);
#pragma unroll
    for (int r = 0; r < 16; ++r) p1[r] = fmaf(p1[r], C, mnC);
#pragma unroll
    for (int r = 0; r < 16; ++r) p0[r] = __builtin_amdgcn_exp2f(p0[r]);
}
__device__ __forceinline__ void finishSM(f32x16& p0, f32x16& p1, float alpha, float& l_reg, bf16x8& pa0, bf16x8& pa1, bf16x8& pa2, bf16x8& pa3) {
#pragma unroll
    for (int r = 0; r < 16; ++r) p1[r] = __builtin_amdgcn_exp2f(p1[r]);
    float ps = 0;
#pragma unroll
    for (int r = 0; r < 16; ++r) ps += p0[r];
#pragma unroll
    for (int r = 0; r < 16; ++r) ps += p1[r];
    { auto rr = __builtin_amdgcn_permlane32_swap(__float_as_uint(ps), __float_as_uint(ps), false, false); ps = __uint_as_float(rr[0]) + __uint_as_float(rr[1]); }
    l_reg = l_reg * alpha + ps;
#define PK4(P, BASE, OUT) do { unsigned a0 = cvtpk(P[BASE + 0], P[BASE + 1]), a1 = cvtpk(P[BASE + 2], P[BASE + 3]);   \
    unsigned b0 = cvtpk(P[BASE + 4], P[BASE + 5]), b1 = cvtpk(P[BASE + 6], P[BASE + 7]);                              \
    auto r0 = __builtin_amdgcn_permlane32_swap(a0, b0, false, false); auto r1 = __builtin_amdgcn_permlane32_swap(a1, b1, false, false); \
    u32x4 w = {r0[0], r1[0], r0[1], r1[1]}; OUT = __builtin_bit_cast(bf16x8, w); } while (0)
    PK4(p0, 0, pa0); PK4(p0, 8, pa1); PK4(p1, 0, pa2); PK4(p1, 8, pa3);
#undef PK4
}
__device__ __forceinline__ void qkt(f32x16& p0, f32x16& p1, const LAS unsigned char* Ks, const bf16x8* qr, int r32, int hi) {
    p0 = f32x16{}; p1 = f32x16{};
#pragma unroll
    for (int d0 = 0; d0 < 6; ++d0) { const int cb = (d0 * 16 + hi * 8) * 2;
        const bf16x8 b0 = *(const LAS bf16x8*)(Ks + r32 * KP + cb);
        const bf16x8 b1 = *(const LAS bf16x8*)(Ks + (32 + r32) * KP + cb);
        p0 = __builtin_amdgcn_mfma_f32_32x32x16_bf16(b0, qr[d0], p0, 0, 0, 0);
        p1 = __builtin_amdgcn_mfma_f32_32x32x16_bf16(b1, qr[d0], p1, 0, 0, 0); }
}
__device__ __forceinline__ int v_st(int k, int c) { const int kk = (k & ~0xC) | ((k & 4) << 1) | ((k & 8) >> 1); return ((kk >> 3) * 2 + (c >> 5)) * 512 + ((kk & 7) * 32 + (c & 31)) * 2; }
__device__ __forceinline__ int v_rd_base(int lane) { return ((lane & 3) << 3) | (((lane >> 2) & 3) << 6) | (((lane >> 4) & 1) << 5) | (((lane >> 5) & 1) << 8); }
constexpr int v_rd_off(int d0, int ks, int half) { return d0 * 512 + ks * 2048 + half * 1024; }
template <int OFF> __device__ __forceinline__ s16x4 tr_read(int vb) { s16x4 r; asm volatile("ds_read_b64_tr_b16 %0, %1 offset:%2" : "=&v"(r) : "v"(vb), "i"(OFF) : "memory"); return r; }
template <int D0> __device__ __forceinline__ void pv_one(f32x16& od, int vb, bf16x8 pa0, bf16x8 pa1, bf16x8 pa2, bf16x8 pa3) {
    const s16x4 l0 = tr_read<v_rd_off(D0, 0, 0)>(vb), h0 = tr_read<v_rd_off(D0, 0, 1)>(vb), l1 = tr_read<v_rd_off(D0, 1, 0)>(vb), h1 = tr_read<v_rd_off(D0, 1, 1)>(vb);
    const s16x4 l2 = tr_read<v_rd_off(D0, 2, 0)>(vb), h2 = tr_read<v_rd_off(D0, 2, 1)>(vb), l3 = tr_read<v_rd_off(D0, 3, 0)>(vb), h3 = tr_read<v_rd_off(D0, 3, 1)>(vb);
    asm volatile("s_waitcnt lgkmcnt(0)" ::: "memory"); SBAR();
#define PK(L, H) (bf16x8){L[0], L[1], L[2], L[3], H[0], H[1], H[2], H[3]}
    od = __builtin_amdgcn_mfma_f32_32x32x16_bf16(pa0, PK(l0, h0), od, 0, 0, 0);
    od = __builtin_amdgcn_mfma_f32_32x32x16_bf16(pa1, PK(l1, h1), od, 0, 0, 0);
    od = __builtin_amdgcn_mfma_f32_32x32x16_bf16(pa2, PK(l2, h2), od, 0, 0, 0);
    od = __builtin_amdgcn_mfma_f32_32x32x16_bf16(pa3, PK(l3, h3), od, 0, 0, 0);
#undef PK
}
__device__ __forceinline__ void pv_d0(f32x16* o, int vb, bf16x8 pa0, bf16x8 pa1, bf16x8 pa2, bf16x8 pa3) { pv_one<0>(o[0], vb, pa0, pa1, pa2, pa3); pv_one<1>(o[1], vb, pa0, pa1, pa2, pa3); }

__device__ __forceinline__ void attn_unit(const bf16_t* __restrict__ Qb, const bf16_t* __restrict__ Kn, const bf16_t* __restrict__ Kr, const bf16_t* __restrict__ Vh,
                                          bf16_t* __restrict__ Ob, long lat0, long ctx0, int nlat, int NT, LAS unsigned char* lds) {
    int tid_ = threadIdx.x; asm volatile("" : "+v"(tid_));
    const int tid = tid_, wid = tid >> 6, lane = tid & 63, r32 = lane & 31, hi = lane >> 5;
    LAS unsigned char* V_lds = lds + OFF_V; LAS unsigned char* K_lds = lds + OFF_K;
    LAS float* ws = (LAS float*)(lds + OFF_WS) + wid * 64; LAS float* li_l = ws; LAS float* al_l = ws + 32;
    float m_reg = -1e30f, l_reg = 0; f32x16 o[2] = {}; bf16x8 qr[6];
    const bf16_t* Qw = Qb + (long)(wid * 32 + r32) * 768 + hi * 8;
#pragma unroll
    for (int d0 = 0; d0 < 6; ++d0) qr[d0] = *(const bf16x8*)(Qw + d0 * 16);
    const int sr = tid >> 3, sc = (tid & 7) * 8, vst = v_st(sr, sc);
    const int kr_ = (tid & 255) >> 2, kc_ = (tid & 3) * 8;
    const int vb0 = (int)(uintptr_t)V_lds + v_rd_base(lane);
    struct { bf16x8 vs, kn, kp; } sr_[2];
#define KROW(j, kk) (((j) < nlat) ? (lat0 + (long)(j) * 64 + (kk)) : (ctx0 + (long)((j) - nlat) * 64 + (kk)))
#define SLOAD(i, j) do { const long r0_ = KROW(j, sr), r1_ = KROW(j, kr_); sr_[i].vs = *(const bf16x8*)(Vh + r0_ * 512 + sc); sr_[i].kn = *(const bf16x8*)(Kn + r0_ * 544 + sc); sr_[i].kp = *(const bf16x8*)(Kr + r1_ * 544 + kc_); } while (0)
#define SWRITE(b, i) do { *(LAS bf16x8*)(V_lds + (b) * SHM_V + vst) = sr_[i].vs; *(LAS bf16x8*)(K_lds + (b) * SHM_K + sr * KP + sc * 2) = sr_[i].kn; \
    *(LAS bf16x8*)(K_lds + (b) * SHM_K + kr_ * KP + 128 + kc_ * 2) = sr_[i].kp; } while (0)
#define SWAIT() asm volatile("s_waitcnt vmcnt(3)" ::: "memory")
#define RESC(a) do { if (__any((a) < 1.f)) { if (hi == 0) al_l[r32] = (a); asm volatile("s_waitcnt lgkmcnt(0)" ::: "memory"); \
    _Pragma("unroll") for (int d = 0; d < 2; ++d) _Pragma("unroll") for (int r = 0; r < 16; ++r) o[d][r] *= al_l[crow(r, hi)]; } } while (0)
    f32x16 pA0, pA1, pB0, pB1; float mnA, mnB, alA, alB; bf16x8 pa0, pa1, pa2, pa3;
    constexpr int SE = 0, SO = 1;
    SLOAD(SE, 0); asm volatile("s_waitcnt vmcnt(0)" ::: "memory"); SWRITE(0, SE); __syncthreads();
    qkt(pA0, pA1, K_lds, qr, r32, hi); partialSM(pA0, pA1, m_reg, mnA, alA);
    SLOAD(SO, 1); if (2 < NT) SLOAD(SE, 2);
    SWAIT(); SWRITE(1, SO); __syncthreads();
    for (int j = 1; j + 1 < NT; j += 2) {
        SBAR(); qkt(pB0, pB1, K_lds + SHM_K, qr, r32, hi);
        finishSM(pA0, pA1, alA, l_reg, pa0, pa1, pa2, pa3); SBAR();
        SLOAD(SO, j + 2); SBAR();
        pv_d0(o, vb0, pa0, pa1, pa2, pa3); partialSM(pB0, pB1, m_reg, mnB, alB);
        __syncthreads(); SWAIT(); SWRITE(0, SE);
        RESC(alB); __syncthreads();
        SBAR(); qkt(pA0, pA1, K_lds, qr, r32, hi);
        finishSM(pB0, pB1, alB, l_reg, pa0, pa1, pa2, pa3); SBAR();
        if (j + 3 < NT) SLOAD(SE, j + 3); SBAR();
        pv_d0(o, vb0 + SHM_V, pa0, pa1, pa2, pa3); partialSM(pA0, pA1, m_reg, mnA, alA);
        __syncthreads(); SWAIT(); SWRITE(1, SO);
        RESC(alA); __syncthreads();
    }
    SBAR(); qkt(pB0, pB1, K_lds + SHM_K, qr, r32, hi);
    finishSM(pA0, pA1, alA, l_reg, pa0, pa1, pa2, pa3); SBAR();
    pv_d0(o, vb0, pa0, pa1, pa2, pa3); partialSM(pB0, pB1, m_reg, mnB, alB);
    __syncthreads(); RESC(alB);
    finishSM(pB0, pB1, alB, l_reg, pa0, pa1, pa2, pa3); SBAR();
    pv_d0(o, vb0 + SHM_V, pa0, pa1, pa2, pa3);
    if (hi == 0) li_l[r32] = l_reg; asm volatile("s_waitcnt lgkmcnt(0)" ::: "memory");
    float rli[16];
#pragma unroll
    for (int r = 0; r < 16; ++r) rli[r] = __builtin_amdgcn_rcpf(li_l[crow(r, hi)]);
    bf16_t* Ow = Ob + (long)(wid * 32) * 512;
#pragma unroll
    for (int r = 0; r < 16; ++r) { const int orow = crow(r, hi);
#pragma unroll
        for (int d0 = 0; d0 < 2; ++d0) Ow[(long)orow * 512 + d0 * 32 + r32] = (bf16_t)f2bf(o[d0][r] * rli[r]); }
    __syncthreads();
#undef KROW
#undef SLOAD
#undef SWRITE
#undef SWAIT
#undef RESC
}
#undef SBAR
}

__device__ __forceinline__ void attn_latent_unit(const Ctx& F, unsigned char* ws, unsigned char* ha, int b, int h, int qb) {
    bf16_t* Y = (bf16_t*)(ws + D_YMLA); const long q0 = (long)b * SEQ + qb * 256;
    if (b < 4) { const bf16_t* Q = (const bf16_t*)(ha + HA_Q); const bf16_t* K = (const bf16_t*)(ha + HA_K); const bf16_t* V = (const bf16_t*)(ha + HA_V);
        attn::attn_unit(Q + q0 * 768 + h * 96, K + h * 64, K + 512, V + h * 64, Y + q0 * 512 + h * 64, (long)b * SEQ, (long)4 * SEQ + b * CTXL, 64, 68, F.lds); }
    else { const bf16_t* Q = (const bf16_t*)(ws + D_Q); const bf16_t* K = (const bf16_t*)(ws + D_K); const bf16_t* V = (const bf16_t*)(ws + D_V);
        attn::attn_unit(Q + q0 * 768 + h * 96, K + h * 64, K + 512, V + h * 64, Y + q0 * 512 + h * 64, (long)b * SEQ, (long)RL + b * CTXL, 64, 68, F.lds); }
}
__device__ __forceinline__ void attn_phase(const Ctx& F, int layer) {
    unsigned char* ws = getpp()->ws; unsigned char* ha = half_a_base(layer); const bool with_ctx_q = (layer == 0);
    const int vcu = (F.G % 8 == 0) ? (F.bid % 8) * (F.G / 8) + F.bid / 8 : F.bid;
    const int nlat_units = 4 * 8 * 16, nunits = nlat_units + (with_ctx_q ? NBATCH * 8 : 0);
    for (int u = vcu; u < nunits; u += F.G) {
        if (u < nlat_units) { const int bh = u >> 4, qb = u & 15; attn_latent_unit(F, ws, ha, 4 + (bh >> 3), bh & 7, qb); }
        else { const int bh = u - nlat_units, b = bh >> 3, h = bh & 7; bf16_t* Y = (bf16_t*)(ws + D_YMLA); const long yrow = (long)RL + b * CTXL;
            if (b < 4) { const bf16_t* Q = (const bf16_t*)(ha + HA_Q); const bf16_t* K = (const bf16_t*)(ha + HA_K); const bf16_t* V = (const bf16_t*)(ha + HA_V); const long q0 = (long)4 * SEQ + b * CTXL;
                attn::attn_unit(Q + q0 * 768 + h * 96, K + h * 64, K + 512, V + h * 64, Y + yrow * 512 + h * 64, 0, q0, 0, 4, F.lds); }
            else { const bf16_t* Q = (const bf16_t*)(ws + D_Q); const bf16_t* K = (const bf16_t*)(ws + D_K); const bf16_t* V = (const bf16_t*)(ws + D_V);
                attn::attn_unit(Q + yrow * 768 + h * 96, K + h * 64, K + 512, V + h * 64, Y + yrow * 512 + h * 64, 0, yrow, 0, 4, F.lds); } }
    }
}

__device__ __forceinline__ void load8_shift(const bf16_t* u, long row, int t, int T, int col, const float* mu, float* out) {
    float x[8], p[8], n[8];
    const bool hp = t > 0, hn = t < T - 1;
    const u32x4 wx = *(const u32x4*)(u + row * RWC + col), wp = *(const u32x4*)(u + (row - (hp ? 1 : 0)) * RWC + col), wn = *(const u32x4*)(u + (row + (hn ? 1 : 0)) * RWC + col);
    unpack8(wx, x); unpack8(wp, p); unpack8(wn, n);
    const float mp = hp ? 0.5f : 0.f, mn = hn ? 0.5f : 0.f;
    const f32x4 m0 = *(const f32x4*)(mu + col), m1 = *(const f32x4*)(mu + col + 4);
#pragma unroll
    for (int j = 0; j < 8; ++j) out[j] = x[j] + (j < 4 ? m0[j & 3] : m1[j & 3]) * (mp * p[j] + mn * n[j] - x[j]);
}
__device__ __forceinline__ void load8_shift_l(const bf16_t* u, long row, int t, int T, int col, const LAS float* mu8, float* out) {
    float x[8], p[8], n[8];
    const bool hp = t > 0, hn = t < T - 1;
    const u32x4 wx = *(const u32x4*)(u + row * RWC + col), wp = *(const u32x4*)(u + (row - (hp ? 1 : 0)) * RWC + col), wn = *(const u32x4*)(u + (row + (hn ? 1 : 0)) * RWC + col);
    unpack8(wx, x); unpack8(wp, p); unpack8(wn, n);
    const float mp = hp ? 0.5f : 0.f, mn = hn ? 0.5f : 0.f;
    const f32x4 m0 = *(const LAS f32x4*)(mu8), m1 = *(const LAS f32x4*)(mu8 + 4);
#pragma unroll
    for (int j = 0; j < 8; ++j) out[j] = x[j] + (j < 4 ? m0[j & 3] : m1[j & 3]) * (mp * p[j] + mn * n[j] - x[j]);
}
namespace rw2 {
constexpr int PT = 72;
constexpr int O_W2T = 0, O_A2T = 9216, O_ZL = 18432, O_AL = 34816, O_XWD = 51200, O_XAD = 60416, O_RING = 18432;
constexpr int O_TA = 69632, O_TB = O_TA + 9216, O_TK = O_TB + 9216, O_TR = O_TK + 9216, O_OUT = 69632;
constexpr int O_BH = 106496, O_KH = O_BH + 9216, O_V = O_KH + 9216, O_TOT = 134144, O_PL = 136192, O_PRM = 137216;
__device__ __forceinline__ s16x4 cv4(f32x4 v) { u32x2 w; w.x = pk2(v[0], v[1]); w.y = pk2(v[2], v[3]); return __builtin_bit_cast(s16x4, w); }
__device__ __forceinline__ f32x4 mm16(s16x4 a, s16x4 b, f32x4 c) { return __builtin_amdgcn_mfma_f32_16x16x16bf16_1k(a, b, c, 0, 0, 0); }
__device__ __forceinline__ f32x4 mm32(bf16x8 a, bf16x8 b, f32x4 c) { return __builtin_amdgcn_mfma_f32_16x16x32_bf16(a, b, c, 0, 0, 0); }
__device__ __forceinline__ f32x4 bf4_to_f(s16x4 s) { const u32x2 w = __builtin_bit_cast(u32x2, s); return (f32x4){bflo(w.x), bfhi(w.x), bflo(w.y), bfhi(w.y)}; }
typedef short v4i16_t __attribute__((ext_vector_type(4)));
__device__ __forceinline__ s16x4 trd(const LAS bf16_t* base, int row0, int col0, int lane) {
    const int g = lane >> 4, i = lane & 15, q = i >> 2, p = i & 3;
    return __builtin_bit_cast(s16x4, __builtin_amdgcn_ds_read_tr16_b64_v4i16((LAS v4i16_t*)(base + (row0 + 4 * g + q) * PT + col0 + 4 * p)));
}
__device__ __forceinline__ float fast_tanh(float x) { return 1.0f - 2.0f * __builtin_amdgcn_rcpf(__builtin_amdgcn_exp2f(2.8853900817779268f * x) + 1.0f); }
}
__device__ __forceinline__ void rwkv_chain2(const Ctx& F, int layer, int b, int h, int d) {
    using namespace rw2;
    PP P = getpp(); unsigned char* ws = P->ws;
    const bf16_t* u = (const bf16_t*)(ws + D_URWKV);
    bf16_t* od = (bf16_t*)(ws + (d ? D_OB : D_OF));
    float* bsc = (float*)(ws + WS_BSC) + (size_t)d * RT * 8;
    LAS unsigned char* L = F.lds;
    LAS bf16_t* w2t = (LAS bf16_t*)(L + O_W2T); LAS bf16_t* a2t = (LAS bf16_t*)(L + O_A2T);
    LAS float* Zl = (LAS float*)(L + O_ZL); LAS float* Al = (LAS float*)(L + O_AL);
    LAS bf16_t* Xwd = (LAS bf16_t*)(L + O_XWD); LAS bf16_t* Xad = (LAS bf16_t*)(L + O_XAD);
    LAS bf16_t* TA = (LAS bf16_t*)(L + O_TA); LAS bf16_t* TB = (LAS bf16_t*)(L + O_TB); LAS bf16_t* TK = (LAS bf16_t*)(L + O_TK); LAS bf16_t* TR = (LAS bf16_t*)(L + O_TR);
    LAS bf16_t* BH = (LAS bf16_t*)(L + O_BH); LAS bf16_t* KH = (LAS bf16_t*)(L + O_KH); LAS bf16_t* Vm = (LAS bf16_t*)(L + O_V);
    LAS float* tot = (LAS float*)(L + O_TOT); LAS float* pLs = (LAS float*)(L + O_PL); LAS float* Out = (LAS float*)(L + O_OUT);
    LAS float* prm = (LAS float*)(L + O_PRM);
    const int tid0 = F.tid, w = F.wave;
    {
        const int tid = tid0;
        const float* mu = P->in[I_MU] + layer * RWC;
        const float* w0 = P->in[I_W0] + (layer * 2 + d) * 512 + h * 64;
        const float* w2 = P->in[I_W2] + (size_t)(layer * 2 + d) * 64 * 512 + h * 64;
        const float* a0 = P->in[I_A0] + (layer * 2 + d) * 512 + h * 64;
        const float* a2 = P->in[I_A2] + (size_t)(layer * 2 + d) * 64 * 512 + h * 64;
        const float* k_k = P->in[I_KK] + layer * 512 + h * 64; const float* k_a = P->in[I_KA] + layer * 512 + h * 64; const float* r_k = P->in[I_RK] + layer * 512 + h * 64;
        for (int i = tid; i < 640; i += NTHREADS) { const int rr = i >> 6, cc = i & 63; float v;
            if (rr == 0) v = mu[h * 64 + cc]; else if (rr == 1) v = mu[512 + h * 64 + cc]; else if (rr == 2) v = mu[1024 + h * 64 + cc]; else if (rr == 3) v = mu[1536 + d * 64 + cc]; else if (rr == 4) v = mu[1664 + d * 64 + cc];
            else if (rr == 5) v = w0[cc]; else if (rr == 6) v = a0[cc]; else if (rr == 7) v = k_k[cc]; else if (rr == 8) v = k_a[cc]; else v = r_k[cc];
            prm[i] = v; }
        for (int i = tid; i < 4096; i += NTHREADS) { const int k = i >> 6, cc = i & 63; w2t[cc * PT + k] = (bf16_t)f2bf(w2[(size_t)k * 512 + cc]); a2t[cc * PT + k] = (bf16_t)f2bf(a2[(size_t)k * 512 + cc]); }
    }
    f32x4 Z[4];
#pragma unroll
    for (int j = 0; j < 4; ++j) Z[j] = (f32x4){0.f, 0.f, 0.f, 0.f};
    __syncthreads();
    for (int seq = 0; seq < 2; ++seq) {
        const int T = seq ? SEQ : CTXL; const long rbase = seq ? (long)b * SEQ : (long)RL + b * CTXL; const int nch = T / 64;
        for (int ci = 0; ci < nch; ++ci) {
            int tid = tid0; asm volatile("" : "+v"(tid));
            const int lane = tid & 63, fr = lane & 15, fq = lane >> 4, tt = tid >> 3, c8 = (tid & 7) * 8;
            const int tpos = d ? (T - 1 - (ci * 64 + tt)) : (ci * 64 + tt); const long row = rbase + tpos;
            float r[8], k[8], kk[8], av[8], kd[8], lw[8];
            {
                float v[8], x[8];
                load8_shift_l(u, row, tpos, T, h * 64 + c8, prm + c8, r);
                load8_shift_l(u, row, tpos, T, 512 + h * 64 + c8, prm + 64 + c8, k);
                load8_shift_l(u, row, tpos, T, 1024 + h * 64 + c8, prm + 128 + c8, v);
                *(LAS u32x4*)(Vm + tt * PT + c8) = pack8(v);
                load8_shift_l(u, row, tpos, T, 1536 + d * 64 + c8, prm + 192 + c8, x);
#pragma unroll
                for (int e = 0; e < 8; ++e) x[e] = fast_tanh(x[e]);
                *(LAS u32x4*)(Xwd + tt * PT + c8) = pack8(x);
                load8_shift_l(u, row, tpos, T, 1664 + d * 64 + c8, prm + 256 + c8, x);
                *(LAS u32x4*)(Xad + tt * PT + c8) = pack8(x);
            }
            __syncthreads();
            {
#pragma unroll
                for (int q = 0; q < 2; ++q) { const int id = 2 * w + q, tm = id >> 2, tn = id & 3;
                    f32x4 az = {0.f, 0.f, 0.f, 0.f}, aa = {0.f, 0.f, 0.f, 0.f};
#pragma unroll
                    for (int ks = 0; ks < 2; ++ks) {
                        az = mm32(*(const LAS bf16x8*)(Xwd + (16 * tm + fr) * PT + ks * 32 + fq * 8), *(const LAS bf16x8*)(w2t + (16 * tn + fr) * PT + ks * 32 + fq * 8), az);
                        aa = mm32(*(const LAS bf16x8*)(Xad + (16 * tm + fr) * PT + ks * 32 + fq * 8), *(const LAS bf16x8*)(a2t + (16 * tn + fr) * PT + ks * 32 + fq * 8), aa); }
#pragma unroll
                    for (int e = 0; e < 4; ++e) { Zl[(16 * tm + 4 * fq + e) * 64 + 16 * tn + fr] = az[e]; Al[(16 * tm + 4 * fq + e) * 64 + 16 * tn + fr] = aa[e]; } }
            }
            __syncthreads();
            {
                float ss = 0.f, bs = 0.f;
#pragma unroll
                for (int e = 0; e < 8; ++e) { kk[e] = k[e] * prm[448 + c8 + e]; ss += kk[e] * kk[e]; }
                ss += shx(ss, 1, lane); ss += shx(ss, 2, lane); ss += shx(ss, 4, lane);
                const float inv = __builtin_amdgcn_rsqf(fmaxf(ss, 1e-24f));
#pragma unroll
                for (int e = 0; e < 8; ++e) {
                    kk[e] *= inv;
                    const float z = Zl[tt * 64 + c8 + e] + prm[320 + c8 + e];
                    lw[e] = -sigmoidf_(z) * 0.8750612633917001f;
                    av[e] = sigmoidf_(Al[tt * 64 + c8 + e] + prm[384 + c8 + e]);
                    kd[e] = k[e] * (1.0f + (av[e] - 1.0f) * prm[512 + c8 + e]);
                    bs += r[e] * kd[e] * prm[576 + c8 + e];
                }
                bs += shx(bs, 1, lane); bs += shx(bs, 2, lane); bs += shx(bs, 4, lane);
                if ((tid & 7) == 0) bsc[(size_t)row * 8 + h] = bs;
            }
            float cum[8];
            {
#pragma unroll
                for (int e = 0; e < 8; ++e) cum[e] = lw[e];
#pragma unroll
                for (int off = 8; off < 64; off <<= 1) {
#pragma unroll
                    for (int e = 0; e < 8; ++e) { const float t = __int_as_float(__builtin_amdgcn_ds_bpermute(((lane - off) & 63) << 2, __float_as_int(cum[e]))); cum[e] += (lane >= off) ? t : 0.f; } }
                if (lane >= 56) {
#pragma unroll
                    for (int e = 0; e < 8; ++e) tot[w * 64 + c8 + e] = cum[e]; }
            }
            __syncthreads();
            {
                float ta[8], tb[8], tk[8], tr[8], bh[8], kh[8];
                const int w0i = (w & ~1) * 64 + c8;
#pragma unroll
                for (int e = 0; e < 8; ++e) {
                    const float t0 = tot[w0i + e], t1 = tot[w0i + 64 + e];
                    const float cm = cum[e] + ((w & 1) ? t0 : 0.f), cumL = t0 + t1;
                    const float e1 = __builtin_amdgcn_exp2f(cm - lw[e]), e2 = __builtin_amdgcn_exp2f(-cm), e3 = __builtin_amdgcn_exp2f(cm), e4 = __builtin_amdgcn_exp2f(cumL - cm);
                    const float ka = kk[e] * av[e];
                    ta[e] = -kk[e] * e1; tb[e] = ka * e2; tk[e] = kd[e] * e2; tr[e] = r[e] * e3; bh[e] = ka * e4; kh[e] = kd[e] * e4;
                    if ((tt & 15) == 15) pLs[(tt >> 4) * 64 + c8 + e] = e3;
                }
                *(LAS u32x4*)(TA + tt * PT + c8) = pack8(ta); *(LAS u32x4*)(TB + tt * PT + c8) = pack8(tb); *(LAS u32x4*)(TK + tt * PT + c8) = pack8(tk); *(LAS u32x4*)(TR + tt * PT + c8) = pack8(tr);
                *(LAS u32x4*)(BH + tt * PT + c8) = pack8(bh); *(LAS u32x4*)(KH + tt * PT + c8) = pack8(kh);
            }
            __syncthreads();
            if (w < 4) {
                const int s = w; const int rowf = (16 * s + fr) * PT;
                f32x4 Mab = {0.f, 0.f, 0.f, 0.f}, MabT = Mab, MakT = Mab, Mbr = Mab, Mkr = Mab;
#pragma unroll
                for (int ks = 0; ks < 2; ++ks) { const int o = rowf + ks * 32 + fq * 8;
                    const bf16x8 fa = *(const LAS bf16x8*)(TA + o), fb = *(const LAS bf16x8*)(TB + o), fk = *(const LAS bf16x8*)(TK + o), frr = *(const LAS bf16x8*)(TR + o);
                    Mab = mm32(fb, fa, Mab); MabT = mm32(fa, fb, MabT); MakT = mm32(fa, fk, MakT); Mbr = mm32(fb, frr, Mbr); Mkr = mm32(fk, frr, Mkr); }
                f32x4 Pm, Pt;
#pragma unroll
                for (int e = 0; e < 4; ++e) { const int m = 4 * fq + e, n = fr;
                    Mab[e] = (m < n) ? Mab[e] : 0.f; MabT[e] = (n < m) ? MabT[e] : 0.f; MakT[e] = (n < m) ? MakT[e] : 0.f; Mbr[e] = (m <= n) ? Mbr[e] : 0.f; Mkr[e] = (m <= n) ? Mkr[e] : 0.f;
                    const float id = (m == n) ? 1.f : 0.f; Pm[e] = Mab[e] + id; Pt[e] = MabT[e] + id; }
                f32x4 Nn = Mab, Nt = MabT; const f32x4 zero = {0.f, 0.f, 0.f, 0.f};
#pragma unroll
                for (int it = 0; it < 3; ++it) {
                    const s16x4 cn = cv4(Nn), cnt = cv4(Nt);
                    const f32x4 N2 = mm16(cnt, cn, zero), Nt2 = mm16(cn, cnt, zero);
                    const s16x4 cp = cv4(Pm), cpt = cv4(Pt), cn2 = cv4(N2);
                    const f32x4 Pn = mm16(cpt, cn2, Pm), Ptn = mm16(cn2, cpt, Pt);
                    Nn = N2; Nt = Nt2; Pm = Pn; Pt = Ptn; (void)cp;
                }
                const s16x4 cT = cv4(Pm), cMakT = cv4(MakT), cMbr = cv4(Mbr);
                const f32x4 Q1T = mm16(cT, cMakT, zero);
                const s16x4 cQ1T = cv4(Q1T);
                const f32x4 Hy = mm16(cQ1T, cMbr, Mkr);
                LAS unsigned char* ring = L + O_RING + s * 12800 + lane * 8;
                *(LAS s16x4*)(ring + 20 * 512) = cv4(Hy);
                s16x4 bhf[4];
#pragma unroll
                for (int jt = 0; jt < 4; ++jt) bhf[jt] = trd(BH, 16 * s, 16 * jt, lane);
#pragma unroll
                for (int jt = 0; jt < 4; ++jt) {
                    const s16x4 atf = trd(TA, 16 * s, 16 * jt, lane);
                    const f32x4 P1T = mm16(cT, atf, zero); const s16x4 cP1T = cv4(P1T);
                    const f32x4 rinit = bf4_to_f(*(const LAS s16x4*)(TR + (16 * s + fr) * PT + 16 * jt + 4 * fq));
                    const f32x4 Gy = mm16(cP1T, cMbr, rinit);
                    *(LAS s16x4*)(ring + jt * 512) = cv4(Gy);
#pragma unroll
                    for (int j2 = 0; j2 < 4; ++j2) { const f32x4 Gs = mm16(cP1T, bhf[j2], zero); *(LAS s16x4*)(ring + (4 + jt * 4 + j2) * 512) = cv4(Gs); }
                    const f32x4 kinit = bf4_to_f(trd(KH, 16 * s, 16 * jt, lane));
                    const f32x4 Hs = mm16(cQ1T, bhf[jt], kinit);
                    *(LAS s16x4*)(ring + (21 + jt) * 512) = cv4(Hs);
                }
            }
            __syncthreads();
            if (w < 4) {
                const int it = w;
#pragma unroll 1
                for (int s = 0; s < 4; ++s) {
                    const LAS unsigned char* ring = L + O_RING + s * 12800 + lane * 8;
                    const s16x4 vb = trd(Vm, 16 * s, 16 * it, lane);
                    s16x4 zb[4];
#pragma unroll
                    for (int jt = 0; jt < 4; ++jt) zb[jt] = cv4(Z[jt]);
                    f32x4 Yt = mm16(*(const LAS s16x4*)(ring + 20 * 512), vb, (f32x4){0.f, 0.f, 0.f, 0.f});
#pragma unroll
                    for (int jt = 0; jt < 4; ++jt) Yt = mm16(*(const LAS s16x4*)(ring + jt * 512), zb[jt], Yt);
#pragma unroll
                    for (int e = 0; e < 4; ++e) Out[(16 * s + 4 * fq + e) * 64 + 16 * it + fr] = Yt[e];
                    f32x4 Zn[4];
#pragma unroll
                    for (int j2 = 0; j2 < 4; ++j2) {
                        const f32x4 pv = *(const LAS f32x4*)(pLs + s * 64 + 16 * j2 + 4 * fq);
                        f32x4 zn = Z[j2] * pv;
                        zn = mm16(*(const LAS s16x4*)(ring + (21 + j2) * 512), vb, zn);
#pragma unroll
                        for (int jt = 0; jt < 4; ++jt) zn = mm16(*(const LAS s16x4*)(ring + (4 + jt * 4 + j2) * 512), zb[jt], zn);
                        Zn[j2] = zn;
                    }
#pragma unroll
                    for (int j2 = 0; j2 < 4; ++j2) Z[j2] = Zn[j2];
                }
            }
            __syncthreads();
            {
                float v[8];
#pragma unroll
                for (int e = 0; e < 8; ++e) v[e] = Out[tt * 64 + c8 + e];
                *(u32x4*)(od + (size_t)row * 512 + h * 64 + c8) = pack8(v);
            }
            __syncthreads();
        }
    }
}

namespace rw4 {
using namespace rw2;
constexpr int RGN = 16384, R_TA = 0, R_TB = 2304, R_TK = 4608, R_TR = 6912, R_BH = 9216, R_KH = 11520, R_V = 13824, R_PL = 16128;
constexpr int R_XWD = 0, R_XAD = 2304, R_ZL = 4608, R_AL = 8704;
constexpr int O_PRM4 = 8 * RGN;
}
__device__ __forceinline__ void rwkv_chain4(const Ctx& F, int layer, int b, int h, int d) {
    using namespace rw4;
    PP P = getpp(); unsigned char* ws = P->ws;
    const bf16_t* u = (const bf16_t*)(ws + D_URWKV);
    bf16_t* od = (bf16_t*)(ws + (d ? D_OB : D_OF));
    float* bsc = (float*)(ws + WS_BSC) + (size_t)d * RT * 8;
    const bf16_t* w2g = (const bf16_t*)(ws + WS_W2T) + (size_t)((layer * 2 + d) * 2 + 0) * 512 * 64 + (size_t)h * 64 * 64;
    const bf16_t* a2g = (const bf16_t*)(ws + WS_W2T) + (size_t)((layer * 2 + d) * 2 + 1) * 512 * 64 + (size_t)h * 64 * 64;
    LAS unsigned char* L = F.lds;
    LAS float* prm = (LAS float*)(L + O_PRM4);
    volatile LAS unsigned* rdy = (volatile LAS unsigned*)(L + O_PRM4 + 2560); LAS unsigned* dne = (LAS unsigned*)(L + O_PRM4 + 2560 + 64);
    unsigned gseq = 0;
    const int tid0 = F.tid, w = F.wave;
    {
        const float* mu = P->in[I_MU] + layer * RWC;
        const float* w0 = P->in[I_W0] + (layer * 2 + d) * 512 + h * 64; const float* a0 = P->in[I_A0] + (layer * 2 + d) * 512 + h * 64;
        const float* k_k = P->in[I_KK] + layer * 512 + h * 64; const float* k_a = P->in[I_KA] + layer * 512 + h * 64; const float* r_k = P->in[I_RK] + layer * 512 + h * 64;
        for (int i = tid0; i < 640; i += NTHREADS) { const int rr = i >> 6, cc = i & 63; float v;
            if (rr == 0) v = mu[h * 64 + cc]; else if (rr == 1) v = mu[512 + h * 64 + cc]; else if (rr == 2) v = mu[1024 + h * 64 + cc]; else if (rr == 3) v = mu[1536 + d * 64 + cc]; else if (rr == 4) v = mu[1664 + d * 64 + cc];
            else if (rr == 5) v = w0[cc]; else if (rr == 6) v = a0[cc]; else if (rr == 7) v = k_k[cc]; else if (rr == 8) v = k_a[cc]; else v = r_k[cc];
            prm[i] = v; }
        if (tid0 < 8) { rdy[tid0] = 0u; dne[tid0] = 0u; }
    }
    f32x4 Z[4];
#pragma unroll
    for (int j = 0; j < 4; ++j) Z[j] = (f32x4){0.f, 0.f, 0.f, 0.f};
    u32x4 raw[2][5][3];
#define RW4_PREFETCH(T_, rbase_, gi_) do { int t0_ = tid0; asm volatile("" : "+v"(t0_)); const int lane_ = t0_ & 63, tk_ = lane_ >> 2, cg_ = lane_ & 3; const int pi_ = (gi_) * 128 + 16 * w + tk_; const int tp_ = d ? ((T_) - 1 - pi_) : pi_; \
        const long row_ = (rbase_) + tp_; const long rp_ = row_ - (tp_ > 0 ? 1 : 0), rn_ = row_ + (tp_ < (T_) - 1 ? 1 : 0); \
        _Pragma("unroll") for (int q_ = 0; q_ < 2; ++q_) _Pragma("unroll") for (int g_ = 0; g_ < 5; ++g_) { \
            const int col_ = (g_ == 0 ? h * 64 : g_ == 1 ? 512 + h * 64 : g_ == 2 ? 1024 + h * 64 : g_ == 3 ? 1536 + d * 64 : 1664 + d * 64) + q_ * 32 + cg_ * 8; \
            raw[q_][g_][0] = *(const u32x4*)(u + row_ * RWC + col_); raw[q_][g_][1] = *(const u32x4*)(u + rp_ * RWC + col_); raw[q_][g_][2] = *(const u32x4*)(u + rn_ * RWC + col_); } } while (0)
    RW4_PREFETCH(CTXL, (long)RL + b * CTXL, 0);
    __syncthreads();
    for (int seq = 0; seq < 2; ++seq) {
        const int T = seq ? SEQ : CTXL; const long rbase = seq ? (long)b * SEQ : (long)RL + b * CTXL; const int ngr = T / 128;
        for (int gi = 0; gi < ngr; ++gi) {
            int tid = tid0; asm volatile("" : "+v"(tid));
            const int lane = tid & 63, fr = lane & 15, fq = lane >> 4, tk = lane >> 2, cg = lane & 3;
            LAS unsigned char* R = L + w * RGN;
            { unsigned sp = 0; while (*(volatile LAS unsigned*)(dne + w) != 4u * gseq) { __builtin_amdgcn_s_sleep(1); if (++sp > (1u << 24)) break; } }
            asm volatile("" ::: "memory");
            {
                const int pi = gi * 128 + 16 * w + tk; const int tpos = d ? (T - 1 - pi) : pi; const long row = rbase + tpos;
                float r[16], k[16], kk[16], av[16], kd[16], lw[16];
                {
                    const float mp = (tpos > 0) ? 0.5f : 0.f, mn = (tpos < T - 1) ? 0.5f : 0.f;
#pragma unroll
                    for (int q = 0; q < 2; ++q) { const int c8 = q * 32 + cg * 8;
#pragma unroll
                        for (int g5 = 0; g5 < 5; ++g5) {
                            float x[8], p[8], n[8], o[8];
                            unpack8(raw[q][g5][0], x); unpack8(raw[q][g5][1], p); unpack8(raw[q][g5][2], n);
                            const f32x4 m0 = *(const LAS f32x4*)(prm + g5 * 64 + c8), m1 = *(const LAS f32x4*)(prm + g5 * 64 + c8 + 4);
#pragma unroll
                            for (int j = 0; j < 8; ++j) o[j] = x[j] + (j < 4 ? m0[j & 3] : m1[j & 3]) * (mp * p[j] + mn * n[j] - x[j]);
                            if (g5 == 0) {
#pragma unroll
                                for (int j = 0; j < 8; ++j) r[8 * q + j] = o[j]; }
                            else if (g5 == 1) {
#pragma unroll
                                for (int j = 0; j < 8; ++j) k[8 * q + j] = o[j]; }
                            else if (g5 == 2) *(LAS u32x4*)(R + R_V + (tk * PT + c8) * 2) = pack8(o);
                            else if (g5 == 3) {
#pragma unroll
                                for (int j = 0; j < 8; ++j) o[j] = fast_tanh(o[j]);
                                *(LAS u32x4*)(R + R_XWD + (tk * PT + c8) * 2) = pack8(o); }
                            else *(LAS u32x4*)(R + R_XAD + (tk * PT + c8) * 2) = pack8(o);
                        } }
                }
                {
                    const LAS bf16_t* Xwd = (const LAS bf16_t*)(R + R_XWD); const LAS bf16_t* Xad = (const LAS bf16_t*)(R + R_XAD);
                    LAS float* Zl = (LAS float*)(R + R_ZL); LAS float* Al = (LAS float*)(R + R_AL);
                    bf16x8 fw[2], fa[2];
#pragma unroll
                    for (int ks = 0; ks < 2; ++ks) { fw[ks] = *(const LAS bf16x8*)(Xwd + fr * PT + ks * 32 + fq * 8); fa[ks] = *(const LAS bf16x8*)(Xad + fr * PT + ks * 32 + fq * 8); }
#pragma unroll
                    for (int tn = 0; tn < 4; ++tn) { f32x4 az = {0.f, 0.f, 0.f, 0.f}, aa = {0.f, 0.f, 0.f, 0.f};
#pragma unroll
                        for (int ks = 0; ks < 2; ++ks) { az = mm32(fw[ks], *(const bf16x8*)(w2g + (16 * tn + fr) * 64 + ks * 32 + fq * 8), az); aa = mm32(fa[ks], *(const bf16x8*)(a2g + (16 * tn + fr) * 64 + ks * 32 + fq * 8), aa); }
#pragma unroll
                        for (int e = 0; e < 4; ++e) { Zl[(4 * fq + e) * 64 + 16 * tn + fr] = az[e]; Al[(4 * fq + e) * 64 + 16 * tn + fr] = aa[e]; } }
                }
                {
                    const LAS float* Zl = (const LAS float*)(R + R_ZL); const LAS float* Al = (const LAS float*)(R + R_AL);
                    float ss = 0.f, bs = 0.f;
                    float pkk[16], pw0[16], pa0[16], pka[16], prk[16], zz[16], aa2[16];
#pragma unroll
                    for (int q = 0; q < 2; ++q) { const int c8 = q * 32 + cg * 8;
#pragma unroll
                        for (int hh = 0; hh < 2; ++hh) { const int o4 = c8 + 4 * hh, i4 = 8 * q + 4 * hh;
                            const f32x4 a = *(const LAS f32x4*)(prm + 448 + o4), b2 = *(const LAS f32x4*)(prm + 320 + o4), c = *(const LAS f32x4*)(prm + 384 + o4), d2 = *(const LAS f32x4*)(prm + 512 + o4), e2 = *(const LAS f32x4*)(prm + 576 + o4);
                            const f32x4 z4 = *(const LAS f32x4*)(Zl + tk * 64 + o4), a4 = *(const LAS f32x4*)(Al + tk * 64 + o4);
#pragma unroll
                            for (int j = 0; j < 4; ++j) { pkk[i4 + j] = a[j]; pw0[i4 + j] = b2[j]; pa0[i4 + j] = c[j]; pka[i4 + j] = d2[j]; prk[i4 + j] = e2[j]; zz[i4 + j] = z4[j]; aa2[i4 + j] = a4[j]; } } }
#pragma unroll
                    for (int i = 0; i < 16; ++i) { kk[i] = k[i] * pkk[i]; ss += kk[i] * kk[i]; }
                    ss += shx(ss, 1, lane); ss += shx(ss, 2, lane);
                    const float inv = __builtin_amdgcn_rsqf(fmaxf(ss, 1e-24f));
#pragma unroll
                    for (int i = 0; i < 16; ++i) {
                        kk[i] *= inv;
                        lw[i] = -sigmoidf_(zz[i] + pw0[i]) * 0.8750612633917001f;
                        av[i] = sigmoidf_(aa2[i] + pa0[i]);
                        kd[i] = k[i] * (1.0f + (av[i] - 1.0f) * pka[i]);
                        bs += r[i] * kd[i] * prk[i]; }
                    bs += shx(bs, 1, lane); bs += shx(bs, 2, lane);
                    if (cg == 0) bsc[(size_t)row * 8 + h] = bs;
                }
                float cum[16], cumL[16];
                {
                    LAS float* Sc = (LAS float*)(R + R_ZL);
#pragma unroll
                    for (int q = 0; q < 2; ++q) { *(LAS f32x4*)(Sc + tk * 64 + q * 32 + cg * 8) = (f32x4){lw[8 * q], lw[8 * q + 1], lw[8 * q + 2], lw[8 * q + 3]}; *(LAS f32x4*)(Sc + tk * 64 + q * 32 + cg * 8 + 4) = (f32x4){lw[8 * q + 4], lw[8 * q + 5], lw[8 * q + 6], lw[8 * q + 7]}; }
                    float a = 0.f;
#pragma unroll
                    for (int t = 0; t < 16; ++t) { a += Sc[t * 64 + lane]; Sc[t * 64 + lane] = a; }
#pragma unroll
                    for (int q = 0; q < 2; ++q) { const f32x4 c0 = *(const LAS f32x4*)(Sc + tk * 64 + q * 32 + cg * 8), c1 = *(const LAS f32x4*)(Sc + tk * 64 + q * 32 + cg * 8 + 4);
                        const f32x4 l0 = *(const LAS f32x4*)(Sc + 15 * 64 + q * 32 + cg * 8), l1 = *(const LAS f32x4*)(Sc + 15 * 64 + q * 32 + cg * 8 + 4);
#pragma unroll
                        for (int e = 0; e < 4; ++e) { cum[8 * q + e] = c0[e]; cum[8 * q + 4 + e] = c1[e]; cumL[8 * q + e] = l0[e]; cumL[8 * q + 4 + e] = l1[e]; } }
                }
                {
#pragma unroll
                    for (int q = 0; q < 2; ++q) { float ta[8], tb[8], tkk[8], tr[8], bh[8], kh[8], plv[8]; const int c8 = q * 32 + cg * 8;
#pragma unroll
                        for (int e = 0; e < 8; ++e) { const int i = 8 * q + e;
                            const float e3 = __builtin_amdgcn_exp2f(cum[i]), e2 = __builtin_amdgcn_rcpf(e3), e1 = __builtin_amdgcn_exp2f(cum[i] - lw[i]), e4 = __builtin_amdgcn_exp2f(cumL[i] - cum[i]);
                            const float ka = kk[i] * av[i];
                            ta[e] = -kk[i] * e1; tb[e] = ka * e2; tkk[e] = kd[i] * e2; tr[e] = r[i] * e3; bh[e] = ka * e4; kh[e] = kd[i] * e4;
                            plv[e] = e3; }
                        *(LAS u32x4*)(R + R_TA + (tk * PT + c8) * 2) = pack8(ta); *(LAS u32x4*)(R + R_TB + (tk * PT + c8) * 2) = pack8(tb); *(LAS u32x4*)(R + R_TK + (tk * PT + c8) * 2) = pack8(tkk);
                        *(LAS u32x4*)(R + R_TR + (tk * PT + c8) * 2) = pack8(tr); *(LAS u32x4*)(R + R_BH + (tk * PT + c8) * 2) = pack8(bh); *(LAS u32x4*)(R + R_KH + (tk * PT + c8) * 2) = pack8(kh);
                        if (tk == 15) { LAS float* pp = (LAS float*)(R + R_PL) + c8; *(LAS f32x4*)pp = (f32x4){plv[0], plv[1], plv[2], plv[3]}; *(LAS f32x4*)(pp + 4) = (f32x4){plv[4], plv[5], plv[6], plv[7]}; } }
                }
                {
                    const LAS bf16_t* TA = (const LAS bf16_t*)(R + R_TA); const LAS bf16_t* TB = (const LAS bf16_t*)(R + R_TB); const LAS bf16_t* TK = (const LAS bf16_t*)(R + R_TK);
                    const LAS bf16_t* TR = (const LAS bf16_t*)(R + R_TR); const LAS bf16_t* BH = (const LAS bf16_t*)(R + R_BH); const LAS bf16_t* KH = (const LAS bf16_t*)(R + R_KH);
                    f32x4 Mab = {0.f, 0.f, 0.f, 0.f}, MabT = Mab, MakT = Mab, Mbr = Mab, Mkr = Mab;
#pragma unroll
                    for (int ks = 0; ks < 2; ++ks) { const int o = fr * PT + ks * 32 + fq * 8;
                        const bf16x8 fa = *(const LAS bf16x8*)(TA + o), fb = *(const LAS bf16x8*)(TB + o), fk = *(const LAS bf16x8*)(TK + o), frr = *(const LAS bf16x8*)(TR + o);
                        Mab = mm32(fb, fa, Mab); MabT = mm32(fa, fb, MabT); MakT = mm32(fa, fk, MakT); Mbr = mm32(fb, frr, Mbr); Mkr = mm32(fk, frr, Mkr); }
                    s16x4 bhf[4], atf[4], rin[4], kin[4];
#pragma unroll
                    for (int jt = 0; jt < 4; ++jt) { bhf[jt] = trd(BH, 0, 16 * jt, lane); atf[jt] = trd(TA, 0, 16 * jt, lane); kin[jt] = trd(KH, 0, 16 * jt, lane); rin[jt] = *(const LAS s16x4*)(TR + fr * PT + 16 * jt + 4 * fq); }
                    f32x4 Pm, Pt;
#pragma unroll
                    for (int e = 0; e < 4; ++e) { const int m = 4 * fq + e, n = fr;
                        Mab[e] = (m < n) ? Mab[e] : 0.f; MabT[e] = (n < m) ? MabT[e] : 0.f; MakT[e] = (n < m) ? MakT[e] : 0.f; Mbr[e] = (m <= n) ? Mbr[e] : 0.f; Mkr[e] = (m <= n) ? Mkr[e] : 0.f;
                        const float id = (m == n) ? 1.f : 0.f; Pm[e] = Mab[e] + id; Pt[e] = MabT[e] + id; }
                    f32x4 Nn = Mab, Nt = MabT; const f32x4 zero = {0.f, 0.f, 0.f, 0.f};
#pragma unroll
                    for (int it = 0; it < 3; ++it) {
                        const s16x4 cn = cv4(Nn), cnt = cv4(Nt);
                        const f32x4 N2 = mm16(cnt, cn, zero), Nt2 = mm16(cn, cnt, zero);
                        const s16x4 cpt = cv4(Pt), cn2 = cv4(N2);
                        const f32x4 Pn = mm16(cpt, cn2, Pm), Ptn = mm16(cn2, cpt, Pt);
                        Nn = N2; Nt = Nt2; Pm = Pn; Pt = Ptn;
                    }
                    const s16x4 cT = cv4(Pm), cMakT = cv4(MakT), cMbr = cv4(Mbr);
                    const f32x4 Q1T = mm16(cT, cMakT, zero);
                    const s16x4 cQ1T = cv4(Q1T);
                    const f32x4 Hy = mm16(cQ1T, cMbr, Mkr);
                    asm volatile("s_waitcnt lgkmcnt(0)" ::: "memory");
                    LAS unsigned char* ring = R + lane * 8;
                    *(LAS s16x4*)(ring + 20 * 512) = cv4(Hy);
#pragma unroll
                    for (int jt = 0; jt < 4; ++jt) {
                        const f32x4 P1T = mm16(cT, atf[jt], zero); const s16x4 cP1T = cv4(P1T);
                        const f32x4 Gy = mm16(cP1T, cMbr, bf4_to_f(rin[jt]));
                        *(LAS s16x4*)(ring + jt * 512) = cv4(Gy);
#pragma unroll
                        for (int j2 = 0; j2 < 4; ++j2) { const f32x4 Gs = mm16(cP1T, bhf[j2], zero); *(LAS s16x4*)(ring + (4 + jt * 4 + j2) * 512) = cv4(Gs); }
                        const f32x4 Hs = mm16(cQ1T, bhf[jt], bf4_to_f(kin[jt]));
                        *(LAS s16x4*)(ring + (21 + jt) * 512) = cv4(Hs);
                    }
                }
            }
            {
                const bool more = gi + 1 < ngr; const bool nseq = !more && seq == 0;
                const int nT = nseq ? SEQ : T; const long nrb = nseq ? (long)b * SEQ : rbase; const int ngi = more ? gi + 1 : (nseq ? 0 : gi);
                RW4_PREFETCH(nT, nrb, ngi);
            }
            ++gseq;
            asm volatile("s_waitcnt lgkmcnt(0)" ::: "memory");
            if (lane == 0) rdy[w] = gseq;
            asm volatile("" ::: "memory");
            if (w < 4) {
                const int it = w;
#pragma unroll 1
                for (int s = 0; s < 8; ++s) {
                    { unsigned sp = 0; while (rdy[s] != gseq) { __builtin_amdgcn_s_sleep(1); if (++sp > (1u << 24)) break; } }
                    asm volatile("" ::: "memory");
                    const LAS unsigned char* Rs = L + s * RGN; const LAS unsigned char* ring = Rs + lane * 8;
                    const s16x4 vb = trd((const LAS bf16_t*)(Rs + R_V), 0, 16 * it, lane);
                    s16x4 zb[4];
#pragma unroll
                    for (int jt = 0; jt < 4; ++jt) zb[jt] = cv4(Z[jt]);
                    f32x4 Yt = mm16(*(const LAS s16x4*)(ring + 20 * 512), vb, (f32x4){0.f, 0.f, 0.f, 0.f});
#pragma unroll
                    for (int jt = 0; jt < 4; ++jt) Yt = mm16(*(const LAS s16x4*)(ring + jt * 512), zb[jt], Yt);
#pragma unroll
                    for (int e = 0; e < 4; ++e) { const int pi = gi * 128 + 16 * s + 4 * fq + e; const int tp = d ? (T - 1 - pi) : pi;
                        od[(size_t)(rbase + tp) * 512 + h * 64 + 16 * it + fr] = (bf16_t)f2bf(Yt[e]); }
                    f32x4 Zn[4];
#pragma unroll
                    for (int j2 = 0; j2 < 4; ++j2) {
                        const f32x4 pv = *(const LAS f32x4*)((const LAS float*)(Rs + R_PL) + 16 * j2 + 4 * fq);
                        f32x4 zn = Z[j2] * pv;
                        zn = mm16(*(const LAS s16x4*)(ring + (21 + j2) * 512), vb, zn);
#pragma unroll
                        for (int jt = 0; jt < 4; ++jt) zn = mm16(*(const LAS s16x4*)(ring + (4 + jt * 4 + j2) * 512), zb[jt], zn);
                        Zn[j2] = zn;
                    }
#pragma unroll
                    for (int j2 = 0; j2 < 4; ++j2) Z[j2] = Zn[j2];
                    asm volatile("s_waitcnt lgkmcnt(0)" ::: "memory");
                    if (lane == 0) (void)__hip_atomic_fetch_add(dne + s, 1u, __ATOMIC_RELAXED, __HIP_MEMORY_SCOPE_WORKGROUP);
                }
            }
        }
    }
#undef RW4_PREFETCH
}

__device__ __forceinline__ void rwkv_post_phase(const Ctx& F, int layer, int nrows_y) {
    PP P = getpp(); unsigned char* ws = P->ws;
    const bf16_t* u = (const bf16_t*)(ws + D_URWKV); const bf16_t* of = (const bf16_t*)(ws + D_OF); const bf16_t* ob = (const bf16_t*)(ws + D_OB);
    bf16_t* y = (bf16_t*)(ws + D_YRWKV);
    const float* bf_ = (const float*)(ws + WS_BSC); const float* bb_ = bf_ + (size_t)RT * 8;
    const float* mu = P->in[I_MU] + layer * RWC; const float* lng = P->in[I_LNG] + layer * 512; const float* lnb = P->in[I_LNB] + layer * 512;
    const bf16_t* wg2 = (const bf16_t*)(ws + WS_WG2) + (size_t)layer * 512 * 128;
    LAS bf16_t* sg = (LAS bf16_t*)F.lds;
    LAS bf16_t* gt = (LAS bf16_t*)(F.lds + 64 * 136 * 2);
    const int tid0 = F.tid, wave = F.wave; const int lane = F.lane;
    const int nunits = nrows_y / 64;
    for (int un = F.bid; un < nunits; un += F.G) {
        int tid = tid0; asm volatile("" : "+v"(tid)); const int lane = tid & 63;
        const long r0 = (long)un * 64; const bool lat = r0 < RL; const int T = lat ? SEQ : CTXL; const int tbase = lat ? (int)(r0 & (SEQ - 1)) : (int)((r0 - RL) & (CTXL - 1));
        for (int it = tid; it < 1024; it += NTHREADS) { const int tk = it >> 4, q = it & 15; float v[8]; load8_shift(u, r0 + tk, tbase + tk, T, 1792 + q * 8, mu, v);
#pragma unroll
            for (int j = 0; j < 8; ++j) v[j] = sigmoidf_(v[j]);
            *(LAS u32x4*)(sg + tk * 136 + q * 8) = pack8(v); }
        __syncthreads();
        {
            const int fr = lane & 15, fq = lane >> 4;
#pragma unroll
            for (int tn = 0; tn < 4; ++tn) { const int cn = (wave * 4 + tn) * 16;
                bf16x8 bfrag[4];
#pragma unroll
                for (int k = 0; k < 4; ++k) bfrag[k] = *(const bf16x8*)(wg2 + (size_t)(cn + fr) * 128 + k * 32 + fq * 8);
#pragma unroll
                for (int tm = 0; tm < 4; ++tm) { f32x4 acc = {0.f, 0.f, 0.f, 0.f};
#pragma unroll
                    for (int k = 0; k < 4; ++k) { const bf16x8 afrag = *(const LAS bf16x8*)(sg + (tm * 16 + fr) * 136 + k * 32 + fq * 8); acc = __builtin_amdgcn_mfma_f32_16x16x32_bf16(afrag, bfrag[k], acc, 0, 0, 0); }
#pragma unroll
                    for (int j = 0; j < 4; ++j) gt[(tm * 16 + fq * 4 + j) * 520 + cn + fr] = (bf16_t)f2bf(acc[j]); } }
        }
        __syncthreads();
        {
            const int tk = tid >> 3, hh = tid & 7; const long row = r0 + tk; const int t = tbase + tk;
            const float bsum = bf_[row * 8 + hh] + bb_[row * 8 + hh];
            float o[64]; float s = 0.f;
#pragma unroll
            for (int q = 0; q < 8; ++q) { float a[8], c[8]; unpack8(*(const u32x4*)(of + row * 512 + hh * 64 + q * 8), a); unpack8(*(const u32x4*)(ob + row * 512 + hh * 64 + q * 8), c);
#pragma unroll
                for (int j = 0; j < 8; ++j) { o[q * 8 + j] = a[j] + c[j]; s += o[q * 8 + j]; } }
            const float mean = s * (1.0f / 64.0f); float vs = 0.f;
#pragma unroll
            for (int j = 0; j < 64; ++j) { const float dd = o[j] - mean; vs += dd * dd; }
            const float rstd = rsqrtf(vs * (1.0f / 64.0f) + 64e-5f);
#pragma unroll
            for (int q = 0; q < 8; ++q) { float vv[8], res[8]; load8_shift(u, row, t, T, 1024 + hh * 64 + q * 8, mu, vv);
                float g8[8]; unpack8(*(const LAS u32x4*)(gt + tk * 520 + hh * 64 + q * 8), g8);
#pragma unroll
                for (int j = 0; j < 8; ++j) { const int c = hh * 64 + q * 8 + j; res[j] = ((o[q * 8 + j] - mean) * rstd * lng[c] + lnb[c] + bsum * vv[j]) * g8[j]; }
                *(u32x4*)(y + row * 512 + hh * 64 + q * 8) = pack8(res); }
        }
        __syncthreads();
    }
}
__device__ __forceinline__ void mla_stats_pass(const Ctx& F, int w0, int nw) {
    unsigned char* ws = getpp()->ws; const int lane = F.lane;
    const bf16_t* um = (const bf16_t*)(ws + D_UMLA); float* rq = (float*)(ws + WS_RSTD); float* rkv = rq + RT;
    for (int row = GW(F) - w0; row < RT; row += nw) {
        const bf16_t* ur = um + (size_t)row * MLC;
        float sq = 0.f, skv = 0.f;
        { float v[8]; unpack8(*(const u32x4*)(ur + lane * 8), v); float s = 0.f;
#pragma unroll
            for (int j = 0; j < 8; ++j) s += v[j] * v[j];
            if (lane < 48) sq += s; else skv += s; }
        if (lane < 16) { float v[8]; unpack8(*(const u32x4*)(ur + 512 + lane * 8), v); float s = 0.f;
#pragma unroll
            for (int j = 0; j < 8; ++j) s += v[j] * v[j];
            skv += s; }
        sq = wave_sum(sq, lane); skv = wave_sum(skv, lane);
        if (lane == 0) { rq[row] = rsqrtf(sq * (1.0f / 384.0f) + 1e-6f); rkv[row] = rsqrtf(skv * (1.0f / 256.0f) + 1e-6f); }
    }
}
__device__ __forceinline__ void krope_pass(const Ctx& F, int half, int layer) {
    unsigned char* ws = getpp()->ws; const int lane = F.lane;
    const bf16_t* um = (const bf16_t*)(ws + D_UMLA); bf16_t* Kb = half ? (bf16_t*)(ws + D_K) : (bf16_t*)(half_a_base(layer) + HA_K);
    const float* cm = (const float*)(ws + WS_ROPE_M); const float* sm = cm + 4096 * 16;
    for (int ci = GW(F) * 4 + (lane >> 4); ci < HROWS; ci += NGW(F) * 4) {
        const int row = ci < 4 * SEQ ? 4 * SEQ * half + ci : RL + 4 * CTXL * half + (ci - 4 * SEQ);
        const int orow = half ? row : ci;
        const bf16_t* ur = um + (size_t)row * MLC; const int l = lane & 15;
        float x1 = bf2f(ur[640 + l]), x2 = bf2f(ur[656 + l]);
        if (row < RL) { const int t = row & (SEQ - 1); const float cs = cm[t * 16 + l], sn = sm[t * 16 + l]; const float o1 = x1 * cs - x2 * sn, o2 = x1 * sn + x2 * cs; x1 = o1; x2 = o2; }
        Kb[(size_t)orow * 544 + 512 + l] = (bf16_t)f2bf(x1); Kb[(size_t)orow * 544 + 528 + l] = (bf16_t)f2bf(x2);
    }
}

constexpr size_t D_KV = D_END1;
static_assert(D_KV + 34 * MiB <= WS_NEED, "retention state buffer");
namespace ret2 {
constexpr int QP = 72, VP = 136, NUNITS = NBATCH * 4 * 34;
typedef short v4i16_t __attribute__((ext_vector_type(4)));
__device__ __forceinline__ bf16x8 tr8(const LAS bf16_t* base, int pitch, int row0, int col0, int lane) {
    const int g = lane >> 4, i = lane & 15, q = i >> 2, p = i & 3;
    const LAS bf16_t* a = base + (row0 + 8 * g + q) * pitch + col0 + 4 * p;
    const s16x4 lo = __builtin_bit_cast(s16x4, __builtin_amdgcn_ds_read_tr16_b64_v4i16((LAS v4i16_t*)a));
    const s16x4 hi = __builtin_bit_cast(s16x4, __builtin_amdgcn_ds_read_tr16_b64_v4i16((LAS v4i16_t*)(a + 4 * pitch)));
    return (bf16x8){lo[0], lo[1], lo[2], lo[3], hi[0], hi[1], hi[2], hi[3]};
}
__device__ __forceinline__ f32x4 mm32(bf16x8 a, bf16x8 b, f32x4 c) { return __builtin_amdgcn_mfma_f32_16x16x32_bf16(a, b, c, 0, 0, 0); }
struct UnitPos { int b, h, cs; long rbase; bool isctx; int t0; };
__device__ __forceinline__ UnitPos unit_pos(int un) { UnitPos U; const int bh = un / 34; U.cs = un % 34; U.b = bh >> 2; U.h = bh & 3; U.isctx = U.cs < 2;
    U.t0 = U.isctx ? 0 : (U.cs - 2) * 128; U.rbase = U.isctx ? (long)RL + U.b * CTXL + U.cs * 128 : (long)U.b * SEQ + U.t0; return U; }
}
__device__ __forceinline__ void ret_r1_unit(const Ctx& F, int layer, int un) {
    using namespace ret2;
    PP P = getpp(); unsigned char* ws = P->ws;
    const bf16_t* u = (const bf16_t*)(ws + D_URET); bf16_t* kv = (bf16_t*)(ws + D_KV);
    const float* cr = (const float*)(ws + WS_ROPE_R); const float* sr = cr + 4096 * 32;
    const UnitPos U = unit_pos(un);
    const float lgf = -__expf(P->in[I_RDEC][(layer * 2 + 0) * 4 + U.h]) * 1.4426950408889634f, lgb = -__expf(P->in[I_RDEC][(layer * 2 + 1) * 4 + U.h]) * 1.4426950408889634f;
    LAS bf16_t* Vt = (LAS bf16_t*)F.lds; LAS bf16_t* kzf = Vt + 128 * VP; LAS bf16_t* kzb = kzf + 128 * QP; LAS bf16_t* St = kzb + 128 * QP;
    const int tid = F.tid, lane = F.lane, w = F.wave;
    {
        const int tk = tid >> 2, pc = tid & 3; float k1[8], k2[8], a[8], c[8];
        u32x4 vv[4], kr[2]; f32x4 rc[2], rs[2];
#pragma unroll
        for (int k4 = 0; k4 < 4; ++k4) { const int it = tid + 512 * k4, tv = it >> 4, ch = it & 15; vv[k4] = *(const u32x4*)(u + (U.rbase + tv) * REC + 512 + U.h * 128 + ch * 8); }
        { const bf16_t* kp = u + (U.rbase + tk) * REC + 256 + U.h * 64 + pc * 8; kr[0] = *(const u32x4*)kp; kr[1] = *(const u32x4*)(kp + 32);
          const int ro = (U.t0 + tk) * 32 + pc * 8; rc[0] = *(const f32x4*)(cr + ro); rc[1] = *(const f32x4*)(cr + ro + 4); rs[0] = *(const f32x4*)(sr + ro); rs[1] = *(const f32x4*)(sr + ro + 4); }
        __builtin_amdgcn_sched_barrier(0);
        unpack8(kr[0], k1); unpack8(kr[1], k2);
#pragma unroll
        for (int j = 0; j < 8; ++j) { const float cs = U.isctx ? 1.0f : rc[j >> 2][j & 3], sn = U.isctx ? 0.0f : rs[j >> 2][j & 3];
            const float ka_ = k1[j] * cs - k2[j] * sn, kb_ = k1[j] * sn + k2[j] * cs; k1[j] = ka_; k2[j] = kb_; }
        const float zf = 0.125f * __builtin_amdgcn_exp2f((float)(127 - tk) * lgf), zb = 0.125f * __builtin_amdgcn_exp2f((float)tk * lgb);
#pragma unroll
        for (int j = 0; j < 8; ++j) { a[j] = k1[j] * zf; c[j] = k2[j] * zf; }
        *(LAS u32x4*)(kzf + tk * QP + pc * 8) = pack8(a); *(LAS u32x4*)(kzf + tk * QP + 32 + pc * 8) = pack8(c);
#pragma unroll
        for (int j = 0; j < 8; ++j) { a[j] = k1[j] * zb; c[j] = k2[j] * zb; }
        *(LAS u32x4*)(kzb + tk * QP + pc * 8) = pack8(a); *(LAS u32x4*)(kzb + tk * QP + 32 + pc * 8) = pack8(c);
#pragma unroll
        for (int k4 = 0; k4 < 4; ++k4) { const int it = tid + 512 * k4, tv = it >> 4, ch = it & 15; *(LAS u32x4*)(Vt + tv * VP + ch * 8) = vv[k4]; }
    }
    __syncthreads();
    {
        const int fr = lane & 15, fq = lane >> 4;
        f32x4 acc[2][4];
#pragma unroll
        for (int dd = 0; dd < 2; ++dd)
#pragma unroll
            for (int tj = 0; tj < 4; ++tj) acc[dd][tj] = (f32x4){0.f, 0.f, 0.f, 0.f};
#pragma unroll
        for (int ks = 0; ks < 4; ++ks) { const bf16x8 a = tr8(Vt, VP, 32 * ks, 16 * w, lane);
#pragma unroll
            for (int tj = 0; tj < 4; ++tj) { acc[0][tj] = mm32(a, tr8(kzf, QP, 32 * ks, 16 * tj, lane), acc[0][tj]); acc[1][tj] = mm32(a, tr8(kzb, QP, 32 * ks, 16 * tj, lane), acc[1][tj]); } }
#pragma unroll
        for (int dd = 0; dd < 2; ++dd)
#pragma unroll
            for (int tj = 0; tj < 4; ++tj)
#pragma unroll
                for (int j = 0; j < 4; ++j) St[dd * 128 * QP + (16 * w + 4 * fq + j) * QP + 16 * tj + fr] = (bf16_t)f2bf(acc[dd][tj][j]);
    }
    __syncthreads();
#pragma unroll
    for (int k4 = 0; k4 < 4; ++k4) { const int it = tid + 512 * k4, dd = it >> 10, e = (it >> 3) & 127, ch = it & 7;
        *(u32x4*)(kv + ((size_t)un * 2 + dd) * 8192 + e * 64 + ch * 8) = *(const LAS u32x4*)(St + dd * 128 * QP + e * QP + ch * 8); }
    __syncthreads();
}
__device__ __forceinline__ void ret_r2(const Ctx& F, int layer, int b0, int nb) {
    using namespace ret2;
    PP P = getpp(); bf16_t* kv = (bf16_t*)(P->ws + D_KV);
    for (int item = (F.bid - b0) * NTHREADS + F.tid; item < 65536; item += nb * NTHREADS) {
        const int bh = item >> 11, dd = (item >> 10) & 1, off = (item & 1023) * 8;
        const float g = __builtin_amdgcn_exp2f(-128.0f * __expf(P->in[I_RDEC][(layer * 2 + dd) * 4 + (bh & 3)]) * 1.4426950408889634f);
        float st[8];
#pragma unroll
        for (int j = 0; j < 8; ++j) st[j] = 0.f;
#pragma unroll
        for (int half = 0; half < 2; ++half) {
            asm volatile("" ::: "memory");
            u32x4 xv[17];
#pragma unroll
            for (int q = 0; q < 17; ++q) { const int i = half * 17 + q; const int cs = dd ? (i < 2 ? 1 - i : 35 - i) : i;
                xv[q] = *(const u32x4*)(kv + ((size_t)(bh * 34 + cs) * 2 + dd) * 8192 + off); }
#pragma unroll
            for (int q = 0; q < 17; ++q) { const int i = half * 17 + q; const int cs = dd ? (i < 2 ? 1 - i : 35 - i) : i;
                float x[8]; unpack8(xv[q], x);
                *(u32x4*)(kv + ((size_t)(bh * 34 + cs) * 2 + dd) * 8192 + off) = pack8(st);
#pragma unroll
                for (int j = 0; j < 8; ++j) st[j] = st[j] * g + x[j]; }
        }
    }
}
__device__ __forceinline__ void ret_r3_unit(const Ctx& F, int layer, int un) {
    using namespace ret2;
    PP P = getpp(); unsigned char* ws = P->ws;
    const bf16_t* u = (const bf16_t*)(ws + D_URET); const bf16_t* kv = (const bf16_t*)(ws + D_KV); bf16_t* y = (bf16_t*)(ws + D_YRET);
    const float* cr = (const float*)(ws + WS_ROPE_R); const float* sr = cr + 4096 * 32;
    const UnitPos U = unit_pos(un);
    const float* lng = P->in[I_RLNG] + layer * 512 + U.h * 128; const float* lnb = P->in[I_RLNB] + layer * 512 + U.h * 128;
    const float lgf = -__expf(P->in[I_RDEC][(layer * 2 + 0) * 4 + U.h]) * 1.4426950408889634f, lgb = -__expf(P->in[I_RDEC][(layer * 2 + 1) * 4 + U.h]) * 1.4426950408889634f;
    LAS bf16_t* qf = (LAS bf16_t*)F.lds; LAS bf16_t* qb = qf + 128 * QP; LAS bf16_t* qn = qb + 128 * QP; LAS bf16_t* ks = qn + 128 * QP; LAS bf16_t* Sm = qn;
    LAS bf16_t* Vt = (LAS bf16_t*)(F.lds + 73728); LAS bf16_t* Rf = (LAS bf16_t*)(F.lds + 108544); LAS bf16_t* Rb = Rf + 128 * QP; LAS bf16_t* Yst = qf;
    const int tid = F.tid, lane = F.lane, w = F.wave, fr = lane & 15, fq = lane >> 4;
    const int n0 = 16 * w;
    u32x4 vv[4], rr[4], gq[4]; float lgv[8], lbv[8];
#pragma unroll
    for (int k4 = 0; k4 < 4; ++k4) { const int it = tid + 512 * k4, tv = it >> 4, ch = it & 15; vv[k4] = *(const u32x4*)(u + (U.rbase + tv) * REC + 512 + U.h * 128 + ch * 8); }
#pragma unroll
    for (int k4 = 0; k4 < 4; ++k4) { const int it = tid + 512 * k4, dd = it >> 10, e = (it >> 3) & 127, ch = it & 7; rr[k4] = *(const u32x4*)(kv + ((size_t)un * 2 + dd) * 8192 + e * 64 + ch * 8); }
#pragma unroll
    for (int k4 = 0; k4 < 4; ++k4) { const int it = lane + 64 * k4, r = it >> 4, ch = it & 15; gq[k4] = *(const u32x4*)(u + (U.rbase + n0 + r) * REC + 1024 + U.h * 128 + ch * 8); }
#pragma unroll
    for (int te = 0; te < 8; ++te) { lgv[te] = lng[16 * te + fr]; lbv[te] = lnb[16 * te + fr]; }
    const int tk = tid >> 2, pc = tid & 3;
    u32x4 qr[2], kr[2]; f32x4 rc[2], rs[2];
    { const bf16_t* qp = u + (U.rbase + tk) * REC + U.h * 64 + pc * 8; qr[0] = *(const u32x4*)qp; qr[1] = *(const u32x4*)(qp + 32); kr[0] = *(const u32x4*)(qp + 256); kr[1] = *(const u32x4*)(qp + 288);
      const int ro = (U.t0 + tk) * 32 + pc * 8; rc[0] = *(const f32x4*)(cr + ro); rc[1] = *(const f32x4*)(cr + ro + 4); rs[0] = *(const f32x4*)(sr + ro); rs[1] = *(const f32x4*)(sr + ro + 4); }
    __builtin_amdgcn_sched_barrier(0);
    {
        float q1[8], q2[8], k1[8], k2[8], a[8], c[8];
        unpack8(qr[0], q1); unpack8(qr[1], q2); unpack8(kr[0], k1); unpack8(kr[1], k2);
#pragma unroll
        for (int j = 0; j < 8; ++j) { const float cs = U.isctx ? 1.0f : rc[j >> 2][j & 3], sn = U.isctx ? 0.0f : rs[j >> 2][j & 3];
            const float qa_ = q1[j] * cs - q2[j] * sn, qb_ = q1[j] * sn + q2[j] * cs, ka_ = k1[j] * cs - k2[j] * sn, kb_ = k1[j] * sn + k2[j] * cs;
            q1[j] = qa_; q2[j] = qb_; k1[j] = ka_; k2[j] = kb_; }
        *(LAS u32x4*)(qn + tk * QP + pc * 8) = pack8(q1); *(LAS u32x4*)(qn + tk * QP + 32 + pc * 8) = pack8(q2);
        const float xf = __builtin_amdgcn_exp2f((float)(tk + 1) * lgf), xb = __builtin_amdgcn_exp2f((float)(128 - tk) * lgb);
#pragma unroll
        for (int j = 0; j < 8; ++j) { a[j] = q1[j] * xf; c[j] = q2[j] * xf; }
        *(LAS u32x4*)(qf + tk * QP + pc * 8) = pack8(a); *(LAS u32x4*)(qf + tk * QP + 32 + pc * 8) = pack8(c);
#pragma unroll
        for (int j = 0; j < 8; ++j) { a[j] = q1[j] * xb; c[j] = q2[j] * xb; }
        *(LAS u32x4*)(qb + tk * QP + pc * 8) = pack8(a); *(LAS u32x4*)(qb + tk * QP + 32 + pc * 8) = pack8(c);
#pragma unroll
        for (int j = 0; j < 8; ++j) { a[j] = k1[j] * 0.125f; c[j] = k2[j] * 0.125f; }
        *(LAS u32x4*)(ks + tk * QP + pc * 8) = pack8(a); *(LAS u32x4*)(ks + tk * QP + 32 + pc * 8) = pack8(c);
#pragma unroll
        for (int k4 = 0; k4 < 4; ++k4) { const int it = tid + 512 * k4, tv = it >> 4, ch = it & 15; *(LAS u32x4*)(Vt + tv * VP + ch * 8) = vv[k4]; }
#pragma unroll
        for (int k4 = 0; k4 < 4; ++k4) { const int it = tid + 512 * k4, dd = it >> 10, e = (it >> 3) & 127, ch = it & 7; *(LAS u32x4*)((dd ? Rb : Rf) + e * QP + ch * 8) = rr[k4]; }
    }
    __syncthreads();
    f32x4 ST[8];
    {
        bf16x8 qa[2];
#pragma unroll
        for (int k2 = 0; k2 < 2; ++k2) qa[k2] = *(const LAS bf16x8*)(qn + (n0 + fr) * QP + k2 * 32 + fq * 8);
#pragma unroll
        for (int tm = 0; tm < 8; ++tm) { ST[tm] = (f32x4){0.f, 0.f, 0.f, 0.f};
#pragma unroll
            for (int k2 = 0; k2 < 2; ++k2) ST[tm] = mm32(*(const LAS bf16x8*)(ks + (16 * tm + fr) * QP + k2 * 32 + fq * 8), qa[k2], ST[tm]); }
    }
    s16x4 cst[8];
#pragma unroll
    for (int tm = 0; tm < 8; ++tm) { f32x4 t;
#pragma unroll
        for (int j = 0; j < 4; ++j) { const int n = n0 + fr, m = 16 * tm + 4 * fq + j; const int dd = n - m;
            const float ex = __builtin_amdgcn_exp2f((float)(dd < 0 ? -dd : dd) * (dd > 0 ? lgf : lgb));
            t[j] = ST[tm][j] * ((dd == 0) ? 2.0f : ex); }
        u32x2 pw; pw.x = pk2(t[0], t[1]); pw.y = pk2(t[2], t[3]); cst[tm] = __builtin_bit_cast(s16x4, pw); }
    f32x4 Y[8];
#pragma unroll
    for (int te = 0; te < 8; ++te) Y[te] = (f32x4){0.f, 0.f, 0.f, 0.f};
    {
        const int g = lane >> 4, i = lane & 15, q = i >> 2, pp = i & 3;
#pragma unroll
        for (int p = 0; p < 4; ++p) { const bf16x8 a = (bf16x8){cst[2 * p][0], cst[2 * p][1], cst[2 * p][2], cst[2 * p][3], cst[2 * p + 1][0], cst[2 * p + 1][1], cst[2 * p + 1][2], cst[2 * p + 1][3]};
#pragma unroll
            for (int te = 0; te < 8; ++te) {
                const LAS bf16_t* va = Vt + (32 * p + 4 * g + q) * VP + 16 * te + 4 * pp;
                const s16x4 lo = __builtin_bit_cast(s16x4, __builtin_amdgcn_ds_read_tr16_b64_v4i16((LAS v4i16_t*)va));
                const s16x4 hi = __builtin_bit_cast(s16x4, __builtin_amdgcn_ds_read_tr16_b64_v4i16((LAS v4i16_t*)(va + 16 * VP)));
                Y[te] = mm32(a, (bf16x8){lo[0], lo[1], lo[2], lo[3], hi[0], hi[1], hi[2], hi[3]}, Y[te]); } }
    }
#pragma unroll
    for (int k2 = 0; k2 < 2; ++k2) { const bf16x8 af = *(const LAS bf16x8*)(qf + (n0 + fr) * QP + k2 * 32 + fq * 8), ab = *(const LAS bf16x8*)(qb + (n0 + fr) * QP + k2 * 32 + fq * 8);
#pragma unroll
        for (int te = 0; te < 8; ++te) { Y[te] = mm32(af, *(const LAS bf16x8*)(Rf + (16 * te + fr) * QP + k2 * 32 + fq * 8), Y[te]); Y[te] = mm32(ab, *(const LAS bf16x8*)(Rb + (16 * te + fr) * QP + k2 * 32 + fq * 8), Y[te]); } }
    __syncthreads();
#pragma unroll
    for (int j = 0; j < 4; ++j) { float s = 0.f;
#pragma unroll
        for (int te = 0; te < 8; ++te) s += Y[te][j];
        s += shx(s, 1, lane); s += shx(s, 2, lane); s += shx(s, 4, lane); s += shx(s, 8, lane);
        const float mean = s * (1.0f / 128.0f); float vs = 0.f;
#pragma unroll
        for (int te = 0; te < 8; ++te) { const float dd = Y[te][j] - mean; vs += dd * dd; }
        vs += shx(vs, 1, lane); vs += shx(vs, 2, lane); vs += shx(vs, 4, lane); vs += shx(vs, 8, lane);
        const float rstd = rsqrtf(vs * (1.0f / 128.0f) + 1e-5f);
        const int r = 4 * fq + j; LAS bf16_t* yst = (r < 8 ? qf + n0 * QP + r * VP : qb + n0 * QP + (r - 8) * VP);
#pragma unroll
        for (int te = 0; te < 8; ++te) { const int e = 16 * te + fr; yst[e] = (bf16_t)f2bf((Y[te][j] - mean) * rstd * lgv[te] + lbv[te]); } }
    __syncthreads();
#pragma unroll
    for (int k4 = 0; k4 < 4; ++k4) { const int it = lane + 64 * k4, r = it >> 4, ch = it & 15; const long row = U.rbase + n0 + r;
        const LAS bf16_t* yst = (r < 8 ? qf + n0 * QP + r * VP : qb + n0 * QP + (r - 8) * VP);
        float yv[8], gv[8]; unpack8(*(const LAS u32x4*)(yst + ch * 8), yv); unpack8(gq[k4], gv);
#pragma unroll
        for (int j = 0; j < 8; ++j) yv[j] *= siluf_(gv[j]);
        *(u32x4*)(y + row * 512 + U.h * 128 + ch * 8) = pack8(yv); }
    __syncthreads();
}
__device__ __forceinline__ void ret_r3_phase(const Ctx& F, int layer) {
    for (int un = F.bid; un < ret2::NUNITS; un += F.G) { if (layer != 0 && (un % 34) < 2) continue; ret_r3_unit(F, layer, un); }
}
__device__ __forceinline__ void ret_r1_phase(const Ctx& F, int layer) { for (int un = F.bid; un < ret2::NUNITS; un += F.G) ret_r1_unit(F, layer, un); }
__device__ __forceinline__ void rw_phase(const Ctx& F, int layer) {
    unsigned char* ws = getpp()->ws;
    if (F.G >= 160) {
        if (F.bid < 128) rwkv_chain4(F, layer, F.bid >> 4, (F.bid >> 1) & 7, F.bid & 1);
        unsigned* ctr = (unsigned*)(ws + WS_CTL) + 192 + 64 * layer; LAS unsigned* bc = (LAS unsigned*)(F.lds + LDS_BYTES - 32);
        for (;;) {
            __syncthreads();
            if (F.tid == 0) *bc = __hip_atomic_fetch_add(ctr, 1u, __ATOMIC_RELAXED, __HIP_MEMORY_SCOPE_AGENT);
            __syncthreads();
            const unsigned u = *bc; if (u >= 512u) break;
            const int bh = (int)u >> 4; attn_latent_unit(F, ws, half_a_base(layer), bh >> 3, bh & 7, (int)u & 15);
        }
    } else {
        for (int un = F.bid; un < 128; un += F.G) { rwkv_chain4(F, layer, un >> 4, (un >> 1) & 7, un & 1); __syncthreads(); }
        for (int u = F.bid; u < 512; u += F.G) { const int bh = u >> 4; attn_latent_unit(F, ws, half_a_base(layer), bh >> 3, bh & 7, u & 15); }
    }
}

template <int NB> __device__ __forceinline__ void rows_norm(int lane, const float* hbase, const int* rows, const float* gain, const float* mod, f32x4 (*y)[4]) {
    float ss[NB];
#pragma unroll
    for (int b = 0; b < NB; ++b) { const float* src = hbase + (size_t)rows[b] * 1024; ss[b] = 0.f;
#pragma unroll
        for (int j = 0; j < 4; ++j) { y[b][j] = *(const f32x4*)(src + 4 * lane + 256 * j); ss[b] += y[b][j].x * y[b][j].x + y[b][j].y * y[b][j].y + y[b][j].z * y[b][j].z + y[b][j].w * y[b][j].w; } }
#pragma unroll
    for (int b = 0; b < NB; ++b) ss[b] = wave_sum(ss[b], lane);
#pragma unroll
    for (int b = 0; b < NB; ++b) { const float rstd = rsqrtf(ss[b] * (1.0f / 1024.0f) + 1e-6f); const float* sh = mod + (rows[b] >> 12) * 6144; const float* sc = sh + 1024;
#pragma unroll
        for (int j = 0; j < 4; ++j) { const int c = 4 * lane + 256 * j; y[b][j] = y[b][j] * rstd * *(const f32x4*)(gain + c) * (*(const f32x4*)(sc + c) + 1.0f) + *(const f32x4*)(sh + c); } }
}
__device__ __forceinline__ void moe_route_pass(const Ctx& F, int layer) {
    PP P = getpp(); unsigned char* ws = P->ws;
    const float* gain = P->in[I_NFFN] + layer * 1024; const float* mod = (const float*)(ws + WS_MOD) + (size_t)layer * 9 * 6144 + 3072;
    const float* router = P->in[I_ROUTER];
    unsigned* cnt = (unsigned*)(ws + WS_CTL); int* route = (int*)(ws + WS_ROUTE);
    LAS float* rl = (LAS float*)F.lds;
    LAS unsigned* lc = (LAS unsigned*)(F.lds + 32768);
    for (int i = F.tid; i < 8192; i += NTHREADS) rl[i] = router[i];
    if (F.tid < 16) lc[F.tid] = 0u;
    __syncthreads();
    const int rpb = (RL + F.G - 1) / F.G, rpw = (rpb + 7) / 8;
    const int b0 = F.bid * rpb, b1 = (b0 + rpb < RL) ? b0 + rpb : RL;
    const int r0 = b0 + F.wave * rpw, r1 = (r0 + rpw < b1) ? r0 + rpw : b1;
    constexpr int NB = 2;
    for (int rb = r0; rb < r1; rb += NB) {
        int lane = F.lane; asm volatile("" : "+v"(lane));
        int rows[NB]; f32x4 y[NB][4];
#pragma unroll
        for (int b = 0; b < NB; ++b) rows[b] = (rb + b < r1) ? rb + b : r1 - 1;
        rows_norm<NB>(lane, P->out, rows, gain, mod, y);
        float lg[NB][8];
#pragma unroll
        for (int b = 0; b < NB; ++b)
#pragma unroll
            for (int e = 0; e < 8; ++e) lg[b][e] = 0.f;
#pragma unroll
        for (int j = 0; j < 4; ++j)
#pragma unroll
            for (int q = 0; q < 4; ++q) { const int c = 4 * lane + 256 * j + q; const f32x4 ra = *(const LAS f32x4*)(rl + c * 8), rb2 = *(const LAS f32x4*)(rl + c * 8 + 4);
#pragma unroll
                for (int b = 0; b < NB; ++b) { const float xv = y[b][j][q];
#pragma unroll
                    for (int e = 0; e < 4; ++e) { lg[b][e] += xv * ra[e]; lg[b][4 + e] += xv * rb2[e]; } } }
#pragma unroll
        for (int b = 0; b < NB; ++b)
#pragma unroll
            for (int e = 0; e < 8; ++e) lg[b][e] = wave_sum(lg[b][e], lane);
        if (lane == 0) {
#pragma unroll
            for (int b = 0; b < NB; ++b) if (rb + b < r1) {
                int i0 = 0; float v0 = lg[b][0];
#pragma unroll
                for (int e = 1; e < 8; ++e) if (lg[b][e] > v0) { v0 = lg[b][e]; i0 = e; }
                int i1 = -1; float v1 = -3.0e38f;
#pragma unroll
                for (int e = 0; e < 8; ++e) if (e != i0 && lg[b][e] > v1) { v1 = lg[b][e]; i1 = e; }
                const float w0 = 1.0f / (1.0f + __expf(v1 - v0)), w1 = 1.0f - w0;
                const unsigned p0 = __hip_atomic_fetch_add(&lc[i0], 1u, __ATOMIC_RELAXED, __HIP_MEMORY_SCOPE_WORKGROUP), p1 = __hip_atomic_fetch_add(&lc[i1], 1u, __ATOMIC_RELAXED, __HIP_MEMORY_SCOPE_WORKGROUP);
                int* r = route + (size_t)rows[b] * 8; r[0] = i0; r[1] = i1; r[2] = __float_as_int(w0); r[3] = __float_as_int(w1); r[4] = (int)p0; r[5] = (int)p1;
            }
        }
    }
    __syncthreads();
    if (F.tid < 8) lc[8 + F.tid] = atomicAdd(&cnt[F.tid], lc[F.tid]);
    __syncthreads();
    for (int row = r0 + F.lane; row < r1; row += 64) { int* r = route + (size_t)row * 8; const int e0 = r[0], e1 = r[1], p0 = r[4], p1 = r[5]; r[4] = p0 + (int)lc[8 + e0]; r[5] = p1 + (int)lc[8 + e1]; }
    __syncthreads();
}
__device__ __forceinline__ void moe_gather_pass(const Ctx& F, int layer) {
    PP P = getpp(); unsigned char* ws = P->ws;
    const float* gain = P->in[I_NFFN] + layer * 1024; const float* mod = (const float*)(ws + WS_MOD) + (size_t)layer * 9 * 6144 + 3072;
    const unsigned* cnt = (const unsigned*)(ws + WS_CTL); const int* route = (const int*)(ws + WS_ROUTE);
    bf16_t* xlo = (bf16_t*)(ws + D_XG); bf16_t* xhi = xlo + (size_t)RG * 512;
    const MoeTiles T = moe_tiles(cnt);
    const int rpw = (RL + NGW(F) - 1) / NGW(F); const int r0 = GW(F) * rpw; const int r1 = (r0 + rpw < RL) ? r0 + rpw : RL;
    constexpr int NB = 2;
    for (int rb = r0; rb < r1; rb += NB) {
        int lane = F.lane; asm volatile("" : "+v"(lane));
        int rows[NB]; f32x4 y[NB][4];
#pragma unroll
        for (int b = 0; b < NB; ++b) rows[b] = (rb + b < r1) ? rb + b : r1 - 1;
        rows_norm<NB>(lane, P->out, rows, gain, mod, y);
#pragma unroll
        for (int b = 0; b < NB; ++b) {
            const int* r = route + (size_t)rows[b] * 8; const int e0 = r[0], e1 = r[1];
            int t0 = 0, t1 = 0;
#pragma unroll
            for (int e = 0; e < 8; ++e) { if (e == e0) t0 = T.tstart[e]; if (e == e1) t1 = T.tstart[e]; }
            const size_t s0 = (size_t)t0 * 256 + r[4], s1 = (size_t)t1 * 256 + r[5];
#pragma unroll
            for (int j = 0; j < 4; ++j) { const int c = 4 * lane + 256 * j; u32x2 o; o.x = pk2(y[b][j].x, y[b][j].y); o.y = pk2(y[b][j].z, y[b][j].w);
                bf16_t* bp = (c < 512) ? xlo + c : xhi + (c - 512);
                *(u32x2*)(bp + s0 * 512) = o; *(u32x2*)(bp + s1 * 512) = o; } }
    }
}
__device__ __forceinline__ void moe_final_pass(const Ctx& F, int layer) {
    PP P = getpp(); unsigned char* ws = P->ws;
    const float* mod = (const float*)(ws + WS_MOD) + (size_t)layer * 9 * 6144 + 5120;
    const unsigned* cnt = (const unsigned*)(ws + WS_CTL); const int* route = (const int*)(ws + WS_ROUTE);
    const bf16_t* ym = (const bf16_t*)(ws + D_XG); const float* fn = P->in[I_FNORM];
    const MoeTiles T = moe_tiles(cnt);
    const int rpw = (RL + NGW(F) - 1) / NGW(F); const int r0 = GW(F) * rpw; const int r1 = (r0 + rpw < RL) ? r0 + rpw : RL;
    constexpr int NB = 2;
    for (int rb = r0; rb < r1; rb += NB) {
        int lane = F.lane; asm volatile("" : "+v"(lane));
        f32x4 v[NB][4]; float ss[NB]; int rows[NB];
#pragma unroll
        for (int b = 0; b < NB; ++b) { const int row = (rb + b < r1) ? rb + b : r1 - 1; rows[b] = row;
            const int* r = route + (size_t)row * 8; const int e0 = r[0], e1 = r[1]; const float w0 = __int_as_float(r[2]), w1 = __int_as_float(r[3]);
            int t0 = 0, t1 = 0;
#pragma unroll
            for (int e = 0; e < 8; ++e) { if (e == e0) t0 = T.tstart[e]; if (e == e1) t1 = T.tstart[e]; }
            const size_t s0 = (size_t)t0 * 256 + r[4], s1 = (size_t)t1 * 256 + r[5];
            const float* g = mod + (row >> 12) * 6144; const float* hp = P->out + (size_t)row * 1024; ss[b] = 0.f;
#pragma unroll
            for (int j = 0; j < 4; ++j) { const int c = 4 * lane + 256 * j; const u32x2 a = *(const u32x2*)(ym + s0 * 1024 + c), bq = *(const u32x2*)(ym + s1 * 1024 + c);
                const f32x4 ya = {bflo(a.x), bfhi(a.x), bflo(a.y), bfhi(a.y)}, yb = {bflo(bq.x), bfhi(bq.x), bflo(bq.y), bfhi(bq.y)};
                v[b][j] = *(const f32x4*)(hp + c) + *(const f32x4*)(g + c) * (ya * w0 + yb * w1);
                ss[b] += v[b][j].x * v[b][j].x + v[b][j].y * v[b][j].y + v[b][j].z * v[b][j].z + v[b][j].w * v[b][j].w; } }
#pragma unroll
        for (int b = 0; b < NB; ++b) ss[b] = wave_sum(ss[b], lane);
#pragma unroll
        for (int b = 0; b < NB; ++b) { const float rstd = rsqrtf(ss[b] * (1.0f / 1024.0f) + 1e-6f); float* hp = P->out + (size_t)rows[b] * 1024;
#pragma unroll
            for (int j = 0; j < 4; ++j) { const int c = 4 * lane + 256 * j; *(f32x4*)(hp + c) = v[b][j] * rstd * *(const f32x4*)(fn + c); } }
    }
}

#define XB_TMO      128
#define XB_XCNT(j)  (256  + 64 * (j))
#define XB_XSUB(j)  (1280 + 64 * (j))
#define XB_XGEN(j)  (2304 + 64 * (j))
#define XB_TOP      3328
#define XB_TOPGEN   3392
#define XCD_BAR_WORDS 3456
#define XB_SPIN_CAP (1u << 18)
constexpr int CW_BAR = 4096;
constexpr int LDS_BARST = LDS_BYTES - 16;
__device__ __forceinline__ unsigned xb_ld(unsigned* p)              { return __hip_atomic_load(p, __ATOMIC_RELAXED, __HIP_MEMORY_SCOPE_AGENT); }
__device__ __forceinline__ unsigned xb_add(unsigned* p, unsigned v) { return __hip_atomic_fetch_add(p, v, __ATOMIC_RELAXED, __HIP_MEMORY_SCOPE_AGENT); }
__device__ __forceinline__ unsigned xb_xcc_id() { return (unsigned)__builtin_amdgcn_s_getreg((3 << 11) | 20) & 0xFu; }
#define XB_SPIN(cond, bar) do { unsigned _sp = 0; while (cond) { __builtin_amdgcn_s_sleep(1); \
    if ((++_sp & 255u) == 0u) { if (xb_ld(&(bar)[XB_TMO])) break; if (_sp > XB_SPIN_CAP) { atomicAdd(&(bar)[XB_TMO], 1u); break; } } } } while (0)
__device__ __forceinline__ void xcd_barrier_complete(unsigned* bar, unsigned x, unsigned& nloc, unsigned& nx) {
    const unsigned G = gridDim.x * gridDim.y * gridDim.z;
    unsigned sum, cnt, mine, sp = 0u;
    for (;;) {
        sum = 0u; cnt = 0u; mine = 0u;
#pragma unroll
        for (unsigned j = 0; j < 16; ++j) { const unsigned c = xb_ld(&bar[XB_XCNT(j)]); sum += c; cnt += (c > 0u) ? 1u : 0u; mine = (j == x) ? c : mine; }
        if (sum == G) break;
        __builtin_amdgcn_s_sleep(1);
        if ((++sp & 255u) == 0u) { if (xb_ld(&bar[XB_TMO])) break; if (sp > XB_SPIN_CAP) { atomicAdd(&bar[XB_TMO], 1u); break; } }
    }
    nloc = mine > 0u ? mine : 1u; nx = cnt > 0u ? cnt : 1u;
}
__device__ __forceinline__ void xcd_barrier(LAS unsigned char* lds) {
    asm volatile("s_waitcnt vmcnt(0)" ::: "memory");
    __syncthreads();
    if (threadIdx.x == 0) {
        unsigned* bar = (unsigned*)(getpp()->ws + WS_CTL) + CW_BAR;
        volatile LAS unsigned* st = (volatile LAS unsigned*)(lds + LDS_BARST);
        const unsigned x = xb_xcc_id();
        __builtin_amdgcn_s_waitcnt(0);
        unsigned nloc = st[0], nx = st[1];
        if (nloc == 0u) { xcd_barrier_complete(bar, x, nloc, nx); st[0] = nloc; st[1] = nx; }
        const unsigned old = xb_add(&bar[XB_XSUB(x)], 1u);
        const unsigned gen = old / nloc;
        if (old + 1u == (gen + 1u) * nloc) {
            __builtin_amdgcn_fence(__ATOMIC_RELEASE, "agent");
            asm volatile("s_waitcnt vmcnt(0)" ::: "memory");
            const unsigned og = xb_add(&bar[XB_TOP], 1u);
            const unsigned tg = og / nx;
            if (og + 1u == (tg + 1u) * nx) xb_add(&bar[XB_TOPGEN], 1u);
            else XB_SPIN(xb_ld(&bar[XB_TOPGEN]) == tg, bar);
            __builtin_amdgcn_fence(__ATOMIC_ACQUIRE, "agent");
            xb_add(&bar[XB_XGEN(x)], 1u);
            asm volatile("s_waitcnt vmcnt(0)" ::: "memory");
        } else {
            XB_SPIN(xb_ld(&bar[XB_XGEN(x)]) == gen, bar);
            __builtin_amdgcn_fence(__ATOMIC_ACQUIRE, "agent");
            asm volatile("s_waitcnt vmcnt(0)" ::: "memory");
        }
    }
    __syncthreads();
}
#define FRESH() do { int t_ = threadIdx.x; asm volatile("" : "+v"(t_)); F.tid = t_; F.lane = t_ & 63; F.wave = __builtin_amdgcn_readfirstlane(t_ >> 6); \
    int g_ = gridDim.x, b_ = blockIdx.x; asm volatile("" : "+s"(g_), "+s"(b_)); F.G = g_; F.bid = b_; } while (0)
#define PHASE_VARS FRESH(); const int G = F.G, c = F.bid; (void)G; (void)c; PP P = getpp(); unsigned char* ws = P->ws; const bool L0 = (layer == 0); \
    const float* hl = L0 ? P->in[I_X] : P->out; const float* hcx = L0 ? P->in[I_CTX] : (const float*)(ws + WS_HC); float* hc = (float*)(ws + WS_HC); \
    const char* wl = (const char*)(ws + WS_W + (size_t)layer * WL_STRIDE); const float* mod = (const float*)(ws + WS_MOD) + (size_t)layer * 9 * 6144; \
    const int nMm = L0 ? RT / 256 : RL / 256; (void)hl; (void)hcx; (void)hc; (void)wl; (void)mod; (void)nMm;

template <int layer> __device__ __forceinline__ void layer_fwd(Ctx& F, cg::grid_group& grid) {

        { PHASE_VARS norm_pass(F, layer, 0, hl, hcx, RT, (bf16_t*)(ws + D_XN1), (bf16_t*)(ws + D_XN1 + Y34)); }
        xcd_barrier(F.lds);
        { PHASE_VARS SchedSplit2 S{(const char*)(ws + D_XN1), (const char*)(ws + D_XN1 + Y34), wl + WL_WINLO, wl + WL_WINHI, RT / 256, MIXP / 256, G, c};
          EpiInproj E{ws};
          pg8::gemm_phase<512, 512, true>(F.lds, S, E); }
        xcd_barrier(F.lds);
        FRESH(); mla_stats_pass(F, 0, F.G * 8);
        FRESH(); ret_r1_phase(F, layer);
        xcd_barrier(F.lds);
        FRESH(); ret_r2(F, layer, 0, F.G);
        FRESH(); krope_pass(F, 0, layer);
        { PHASE_VARS SchedHalf S{(const char*)(ws + D_UMLA), wl + WL_WQ, (size_t)256 * MLC * 2, (size_t)256 * 384 * 2, 6, 3, 0, G, c};
          EpiQup E{(bf16_t*)(half_a_base(layer) + HA_Q), (const float*)(ws + WS_RSTD), (const float*)(ws + WS_ROPE_M), (const float*)(ws + WS_ROPE_M) + 4096 * 16, 1};
          pg8::gemm_phase<MLC, 384, false>(F.lds, S, E); }
        { PHASE_VARS SchedHalf S{(const char*)(ws + D_UMLA) + 384 * 2, wl + WL_WKV, (size_t)256 * MLC * 2, (size_t)256 * 256 * 2, 4, 4, 0, G, c};
          EpiKVup E{(bf16_t*)(half_a_base(layer) + HA_K), (bf16_t*)(half_a_base(layer) + HA_V), (const float*)(ws + WS_RSTD) + RT, 1};
          pg8::gemm_phase<MLC, 256, true>(F.lds, S, E); }
        xcd_barrier(F.lds);
        FRESH(); rw_phase(F, layer);
        xcd_barrier(F.lds);
        FRESH(); rwkv_post_phase(F, layer, layer == 0 ? RT : RL);
        xcd_barrier(F.lds);
        FRESH(); krope_pass(F, 1, layer);
        FRESH(); ret_r3_phase(F, layer);
        { PHASE_VARS SchedHalf S{(const char*)(ws + D_UMLA), wl + WL_WQ, (size_t)256 * MLC * 2, (size_t)256 * 384 * 2, 6, 3, 1, G, c};
          EpiQup E{(bf16_t*)(ws + D_Q), (const float*)(ws + WS_RSTD), (const float*)(ws + WS_ROPE_M), (const float*)(ws + WS_ROPE_M) + 4096 * 16, 0};
          pg8::gemm_phase<MLC, 384, false>(F.lds, S, E); }
        { PHASE_VARS SchedHalf S{(const char*)(ws + D_UMLA) + 384 * 2, wl + WL_WKV, (size_t)256 * MLC * 2, (size_t)256 * 256 * 2, 4, 4, 1, G, c};
          EpiKVup E{(bf16_t*)(ws + D_K), (bf16_t*)(ws + D_V), (const float*)(ws + WS_RSTD) + RT, 0};
          pg8::gemm_phase<MLC, 256, true>(F.lds, S, E); }
        xcd_barrier(F.lds);
        FRESH(); attn_phase(F, layer);
        xcd_barrier(F.lds);
        if (layer != 0) { { PHASE_VARS norm_pass(F, layer, 0, hl, hcx, nMm * 256, (bf16_t*)(ws + D_XN1), (bf16_t*)(ws + D_XN1 + Y34)); }
        xcd_barrier(F.lds); }
        { PHASE_VARS SchedMerge S; S.XNlo = (const char*)(ws + D_XN1); S.XNhi = (const char*)(ws + D_XN1 + Y34); S.WgLo = wl + WL_WGLO; S.WgHi = wl + WL_WGHI;
          S.wsb = (const char*)ws; S.Wb = wl + WL_WB; S.nM = nMm; S.G = G; S.c = c; S.ctx3 = L0 && G > 64;
          EpiMerge E{(u32x4*)(ws + D_SCR + (size_t)c * 131072), (bf16_t*)(ws + D_M), (bf16_t*)(ws + D_P12)};
          pg8::gemm_phase<512, 512, true>(F.lds, S, E); }
        xcd_barrier(F.lds);
        if (layer == 0 && F.G > 64) { PHASE_VARS SchedWout0 S{(const char*)(ws + D_M), wl + WL_WO, (const char*)ws, G, c};
          EpiResid E{hl, hcx, P->out, hc, mod, 2048};
          pg8::gemm_phase<1024, 1024, false>(F.lds, S, E); }
        else { PHASE_VARS Sched1 S{(const char*)(ws + D_M), wl + WL_WO, (size_t)256 * 1024 * 2, (size_t)256 * 1024 * 2, 16, nMm, 4, G, c};
          EpiResid E{hl, hcx, P->out, hc, mod, 2048};
          pg8::gemm_phase<1024, 1024, false>(F.lds, S, E); }
        xcd_barrier(F.lds);
        if (layer == 0) {
            { PHASE_VARS norm_pass(F, layer, 1, P->out, hc, RT, (bf16_t*)(ws + D_XN2), (bf16_t*)(ws + D_XN2 + Y34)); }
            FRESH(); convert_ffn0(F);
            xcd_barrier(F.lds);
            { PHASE_VARS SchedSplit2 S{(const char*)(ws + D_XN2), (const char*)(ws + D_XN2 + Y34), (const char*)(ws + D_FFW), (const char*)(ws + D_FFW) + (size_t)5632 * 1024, RT / 256, 22, G, c};
              EpiSwiglu E{(bf16_t*)(ws + D_H), DFF};
              pg8::gemm_phase<512, 512, true>(F.lds, S, E); }
            xcd_barrier(F.lds);
            { PHASE_VARS Sched1 S{(const char*)(ws + D_H), (const char*)(ws + D_FFW) + (size_t)2 * 5632 * 1024, (size_t)256 * DFF * 2, (size_t)256 * DFF * 2, 44, RT / 256, 4, G, c};
              EpiResid E{P->out, hc, P->out, hc, mod, 5120};
              pg8::gemm_phase<DFF, DFF, false>(F.lds, S, E); }
            xcd_barrier(F.lds);
        } else {
            FRESH(); moe_route_pass(F, layer);
            FRESH(); convert_moe(F);
            xcd_barrier(F.lds);
            FRESH(); moe_gather_pass(F, layer);
            xcd_barrier(F.lds);
            { PHASE_VARS const MoeTiles T = moe_tiles((const unsigned*)(ws + WS_CTL));
              SchedMoeUp S{(const char*)(ws + D_XG), (const char*)(ws + D_XG) + (size_t)RG * 1024, (const char*)(ws + D_MOEW), T, G, c};
              EpiSwiglu E{(bf16_t*)(ws + D_HM), DFE};
              pg8::gemm_phase<512, 512, true>(F.lds, S, E); }
            xcd_barrier(F.lds);
            { PHASE_VARS const MoeTiles T = moe_tiles((const unsigned*)(ws + WS_CTL));
              SchedMoeDown S{(const char*)(ws + D_HM), (const char*)(ws + D_MOEW), T, G, c};
              EpiBf16 E{(bf16_t*)(ws + D_XG), 1024};
              pg8::gemm_phase<DFE, DFE, true>(F.lds, S, E); }
            xcd_barrier(F.lds);
            FRESH(); moe_final_pass(F, layer);
        }
    }
#undef PHASE_VARS
#undef FRESH

__global__ void __launch_bounds__(NTHREADS, 2) mega_fwd(Params prm) {
    extern __shared__ __attribute__((aligned(16))) unsigned char lds_raw[];
    cg::grid_group grid = cg::this_grid();
    Ctx F; F.lds = (LAS unsigned char*)lds_raw; F.tid = threadIdx.x; F.lane = F.tid & 63; F.wave = __builtin_amdgcn_readfirstlane(F.tid >> 6); F.G = gridDim.x; F.bid = blockIdx.x;
    if (F.tid < 4) ((LAS unsigned*)(F.lds + LDS_BARST))[F.tid] = 0u;
    __syncthreads();
    if (F.tid == 0) (void)xb_add((unsigned*)(prm.ws + WS_CTL) + CW_BAR + XB_XCNT(xb_xcc_id()), 1u);
    phase0(F);
    grid.sync();
    layer_fwd<0>(F, grid);
    layer_fwd<1>(F, grid);
}

extern "C" void kernel_launch(void* const* d_in, const int* in_sizes, int n_in, void* d_out, int out_size, void* d_ws, size_t ws_size, hipStream_t stream) {
    static int grid_blocks = 0;
    if (grid_blocks == 0) {
        if (n_in != 37 || ws_size < WS_NEED) { fprintf(stderr, "kernel_launch: unexpected n_in %d / ws %zu\n", n_in, ws_size); grid_blocks = -1; return; }
        int dev = 0, cus = 0, per_cu = 0;
        hipGetDevice(&dev); hipDeviceGetAttribute(&cus, hipDeviceAttributeMultiprocessorCount, dev);
        hipFuncSetAttribute((const void*)mega_fwd, hipFuncAttributeMaxDynamicSharedMemorySize, LDS_BYTES);
        hipOccupancyMaxActiveBlocksPerMultiprocessor(&per_cu, (const void*)mega_fwd, NTHREADS, LDS_BYTES);
        if (per_cu < 1) { fprintf(stderr, "kernel_launch: occupancy query says %d blocks/CU\n", per_cu); per_cu = 1; }
        grid_blocks = cus;
        (void)hipGetLastError();
    }
    if (grid_blocks < 0) return;
    (void)hipMemsetAsync((char*)d_ws + WS_CTL, 0, 65536, stream);
    Params p{};
    for (int i = 0; i < 37; ++i) p.in[i] = (const float*)d_in[i];
    p.out = (float*)d_out; p.ws = (unsigned char*)d_ws;
    void* args[] = {&p};
    hipError_t e = hipLaunchCooperativeKernel((const void*)mega_fwd, dim3(grid_blocks), dim3(NTHREADS), args, LDS_BYTES, stream);
    if (e != hipSuccess) fprintf(stderr, "cooperative launch failed: %s (grid %d)\n", hipGetErrorString(e), grid_blocks);
}
```

```cpp
#include <hip/hip_runtime.h>
#include <hip/hip_cooperative_groups.h>
#include <cstdio>
#include <cstdint>
namespace cg = cooperative_groups;

#define LAS __attribute__((address_space(3)))
typedef unsigned short bf16_t;
typedef short bf16x8 __attribute__((ext_vector_type(8)));
typedef short s16x4 __attribute__((ext_vector_type(4)));
typedef float f32x4 __attribute__((ext_vector_type(4)));
typedef float f32x2 __attribute__((ext_vector_type(2)));
typedef float f32x16 __attribute__((ext_vector_type(16)));
typedef unsigned u32x4 __attribute__((ext_vector_type(4)));
typedef unsigned u32x2 __attribute__((ext_vector_type(2)));

constexpr int DM = 1024, NBATCH = 8, SEQ = 4096, CTXL = 256;
constexpr int RL = NBATCH * SEQ, RC = NBATCH * CTXL, RT = RL + RC;
constexpr int RWC = 1920, REC = 1536, MLC = 672, MIXC = 4128, MIXP = 4352, GATEC = 3072, NIN = 7200;
constexpr int DFF = 2816, NEXP = 8, DFE = 1408;
constexpr int RG = 2 * RL + NEXP * 256;
constexpr int NTHREADS = 512;
constexpr int LDS_BYTES = 147456;

constexpr size_t MiB = 1u << 20;
constexpr size_t WS_CTL = 0;
constexpr size_t WS_MOD = 1 * MiB;
constexpr size_t WS_ROPE_R = 3 * MiB / 2;
constexpr size_t WS_ROPE_M = 5 * MiB / 2;
constexpr size_t WS_RSTD = 3 * MiB;
constexpr size_t WS_BSC = 7 * MiB / 2;
constexpr size_t WS_ROUTE = 6 * MiB;
constexpr size_t WS_WG2 = 7 * MiB;
constexpr size_t WS_W2T = 15 * MiB / 2;
constexpr size_t WS_HC = 8 * MiB;
constexpr size_t WS_W = 16 * MiB;
constexpr size_t WL_WINLO = 0, WL_WINHI = 4456448, WL_WGLO = 8912896, WL_WGHI = 12058624, WL_WQ = 15204352, WL_WKV = 15794176, WL_WB = 16318464, WL_WO = 19464192, WL_STRIDE = 21 * MiB;
constexpr size_t WS_DYN = 58 * MiB;
constexpr size_t Y34 = 34 * MiB;
constexpr size_t D_URWKV = WS_DYN, D_URET = WS_DYN + 255 * MiB / 2, D_UMLA = D_URET + 102 * MiB, D_XN1 = D_UMLA + 357 * MiB / 8, D_OF = D_XN1 + 2 * Y34, D_OB = D_OF + Y34, D_END1 = D_OB + Y34;
constexpr size_t D_YRWKV = D_OF, D_YRET = D_OB;
constexpr size_t D_K = WS_DYN, D_V = D_K + 289 * MiB / 8, D_Q = D_V + Y34;
constexpr size_t D_YMLA = D_UMLA;
constexpr int HROWS = 4 * SEQ + 4 * CTXL;
constexpr size_t HA_K = 0, HA_V = HA_K + (size_t)HROWS * 544 * 2, HA_Q = HA_V + (size_t)HROWS * 512 * 2;
static_assert(HA_Q + (size_t)HROWS * 768 * 2 <= 2 * Y34, "half-A K/V/Q fit the xn region / d_out");

constexpr size_t D_SCR = WS_DYN + 68 * MiB;
constexpr size_t D_P12 = WS_DYN + 100 * MiB;
constexpr size_t D_M = WS_DYN;
constexpr size_t D_FFW = WS_DYN;
constexpr size_t D_XN2 = WS_DYN + 17 * MiB;
constexpr size_t D_H = D_URET;
constexpr size_t D_XG = WS_DYN;
constexpr size_t D_HM = WS_DYN + 132 * MiB;
constexpr size_t D_MOEW = D_HM + 363 * MiB / 2;
constexpr size_t WS_NEED = 512 * MiB;
static_assert(D_END1 <= WS_NEED && D_MOEW + 66 * MiB <= WS_NEED && D_H + 187 * MiB <= WS_NEED && D_Q + 51 * MiB <= D_URET, "ws map");

struct Params { const float* in[37]; float* out; unsigned char* ws; };
enum { I_X = 0, I_C, I_CTX, I_CCTX, I_NMIX, I_NFFN, I_WMOD, I_BMOD, I_WIN, I_MU, I_W0, I_W2, I_A0, I_A2, I_G2, I_KK, I_KA, I_RK, I_LNG, I_LNB,
       I_RDEC, I_RLNG, I_RLNB, I_QN, I_QUP, I_KVN, I_KVUP, I_WBR, I_WOUT, I_FG, I_FU, I_FD, I_ROUTER, I_MG, I_MU2, I_MD, I_FNORM };

__device__ __forceinline__ unsigned f2bf(float f) { unsigned u = __builtin_bit_cast(unsigned, f); return (u + 0x7fffu + ((u >> 16) & 1u)) >> 16; }
typedef __bf16 bf16x2_t __attribute__((ext_vector_type(2)));
__device__ __forceinline__ unsigned pk2(float lo, float hi) { const f32x2 v = {lo, hi}; return __builtin_bit_cast(unsigned, __builtin_convertvector(v, bf16x2_t)); }
__device__ __forceinline__ float bf2f(unsigned short b) { return __builtin_bit_cast(float, (unsigned)b << 16); }
__device__ __forceinline__ float bflo(unsigned w) { return __builtin_bit_cast(float, w << 16); }
__device__ __forceinline__ float bfhi(unsigned w) { return __builtin_bit_cast(float, w & 0xffff0000u); }
__device__ __forceinline__ float shx(float v, int m, int lane) { return __int_as_float(__builtin_amdgcn_ds_bpermute((lane ^ m) << 2, __float_as_int(v))); }
__device__ __forceinline__ float wave_sum(float v, int lane) {
#pragma unroll
    for (int o = 1; o < 64; o <<= 1) v += shx(v, o, lane);
    return v;
}
__device__ __forceinline__ float sigmoidf_(float x) { return __builtin_amdgcn_rcpf(1.0f + __builtin_amdgcn_exp2f(-1.4426950408889634f * x)); }
__device__ __forceinline__ float siluf_(float x) { return x * __builtin_amdgcn_rcpf(1.0f + __builtin_amdgcn_exp2f(-1.4426950408889634f * x)); }
__device__ __forceinline__ void unpack8(u32x4 w, float* f) { f[0] = bflo(w.x); f[1] = bfhi(w.x); f[2] = bflo(w.y); f[3] = bfhi(w.y); f[4] = bflo(w.z); f[5] = bfhi(w.z); f[6] = bflo(w.w); f[7] = bfhi(w.w); }
__device__ __forceinline__ u32x4 pack8(const float* f) { u32x4 w; w.x = pk2(f[0], f[1]); w.y = pk2(f[2], f[3]); w.z = pk2(f[4], f[5]); w.w = pk2(f[6], f[7]); return w; }

namespace pg8 {
constexpr int BM = 256, BK = 64, HALF = 128, HTB = HALF * BK * 2, STAGE_BYTES = 8 * HTB, NXCD = 8, WGM = 4;
__host__ __device__ __forceinline__ int lds_byte(int r, int c) { const int st = (r >> 4) * 2 + (c >> 5), rr = r & 15, cc = c & 31, ob = rr * 64 + cc * 2; return st * 1024 + (ob ^ (((ob >> 9) & 1) << 5)); }
__host__ __device__ __forceinline__ void stage_rc(int b, int& R, int& C) { const int st = b / 1024, sb = b % 1024, swz = sb ^ (((sb >> 9) & 1) << 5); R = (st >> 1) * 16 + swz / 64; C = (st & 1) * 32 + (swz % 64) / 2; }
__host__ __device__ __forceinline__ int perm32(int rho) { const int n = rho >> 4, i = rho & 15; return 8 * (i >> 2) + 4 * n + (i & 3); }

struct Seg { const char* A; const char* B; int nt; int pm, pn, aux; bool first, last; };

__device__ __forceinline__ void tile_order(int L, int nM, int nN, int& pm, int& pn) {
    const int nwg = nM * nN; int wgid = L;
    { const int q = nwg / NXCD, r = nwg % NXCD, xcd = wgid % NXCD, off = wgid / NXCD; wgid = (xcd < r ? xcd * (q + 1) : r * (q + 1) + (xcd - r) * q) + off; }
    const int nig = WGM * nN, gid = wgid / nig, fm = gid * WGM, gsz = (nM - fm) < WGM ? (nM - fm) : WGM;
    pm = fm + ((wgid % nig) % gsz); pn = (wgid % nig) / gsz;
}

template <int LDA, int LDB, bool PERM, class Sched, class Epi>
__device__ __forceinline__ void gemm_phase(LAS unsigned char* lds, const Sched& S, const Epi& E) {
    int tid_ = threadIdx.x; asm volatile("" : "+v"(tid_));
    const int tid = tid_, wid = __builtin_amdgcn_readfirstlane(tid >> 6), lane = tid & 63, wr = wid >> 2, wc = wid & 3, fr = lane & 15, fq = lane >> 4;
    unsigned voffA[2], voffB[2];
#pragma unroll
    for (int i = 0; i < 2; ++i) { int R, C; stage_rc(tid * 16 + i * 8192, R, C); const int Rb = PERM ? ((R & ~31) + perm32(R & 31)) : R;
        voffA[i] = (unsigned)(R * LDA + C) * 2u; voffB[i] = (unsigned)(Rb * LDB + C) * 2u; }
    constexpr size_t kstep = (size_t)(BK * 2);
    constexpr size_t hstepA = (size_t)HALF * LDA * 2, hstepB = (size_t)HALF * LDB * 2;
    const unsigned ldsw = (unsigned)wid * 1024u;
    const int aoff = lds_byte(wr * 64 + fr, fq * 8), boff = lds_byte(wc * 32 + fr, fq * 8);
#define PG8_SA(b, h) (((b) * 2 + (h)) * HTB)
#define PG8_SB(b, h) ((4 + (b) * 2 + (h)) * HTB)
#define PG8_STAGE(bufoff, gbase, voff) do { _Pragma("unroll") for (int _i = 0; _i < 2; ++_i) \
        __builtin_amdgcn_global_load_lds((const unsigned*)((const char*)(gbase) + (voff)[_i]), (LAS unsigned*)(lds + (bufoff) + ldsw + _i * 8192), 16, 0, 0); } while (0)
#define PG8_LDA(dst, b, h) do { _Pragma("unroll") for (int m = 0; m < 4; ++m) _Pragma("unroll") for (int k = 0; k < 2; ++k) dst[m][k] = *(const LAS bf16x8*)(lds + PG8_SA(b, h) + aoff + m * 2048 + k * 1024); } while (0)
#define PG8_LDB(dst, b, h) do { _Pragma("unroll") for (int n = 0; n < 2; ++n) _Pragma("unroll") for (int k = 0; k < 2; ++k) dst[n][k] = *(const LAS bf16x8*)(lds + PG8_SB(b, h) + boff + n * 2048 + k * 1024); } while (0)
#define PG8_MMA(ai, bj, At, Bt) do { __builtin_amdgcn_s_setprio(1); _Pragma("unroll") for (int m = 0; m < 4; ++m) _Pragma("unroll") for (int n = 0; n < 2; ++n) _Pragma("unroll") for (int k = 0; k < 2; ++k) \
        acc[ai][bj][m][n] = __builtin_amdgcn_mfma_f32_16x16x32_bf16(Bt[n][k], At[m][k], acc[ai][bj][m][n], 0, 0, 0); __builtin_amdgcn_s_setprio(0); } while (0)
#define PG8_WAIT_V(n) asm volatile("s_waitcnt vmcnt(" #n ")" ::: "memory")
#define PG8_WAIT_L(n) asm volatile("s_waitcnt lgkmcnt(" #n ")" ::: "memory")
#define PG8_BAR __builtin_amdgcn_s_barrier()
#define PG8_SCHED __builtin_amdgcn_sched_barrier(0)
    Seg cur, nxt; int ui = 0;
    if (!S.next(0, cur)) return;
    f32x4 acc[2][2][4][2];
#pragma unroll
    for (int a = 0; a < 2; ++a)
#pragma unroll
        for (int b = 0; b < 2; ++b)
#pragma unroll
            for (int m = 0; m < 4; ++m)
#pragma unroll
                for (int n = 0; n < 2; ++n) acc[a][b][m][n] = (f32x4){0.f, 0.f, 0.f, 0.f};
    bf16x8 At[4][2], B0[2][2], B1[2][2];
    const char* cA = cur.A; const char* cB = cur.B;
    PG8_STAGE(PG8_SB(0, 0), cB, voffB); PG8_STAGE(PG8_SB(0, 1), cB + hstepB, voffB); PG8_STAGE(PG8_SA(0, 0), cA, voffA); PG8_STAGE(PG8_SA(0, 1), cA + hstepA, voffA);
    if (wr == 1) PG8_BAR;
    PG8_WAIT_V(2); PG8_BAR;
    PG8_STAGE(PG8_SB(1, 0), cB + kstep, voffB); PG8_STAGE(PG8_SA(1, 0), cA + kstep, voffA); PG8_STAGE(PG8_SB(1, 1), cB + hstepB + kstep, voffB);
    PG8_WAIT_V(6); PG8_BAR;
    for (;;) {
        const bool has_next = S.next(ui + 1, nxt);
        const char* nA = has_next ? nxt.A : cA; const char* nB = has_next ? nxt.B : cB;
        const int nt = cur.nt;
        for (int t = 0; t < nt; t += 2) {
            const bool last = (t == nt - 2);
            const char* a1 = cA + (size_t)(t + 1) * kstep;
            const char* a2 = last ? nA : cA + (size_t)(t + 2) * kstep; const char* b2 = last ? nB : cB + (size_t)(t + 2) * kstep;
            const char* a3 = a2 + kstep; const char* b3 = b2 + kstep;
            PG8_LDB(B0, 0, 0); PG8_LDB(B1, 0, 1); PG8_SCHED; PG8_LDA(At, 0, 0); PG8_STAGE(PG8_SA(1, 1), a1 + hstepA, voffA);
            PG8_WAIT_V(8); PG8_WAIT_L(0); PG8_BAR; PG8_MMA(0, 0, At, B0); PG8_MMA(0, 1, At, B1); PG8_BAR; PG8_SCHED;
            PG8_LDA(At, 0, 1); PG8_STAGE(PG8_SB(0, 0), b2, voffB); PG8_STAGE(PG8_SB(0, 1), b2 + hstepB, voffB); PG8_STAGE(PG8_SA(0, 0), a2, voffA);
            PG8_WAIT_V(8); PG8_WAIT_L(0); PG8_BAR; PG8_MMA(1, 0, At, B0); PG8_MMA(1, 1, At, B1); PG8_BAR; PG8_SCHED;
            PG8_LDB(B0, 1, 0); PG8_LDB(B1, 1, 1); PG8_SCHED; PG8_LDA(At, 1, 0); PG8_STAGE(PG8_SA(0, 1), a2 + hstepA, voffA);
            PG8_WAIT_V(8); PG8_WAIT_L(0); PG8_BAR; PG8_MMA(0, 0, At, B0); PG8_MMA(0, 1, At, B1); PG8_BAR; PG8_SCHED;
            PG8_LDA(At, 1, 1); PG8_STAGE(PG8_SB(1, 0), b3, voffB); PG8_STAGE(PG8_SB(1, 1), b3 + hstepB, voffB); PG8_STAGE(PG8_SA(1, 0), a3, voffA);
            PG8_WAIT_V(8); PG8_WAIT_L(0); PG8_BAR; PG8_MMA(1, 0, At, B0); PG8_MMA(1, 1, At, B1); PG8_BAR; PG8_SCHED;
        }
        const bool was_last = cur.last;
        if (was_last) { if (wr == 0) PG8_BAR; E(acc, cur, wr, wc, fr, fq); }
        if (!has_next) break;
        if (nxt.first) {
#pragma unroll
            for (int a = 0; a < 2; ++a)
#pragma unroll
                for (int b = 0; b < 2; ++b)
#pragma unroll
                    for (int m = 0; m < 4; ++m)
#pragma unroll
                        for (int n = 0; n < 2; ++n) acc[a][b][m][n] = (f32x4){0.f, 0.f, 0.f, 0.f};
        }
        cur = nxt; cA = nA; cB = nB; ++ui;
        if (was_last) { if (wr == 1) PG8_BAR; }
    }
    PG8_WAIT_V(0);
    PG8_BAR;
#undef PG8_SA
#undef PG8_SB
#undef PG8_STAGE
#undef PG8_LDA
#undef PG8_LDB
#undef PG8_MMA
#undef PG8_WAIT_V
#undef PG8_WAIT_L
#undef PG8_BAR
#undef PG8_SCHED
}
}
using pg8::Seg;

struct Ctx {
    LAS unsigned char* lds; int tid, lane, wave, G, bid;
};
typedef const __attribute__((address_space(4))) Params* PP;
__device__ __forceinline__ PP getpp() { PP p = (PP)__builtin_amdgcn_kernarg_segment_ptr(); asm volatile("" : "+s"(p)); return p; }
__device__ __forceinline__ unsigned char* half_a_base(int layer) { PP p = getpp(); return layer == 0 ? (unsigned char*)p->out : p->ws + D_XN1; }
#define GW(F) ((F).bid * 8 + (F).wave)
#define NGW(F) ((F).G * 8)
#define LDS_WAIT() asm volatile("s_waitcnt lgkmcnt(0)" ::: "memory")

struct TrJob {
    const float* s0; const float* s1; int spitch; int K; int nd; int mode; int c0; int nvalid; const float* ks;
    bf16_t* dlo; bf16_t* dhi; int dpitch; int ksplit;
};
__device__ __forceinline__ void tr_item(const TrJob& J, LAS float* scr, int item, int lane) {
    const int nblk = J.nd / 32, kb = item / nblk, nb = item % nblk, k0 = 64 * kb, n0 = 32 * nb;
    const int np = n0 + (lane & 31);
    const float* src = J.s0; int col = 0; bool valid = true;
    if (J.mode == 0) { col = J.c0 + np; valid = np < J.nvalid; }
    else if (J.mode == 1) { if (np < 512) col = (np >> 6) * 128 + (np & 63); else col = ((np - 512) >> 6) * 128 + 64 + (np & 63); }
    else { const int tile = np >> 8, w = np & 255; if (w < 128) col = tile * 128 + w; else { col = tile * 128 + (w - 128); src = J.s1; } }
    if (!valid) col = J.c0;
    const float* sp = src + (size_t)(k0 + (lane >> 5)) * J.spitch + col;
    float v[32];
#pragma unroll
    for (int i = 0; i < 32; ++i) v[i] = __builtin_nontemporal_load(sp + (size_t)(2 * i) * J.spitch);
    if (J.ks) {
#pragma unroll
        for (int i = 0; i < 32; ++i) v[i] *= J.ks[k0 + 2 * i + (lane >> 5)]; }
#pragma unroll
    for (int i = 0; i < 32; ++i) scr[(2 * i + (lane >> 5)) * 33 + (lane & 31)] = valid ? v[i] : 0.f;
    LDS_WAIT(); asm volatile("" ::: "memory");
    const int c = lane & 7;
    bf16_t* dst = (k0 < J.ksplit) ? J.dlo : J.dhi; const int kd = (k0 < J.ksplit) ? k0 : k0 - J.ksplit;
#pragma unroll
    for (int j = 0; j < 4; ++j) { const int n = (lane >> 3) + 8 * j; const LAS float* s = scr + (8 * c) * 33 + n;
        u32x4 o; o.x = pk2(s[0 * 33], s[1 * 33]); o.y = pk2(s[2 * 33], s[3 * 33]); o.z = pk2(s[4 * 33], s[5 * 33]); o.w = pk2(s[6 * 33], s[7 * 33]);
        *(u32x4*)(dst + (size_t)(n0 + n) * J.dpitch + kd + 8 * c) = o; }
    LDS_WAIT(); asm volatile("" ::: "memory");
}
__device__ __forceinline__ void tr_job(const Ctx& F, const TrJob& J, int& rot) {
    LAS float* scr = (LAS float*)(F.lds + F.wave * 8704);
    const int nitems = (J.K / 64) * (J.nd / 32); const int ngw = NGW(F);
    int first = (GW(F) - rot % ngw); if (first < 0) first += ngw;
    for (int it = first; it < nitems; it += ngw) tr_item(J, scr, it, F.lane);
    rot += nitems;
}
__device__ __forceinline__ TrJob mk_job(const float* s0, int spitch, int K, int nd, int c0, int nvalid, bf16_t* dst, int dpitch) {
    TrJob J; J.s0 = s0; J.s1 = nullptr; J.spitch = spitch; J.K = K; J.nd = nd; J.mode = 0; J.c0 = c0; J.nvalid = nvalid; J.ks = nullptr; J.dlo = dst; J.dhi = dst; J.dpitch = dpitch; J.ksplit = 1 << 30; return J;
}

__device__ __forceinline__ void phase0(const Ctx& F) {
    PP P = getpp(); unsigned char* ws = P->ws;
    {
        float* cr = (float*)(ws + WS_ROPE_R); float* sr = cr + 4096 * 32; float* cm = (float*)(ws + WS_ROPE_M); float* sm = cm + 4096 * 16;
        for (int i = F.bid * NTHREADS + F.tid; i < 4096 * 48; i += F.G * NTHREADS) {
            const int t = i / 48, j = i % 48; const float row = (float)(t >> 6), colp = (float)(t & 63);
            if (j < 32) { const int f = j & 15; const float inv = powf(10000.0f, -(float)f / 16.0f); const float ang = (j < 16 ? row : colp) * inv; cr[t * 32 + j] = cosf(ang); sr[t * 32 + j] = sinf(ang); }
            else { const int jj = j - 32, f = jj & 7; const float inv = powf(10000.0f, -(float)f / 8.0f); const float ang = (jj < 8 ? row : colp) * inv; cm[t * 16 + jj] = cosf(ang); sm[t * 16 + jj] = sinf(ang); }
        }
        if (F.bid == 0 && F.tid < 64) ((unsigned*)(ws + WS_CTL))[F.tid] = 0u;
    }
    {
        LAS float* sc = (LAS float*)(F.lds + 70000);
        LAS float* red = (LAS float*)(F.lds + 70000 + 36864);
        for (int i = F.tid; i < 9 * 1024; i += NTHREADS) { const int v = i >> 10, k = i & 1023; const float x = v < 8 ? P->in[I_C][v * 1024 + k] : P->in[I_CCTX][k]; sc[i] = siluf_(x); }
        __syncthreads();
        for (int it = F.bid; it < 2 * 96; it += F.G) {
            const int l = it / 96, jc = F.tid & 63, j = (it % 96) * 64 + jc, ksl = F.tid >> 6;
            const float* w = P->in[I_WMOD] + (size_t)l * 1024 * 6144 + j + (size_t)(ksl * 128) * 6144;
            float a[9];
#pragma unroll
            for (int v = 0; v < 9; ++v) a[v] = 0.f;
#pragma unroll 1
            for (int k0 = 0; k0 < 128; k0 += 16) { float wv[16];
#pragma unroll
                for (int q = 0; q < 16; ++q) wv[q] = w[(size_t)(k0 + q) * 6144];
#pragma unroll
                for (int q = 0; q < 16; ++q)
#pragma unroll
                    for (int v = 0; v < 9; ++v) a[v] += sc[v * 1024 + ksl * 128 + k0 + q] * wv[q]; }
#pragma unroll
            for (int v = 0; v < 9; ++v) red[(ksl * 64 + jc) * 9 + v] = a[v];
            __syncthreads();
            if (F.tid < 64) {
                float* mo = (float*)(ws + WS_MOD) + (size_t)l * 9 * 6144;
#pragma unroll
                for (int v = 0; v < 9; ++v) { float s = 0.f;
#pragma unroll
                    for (int q = 0; q < 8; ++q) s += red[(q * 64 + F.tid) * 9 + v];
                    mo[v * 6144 + j] = s + P->in[I_BMOD][l * 6144 + j]; }
            }
            __syncthreads();
        }
    }
    int rot = (192 * 8) % NGW(F);
    for (int l = 0; l < 2; ++l) {
        unsigned char* wb = ws + WS_W + (size_t)l * WL_STRIDE;
        const float* win = P->in[I_WIN] + (size_t)l * 1024 * NIN;
        { TrJob J = mk_job(win, NIN, 1024, MIXP, 0, MIXC, (bf16_t*)(wb + WL_WINLO), 512); J.dhi = (bf16_t*)(wb + WL_WINHI); J.ksplit = 512; tr_job(F, J, rot); }
        { TrJob J = mk_job(win, NIN, 1024, GATEC, MIXC, GATEC, (bf16_t*)(wb + WL_WGLO), 512); J.dhi = (bf16_t*)(wb + WL_WGHI); J.ksplit = 512; tr_job(F, J, rot); }
        { TrJob J = mk_job(P->in[I_QUP] + (size_t)l * 384 * 768, 768, 384, 768, 0, 768, (bf16_t*)(wb + WL_WQ), 384); J.ks = P->in[I_QN] + l * 384; tr_job(F, J, rot); }
        { TrJob J = mk_job(P->in[I_KVUP] + (size_t)l * 256 * 1024, 1024, 256, 1024, 0, 1024, (bf16_t*)(wb + WL_WKV), 256); J.mode = 1; J.ks = P->in[I_KVN] + l * 256; tr_job(F, J, rot); }
        for (int n = 0; n < 3; ++n) { TrJob J = mk_job(P->in[I_WBR] + ((size_t)l * 3 + n) * 512 * 1024, 1024, 512, 1024, 0, 1024, (bf16_t*)(wb + WL_WB) + (size_t)n * 1024 * 512, 512); tr_job(F, J, rot); }
        { TrJob J = mk_job(P->in[I_WOUT] + (size_t)l * 1024 * 1024, 1024, 1024, 1024, 0, 1024, (bf16_t*)(wb + WL_WO), 1024); tr_job(F, J, rot); }
        { TrJob J = mk_job(P->in[I_G2] + (size_t)l * 128 * 512, 512, 128, 512, 0, 512, (bf16_t*)(ws + WS_WG2) + (size_t)l * 512 * 128, 128); tr_job(F, J, rot); }
        for (int dd = 0; dd < 2; ++dd) {
            { TrJob J = mk_job(P->in[I_W2] + (size_t)(l * 2 + dd) * 64 * 512, 512, 64, 512, 0, 512, (bf16_t*)(ws + WS_W2T) + (size_t)((l * 2 + dd) * 2 + 0) * 512 * 64, 64); tr_job(F, J, rot); }
            { TrJob J = mk_job(P->in[I_A2] + (size_t)(l * 2 + dd) * 64 * 512, 512, 64, 512, 0, 512, (bf16_t*)(ws + WS_W2T) + (size_t)((l * 2 + dd) * 2 + 1) * 512 * 64, 64); tr_job(F, J, rot); }
        }
    }
}
__device__ __forceinline__ void convert_ffn0(const Ctx& F) {
    PP P = getpp(); unsigned char* ws = P->ws;
    bf16_t* glo = (bf16_t*)(ws + D_FFW); bf16_t* ghi = glo + (size_t)5632 * 512; bf16_t* wd = ghi + (size_t)5632 * 512;
    int rot = 0;
    { TrJob J = mk_job(P->in[I_FG], DFF, 1024, 5632, 0, 5632, glo, 512); J.s1 = P->in[I_FU]; J.mode = 2; J.dhi = ghi; J.ksplit = 512; tr_job(F, J, rot); }
    { TrJob J = mk_job(P->in[I_FD], 1024, DFF, 1024, 0, 1024, wd, DFF); tr_job(F, J, rot); }
}
__device__ __forceinline__ void convert_moe(const Ctx& F) {
    PP P = getpp(); unsigned char* ws = P->ws;
    int rot = 0;
    for (int e = 0; e < NEXP; ++e) {
        bf16_t* glo = (bf16_t*)(ws + D_MOEW + (size_t)e * (33 * MiB / 4)); bf16_t* ghi = glo + (size_t)2816 * 512; bf16_t* wd = ghi + (size_t)2816 * 512;
        { TrJob J = mk_job(P->in[I_MG] + (size_t)e * 1024 * DFE, DFE, 1024, 2816, 0, 2816, glo, 512); J.s1 = P->in[I_MU2] + (size_t)e * 1024 * DFE; J.mode = 2; J.dhi = ghi; J.ksplit = 512; tr_job(F, J, rot); }
        { TrJob J = mk_job(P->in[I_MD] + (size_t)e * DFE * 1024, 1024, DFE, 1024, 0, 1024, wd, DFE); tr_job(F, J, rot); }
    }
}

__device__ __forceinline__ void norm_pass(const Ctx& F, int layer, int which, const float* hl, const float* hcx, int nrows, bf16_t* xlo, bf16_t* xhi) {
    PP P = getpp();
    const float* gain = P->in[which ? I_NFFN : I_NMIX] + layer * 1024;
    const float* mod = (const float*)(P->ws + WS_MOD) + (size_t)layer * 9 * 6144 + (which ? 3072 : 0);
    const int rpw = (nrows + NGW(F) - 1) / NGW(F); const int r0 = GW(F) * rpw; const int r1 = (r0 + rpw < nrows) ? r0 + rpw : nrows;
    int vprev = -1; f32x4 gs[4], sh4[4];
    constexpr int NB = 4;
    for (int rb = r0; rb < r1; rb += NB) {
        f32x4 x[NB][4]; float ss[NB];
#pragma unroll
        for (int b = 0; b < NB; ++b) { const int row = (rb + b < r1) ? rb + b : r1 - 1;
            const float* src = row < RL ? hl + (size_t)row * 1024 : hcx + (size_t)(row - RL) * 1024; ss[b] = 0.f;
#pragma unroll
            for (int j = 0; j < 4; ++j) { x[b][j] = *(const f32x4*)(src + 4 * F.lane + 256 * j); ss[b] += x[b][j].x * x[b][j].x + x[b][j].y * x[b][j].y + x[b][j].z * x[b][j].z + x[b][j].w * x[b][j].w; } }
#pragma unroll
        for (int b = 0; b < NB; ++b) ss[b] = wave_sum(ss[b], F.lane);
#pragma unroll
        for (int b = 0; b < NB; ++b) { const int row = (rb + b < r1) ? rb + b : r1 - 1;
            const int v = row < RL ? (row >> 12) : 8;
            if (v != vprev) { const float* sh = mod + v * 6144; const float* sc = sh + 1024;
#pragma unroll
                for (int j = 0; j < 4; ++j) { const int c = 4 * F.lane + 256 * j; gs[j] = *(const f32x4*)(gain + c) * (*(const f32x4*)(sc + c) + 1.0f); sh4[j] = *(const f32x4*)(sh + c); }
                vprev = v; }
            const float rstd = rsqrtf(ss[b] * (1.0f / 1024.0f) + 1e-6f);
#pragma unroll
            for (int j = 0; j < 4; ++j) { const int c = 4 * F.lane + 256 * j;
                const f32x4 y = x[b][j] * rstd * gs[j] + sh4[j];
                u32x2 o; o.x = pk2(y.x, y.y); o.y = pk2(y.z, y.w);
                bf16_t* d = (c < 512) ? xlo + (size_t)row * 512 + c : xhi + (size_t)row * 512 + (c - 512);
                *(u32x2*)d = o; } }
    }
}

struct SchedSplit2 {
    const char *Alo, *Ahi, *Blo, *Bhi; int nM, nN, G, c;
    __device__ __forceinline__ bool next(int i, Seg& s) const {
        const int iu = i >> 1, h = i & 1; const long L = (long)iu * G + c; if (L >= (long)nM * nN) return false;
        int pm, pn; pg8::tile_order((int)L, nM, nN, pm, pn);
        s.A = (h ? Ahi : Alo) + (size_t)pm * 256 * 1024; s.B = (h ? Bhi : Blo) + (size_t)pn * 256 * 1024; s.nt = 8; s.pm = pm; s.pn = pn; s.aux = 0; s.first = (h == 0); s.last = (h == 1); return true;
    }
};
struct Sched1 {
    const char *A, *B; size_t astride, bstride; int nt, nM, nN, G, c;
    __device__ __forceinline__ bool next(int i, Seg& s) const {
        const long L = (long)i * G + c; if (L >= (long)nM * nN) return false;
        int pm, pn; pg8::tile_order((int)L, nM, nN, pm, pn);
        s.A = A + (size_t)pm * astride; s.B = B + (size_t)pn * bstride; s.nt = nt; s.pm = pm; s.pn = pn; s.aux = 0; s.first = true; s.last = true; return true;
    }
};
struct SchedHalf {
    const char *A, *B; size_t astride, bstride; int nt, nN, half, G, c;
    __device__ __forceinline__ bool next(int i, Seg& s) const {
        const long L = (long)i * G + c; if (L >= (long)68 * nN) return false;
        int mi, pn; pg8::tile_order((int)L, 68, nN, mi, pn);
        const int pm = mi < 64 ? 64 * half + mi : 128 + 4 * half + (mi - 64);
        s.A = A + (size_t)pm * astride; s.B = B + (size_t)pn * bstride; s.nt = nt; s.pm = pm; s.pn = pn; s.aux = 0; s.first = true; s.last = true; return true;
    }
};
struct SchedMerge {
    const char *XNlo, *XNhi, *WgLo, *WgHi, *wsb, *Wb; int nM, G, c; bool ctx3;
    __device__ __forceinline__ void fill(Seg& s, int pm, int pn, int n, int k, int ctxbit) const {
        s.pm = pm; s.pn = pn; s.nt = 8;
        if (k == 0) { s.A = XNlo + (size_t)pm * 256 * 1024; s.B = WgLo + (size_t)(n * 1024 + pn * 256) * 1024; s.first = true; s.last = false; s.aux = n * 2; }
        else if (k == 1) { s.A = XNhi + (size_t)pm * 256 * 1024; s.B = WgHi + (size_t)(n * 1024 + pn * 256) * 1024; s.first = false; s.last = true; s.aux = n * 2; }
        else { const size_t yo = (n == 0) ? D_YRWKV : ((n == 1) ? D_YRET : D_YMLA); s.A = wsb + yo + (size_t)pm * 256 * 1024; s.B = Wb + (size_t)(n * 1024 + pn * 256) * 1024; s.first = true; s.last = true; s.aux = n * 2 + 1 + ctxbit; }
    }
    __device__ __forceinline__ bool next(int i, Seg& s) const {
        const int nMl = ctx3 ? RL / 256 : nM; const int NL = nMl * 4;
        const int kmax = (NL - c + G - 1) / G;
        if (i < 9 * kmax) { const int su = i / 9, r = i % 9; const long L = (long)su * G + c; int pm, pn; pg8::tile_order((int)L, nMl, 4, pm, pn); fill(s, pm, pn, r / 3, r % 3, 0); return true; }
        if (!ctx3) return false;
        const int j = i - 9 * kmax, t = j / 3, k = j % 3; const long idx = (long)t * G + c; if (idx >= 96) return false;
        const int tile = (int)idx / 3, n = (int)idx % 3; fill(s, RL / 256 + (tile & 7), tile >> 3, n, k, 8); return true;
    }
};
struct SchedWout0 {
    const char *A, *B, *wsb; int G, c;
    __device__ __forceinline__ bool next(int i, Seg& s) const {
        if (c < 32) { if (i >= 3) return false; const int pmc = c & 7, pn = c >> 3;
            const size_t ao = (i == 0) ? D_M + (size_t)RL * 1024 * 2 : ((i == 1) ? D_P12 : D_P12 + (size_t)RC * 1024 * 2);
            s.A = wsb + ao + (size_t)pmc * 256 * 1024 * 2; s.B = B + (size_t)pn * 256 * 1024 * 2; s.nt = 16; s.pm = RL / 256 + pmc; s.pn = pn; s.aux = 0; s.first = (i == 0); s.last = (i == 2); return true; }
        const long L = (long)i * (G - 32) + (c - 32); if (L >= (RL / 256) * 4) return false;
        int pm, pn; pg8::tile_order((int)L, RL / 256, 4, pm, pn);
        s.A = A + (size_t)pm * 256 * 1024 * 2; s.B = B + (size_t)pn * 256 * 1024 * 2; s.nt = 16; s.pm = pm; s.pn = pn; s.aux = 0; s.first = true; s.last = true; return true;
    }
};
struct MoeTiles { int tstart[NEXP + 1]; };
__device__ __forceinline__ MoeTiles moe_tiles(const unsigned* cnt) {
    MoeTiles T; int a = 0;
#pragma unroll
    for (int e = 0; e < NEXP; ++e) { T.tstart[e] = a; a += (int)((__builtin_amdgcn_readfirstlane(cnt[e]) + 255u) >> 8); }
    T.tstart[NEXP] = a; return T;
}
__device__ __forceinline__ int moe_expert_of(const MoeTiles& T, int mt) { int e = 0;
#pragma unroll
    for (int k = 1; k < NEXP; ++k) e += (mt >= T.tstart[k]) ? 1 : 0;
    return e; }
struct SchedMoeUp {
    const char *Alo, *Ahi, *W; MoeTiles T; int G, c;
    __device__ __forceinline__ bool next(int i, Seg& s) const {
        const int iu = i >> 1, h = i & 1; const int nM = T.tstart[NEXP]; const long L = (long)iu * G + c; if (L >= (long)nM * 11) return false;
        int pm, pn; pg8::tile_order((int)L, nM, 11, pm, pn);
        const int e = moe_expert_of(T, pm); const char* we = W + (size_t)e * (33 * MiB / 4);
        s.A = (h ? Ahi : Alo) + (size_t)pm * 256 * 1024; s.B = we + (h ? (size_t)2816 * 1024 : 0) + (size_t)pn * 256 * 1024; s.nt = 8; s.pm = pm; s.pn = pn; s.aux = e; s.first = (h == 0); s.last = (h == 1); return true;
    }
};
struct SchedMoeDown {
    const char *A, *W; MoeTiles T; int G, c;
    __device__ __forceinline__ bool next(int i, Seg& s) const {
        const int nM = T.tstart[NEXP]; const long L = (long)i * G + c; if (L >= (long)nM * 4) return false;
        int pm, pn; pg8::tile_order((int)L, nM, 4, pm, pn);
        const int e = moe_expert_of(T, pm); const char* we = W + (size_t)e * (33 * MiB / 4) + (size_t)2 * 2816 * 1024;
        s.A = A + (size_t)pm * 256 * DFE * 2; s.B = we + (size_t)pn * 256 * DFE * 2; s.nt = 22; s.pm = pm; s.pn = pn; s.aux = e; s.first = true; s.last = true; return true;
    }
};

typedef f32x4 Acc[2][2][4][2];
struct EpiInproj {
    unsigned char* ws;
    __device__ __forceinline__ void operator()(const Acc& acc, const Seg& u, int wr, int wc, int fr, int fq) const {
        const int row0 = u.pm * 256 + wr * 64 + fr;
#pragma unroll
        for (int bj = 0; bj < 2; ++bj) {
            const int c0 = u.pn * 256 + bj * 128 + wc * 32 + 8 * fq;
            const bool a = c0 < RWC, b = c0 < RWC + REC;
            const size_t boff = a ? D_URWKV : (b ? D_URET : D_UMLA); const int pitch = a ? RWC : (b ? REC : MLC); const int col = c0 - (a ? 0 : (b ? RWC : RWC + REC));
            bf16_t* base = (bf16_t*)(ws + boff);
            if (c0 < MIXC) {
#pragma unroll
                for (int ai = 0; ai < 2; ++ai)
#pragma unroll
                    for (int m = 0; m < 4; ++m) { const int row = row0 + ai * 128 + m * 16; const f32x4 v0 = acc[ai][bj][m][0], v1 = acc[ai][bj][m][1];
                        u32x4 w; w.x = pk2(v0[0], v0[1]); w.y = pk2(v0[2], v0[3]); w.z = pk2(v1[0], v1[1]); w.w = pk2(v1[2], v1[3]);
                        *(u32x4*)(base + (size_t)row * pitch + col) = w; }
            }
        }
    }
};
struct EpiQup {
    bf16_t* Q; const float* rstd; const float* cosm; const float* sinm; int compact;
    __device__ __forceinline__ void operator()(const Acc& acc, const Seg& u, int wr, int wc, int fr, int fq) const {
        const int row0 = u.pm * 256 + wr * 64 + fr; const bool lat = u.pm * 256 < RL;
        const int cbA = u.pn * 256 + wc * 32; const bool ropeA = lat && ((cbA % 96) == 64), ropeB = lat && (((cbA + 128) % 96) == 64);
        float rsv[8]; f32x4 cs[8], sn[8];
#pragma unroll
        for (int r = 0; r < 8; ++r) rsv[r] = rstd[row0 + (r >> 2) * 128 + (r & 3) * 16];
        if (ropeA || ropeB) {
#pragma unroll
            for (int r = 0; r < 8; ++r) { const int t = (row0 + (r >> 2) * 128 + (r & 3) * 16) & 4095; cs[r] = *(const f32x4*)(cosm + t * 16 + 4 * fq); sn[r] = *(const f32x4*)(sinm + t * 16 + 4 * fq); }
        } else {
#pragma unroll
            for (int r = 0; r < 8; ++r) { cs[r] = (f32x4){1.f, 1.f, 1.f, 1.f}; sn[r] = (f32x4){0.f, 0.f, 0.f, 0.f}; }
        }
        __builtin_amdgcn_sched_barrier(0);
#pragma unroll
        for (int ai = 0; ai < 2; ++ai)
#pragma unroll
            for (int m = 0; m < 4; ++m) { const int row = row0 + ai * 128 + m * 16; const float rs = rsv[ai * 4 + m];
#pragma unroll
                for (int bj = 0; bj < 2; ++bj) { const int cb = cbA + bj * 128; const bool rope = bj ? ropeB : ropeA;
                    f32x4 x1 = acc[ai][bj][m][0] * rs, x2 = acc[ai][bj][m][1] * rs;
                    if (rope) { const f32x4 o1 = x1 * cs[ai * 4 + m] - x2 * sn[ai * 4 + m], o2 = x1 * sn[ai * 4 + m] + x2 * cs[ai * 4 + m]; x1 = o1; x2 = o2; }
                    u32x2 a, b; a.x = pk2(x1[0], x1[1]); a.y = pk2(x1[2], x1[3]); b.x = pk2(x2[0], x2[1]); b.y = pk2(x2[2], x2[3]);
                    const int orow = compact ? (lat ? row : row - RL + 4 * SEQ) : row;
                    bf16_t* d = Q + (size_t)orow * 768 + cb + 4 * fq; *(u32x2*)d = a; *(u32x2*)(d + 16) = b; } }
    }
};
struct EpiKVup {
    bf16_t *Kb, *Vb; const float* rstd; int compact;
    __device__ __forceinline__ void operator()(const Acc& acc, const Seg& u, int wr, int wc, int fr, int fq) const {
        const int row0 = u.pm * 256 + wr * 64 + fr;
        float rsv[8];
#pragma unroll
        for (int r = 0; r < 8; ++r) rsv[r] = rstd[row0 + (r >> 2) * 128 + (r & 3) * 16];
        __builtin_amdgcn_sched_barrier(0);
#pragma unroll
        for (int ai = 0; ai < 2; ++ai)
#pragma unroll
            for (int m = 0; m < 4; ++m) { const int row = row0 + ai * 128 + m * 16; const float rs = rsv[ai * 4 + m];
#pragma unroll
                for (int bj = 0; bj < 2; ++bj) { const int c0 = u.pn * 256 + bj * 128 + wc * 32 + 8 * fq; const f32x4 v0 = acc[ai][bj][m][0] * rs, v1 = acc[ai][bj][m][1] * rs;
                    u32x4 w; w.x = pk2(v0[0], v0[1]); w.y = pk2(v0[2], v0[3]); w.z = pk2(v1[0], v1[1]); w.w = pk2(v1[2], v1[3]);
                    const int orow = compact ? (row < RL ? row : row - RL + 4 * SEQ) : row;
                    bf16_t* d = (u.pn < 2) ? Kb + (size_t)orow * 544 + c0 : Vb + (size_t)orow * 512 + (c0 - 512);
                    *(u32x4*)d = w; } }
    }
};
struct EpiMerge {
    u32x4* scr; bf16_t* M; bf16_t* P12;
    __device__ __forceinline__ void operator()(const Acc& acc, const Seg& u, int wr, int wc, int fr, int fq) const {
        int tid = threadIdx.x; asm volatile("" : "+v"(tid));
        if ((u.aux & 1) == 0) {
#pragma unroll
            for (int ai = 0; ai < 2; ++ai)
#pragma unroll
                for (int bj = 0; bj < 2; ++bj)
#pragma unroll
                    for (int m = 0; m < 4; ++m) { const f32x4 v0 = acc[ai][bj][m][0], v1 = acc[ai][bj][m][1];
                        u32x4 w; w.x = pk2(sigmoidf_(v0[0]), sigmoidf_(v0[1])); w.y = pk2(sigmoidf_(v0[2]), sigmoidf_(v0[3])); w.z = pk2(sigmoidf_(v1[0]), sigmoidf_(v1[1])); w.w = pk2(sigmoidf_(v1[2]), sigmoidf_(v1[3]));
                        scr[((ai * 2 + bj) * 4 + m) * 512 + tid] = w; }
        } else {
            const int n = (u.aux & 7) >> 1; const bool part = (u.aux & 8) != 0; const int row0 = u.pm * 256 + wr * 64 + fr; const bool accum = n > 0 && !part;
            u32x4 gq[2][4], pq[2][4];
#pragma unroll
            for (int k = 0; k < 5; ++k) {
                if (k < 4) { const int ai = k >> 1, bj = k & 1;
#pragma unroll
                    for (int m = 0; m < 4; ++m) { const int row = row0 + ai * 128 + m * 16; const int c0 = u.pn * 256 + bj * 128 + wc * 32 + 8 * fq;
                        gq[k & 1][m] = scr[((ai * 2 + bj) * 4 + m) * 512 + tid];
                        if (accum) pq[k & 1][m] = *(const u32x4*)(M + (size_t)row * 1024 + c0); else pq[k & 1][m] = (u32x4){0u, 0u, 0u, 0u}; } }
                if (k > 0) { const int kk = k - 1, ai = kk >> 1, bj = kk & 1;
#pragma unroll
                    for (int m = 0; m < 4; ++m) { const int row = row0 + ai * 128 + m * 16; const int c0 = u.pn * 256 + bj * 128 + wc * 32 + 8 * fq;
                        float gf[8], pf[8]; unpack8(gq[kk & 1][m], gf); unpack8(pq[kk & 1][m], pf);
                        const f32x4 v0 = acc[ai][bj][m][0], v1 = acc[ai][bj][m][1];
                        bf16_t* d = (part && n > 0) ? P12 + (size_t)(n - 1) * RC * 1024 + (size_t)(row - RL) * 1024 + c0 : M + (size_t)row * 1024 + c0;
#pragma unroll
                        for (int j = 0; j < 4; ++j) { pf[j] += gf[j] * v0[j]; pf[4 + j] += gf[4 + j] * v1[j]; }
                        *(u32x4*)d = pack8(pf); } }
            }
        }
    }
};
struct EpiResid {
    const float *srcl, *srcc; float *dstl, *dstc; const float* mod; int goff;
    __device__ __forceinline__ void operator()(const Acc& acc, const Seg& u, int wr, int wc, int fr, int fq) const {
        const int row0 = u.pm * 256 + wr * 64 + fr; const bool lat = u.pm * 256 < RL;
        const float* sb = lat ? srcl : srcc; float* db = lat ? dstl : dstc; const size_t rsub = lat ? 0 : (size_t)RL;
        const float* g = mod + (lat ? ((u.pm * 256) >> 12) : 8) * 6144 + goff;
        f32x4 gv[2][2];
#pragma unroll
        for (int bj = 0; bj < 2; ++bj)
#pragma unroll
            for (int n = 0; n < 2; ++n) gv[bj][n] = *(const f32x4*)(g + u.pn * 256 + bj * 128 + wc * 32 + 16 * n + 4 * fq);
        f32x4 sv[2][2][2][2];
#pragma unroll
        for (int k = 0; k < 5; ++k) {
            if (k < 4) {
#pragma unroll
                for (int mm = 0; mm < 2; ++mm) { const int row = row0 + (k >> 1) * 128 + ((k & 1) * 2 + mm) * 16; const float* s = sb + ((size_t)row - rsub) * 1024;
#pragma unroll
                    for (int bj = 0; bj < 2; ++bj)
#pragma unroll
                        for (int n = 0; n < 2; ++n) sv[k & 1][mm][bj][n] = *(const f32x4*)(s + u.pn * 256 + bj * 128 + wc * 32 + 16 * n + 4 * fq); } }
            if (k > 0) { const int kk = k - 1, ai = kk >> 1;
#pragma unroll
                for (int mm = 0; mm < 2; ++mm) { const int m = (kk & 1) * 2 + mm; const int row = row0 + ai * 128 + m * 16; float* d = db + ((size_t)row - rsub) * 1024;
#pragma unroll
                    for (int bj = 0; bj < 2; ++bj)
#pragma unroll
                        for (int n = 0; n < 2; ++n) *(f32x4*)(d + u.pn * 256 + bj * 128 + wc * 32 + 16 * n + 4 * fq) = sv[kk & 1][mm][bj][n] + gv[bj][n] * acc[ai][bj][m][n]; } }
        }
    }
};
struct EpiSwiglu {
    bf16_t* H; int pitch;
    __device__ __forceinline__ void operator()(const Acc& acc, const Seg& u, int wr, int wc, int fr, int fq) const {
        const int row0 = u.pm * 256 + wr * 64 + fr; const int c0 = u.pn * 128 + wc * 32 + 8 * fq;
#pragma unroll
        for (int ai = 0; ai < 2; ++ai)
#pragma unroll
            for (int m = 0; m < 4; ++m) { const int row = row0 + ai * 128 + m * 16; float o[8];
#pragma unroll
                for (int n = 0; n < 2; ++n)
#pragma unroll
                    for (int j = 0; j < 4; ++j) o[4 * n + j] = siluf_(acc[ai][0][m][n][j]) * acc[ai][1][m][n][j];
                *(u32x4*)(H + (size_t)row * pitch + c0) = pack8(o); }
    }
};
struct EpiBf16 {
    bf16_t* O; int pitch;
    __device__ __forceinline__ void operator()(const Acc& acc, const Seg& u, int wr, int wc, int fr, int fq) const {
        const int row0 = u.pm * 256 + wr * 64 + fr;
#pragma unroll
        for (int ai = 0; ai < 2; ++ai)
#pragma unroll
            for (int m = 0; m < 4; ++m) { const int row = row0 + ai * 128 + m * 16;
#pragma unroll
                for (int bj = 0; bj < 2; ++bj) { const int c0 = u.pn * 256 + bj * 128 + wc * 32 + 8 * fq; const f32x4 v0 = acc[ai][bj][m][0], v1 = acc[ai][bj][m][1];
                    u32x4 w; w.x = pk2(v0[0], v0[1]); w.y = pk2(v0[2], v0[3]); w.z = pk2(v1[0], v1[1]); w.w = pk2(v1[2], v1[3]);
                    *(u32x4*)(O + (size_t)row * pitch + c0) = w; } }
    }
};

namespace attn {
constexpr float SCALE = 0.10206207261596577f;
constexpr float THR = 8.f;
constexpr int KP = 208;
constexpr int SHM_V = 8192, SHM_K = 64 * KP;
constexpr int OFF_V = 0, OFF_K = 2 * SHM_V, OFF_WS = OFF_K + 2 * SHM_K, SHM_TOTAL = OFF_WS + 8 * 64 * 4;
#define SBAR() __builtin_amdgcn_sched_barrier(0)
__device__ __forceinline__ int crow(int r, int hi) { return (r & 3) + 8 * (r >> 2) + 4 * hi; }
__device__ __forceinline__ unsigned cvtpk(float lo, float hi) { unsigned r; asm volatile("v_cvt_pk_bf16_f32 %0, %1, %2" : "=v"(r) : "v"(lo), "v"(hi)); return r; }
__device__ __forceinline__ void partialSM(f32x16& p0, f32x16& p1, float& m_reg, float& mn, float& alpha) {
    constexpr float C = SCALE * 1.4426950408889634f;
    float pmax = p0[0];
#pragma unroll
    for (int r = 1; r < 16; ++r) pmax = fmaxf(pmax, p0[r]);
#pragma unroll
    for (int r = 0; r < 16; ++r) pmax = fmaxf(pmax, p1[r]);
    { auto rr = __builtin_amdgcn_permlane32_swap(__float_as_uint(pmax), __float_as_uint(pmax), false, false); pmax = fmaxf(__uint_as_float(rr[0]), __uint_as_float(rr[1])); }
    if (__builtin_expect(__all(pmax - m_reg <= THR / SCALE), 1)) { mn = m_reg; alpha = 1.f; }
    else { mn = fmaxf(m_reg, pmax); alpha = __builtin_amdgcn_exp2f((m_reg - mn) * C); m_reg = mn; }
    const float mnC = -mn * C;
#pragma unroll
    for (int r = 0; r < 16; ++r) p0[r] = fmaf(p0[r], C, mnC);
#pragma unroll
    for (int r = 0; r < 16; ++r) p1[r] = fmaf(p1[r], C, mnC);
#pragma unroll
    for (int r = 0; r < 16; ++r) p0[r] = __builtin_amdgcn_exp2f(p0[r]);
}
__device__ __forceinline__ void finishSM(f32x16& p0, f32x16& p1, float alpha, float& l_reg, bf16x8& pa0, bf16x8& pa1, bf16x8& pa2, bf16x8& pa3) {
#pragma unroll
    for (int r = 0; r < 16; ++r) p1[r] = __builtin_amdgcn_exp2f(p1[r]);
    float ps = 0;
#pragma unroll
    for (int r = 0; r < 16; ++r) ps += p0[r];
#pragma unroll
    for (int r = 0; r < 16; ++r) ps += p1[r];
    { auto rr = __builtin_amdgcn_permlane32_swap(__float_as_uint(ps), __float_as_uint(ps), false, false); ps = __uint_as_float(rr[0]) + __uint_as_float(rr[1]); }
    l_reg = l_reg * alpha + ps;
#define PK4(P, BASE, OUT) do { unsigned a0 = cvtpk(P[BASE + 0], P[BASE + 1]), a1 = cvtpk(P[BASE + 2], P[BASE + 3]);   \
    unsigned b0 = cvtpk(P[BASE + 4], P[BASE + 5]), b1 = cvtpk(P[BASE + 6], P[BASE + 7]);                              \
    auto r0 = __builtin_amdgcn_permlane32_swap(a0, b0, false, false); auto r1 = __builtin_amdgcn_permlane32_swap(a1, b1, false, false); \
    u32x4 w = {r0[0], r1[0], r0[1], r1[1]}; OUT = __builtin_bit_cast(bf16x8, w); } while (0)
    PK4(p0, 0, pa0); PK4(p0, 8, pa1); PK4(p1, 0, pa2); PK4(p1, 8, pa3);
#undef PK4
}
__device__ __forceinline__ void qkt(f32x16& p0, f32x16& p1, const LAS unsigned char* Ks, const bf16x8* qr, int r32, int hi) {
    p0 = f32x16{}; p1 = f32x16{};
#pragma unroll
    for (int d0 = 0; d0 < 6; ++d0) { const int cb = (d0 * 16 + hi * 8) * 2;
        const bf16x8 b0 = *(const LAS bf16x8*)(Ks + r32 * KP + cb);
        const bf16x8 b1 = *(const LAS bf16x8*)(Ks + (32 + r32) * KP + cb);
        p0 = __builtin_amdgcn_mfma_f32_32x32x16_bf16(b0, qr[d0], p0, 0, 0, 0);
        p1 = __builtin_amdgcn_mfma_f32_32x32x16_bf16(b1, qr[d0], p1, 0, 0, 0); }
}
__device__ __forceinline__ int v_st(int k, int c) { const int kk = (k & ~0xC) | ((k & 4) << 1) | ((k & 8) >> 1); return ((kk >> 3) * 2 + (c >> 5)) * 512 + ((kk & 7) * 32 + (c & 31)) * 2; }
__device__ __forceinline__ int v_rd_base(int lane) { return ((lane & 3) << 3) | (((lane >> 2) & 3) << 6) | (((lane >> 4) & 1) << 5) | (((lane >> 5) & 1) << 8); }
constexpr int v_rd_off(int d0, int ks, int half) { return d0 * 512 + ks * 2048 + half * 1024; }
template <int OFF> __device__ __forceinline__ s16x4 tr_read(int vb) { s16x4 r; asm volatile("ds_read_b64_tr_b16 %0, %1 offset:%2" : "=&v"(r) : "v"(vb), "i"(OFF) : "memory"); return r; }
template <int D0> __device__ __forceinline__ void pv_one(f32x16& od, int vb, bf16x8 pa0, bf16x8 pa1, bf16x8 pa2, bf16x8 pa3) {
    const s16x4 l0 = tr_read<v_rd_off(D0, 0, 0)>(vb), h0 = tr_read<v_rd_off(D0, 0, 1)>(vb), l1 = tr_read<v_rd_off(D0, 1, 0)>(vb), h1 = tr_read<v_rd_off(D0, 1, 1)>(vb);
    const s16x4 l2 = tr_read<v_rd_off(D0, 2, 0)>(vb), h2 = tr_read<v_rd_off(D0, 2, 1)>(vb), l3 = tr_read<v_rd_off(D0, 3, 0)>(vb), h3 = tr_read<v_rd_off(D0, 3, 1)>(vb);
    asm volatile("s_waitcnt lgkmcnt(0)" ::: "memory"); SBAR();
#define PK(L, H) (bf16x8){L[0], L[1], L[2], L[3], H[0], H[1], H[2], H[3]}
    od = __builtin_amdgcn_mfma_f32_32x32x16_bf16(pa0, PK(l0, h0), od, 0, 0, 0);
    od = __builtin_amdgcn_mfma_f32_32x32x16_bf16(pa1, PK(l1, h1), od, 0, 0, 0);
    od = __builtin_amdgcn_mfma_f32_32x32x16_bf16(pa2, PK(l2, h2), od, 0, 0, 0);
    od = __builtin_amdgcn_mfma_f32_32x32x16_bf16(pa3, PK(l3, h3), od, 0, 0, 0);
#undef PK
}
__device__ __forceinline__ void pv_d0(f32x16* o, int vb, bf16x8 pa0, bf16x8 pa1, bf16x8 pa2, bf16x8 pa3) { pv_one<0>(o[0], vb, pa0, pa1, pa2, pa3); pv_one<1>(o[1], vb, pa0, pa1, pa2, pa3); }

__device__ __forceinline__ void attn_unit(const bf16_t* __restrict__ Qb, const bf16_t* __restrict__ Kn, const bf16_t* __restrict__ Kr, const bf16_t* __restrict__ Vh,
                                          bf16_t* __restrict__ Ob, long lat0, long ctx0, int nlat, int NT, LAS unsigned char* lds) {
    int tid_ = threadIdx.x; asm volatile("" : "+v"(tid_));
    const int tid = tid_, wid = tid >> 6, lane = tid & 63, r32 = lane & 31, hi = lane >> 5;
    LAS unsigned char* V_lds = lds + OFF_V; LAS unsigned char* K_lds = lds + OFF_K;
    LAS float* ws = (LAS float*)(lds + OFF_WS) + wid * 64; LAS float* li_l = ws; LAS float* al_l = ws + 32;
    float m_reg = -1e30f, l_reg = 0; f32x16 o[2] = {}; bf16x8 qr[6];
    const bf16_t* Qw = Qb + (long)(wid * 32 + r32) * 768 + hi * 8;
#pragma unroll
    for (int d0 = 0; d0 < 6; ++d0) qr[d0] = *(const bf16x8*)(Qw + d0 * 16);
    const int sr = tid >> 3, sc = (tid & 7) * 8, vst = v_st(sr, sc);
    const int kr_ = (tid & 255) >> 2, kc_ = (tid & 3) * 8;
    const int vb0 = (int)(uintptr_t)V_lds + v_rd_base(lane);
    struct { bf16x8 vs, kn, kp; } sr_[2];
#define KROW(j, kk) (((j) < nlat) ? (lat0 + (long)(j) * 64 + (kk)) : (ctx0 + (long)((j) - nlat) * 64 + (kk)))
#define SLOAD(i, j) do { const long r0_ = KROW(j, sr), r1_ = KROW(j, kr_); sr_[i].vs = *(const bf16x8*)(Vh + r0_ * 512 + sc); sr_[i].kn = *(const bf16x8*)(Kn + r0_ * 544 + sc); sr_[i].kp = *(const bf16x8*)(Kr + r1_ * 544 + kc_); } while (0)
#define SWRITE(b, i) do { *(LAS bf16x8*)(V_lds + (b) * SHM_V + vst) = sr_[i].vs; *(LAS bf16x8*)(K_lds + (b) * SHM_K + sr * KP + sc * 2) = sr_[i].kn; \
    *(LAS bf16x8*)(K_lds + (b) * SHM_K + kr_ * KP + 128 + kc_ * 2) = sr_[i].kp; } while (0)
#define SWAIT() asm volatile("s_waitcnt vmcnt(3)" ::: "memory")
#define RESC(a) do { if (__any((a) < 1.f)) { if (hi == 0) al_l[r32] = (a); asm volatile("s_waitcnt lgkmcnt(0)" ::: "memory"); \
    _Pragma("unroll") for (int d = 0; d < 2; ++d) _Pragma("unroll") for (int r = 0; r < 16; ++r) o[d][r] *= al_l[crow(r, hi)]; } } while (0)
    f32x16 pA0, pA1, pB0, pB1; float mnA, mnB, alA, alB; bf16x8 pa0, pa1, pa2, pa3;
    constexpr int SE = 0, SO = 1;
    SLOAD(SE, 0); asm volatile("s_waitcnt vmcnt(0)" ::: "memory"); SWRITE(0, SE); __syncthreads();
    qkt(pA0, pA1, K_lds, qr, r32, hi); partialSM(pA0, pA1, m_reg, mnA, alA);
    SLOAD(SO, 1); if (2 < NT) SLOAD(SE, 2);
    SWAIT(); SWRITE(1, SO); __syncthreads();
    for (int j = 1; j + 1 < NT; j += 2) {
        SBAR(); qkt(pB0, pB1, K_lds + SHM_K, qr, r32, hi);
        finishSM(pA0, pA1, alA, l_reg, pa0, pa1, pa2, pa3); SBAR();
        SLOAD(SO, j + 2); SBAR();
        pv_d0(o, vb0, pa0, pa1, pa2, pa3); partialSM(pB0, pB1, m_reg, mnB, alB);
        __syncthreads(); SWAIT(); SWRITE(0, SE);
        RESC(alB); __syncthreads();
        SBAR(); qkt(pA0, pA1, K_lds, qr, r32, hi);
        finishSM(pB0, pB1, alB, l_reg, pa0, pa1, pa2, pa3); SBAR();
        if (j + 3 < NT) SLOAD(SE, j + 3); SBAR();
        pv_d0(o, vb0 + SHM_V, pa0, pa1, pa2, pa3); partialSM(pA0, pA1, m_reg, mnA, alA);
        __syncthreads(); SWAIT(); SWRITE(1, SO);
        RESC(alA); __syncthreads();
    }
    SBAR(); qkt(pB0, pB1, K_lds + SHM_K, qr, r32, hi);
    finishSM(pA0, pA1, alA, l_reg, pa0, pa1, pa2, pa3); SBAR();
    pv_d0(o, vb0, pa0, pa1, pa2, pa3); partialSM(pB0, pB1, m_reg, mnB, alB);
    __syncthreads(); RESC(alB);
    finishSM(pB0, pB1, alB, l_reg, pa0, pa1, pa2, pa3); SBAR();
    pv_d0(o, vb0 + SHM_V, pa0, pa1, pa2, pa3);
    if (hi == 0) li_l[r32] = l_reg; asm volatile("s_waitcnt lgkmcnt(0)" ::: "memory");
    float rli[16];
#pragma unroll
    for (int r = 0; r < 16; ++r) rli[r] = __builtin_amdgcn_rcpf(li_l[crow(r, hi)]);
    bf16_t* Ow = Ob + (long)(wid * 32) * 512;
#pragma unroll
    for (int r = 0; r < 16; ++r) { const int orow = crow(r, hi);
#pragma unroll
        for (int d0 = 0; d0 < 2; ++d0) Ow[(long)orow * 512 + d0 * 32 + r32] = (bf16_t)f2bf(o[d0][r] * rli[r]); }
    __syncthreads();
#undef KROW
#undef SLOAD
#undef SWRITE
#undef SWAIT
#undef RESC
}
#undef SBAR
}

__device__ __forceinline__ void attn_latent_unit(const Ctx& F, unsigned char* ws, unsigned char* ha, int b, int h, int qb) {
    bf16_t* Y = (bf16_t*)(ws + D_YMLA); const long q0 = (long)b * SEQ + qb * 256;
    if (b < 4) { const bf16_t* Q = (const bf16_t*)(ha + HA_Q); const bf16_t* K = (const bf16_t*)(ha + HA_K); const bf16_t* V = (const bf16_t*)(ha + HA_V);
        attn::attn_unit(Q + q0 * 768 + h * 96, K + h * 64, K + 512, V + h * 64, Y + q0 * 512 + h * 64, (long)b * SEQ, (long)4 * SEQ + b * CTXL, 64, 68, F.lds); }
    else { const bf16_t* Q = (const bf16_t*)(ws + D_Q); const bf16_t* K = (const bf16_t*)(ws + D_K); const bf16_t* V = (const bf16_t*)(ws + D_V);
        attn::attn_unit(Q + q0 * 768 + h * 96, K + h * 64, K + 512, V + h * 64, Y + q0 * 512 + h * 64, (long)b * SEQ, (long)RL + b * CTXL, 64, 68, F.lds); }
}
__device__ __forceinline__ void attn_phase(const Ctx& F, int layer) {
    unsigned char* ws = getpp()->ws; unsigned char* ha = half_a_base(layer); const bool with_ctx_q = (layer == 0);
    const int vcu = (F.G % 8 == 0) ? (F.bid % 8) * (F.G / 8) + F.bid / 8 : F.bid;
    const int nlat_units = 4 * 8 * 16, nunits = nlat_units + (with_ctx_q ? NBATCH * 8 : 0);
    for (int u = vcu; u < nunits; u += F.G) {
        if (u < nlat_units) { const int bh = u >> 4, qb = u & 15; attn_latent_unit(F, ws, ha, 4 + (bh >> 3), bh & 7, qb); }
        else { const int bh = u - nlat_units, b = bh >> 3, h = bh & 7; bf16_t* Y = (bf16_t*)(ws + D_YMLA); const long yrow = (long)RL + b * CTXL;
            if (b < 4) { const bf16_t* Q = (const bf16_t*)(ha + HA_Q); const bf16_t* K = (const bf16_t*)(ha + HA_K); const bf16_t* V = (const bf16_t*)(ha + HA_V); const long q0 = (long)4 * SEQ + b * CTXL;
                attn::attn_unit(Q + q0 * 768 + h * 96, K + h * 64, K + 512, V + h * 64, Y + yrow * 512 + h * 64, 0, q0, 0, 4, F.lds); }
            else { const bf16_t* Q = (const bf16_t*)(ws + D_Q); const bf16_t* K = (const bf16_t*)(ws + D_K); const bf16_t* V = (const bf16_t*)(ws + D_V);
                attn::attn_unit(Q + yrow * 768 + h * 96, K + h * 64, K + 512, V + h * 64, Y + yrow * 512 + h * 64, 0, yrow, 0, 4, F.lds); } }
    }
}

__device__ __forceinline__ void load8_shift(const bf16_t* u, long row, int t, int T, int col, const float* mu, float* out) {
    float x[8], p[8], n[8];
    const bool hp = t > 0, hn = t < T - 1;
    const u32x4 wx = *(const u32x4*)(u + row * RWC + col), wp = *(const u32x4*)(u + (row - (hp ? 1 : 0)) * RWC + col), wn = *(const u32x4*)(u + (row + (hn ? 1 : 0)) * RWC + col);
    unpack8(wx, x); unpack8(wp, p); unpack8(wn, n);
    const float mp = hp ? 0.5f : 0.f, mn = hn ? 0.5f : 0.f;
    const f32x4 m0 = *(const f32x4*)(mu + col), m1 = *(const f32x4*)(mu + col + 4);
#pragma unroll
    for (int j = 0; j < 8; ++j) out[j] = x[j] + (j < 4 ? m0[j & 3] : m1[j & 3]) * (mp * p[j] + mn * n[j] - x[j]);
}
__device__ __forceinline__ void load8_shift_l(const bf16_t* u, long row, int t, int T, int col, const LAS float* mu8, float* out) {
    float x[8], p[8], n[8];
    const bool hp = t > 0, hn = t < T - 1;
    const u32x4 wx = *(const u32x4*)(u + row * RWC + col), wp = *(const u32x4*)(u + (row - (hp ? 1 : 0)) * RWC + col), wn = *(const u32x4*)(u + (row + (hn ? 1 : 0)) * RWC + col);
    unpack8(wx, x); unpack8(wp, p); unpack8(wn, n);
    const float mp = hp ? 0.5f : 0.f, mn = hn ? 0.5f : 0.f;
    const f32x4 m0 = *(const LAS f32x4*)(mu8), m1 = *(const LAS f32x4*)(mu8 + 4);
#pragma unroll
    for (int j = 0; j < 8; ++j) out[j] = x[j] + (j < 4 ? m0[j & 3] : m1[j & 3]) * (mp * p[j] + mn * n[j] - x[j]);
}
namespace rw2 {
constexpr int PT = 72;
constexpr int O_W2T = 0, O_A2T = 9216, O_ZL = 18432, O_AL = 34816, O_XWD = 51200, O_XAD = 60416, O_RING = 18432;
constexpr int O_TA = 69632, O_TB = O_TA + 9216, O_TK = O_TB + 9216, O_TR = O_TK + 9216, O_OUT = 69632;
constexpr int O_BH = 106496, O_KH = O_BH + 9216, O_V = O_KH + 9216, O_TOT = 134144, O_PL = 136192, O_PRM = 137216;
__device__ __forceinline__ s16x4 cv4(f32x4 v) { u32x2 w; w.x = pk2(v[0], v[1]); w.y = pk2(v[2], v[3]); return __builtin_bit_cast(s16x4, w); }
__device__ __forceinline__ f32x4 mm16(s16x4 a, s16x4 b, f32x4 c) { return __builtin_amdgcn_mfma_f32_16x16x16bf16_1k(a, b, c, 0, 0, 0); }
__device__ __forceinline__ f32x4 mm32(bf16x8 a, bf16x8 b, f32x4 c) { return __builtin_amdgcn_mfma_f32_16x16x32_bf16(a, b, c, 0, 0, 0); }
__device__ __forceinline__ f32x4 bf4_to_f(s16x4 s) { const u32x2 w = __builtin_bit_cast(u32x2, s); return (f32x4){bflo(w.x), bfhi(w.x), bflo(w.y), bfhi(w.y)}; }
typedef short v4i16_t __attribute__((ext_vector_type(4)));
__device__ __forceinline__ s16x4 trd(const LAS bf16_t* base, int row0, int col0, int lane) {
    const int g = lane >> 4, i = lane & 15, q = i >> 2, p = i & 3;
    return __builtin_bit_cast(s16x4, __builtin_amdgcn_ds_read_tr16_b64_v4i16((LAS v4i16_t*)(base + (row0 + 4 * g + q) * PT + col0 + 4 * p)));
}
__device__ __forceinline__ float fast_tanh(float x) { return 1.0f - 2.0f * __builtin_amdgcn_rcpf(__builtin_amdgcn_exp2f(2.8853900817779268f * x) + 1.0f); }
}
__device__ __forceinline__ void rwkv_chain2(const Ctx& F, int layer, int b, int h, int d) {
    using namespace rw2;
    PP P = getpp(); unsigned char* ws = P->ws;
    const bf16_t* u = (const bf16_t*)(ws + D_URWKV);
    bf16_t* od = (bf16_t*)(ws + (d ? D_OB : D_OF));
    float* bsc = (float*)(ws + WS_BSC) + (size_t)d * RT * 8;
    LAS unsigned char* L = F.lds;
    LAS bf16_t* w2t = (LAS bf16_t*)(L + O_W2T); LAS bf16_t* a2t = (LAS bf16_t*)(L + O_A2T);
    LAS float* Zl = (LAS float*)(L + O_ZL); LAS float* Al = (LAS float*)(L + O_AL);
    LAS bf16_t* Xwd = (LAS bf16_t*)(L + O_XWD); LAS bf16_t* Xad = (LAS bf16_t*)(L + O_XAD);
    LAS bf16_t* TA = (LAS bf16_t*)(L + O_TA); LAS bf16_t* TB = (LAS bf16_t*)(L + O_TB); LAS bf16_t* TK = (LAS bf16_t*)(L + O_TK); LAS bf16_t* TR = (LAS bf16_t*)(L + O_TR);
    LAS bf16_t* BH = (LAS bf16_t*)(L + O_BH); LAS bf16_t* KH = (LAS bf16_t*)(L + O_KH); LAS bf16_t* Vm = (LAS bf16_t*)(L + O_V);
    LAS float* tot = (LAS float*)(L + O_TOT); LAS float* pLs = (LAS float*)(L + O_PL); LAS float* Out = (LAS float*)(L + O_OUT);
    LAS float* prm = (LAS float*)(L + O_PRM);
    const int tid0 = F.tid, w = F.wave;
    {
        const int tid = tid0;
        const float* mu = P->in[I_MU] + layer * RWC;
        const float* w0 = P->in[I_W0] + (layer * 2 + d) * 512 + h * 64;
        const float* w2 = P->in[I_W2] + (size_t)(layer * 2 + d) * 64 * 512 + h * 64;
        const float* a0 = P->in[I_A0] + (layer * 2 + d) * 512 + h * 64;
        const float* a2 = P->in[I_A2] + (size_t)(layer * 2 + d) * 64 * 512 + h * 64;
        const float* k_k = P->in[I_KK] + layer * 512 + h * 64; const float* k_a = P->in[I_KA] + layer * 512 + h * 64; const float* r_k = P->in[I_RK] + layer * 512 + h * 64;
        for (int i = tid; i < 640; i += NTHREADS) { const int rr = i >> 6, cc = i & 63; float v;
            if (rr == 0) v = mu[h * 64 + cc]; else if (rr == 1) v = mu[512 + h * 64 + cc]; else if (rr == 2) v = mu[1024 + h * 64 + cc]; else if (rr == 3) v = mu[1536 + d * 64 + cc]; else if (rr == 4) v = mu[1664 + d * 64 + cc];
            else if (rr == 5) v = w0[cc]; else if (rr == 6) v = a0[cc]; else if (rr == 7) v = k_k[cc]; else if (rr == 8) v = k_a[cc]; else v = r_k[cc];
            prm[i] = v; }
        for (int i = tid; i < 4096; i += NTHREADS) { const int k = i >> 6, cc = i & 63; w2t[cc * PT + k] = (bf16_t)f2bf(w2[(size_t)k * 512 + cc]); a2t[cc * PT + k] = (bf16_t)f2bf(a2[(size_t)k * 512 + cc]); }
    }
    f32x4 Z[4];
#pragma unroll
    for (int j = 0; j < 4; ++j) Z[j] = (f32x4){0.f, 0.f, 0.f, 0.f};
    __syncthreads();
    for (int seq = 0; seq < 2; ++seq) {
        const int T = seq ? SEQ : CTXL; const long rbase = seq ? (long)b * SEQ : (long)RL + b * CTXL; const int nch = T / 64;
        for (int ci = 0; ci < nch; ++ci) {
            int tid = tid0; asm volatile("" : "+v"(tid));
            const int lane = tid & 63, fr = lane & 15, fq = lane >> 4, tt = tid >> 3, c8 = (tid & 7) * 8;
            const int tpos = d ? (T - 1 - (ci * 64 + tt)) : (ci * 64 + tt); const long row = rbase + tpos;
            float r[8], k[8], kk[8], av[8], kd[8], lw[8];
            {
                float v[8], x[8];
                load8_shift_l(u, row, tpos, T, h * 64 + c8, prm + c8, r);
                load8_shift_l(u, row, tpos, T, 512 + h * 64 + c8, prm + 64 + c8, k);
                load8_shift_l(u, row, tpos, T, 1024 + h * 64 + c8, prm + 128 + c8, v);
                *(LAS u32x4*)(Vm + tt * PT + c8) = pack8(v);
                load8_shift_l(u, row, tpos, T, 1536 + d * 64 + c8, prm + 192 + c8, x);
#pragma unroll
                for (int e = 0; e < 8; ++e) x[e] = fast_tanh(x[e]);
                *(LAS u32x4*)(Xwd + tt * PT + c8) = pack8(x);
                load8_shift_l(u, row, tpos, T, 1664 + d * 64 + c8, prm + 256 + c8, x);
                *(LAS u32x4*)(Xad + tt * PT + c8) = pack8(x);
            }
            __syncthreads();
            {
#pragma unroll
                for (int q = 0; q < 2; ++q) { const int id = 2 * w + q, tm = id >> 2, tn = id & 3;
                    f32x4 az = {0.f, 0.f, 0.f, 0.f}, aa = {0.f, 0.f, 0.f, 0.f};
#pragma unroll
                    for (int ks = 0; ks < 2; ++ks) {
                        az = mm32(*(const LAS bf16x8*)(Xwd + (16 * tm + fr) * PT + ks * 32 + fq * 8), *(const LAS bf16x8*)(w2t + (16 * tn + fr) * PT + ks * 32 + fq * 8), az);
                        aa = mm32(*(const LAS bf16x8*)(Xad + (16 * tm + fr) * PT + ks * 32 + fq * 8), *(const LAS bf16x8*)(a2t + (16 * tn + fr) * PT + ks * 32 + fq * 8), aa); }
#pragma unroll
                    for (int e = 0; e < 4; ++e) { Zl[(16 * tm + 4 * fq + e) * 64 + 16 * tn + fr] = az[e]; Al[(16 * tm + 4 * fq + e) * 64 + 16 * tn + fr] = aa[e]; } }
            }
            __syncthreads();
            {
                float ss = 0.f, bs = 0.f;
#pragma unroll
                for (int e = 0; e < 8; ++e) { kk[e] = k[e] * prm[448 + c8 + e]; ss += kk[e] * kk[e]; }
                ss += shx(ss, 1, lane); ss += shx(ss, 2, lane); ss += shx(ss, 4, lane);
                const float inv = __builtin_amdgcn_rsqf(fmaxf(ss, 1e-24f));
#pragma unroll
                for (int e = 0; e < 8; ++e) {
                    kk[e] *= inv;
                    const float z = Zl[tt * 64 + c8 + e] + prm[320 + c8 + e];
                    lw[e] = -sigmoidf_(z) * 0.8750612633917001f;
                    av[e] = sigmoidf_(Al[tt * 64 + c8 + e] + prm[384 + c8 + e]);
                    kd[e] = k[e] * (1.0f + (av[e] - 1.0f) * prm[512 + c8 + e]);
                    bs += r[e] * kd[e] * prm[576 + c8 + e];
                }
                bs += shx(bs, 1, lane); bs += shx(bs, 2, lane); bs += shx(bs, 4, lane);
                if ((tid & 7) == 0) bsc[(size_t)row * 8 + h] = bs;
            }
            float cum[8];
            {
#pragma unroll
                for (int e = 0; e < 8; ++e) cum[e] = lw[e];
#pragma unroll
                for (int off = 8; off < 64; off <<= 1) {
#pragma unroll
                    for (int e = 0; e < 8; ++e) { const float t = __int_as_float(__builtin_amdgcn_ds_bpermute(((lane - off) & 63) << 2, __float_as_int(cum[e]))); cum[e] += (lane >= off) ? t : 0.f; } }
                if (lane >= 56) {
#pragma unroll
                    for (int e = 0; e < 8; ++e) tot[w * 64 + c8 + e] = cum[e]; }
            }
            __syncthreads();
            {
                float ta[8], tb[8], tk[8], tr[8], bh[8], kh[8];
                const int w0i = (w & ~1) * 64 + c8;
#pragma unroll
                for (int e = 0; e < 8; ++e) {
                    const float t0 = tot[w0i + e], t1 = tot[w0i + 64 + e];
                    const float cm = cum[e] + ((w & 1) ? t0 : 0.f), cumL = t0 + t1;
                    const float e1 = __builtin_amdgcn_exp2f(cm - lw[e]), e2 = __builtin_amdgcn_exp2f(-cm), e3 = __builtin_amdgcn_exp2f(cm), e4 = __builtin_amdgcn_exp2f(cumL - cm);
                    const float ka = kk[e] * av[e];
                    ta[e] = -kk[e] * e1; tb[e] = ka * e2; tk[e] = kd[e] * e2; tr[e] = r[e] * e3; bh[e] = ka * e4; kh[e] = kd[e] * e4;
                    if ((tt & 15) == 15) pLs[(tt >> 4) * 64 + c8 + e] = e3;
                }
                *(LAS u32x4*)(TA + tt * PT + c8) = pack8(ta); *(LAS u32x4*)(TB + tt * PT + c8) = pack8(tb); *(LAS u32x4*)(TK + tt * PT + c8) = pack8(tk); *(LAS u32x4*)(TR + tt * PT + c8) = pack8(tr);
                *(LAS u32x4*)(BH + tt * PT + c8) = pack8(bh); *(LAS u32x4*)(KH + tt * PT + c8) = pack8(kh);
            }
            __syncthreads();
            if (w < 4) {
                const int s = w; const int rowf = (16 * s + fr) * PT;
                f32x4 Mab = {0.f, 0.f, 0.f, 0.f}, MabT = Mab, MakT = Mab, Mbr = Mab, Mkr = Mab;
#pragma unroll
                for (int ks = 0; ks < 2; ++ks) { const int o = rowf + ks * 32 + fq * 8;
                    const bf16x8 fa = *(const LAS bf16x8*)(TA + o), fb = *(const LAS bf16x8*)(TB + o), fk = *(const LAS bf16x8*)(TK + o), frr = *(const LAS bf16x8*)(TR + o);
                    Mab = mm32(fb, fa, Mab); MabT = mm32(fa, fb, MabT); MakT = mm32(fa, fk, MakT); Mbr = mm32(fb, frr, Mbr); Mkr = mm32(fk, frr, Mkr); }
                f32x4 Pm, Pt;
#pragma unroll
                for (int e = 0; e < 4; ++e) { const int m = 4 * fq + e, n = fr;
                    Mab[e] = (m < n) ? Mab[e] : 0.f; MabT[e] = (n < m) ? MabT[e] : 0.f; MakT[e] = (n < m) ? MakT[e] : 0.f; Mbr[e] = (m <= n) ? Mbr[e] : 0.f; Mkr[e] = (m <= n) ? Mkr[e] : 0.f;
                    const float id = (m == n) ? 1.f : 0.f; Pm[e] = Mab[e] + id; Pt[e] = MabT[e] + id; }
                f32x4 Nn = Mab, Nt = MabT; const f32x4 zero = {0.f, 0.f, 0.f, 0.f};
#pragma unroll
                for (int it = 0; it < 3; ++it) {
                    const s16x4 cn = cv4(Nn), cnt = cv4(Nt);
                    const f32x4 N2 = mm16(cnt, cn, zero), Nt2 = mm16(cn, cnt, zero);
                    const s16x4 cp = cv4(Pm), cpt = cv4(Pt), cn2 = cv4(N2);
                    const f32x4 Pn = mm16(cpt, cn2, Pm), Ptn = mm16(cn2, cpt, Pt);
                    Nn = N2; Nt = Nt2; Pm = Pn; Pt = Ptn; (void)cp;
                }
                const s16x4 cT = cv4(Pm), cMakT = cv4(MakT), cMbr = cv4(Mbr);
                const f32x4 Q1T = mm16(cT, cMakT, zero);
                const s16x4 cQ1T = cv4(Q1T);
                const f32x4 Hy = mm16(cQ1T, cMbr, Mkr);
                LAS unsigned char* ring = L + O_RING + s * 12800 + lane * 8;
                *(LAS s16x4*)(ring + 20 * 512) = cv4(Hy);
                s16x4 bhf[4];
#pragma unroll
                for (int jt = 0; jt < 4; ++jt) bhf[jt] = trd(BH, 16 * s, 16 * jt, lane);
#pragma unroll
                for (int jt = 0; jt < 4; ++jt) {
                    const s16x4 atf = trd(TA, 16 * s, 16 * jt, lane);
                    const f32x4 P1T = mm16(cT, atf, zero); const s16x4 cP1T = cv4(P1T);
                    const f32x4 rinit = bf4_to_f(*(const LAS s16x4*)(TR + (16 * s + fr) * PT + 16 * jt + 4 * fq));
                    const f32x4 Gy = mm16(cP1T, cMbr, rinit);
                    *(LAS s16x4*)(ring + jt * 512) = cv4(Gy);
#pragma unroll
                    for (int j2 = 0; j2 < 4; ++j2) { const f32x4 Gs = mm16(cP1T, bhf[j2], zero); *(LAS s16x4*)(ring + (4 + jt * 4 + j2) * 512) = cv4(Gs); }
                    const f32x4 kinit = bf4_to_f(trd(KH, 16 * s, 16 * jt, lane));
                    const f32x4 Hs = mm16(cQ1T, bhf[jt], kinit);
                    *(LAS s16x4*)(ring + (21 + jt) * 512) = cv4(Hs);
                }
            }
            __syncthreads();
            if (w < 4) {
                const int it = w;
#pragma unroll 1
                for (int s = 0; s < 4; ++s) {
                    const LAS unsigned char* ring = L + O_RING + s * 12800 + lane * 8;
                    const s16x4 vb = trd(Vm, 16 * s, 16 * it, lane);
                    s16x4 zb[4];
#pragma unroll
                    for (int jt = 0; jt < 4; ++jt) zb[jt] = cv4(Z[jt]);
                    f32x4 Yt = mm16(*(const LAS s16x4*)(ring + 20 * 512), vb, (f32x4){0.f, 0.f, 0.f, 0.f});
#pragma unroll
                    for (int jt = 0; jt < 4; ++jt) Yt = mm16(*(const LAS s16x4*)(ring + jt * 512), zb[jt], Yt);
#pragma unroll
                    for (int e = 0; e < 4; ++e) Out[(16 * s + 4 * fq + e) * 64 + 16 * it + fr] = Yt[e];
                    f32x4 Zn[4];
#pragma unroll
                    for (int j2 = 0; j2 < 4; ++j2) {
                        const f32x4 pv = *(const LAS f32x4*)(pLs + s * 64 + 16 * j2 + 4 * fq);
                        f32x4 zn = Z[j2] * pv;
                        zn = mm16(*(const LAS s16x4*)(ring + (21 + j2) * 512), vb, zn);
#pragma unroll
                        for (int jt = 0; jt < 4; ++jt) zn = mm16(*(const LAS s16x4*)(ring + (4 + jt * 4 + j2) * 512), zb[jt], zn);
                        Zn[j2] = zn;
                    }
#pragma unroll
                    for (int j2 = 0; j2 < 4; ++j2) Z[j2] = Zn[j2];
                }
            }
            __syncthreads();
            {
                float v[8];
#pragma unroll
                for (int e = 0; e < 8; ++e) v[e] = Out[tt * 64 + c8 + e];
                *(u32x4*)(od + (size_t)row * 512 + h * 64 + c8) = pack8(v);
            }
            __syncthreads();
        }
    }
}

namespace rw4 {
using namespace rw2;
constexpr int RGN = 16384, R_TA = 0, R_TB = 2304, R_TK = 4608, R_TR = 6912, R_BH = 9216, R_KH = 11520, R_V = 13824, R_PL = 16128;
constexpr int R_XWD = 0, R_XAD = 2304, R_ZL = 4608, R_AL = 8704;
constexpr int O_PRM4 = 8 * RGN;
}
__device__ __forceinline__ void rwkv_chain4(const Ctx& F, int layer, int b, int h, int d) {
    using namespace rw4;
    PP P = getpp(); unsigned char* ws = P->ws;
    const bf16_t* u = (const bf16_t*)(ws + D_URWKV);
    bf16_t* od = (bf16_t*)(ws + (d ? D_OB : D_OF));
    float* bsc = (float*)(ws + WS_BSC) + (size_t)d * RT * 8;
    const bf16_t* w2g = (const bf16_t*)(ws + WS_W2T) + (size_t)((layer * 2 + d) * 2 + 0) * 512 * 64 + (size_t)h * 64 * 64;
    const bf16_t* a2g = (const bf16_t*)(ws + WS_W2T) + (size_t)((layer * 2 + d) * 2 + 1) * 512 * 64 + (size_t)h * 64 * 64;
    LAS unsigned char* L = F.lds;
    LAS float* prm = (LAS float*)(L + O_PRM4);
    volatile LAS unsigned* rdy = (volatile LAS unsigned*)(L + O_PRM4 + 2560); LAS unsigned* dne = (LAS unsigned*)(L + O_PRM4 + 2560 + 64);
    unsigned gseq = 0;
    const int tid0 = F.tid, w = F.wave;
    {
        const float* mu = P->in[I_MU] + layer * RWC;
        const float* w0 = P->in[I_W0] + (layer * 2 + d) * 512 + h * 64; const float* a0 = P->in[I_A0] + (layer * 2 + d) * 512 + h * 64;
        const float* k_k = P->in[I_KK] + layer * 512 + h * 64; const float* k_a = P->in[I_KA] + layer * 512 + h * 64; const float* r_k = P->in[I_RK] + layer * 512 + h * 64;
        for (int i = tid0; i < 640; i += NTHREADS) { const int rr = i >> 6, cc = i & 63; float v;
            if (rr == 0) v = mu[h * 64 + cc]; else if (rr == 1) v = mu[512 + h * 64 + cc]; else if (rr == 2) v = mu[1024 + h * 64 + cc]; else if (rr == 3) v = mu[1536 + d * 64 + cc]; else if (rr == 4) v = mu[1664 + d * 64 + cc];
            else if (rr == 5) v = w0[cc]; else if (rr == 6) v = a0[cc]; else if (rr == 7) v = k_k[cc]; else if (rr == 8) v = k_a[cc]; else v = r_k[cc];
            prm[i] = v; }
        if (tid0 < 8) { rdy[tid0] = 0u; dne[tid0] = 0u; }
    }
    f32x4 Z[4];
#pragma unroll
    for (int j = 0; j < 4; ++j) Z[j] = (f32x4){0.f, 0.f, 0.f, 0.f};
    u32x4 raw[2][5][3];
#define RW4_PREFETCH(T_, rbase_, gi_) do { int t0_ = tid0; asm volatile("" : "+v"(t0_)); const int lane_ = t0_ & 63, tk_ = lane_ >> 2, cg_ = lane_ & 3; const int pi_ = (gi_) * 128 + 16 * w + tk_; const int tp_ = d ? ((T_) - 1 - pi_) : pi_; \
        const long row_ = (rbase_) + tp_; const long rp_ = row_ - (tp_ > 0 ? 1 : 0), rn_ = row_ + (tp_ < (T_) - 1 ? 1 : 0); \
        _Pragma("unroll") for (int q_ = 0; q_ < 2; ++q_) _Pragma("unroll") for (int g_ = 0; g_ < 5; ++g_) { \
            const int col_ = (g_ == 0 ? h * 64 : g_ == 1 ? 512 + h * 64 : g_ == 2 ? 1024 + h * 64 : g_ == 3 ? 1536 + d * 64 : 1664 + d * 64) + q_ * 32 + cg_ * 8; \
            raw[q_][g_][0] = *(const u32x4*)(u + row_ * RWC + col_); raw[q_][g_][1] = *(const u32x4*)(u + rp_ * RWC + col_); raw[q_][g_][2] = *(const u32x4*)(u + rn_ * RWC + col_); } } while (0)
    RW4_PREFETCH(CTXL, (long)RL + b * CTXL, 0);
    __syncthreads();
    for (int seq = 0; seq < 2; ++seq) {
        const int T = seq ? SEQ : CTXL; const long rbase = seq ? (long)b * SEQ : (long)RL + b * CTXL; const int ngr = T / 128;
        for (int gi = 0; gi < ngr; ++gi) {
            int tid = tid0; asm volatile("" : "+v"(tid));
            const int lane = tid & 63, fr = lane & 15, fq = lane >> 4, tk = lane >> 2, cg = lane & 3;
            LAS unsigned char* R = L + w * RGN;
            { unsigned sp = 0; while (*(volatile LAS unsigned*)(dne + w) != 4u * gseq) { __builtin_amdgcn_s_sleep(1); if (++sp > (1u << 24)) break; } }
            asm volatile("" ::: "memory");
            {
                const int pi = gi * 128 + 16 * w + tk; const int tpos = d ? (T - 1 - pi) : pi; const long row = rbase + tpos;
                float r[16], k[16], kk[16], av[16], kd[16], lw[16];
                {
                    const float mp = (tpos > 0) ? 0.5f : 0.f, mn = (tpos < T - 1) ? 0.5f : 0.f;
#pragma unroll
                    for (int q = 0; q < 2; ++q) { const int c8 = q * 32 + cg * 8;
#pragma unroll
                        for (int g5 = 0; g5 < 5; ++g5) {
                            float x[8], p[8], n[8], o[8];
                            unpack8(raw[q][g5][0], x); unpack8(raw[q][g5][1], p); unpack8(raw[q][g5][2], n);
                            const f32x4 m0 = *(const LAS f32x4*)(prm + g5 * 64 + c8), m1 = *(const LAS f32x4*)(prm + g5 * 64 + c8 + 4);
#pragma unroll
                            for (int j = 0; j < 8; ++j) o[j] = x[j] + (j < 4 ? m0[j & 3] : m1[j & 3]) * (mp * p[j] + mn * n[j] - x[j]);
                            if (g5 == 0) {
#pragma unroll
                                for (int j = 0; j < 8; ++j) r[8 * q + j] = o[j]; }
                            else if (g5 == 1) {
#pragma unroll
                                for (int j = 0; j < 8; ++j) k[8 * q + j] = o[j]; }
                            else if (g5 == 2) *(LAS u32x4*)(R + R_V + (tk * PT + c8) * 2) = pack8(o);
                            else if (g5 == 3) {
#pragma unroll
                                for (int j = 0; j < 8; ++j) o[j] = fast_tanh(o[j]);
                                *(LAS u32x4*)(R + R_XWD + (tk * PT + c8) * 2) = pack8(o); }
                            else *(LAS u32x4*)(R + R_XAD + (tk * PT + c8) * 2) = pack8(o);
                        } }
                }
                {
                    const LAS bf16_t* Xwd = (const LAS bf16_t*)(R + R_XWD); const LAS bf16_t* Xad = (const LAS bf16_t*)(R + R_XAD);
                    LAS float* Zl = (LAS float*)(R + R_ZL); LAS float* Al = (LAS float*)(R + R_AL);
                    bf16x8 fw[2], fa[2];
#pragma unroll
                    for (int ks = 0; ks < 2; ++ks) { fw[ks] = *(const LAS bf16x8*)(Xwd + fr * PT + ks * 32 + fq * 8); fa[ks] = *(const LAS bf16x8*)(Xad + fr * PT + ks * 32 + fq * 8); }
#pragma unroll
                    for (int tn = 0; tn < 4; ++tn) { f32x4 az = {0.f, 0.f, 0.f, 0.f}, aa = {0.f, 0.f, 0.f, 0.f};
#pragma unroll
                        for (int ks = 0; ks < 2; ++ks) { az = mm32(fw[ks], *(const bf16x8*)(w2g + (16 * tn + fr) * 64 + ks * 32 + fq * 8), az); aa = mm32(fa[ks], *(const bf16x8*)(a2g + (16 * tn + fr) * 64 + ks * 32 + fq * 8), aa); }
#pragma unroll
                        for (int e = 0; e < 4; ++e) { Zl[(4 * fq + e) * 64 + 16 * tn + fr] = az[e]; Al[(4 * fq + e) * 64 + 16 * tn + fr] = aa[e]; } }
                }
                {
                    const LAS float* Zl = (const LAS float*)(R + R_ZL); const LAS float* Al = (const LAS float*)(R + R_AL);
                    float ss = 0.f, bs = 0.f;
                    float pkk[16], pw0[16], pa0[16], pka[16], prk[16], zz[16], aa2[16];
#pragma unroll
                    for (int q = 0; q < 2; ++q) { const int c8 = q * 32 + cg * 8;
#pragma unroll
                        for (int hh = 0; hh < 2; ++hh) { const int o4 = c8 + 4 * hh, i4 = 8 * q + 4 * hh;
                            const f32x4 a = *(const LAS f32x4*)(prm + 448 + o4), b2 = *(const LAS f32x4*)(prm + 320 + o4), c = *(const LAS f32x4*)(prm + 384 + o4), d2 = *(const LAS f32x4*)(prm + 512 + o4), e2 = *(const LAS f32x4*)(prm + 576 + o4);
                            const f32x4 z4 = *(const LAS f32x4*)(Zl + tk * 64 + o4), a4 = *(const LAS f32x4*)(Al + tk * 64 + o4);
#pragma unroll
                            for (int j = 0; j < 4; ++j) { pkk[i4 + j] = a[j]; pw0[i4 + j] = b2[j]; pa0[i4 + j] = c[j]; pka[i4 + j] = d2[j]; prk[i4 + j] = e2[j]; zz[i4 + j] = z4[j]; aa2[i4 + j] = a4[j]; } } }
#pragma unroll
                    for (int i = 0; i < 16; ++i) { kk[i] = k[i] * pkk[i]; ss += kk[i] * kk[i]; }
                    ss += shx(ss, 1, lane); ss += shx(ss, 2, lane);
                    const float inv = __builtin_amdgcn_rsqf(fmaxf(ss, 1e-24f));
#pragma unroll
                    for (int i = 0; i < 16; ++i) {
                        kk[i] *= inv;
                        lw[i] = -sigmoidf_(zz[i] + pw0[i]) * 0.8750612633917001f;
                        av[i] = sigmoidf_(aa2[i] + pa0[i]);
                        kd[i] = k[i] * (1.0f + (av[i] - 1.0f) * pka[i]);
                        bs += r[i] * kd[i] * prk[i]; }
                    bs += shx(bs, 1, lane); bs += shx(bs, 2, lane);
                    if (cg == 0) bsc[(size_t)row * 8 + h] = bs;
                }
                float cum[16], cumL[16];
                {
                    LAS float* Sc = (LAS float*)(R + R_ZL);
#pragma unroll
                    for (int q = 0; q < 2; ++q) { *(LAS f32x4*)(Sc + tk * 64 + q * 32 + cg * 8) = (f32x4){lw[8 * q], lw[8 * q + 1], lw[8 * q + 2], lw[8 * q + 3]}; *(LAS f32x4*)(Sc + tk * 64 + q * 32 + cg * 8 + 4) = (f32x4){lw[8 * q + 4], lw[8 * q + 5], lw[8 * q + 6], lw[8 * q + 7]}; }
                    float a = 0.f;
#pragma unroll
                    for (int t = 0; t < 16; ++t) { a += Sc[t * 64 + lane]; Sc[t * 64 + lane] = a; }
#pragma unroll
                    for (int q = 0; q < 2; ++q) { const f32x4 c0 = *(const LAS f32x4*)(Sc + tk * 64 + q * 32 + cg * 8), c1 = *(const LAS f32x4*)(Sc + tk * 64 + q * 32 + cg * 8 + 4);
                        const f32x4 l0 = *(const LAS f32x4*)(Sc + 15 * 64 + q * 32 + cg * 8), l1 = *(const LAS f32x4*)(Sc + 15 * 64 + q * 32 + cg * 8 + 4);
#pragma unroll
                        for (int e = 0; e < 4; ++e) { cum[8 * q + e] = c0[e]; cum[8 * q + 4 + e] = c1[e]; cumL[8 * q + e] = l0[e]; cumL[8 * q + 4 + e] = l1[e]; } }
                }
                {
#pragma unroll
                    for (int q = 0; q < 2; ++q) { float ta[8], tb[8], tkk[8], tr[8], bh[8], kh[8], plv[8]; const int c8 = q * 32 + cg * 8;
#pragma unroll
                        for (int e = 0; e < 8; ++e) { const int i = 8 * q + e;
                            const float e3 = __builtin_amdgcn_exp2f(cum[i]), e2 = __builtin_amdgcn_rcpf(e3), e1 = __builtin_amdgcn_exp2f(cum[i] - lw[i]), e4 = __builtin_amdgcn_exp2f(cumL[i] - cum[i]);
                            const float ka = kk[i] * av[i];
                            ta[e] = -kk[i] * e1; tb[e] = ka * e2; tkk[e] = kd[i] * e2; tr[e] = r[i] * e3; bh[e] = ka * e4; kh[e] = kd[i] * e4;
                            plv[e] = e3; }
                        *(LAS u32x4*)(R + R_TA + (tk * PT + c8) * 2) = pack8(ta); *(LAS u32x4*)(R + R_TB + (tk * PT + c8) * 2) = pack8(tb); *(LAS u32x4*)(R + R_TK + (tk * PT + c8) * 2) = pack8(tkk);
                        *(LAS u32x4*)(R + R_TR + (tk * PT + c8) * 2) = pack8(tr); *(LAS u32x4*)(R + R_BH + (tk * PT + c8) * 2) = pack8(bh); *(LAS u32x4*)(R + R_KH + (tk * PT + c8) * 2) = pack8(kh);
                        if (tk == 15) { LAS float* pp = (LAS float*)(R + R_PL) + c8; *(LAS f32x4*)pp = (f32x4){plv[0], plv[1], plv[2], plv[3]}; *(LAS f32x4*)(pp + 4) = (f32x4){plv[4], plv[5], plv[6], plv[7]}; } }
                }
                {
                    const LAS bf16_t* TA = (const LAS bf16_t*)(R + R_TA); const LAS bf16_t* TB = (const LAS bf16_t*)(R + R_TB); const LAS bf16_t* TK = (const LAS bf16_t*)(R + R_TK);
                    const LAS bf16_t* TR = (const LAS bf16_t*)(R + R_TR); const LAS bf16_t* BH = (const LAS bf16_t*)(R + R_BH); const LAS bf16_t* KH = (const LAS bf16_t*)(R + R_KH);
                    f32x4 Mab = {0.f, 0.f, 0.f, 0.f}, MabT = Mab, MakT = Mab, Mbr = Mab, Mkr = Mab;
#pragma unroll
                    for (int ks = 0; ks < 2; ++ks) { const int o = fr * PT + ks * 32 + fq * 8;
                        const bf16x8 fa = *(const LAS bf16x8*)(TA + o), fb = *(const LAS bf16x8*)(TB + o), fk = *(const LAS bf16x8*)(TK + o), frr = *(const LAS bf16x8*)(TR + o);
                        Mab = mm32(fb, fa, Mab); MabT = mm32(fa, fb, MabT); MakT = mm32(fa, fk, MakT); Mbr = mm32(fb, frr, Mbr); Mkr = mm32(fk, frr, Mkr); }
                    s16x4 bhf[4], atf[4], rin[4], kin[4];
#pragma unroll
                    for (int jt = 0; jt < 4; ++jt) { bhf[jt] = trd(BH, 0, 16 * jt, lane); atf[jt] = trd(TA, 0, 16 * jt, lane); kin[jt] = trd(KH, 0, 16 * jt, lane); rin[jt] = *(const LAS s16x4*)(TR + fr * PT + 16 * jt + 4 * fq); }
                    f32x4 Pm, Pt;
#pragma unroll
                    for (int e = 0; e < 4; ++e) { const int m = 4 * fq + e, n = fr;
                        Mab[e] = (m < n) ? Mab[e] : 0.f; MabT[e] = (n < m) ? MabT[e] : 0.f; MakT[e] = (n < m) ? MakT[e] : 0.f; Mbr[e] = (m <= n) ? Mbr[e] : 0.f; Mkr[e] = (m <= n) ? Mkr[e] : 0.f;
                        const float id = (m == n) ? 1.f : 0.f; Pm[e] = Mab[e] + id; Pt[e] = MabT[e] + id; }
                    f32x4 Nn = Mab, Nt = MabT; const f32x4 zero = {0.f, 0.f, 0.f, 0.f};
#pragma unroll
                    for (int it = 0; it < 3; ++it) {
                        const s16x4 cn = cv4(Nn), cnt = cv4(Nt);
                        const f32x4 N2 = mm16(cnt, cn, zero), Nt2 = mm16(cn, cnt, zero);
                        const s16x4 cpt = cv4(Pt), cn2 = cv4(N2);
                        const f32x4 Pn = mm16(cpt, cn2, Pm), Ptn = mm16(cn2, cpt, Pt);
                        Nn = N2; Nt = Nt2; Pm = Pn; Pt = Ptn;
                    }
                    const s16x4 cT = cv4(Pm), cMakT = cv4(MakT), cMbr = cv4(Mbr);
                    const f32x4 Q1T = mm16(cT, cMakT, zero);
                    const s16x4 cQ1T = cv4(Q1T);
                    const f32x4 Hy = mm16(cQ1T, cMbr, Mkr);
                    asm volatile("s_waitcnt lgkmcnt(0)" ::: "memory");
                    LAS unsigned char* ring = R + lane * 8;
                    *(LAS s16x4*)(ring + 20 * 512) = cv4(Hy);
#pragma unroll
                    for (int jt = 0; jt < 4; ++jt) {
                        const f32x4 P1T = mm16(cT, atf[jt], zero); const s16x4 cP1T = cv4(P1T);
                        const f32x4 Gy = mm16(cP1T, cMbr, bf4_to_f(rin[jt]));
                        *(LAS s16x4*)(ring + jt * 512) = cv4(Gy);
#pragma unroll
                        for (int j2 = 0; j2 < 4; ++j2) { const f32x4 Gs = mm16(cP1T, bhf[j2], zero); *(LAS s16x4*)(ring + (4 + jt * 4 + j2) * 512) = cv4(Gs); }
                        const f32x4 Hs = mm16(cQ1T, bhf[jt], bf4_to_f(kin[jt]));
                        *(LAS s16x4*)(ring + (21 + jt) * 512) = cv4(Hs);
                    }
                }
            }
            {
                const bool more = gi + 1 < ngr; const bool nseq = !more && seq == 0;
                const int nT = nseq ? SEQ : T; const long nrb = nseq ? (long)b * SEQ : rbase; const int ngi = more ? gi + 1 : (nseq ? 0 : gi);
                RW4_PREFETCH(nT, nrb, ngi);
            }
            ++gseq;
            asm volatile("s_waitcnt lgkmcnt(0)" ::: "memory");
            if (lane == 0) rdy[w] = gseq;
            asm volatile("" ::: "memory");
            if (w < 4) {
                const int it = w;
#pragma unroll 1
                for (int s = 0; s < 8; ++s) {
                    { unsigned sp = 0; while (rdy[s] != gseq) { __builtin_amdgcn_s_sleep(1); if (++sp > (1u << 24)) break; } }
                    asm volatile("" ::: "memory");
                    const LAS unsigned char* Rs = L + s * RGN; const LAS unsigned char* ring = Rs + lane * 8;
                    const s16x4 vb = trd((const LAS bf16_t*)(Rs + R_V), 0, 16 * it, lane);
                    s16x4 zb[4];
#pragma unroll
                    for (int jt = 0; jt < 4; ++jt) zb[jt] = cv4(Z[jt]);
                    f32x4 Yt = mm16(*(const LAS s16x4*)(ring + 20 * 512), vb, (f32x4){0.f, 0.f, 0.f, 0.f});
#pragma unroll
                    for (int jt = 0; jt < 4; ++jt) Yt = mm16(*(const LAS s16x4*)(ring + jt * 512), zb[jt], Yt);
#pragma unroll
                    for (int e = 0; e < 4; ++e) { const int pi = gi * 128 + 16 * s + 4 * fq + e; const int tp = d ? (T - 1 - pi) : pi;
                        od[(size_t)(rbase + tp) * 512 + h * 64 + 16 * it + fr] = (bf16_t)f2bf(Yt[e]); }
                    f32x4 Zn[4];
#pragma unroll
                    for (int j2 = 0; j2 < 4; ++j2) {
                        const f32x4 pv = *(const LAS f32x4*)((const LAS float*)(Rs + R_PL) + 16 * j2 + 4 * fq);
                        f32x4 zn = Z[j2] * pv;
                        zn = mm16(*(const LAS s16x4*)(ring + (21 + j2) * 512), vb, zn);
#pragma unroll
                        for (int jt = 0; jt < 4; ++jt) zn = mm16(*(const LAS s16x4*)(ring + (4 + jt * 4 + j2) * 512), zb[jt], zn);
                        Zn[j2] = zn;
                    }
#pragma unroll
                    for (int j2 = 0; j2 < 4; ++j2) Z[j2] = Zn[j2];
                    asm volatile("s_waitcnt lgkmcnt(0)" ::: "memory");
                    if (lane == 0) (void)__hip_atomic_fetch_add(dne + s, 1u, __ATOMIC_RELAXED, __HIP_MEMORY_SCOPE_WORKGROUP);
                }
            }
        }
    }
#undef RW4_PREFETCH
}

__device__ __forceinline__ void rwkv_post_phase(const Ctx& F, int layer, int nrows_y) {
    PP P = getpp(); unsigned char* ws = P->ws;
    const bf16_t* u = (const bf16_t*)(ws + D_URWKV); const bf16_t* of = (const bf16_t*)(ws + D_OF); const bf16_t* ob = (const bf16_t*)(ws + D_OB);
    bf16_t* y = (bf16_t*)(ws + D_YRWKV);
    const float* bf_ = (const float*)(ws + WS_BSC); const float* bb_ = bf_ + (size_t)RT * 8;
    const float* mu = P->in[I_MU] + layer * RWC; const float* lng = P->in[I_LNG] + layer * 512; const float* lnb = P->in[I_LNB] + layer * 512;
    const bf16_t* wg2 = (const bf16_t*)(ws + WS_WG2) + (size_t)layer * 512 * 128;
    LAS bf16_t* sg = (LAS bf16_t*)F.lds;
    LAS bf16_t* gt = (LAS bf16_t*)(F.lds + 64 * 136 * 2);
    const int tid0 = F.tid, wave = F.wave; const int lane = F.lane;
    const int nunits = nrows_y / 64;
    for (int un = F.bid; un < nunits; un += F.G) {
        int tid = tid0; asm volatile("" : "+v"(tid)); const int lane = tid & 63;
        const long r0 = (long)un * 64; const bool lat = r0 < RL; const int T = lat ? SEQ : CTXL; const int tbase = lat ? (int)(r0 & (SEQ - 1)) : (int)((r0 - RL) & (CTXL - 1));
        for (int it = tid; it < 1024; it += NTHREADS) { const int tk = it >> 4, q = it & 15; float v[8]; load8_shift(u, r0 + tk, tbase + tk, T, 1792 + q * 8, mu, v);
#pragma unroll
            for (int j = 0; j < 8; ++j) v[j] = sigmoidf_(v[j]);
            *(LAS u32x4*)(sg + tk * 136 + q * 8) = pack8(v); }
        __syncthreads();
        {
            const int fr = lane & 15, fq = lane >> 4;
#pragma unroll
            for (int tn = 0; tn < 4; ++tn) { const int cn = (wave * 4 + tn) * 16;
                bf16x8 bfrag[4];
#pragma unroll
                for (int k = 0; k < 4; ++k) bfrag[k] = *(const bf16x8*)(wg2 + (size_t)(cn + fr) * 128 + k * 32 + fq * 8);
#pragma unroll
                for (int tm = 0; tm < 4; ++tm) { f32x4 acc = {0.f, 0.f, 0.f, 0.f};
#pragma unroll
                    for (int k = 0; k < 4; ++k) { const bf16x8 afrag = *(const LAS bf16x8*)(sg + (tm * 16 + fr) * 136 + k * 32 + fq * 8); acc = __builtin_amdgcn_mfma_f32_16x16x32_bf16(afrag, bfrag[k], acc, 0, 0, 0); }
#pragma unroll
                    for (int j = 0; j < 4; ++j) gt[(tm * 16 + fq * 4 + j) * 520 + cn + fr] = (bf16_t)f2bf(acc[j]); } }
        }
        __syncthreads();
        {
            const int tk = tid >> 3, hh = tid & 7; const long row = r0 + tk; const int t = tbase + tk;
            const float bsum = bf_[row * 8 + hh] + bb_[row * 8 + hh];
            float o[64]; float s = 0.f;
#pragma unroll
            for (int q = 0; q < 8; ++q) { float a[8], c[8]; unpack8(*(const u32x4*)(of + row * 512 + hh * 64 + q * 8), a); unpack8(*(const u32x4*)(ob + row * 512 + hh * 64 + q * 8), c);
#pragma unroll
                for (int j = 0; j < 8; ++j) { o[q * 8 + j] = a[j] + c[j]; s += o[q * 8 + j]; } }
            const float mean = s * (1.0f / 64.0f); float vs = 0.f;
#pragma unroll
            for (int j = 0; j < 64; ++j) { const float dd = o[j] - mean; vs += dd * dd; }
            const float rstd = rsqrtf(vs * (1.0f / 64.0f) + 64e-5f);
#pragma unroll
            for (int q = 0; q < 8; ++q) { float vv[8], res[8]; load8_shift(u, row, t, T, 1024 + hh * 64 + q * 8, mu, vv);
                float g8[8]; unpack8(*(const LAS u32x4*)(gt + tk * 520 + hh * 64 + q * 8), g8);
#pragma unroll
                for (int j = 0; j < 8; ++j) { const int c = hh * 64 + q * 8 + j; res[j] = ((o[q * 8 + j] - mean) * rstd * lng[c] + lnb[c] + bsum * vv[j]) * g8[j]; }
                *(u32x4*)(y + row * 512 + hh * 64 + q * 8) = pack8(res); }
        }
        __syncthreads();
    }
}
__device__ __forceinline__ void mla_stats_pass(const Ctx& F, int w0, int nw) {
    unsigned char* ws = getpp()->ws; const int lane = F.lane;
    const bf16_t* um = (const bf16_t*)(ws + D_UMLA); float* rq = (float*)(ws + WS_RSTD); float* rkv = rq + RT;
    for (int row = GW(F) - w0; row < RT; row += nw) {
        const bf16_t* ur = um + (size_t)row * MLC;
        float sq = 0.f, skv = 0.f;
        { float v[8]; unpack8(*(const u32x4*)(ur + lane * 8), v); float s = 0.f;
#pragma unroll
            for (int j = 0; j < 8; ++j) s += v[j] * v[j];
            if (lane < 48) sq += s; else skv += s; }
        if (lane < 16) { float v[8]; unpack8(*(const u32x4*)(ur + 512 + lane * 8), v); float s = 0.f;
#pragma unroll
            for (int j = 0; j < 8; ++j) s += v[j] * v[j];
            skv += s; }
        sq = wave_sum(sq, lane); skv = wave_sum(skv, lane);
        if (lane == 0) { rq[row] = rsqrtf(sq * (1.0f / 384.0f) + 1e-6f); rkv[row] = rsqrtf(skv * (1.0f / 256.0f) + 1e-6f); }
    }
}
__device__ __forceinline__ void krope_pass(const Ctx& F, int half, int layer) {
    unsigned char* ws = getpp()->ws; const int lane = F.lane;
    const bf16_t* um = (const bf16_t*)(ws + D_UMLA); bf16_t* Kb = half ? (bf16_t*)(ws + D_K) : (bf16_t*)(half_a_base(layer) + HA_K);
    const float* cm = (const float*)(ws + WS_ROPE_M); const float* sm = cm + 4096 * 16;
    for (int ci = GW(F) * 4 + (lane >> 4); ci < HROWS; ci += NGW(F) * 4) {
        const int row = ci < 4 * SEQ ? 4 * SEQ * half + ci : RL + 4 * CTXL * half + (ci - 4 * SEQ);
        const int orow = half ? row : ci;
        const bf16_t* ur = um + (size_t)row * MLC; const int l = lane & 15;
        float x1 = bf2f(ur[640 + l]), x2 = bf2f(ur[656 + l]);
        if (row < RL) { const int t = row & (SEQ - 1); const float cs = cm[t * 16 + l], sn = sm[t * 16 + l]; const float o1 = x1 * cs - x2 * sn, o2 = x1 * sn + x2 * cs; x1 = o1; x2 = o2; }
        Kb[(size_t)orow * 544 + 512 + l] = (bf16_t)f2bf(x1); Kb[(size_t)orow * 544 + 528 + l] = (bf16_t)f2bf(x2);
    }
}

constexpr size_t D_KV = D_END1;
static_assert(D_KV + 34 * MiB <= WS_NEED, "retention state buffer");
namespace ret2 {
constexpr int QP = 72, VP = 136, NUNITS = NBATCH * 4 * 34;
typedef short v4i16_t __attribute__((ext_vector_type(4)));
__device__ __forceinline__ bf16x8 tr8(const LAS bf16_t* base, int pitch, int row0, int col0, int lane) {
    const int g = lane >> 4, i = lane & 15, q = i >> 2, p = i & 3;
    const LAS bf16_t* a = base + (row0 + 8 * g + q) * pitch + col0 + 4 * p;
    const s16x4 lo = __builtin_bit_cast(s16x4, __builtin_amdgcn_ds_read_tr16_b64_v4i16((LAS v4i16_t*)a));
    const s16x4 hi = __builtin_bit_cast(s16x4, __builtin_amdgcn_ds_read_tr16_b64_v4i16((LAS v4i16_t*)(a + 4 * pitch)));
    return (bf16x8){lo[0], lo[1], lo[2], lo[3], hi[0], hi[1], hi[2], hi[3]};
}
__device__ __forceinline__ f32x4 mm32(bf16x8 a, bf16x8 b, f32x4 c) { return __builtin_amdgcn_mfma_f32_16x16x32_bf16(a, b, c, 0, 0, 0); }
struct UnitPos { int b, h, cs; long rbase; bool isctx; int t0; };
__device__ __forceinline__ UnitPos unit_pos(int un) { UnitPos U; const int bh = un / 34; U.cs = un % 34; U.b = bh >> 2; U.h = bh & 3; U.isctx = U.cs < 2;
    U.t0 = U.isctx ? 0 : (U.cs - 2) * 128; U.rbase = U.isctx ? (long)RL + U.b * CTXL + U.cs * 128 : (long)U.b * SEQ + U.t0; return U; }
}
__device__ __forceinline__ void ret_r1_unit(const Ctx& F, int layer, int un) {
    using namespace ret2;
    PP P = getpp(); unsigned char* ws = P->ws;
    const bf16_t* u = (const bf16_t*)(ws + D_URET); bf16_t* kv = (bf16_t*)(ws + D_KV);
    const float* cr = (const float*)(ws + WS_ROPE_R); const float* sr = cr + 4096 * 32;
    const UnitPos U = unit_pos(un);
    const float lgf = -__expf(P->in[I_RDEC][(layer * 2 + 0) * 4 + U.h]) * 1.4426950408889634f, lgb = -__expf(P->in[I_RDEC][(layer * 2 + 1) * 4 + U.h]) * 1.4426950408889634f;
    LAS bf16_t* Vt = (LAS bf16_t*)F.lds; LAS bf16_t* kzf = Vt + 128 * VP; LAS bf16_t* kzb = kzf + 128 * QP; LAS bf16_t* St = kzb + 128 * QP;
    const int tid = F.tid, lane = F.lane, w = F.wave;
    {
        const int tk = tid >> 2, pc = tid & 3; float k1[8], k2[8], a[8], c[8];
        u32x4 vv[4], kr[2]; f32x4 rc[2], rs[2];
#pragma unroll
        for (int k4 = 0; k4 < 4; ++k4) { const int it = tid + 512 * k4, tv = it >> 4, ch = it & 15; vv[k4] = *(const u32x4*)(u + (U.rbase + tv) * REC + 512 + U.h * 128 + ch * 8); }
        { const bf16_t* kp = u + (U.rbase + tk) * REC + 256 + U.h * 64 + pc * 8; kr[0] = *(const u32x4*)kp; kr[1] = *(const u32x4*)(kp + 32);
          const int ro = (U.t0 + tk) * 32 + pc * 8; rc[0] = *(const f32x4*)(cr + ro); rc[1] = *(const f32x4*)(cr + ro + 4); rs[0] = *(const f32x4*)(sr + ro); rs[1] = *(const f32x4*)(sr + ro + 4); }
        __builtin_amdgcn_sched_barrier(0);
        unpack8(kr[0], k1); unpack8(kr[1], k2);
#pragma unroll
        for (int j = 0; j < 8; ++j) { const float cs = U.isctx ? 1.0f : rc[j >> 2][j & 3], sn = U.isctx ? 0.0f : rs[j >> 2][j & 3];
            const float ka_ = k1[j] * cs - k2[j] * sn, kb_ = k1[j] * sn + k2[j] * cs; k1[j] = ka_; k2[j] = kb_; }
        const float zf = 0.125f * __builtin_amdgcn_exp2f((float)(127 - tk) * lgf), zb = 0.125f * __builtin_amdgcn_exp2f((float)tk * lgb);
#pragma unroll
        for (int j = 0; j < 8; ++j) { a[j] = k1[j] * zf; c[j] = k2[j] * zf; }
        *(LAS u32x4*)(kzf + tk * QP + pc * 8) = pack8(a); *(LAS u32x4*)(kzf + tk * QP + 32 + pc * 8) = pack8(c);
#pragma unroll
        for (int j = 0; j < 8; ++j) { a[j] = k1[j] * zb; c[j] = k2[j] * zb; }
        *(LAS u32x4*)(kzb + tk * QP + pc * 8) = pack8(a); *(LAS u32x4*)(kzb + tk * QP + 32 + pc * 8) = pack8(c);
#pragma unroll
        for (int k4 = 0; k4 < 4; ++k4) { const int it = tid + 512 * k4, tv = it >> 4, ch = it & 15; *(LAS u32x4*)(Vt + tv * VP + ch * 8) = vv[k4]; }
    }
    __syncthreads();
    {
        const int fr = lane & 15, fq = lane >> 4;
        f32x4 acc[2][4];
#pragma unroll
        for (int dd = 0; dd < 2; ++dd)
#pragma unroll
            for (int tj = 0; tj < 4; ++tj) acc[dd][tj] = (f32x4){0.f, 0.f, 0.f, 0.f};
#pragma unroll
        for (int ks = 0; ks < 4; ++ks) { const bf16x8 a = tr8(Vt, VP, 32 * ks, 16 * w, lane);
#pragma unroll
            for (int tj = 0; tj < 4; ++tj) { acc[0][tj] = mm32(a, tr8(kzf, QP, 32 * ks, 16 * tj, lane), acc[0][tj]); acc[1][tj] = mm32(a, tr8(kzb, QP, 32 * ks, 16 * tj, lane), acc[1][tj]); } }
#pragma unroll
        for (int dd = 0; dd < 2; ++dd)
#pragma unroll
            for (int tj = 0; tj < 4; ++tj)
#pragma unroll
                for (int j = 0; j < 4; ++j) St[dd * 128 * QP + (16 * w + 4 * fq + j) * QP + 16 * tj + fr] = (bf16_t)f2bf(acc[dd][tj][j]);
    }
    __syncthreads();
#pragma unroll
    for (int k4 = 0; k4 < 4; ++k4) { const int it = tid + 512 * k4, dd = it >> 10, e = (it >> 3) & 127, ch = it & 7;
        *(u32x4*)(kv + ((size_t)un * 2 + dd) * 8192 + e * 64 + ch * 8) = *(const LAS u32x4*)(St + dd * 128 * QP + e * QP + ch * 8); }
    __syncthreads();
}
__device__ __forceinline__ void ret_r2(const Ctx& F, int layer, int b0, int nb) {
    using namespace ret2;
    PP P = getpp(); bf16_t* kv = (bf16_t*)(P->ws + D_KV);
    for (int item = (F.bid - b0) * NTHREADS + F.tid; item < 65536; item += nb * NTHREADS) {
        const int bh = item >> 11, dd = (item >> 10) & 1, off = (item & 1023) * 8;
        const float g = __builtin_amdgcn_exp2f(-128.0f * __expf(P->in[I_RDEC][(layer * 2 + dd) * 4 + (bh & 3)]) * 1.4426950408889634f);
        float st[8];
#pragma unroll
        for (int j = 0; j < 8; ++j) st[j] = 0.f;
#pragma unroll
        for (int half = 0; half < 2; ++half) {
            asm volatile("" ::: "memory");
            u32x4 xv[17];
#pragma unroll
            for (int q = 0; q < 17; ++q) { const int i = half * 17 + q; const int cs = dd ? (i < 2 ? 1 - i : 35 - i) : i;
                xv[q] = *(const u32x4*)(kv + ((size_t)(bh * 34 + cs) * 2 + dd) * 8192 + off); }
#pragma unroll
            for (int q = 0; q < 17; ++q) { const int i = half * 17 + q; const int cs = dd ? (i < 2 ? 1 - i : 35 - i) : i;
                float x[8]; unpack8(xv[q], x);
                *(u32x4*)(kv + ((size_t)(bh * 34 + cs) * 2 + dd) * 8192 + off) = pack8(st);
#pragma unroll
                for (int j = 0; j < 8; ++j) st[j] = st[j] * g + x[j]; }
        }
    }
}
__device__ __forceinline__ void ret_r3_unit(const Ctx& F, int layer, int un) {
    using namespace ret2;
    PP P = getpp(); unsigned char* ws = P->ws;
    const bf16_t* u = (const bf16_t*)(ws + D_URET); const bf16_t* kv = (const bf16_t*)(ws + D_KV); bf16_t* y = (bf16_t*)(ws + D_YRET);
    const float* cr = (const float*)(ws + WS_ROPE_R); const float* sr = cr + 4096 * 32;
    const UnitPos U = unit_pos(un);
    const float* lng = P->in[I_RLNG] + layer * 512 + U.h * 128; const float* lnb = P->in[I_RLNB] + layer * 512 + U.h * 128;
    const float lgf = -__expf(P->in[I_RDEC][(layer * 2 + 0) * 4 + U.h]) * 1.4426950408889634f, lgb = -__expf(P->in[I_RDEC][(layer * 2 + 1) * 4 + U.h]) * 1.4426950408889634f;
    LAS bf16_t* qf = (LAS bf16_t*)F.lds; LAS bf16_t* qb = qf + 128 * QP; LAS bf16_t* qn = qb + 128 * QP; LAS bf16_t* ks = qn + 128 * QP; LAS bf16_t* Sm = qn;
    LAS bf16_t* Vt = (LAS bf16_t*)(F.lds + 73728); LAS bf16_t* Rf = (LAS bf16_t*)(F.lds + 108544); LAS bf16_t* Rb = Rf + 128 * QP; LAS bf16_t* Yst = qf;
    const int tid = F.tid, lane = F.lane, w = F.wave, fr = lane & 15, fq = lane >> 4;
    const int n0 = 16 * w;
    u32x4 vv[4], rr[4], gq[4]; float lgv[8], lbv[8];
#pragma unroll
    for (int k4 = 0; k4 < 4; ++k4) { const int it = tid + 512 * k4, tv = it >> 4, ch = it & 15; vv[k4] = *(const u32x4*)(u + (U.rbase + tv) * REC + 512 + U.h * 128 + ch * 8); }
#pragma unroll
    for (int k4 = 0; k4 < 4; ++k4) { const int it = tid + 512 * k4, dd = it >> 10, e = (it >> 3) & 127, ch = it & 7; rr[k4] = *(const u32x4*)(kv + ((size_t)un * 2 + dd) * 8192 + e * 64 + ch * 8); }
#pragma unroll
    for (int k4 = 0; k4 < 4; ++k4) { const int it = lane + 64 * k4, r = it >> 4, ch = it & 15; gq[k4] = *(const u32x4*)(u + (U.rbase + n0 + r) * REC + 1024 + U.h * 128 + ch * 8); }
#pragma unroll
    for (int te = 0; te < 8; ++te) { lgv[te] = lng[16 * te + fr]; lbv[te] = lnb[16 * te + fr]; }
    const int tk = tid >> 2, pc = tid & 3;
    u32x4 qr[2], kr[2]; f32x4 rc[2], rs[2];
    { const bf16_t* qp = u + (U.rbase + tk) * REC + U.h * 64 + pc * 8; qr[0] = *(const u32x4*)qp; qr[1] = *(const u32x4*)(qp + 32); kr[0] = *(const u32x4*)(qp + 256); kr[1] = *(const u32x4*)(qp + 288);
      const int ro = (U.t0 + tk) * 32 + pc * 8; rc[0] = *(const f32x4*)(cr + ro); rc[1] = *(const f32x4*)(cr + ro + 4); rs[0] = *(const f32x4*)(sr + ro); rs[1] = *(const f32x4*)(sr + ro + 4); }
    __builtin_amdgcn_sched_barrier(0);
    {
        float q1[8], q2[8], k1[8], k2[8], a[8], c[8];
        unpack8(qr[0], q1); unpack8(qr[1], q2); unpack8(kr[0], k1); unpack8(kr[1], k2);
#pragma unroll
        for (int j = 0; j < 8; ++j) { const float cs = U.isctx ? 1.0f : rc[j >> 2][j & 3], sn = U.isctx ? 0.0f : rs[j >> 2][j & 3];
            const float qa_ = q1[j] * cs - q2[j] * sn, qb_ = q1[j] * sn + q2[j] * cs, ka_ = k1[j] * cs - k2[j] * sn, kb_ = k1[j] * sn + k2[j] * cs;
            q1[j] = qa_; q2[j] = qb_; k1[j] = ka_; k2[j] = kb_; }
        *(LAS u32x4*)(qn + tk * QP + pc * 8) = pack8(q1); *(LAS u32x4*)(qn + tk * QP + 32 + pc * 8) = pack8(q2);
        const float xf = __builtin_amdgcn_exp2f((float)(tk + 1) * lgf), xb = __builtin_amdgcn_exp2f((float)(128 - tk) * lgb);
#pragma unroll
        for (int j = 0; j < 8; ++j) { a[j] = q1[j] * xf; c[j] = q2[j] * xf; }
        *(LAS u32x4*)(qf + tk * QP + pc * 8) = pack8(a); *(LAS u32x4*)(qf + tk * QP + 32 + pc * 8) = pack8(c);
#pragma unroll
        for (int j = 0; j < 8; ++j) { a[j] = q1[j] * xb; c[j] = q2[j] * xb; }
        *(LAS u32x4*)(qb + tk * QP + pc * 8) = pack8(a); *(LAS u32x4*)(qb + tk * QP + 32 + pc * 8) = pack8(c);
#pragma unroll
        for (int j = 0; j < 8; ++j) { a[j] = k1[j] * 0.125f; c[j] = k2[j] * 0.125f; }
        *(LAS u32x4*)(ks + tk * QP + pc * 8) = pack8(a); *(LAS u32x4*)(ks + tk * QP + 32 + pc * 8) = pack8(c);
#pragma unroll
        for (int k4 = 0; k4 < 4; ++k4) { const int it = tid + 512 * k4, tv = it >> 4, ch = it & 15; *(LAS u32x4*)(Vt + tv * VP + ch * 8) = vv[k4]; }
#pragma unroll
        for (int k4 = 0; k4 < 4; ++k4) { const int it = tid + 512 * k4, dd = it >> 10, e = (it >> 3) & 127, ch = it & 7; *(LAS u32x4*)((dd ? Rb : Rf) + e * QP + ch * 8) = rr[k4]; }
    }
    __syncthreads();
    f32x4 ST[8];
    {
        bf16x8 qa[2];
#pragma unroll
        for (int k2 = 0; k2 < 2; ++k2) qa[k2] = *(const LAS bf16x8*)(qn + (n0 + fr) * QP + k2 * 32 + fq * 8);
#pragma unroll
        for (int tm = 0; tm < 8; ++tm) { ST[tm] = (f32x4){0.f, 0.f, 0.f, 0.f};
#pragma unroll
            for (int k2 = 0; k2 < 2; ++k2) ST[tm] = mm32(*(const LAS bf16x8*)(ks + (16 * tm + fr) * QP + k2 * 32 + fq * 8), qa[k2], ST[tm]); }
    }
    s16x4 cst[8];
#pragma unroll
    for (int tm = 0; tm < 8; ++tm) { f32x4 t;
#pragma unroll
        for (int j = 0; j < 4; ++j) { const int n = n0 + fr, m = 16 * tm + 4 * fq + j; const int dd = n - m;
            const float ex = __builtin_amdgcn_exp2f((float)(dd < 0 ? -dd : dd) * (dd > 0 ? lgf : lgb));
            t[j] = ST[tm][j] * ((dd == 0) ? 2.0f : ex); }
        u32x2 pw; pw.x = pk2(t[0], t[1]); pw.y = pk2(t[2], t[3]); cst[tm] = __builtin_bit_cast(s16x4, pw); }
    f32x4 Y[8];
#pragma unroll
    for (int te = 0; te < 8; ++te) Y[te] = (f32x4){0.f, 0.f, 0.f, 0.f};
    {
        const int g = lane >> 4, i = lane & 15, q = i >> 2, pp = i & 3;
#pragma unroll
        for (int p = 0; p < 4; ++p) { const bf16x8 a = (bf16x8){cst[2 * p][0], cst[2 * p][1], cst[2 * p][2], cst[2 * p][3], cst[2 * p + 1][0], cst[2 * p + 1][1], cst[2 * p + 1][2], cst[2 * p + 1][3]};
#pragma unroll
            for (int te = 0; te < 8; ++te) {
                const LAS bf16_t* va = Vt + (32 * p + 4 * g + q) * VP + 16 * te + 4 * pp;
                const s16x4 lo = __builtin_bit_cast(s16x4, __builtin_amdgcn_ds_read_tr16_b64_v4i16((LAS v4i16_t*)va));
                const s16x4 hi = __builtin_bit_cast(s16x4, __builtin_amdgcn_ds_read_tr16_b64_v4i16((LAS v4i16_t*)(va + 16 * VP)));
                Y[te] = mm32(a, (bf16x8){lo[0], lo[1], lo[2], lo[3], hi[0], hi[1], hi[2], hi[3]}, Y[te]); } }
    }
#pragma unroll
    for (int k2 = 0; k2 < 2; ++k2) { const bf16x8 af = *(const LAS bf16x8*)(qf + (n0 + fr) * QP + k2 * 32 + fq * 8), ab = *(const LAS bf16x8*)(qb + (n0 + fr) * QP + k2 * 32 + fq * 8);
#pragma unroll
        for (int te = 0; te < 8; ++te) { Y[te] = mm32(af, *(const LAS bf16x8*)(Rf + (16 * te + fr) * QP + k2 * 32 + fq * 8), Y[te]); Y[te] = mm32(ab, *(const LAS bf16x8*)(Rb + (16 * te + fr) * QP + k2 * 32 + fq * 8), Y[te]); } }
    __syncthreads();
#pragma unroll
    for (int j = 0; j < 4; ++j) { float s = 0.f;
#pragma unroll
        for (int te = 0; te < 8; ++te) s += Y[te][j];
        s += shx(s, 1, lane); s += shx(s, 2, lane); s += shx(s, 4, lane); s += shx(s, 8, lane);
        const float mean = s * (1.0f / 128.0f); float vs = 0.f;
#pragma unroll
        for (int te = 0; te < 8; ++te) { const float dd = Y[te][j] - mean; vs += dd * dd; }
        vs += shx(vs, 1, lane); vs += shx(vs, 2, lane); vs += shx(vs, 4, lane); vs += shx(vs, 8, lane);
        const float rstd = rsqrtf(vs * (1.0f / 128.0f) + 1e-5f);
        const int r = 4 * fq + j; LAS bf16_t* yst = (r < 8 ? qf + n0 * QP + r * VP : qb + n0 * QP + (r - 8) * VP);
#pragma unroll
        for (int te = 0; te < 8; ++te) { const int e = 16 * te + fr; yst[e] = (bf16_t)f2bf((Y[te][j] - mean) * rstd * lgv[te] + lbv[te]); } }
    __syncthreads();
#pragma unroll
    for (int k4 = 0; k4 < 4; ++k4) { const int it = lane + 64 * k4, r = it >> 4, ch = it & 15; const long row = U.rbase + n0 + r;
        const LAS bf16_t* yst = (r < 8 ? qf + n0 * QP + r * VP : qb + n0 * QP + (r - 8) * VP);
        float yv[8], gv[8]; unpack8(*(const LAS u32x4*)(yst + ch * 8), yv); unpack8(gq[k4], gv);
#pragma unroll
        for (int j = 0; j < 8; ++j) yv[j] *= siluf_(gv[j]);
        *(u32x4*)(y + row * 512 + U.h * 128 + ch * 8) = pack8(yv); }
    __syncthreads();
}
__device__ __forceinline__ void ret_r3_phase(const Ctx& F, int layer) {
    for (int un = F.bid; un < ret2::NUNITS; un += F.G) { if (layer != 0 && (un % 34) < 2) continue; ret_r3_unit(F, layer, un); }
}
__device__ __forceinline__ void ret_r1_phase(const Ctx& F, int layer) { for (int un = F.bid; un < ret2::NUNITS; un += F.G) ret_r1_unit(F, layer, un); }
__device__ __forceinline__ void rw_phase(const Ctx& F, int layer) {
    unsigned char* ws = getpp()->ws;
    if (F.G >= 160) {
        if (F.bid < 128) rwkv_chain4(F, layer, F.bid >> 4, (F.bid >> 1) & 7, F.bid & 1);
        unsigned* ctr = (unsigned*)(ws + WS_CTL) + 192 + 64 * layer; LAS unsigned* bc = (LAS unsigned*)(F.lds + LDS_BYTES - 32);
        for (;;) {
            __syncthreads();
            if (F.tid == 0) *bc = __hip_atomic_fetch_add(ctr, 1u, __ATOMIC_RELAXED, __HIP_MEMORY_SCOPE_AGENT);
            __syncthreads();
            const unsigned u = *bc; if (u >= 512u) break;
            const int bh = (int)u >> 4; attn_latent_unit(F, ws, half_a_base(layer), bh >> 3, bh & 7, (int)u & 15);
        }
    } else {
        for (int un = F.bid; un < 128; un += F.G) { rwkv_chain4(F, layer, un >> 4, (un >> 1) & 7, un & 1); __syncthreads(); }
        for (int u = F.bid; u < 512; u += F.G) { const int bh = u >> 4; attn_latent_unit(F, ws, half_a_base(layer), bh >> 3, bh & 7, u & 15); }
    }
}

template <int NB> __device__ __forceinline__ void rows_norm(int lane, const float* hbase, const int* rows, const float* gain, const float* mod, f32x4 (*y)[4]) {
    float ss[NB];
#pragma unroll
    for (int b = 0; b < NB; ++b) { const float* src = hbase + (size_t)rows[b] * 1024; ss[b] = 0.f;
#pragma unroll
        for (int j = 0; j < 4; ++j) { y[b][j] = *(const f32x4*)(src + 4 * lane + 256 * j); ss[b] += y[b][j].x * y[b][j].x + y[b][j].y * y[b][j].y + y[b][j].z * y[b][j].z + y[b][j].w * y[b][j].w; } }
#pragma unroll
    for (int b = 0; b < NB; ++b) ss[b] = wave_sum(ss[b], lane);
#pragma unroll
    for (int b = 0; b < NB; ++b) { const float rstd = rsqrtf(ss[b] * (1.0f / 1024.0f) + 1e-6f); const float* sh = mod + (rows[b] >> 12) * 6144; const float* sc = sh + 1024;
#pragma unroll
        for (int j = 0; j < 4; ++j) { const int c = 4 * lane + 256 * j; y[b][j] = y[b][j] * rstd * *(const f32x4*)(gain + c) * (*(const f32x4*)(sc + c) + 1.0f) + *(const f32x4*)(sh + c); } }
}
__device__ __forceinline__ void moe_route_pass(const Ctx& F, int layer) {
    PP P = getpp(); unsigned char* ws = P->ws;
    const float* gain = P->in[I_NFFN] + layer * 1024; const float* mod = (const float*)(ws + WS_MOD) + (size_t)layer * 9 * 6144 + 3072;
    const float* router = P->in[I_ROUTER];
    unsigned* cnt = (unsigned*)(ws + WS_CTL); int* route = (int*)(ws + WS_ROUTE);
    LAS float* rl = (LAS float*)F.lds;
    LAS unsigned* lc = (LAS unsigned*)(F.lds + 32768);
    for (int i = F.tid; i < 8192; i += NTHREADS) rl[(i & 7) * 1024 + (i >> 3)] = router[i];
    if (F.tid < 16) lc[F.tid] = 0u;
    __syncthreads();
    const int rpb = (RL + F.G - 1) / F.G, rpw = (rpb + 7) / 8;
    const int b0 = F.bid * rpb, b1 = (b0 + rpb < RL) ? b0 + rpb : RL;
    const int r0 = b0 + F.wave * rpw, r1 = (r0 + rpw < b1) ? r0 + rpw : b1;
    constexpr int NB = 2;
    for (int rb = r0; rb < r1; rb += NB) {
        int lane = F.lane; asm volatile("" : "+v"(lane));
        int rows[NB]; f32x4 y[NB][4];
#pragma unroll
        for (int b = 0; b < NB; ++b) rows[b] = (rb + b < r1) ? rb + b : r1 - 1;
        rows_norm<NB>(lane, P->out, rows, gain, mod, y);
        float lg[NB][8];
#pragma unroll
        for (int b = 0; b < NB; ++b)
#pragma unroll
            for (int e = 0; e < 8; ++e) lg[b][e] = 0.f;
#pragma unroll
        for (int j = 0; j < 4; ++j)
#pragma unroll
            for (int e = 0; e < 8; ++e) { const f32x4 r4 = *(const LAS f32x4*)(rl + e * 1024 + 4 * lane + 256 * j);
#pragma unroll
                for (int b = 0; b < NB; ++b) lg[b][e] += y[b][j][0] * r4[0] + y[b][j][1] * r4[1] + y[b][j][2] * r4[2] + y[b][j][3] * r4[3]; }
#pragma unroll
        for (int b = 0; b < NB; ++b)
#pragma unroll
            for (int e = 0; e < 8; ++e) lg[b][e] = wave_sum(lg[b][e], lane);
        if (lane == 0) {
#pragma unroll
            for (int b = 0; b < NB; ++b) if (rb + b < r1) {
                int i0 = 0; float v0 = lg[b][0];
#pragma unroll
                for (int e = 1; e < 8; ++e) if (lg[b][e] > v0) { v0 = lg[b][e]; i0 = e; }
                int i1 = -1; float v1 = -3.0e38f;
#pragma unroll
                for (int e = 0; e < 8; ++e) if (e != i0 && lg[b][e] > v1) { v1 = lg[b][e]; i1 = e; }
                const float w0 = 1.0f / (1.0f + __expf(v1 - v0)), w1 = 1.0f - w0;
                const unsigned p0 = __hip_atomic_fetch_add(&lc[i0], 1u, __ATOMIC_RELAXED, __HIP_MEMORY_SCOPE_WORKGROUP), p1 = __hip_atomic_fetch_add(&lc[i1], 1u, __ATOMIC_RELAXED, __HIP_MEMORY_SCOPE_WORKGROUP);
                int* r = route + (size_t)rows[b] * 8; r[0] = i0; r[1] = i1; r[2] = __float_as_int(w0); r[3] = __float_as_int(w1); r[4] = (int)p0; r[5] = (int)p1;
            }
        }
    }
    __syncthreads();
    if (F.tid < 8) lc[8 + F.tid] = atomicAdd(&cnt[F.tid], lc[F.tid]);
    __syncthreads();
    for (int row = r0 + F.lane; row < r1; row += 64) { int* r = route + (size_t)row * 8; const int e0 = r[0], e1 = r[1], p0 = r[4], p1 = r[5]; r[4] = p0 + (int)lc[8 + e0]; r[5] = p1 + (int)lc[8 + e1]; }
    __syncthreads();
}
__device__ __forceinline__ void moe_gather_pass(const Ctx& F, int layer) {
    PP P = getpp(); unsigned char* ws = P->ws;
    const float* gain = P->in[I_NFFN] + layer * 1024; const float* mod = (const float*)(ws + WS_MOD) + (size_t)layer * 9 * 6144 + 3072;
    const unsigned* cnt = (const unsigned*)(ws + WS_CTL); const int* route = (const int*)(ws + WS_ROUTE);
    bf16_t* xlo = (bf16_t*)(ws + D_XG); bf16_t* xhi = xlo + (size_t)RG * 512;
    const MoeTiles T = moe_tiles(cnt);
    const int rpw = (RL + NGW(F) - 1) / NGW(F); const int r0 = GW(F) * rpw; const int r1 = (r0 + rpw < RL) ? r0 + rpw : RL;
    constexpr int NB = 2;
    for (int rb = r0; rb < r1; rb += NB) {
        int lane = F.lane; asm volatile("" : "+v"(lane));
        int rows[NB]; f32x4 y[NB][4];
#pragma unroll
        for (int b = 0; b < NB; ++b) rows[b] = (rb + b < r1) ? rb + b : r1 - 1;
        rows_norm<NB>(lane, P->out, rows, gain, mod, y);
#pragma unroll
        for (int b = 0; b < NB; ++b) {
            const int* r = route + (size_t)rows[b] * 8; const int e0 = r[0], e1 = r[1];
            int t0 = 0, t1 = 0;
#pragma unroll
            for (int e = 0; e < 8; ++e) { if (e == e0) t0 = T.tstart[e]; if (e == e1) t1 = T.tstart[e]; }
            const size_t s0 = (size_t)t0 * 256 + r[4], s1 = (size_t)t1 * 256 + r[5];
#pragma unroll
            for (int j = 0; j < 4; ++j) { const int c = 4 * lane + 256 * j; u32x2 o; o.x = pk2(y[b][j].x, y[b][j].y); o.y = pk2(y[b][j].z, y[b][j].w);
                bf16_t* bp = (c < 512) ? xlo + c : xhi + (c - 512);
                *(u32x2*)(bp + s0 * 512) = o; *(u32x2*)(bp + s1 * 512) = o; } }
    }
}
__device__ __forceinline__ void moe_final_pass(const Ctx& F, int layer) {
    PP P = getpp(); unsigned char* ws = P->ws;
    const float* mod = (const float*)(ws + WS_MOD) + (size_t)layer * 9 * 6144 + 5120;
    const unsigned* cnt = (const unsigned*)(ws + WS_CTL); const int* route = (const int*)(ws + WS_ROUTE);
    const bf16_t* ym = (const bf16_t*)(ws + D_XG); const float* fn = P->in[I_FNORM];
    const MoeTiles T = moe_tiles(cnt);
    const int rpw = (RL + NGW(F) - 1) / NGW(F); const int r0 = GW(F) * rpw; const int r1 = (r0 + rpw < RL) ? r0 + rpw : RL;
    constexpr int NB = 2;
    for (int rb = r0; rb < r1; rb += NB) {
        int lane = F.lane; asm volatile("" : "+v"(lane));
        f32x4 v[NB][4]; float ss[NB]; int rows[NB];
#pragma unroll
        for (int b = 0; b < NB; ++b) { const int row = (rb + b < r1) ? rb + b : r1 - 1; rows[b] = row;
            const int* r = route + (size_t)row * 8; const int e0 = r[0], e1 = r[1]; const float w0 = __int_as_float(r[2]), w1 = __int_as_float(r[3]);
            int t0 = 0, t1 = 0;
#pragma unroll
            for (int e = 0; e < 8; ++e) { if (e == e0) t0 = T.tstart[e]; if (e == e1) t1 = T.tstart[e]; }
            const size_t s0 = (size_t)t0 * 256 + r[4], s1 = (size_t)t1 * 256 + r[5];
            const float* g = mod + (row >> 12) * 6144; const float* hp = P->out + (size_t)row * 1024; ss[b] = 0.f;
#pragma unroll
            for (int j = 0; j < 4; ++j) { const int c = 4 * lane + 256 * j; const u32x2 a = *(const u32x2*)(ym + s0 * 1024 + c), bq = *(const u32x2*)(ym + s1 * 1024 + c);
                const f32x4 ya = {bflo(a.x), bfhi(a.x), bflo(a.y), bfhi(a.y)}, yb = {bflo(bq.x), bfhi(bq.x), bflo(bq.y), bfhi(bq.y)};
                v[b][j] = *(const f32x4*)(hp + c) + *(const f32x4*)(g + c) * (ya * w0 + yb * w1);
                ss[b] += v[b][j].x * v[b][j].x + v[b][j].y * v[b][j].y + v[b][j].z * v[b][j].z + v[b][j].w * v[b][j].w; } }
#pragma unroll
        for (int b = 0; b < NB; ++b) ss[b] = wave_sum(ss[b], lane);
#pragma unroll
        for (int b = 0; b < NB; ++b) { const float rstd = rsqrtf(ss[b] * (1.0f / 1024.0f) + 1e-6f); float* hp = P->out + (size_t)rows[b] * 1024;
#pragma unroll
            for (int j = 0; j < 4; ++j) { const int c = 4 * lane + 256 * j; *(f32x4*)(hp + c) = v[b][j] * rstd * *(const f32x4*)(fn + c); } }
    }
}

#define XB_TMO      128
#define XB_XCNT(j)  (256  + 64 * (j))
#define XB_XSUB(j)  (1280 + 64 * (j))
#define XB_XGEN(j)  (2304 + 64 * (j))
#define XB_TOP      3328
#define XB_TOPGEN   3392
#define XCD_BAR_WORDS 3456
#define XB_SPIN_CAP (1u << 18)
constexpr int CW_BAR = 4096;
constexpr int LDS_BARST = LDS_BYTES - 16;
__device__ __forceinline__ unsigned xb_ld(unsigned* p)              { return __hip_atomic_load(p, __ATOMIC_RELAXED, __HIP_MEMORY_SCOPE_AGENT); }
__device__ __forceinline__ unsigned xb_add(unsigned* p, unsigned v) { return __hip_atomic_fetch_add(p, v, __ATOMIC_RELAXED, __HIP_MEMORY_SCOPE_AGENT); }
__device__ __forceinline__ unsigned xb_xcc_id() { return (unsigned)__builtin_amdgcn_s_getreg((3 << 11) | 20) & 0xFu; }
#define XB_SPIN(cond, bar) do { unsigned _sp = 0; while (cond) { __builtin_amdgcn_s_sleep(1); \
    if ((++_sp & 255u) == 0u) { if (xb_ld(&(bar)[XB_TMO])) break; if (_sp > XB_SPIN_CAP) { atomicAdd(&(bar)[XB_TMO], 1u); break; } } } } while (0)
__device__ __forceinline__ void xcd_barrier_complete(unsigned* bar, unsigned x, unsigned& nloc, unsigned& nx) {
    const unsigned G = gridDim.x * gridDim.y * gridDim.z;
    unsigned sum, cnt, mine, sp = 0u;
    for (;;) {
        sum = 0u; cnt = 0u; mine = 0u;
#pragma unroll
        for (unsigned j = 0; j < 16; ++j) { const unsigned c = xb_ld(&bar[XB_XCNT(j)]); sum += c; cnt += (c > 0u) ? 1u : 0u; mine = (j == x) ? c : mine; }
        if (sum == G) break;
        __builtin_amdgcn_s_sleep(1);
        if ((++sp & 255u) == 0u) { if (xb_ld(&bar[XB_TMO])) break; if (sp > XB_SPIN_CAP) { atomicAdd(&bar[XB_TMO], 1u); break; } }
    }
    nloc = mine > 0u ? mine : 1u; nx = cnt > 0u ? cnt : 1u;
}
__device__ __forceinline__ void xcd_barrier(LAS unsigned char* lds) {
    asm volatile("s_waitcnt vmcnt(0)" ::: "memory");
    __syncthreads();
    if (threadIdx.x == 0) {
        unsigned* bar = (unsigned*)(getpp()->ws + WS_CTL) + CW_BAR;
        volatile LAS unsigned* st = (volatile LAS unsigned*)(lds + LDS_BARST);
        const unsigned x = xb_xcc_id();
        __builtin_amdgcn_s_waitcnt(0);
        unsigned nloc = st[0], nx = st[1];
        if (nloc == 0u) { xcd_barrier_complete(bar, x, nloc, nx); st[0] = nloc; st[1] = nx; }
        const unsigned old = xb_add(&bar[XB_XSUB(x)], 1u);
        const unsigned gen = old / nloc;
        if (old + 1u == (gen + 1u) * nloc) {
            __builtin_amdgcn_fence(__ATOMIC_RELEASE, "agent");
            asm volatile("s_waitcnt vmcnt(0)" ::: "memory");
            const unsigned og = xb_add(&bar[XB_TOP], 1u);
            const unsigned tg = og / nx;
            if (og + 1u == (tg + 1u) * nx) xb_add(&bar[XB_TOPGEN], 1u);
            else XB_SPIN(xb_ld(&bar[XB_TOPGEN]) == tg, bar);
            __builtin_amdgcn_fence(__ATOMIC_ACQUIRE, "agent");
            xb_add(&bar[XB_XGEN(x)], 1u);
            asm volatile("s_waitcnt vmcnt(0)" ::: "memory");
        } else {
            XB_SPIN(xb_ld(&bar[XB_XGEN(x)]) == gen, bar);
            __builtin_amdgcn_fence(__ATOMIC_ACQUIRE, "agent");
            asm volatile("s_waitcnt vmcnt(0)" ::: "memory");
        }
    }
    __syncthreads();
}
#define FRESH() do { int t_ = threadIdx.x; asm volatile("" : "+v"(t_)); F.tid = t_; F.lane = t_ & 63; F.wave = __builtin_amdgcn_readfirstlane(t_ >> 6); \
    int g_ = gridDim.x, b_ = blockIdx.x; asm volatile("" : "+s"(g_), "+s"(b_)); F.G = g_; F.bid = b_; } while (0)
#define PHASE_VARS FRESH(); const int G = F.G, c = F.bid; (void)G; (void)c; PP P = getpp(); unsigned char* ws = P->ws; const bool L0 = (layer == 0); \
    const float* hl = L0 ? P->in[I_X] : P->out; const float* hcx = L0 ? P->in[I_CTX] : (const float*)(ws + WS_HC); float* hc = (float*)(ws + WS_HC); \
    const char* wl = (const char*)(ws + WS_W + (size_t)layer * WL_STRIDE); const float* mod = (const float*)(ws + WS_MOD) + (size_t)layer * 9 * 6144; \
    const int nMm = L0 ? RT / 256 : RL / 256; (void)hl; (void)hcx; (void)hc; (void)wl; (void)mod; (void)nMm;

template <int layer> __device__ __forceinline__ void layer_fwd(Ctx& F, cg::grid_group& grid) {

        { PHASE_VARS norm_pass(F, layer, 0, hl, hcx, RT, (bf16_t*)(ws + D_XN1), (bf16_t*)(ws + D_XN1 + Y34)); }
        xcd_barrier(F.lds);
        { PHASE_VARS SchedSplit2 S{(const char*)(ws + D_XN1), (const char*)(ws + D_XN1 + Y34), wl + WL_WINLO, wl + WL_WINHI, RT / 256, MIXP / 256, G, c};
          EpiInproj E{ws};
          pg8::gemm_phase<512, 512, true>(F.lds, S, E); }
        xcd_barrier(F.lds);
        FRESH(); mla_stats_pass(F, 0, F.G * 8);
        FRESH(); ret_r1_phase(F, layer);
        xcd_barrier(F.lds);
        FRESH(); ret_r2(F, layer, 0, F.G);
        FRESH(); krope_pass(F, 0, layer);
        { PHASE_VARS SchedHalf S{(const char*)(ws + D_UMLA), wl + WL_WQ, (size_t)256 * MLC * 2, (size_t)256 * 384 * 2, 6, 3, 0, G, (c + G - 128 % G) % G};
          EpiQup E{(bf16_t*)(half_a_base(layer) + HA_Q), (const float*)(ws + WS_RSTD), (const float*)(ws + WS_ROPE_M), (const float*)(ws + WS_ROPE_M) + 4096 * 16, 1};
          pg8::gemm_phase<MLC, 384, false>(F.lds, S, E); }
        { PHASE_VARS SchedHalf S{(const char*)(ws + D_UMLA) + 384 * 2, wl + WL_WKV, (size_t)256 * MLC * 2, (size_t)256 * 256 * 2, 4, 4, 0, G, (c + G - 24 % G) % G};
          EpiKVup E{(bf16_t*)(half_a_base(layer) + HA_K), (bf16_t*)(half_a_base(layer) + HA_V), (const float*)(ws + WS_RSTD) + RT, 1};
          pg8::gemm_phase<MLC, 256, true>(F.lds, S, E); }
        xcd_barrier(F.lds);
        FRESH(); rw_phase(F, layer);
        xcd_barrier(F.lds);
        FRESH(); rwkv_post_phase(F, layer, layer == 0 ? RT : RL);
        xcd_barrier(F.lds);
        FRESH(); krope_pass(F, 1, layer);
        FRESH(); ret_r3_phase(F, layer);
        { PHASE_VARS SchedHalf S{(const char*)(ws + D_UMLA), wl + WL_WQ, (size_t)256 * MLC * 2, (size_t)256 * 384 * 2, 6, 3, 1, G, (c + G - 64 % G) % G};
          EpiQup E{(bf16_t*)(ws + D_Q), (const float*)(ws + WS_RSTD), (const float*)(ws + WS_ROPE_M), (const float*)(ws + WS_ROPE_M) + 4096 * 16, 0};
          pg8::gemm_phase<MLC, 384, false>(F.lds, S, E); }
        { PHASE_VARS SchedHalf S{(const char*)(ws + D_UMLA) + 384 * 2, wl + WL_WKV, (size_t)256 * MLC * 2, (size_t)256 * 256 * 2, 4, 4, 1, G, (c + G - 216 % G) % G};
          EpiKVup E{(bf16_t*)(ws + D_K), (bf16_t*)(ws + D_V), (const float*)(ws + WS_RSTD) + RT, 0};
          pg8::gemm_phase<MLC, 256, true>(F.lds, S, E); }
        xcd_barrier(F.lds);
        FRESH(); attn_phase(F, layer);
        xcd_barrier(F.lds);
        if (layer != 0) { { PHASE_VARS norm_pass(F, layer, 0, hl, hcx, nMm * 256, (bf16_t*)(ws + D_XN1), (bf16_t*)(ws + D_XN1 + Y34)); }
        xcd_barrier(F.lds); }
        { PHASE_VARS SchedMerge S; S.XNlo = (const char*)(ws + D_XN1); S.XNhi = (const char*)(ws + D_XN1 + Y34); S.WgLo = wl + WL_WGLO; S.WgHi = wl + WL_WGHI;
          S.wsb = (const char*)ws; S.Wb = wl + WL_WB; S.nM = nMm; S.G = G; S.c = c; S.ctx3 = L0 && G > 64;
          EpiMerge E{(u32x4*)(ws + D_SCR + (size_t)c * 131072), (bf16_t*)(ws + D_M), (bf16_t*)(ws + D_P12)};
          pg8::gemm_phase<512, 512, true>(F.lds, S, E); }
        xcd_barrier(F.lds);
        if (layer == 0 && F.G > 64) { PHASE_VARS SchedWout0 S{(const char*)(ws + D_M), wl + WL_WO, (const char*)ws, G, c};
          EpiResid E{hl, hcx, P->out, hc, mod, 2048};
          pg8::gemm_phase<1024, 1024, false>(F.lds, S, E); }
        else { PHASE_VARS Sched1 S{(const char*)(ws + D_M), wl + WL_WO, (size_t)256 * 1024 * 2, (size_t)256 * 1024 * 2, 16, nMm, 4, G, c};
          EpiResid E{hl, hcx, P->out, hc, mod, 2048};
          pg8::gemm_phase<1024, 1024, false>(F.lds, S, E); }
        xcd_barrier(F.lds);
        if (layer == 0) {
            { PHASE_VARS norm_pass(F, layer, 1, P->out, hc, RT, (bf16_t*)(ws + D_XN2), (bf16_t*)(ws + D_XN2 + Y34)); }
            FRESH(); convert_ffn0(F);
            xcd_barrier(F.lds);
            { PHASE_VARS SchedSplit2 S{(const char*)(ws + D_XN2), (const char*)(ws + D_XN2 + Y34), (const char*)(ws + D_FFW), (const char*)(ws + D_FFW) + (size_t)5632 * 1024, RT / 256, 22, G, c};
              EpiSwiglu E{(bf16_t*)(ws + D_H), DFF};
              pg8::gemm_phase<512, 512, true>(F.lds, S, E); }
            xcd_barrier(F.lds);
            { PHASE_VARS Sched1 S{(const char*)(ws + D_H), (const char*)(ws + D_FFW) + (size_t)2 * 5632 * 1024, (size_t)256 * DFF * 2, (size_t)256 * DFF * 2, 44, RT / 256, 4, G, c};
              EpiResid E{P->out, hc, P->out, hc, mod, 5120};
              pg8::gemm_phase<DFF, DFF, false>(F.lds, S, E); }
            xcd_barrier(F.lds);
        } else {
            FRESH(); moe_route_pass(F, layer);
            FRESH(); convert_moe(F);
            xcd_barrier(F.lds);
            FRESH(); moe_gather_pass(F, layer);
            xcd_barrier(F.lds);
            { PHASE_VARS const MoeTiles T = moe_tiles((const unsigned*)(ws + WS_CTL));
              SchedMoeUp S{(const char*)(ws + D_XG), (const char*)(ws + D_XG) + (size_t)RG * 1024, (const char*)(ws + D_MOEW), T, G, c};
              EpiSwiglu E{(bf16_t*)(ws + D_HM), DFE};
              pg8::gemm_phase<512, 512, true>(F.lds, S, E); }
            xcd_barrier(F.lds);
            { PHASE_VARS const MoeTiles T = moe_tiles((const unsigned*)(ws + WS_CTL));
              SchedMoeDown S{(const char*)(ws + D_HM), (const char*)(ws + D_MOEW), T, G, c};
              EpiBf16 E{(bf16_t*)(ws + D_XG), 1024};
              pg8::gemm_phase<DFE, DFE, true>(F.lds, S, E); }
            xcd_barrier(F.lds);
            FRESH(); moe_final_pass(F, layer);
        }
    }
#undef PHASE_VARS
#undef FRESH

__global__ void __launch_bounds__(NTHREADS, 2) mega_fwd(Params prm) {
    extern __shared__ __attribute__((aligned(16))) unsigned char lds_raw[];
    cg::grid_group grid = cg::this_grid();
    Ctx F; F.lds = (LAS unsigned char*)lds_raw; F.tid = threadIdx.x; F.lane = F.tid & 63; F.wave = __builtin_amdgcn_readfirstlane(F.tid >> 6); F.G = gridDim.x; F.bid = blockIdx.x;
    if (F.tid < 4) ((LAS unsigned*)(F.lds + LDS_BARST))[F.tid] = 0u;
    __syncthreads();
    if (F.tid == 0) (void)xb_add((unsigned*)(prm.ws + WS_CTL) + CW_BAR + XB_XCNT(xb_xcc_id()), 1u);
    phase0(F);
    grid.sync();
    layer_fwd<0>(F, grid);
    layer_fwd<1>(F, grid);
}

extern "C" void kernel_launch(void* const* d_in, const int* in_sizes, int n_in, void* d_out, int out_size, void* d_ws, size_t ws_size, hipStream_t stream) {
    static int grid_blocks = 0;
    if (grid_blocks == 0) {
        if (n_in != 37 || ws_size < WS_NEED) { fprintf(stderr, "kernel_launch: unexpected n_in %d / ws %zu\n", n_in, ws_size); grid_blocks = -1; return; }
        int dev = 0, cus = 0, per_cu = 0;
        hipGetDevice(&dev); hipDeviceGetAttribute(&cus, hipDeviceAttributeMultiprocessorCount, dev);
        hipFuncSetAttribute((const void*)mega_fwd, hipFuncAttributeMaxDynamicSharedMemorySize, LDS_BYTES);
        hipOccupancyMaxActiveBlocksPerMultiprocessor(&per_cu, (const void*)mega_fwd, NTHREADS, LDS_BYTES);
        if (per_cu < 1) { fprintf(stderr, "kernel_launch: occupancy query says %d blocks/CU\n", per_cu); per_cu = 1; }
        grid_blocks = cus;
        (void)hipGetLastError();
    }
    if (grid_blocks < 0) return;
    (void)hipMemsetAsync((char*)d_ws + WS_CTL, 0, 65536, stream);
    Params p{};
    for (int i = 0; i < 37; ++i) p.in[i] = (const float*)d_in[i];
    p.out = (float*)d_out; p.ws = (unsigned char*)d_ws;
    void* args[] = {&p};
    hipError_t e = hipLaunchCooperativeKernel((const void*)mega_fwd, dim3(grid_blocks), dim3(NTHREADS), args, LDS_BYTES, stream);
    if (e != hipSuccess) fprintf(stderr, "cooperative launch failed: %s (grid %d)\n", hipGetErrorString(e), grid_blocks);
}
```

```cpp
#include <hip/hip_runtime.h>
#include <hip/hip_cooperative_groups.h>
#include <cstdio>
#include <cstdint>
namespace cg = cooperative_groups;

#define LAS __attribute__((address_space(3)))
typedef unsigned short bf16_t;
typedef short bf16x8 __attribute__((ext_vector_type(8)));
typedef short s16x4 __attribute__((ext_vector_type(4)));
typedef float f32x4 __attribute__((ext_vector_type(4)));
typedef float f32x2 __attribute__((ext_vector_type(2)));
typedef float f32x16 __attribute__((ext_vector_type(16)));
typedef unsigned u32x4 __attribute__((ext_vector_type(4)));
typedef unsigned u32x2 __attribute__((ext_vector_type(2)));

constexpr int DM = 1024, NBATCH = 8, SEQ = 4096, CTXL = 256;
constexpr int RL = NBATCH * SEQ, RC = NBATCH * CTXL, RT = RL + RC;
constexpr int RWC = 1920, REC = 1536, MLC = 672, MIXC = 4128, MIXP = 4352, GATEC = 3072, NIN = 7200;
constexpr int DFF = 2816, NEXP = 8, DFE = 1408;
constexpr int RG = 2 * RL + NEXP * 256;
constexpr int NTHREADS = 512;
constexpr int LDS_BYTES = 147456;

constexpr size_t MiB = 1u << 20;
constexpr size_t WS_CTL = 0;
constexpr size_t WS_MOD = 1 * MiB;
constexpr size_t WS_ROPE_R = 3 * MiB / 2;
constexpr size_t WS_ROPE_M = 5 * MiB / 2;
constexpr size_t WS_RSTD = 3 * MiB;
constexpr size_t WS_BSC = 7 * MiB / 2;
constexpr size_t WS_ROUTE = 6 * MiB;
constexpr size_t WS_WG2 = 7 * MiB;
constexpr size_t WS_W2T = 15 * MiB / 2;
constexpr size_t WS_HC = 8 * MiB;
constexpr size_t WS_W = 16 * MiB;
constexpr size_t WL_WINLO = 0, WL_WINHI = 4456448, WL_WGLO = 8912896, WL_WGHI = 12058624, WL_WQ = 15204352, WL_WKV = 15794176, WL_WB = 16318464, WL_WO = 19464192, WL_STRIDE = 21 * MiB;
constexpr size_t WS_DYN = 58 * MiB;
constexpr size_t Y34 = 34 * MiB;
constexpr size_t D_URWKV = WS_DYN, D_URET = WS_DYN + 255 * MiB / 2, D_UMLA = D_URET + 102 * MiB, D_XN1 = D_UMLA + 357 * MiB / 8, D_OF = D_XN1 + 2 * Y34, D_OB = D_OF + Y34, D_END1 = D_OB + Y34;
constexpr size_t D_YRWKV = D_OF, D_YRET = D_OB;
constexpr size_t D_K = WS_DYN, D_V = D_K + 289 * MiB / 8, D_Q = D_V + Y34;
constexpr size_t D_YMLA = D_UMLA;
constexpr int HROWS = 4 * SEQ + 4 * CTXL;
constexpr size_t HA_K = 0, HA_V = HA_K + (size_t)HROWS * 544 * 2, HA_Q = HA_V + (size_t)HROWS * 512 * 2;
static_assert(HA_Q + (size_t)HROWS * 768 * 2 <= 2 * Y34, "half-A K/V/Q fit the xn region / d_out");

constexpr size_t D_SCR = WS_DYN + 68 * MiB;
constexpr size_t D_P12 = WS_DYN + 100 * MiB;
constexpr size_t D_M = WS_DYN;
constexpr size_t D_FFW = WS_DYN;
constexpr size_t D_XN2 = WS_DYN + 17 * MiB;
constexpr size_t D_H = D_URET;
constexpr size_t D_PART = WS_DYN + 17 * MiB;
constexpr size_t D_XG = WS_DYN;
constexpr size_t D_HM = WS_DYN + 132 * MiB;
constexpr size_t D_MOEW = D_HM + 363 * MiB / 2;
constexpr size_t WS_NEED = 512 * MiB;
static_assert(D_END1 <= WS_NEED && D_MOEW + 66 * MiB <= WS_NEED && D_H + 187 * MiB <= WS_NEED && D_Q + 51 * MiB <= D_URET, "ws map");

struct Params { const float* in[37]; float* out; unsigned char* ws; };
enum { I_X = 0, I_C, I_CTX, I_CCTX, I_NMIX, I_NFFN, I_WMOD, I_BMOD, I_WIN, I_MU, I_W0, I_W2, I_A0, I_A2, I_G2, I_KK, I_KA, I_RK, I_LNG, I_LNB,
       I_RDEC, I_RLNG, I_RLNB, I_QN, I_QUP, I_KVN, I_KVUP, I_WBR, I_WOUT, I_FG, I_FU, I_FD, I_ROUTER, I_MG, I_MU2, I_MD, I_FNORM };

__device__ __forceinline__ unsigned f2bf(float f) { unsigned u = __builtin_bit_cast(unsigned, f); return (u + 0x7fffu + ((u >> 16) & 1u)) >> 16; }
typedef __bf16 bf16x2_t __attribute__((ext_vector_type(2)));
__device__ __forceinline__ unsigned pk2(float lo, float hi) { const f32x2 v = {lo, hi}; return __builtin_bit_cast(unsigned, __builtin_convertvector(v, bf16x2_t)); }
__device__ __forceinline__ float bf2f(unsigned short b) { return __builtin_bit_cast(float, (unsigned)b << 16); }
__device__ __forceinline__ float bflo(unsigned w) { return __builtin_bit_cast(float, w << 16); }
__device__ __forceinline__ float bfhi(unsigned w) { return __builtin_bit_cast(float, w & 0xffff0000u); }
__device__ __forceinline__ float shx(float v, int m, int lane) { return __int_as_float(__builtin_amdgcn_ds_bpermute((lane ^ m) << 2, __float_as_int(v))); }
__device__ __forceinline__ float wave_sum(float v, int lane) {
#pragma unroll
    for (int o = 1; o < 64; o <<= 1) v += shx(v, o, lane);
    return v;
}
__device__ __forceinline__ float sigmoidf_(float x) { return __builtin_amdgcn_rcpf(1.0f + __builtin_amdgcn_exp2f(-1.4426950408889634f * x)); }
__device__ __forceinline__ float siluf_(float x) { return x * __builtin_amdgcn_rcpf(1.0f + __builtin_amdgcn_exp2f(-1.4426950408889634f * x)); }
__device__ __forceinline__ void unpack8(u32x4 w, float* f) { f[0] = bflo(w.x); f[1] = bfhi(w.x); f[2] = bflo(w.y); f[3] = bfhi(w.y); f[4] = bflo(w.z); f[5] = bfhi(w.z); f[6] = bflo(w.w); f[7] = bfhi(w.w); }
__device__ __forceinline__ u32x4 pack8(const float* f) { u32x4 w; w.x = pk2(f[0], f[1]); w.y = pk2(f[2], f[3]); w.z = pk2(f[4], f[5]); w.w = pk2(f[6], f[7]); return w; }

namespace pg8 {
constexpr int BM = 256, BK = 64, HALF = 128, HTB = HALF * BK * 2, STAGE_BYTES = 8 * HTB, NXCD = 8, WGM = 4;
__host__ __device__ __forceinline__ int lds_byte(int r, int c) { const int st = (r >> 4) * 2 + (c >> 5), rr = r & 15, cc = c & 31, ob = rr * 64 + cc * 2; return st * 1024 + (ob ^ (((ob >> 9) & 1) << 5)); }
__host__ __device__ __forceinline__ void stage_rc(int b, int& R, int& C) { const int st = b / 1024, sb = b % 1024, swz = sb ^ (((sb >> 9) & 1) << 5); R = (st >> 1) * 16 + swz / 64; C = (st & 1) * 32 + (swz % 64) / 2; }
__host__ __device__ __forceinline__ int perm32(int rho) { const int n = rho >> 4, i = rho & 15; return 8 * (i >> 2) + 4 * n + (i & 3); }

struct Seg { const char* A; const char* B; int nt; int pm, pn, aux; bool first, last; };

__device__ __forceinline__ void tile_order(int L, int nM, int nN, int& pm, int& pn) {
    const int nwg = nM * nN; int wgid = L;
    { const int q = nwg / NXCD, r = nwg % NXCD, xcd = wgid % NXCD, off = wgid / NXCD; wgid = (xcd < r ? xcd * (q + 1) : r * (q + 1) + (xcd - r) * q) + off; }
    const int nig = WGM * nN, gid = wgid / nig, fm = gid * WGM, gsz = (nM - fm) < WGM ? (nM - fm) : WGM;
    pm = fm + ((wgid % nig) % gsz); pn = (wgid % nig) / gsz;
}

template <int LDA, int LDB, bool PERM, class Sched, class Epi>
__device__ __forceinline__ void gemm_phase(LAS unsigned char* lds, const Sched& S, const Epi& E) {
    int tid_ = threadIdx.x; asm volatile("" : "+v"(tid_));
    const int tid = tid_, wid = __builtin_amdgcn_readfirstlane(tid >> 6), lane = tid & 63, wr = wid >> 2, wc = wid & 3, fr = lane & 15, fq = lane >> 4;
    unsigned voffA[2], voffB[2];
#pragma unroll
    for (int i = 0; i < 2; ++i) { int R, C; stage_rc(tid * 16 + i * 8192, R, C); const int Rb = PERM ? ((R & ~31) + perm32(R & 31)) : R;
        voffA[i] = (unsigned)(R * LDA + C) * 2u; voffB[i] = (unsigned)(Rb * LDB + C) * 2u; }
    constexpr size_t kstep = (size_t)(BK * 2);
    constexpr size_t hstepA = (size_t)HALF * LDA * 2, hstepB = (size_t)HALF * LDB * 2;
    const unsigned ldsw = (unsigned)wid * 1024u;
    const int aoff = lds_byte(wr * 64 + fr, fq * 8), boff = lds_byte(wc * 32 + fr, fq * 8);
#define PG8_SA(b, h) (((b) * 2 + (h)) * HTB)
#define PG8_SB(b, h) ((4 + (b) * 2 + (h)) * HTB)
#define PG8_STAGE(bufoff, gbase, voff) do { _Pragma("unroll") for (int _i = 0; _i < 2; ++_i) \
        __builtin_amdgcn_global_load_lds((const unsigned*)((const char*)(gbase) + (voff)[_i]), (LAS unsigned*)(lds + (bufoff) + ldsw + _i * 8192), 16, 0, 0); } while (0)
#define PG8_LDA(dst, b, h) do { _Pragma("unroll") for (int m = 0; m < 4; ++m) _Pragma("unroll") for (int k = 0; k < 2; ++k) dst[m][k] = *(const LAS bf16x8*)(lds + PG8_SA(b, h) + aoff + m * 2048 + k * 1024); } while (0)
#define PG8_LDB(dst, b, h) do { _Pragma("unroll") for (int n = 0; n < 2; ++n) _Pragma("unroll") for (int k = 0; k < 2; ++k) dst[n][k] = *(const LAS bf16x8*)(lds + PG8_SB(b, h) + boff + n * 2048 + k * 1024); } while (0)
#define PG8_MMA(ai, bj, At, Bt) do { __builtin_amdgcn_s_setprio(1); _Pragma("unroll") for (int m = 0; m < 4; ++m) _Pragma("unroll") for (int n = 0; n < 2; ++n) _Pragma("unroll") for (int k = 0; k < 2; ++k) \
        acc[ai][bj][m][n] = __builtin_amdgcn_mfma_f32_16x16x32_bf16(Bt[n][k], At[m][k], acc[ai][bj][m][n], 0, 0, 0); __builtin_amdgcn_s_setprio(0); } while (0)
#define PG8_WAIT_V(n) asm volatile("s_waitcnt vmcnt(" #n ")" ::: "memory")
#define PG8_WAIT_L(n) asm volatile("s_waitcnt lgkmcnt(" #n ")" ::: "memory")
#define PG8_BAR __builtin_amdgcn_s_barrier()
#define PG8_SCHED __builtin_amdgcn_sched_barrier(0)
    Seg cur, nxt; int ui = 0;
    if (!S.next(0, cur)) return;
    f32x4 acc[2][2][4][2];
#pragma unroll
    for (int a = 0; a < 2; ++a)
#pragma unroll
        for (int b = 0; b < 2; ++b)
#pragma unroll
            for (int m = 0; m < 4; ++m)
#pragma unroll
                for (int n = 0; n < 2; ++n) acc[a][b][m][n] = (f32x4){0.f, 0.f, 0.f, 0.f};
    bf16x8 At[4][2], B0[2][2], B1[2][2];
    const char* cA = cur.A; const char* cB = cur.B;
    PG8_STAGE(PG8_SB(0, 0), cB, voffB); PG8_STAGE(PG8_SB(0, 1), cB + hstepB, voffB); PG8_STAGE(PG8_SA(0, 0), cA, voffA); PG8_STAGE(PG8_SA(0, 1), cA + hstepA, voffA);
    if (wr == 1) PG8_BAR;
    PG8_WAIT_V(2); PG8_BAR;
    PG8_STAGE(PG8_SB(1, 0), cB + kstep, voffB); PG8_STAGE(PG8_SA(1, 0), cA + kstep, voffA); PG8_STAGE(PG8_SB(1, 1), cB + hstepB + kstep, voffB);
    PG8_WAIT_V(6); PG8_BAR;
    for (;;) {
        const bool has_next = S.next(ui + 1, nxt);
        const char* nA = has_next ? nxt.A : cA; const char* nB = has_next ? nxt.B : cB;
        const int nt = cur.nt;
        for (int t = 0; t < nt; t += 2) {
            const bool last = (t == nt - 2);
            const char* a1 = cA + (size_t)(t + 1) * kstep;
            const char* a2 = last ? nA : cA + (size_t)(t + 2) * kstep; const char* b2 = last ? nB : cB + (size_t)(t + 2) * kstep;
            const char* a3 = a2 + kstep; const char* b3 = b2 + kstep;
            PG8_LDB(B0, 0, 0); PG8_LDB(B1, 0, 1); PG8_SCHED; PG8_LDA(At, 0, 0); PG8_STAGE(PG8_SA(1, 1), a1 + hstepA, voffA);
            PG8_WAIT_V(8); PG8_WAIT_L(0); PG8_BAR; PG8_MMA(0, 0, At, B0); PG8_MMA(0, 1, At, B1); PG8_BAR; PG8_SCHED;
            PG8_LDA(At, 0, 1); PG8_STAGE(PG8_SB(0, 0), b2, voffB); PG8_STAGE(PG8_SB(0, 1), b2 + hstepB, voffB); PG8_STAGE(PG8_SA(0, 0), a2, voffA);
            PG8_WAIT_V(8); PG8_WAIT_L(0); PG8_BAR; PG8_MMA(1, 0, At, B0); PG8_MMA(1, 1, At, B1); PG8_BAR; PG8_SCHED;
            PG8_LDB(B0, 1, 0); PG8_LDB(B1, 1, 1); PG8_SCHED; PG8_LDA(At, 1, 0); PG8_STAGE(PG8_SA(0, 1), a2 + hstepA, voffA);
            PG8_WAIT_V(8); PG8_WAIT_L(0); PG8_BAR; PG8_MMA(0, 0, At, B0); PG8_MMA(0, 1, At, B1); PG8_BAR; PG8_SCHED;
            PG8_LDA(At, 1, 1); PG8_STAGE(PG8_SB(1, 0), b3, voffB); PG8_STAGE(PG8_SB(1, 1), b3 + hstepB, voffB); PG8_STAGE(PG8_SA(1, 0), a3, voffA);
            PG8_WAIT_V(8); PG8_WAIT_L(0); PG8_BAR; PG8_MMA(1, 0, At, B0); PG8_MMA(1, 1, At, B1); PG8_BAR; PG8_SCHED;
        }
        const bool was_last = cur.last;
        if (was_last) { if (wr == 0) PG8_BAR; E(acc, cur, wr, wc, fr, fq); }
        if (!has_next) break;
        if (nxt.first) {
#pragma unroll
            for (int a = 0; a < 2; ++a)
#pragma unroll
                for (int b = 0; b < 2; ++b)
#pragma unroll
                    for (int m = 0; m < 4; ++m)
#pragma unroll
                        for (int n = 0; n < 2; ++n) acc[a][b][m][n] = (f32x4){0.f, 0.f, 0.f, 0.f};
        }
        cur = nxt; cA = nA; cB = nB; ++ui;
        if (was_last) { if (wr == 1) PG8_BAR; }
    }
    PG8_WAIT_V(0);
    PG8_BAR;
#undef PG8_SA
#undef PG8_SB
#undef PG8_STAGE
#undef PG8_LDA
#undef PG8_LDB
#undef PG8_MMA
#undef PG8_WAIT_V
#undef PG8_WAIT_L
#undef PG8_BAR
#undef PG8_SCHED
}
}
using pg8::Seg;

struct Ctx {
    LAS unsigned char* lds; int tid, lane, wave, G, bid;
};
typedef const __attribute__((address_space(4))) Params* PP;
__device__ __forceinline__ PP getpp() { PP p = (PP)__builtin_amdgcn_kernarg_segment_ptr(); asm volatile("" : "+s"(p)); return p; }
__device__ __forceinline__ unsigned char* half_a_base(int layer) { PP p = getpp(); return layer == 0 ? (unsigned char*)p->out : p->ws + D_XN1; }
#define GW(F) ((F).bid * 8 + (F).wave)
#define NGW(F) ((F).G * 8)
#define LDS_WAIT() asm volatile("s_waitcnt lgkmcnt(0)" ::: "memory")

struct TrJob {
    const float* s0; const float* s1; int spitch; int K; int nd; int mode; int c0; int nvalid; const float* ks;
    bf16_t* dlo; bf16_t* dhi; int dpitch; int ksplit;
};
__device__ __forceinline__ void tr_item(const TrJob& J, LAS float* scr, int item, int lane) {
    const int nblk = J.nd / 32, kb = item / nblk, nb = item % nblk, k0 = 64 * kb, n0 = 32 * nb;
    const int np = n0 + (lane & 31);
    const float* src = J.s0; int col = 0; bool valid = true;
    if (J.mode == 0) { col = J.c0 + np; valid = np < J.nvalid; }
    else if (J.mode == 1) { if (np < 512) col = (np >> 6) * 128 + (np & 63); else col = ((np - 512) >> 6) * 128 + 64 + (np & 63); }
    else { const int tile = np >> 8, w = np & 255; if (w < 128) col = tile * 128 + w; else { col = tile * 128 + (w - 128); src = J.s1; } }
    if (!valid) col = J.c0;
    const float* sp = src + (size_t)(k0 + (lane >> 5)) * J.spitch + col;
    float v[32];
#pragma unroll
    for (int i = 0; i < 32; ++i) v[i] = __builtin_nontemporal_load(sp + (size_t)(2 * i) * J.spitch);
    if (J.ks) {
#pragma unroll
        for (int i = 0; i < 32; ++i) v[i] *= J.ks[k0 + 2 * i + (lane >> 5)]; }
#pragma unroll
    for (int i = 0; i < 32; ++i) scr[(2 * i + (lane >> 5)) * 33 + (lane & 31)] = valid ? v[i] : 0.f;
    LDS_WAIT(); asm volatile("" ::: "memory");
    const int c = lane & 7;
    bf16_t* dst = (k0 < J.ksplit) ? J.dlo : J.dhi; const int kd = (k0 < J.ksplit) ? k0 : k0 - J.ksplit;
#pragma unroll
    for (int j = 0; j < 4; ++j) { const int n = (lane >> 3) + 8 * j; const LAS float* s = scr + (8 * c) * 33 + n;
        u32x4 o; o.x = pk2(s[0 * 33], s[1 * 33]); o.y = pk2(s[2 * 33], s[3 * 33]); o.z = pk2(s[4 * 33], s[5 * 33]); o.w = pk2(s[6 * 33], s[7 * 33]);
        *(u32x4*)(dst + (size_t)(n0 + n) * J.dpitch + kd + 8 * c) = o; }
    LDS_WAIT(); asm volatile("" ::: "memory");
}
__device__ __forceinline__ void tr_job(const Ctx& F, const TrJob& J, int& rot) {
    LAS float* scr = (LAS float*)(F.lds + F.wave * 8704);
    const int nitems = (J.K / 64) * (J.nd / 32); const int ngw = NGW(F);
    int first = (GW(F) - rot % ngw); if (first < 0) first += ngw;
    for (int it = first; it < nitems; it += ngw) tr_item(J, scr, it, F.lane);
    rot += nitems;
}
__device__ __forceinline__ TrJob mk_job(const float* s0, int spitch, int K, int nd, int c0, int nvalid, bf16_t* dst, int dpitch) {
    TrJob J; J.s0 = s0; J.s1 = nullptr; J.spitch = spitch; J.K = K; J.nd = nd; J.mode = 0; J.c0 = c0; J.nvalid = nvalid; J.ks = nullptr; J.dlo = dst; J.dhi = dst; J.dpitch = dpitch; J.ksplit = 1 << 30; return J;
}

__device__ __forceinline__ void phase0(const Ctx& F) {
    PP P = getpp(); unsigned char* ws = P->ws;
    {
        float* cr = (float*)(ws + WS_ROPE_R); float* sr = cr + 4096 * 32; float* cm = (float*)(ws + WS_ROPE_M); float* sm = cm + 4096 * 16;
        for (int i = F.bid * NTHREADS + F.tid; i < 4096 * 48; i += F.G * NTHREADS) {
            const int t = i / 48, j = i % 48; const float row = (float)(t >> 6), colp = (float)(t & 63);
            if (j < 32) { const int f = j & 15; const float inv = powf(10000.0f, -(float)f / 16.0f); const float ang = (j < 16 ? row : colp) * inv; cr[t * 32 + j] = cosf(ang); sr[t * 32 + j] = sinf(ang); }
            else { const int jj = j - 32, f = jj & 7; const float inv = powf(10000.0f, -(float)f / 8.0f); const float ang = (jj < 8 ? row : colp) * inv; cm[t * 16 + jj] = cosf(ang); sm[t * 16 + jj] = sinf(ang); }
        }
        if (F.bid == 0 && F.tid < 64) ((unsigned*)(ws + WS_CTL))[F.tid] = 0u;
    }
    {
        LAS float* sc = (LAS float*)(F.lds + 70000);
        LAS float* red = (LAS float*)(F.lds + 70000 + 36864);
        for (int i = F.tid; i < 9 * 1024; i += NTHREADS) { const int v = i >> 10, k = i & 1023; const float x = v < 8 ? P->in[I_C][v * 1024 + k] : P->in[I_CCTX][k]; sc[i] = siluf_(x); }
        __syncthreads();
        for (int it = F.bid; it < 2 * 96; it += F.G) {
            const int l = it / 96, jc = F.tid & 63, j = (it % 96) * 64 + jc, ksl = F.tid >> 6;
            const float* w = P->in[I_WMOD] + (size_t)l * 1024 * 6144 + j + (size_t)(ksl * 128) * 6144;
            float a[9];
#pragma unroll
            for (int v = 0; v < 9; ++v) a[v] = 0.f;
#pragma unroll 1
            for (int k0 = 0; k0 < 128; k0 += 16) { float wv[16];
#pragma unroll
                for (int q = 0; q < 16; ++q) wv[q] = w[(size_t)(k0 + q) * 6144];
#pragma unroll
                for (int q = 0; q < 16; ++q)
#pragma unroll
                    for (int v = 0; v < 9; ++v) a[v] += sc[v * 1024 + ksl * 128 + k0 + q] * wv[q]; }
#pragma unroll
            for (int v = 0; v < 9; ++v) red[(ksl * 64 + jc) * 9 + v] = a[v];
            __syncthreads();
            if (F.tid < 64) {
                float* mo = (float*)(ws + WS_MOD) + (size_t)l * 9 * 6144;
#pragma unroll
                for (int v = 0; v < 9; ++v) { float s = 0.f;
#pragma unroll
                    for (int q = 0; q < 8; ++q) s += red[(q * 64 + F.tid) * 9 + v];
                    mo[v * 6144 + j] = s + P->in[I_BMOD][l * 6144 + j]; }
            }
            __syncthreads();
        }
    }
    int rot = (192 * 8) % NGW(F);
    for (int l = 0; l < 2; ++l) {
        unsigned char* wb = ws + WS_W + (size_t)l * WL_STRIDE;
        const float* win = P->in[I_WIN] + (size_t)l * 1024 * NIN;
        { TrJob J = mk_job(win, NIN, 1024, MIXP, 0, MIXC, (bf16_t*)(wb + WL_WINLO), 512); J.dhi = (bf16_t*)(wb + WL_WINHI); J.ksplit = 512; tr_job(F, J, rot); }
        { TrJob J = mk_job(win, NIN, 1024, GATEC, MIXC, GATEC, (bf16_t*)(wb + WL_WGLO), 512); J.dhi = (bf16_t*)(wb + WL_WGHI); J.ksplit = 512; tr_job(F, J, rot); }
        { TrJob J = mk_job(P->in[I_QUP] + (size_t)l * 384 * 768, 768, 384, 768, 0, 768, (bf16_t*)(wb + WL_WQ), 384); J.ks = P->in[I_QN] + l * 384; tr_job(F, J, rot); }
        { TrJob J = mk_job(P->in[I_KVUP] + (size_t)l * 256 * 1024, 1024, 256, 1024, 0, 1024, (bf16_t*)(wb + WL_WKV), 256); J.mode = 1; J.ks = P->in[I_KVN] + l * 256; tr_job(F, J, rot); }
        for (int n = 0; n < 3; ++n) { TrJob J = mk_job(P->in[I_WBR] + ((size_t)l * 3 + n) * 512 * 1024, 1024, 512, 1024, 0, 1024, (bf16_t*)(wb + WL_WB) + (size_t)n * 1024 * 512, 512); tr_job(F, J, rot); }
        { TrJob J = mk_job(P->in[I_WOUT] + (size_t)l * 1024 * 1024, 1024, 1024, 1024, 0, 1024, (bf16_t*)(wb + WL_WO), 1024); tr_job(F, J, rot); }
        { TrJob J = mk_job(P->in[I_G2] + (size_t)l * 128 * 512, 512, 128, 512, 0, 512, (bf16_t*)(ws + WS_WG2) + (size_t)l * 512 * 128, 128); tr_job(F, J, rot); }
        for (int dd = 0; dd < 2; ++dd) {
            { TrJob J = mk_job(P->in[I_W2] + (size_t)(l * 2 + dd) * 64 * 512, 512, 64, 512, 0, 512, (bf16_t*)(ws + WS_W2T) + (size_t)((l * 2 + dd) * 2 + 0) * 512 * 64, 64); tr_job(F, J, rot); }
            { TrJob J = mk_job(P->in[I_A2] + (size_t)(l * 2 + dd) * 64 * 512, 512, 64, 512, 0, 512, (bf16_t*)(ws + WS_W2T) + (size_t)((l * 2 + dd) * 2 + 1) * 512 * 64, 64); tr_job(F, J, rot); }
        }
    }
}
__device__ __forceinline__ void convert_ffn0(const Ctx& F) {
    PP P = getpp(); unsigned char* ws = P->ws;
    bf16_t* glo = (bf16_t*)(ws + D_FFW); bf16_t* ghi = glo + (size_t)5632 * 512; bf16_t* wd = ghi + (size_t)5632 * 512;
    int rot = 0;
    { TrJob J = mk_job(P->in[I_FG], DFF, 1024, 5632, 0, 5632, glo, 512); J.s1 = P->in[I_FU]; J.mode = 2; J.dhi = ghi; J.ksplit = 512; tr_job(F, J, rot); }
    { TrJob J = mk_job(P->in[I_FD], 1024, DFF, 1024, 0, 1024, wd, DFF); tr_job(F, J, rot); }
}
__device__ __forceinline__ void convert_moe(const Ctx& F) {
    PP P = getpp(); unsigned char* ws = P->ws;
    int rot = 0;
    for (int e = 0; e < NEXP; ++e) {
        bf16_t* glo = (bf16_t*)(ws + D_MOEW + (size_t)e * (33 * MiB / 4)); bf16_t* ghi = glo + (size_t)2816 * 512; bf16_t* wd = ghi + (size_t)2816 * 512;
        { TrJob J = mk_job(P->in[I_MG] + (size_t)e * 1024 * DFE, DFE, 1024, 2816, 0, 2816, glo, 512); J.s1 = P->in[I_MU2] + (size_t)e * 1024 * DFE; J.mode = 2; J.dhi = ghi; J.ksplit = 512; tr_job(F, J, rot); }
        { TrJob J = mk_job(P->in[I_MD] + (size_t)e * DFE * 1024, 1024, DFE, 1024, 0, 1024, wd, DFE); tr_job(F, J, rot); }
    }
}

__device__ __forceinline__ void norm_pass(const Ctx& F, int layer, int which, const float* hl, const float* hcx, int nrows, bf16_t* xlo, bf16_t* xhi, bool ctxpart = false) {
    PP P = getpp();
    const float* gain = P->in[which ? I_NFFN : I_NMIX] + layer * 1024;
    const float* mod = (const float*)(P->ws + WS_MOD) + (size_t)layer * 9 * 6144 + (which ? 3072 : 0);
    const float* part = (const float*)(P->ws + D_PART); const float* g2c = (const float*)(P->ws + WS_MOD) + 8 * 6144 + 5120;
    const int rpw = (nrows + NGW(F) - 1) / NGW(F); const int r0 = GW(F) * rpw; const int r1 = (r0 + rpw < nrows) ? r0 + rpw : nrows;
    const bool dealt = ctxpart && NGW(F) == 2048 && nrows == RT;
    int vprev = -1; f32x4 gs[4], sh4[4];
    constexpr int NB = 4;
    for (int rb = r0; rb < r1; rb += NB) {
        f32x4 x[NB][4]; float ss[NB]; int rows[NB];
#pragma unroll
        for (int b = 0; b < NB; ++b) { const int v = (rb + b < r1) ? rb + b : r1 - 1; rows[b] = dealt ? ((v % 17) < 16 ? (v / 17) * 16 + (v % 17) : RL + v / 17) : v; }
#pragma unroll
        for (int b = 0; b < NB; ++b) { const int row = rows[b];
            const float* src = row < RL ? hl + (size_t)row * 1024 : hcx + (size_t)(row - RL) * 1024; ss[b] = 0.f;
#pragma unroll
            for (int j = 0; j < 4; ++j) x[b][j] = *(const f32x4*)(src + 4 * F.lane + 256 * j);
            if (ctxpart && row >= RL) {
#pragma unroll
                for (int j = 0; j < 4; ++j) { const int c = 4 * F.lane + 256 * j; const float* pp = part + (size_t)(row - RL) * 1024 + c;
                    const f32x4 s4 = ((*(const f32x4*)pp + *(const f32x4*)(pp + (size_t)RC * 1024)) + *(const f32x4*)(pp + (size_t)2 * RC * 1024)) + *(const f32x4*)(pp + (size_t)3 * RC * 1024);
                    x[b][j] = x[b][j] + *(const f32x4*)(g2c + c) * s4; } }
#pragma unroll
            for (int j = 0; j < 4; ++j) ss[b] += x[b][j].x * x[b][j].x + x[b][j].y * x[b][j].y + x[b][j].z * x[b][j].z + x[b][j].w * x[b][j].w; }
#pragma unroll
        for (int b = 0; b < NB; ++b) ss[b] = wave_sum(ss[b], F.lane);
#pragma unroll
        for (int b = 0; b < NB; ++b) { const int row = rows[b];
            const int v = row < RL ? (row >> 12) : 8;
            if (v != vprev) { const float* sh = mod + v * 6144; const float* sc = sh + 1024;
#pragma unroll
                for (int j = 0; j < 4; ++j) { const int c = 4 * F.lane + 256 * j; gs[j] = *(const f32x4*)(gain + c) * (*(const f32x4*)(sc + c) + 1.0f); sh4[j] = *(const f32x4*)(sh + c); }
                vprev = v; }
            const float rstd = rsqrtf(ss[b] * (1.0f / 1024.0f) + 1e-6f);
#pragma unroll
            for (int j = 0; j < 4; ++j) { const int c = 4 * F.lane + 256 * j;
                const f32x4 y = x[b][j] * rstd * gs[j] + sh4[j];
                u32x2 o; o.x = pk2(y.x, y.y); o.y = pk2(y.z, y.w);
                bf16_t* d = (c < 512) ? xlo + (size_t)row * 512 + c : xhi + (size_t)row * 512 + (c - 512);
                *(u32x2*)d = o; } }
    }
}

struct SchedSplit2 {
    const char *Alo, *Ahi, *Blo, *Bhi; int nM, nN, G, c; bool skipc;
    __device__ __forceinline__ bool next(int i, Seg& s) const {
        const int iu = i >> 1, h = i & 1; const long L = (long)iu * G + c;
        const int nlat = skipc ? (nM - 8) * nN : nM * nN, ntot = skipc ? nlat + 8 * (nN - 1) : nlat;
        if (L >= (long)ntot) return false;
        int pm, pn;
        if (L < nlat) pg8::tile_order((int)L, skipc ? nM - 8 : nM, nN, pm, pn); else { pg8::tile_order((int)L - nlat, 8, nN - 1, pm, pn); pm += nM - 8; }
        s.A = (h ? Ahi : Alo) + (size_t)pm * 256 * 1024; s.B = (h ? Bhi : Blo) + (size_t)pn * 256 * 1024; s.nt = 8; s.pm = pm; s.pn = pn; s.aux = 0; s.first = (h == 0); s.last = (h == 1); return true;
    }
};
struct Sched1 {
    const char *A, *B; size_t astride, bstride; int nt, nM, nN, G, c;
    __device__ __forceinline__ bool next(int i, Seg& s) const {
        const long L = (long)i * G + c; if (L >= (long)nM * nN) return false;
        int pm, pn; pg8::tile_order((int)L, nM, nN, pm, pn);
        s.A = A + (size_t)pm * astride; s.B = B + (size_t)pn * bstride; s.nt = nt; s.pm = pm; s.pn = pn; s.aux = 0; s.first = true; s.last = true; return true;
    }
};
struct SchedDown0 {
    const char *A, *B; int G, c;
    __device__ __forceinline__ bool next(int i, Seg& s) const {
        const long L = (long)i * G + c; s.first = true; s.last = true;
        if (L < 512) { int pm, pn; pg8::tile_order((int)L, RL / 256, 4, pm, pn);
            s.A = A + (size_t)pm * 256 * DFF * 2; s.B = B + (size_t)pn * 256 * DFF * 2; s.nt = 44; s.pm = pm; s.pn = pn; s.aux = 0; return true; }
        const int q = (int)L - 512; if (q >= 128) return false;
        const int tile = q >> 2, sl = q & 3, pmc = tile & 7, pn = tile >> 3; const int k0 = sl < 2 ? 12 * sl : 24 + 10 * (sl - 2);
        s.A = A + (size_t)(RL / 256 + pmc) * 256 * DFF * 2 + (size_t)k0 * 128; s.B = B + (size_t)pn * 256 * DFF * 2 + (size_t)k0 * 128;
        s.nt = sl < 2 ? 12 : 10; s.pm = RL / 256 + pmc; s.pn = pn; s.aux = 1 + sl; return true;
    }
};
struct SchedHalf {
    const char *A, *B; size_t astride, bstride; int nt, nN, half, G, c;
    __device__ __forceinline__ bool next(int i, Seg& s) const {
        const long L = (long)i * G + c; if (L >= (long)68 * nN) return false;
        int mi, pn; pg8::tile_order((int)L, 68, nN, mi, pn);
        const int pm = mi < 64 ? 64 * half + mi : 128 + 4 * half + (mi - 64);
        s.A = A + (size_t)pm * astride; s.B = B + (size_t)pn * bstride; s.nt = nt; s.pm = pm; s.pn = pn; s.aux = 0; s.first = true; s.last = true; return true;
    }
};
struct SchedMerge {
    const char *XNlo, *XNhi, *WgLo, *WgHi, *wsb, *Wb; int nM, G, c; bool ctx3;
    __device__ __forceinline__ void fill(Seg& s, int pm, int pn, int n, int k, int ctxbit) const {
        s.pm = pm; s.pn = pn; s.nt = 8;
        if (k == 0) { s.A = XNlo + (size_t)pm * 256 * 1024; s.B = WgLo + (size_t)(n * 1024 + pn * 256) * 1024; s.first = true; s.last = false; s.aux = n * 2; }
        else if (k == 1) { s.A = XNhi + (size_t)pm * 256 * 1024; s.B = WgHi + (size_t)(n * 1024 + pn * 256) * 1024; s.first = false; s.last = true; s.aux = n * 2; }
        else { const size_t yo = (n == 0) ? D_YRWKV : ((n == 1) ? D_YRET : D_YMLA); s.A = wsb + yo + (size_t)pm * 256 * 1024; s.B = Wb + (size_t)(n * 1024 + pn * 256) * 1024; s.first = true; s.last = true; s.aux = n * 2 + 1 + ctxbit; }
    }
    __device__ __forceinline__ bool next(int i, Seg& s) const {
        const int nMl = ctx3 ? RL / 256 : nM; const int NL = nMl * 4;
        const int kmax = (NL - c + G - 1) / G;
        if (i < 9 * kmax) { const int su = i / 9, r = i % 9; const long L = (long)su * G + c; int pm, pn; pg8::tile_order((int)L, nMl, 4, pm, pn); fill(s, pm, pn, r / 3, r % 3, 0); return true; }
        if (!ctx3) return false;
        const int j = i - 9 * kmax, t = j / 3, k = j % 3; const long idx = (long)t * G + c; if (idx >= 96) return false;
        const int tile = (int)idx / 3, n = (int)idx % 3; fill(s, RL / 256 + (tile & 7), tile >> 3, n, k, 8); return true;
    }
};
struct SchedWout0 {
    const char *A, *B, *wsb; int G, c;
    __device__ __forceinline__ bool next(int i, Seg& s) const {
        if (c < 32) { if (i >= 3) return false; const int pmc = c & 7, pn = c >> 3;
            const size_t ao = (i == 0) ? D_M + (size_t)RL * 1024 * 2 : ((i == 1) ? D_P12 : D_P12 + (size_t)RC * 1024 * 2);
            s.A = wsb + ao + (size_t)pmc * 256 * 1024 * 2; s.B = B + (size_t)pn * 256 * 1024 * 2; s.nt = 16; s.pm = RL / 256 + pmc; s.pn = pn; s.aux = 0; s.first = (i == 0); s.last = (i == 2); return true; }
        const long L = (long)i * (G - 32) + (c - 32); if (L >= (RL / 256) * 4) return false;
        int pm, pn; pg8::tile_order((int)L, RL / 256, 4, pm, pn);
        s.A = A + (size_t)pm * 256 * 1024 * 2; s.B = B + (size_t)pn * 256 * 1024 * 2; s.nt = 16; s.pm = pm; s.pn = pn; s.aux = 0; s.first = true; s.last = true; return true;
    }
};
struct MoeTiles { int tstart[NEXP + 1]; };
__device__ __forceinline__ MoeTiles moe_tiles(const unsigned* cnt) {
    MoeTiles T; int a = 0;
#pragma unroll
    for (int e = 0; e < NEXP; ++e) { T.tstart[e] = a; a += (int)((__builtin_amdgcn_readfirstlane(cnt[e]) + 255u) >> 8); }
    T.tstart[NEXP] = a; return T;
}
__device__ __forceinline__ int moe_expert_of(const MoeTiles& T, int mt) { int e = 0;
#pragma unroll
    for (int k = 1; k < NEXP; ++k) e += (mt >= T.tstart[k]) ? 1 : 0;
    return e; }
struct SchedMoeUp {
    const char *Alo, *Ahi, *W; MoeTiles T; int G, c;
    __device__ __forceinline__ bool next(int i, Seg& s) const {
        const int iu = i >> 1, h = i & 1; const int nM = T.tstart[NEXP]; const long L = (long)iu * G + c; if (L >= (long)nM * 11) return false;
        int pm, pn; pg8::tile_order((int)L, nM, 11, pm, pn);
        const int e = moe_expert_of(T, pm); const char* we = W + (size_t)e * (33 * MiB / 4);
        s.A = (h ? Ahi : Alo) + (size_t)pm * 256 * 1024; s.B = we + (h ? (size_t)2816 * 1024 : 0) + (size_t)pn * 256 * 1024; s.nt = 8; s.pm = pm; s.pn = pn; s.aux = e; s.first = (h == 0); s.last = (h == 1); return true;
    }
};
struct SchedMoeDown {
    const char *A, *W; MoeTiles T; int G, c;
    __device__ __forceinline__ bool next(int i, Seg& s) const {
        const int nM = T.tstart[NEXP]; const long L = (long)i * G + c; if (L >= (long)nM * 4) return false;
        int pm, pn; pg8::tile_order((int)L, nM, 4, pm, pn);
        const int e = moe_expert_of(T, pm); const char* we = W + (size_t)e * (33 * MiB / 4) + (size_t)2 * 2816 * 1024;
        s.A = A + (size_t)pm * 256 * DFE * 2; s.B = we + (size_t)pn * 256 * DFE * 2; s.nt = 22; s.pm = pm; s.pn = pn; s.aux = e; s.first = true; s.last = true; return true;
    }
};

typedef f32x4 Acc[2][2][4][2];
struct EpiInproj {
    unsigned char* ws;
    __device__ __forceinline__ void operator()(const Acc& acc, const Seg& u, int wr, int wc, int fr, int fq) const {
        const int row0 = u.pm * 256 + wr * 64 + fr;
#pragma unroll
        for (int bj = 0; bj < 2; ++bj) {
            const int c0 = u.pn * 256 + bj * 128 + wc * 32 + 8 * fq;
            const bool a = c0 < RWC, b = c0 < RWC + REC;
            const size_t boff = a ? D_URWKV : (b ? D_URET : D_UMLA); const int pitch = a ? RWC : (b ? REC : MLC); const int col = c0 - (a ? 0 : (b ? RWC : RWC + REC));
            bf16_t* base = (bf16_t*)(ws + boff);
            if (c0 < MIXC) {
#pragma unroll
                for (int ai = 0; ai < 2; ++ai)
#pragma unroll
                    for (int m = 0; m < 4; ++m) { const int row = row0 + ai * 128 + m * 16; const f32x4 v0 = acc[ai][bj][m][0], v1 = acc[ai][bj][m][1];
                        u32x4 w; w.x = pk2(v0[0], v0[1]); w.y = pk2(v0[2], v0[3]); w.z = pk2(v1[0], v1[1]); w.w = pk2(v1[2], v1[3]);
                        *(u32x4*)(base + (size_t)row * pitch + col) = w; }
            }
        }
    }
};
struct EpiQup {
    bf16_t* Q; const float* rstd; const float* cosm; const float* sinm; int compact;
    __device__ __forceinline__ void operator()(const Acc& acc, const Seg& u, int wr, int wc, int fr, int fq) const {
        const int row0 = u.pm * 256 + wr * 64 + fr; const bool lat = u.pm * 256 < RL;
        const int cbA = u.pn * 256 + wc * 32; const bool ropeA = lat && ((cbA % 96) == 64), ropeB = lat && (((cbA + 128) % 96) == 64);
        float rsv[8]; f32x4 cs[8], sn[8];
#pragma unroll
        for (int r = 0; r < 8; ++r) rsv[r] = rstd[row0 + (r >> 2) * 128 + (r & 3) * 16];
        if (ropeA || ropeB) {
#pragma unroll
            for (int r = 0; r < 8; ++r) { const int t = (row0 + (r >> 2) * 128 + (r & 3) * 16) & 4095; cs[r] = *(const f32x4*)(cosm + t * 16 + 4 * fq); sn[r] = *(const f32x4*)(sinm + t * 16 + 4 * fq); }
        } else {
#pragma unroll
            for (int r = 0; r < 8; ++r) { cs[r] = (f32x4){1.f, 1.f, 1.f, 1.f}; sn[r] = (f32x4){0.f, 0.f, 0.f, 0.f}; }
        }
        __builtin_amdgcn_sched_barrier(0);
#pragma unroll
        for (int ai = 0; ai < 2; ++ai)
#pragma unroll
            for (int m = 0; m < 4; ++m) { const int row = row0 + ai * 128 + m * 16; const float rs = rsv[ai * 4 + m];
#pragma unroll
                for (int bj = 0; bj < 2; ++bj) { const int cb = cbA + bj * 128; const bool rope = bj ? ropeB : ropeA;
                    f32x4 x1 = acc[ai][bj][m][0] * rs, x2 = acc[ai][bj][m][1] * rs;
                    if (rope) { const f32x4 o1 = x1 * cs[ai * 4 + m] - x2 * sn[ai * 4 + m], o2 = x1 * sn[ai * 4 + m] + x2 * cs[ai * 4 + m]; x1 = o1; x2 = o2; }
                    u32x2 a, b; a.x = pk2(x1[0], x1[1]); a.y = pk2(x1[2], x1[3]); b.x = pk2(x2[0], x2[1]); b.y = pk2(x2[2], x2[3]);
                    const int orow = compact ? (lat ? row : row - RL + 4 * SEQ) : row;
                    bf16_t* d = Q + (size_t)orow * 768 + cb + 4 * fq; *(u32x2*)d = a; *(u32x2*)(d + 16) = b; } }
    }
};
struct EpiKVup {
    bf16_t *Kb, *Vb; const float* rstd; int compact;
    __device__ __forceinline__ void operator()(const Acc& acc, const Seg& u, int wr, int wc, int fr, int fq) const {
        const int row0 = u.pm * 256 + wr * 64 + fr;
        float rsv[8];
#pragma unroll
        for (int r = 0; r < 8; ++r) rsv[r] = rstd[row0 + (r >> 2) * 128 + (r & 3) * 16];
        __builtin_amdgcn_sched_barrier(0);
#pragma unroll
        for (int ai = 0; ai < 2; ++ai)
#pragma unroll
            for (int m = 0; m < 4; ++m) { const int row = row0 + ai * 128 + m * 16; const float rs = rsv[ai * 4 + m];
#pragma unroll
                for (int bj = 0; bj < 2; ++bj) { const int c0 = u.pn * 256 + bj * 128 + wc * 32 + 8 * fq; const f32x4 v0 = acc[ai][bj][m][0] * rs, v1 = acc[ai][bj][m][1] * rs;
                    u32x4 w; w.x = pk2(v0[0], v0[1]); w.y = pk2(v0[2], v0[3]); w.z = pk2(v1[0], v1[1]); w.w = pk2(v1[2], v1[3]);
                    const int orow = compact ? (row < RL ? row : row - RL + 4 * SEQ) : row;
                    bf16_t* d = (u.pn < 2) ? Kb + (size_t)orow * 544 + c0 : Vb + (size_t)orow * 512 + (c0 - 512);
                    *(u32x4*)d = w; } }
    }
};
struct EpiMerge {
    u32x4* scr; bf16_t* M; bf16_t* P12;
    __device__ __forceinline__ void operator()(const Acc& acc, const Seg& u, int wr, int wc, int fr, int fq) const {
        int tid = threadIdx.x; asm volatile("" : "+v"(tid));
        if ((u.aux & 1) == 0) {
#pragma unroll
            for (int ai = 0; ai < 2; ++ai)
#pragma unroll
                for (int bj = 0; bj < 2; ++bj)
#pragma unroll
                    for (int m = 0; m < 4; ++m) { const f32x4 v0 = acc[ai][bj][m][0], v1 = acc[ai][bj][m][1];
                        u32x4 w; w.x = pk2(sigmoidf_(v0[0]), sigmoidf_(v0[1])); w.y = pk2(sigmoidf_(v0[2]), sigmoidf_(v0[3])); w.z = pk2(sigmoidf_(v1[0]), sigmoidf_(v1[1])); w.w = pk2(sigmoidf_(v1[2]), sigmoidf_(v1[3]));
                        scr[((ai * 2 + bj) * 4 + m) * 512 + tid] = w; }
        } else {
            const int n = (u.aux & 7) >> 1; const bool part = (u.aux & 8) != 0; const int row0 = u.pm * 256 + wr * 64 + fr; const bool accum = n > 0 && !part;
            u32x4 gq[2][4], pq[2][4];
#pragma unroll
            for (int k = 0; k < 5; ++k) {
                if (k < 4) { const int ai = k >> 1, bj = k & 1;
#pragma unroll
                    for (int m = 0; m < 4; ++m) { const int row = row0 + ai * 128 + m * 16; const int c0 = u.pn * 256 + bj * 128 + wc * 32 + 8 * fq;
                        gq[k & 1][m] = scr[((ai * 2 + bj) * 4 + m) * 512 + tid];
                        if (accum) pq[k & 1][m] = *(const u32x4*)(M + (size_t)row * 1024 + c0); else pq[k & 1][m] = (u32x4){0u, 0u, 0u, 0u}; } }
                if (k > 0) { const int kk = k - 1, ai = kk >> 1, bj = kk & 1;
#pragma unroll
                    for (int m = 0; m < 4; ++m) { const int row = row0 + ai * 128 + m * 16; const int c0 = u.pn * 256 + bj * 128 + wc * 32 + 8 * fq;
                        float gf[8], pf[8]; unpack8(gq[kk & 1][m], gf); unpack8(pq[kk & 1][m], pf);
                        const f32x4 v0 = acc[ai][bj][m][0], v1 = acc[ai][bj][m][1];
                        bf16_t* d = (part && n > 0) ? P12 + (size_t)(n - 1) * RC * 1024 + (size_t)(row - RL) * 1024 + c0 : M + (size_t)row * 1024 + c0;
#pragma unroll
                        for (int j = 0; j < 4; ++j) { pf[j] += gf[j] * v0[j]; pf[4 + j] += gf[4 + j] * v1[j]; }
                        *(u32x4*)d = pack8(pf); } }
            }
        }
    }
};
struct EpiResid {
    const float *srcl, *srcc; float *dstl, *dstc; const float* mod; int goff; float* part;
    __device__ __forceinline__ void operator()(const Acc& acc, const Seg& u, int wr, int wc, int fr, int fq) const {
        const int row0 = u.pm * 256 + wr * 64 + fr; const bool lat = u.pm * 256 < RL;
        if (u.aux != 0) {
            float* pb = part + (size_t)(u.aux - 1) * RC * 1024;
#pragma unroll
            for (int ai = 0; ai < 2; ++ai)
#pragma unroll
                for (int m = 0; m < 4; ++m) { float* d = pb + (size_t)(row0 + ai * 128 + m * 16 - RL) * 1024;
#pragma unroll
                    for (int bj = 0; bj < 2; ++bj)
#pragma unroll
                        for (int n = 0; n < 2; ++n) *(f32x4*)(d + u.pn * 256 + bj * 128 + wc * 32 + 16 * n + 4 * fq) = acc[ai][bj][m][n]; }
            return; }
        const float* sb = lat ? srcl : srcc; float* db = lat ? dstl : dstc; const size_t rsub = lat ? 0 : (size_t)RL;
        const float* g = mod + (lat ? ((u.pm * 256) >> 12) : 8) * 6144 + goff;
        f32x4 gv[2][2];
#pragma unroll
        for (int bj = 0; bj < 2; ++bj)
#pragma unroll
            for (int n = 0; n < 2; ++n) gv[bj][n] = *(const f32x4*)(g + u.pn * 256 + bj * 128 + wc * 32 + 16 * n + 4 * fq);
        f32x4 sv[2][2][2][2];
#pragma unroll
        for (int k = 0; k < 5; ++k) {
            if (k < 4) {
#pragma unroll
                for (int mm = 0; mm < 2; ++mm) { const int row = row0 + (k >> 1) * 128 + ((k & 1) * 2 + mm) * 16; const float* s = sb + ((size_t)row - rsub) * 1024;
#pragma unroll
                    for (int bj = 0; bj < 2; ++bj)
#pragma unroll
                        for (int n = 0; n < 2; ++n) sv[k & 1][mm][bj][n] = *(const f32x4*)(s + u.pn * 256 + bj * 128 + wc * 32 + 16 * n + 4 * fq); } }
            if (k > 0) { const int kk = k - 1, ai = kk >> 1;
#pragma unroll
                for (int mm = 0; mm < 2; ++mm) { const int m = (kk & 1) * 2 + mm; const int row = row0 + ai * 128 + m * 16; float* d = db + ((size_t)row - rsub) * 1024;
#pragma unroll
                    for (int bj = 0; bj < 2; ++bj)
#pragma unroll
                        for (int n = 0; n < 2; ++n) *(f32x4*)(d + u.pn * 256 + bj * 128 + wc * 32 + 16 * n + 4 * fq) = sv[kk & 1][mm][bj][n] + gv[bj][n] * acc[ai][bj][m][n]; } }
        }
    }
};
struct EpiSwiglu {
    bf16_t* H; int pitch;
    __device__ __forceinline__ void operator()(const Acc& acc, const Seg& u, int wr, int wc, int fr, int fq) const {
        const int row0 = u.pm * 256 + wr * 64 + fr; const int c0 = u.pn * 128 + wc * 32 + 8 * fq;
#pragma unroll
        for (int ai = 0; ai < 2; ++ai)
#pragma unroll
            for (int m = 0; m < 4; ++m) { const int row = row0 + ai * 128 + m * 16; float o[8];
#pragma unroll
                for (int n = 0; n < 2; ++n)
#pragma unroll
                    for (int j = 0; j < 4; ++j) o[4 * n + j] = siluf_(acc[ai][0][m][n][j]) * acc[ai][1][m][n][j];
                *(u32x4*)(H + (size_t)row * pitch + c0) = pack8(o); }
    }
};
struct EpiBf16 {
    bf16_t* O; int pitch;
    __device__ __forceinline__ void operator()(const Acc& acc, const Seg& u, int wr, int wc, int fr, int fq) const {
        const int row0 = u.pm * 256 + wr * 64 + fr;
#pragma unroll
        for (int ai = 0; ai < 2; ++ai)
#pragma unroll
            for (int m = 0; m < 4; ++m) { const int row = row0 + ai * 128 + m * 16;
#pragma unroll
                for (int bj = 0; bj < 2; ++bj) { const int c0 = u.pn * 256 + bj * 128 + wc * 32 + 8 * fq; const f32x4 v0 = acc[ai][bj][m][0], v1 = acc[ai][bj][m][1];
                    u32x4 w; w.x = pk2(v0[0], v0[1]); w.y = pk2(v0[2], v0[3]); w.z = pk2(v1[0], v1[1]); w.w = pk2(v1[2], v1[3]);
                    *(u32x4*)(O + (size_t)row * pitch + c0) = w; } }
    }
};

namespace attn {
constexpr float SCALE = 0.10206207261596577f;
constexpr float THR = 8.f;
constexpr int KP = 208;
constexpr int SHM_V = 8192, SHM_K = 64 * KP;
constexpr int OFF_V = 0, OFF_K = 2 * SHM_V, OFF_WS = OFF_K + 2 * SHM_K, SHM_TOTAL = OFF_WS + 8 * 64 * 4;
#define SBAR() __builtin_amdgcn_sched_barrier(0)
__device__ __forceinline__ int crow(int r, int hi) { return (r & 3) + 8 * (r >> 2) + 4 * hi; }
__device__ __forceinline__ unsigned cvtpk(float lo, float hi) { unsigned r; asm volatile("v_cvt_pk_bf16_f32 %0, %1, %2" : "=v"(r) : "v"(lo), "v"(hi)); return r; }
__device__ __forceinline__ void partialSM(f32x16& p0, f32x16& p1, float& m_reg, float& mn, float& alpha) {
    constexpr float C = SCALE * 1.4426950408889634f;
    float pmax = p0[0];
#pragma unroll
    for (int r = 1; r < 16; ++r) pmax = fmaxf(pmax, p0[r]);
#pragma unroll
    for (int r = 0; r < 16; ++r) pmax = fmaxf(pmax, p1[r]);
    { auto rr = __builtin_amdgcn_permlane32_swap(__float_as_uint(pmax), __float_as_uint(pmax), false, false); pmax = fmaxf(__uint_as_float(rr[0]), __uint_as_float(rr[1])); }
    if (__builtin_expect(__all(pmax - m_reg <= THR / SCALE), 1)) { mn = m_reg; alpha = 1.f; }
    else { mn = fmaxf(m_reg, pmax); alpha = __builtin_amdgcn_exp2f((m_reg - mn) * C); m_reg = mn; }
    const float mnC = -mn * C;
#pragma unroll
    for (int r = 0; r < 16; ++r) p0[r] = fmaf(p0[r], C, mnC);
#pragma unroll
    for (int r = 0; r < 16; ++r) p1[r] = fmaf(p1[r], C, mnC);
#pragma unroll
    for (int r = 0; r < 16; ++r) p0[r] = __builtin_amdgcn_exp2f(p0[r]);
}
__device__ __forceinline__ void finishSM(f32x16& p0, f32x16& p1, float alpha, float& l_reg, bf16x8& pa0, bf16x8& pa1, bf16x8& pa2, bf16x8& pa3) {
#pragma unroll
    for (int r = 0; r < 16; ++r) p1[r] = __builtin_amdgcn_exp2f(p1[r]);
    float ps = 0;
#pragma unroll
    for (int r = 0; r < 16; ++r) ps += p0[r];
#pragma unroll
    for (int r = 0; r < 16; ++r) ps += p1[r];
    { auto rr = __builtin_amdgcn_permlane32_swap(__float_as_uint(ps), __float_as_uint(ps), false, false); ps = __uint_as_float(rr[0]) + __uint_as_float(rr[1]); }
    l_reg = l_reg * alpha + ps;
#define PK4(P, BASE, OUT) do { unsigned a0 = cvtpk(P[BASE + 0], P[BASE + 1]), a1 = cvtpk(P[BASE + 2], P[BASE + 3]);   \
    unsigned b0 = cvtpk(P[BASE + 4], P[BASE + 5]), b1 = cvtpk(P[BASE + 6], P[BASE + 7]);                              \
    auto r0 = __builtin_amdgcn_permlane32_swap(a0, b0, false, false); auto r1 = __builtin_amdgcn_permlane32_swap(a1, b1, false, false); \
    u32x4 w = {r0[0], r1[0], r0[1], r1[1]}; OUT = __builtin_bit_cast(bf16x8, w); } while (0)
    PK4(p0, 0, pa0); PK4(p0, 8, pa1); PK4(p1, 0, pa2); PK4(p1, 8, pa3);
#undef PK4
}
__device__ __forceinline__ void qkt(f32x16& p0, f32x16& p1, const LAS unsigned char* Ks, const bf16x8* qr, int r32, int hi) {
    p0 = f32x16{}; p1 = f32x16{};
#pragma unroll
    for (int d0 = 0; d0 < 6; ++d0) { const int cb = (d0 * 16 + hi * 8) * 2;
        const bf16x8 b0 = *(const LAS bf16x8*)(Ks + r32 * KP + cb);
        const bf16x8 b1 = *(const LAS bf16x8*)(Ks + (32 + r32) * KP + cb);
        p0 = __builtin_amdgcn_mfma_f32_32x32x16_bf16(b0, qr[d0], p0, 0, 0, 0);
        p1 = __builtin_amdgcn_mfma_f32_32x32x16_bf16(b1, qr[d0], p1, 0, 0, 0); }
}
__device__ __forceinline__ int v_st(int k, int c) { const int kk = (k & ~0xC) | ((k & 4) << 1) | ((k & 8) >> 1); return ((kk >> 3) * 2 + (c >> 5)) * 512 + ((kk & 7) * 32 + (c & 31)) * 2; }
__device__ __forceinline__ int v_rd_base(int lane) { return ((lane & 3) << 3) | (((lane >> 2) & 3) << 6) | (((lane >> 4) & 1) << 5) | (((lane >> 5) & 1) << 8); }
constexpr int v_rd_off(int d0, int ks, int half) { return d0 * 512 + ks * 2048 + half * 1024; }
template <int OFF> __device__ __forceinline__ s16x4 tr_read(int vb) { s16x4 r; asm volatile("ds_read_b64_tr_b16 %0, %1 offset:%2" : "=&v"(r) : "v"(vb), "i"(OFF) : "memory"); return r; }
template <int D0> __device__ __forceinline__ void pv_one(f32x16& od, int vb, bf16x8 pa0, bf16x8 pa1, bf16x8 pa2, bf16x8 pa3) {
    const s16x4 l0 = tr_read<v_rd_off(D0, 0, 0)>(vb), h0 = tr_read<v_rd_off(D0, 0, 1)>(vb), l1 = tr_read<v_rd_off(D0, 1, 0)>(vb), h1 = tr_read<v_rd_off(D0, 1, 1)>(vb);
    const s16x4 l2 = tr_read<v_rd_off(D0, 2, 0)>(vb), h2 = tr_read<v_rd_off(D0, 2, 1)>(vb), l3 = tr_read<v_rd_off(D0, 3, 0)>(vb), h3 = tr_read<v_rd_off(D0, 3, 1)>(vb);
    asm volatile("s_waitcnt lgkmcnt(0)" ::: "memory"); SBAR();
#define PK(L, H) (bf16x8){L[0], L[1], L[2], L[3], H[0], H[1], H[2], H[3]}
    od = __builtin_amdgcn_mfma_f32_32x32x16_bf16(pa0, PK(l0, h0), od, 0, 0, 0);
    od = __builtin_amdgcn_mfma_f32_32x32x16_bf16(pa1, PK(l1, h1), od, 0, 0, 0);
    od = __builtin_amdgcn_mfma_f32_32x32x16_bf16(pa2, PK(l2, h2), od, 0, 0, 0);
    od = __builtin_amdgcn_mfma_f32_32x32x16_bf16(pa3, PK(l3, h3), od, 0, 0, 0);
#undef PK
}
__device__ __forceinline__ void pv_d0(f32x16* o, int vb, bf16x8 pa0, bf16x8 pa1, bf16x8 pa2, bf16x8 pa3) { pv_one<0>(o[0], vb, pa0, pa1, pa2, pa3); pv_one<1>(o[1], vb, pa0, pa1, pa2, pa3); }

__device__ __forceinline__ void attn_unit(const bf16_t* __restrict__ Qb, const bf16_t* __restrict__ Kn, const bf16_t* __restrict__ Kr, const bf16_t* __restrict__ Vh,
                                          bf16_t* __restrict__ Ob, long lat0, long ctx0, int nlat, int NT, LAS unsigned char* lds) {
    int tid_ = threadIdx.x; asm volatile("" : "+v"(tid_));
    const int tid = tid_, wid = tid >> 6, lane = tid & 63, r32 = lane & 31, hi = lane >> 5;
    LAS unsigned char* V_lds = lds + OFF_V; LAS unsigned char* K_lds = lds + OFF_K;
    LAS float* ws = (LAS float*)(lds + OFF_WS) + wid * 64; LAS float* li_l = ws; LAS float* al_l = ws + 32;
    float m_reg = -1e30f, l_reg = 0; f32x16 o[2] = {}; bf16x8 qr[6];
    const bf16_t* Qw = Qb + (long)(wid * 32 + r32) * 768 + hi * 8;
#pragma unroll
    for (int d0 = 0; d0 < 6; ++d0) qr[d0] = *(const bf16x8*)(Qw + d0 * 16);
    const int sr = tid >> 3, sc = (tid & 7) * 8, vst = v_st(sr, sc);
    const int kr_ = (tid & 255) >> 2, kc_ = (tid & 3) * 8;
    const int vb0 = (int)(uintptr_t)V_lds + v_rd_base(lane);
    struct { bf16x8 vs, kn, kp; } sr_[2];
#define KROW(j, kk) (((j) < nlat) ? (lat0 + (long)(j) * 64 + (kk)) : (ctx0 + (long)((j) - nlat) * 64 + (kk)))
#define SLOAD(i, j) do { const long r0_ = KROW(j, sr), r1_ = KROW(j, kr_); sr_[i].vs = *(const bf16x8*)(Vh + r0_ * 512 + sc); sr_[i].kn = *(const bf16x8*)(Kn + r0_ * 544 + sc); sr_[i].kp = *(const bf16x8*)(Kr + r1_ * 544 + kc_); } while (0)
#define SWRITE(b, i) do { *(LAS bf16x8*)(V_lds + (b) * SHM_V + vst) = sr_[i].vs; *(LAS bf16x8*)(K_lds + (b) * SHM_K + sr * KP + sc * 2) = sr_[i].kn; \
    *(LAS bf16x8*)(K_lds + (b) * SHM_K + kr_ * KP + 128 + kc_ * 2) = sr_[i].kp; } while (0)
#define SWAIT() asm volatile("s_waitcnt vmcnt(3)" ::: "memory")
#define RESC(a) do { if (__any((a) < 1.f)) { if (hi == 0) al_l[r32] = (a); asm volatile("s_waitcnt lgkmcnt(0)" ::: "memory"); \
    _Pragma("unroll") for (int d = 0; d < 2; ++d) _Pragma("unroll") for (int r = 0; r < 16; ++r) o[d][r] *= al_l[crow(r, hi)]; } } while (0)
    f32x16 pA0, pA1, pB0, pB1; float mnA, mnB, alA, alB; bf16x8 pa0, pa1, pa2, pa3;
    constexpr int SE = 0, SO = 1;
    SLOAD(SE, 0); asm volatile("s_waitcnt vmcnt(0)" ::: "memory"); SWRITE(0, SE); __syncthreads();
    qkt(pA0, pA1, K_lds, qr, r32, hi); partialSM(pA0, pA1, m_reg, mnA, alA);
    SLOAD(SO, 1); if (2 < NT) SLOAD(SE, 2);
    SWAIT(); SWRITE(1, SO); __syncthreads();
    for (int j = 1; j + 1 < NT; j += 2) {
        SBAR(); qkt(pB0, pB1, K_lds + SHM_K, qr, r32, hi);
        finishSM(pA0, pA1, alA, l_reg, pa0, pa1, pa2, pa3); SBAR();
        SLOAD(SO, j + 2); SBAR();
        pv_d0(o, vb0, pa0, pa1, pa2, pa3); partialSM(pB0, pB1, m_reg, mnB, alB);
        __syncthreads(); SWAIT(); SWRITE(0, SE);
        RESC(alB); __syncthreads();
        SBAR(); qkt(pA0, pA1, K_lds, qr, r32, hi);
        finishSM(pB0, pB1, alB, l_reg, pa0, pa1, pa2, pa3); SBAR();
        if (j + 3 < NT) SLOAD(SE, j + 3); SBAR();
        pv_d0(o, vb0 + SHM_V, pa0, pa1, pa2, pa3); partialSM(pA0, pA1, m_reg, mnA, alA);
        __syncthreads(); SWAIT(); SWRITE(1, SO);
        RESC(alA); __syncthreads();
    }
    SBAR(); qkt(pB0, pB1, K_lds + SHM_K, qr, r32, hi);
    finishSM(pA0, pA1, alA, l_reg, pa0, pa1, pa2, pa3); SBAR();
    pv_d0(o, vb0, pa0, pa1, pa2, pa3); partialSM(pB0, pB1, m_reg, mnB, alB);
    __syncthreads(); RESC(alB);
    finishSM(pB0, pB1, alB, l_reg, pa0, pa1, pa2, pa3); SBAR();
    pv_d0(o, vb0 + SHM_V, pa0, pa1, pa2, pa3);
    if (hi == 0) li_l[r32] = l_reg; asm volatile("s_waitcnt lgkmcnt(0)" ::: "memory");
    float rli[16];
#pragma unroll
    for (int r = 0; r < 16; ++r) rli[r] = __builtin_amdgcn_rcpf(li_l[crow(r, hi)]);
    bf16_t* Ow = Ob + (long)(wid * 32) * 512;
#pragma unroll
    for (int r = 0; r < 16; ++r) { const int orow = crow(r, hi);
#pragma unroll
        for (int d0 = 0; d0 < 2; ++d0) Ow[(long)orow * 512 + d0 * 32 + r32] = (bf16_t)f2bf(o[d0][r] * rli[r]); }
    __syncthreads();
#undef KROW
#undef SLOAD
#undef SWRITE
#undef SWAIT
#undef RESC
}
#undef SBAR
}

__device__ __forceinline__ void attn_latent_unit(const Ctx& F, unsigned char* ws, unsigned char* ha, int b, int h, int qb) {
    bf16_t* Y = (bf16_t*)(ws + D_YMLA); const long q0 = (long)b * SEQ + qb * 256;
    if (b < 4) { const bf16_t* Q = (const bf16_t*)(ha + HA_Q); const bf16_t* K = (const bf16_t*)(ha + HA_K); const bf16_t* V = (const bf16_t*)(ha + HA_V);
        attn::attn_unit(Q + q0 * 768 + h * 96, K + h * 64, K + 512, V + h * 64, Y + q0 * 512 + h * 64, (long)b * SEQ, (long)4 * SEQ + b * CTXL, 64, 68, F.lds); }
    else { const bf16_t* Q = (const bf16_t*)(ws + D_Q); const bf16_t* K = (const bf16_t*)(ws + D_K); const bf16_t* V = (const bf16_t*)(ws + D_V);
        attn::attn_unit(Q + q0 * 768 + h * 96, K + h * 64, K + 512, V + h * 64, Y + q0 * 512 + h * 64, (long)b * SEQ, (long)RL + b * CTXL, 64, 68, F.lds); }
}
__device__ __forceinline__ void attn_phase(const Ctx& F, int layer) {
    unsigned char* ws = getpp()->ws; unsigned char* ha = half_a_base(layer); const bool with_ctx_q = (layer == 0);
    const int vcu = (F.G % 8 == 0) ? (F.bid % 8) * (F.G / 8) + F.bid / 8 : F.bid;
    const int nlat_units = 4 * 8 * 16, nunits = nlat_units + (with_ctx_q ? NBATCH * 8 : 0);
    for (int u = vcu; u < nunits; u += F.G) {
        if (u < nlat_units) { const int bh = u >> 4, qb = u & 15; attn_latent_unit(F, ws, ha, 4 + (bh >> 3), bh & 7, qb); }
        else { const int bh = u - nlat_units, b = bh >> 3, h = bh & 7; bf16_t* Y = (bf16_t*)(ws + D_YMLA); const long yrow = (long)RL + b * CTXL;
            if (b < 4) { const bf16_t* Q = (const bf16_t*)(ha + HA_Q); const bf16_t* K = (const bf16_t*)(ha + HA_K); const bf16_t* V = (const bf16_t*)(ha + HA_V); const long q0 = (long)4 * SEQ + b * CTXL;
                attn::attn_unit(Q + q0 * 768 + h * 96, K + h * 64, K + 512, V + h * 64, Y + yrow * 512 + h * 64, 0, q0, 0, 4, F.lds); }
            else { const bf16_t* Q = (const bf16_t*)(ws + D_Q); const bf16_t* K = (const bf16_t*)(ws + D_K); const bf16_t* V = (const bf16_t*)(ws + D_V);
                attn::attn_unit(Q + yrow * 768 + h * 96, K + h * 64, K + 512, V + h * 64, Y + yrow * 512 + h * 64, 0, yrow, 0, 4, F.lds); } }
    }
}

__device__ __forceinline__ void load8_shift(const bf16_t* u, long row, int t, int T, int col, const float* mu, float* out) {
    float x[8], p[8], n[8];
    const bool hp = t > 0, hn = t < T - 1;
    const u32x4 wx = *(const u32x4*)(u + row * RWC + col), wp = *(const u32x4*)(u + (row - (hp ? 1 : 0)) * RWC + col), wn = *(const u32x4*)(u + (row + (hn ? 1 : 0)) * RWC + col);
    unpack8(wx, x); unpack8(wp, p); unpack8(wn, n);
    const float mp = hp ? 0.5f : 0.f, mn = hn ? 0.5f : 0.f;
    const f32x4 m0 = *(const f32x4*)(mu + col), m1 = *(const f32x4*)(mu + col + 4);
#pragma unroll
    for (int j = 0; j < 8; ++j) out[j] = x[j] + (j < 4 ? m0[j & 3] : m1[j & 3]) * (mp * p[j] + mn * n[j] - x[j]);
}
__device__ __forceinline__ void load8_shift_l(const bf16_t* u, long row, int t, int T, int col, const LAS float* mu8, float* out) {
    float x[8], p[8], n[8];
    const bool hp = t > 0, hn = t < T - 1;
    const u32x4 wx = *(const u32x4*)(u + row * RWC + col), wp = *(const u32x4*)(u + (row - (hp ? 1 : 0)) * RWC + col), wn = *(const u32x4*)(u + (row + (hn ? 1 : 0)) * RWC + col);
    unpack8(wx, x); unpack8(wp, p); unpack8(wn, n);
    const float mp = hp ? 0.5f : 0.f, mn = hn ? 0.5f : 0.f;
    const f32x4 m0 = *(const LAS f32x4*)(mu8), m1 = *(const LAS f32x4*)(mu8 + 4);
#pragma unroll
    for (int j = 0; j < 8; ++j) out[j] = x[j] + (j < 4 ? m0[j & 3] : m1[j & 3]) * (mp * p[j] + mn * n[j] - x[j]);
}
namespace rw2 {
constexpr int PT = 72;
constexpr int O_W2T = 0, O_A2T = 9216, O_ZL = 18432, O_AL = 34816, O_XWD = 51200, O_XAD = 60416, O_RING = 18432;
constexpr int O_TA = 69632, O_TB = O_TA + 9216, O_TK = O_TB + 9216, O_TR = O_TK + 9216, O_OUT = 69632;
constexpr int O_BH = 106496, O_KH = O_BH + 9216, O_V = O_KH + 9216, O_TOT = 134144, O_PL = 136192, O_PRM = 137216;
__device__ __forceinline__ s16x4 cv4(f32x4 v) { u32x2 w; w.x = pk2(v[0], v[1]); w.y = pk2(v[2], v[3]); return __builtin_bit_cast(s16x4, w); }
__device__ __forceinline__ f32x4 mm16(s16x4 a, s16x4 b, f32x4 c) { return __builtin_amdgcn_mfma_f32_16x16x16bf16_1k(a, b, c, 0, 0, 0); }
__device__ __forceinline__ f32x4 mm32(bf16x8 a, bf16x8 b, f32x4 c) { return __builtin_amdgcn_mfma_f32_16x16x32_bf16(a, b, c, 0, 0, 0); }
__device__ __forceinline__ f32x4 bf4_to_f(s16x4 s) { const u32x2 w = __builtin_bit_cast(u32x2, s); return (f32x4){bflo(w.x), bfhi(w.x), bflo(w.y), bfhi(w.y)}; }
typedef short v4i16_t __attribute__((ext_vector_type(4)));
__device__ __forceinline__ s16x4 trd(const LAS bf16_t* base, int row0, int col0, int lane) {
    const int g = lane >> 4, i = lane & 15, q = i >> 2, p = i & 3;
    return __builtin_bit_cast(s16x4, __builtin_amdgcn_ds_read_tr16_b64_v4i16((LAS v4i16_t*)(base + (row0 + 4 * g + q) * PT + col0 + 4 * p)));
}
__device__ __forceinline__ float fast_tanh(float x) { return 1.0f - 2.0f * __builtin_amdgcn_rcpf(__builtin_amdgcn_exp2f(2.8853900817779268f * x) + 1.0f); }
}
__device__ __forceinline__ void rwkv_chain2(const Ctx& F, int layer, int b, int h, int d) {
    using namespace rw2;
    PP P = getpp(); unsigned char* ws = P->ws;
    const bf16_t* u = (const bf16_t*)(ws + D_URWKV);
    bf16_t* od = (bf16_t*)(ws + (d ? D_OB : D_OF));
    float* bsc = (float*)(ws + WS_BSC) + (size_t)d * RT * 8;
    LAS unsigned char* L = F.lds;
    LAS bf16_t* w2t = (LAS bf16_t*)(L + O_W2T); LAS bf16_t* a2t = (LAS bf16_t*)(L + O_A2T);
    LAS float* Zl = (LAS float*)(L + O_ZL); LAS float* Al = (LAS float*)(L + O_AL);
    LAS bf16_t* Xwd = (LAS bf16_t*)(L + O_XWD); LAS bf16_t* Xad = (LAS bf16_t*)(L + O_XAD);
    LAS bf16_t* TA = (LAS bf16_t*)(L + O_TA); LAS bf16_t* TB = (LAS bf16_t*)(L + O_TB); LAS bf16_t* TK = (LAS bf16_t*)(L + O_TK); LAS bf16_t* TR = (LAS bf16_t*)(L + O_TR);
    LAS bf16_t* BH = (LAS bf16_t*)(L + O_BH); LAS bf16_t* KH = (LAS bf16_t*)(L + O_KH); LAS bf16_t* Vm = (LAS bf16_t*)(L + O_V);
    LAS float* tot = (LAS float*)(L + O_TOT); LAS float* pLs = (LAS float*)(L + O_PL); LAS float* Out = (LAS float*)(L + O_OUT);
    LAS float* prm = (LAS float*)(L + O_PRM);
    const int tid0 = F.tid, w = F.wave;
    {
        const int tid = tid0;
        const float* mu = P->in[I_MU] + layer * RWC;
        const float* w0 = P->in[I_W0] + (layer * 2 + d) * 512 + h * 64;
        const float* w2 = P->in[I_W2] + (size_t)(layer * 2 + d) * 64 * 512 + h * 64;
        const float* a0 = P->in[I_A0] + (layer * 2 + d) * 512 + h * 64;
        const float* a2 = P->in[I_A2] + (size_t)(layer * 2 + d) * 64 * 512 + h * 64;
        const float* k_k = P->in[I_KK] + layer * 512 + h * 64; const float* k_a = P->in[I_KA] + layer * 512 + h * 64; const float* r_k = P->in[I_RK] + layer * 512 + h * 64;
        for (int i = tid; i < 640; i += NTHREADS) { const int rr = i >> 6, cc = i & 63; float v;
            if (rr == 0) v = mu[h * 64 + cc]; else if (rr == 1) v = mu[512 + h * 64 + cc]; else if (rr == 2) v = mu[1024 + h * 64 + cc]; else if (rr == 3) v = mu[1536 + d * 64 + cc]; else if (rr == 4) v = mu[1664 + d * 64 + cc];
            else if (rr == 5) v = w0[cc]; else if (rr == 6) v = a0[cc]; else if (rr == 7) v = k_k[cc]; else if (rr == 8) v = k_a[cc]; else v = r_k[cc];
            prm[i] = v; }
        for (int i = tid; i < 4096; i += NTHREADS) { const int k = i >> 6, cc = i & 63; w2t[cc * PT + k] = (bf16_t)f2bf(w2[(size_t)k * 512 + cc]); a2t[cc * PT + k] = (bf16_t)f2bf(a2[(size_t)k * 512 + cc]); }
    }
    f32x4 Z[4];
#pragma unroll
    for (int j = 0; j < 4; ++j) Z[j] = (f32x4){0.f, 0.f, 0.f, 0.f};
    __syncthreads();
    for (int seq = 0; seq < 2; ++seq) {
        const int T = seq ? SEQ : CTXL; const long rbase = seq ? (long)b * SEQ : (long)RL + b * CTXL; const int nch = T / 64;
        for (int ci = 0; ci < nch; ++ci) {
            int tid = tid0; asm volatile("" : "+v"(tid));
            const int lane = tid & 63, fr = lane & 15, fq = lane >> 4, tt = tid >> 3, c8 = (tid & 7) * 8;
            const int tpos = d ? (T - 1 - (ci * 64 + tt)) : (ci * 64 + tt); const long row = rbase + tpos;
            float r[8], k[8], kk[8], av[8], kd[8], lw[8];
            {
                float v[8], x[8];
                load8_shift_l(u, row, tpos, T, h * 64 + c8, prm + c8, r);
                load8_shift_l(u, row, tpos, T, 512 + h * 64 + c8, prm + 64 + c8, k);
                load8_shift_l(u, row, tpos, T, 1024 + h * 64 + c8, prm + 128 + c8, v);
                *(LAS u32x4*)(Vm + tt * PT + c8) = pack8(v);
                load8_shift_l(u, row, tpos, T, 1536 + d * 64 + c8, prm + 192 + c8, x);
#pragma unroll
                for (int e = 0; e < 8; ++e) x[e] = fast_tanh(x[e]);
                *(LAS u32x4*)(Xwd + tt * PT + c8) = pack8(x);
                load8_shift_l(u, row, tpos, T, 1664 + d * 64 + c8, prm + 256 + c8, x);
                *(LAS u32x4*)(Xad + tt * PT + c8) = pack8(x);
            }
            __syncthreads();
            {
#pragma unroll
                for (int q = 0; q < 2; ++q) { const int id = 2 * w + q, tm = id >> 2, tn = id & 3;
                    f32x4 az = {0.f, 0.f, 0.f, 0.f}, aa = {0.f, 0.f, 0.f, 0.f};
#pragma unroll
                    for (int ks = 0; ks < 2; ++ks) {
                        az = mm32(*(const LAS bf16x8*)(Xwd + (16 * tm + fr) * PT + ks * 32 + fq * 8), *(const LAS bf16x8*)(w2t + (16 * tn + fr) * PT + ks * 32 + fq * 8), az);
                        aa = mm32(*(const LAS bf16x8*)(Xad + (16 * tm + fr) * PT + ks * 32 + fq * 8), *(const LAS bf16x8*)(a2t + (16 * tn + fr) * PT + ks * 32 + fq * 8), aa); }
#pragma unroll
                    for (int e = 0; e < 4; ++e) { Zl[(16 * tm + 4 * fq + e) * 64 + 16 * tn + fr] = az[e]; Al[(16 * tm + 4 * fq + e) * 64 + 16 * tn + fr] = aa[e]; } }
            }
            __syncthreads();
            {
                float ss = 0.f, bs = 0.f;
#pragma unroll
                for (int e = 0; e < 8; ++e) { kk[e] = k[e] * prm[448 + c8 + e]; ss += kk[e] * kk[e]; }
                ss += shx(ss, 1, lane); ss += shx(ss, 2, lane); ss += shx(ss, 4, lane);
                const float inv = __builtin_amdgcn_rsqf(fmaxf(ss, 1e-24f));
#pragma unroll
                for (int e = 0; e < 8; ++e) {
                    kk[e] *= inv;
                    const float z = Zl[tt * 64 + c8 + e] + prm[320 + c8 + e];
                    lw[e] = -sigmoidf_(z) * 0.8750612633917001f;
                    av[e] = sigmoidf_(Al[tt * 64 + c8 + e] + prm[384 + c8 + e]);
                    kd[e] = k[e] * (1.0f + (av[e] - 1.0f) * prm[512 + c8 + e]);
                    bs += r[e] * kd[e] * prm[576 + c8 + e];
                }
                bs += shx(bs, 1, lane); bs += shx(bs, 2, lane); bs += shx(bs, 4, lane);
                if ((tid & 7) == 0) bsc[(size_t)row * 8 + h] = bs;
            }
            float cum[8];
            {
#pragma unroll
                for (int e = 0; e < 8; ++e) cum[e] = lw[e];
#pragma unroll
                for (int off = 8; off < 64; off <<= 1) {
#pragma unroll
                    for (int e = 0; e < 8; ++e) { const float t = __int_as_float(__builtin_amdgcn_ds_bpermute(((lane - off) & 63) << 2, __float_as_int(cum[e]))); cum[e] += (lane >= off) ? t : 0.f; } }
                if (lane >= 56) {
#pragma unroll
                    for (int e = 0; e < 8; ++e) tot[w * 64 + c8 + e] = cum[e]; }
            }
            __syncthreads();
            {
                float ta[8], tb[8], tk[8], tr[8], bh[8], kh[8];
                const int w0i = (w & ~1) * 64 + c8;
#pragma unroll
                for (int e = 0; e < 8; ++e) {
                    const float t0 = tot[w0i + e], t1 = tot[w0i + 64 + e];
                    const float cm = cum[e] + ((w & 1) ? t0 : 0.f), cumL = t0 + t1;
                    const float e1 = __builtin_amdgcn_exp2f(cm - lw[e]), e2 = __builtin_amdgcn_exp2f(-cm), e3 = __builtin_amdgcn_exp2f(cm), e4 = __builtin_amdgcn_exp2f(cumL - cm);
                    const float ka = kk[e] * av[e];
                    ta[e] = -kk[e] * e1; tb[e] = ka * e2; tk[e] = kd[e] * e2; tr[e] = r[e] * e3; bh[e] = ka * e4; kh[e] = kd[e] * e4;
                    if ((tt & 15) == 15) pLs[(tt >> 4) * 64 + c8 + e] = e3;
                }
                *(LAS u32x4*)(TA + tt * PT + c8) = pack8(ta); *(LAS u32x4*)(TB + tt * PT + c8) = pack8(tb); *(LAS u32x4*)(TK + tt * PT + c8) = pack8(tk); *(LAS u32x4*)(TR + tt * PT + c8) = pack8(tr);
                *(LAS u32x4*)(BH + tt * PT + c8) = pack8(bh); *(LAS u32x4*)(KH + tt * PT + c8) = pack8(kh);
            }
            __syncthreads();
            if (w < 4) {
                const int s = w; const int rowf = (16 * s + fr) * PT;
                f32x4 Mab = {0.f, 0.f, 0.f, 0.f}, MabT = Mab, MakT = Mab, Mbr = Mab, Mkr = Mab;
#pragma unroll
                for (int ks = 0; ks < 2; ++ks) { const int o = rowf + ks * 32 + fq * 8;
                    const bf16x8 fa = *(const LAS bf16x8*)(TA + o), fb = *(const LAS bf16x8*)(TB + o), fk = *(const LAS bf16x8*)(TK + o), frr = *(const LAS bf16x8*)(TR + o);
                    Mab = mm32(fb, fa, Mab); MabT = mm32(fa, fb, MabT); MakT = mm32(fa, fk, MakT); Mbr = mm32(fb, frr, Mbr); Mkr = mm32(fk, frr, Mkr); }
                f32x4 Pm, Pt;
#pragma unroll
                for (int e = 0; e < 4; ++e) { const int m = 4 * fq + e, n = fr;
                    Mab[e] = (m < n) ? Mab[e] : 0.f; MabT[e] = (n < m) ? MabT[e] : 0.f; MakT[e] = (n < m) ? MakT[e] : 0.f; Mbr[e] = (m <= n) ? Mbr[e] : 0.f; Mkr[e] = (m <= n) ? Mkr[e] : 0.f;
                    const float id = (m == n) ? 1.f : 0.f; Pm[e] = Mab[e] + id; Pt[e] = MabT[e] + id; }
                f32x4 Nn = Mab, Nt = MabT; const f32x4 zero = {0.f, 0.f, 0.f, 0.f};
#pragma unroll
                for (int it = 0; it < 3; ++it) {
                    const s16x4 cn = cv4(Nn), cnt = cv4(Nt);
                    const f32x4 N2 = mm16(cnt, cn, zero), Nt2 = mm16(cn, cnt, zero);
                    const s16x4 cp = cv4(Pm), cpt = cv4(Pt), cn2 = cv4(N2);
                    const f32x4 Pn = mm16(cpt, cn2, Pm), Ptn = mm16(cn2, cpt, Pt);
                    Nn = N2; Nt = Nt2; Pm = Pn; Pt = Ptn; (void)cp;
                }
                const s16x4 cT = cv4(Pm), cMakT = cv4(MakT), cMbr = cv4(Mbr);
                const f32x4 Q1T = mm16(cT, cMakT, zero);
                const s16x4 cQ1T = cv4(Q1T);
                const f32x4 Hy = mm16(cQ1T, cMbr, Mkr);
                LAS unsigned char* ring = L + O_RING + s * 12800 + lane * 8;
                *(LAS s16x4*)(ring + 20 * 512) = cv4(Hy);
                s16x4 bhf[4];
#pragma unroll
                for (int jt = 0; jt < 4; ++jt) bhf[jt] = trd(BH, 16 * s, 16 * jt, lane);
#pragma unroll
                for (int jt = 0; jt < 4; ++jt) {
                    const s16x4 atf = trd(TA, 16 * s, 16 * jt, lane);
                    const f32x4 P1T = mm16(cT, atf, zero); const s16x4 cP1T = cv4(P1T);
                    const f32x4 rinit = bf4_to_f(*(const LAS s16x4*)(TR + (16 * s + fr) * PT + 16 * jt + 4 * fq));
                    const f32x4 Gy = mm16(cP1T, cMbr, rinit);
                    *(LAS s16x4*)(ring + jt * 512) = cv4(Gy);
#pragma unroll
                    for (int j2 = 0; j2 < 4; ++j2) { const f32x4 Gs = mm16(cP1T, bhf[j2], zero); *(LAS s16x4*)(ring + (4 + jt * 4 + j2) * 512) = cv4(Gs); }
                    const f32x4 kinit = bf4_to_f(trd(KH, 16 * s, 16 * jt, lane));
                    const f32x4 Hs = mm16(cQ1T, bhf[jt], kinit);
                    *(LAS s16x4*)(ring + (21 + jt) * 512) = cv4(Hs);
                }
            }
            __syncthreads();
            if (w < 4) {
                const int it = w;
#pragma unroll 1
                for (int s = 0; s < 4; ++s) {
                    const LAS unsigned char* ring = L + O_RING + s * 12800 + lane * 8;
                    const s16x4 vb = trd(Vm, 16 * s, 16 * it, lane);
                    s16x4 zb[4];
#pragma unroll
                    for (int jt = 0; jt < 4; ++jt) zb[jt] = cv4(Z[jt]);
                    f32x4 Yt = mm16(*(const LAS s16x4*)(ring + 20 * 512), vb, (f32x4){0.f, 0.f, 0.f, 0.f});
#pragma unroll
                    for (int jt = 0; jt < 4; ++jt) Yt = mm16(*(const LAS s16x4*)(ring + jt * 512), zb[jt], Yt);
#pragma unroll
                    for (int e = 0; e < 4; ++e) Out[(16 * s + 4 * fq + e) * 64 + 16 * it + fr] = Yt[e];
                    f32x4 Zn[4];
#pragma unroll
                    for (int j2 = 0; j2 < 4; ++j2) {
                        const f32x4 pv = *(const LAS f32x4*)(pLs + s * 64 + 16 * j2 + 4 * fq);
                        f32x4 zn = Z[j2] * pv;
                        zn = mm16(*(const LAS s16x4*)(ring + (21 + j2) * 512), vb, zn);
#pragma unroll
                        for (int jt = 0; jt < 4; ++jt) zn = mm16(*(const LAS s16x4*)(ring + (4 + jt * 4 + j2) * 512), zb[jt], zn);
                        Zn[j2] = zn;
                    }
#pragma unroll
                    for (int j2 = 0; j2 < 4; ++j2) Z[j2] = Zn[j2];
                }
            }
            __syncthreads();
            {
                float v[8];
#pragma unroll
                for (int e = 0; e < 8; ++e) v[e] = Out[tt * 64 + c8 + e];
                *(u32x4*)(od + (size_t)row * 512 + h * 64 + c8) = pack8(v);
            }
            __syncthreads();
        }
    }
}

namespace rw4 {
using namespace rw2;
constexpr int RGN = 16384, R_TA = 0, R_TB = 2304, R_TK = 4608, R_TR = 6912, R_BH = 9216, R_KH = 11520, R_V = 13824, R_PL = 16128;
constexpr int R_XWD = 0, R_XAD = 2304, R_ZL = 4608, R_AL = 8704;
constexpr int O_PRM4 = 8 * RGN;
}
__device__ __forceinline__ void rwkv_chain4(const Ctx& F, int layer, int b, int h, int d) {
    using namespace rw4;
    PP P = getpp(); unsigned char* ws = P->ws;
    const bf16_t* u = (const bf16_t*)(ws + D_URWKV);
    bf16_t* od = (bf16_t*)(ws + (d ? D_OB : D_OF));
    float* bsc = (float*)(ws + WS_BSC) + (size_t)d * RT * 8;
    const bf16_t* w2g = (const bf16_t*)(ws + WS_W2T) + (size_t)((layer * 2 + d) * 2 + 0) * 512 * 64 + (size_t)h * 64 * 64;
    const bf16_t* a2g = (const bf16_t*)(ws + WS_W2T) + (size_t)((layer * 2 + d) * 2 + 1) * 512 * 64 + (size_t)h * 64 * 64;
    LAS unsigned char* L = F.lds;
    LAS float* prm = (LAS float*)(L + O_PRM4);
    volatile LAS unsigned* rdy = (volatile LAS unsigned*)(L + O_PRM4 + 2560); LAS unsigned* dne = (LAS unsigned*)(L + O_PRM4 + 2560 + 64);
    unsigned gseq = 0;
    const int tid0 = F.tid, w = F.wave;
    {
        const float* mu = P->in[I_MU] + layer * RWC;
        const float* w0 = P->in[I_W0] + (layer * 2 + d) * 512 + h * 64; const float* a0 = P->in[I_A0] + (layer * 2 + d) * 512 + h * 64;
        const float* k_k = P->in[I_KK] + layer * 512 + h * 64; const float* k_a = P->in[I_KA] + layer * 512 + h * 64; const float* r_k = P->in[I_RK] + layer * 512 + h * 64;
        for (int i = tid0; i < 640; i += NTHREADS) { const int rr = i >> 6, cc = i & 63; float v;
            if (rr == 0) v = mu[h * 64 + cc]; else if (rr == 1) v = mu[512 + h * 64 + cc]; else if (rr == 2) v = mu[1024 + h * 64 + cc]; else if (rr == 3) v = mu[1536 + d * 64 + cc]; else if (rr == 4) v = mu[1664 + d * 64 + cc];
            else if (rr == 5) v = w0[cc]; else if (rr == 6) v = a0[cc]; else if (rr == 7) v = k_k[cc]; else if (rr == 8) v = k_a[cc]; else v = r_k[cc];
            prm[i] = v; }
        if (tid0 < 8) { rdy[tid0] = 0u; dne[tid0] = 0u; }
    }
    f32x4 Z[4];
#pragma unroll
    for (int j = 0; j < 4; ++j) Z[j] = (f32x4){0.f, 0.f, 0.f, 0.f};
    u32x4 raw[2][5][3];
#define RW4_PREFETCH(T_, rbase_, gi_) do { int t0_ = tid0; asm volatile("" : "+v"(t0_)); const int lane_ = t0_ & 63, tk_ = lane_ >> 2, cg_ = lane_ & 3; const int pi_ = (gi_) * 128 + 16 * w + tk_; const int tp_ = d ? ((T_) - 1 - pi_) : pi_; \
        const long row_ = (rbase_) + tp_; const long rp_ = row_ - (tp_ > 0 ? 1 : 0), rn_ = row_ + (tp_ < (T_) - 1 ? 1 : 0); \
        _Pragma("unroll") for (int q_ = 0; q_ < 2; ++q_) _Pragma("unroll") for (int g_ = 0; g_ < 5; ++g_) { \
            const int col_ = (g_ == 0 ? h * 64 : g_ == 1 ? 512 + h * 64 : g_ == 2 ? 1024 + h * 64 : g_ == 3 ? 1536 + d * 64 : 1664 + d * 64) + q_ * 32 + cg_ * 8; \
            raw[q_][g_][0] = *(const u32x4*)(u + row_ * RWC + col_); raw[q_][g_][1] = *(const u32x4*)(u + rp_ * RWC + col_); raw[q_][g_][2] = *(const u32x4*)(u + rn_ * RWC + col_); } } while (0)
    RW4_PREFETCH(CTXL, (long)RL + b * CTXL, 0);
    __syncthreads();
    for (int seq = 0; seq < 2; ++seq) {
        const int T = seq ? SEQ : CTXL; const long rbase = seq ? (long)b * SEQ : (long)RL + b * CTXL; const int ngr = T / 128;
        for (int gi = 0; gi < ngr; ++gi) {
            int tid = tid0; asm volatile("" : "+v"(tid));
            const int lane = tid & 63, fr = lane & 15, fq = lane >> 4, tk = lane >> 2, cg = lane & 3;
            LAS unsigned char* R = L + w * RGN;
            { unsigned sp = 0; while (*(volatile LAS unsigned*)(dne + w) != 4u * gseq) { __builtin_amdgcn_s_sleep(1); if (++sp > (1u << 24)) break; } }
            asm volatile("" ::: "memory");
            {
                const int pi = gi * 128 + 16 * w + tk; const int tpos = d ? (T - 1 - pi) : pi; const long row = rbase + tpos;
                float r[16], k[16], kk[16], av[16], kd[16], lw[16];
                {
                    const float mp = (tpos > 0) ? 0.5f : 0.f, mn = (tpos < T - 1) ? 0.5f : 0.f;
#pragma unroll
                    for (int q = 0; q < 2; ++q) { const int c8 = q * 32 + cg * 8;
#pragma unroll
                        for (int g5 = 0; g5 < 5; ++g5) {
                            float x[8], p[8], n[8], o[8];
                            unpack8(raw[q][g5][0], x); unpack8(raw[q][g5][1], p); unpack8(raw[q][g5][2], n);
                            const f32x4 m0 = *(const LAS f32x4*)(prm + g5 * 64 + c8), m1 = *(const LAS f32x4*)(prm + g5 * 64 + c8 + 4);
#pragma unroll
                            for (int j = 0; j < 8; ++j) o[j] = x[j] + (j < 4 ? m0[j & 3] : m1[j & 3]) * (mp * p[j] + mn * n[j] - x[j]);
                            if (g5 == 0) {
#pragma unroll
                                for (int j = 0; j < 8; ++j) r[8 * q + j] = o[j]; }
                            else if (g5 == 1) {
#pragma unroll
                                for (int j = 0; j < 8; ++j) k[8 * q + j] = o[j]; }
                            else if (g5 == 2) *(LAS u32x4*)(R + R_V + (tk * PT + c8) * 2) = pack8(o);
                            else if (g5 == 3) {
#pragma unroll
                                for (int j = 0; j < 8; ++j) o[j] = fast_tanh(o[j]);
                                *(LAS u32x4*)(R + R_XWD + (tk * PT + c8) * 2) = pack8(o); }
                            else *(LAS u32x4*)(R + R_XAD + (tk * PT + c8) * 2) = pack8(o);
                        } }
                }
                {
                    const LAS bf16_t* Xwd = (const LAS bf16_t*)(R + R_XWD); const LAS bf16_t* Xad = (const LAS bf16_t*)(R + R_XAD);
                    LAS float* Zl = (LAS float*)(R + R_ZL); LAS float* Al = (LAS float*)(R + R_AL);
                    bf16x8 fw[2], fa[2];
#pragma unroll
                    for (int ks = 0; ks < 2; ++ks) { fw[ks] = *(const LAS bf16x8*)(Xwd + fr * PT + ks * 32 + fq * 8); fa[ks] = *(const LAS bf16x8*)(Xad + fr * PT + ks * 32 + fq * 8); }
#pragma unroll
                    for (int tn = 0; tn < 4; ++tn) { f32x4 az = {0.f, 0.f, 0.f, 0.f}, aa = {0.f, 0.f, 0.f, 0.f};
#pragma unroll
                        for (int ks = 0; ks < 2; ++ks) { az = mm32(fw[ks], *(const bf16x8*)(w2g + (16 * tn + fr) * 64 + ks * 32 + fq * 8), az); aa = mm32(fa[ks], *(const bf16x8*)(a2g + (16 * tn + fr) * 64 + ks * 32 + fq * 8), aa); }
#pragma unroll
                        for (int e = 0; e < 4; ++e) { Zl[(4 * fq + e) * 64 + 16 * tn + fr] = az[e]; Al[(4 * fq + e) * 64 + 16 * tn + fr] = aa[e]; } }
                }
                {
                    const LAS float* Zl = (const LAS float*)(R + R_ZL); const LAS float* Al = (const LAS float*)(R + R_AL);
                    float ss = 0.f, bs = 0.f;
                    float pkk[16], pw0[16], pa0[16], pka[16], prk[16], zz[16], aa2[16];
#pragma unroll
                    for (int q = 0; q < 2; ++q) { const int c8 = q * 32 + cg * 8;
#pragma unroll
                        for (int hh = 0; hh < 2; ++hh) { const int o4 = c8 + 4 * hh, i4 = 8 * q + 4 * hh;
                            const f32x4 a = *(const LAS f32x4*)(prm + 448 + o4), b2 = *(const LAS f32x4*)(prm + 320 + o4), c = *(const LAS f32x4*)(prm + 384 + o4), d2 = *(const LAS f32x4*)(prm + 512 + o4), e2 = *(const LAS f32x4*)(prm + 576 + o4);
                            const f32x4 z4 = *(const LAS f32x4*)(Zl + tk * 64 + o4), a4 = *(const LAS f32x4*)(Al + tk * 64 + o4);
#pragma unroll
                            for (int j = 0; j < 4; ++j) { pkk[i4 + j] = a[j]; pw0[i4 + j] = b2[j]; pa0[i4 + j] = c[j]; pka[i4 + j] = d2[j]; prk[i4 + j] = e2[j]; zz[i4 + j] = z4[j]; aa2[i4 + j] = a4[j]; } } }
#pragma unroll
                    for (int i = 0; i < 16; ++i) { kk[i] = k[i] * pkk[i]; ss += kk[i] * kk[i]; }
                    ss += shx(ss, 1, lane); ss += shx(ss, 2, lane);
                    const float inv = __builtin_amdgcn_rsqf(fmaxf(ss, 1e-24f));
#pragma unroll
                    for (int i = 0; i < 16; ++i) {
                        kk[i] *= inv;
                        lw[i] = -sigmoidf_(zz[i] + pw0[i]) * 0.8750612633917001f;
                        av[i] = sigmoidf_(aa2[i] + pa0[i]);
                        kd[i] = k[i] * (1.0f + (av[i] - 1.0f) * pka[i]);
                        bs += r[i] * kd[i] * prk[i]; }
                    bs += shx(bs, 1, lane); bs += shx(bs, 2, lane);
                    if (cg == 0) bsc[(size_t)row * 8 + h] = bs;
                }
                float cum[16], cumL[16];
                {
                    LAS float* Sc = (LAS float*)(R + R_ZL);
#pragma unroll
                    for (int q = 0; q < 2; ++q) { *(LAS f32x4*)(Sc + tk * 64 + q * 32 + cg * 8) = (f32x4){lw[8 * q], lw[8 * q + 1], lw[8 * q + 2], lw[8 * q + 3]}; *(LAS f32x4*)(Sc + tk * 64 + q * 32 + cg * 8 + 4) = (f32x4){lw[8 * q + 4], lw[8 * q + 5], lw[8 * q + 6], lw[8 * q + 7]}; }
                    float a = 0.f;
#pragma unroll
                    for (int t = 0; t < 16; ++t) { a += Sc[t * 64 + lane]; Sc[t * 64 + lane] = a; }
#pragma unroll
                    for (int q = 0; q < 2; ++q) { const f32x4 c0 = *(const LAS f32x4*)(Sc + tk * 64 + q * 32 + cg * 8), c1 = *(const LAS f32x4*)(Sc + tk * 64 + q * 32 + cg * 8 + 4);
                        const f32x4 l0 = *(const LAS f32x4*)(Sc + 15 * 64 + q * 32 + cg * 8), l1 = *(const LAS f32x4*)(Sc + 15 * 64 + q * 32 + cg * 8 + 4);
#pragma unroll
                        for (int e = 0; e < 4; ++e) { cum[8 * q + e] = c0[e]; cum[8 * q + 4 + e] = c1[e]; cumL[8 * q + e] = l0[e]; cumL[8 * q + 4 + e] = l1[e]; } }
                }
                {
#pragma unroll
                    for (int q = 0; q < 2; ++q) { float ta[8], tb[8], tkk[8], tr[8], bh[8], kh[8], plv[8]; const int c8 = q * 32 + cg * 8;
#pragma unroll
                        for (int e = 0; e < 8; ++e) { const int i = 8 * q + e;
                            const float e3 = __builtin_amdgcn_exp2f(cum[i]), e2 = __builtin_amdgcn_rcpf(e3), e1 = __builtin_amdgcn_exp2f(cum[i] - lw[i]), e4 = __builtin_amdgcn_exp2f(cumL[i] - cum[i]);
                            const float ka = kk[i] * av[i];
                            ta[e] = -kk[i] * e1; tb[e] = ka * e2; tkk[e] = kd[i] * e2; tr[e] = r[i] * e3; bh[e] = ka * e4; kh[e] = kd[i] * e4;
                            plv[e] = e3; }
                        *(LAS u32x4*)(R + R_TA + (tk * PT + c8) * 2) = pack8(ta); *(LAS u32x4*)(R + R_TB + (tk * PT + c8) * 2) = pack8(tb); *(LAS u32x4*)(R + R_TK + (tk * PT + c8) * 2) = pack8(tkk);
                        *(LAS u32x4*)(R + R_TR + (tk * PT + c8) * 2) = pack8(tr); *(LAS u32x4*)(R + R_BH + (tk * PT + c8) * 2) = pack8(bh); *(LAS u32x4*)(R + R_KH + (tk * PT + c8) * 2) = pack8(kh);
                        if (tk == 15) { LAS float* pp = (LAS float*)(R + R_PL) + c8; *(LAS f32x4*)pp = (f32x4){plv[0], plv[1], plv[2], plv[3]}; *(LAS f32x4*)(pp + 4) = (f32x4){plv[4], plv[5], plv[6], plv[7]}; } }
                }
                {
                    const LAS bf16_t* TA = (const LAS bf16_t*)(R + R_TA); const LAS bf16_t* TB = (const LAS bf16_t*)(R + R_TB); const LAS bf16_t* TK = (const LAS bf16_t*)(R + R_TK);
                    const LAS bf16_t* TR = (const LAS bf16_t*)(R + R_TR); const LAS bf16_t* BH = (const LAS bf16_t*)(R + R_BH); const LAS bf16_t* KH = (const LAS bf16_t*)(R + R_KH);
                    f32x4 Mab = {0.f, 0.f, 0.f, 0.f}, MabT = Mab, MakT = Mab, Mbr = Mab, Mkr = Mab;
#pragma unroll
                    for (int ks = 0; ks < 2; ++ks) { const int o = fr * PT + ks * 32 + fq * 8;
                        const bf16x8 fa = *(const LAS bf16x8*)(TA + o), fb = *(const LAS bf16x8*)(TB + o), fk = *(const LAS bf16x8*)(TK + o), frr = *(const LAS bf16x8*)(TR + o);
                        Mab = mm32(fb, fa, Mab); MabT = mm32(fa, fb, MabT); MakT = mm32(fa, fk, MakT); Mbr = mm32(fb, frr, Mbr); Mkr = mm32(fk, frr, Mkr); }
                    s16x4 bhf[4], atf[4], rin[4], kin[4];
#pragma unroll
                    for (int jt = 0; jt < 4; ++jt) { bhf[jt] = trd(BH, 0, 16 * jt, lane); atf[jt] = trd(TA, 0, 16 * jt, lane); kin[jt] = trd(KH, 0, 16 * jt, lane); rin[jt] = *(const LAS s16x4*)(TR + fr * PT + 16 * jt + 4 * fq); }
                    f32x4 Pm, Pt;
#pragma unroll
                    for (int e = 0; e < 4; ++e) { const int m = 4 * fq + e, n = fr;
                        Mab[e] = (m < n) ? Mab[e] : 0.f; MabT[e] = (n < m) ? MabT[e] : 0.f; MakT[e] = (n < m) ? MakT[e] : 0.f; Mbr[e] = (m <= n) ? Mbr[e] : 0.f; Mkr[e] = (m <= n) ? Mkr[e] : 0.f;
                        const float id = (m == n) ? 1.f : 0.f; Pm[e] = Mab[e] + id; Pt[e] = MabT[e] + id; }
                    f32x4 Nn = Mab, Nt = MabT; const f32x4 zero = {0.f, 0.f, 0.f, 0.f};
#pragma unroll
                    for (int it = 0; it < 3; ++it) {
                        const s16x4 cn = cv4(Nn), cnt = cv4(Nt);
                        const f32x4 N2 = mm16(cnt, cn, zero), Nt2 = mm16(cn, cnt, zero);
                        const s16x4 cpt = cv4(Pt), cn2 = cv4(N2);
                        const f32x4 Pn = mm16(cpt, cn2, Pm), Ptn = mm16(cn2, cpt, Pt);
                        Nn = N2; Nt = Nt2; Pm = Pn; Pt = Ptn;
                    }
                    const s16x4 cT = cv4(Pm), cMakT = cv4(MakT), cMbr = cv4(Mbr);
                    const f32x4 Q1T = mm16(cT, cMakT, zero);
                    const s16x4 cQ1T = cv4(Q1T);
                    const f32x4 Hy = mm16(cQ1T, cMbr, Mkr);
                    asm volatile("s_waitcnt lgkmcnt(0)" ::: "memory");
                    LAS unsigned char* ring = R + lane * 8;
                    *(LAS s16x4*)(ring + 20 * 512) = cv4(Hy);
#pragma unroll
                    for (int jt = 0; jt < 4; ++jt) {
                        const f32x4 P1T = mm16(cT, atf[jt], zero); const s16x4 cP1T = cv4(P1T);
                        const f32x4 Gy = mm16(cP1T, cMbr, bf4_to_f(rin[jt]));
                        *(LAS s16x4*)(ring + jt * 512) = cv4(Gy);
#pragma unroll
                        for (int j2 = 0; j2 < 4; ++j2) { const f32x4 Gs = mm16(cP1T, bhf[j2], zero); *(LAS s16x4*)(ring + (4 + jt * 4 + j2) * 512) = cv4(Gs); }
                        const f32x4 Hs = mm16(cQ1T, bhf[jt], bf4_to_f(kin[jt]));
                        *(LAS s16x4*)(ring + (21 + jt) * 512) = cv4(Hs);
                    }
                }
            }
            {
                const bool more = gi + 1 < ngr; const bool nseq = !more && seq == 0;
                const int nT = nseq ? SEQ : T; const long nrb = nseq ? (long)b * SEQ : rbase; const int ngi = more ? gi + 1 : (nseq ? 0 : gi);
                RW4_PREFETCH(nT, nrb, ngi);
            }
            ++gseq;
            asm volatile("s_waitcnt lgkmcnt(0)" ::: "memory");
            if (lane == 0) rdy[w] = gseq;
            asm volatile("" ::: "memory");
            if (w < 4) {
                const int it = w;
#pragma unroll 1
                for (int s = 0; s < 8; ++s) {
                    { unsigned sp = 0; while (rdy[s] != gseq) { __builtin_amdgcn_s_sleep(1); if (++sp > (1u << 24)) break; } }
                    asm volatile("" ::: "memory");
                    const LAS unsigned char* Rs = L + s * RGN; const LAS unsigned char* ring = Rs + lane * 8;
                    const s16x4 vb = trd((const LAS bf16_t*)(Rs + R_V), 0, 16 * it, lane);
                    s16x4 zb[4];
#pragma unroll
                    for (int jt = 0; jt < 4; ++jt) zb[jt] = cv4(Z[jt]);
                    f32x4 Yt = mm16(*(const LAS s16x4*)(ring + 20 * 512), vb, (f32x4){0.f, 0.f, 0.f, 0.f});
#pragma unroll
                    for (int jt = 0; jt < 4; ++jt) Yt = mm16(*(const LAS s16x4*)(ring + jt * 512), zb[jt], Yt);
#pragma unroll
                    for (int e = 0; e < 4; ++e) { const int pi = gi * 128 + 16 * s + 4 * fq + e; const int tp = d ? (T - 1 - pi) : pi;
                        od[(size_t)(rbase + tp) * 512 + h * 64 + 16 * it + fr] = (bf16_t)f2bf(Yt[e]); }
                    f32x4 Zn[4];
#pragma unroll
                    for (int j2 = 0; j2 < 4; ++j2) {
                        const f32x4 pv = *(const LAS f32x4*)((const LAS float*)(Rs + R_PL) + 16 * j2 + 4 * fq);
                        f32x4 zn = Z[j2] * pv;
                        zn = mm16(*(const LAS s16x4*)(ring + (21 + j2) * 512), vb, zn);
#pragma unroll
                        for (int jt = 0; jt < 4; ++jt) zn = mm16(*(const LAS s16x4*)(ring + (4 + jt * 4 + j2) * 512), zb[jt], zn);
                        Zn[j2] = zn;
                    }
#pragma unroll
                    for (int j2 = 0; j2 < 4; ++j2) Z[j2] = Zn[j2];
                    asm volatile("s_waitcnt lgkmcnt(0)" ::: "memory");
                    if (lane == 0) (void)__hip_atomic_fetch_add(dne + s, 1u, __ATOMIC_RELAXED, __HIP_MEMORY_SCOPE_WORKGROUP);
                }
            }
        }
    }
#undef RW4_PREFETCH
}

__device__ __forceinline__ void rwkv_post_phase(const Ctx& F, int layer, int nrows_y) {
    PP P = getpp(); unsigned char* ws = P->ws;
    const bf16_t* u = (const bf16_t*)(ws + D_URWKV); const bf16_t* of = (const bf16_t*)(ws + D_OF); const bf16_t* ob = (const bf16_t*)(ws + D_OB);
    bf16_t* y = (bf16_t*)(ws + D_YRWKV);
    const float* bf_ = (const float*)(ws + WS_BSC); const float* bb_ = bf_ + (size_t)RT * 8;
    const float* mu = P->in[I_MU] + layer * RWC; const float* lng = P->in[I_LNG] + layer * 512; const float* lnb = P->in[I_LNB] + layer * 512;
    const bf16_t* wg2 = (const bf16_t*)(ws + WS_WG2) + (size_t)layer * 512 * 128;
    LAS bf16_t* sg = (LAS bf16_t*)F.lds;
    LAS bf16_t* gt = (LAS bf16_t*)(F.lds + 64 * 136 * 2);
    const int tid0 = F.tid, wave = F.wave; const int lane = F.lane;
    const int nunits = nrows_y / 64;
    for (int un = F.bid; un < nunits; un += F.G) {
        int tid = tid0; asm volatile("" : "+v"(tid)); const int lane = tid & 63;
        const long r0 = (long)un * 64; const bool lat = r0 < RL; const int T = lat ? SEQ : CTXL; const int tbase = lat ? (int)(r0 & (SEQ - 1)) : (int)((r0 - RL) & (CTXL - 1));
        for (int it = tid; it < 1024; it += NTHREADS) { const int tk = it >> 4, q = it & 15; float v[8]; load8_shift(u, r0 + tk, tbase + tk, T, 1792 + q * 8, mu, v);
#pragma unroll
            for (int j = 0; j < 8; ++j) v[j] = sigmoidf_(v[j]);
            *(LAS u32x4*)(sg + tk * 136 + q * 8) = pack8(v); }
        __syncthreads();
        {
            const int fr = lane & 15, fq = lane >> 4;
#pragma unroll
            for (int tn = 0; tn < 4; ++tn) { const int cn = (wave * 4 + tn) * 16;
                bf16x8 bfrag[4];
#pragma unroll
                for (int k = 0; k < 4; ++k) bfrag[k] = *(const bf16x8*)(wg2 + (size_t)(cn + fr) * 128 + k * 32 + fq * 8);
#pragma unroll
                for (int tm = 0; tm < 4; ++tm) { f32x4 acc = {0.f, 0.f, 0.f, 0.f};
#pragma unroll
                    for (int k = 0; k < 4; ++k) { const bf16x8 afrag = *(const LAS bf16x8*)(sg + (tm * 16 + fr) * 136 + k * 32 + fq * 8); acc = __builtin_amdgcn_mfma_f32_16x16x32_bf16(afrag, bfrag[k], acc, 0, 0, 0); }
#pragma unroll
                    for (int j = 0; j < 4; ++j) gt[(tm * 16 + fq * 4 + j) * 520 + cn + fr] = (bf16_t)f2bf(acc[j]); } }
        }
        __syncthreads();
        {
            const int tk = tid >> 3, hh = tid & 7; const long row = r0 + tk; const int t = tbase + tk;
            const float bsum = bf_[row * 8 + hh] + bb_[row * 8 + hh];
            float o[64]; float s = 0.f;
#pragma unroll
            for (int q = 0; q < 8; ++q) { float a[8], c[8]; unpack8(*(const u32x4*)(of + row * 512 + hh * 64 + q * 8), a); unpack8(*(const u32x4*)(ob + row * 512 + hh * 64 + q * 8), c);
#pragma unroll
                for (int j = 0; j < 8; ++j) { o[q * 8 + j] = a[j] + c[j]; s += o[q * 8 + j]; } }
            const float mean = s * (1.0f / 64.0f); float vs = 0.f;
#pragma unroll
            for (int j = 0; j < 64; ++j) { const float dd = o[j] - mean; vs += dd * dd; }
            const float rstd = rsqrtf(vs * (1.0f / 64.0f) + 64e-5f);
#pragma unroll
            for (int q = 0; q < 8; ++q) { float vv[8], res[8]; load8_shift(u, row, t, T, 1024 + hh * 64 + q * 8, mu, vv);
                float g8[8]; unpack8(*(const LAS u32x4*)(gt + tk * 520 + hh * 64 + q * 8), g8);
                const int c0 = hh * 64 + q * 8; float lg8[8], lb8[8];
                *(f32x4*)lg8 = *(const f32x4*)(lng + c0); *(f32x4*)(lg8 + 4) = *(const f32x4*)(lng + c0 + 4); *(f32x4*)lb8 = *(const f32x4*)(lnb + c0); *(f32x4*)(lb8 + 4) = *(const f32x4*)(lnb + c0 + 4);
#pragma unroll
                for (int j = 0; j < 8; ++j) res[j] = ((o[q * 8 + j] - mean) * rstd * lg8[j] + lb8[j] + bsum * vv[j]) * g8[j];
                *(u32x4*)(y + row * 512 + hh * 64 + q * 8) = pack8(res); }
        }
        __syncthreads();
    }
}
__device__ __forceinline__ void ctx_krope_proj(const Ctx& F, int layer) {
    unsigned char* ws = getpp()->ws;
    const bf16_t* xlo = (const bf16_t*)(ws + D_XN1); const bf16_t* xhi = (const bf16_t*)(ws + D_XN1 + Y34);
    const bf16_t* wlo = (const bf16_t*)(ws + WS_W + (size_t)layer * WL_STRIDE + WL_WINLO); const bf16_t* whi = (const bf16_t*)(ws + WS_W + (size_t)layer * WL_STRIDE + WL_WINHI);
    bf16_t* um = (bf16_t*)(ws + D_UMLA);
    LAS float* part = (LAS float*)F.lds;
    const int lane = F.lane, w = F.wave, fr = lane & 15, fq = lane >> 4;
    for (int task = (F.bid + F.G - 128 % F.G) % F.G; task < RC / 16; task += F.G) {
        const long r0 = (long)RL + task * 16;
        const bf16_t* xa = (w < 4 ? xlo : xhi) + (r0 + fr) * 512 + (w & 3) * 128 + fq * 8;
        const bf16_t* wb = (w < 4 ? wlo : whi) + (size_t)(4096 + fr) * 512 + (w & 3) * 128 + fq * 8;
        bf16x8 a[4], b0[4], b1[4];
#pragma unroll
        for (int ks = 0; ks < 4; ++ks) { a[ks] = *(const bf16x8*)(xa + ks * 32); b0[ks] = *(const bf16x8*)(wb + ks * 32); b1[ks] = *(const bf16x8*)(wb + 16 * 512 + ks * 32); }
        f32x4 c0 = {0.f, 0.f, 0.f, 0.f}, c1 = {0.f, 0.f, 0.f, 0.f};
#pragma unroll
        for (int ks = 0; ks < 4; ++ks) { c0 = __builtin_amdgcn_mfma_f32_16x16x32_bf16(a[ks], b0[ks], c0, 0, 0, 0); c1 = __builtin_amdgcn_mfma_f32_16x16x32_bf16(a[ks], b1[ks], c1, 0, 0, 0); }
#pragma unroll
        for (int j = 0; j < 4; ++j) { part[(w * 16 + 4 * fq + j) * 33 + fr] = c0[j]; part[(w * 16 + 4 * fq + j) * 33 + 16 + fr] = c1[j]; }
        __syncthreads();
        { const int row = F.tid >> 5, col = F.tid & 31; float s = 0.f;
#pragma unroll
          for (int ww = 0; ww < 8; ++ww) s += part[(ww * 16 + row) * 33 + col];
          um[(r0 + row) * MLC + 640 + col] = (bf16_t)f2bf(s); }
        __syncthreads();
    }
}
__device__ __forceinline__ void mla_stats_pass(const Ctx& F, int w0, int nw) {
    unsigned char* ws = getpp()->ws; const int lane = F.lane;
    const bf16_t* um = (const bf16_t*)(ws + D_UMLA); float* rq = (float*)(ws + WS_RSTD); float* rkv = rq + RT;
    for (int row = GW(F) - w0; row < RT; row += nw) {
        const bf16_t* ur = um + (size_t)row * MLC;
        float sq = 0.f, skv = 0.f;
        { float v[8]; unpack8(*(const u32x4*)(ur + lane * 8), v); float s = 0.f;
#pragma unroll
            for (int j = 0; j < 8; ++j) s += v[j] * v[j];
            if (lane < 48) sq += s; else skv += s; }
        if (lane < 16) { float v[8]; unpack8(*(const u32x4*)(ur + 512 + lane * 8), v); float s = 0.f;
#pragma unroll
            for (int j = 0; j < 8; ++j) s += v[j] * v[j];
            skv += s; }
        sq = wave_sum(sq, lane); skv = wave_sum(skv, lane);
        if (lane == 0) { rq[row] = rsqrtf(sq * (1.0f / 384.0f) + 1e-6f); rkv[row] = rsqrtf(skv * (1.0f / 256.0f) + 1e-6f); }
    }
}
__device__ __forceinline__ void krope_pass(const Ctx& F, int half, int layer) {
    unsigned char* ws = getpp()->ws; const int lane = F.lane;
    const bf16_t* um = (const bf16_t*)(ws + D_UMLA); bf16_t* Kb = half ? (bf16_t*)(ws + D_K) : (bf16_t*)(half_a_base(layer) + HA_K);
    const float* cm = (const float*)(ws + WS_ROPE_M); const float* sm = cm + 4096 * 16;
    for (int ci = GW(F) * 4 + (lane >> 4); ci < HROWS; ci += NGW(F) * 4) {
        const int row = ci < 4 * SEQ ? 4 * SEQ * half + ci : RL + 4 * CTXL * half + (ci - 4 * SEQ);
        const int orow = half ? row : ci;
        const bf16_t* ur = um + (size_t)row * MLC; const int l = lane & 15;
        float x1 = bf2f(ur[640 + l]), x2 = bf2f(ur[656 + l]);
        if (row < RL) { const int t = row & (SEQ - 1); const float cs = cm[t * 16 + l], sn = sm[t * 16 + l]; const float o1 = x1 * cs - x2 * sn, o2 = x1 * sn + x2 * cs; x1 = o1; x2 = o2; }
        Kb[(size_t)orow * 544 + 512 + l] = (bf16_t)f2bf(x1); Kb[(size_t)orow * 544 + 528 + l] = (bf16_t)f2bf(x2);
    }
}

constexpr size_t D_KV = D_END1;
static_assert(D_KV + 34 * MiB <= WS_NEED, "retention state buffer");
namespace ret2 {
constexpr int QP = 72, VP = 136, NUNITS = NBATCH * 4 * 34;
typedef short v4i16_t __attribute__((ext_vector_type(4)));
__device__ __forceinline__ bf16x8 tr8(const LAS bf16_t* base, int pitch, int row0, int col0, int lane) {
    const int g = lane >> 4, i = lane & 15, q = i >> 2, p = i & 3;
    const LAS bf16_t* a = base + (row0 + 8 * g + q) * pitch + col0 + 4 * p;
    const s16x4 lo = __builtin_bit_cast(s16x4, __builtin_amdgcn_ds_read_tr16_b64_v4i16((LAS v4i16_t*)a));
    const s16x4 hi = __builtin_bit_cast(s16x4, __builtin_amdgcn_ds_read_tr16_b64_v4i16((LAS v4i16_t*)(a + 4 * pitch)));
    return (bf16x8){lo[0], lo[1], lo[2], lo[3], hi[0], hi[1], hi[2], hi[3]};
}
__device__ __forceinline__ f32x4 mm32(bf16x8 a, bf16x8 b, f32x4 c) { return __builtin_amdgcn_mfma_f32_16x16x32_bf16(a, b, c, 0, 0, 0); }
struct UnitPos { int b, h, cs; long rbase; bool isctx; int t0; };
__device__ __forceinline__ UnitPos unit_pos(int un) { UnitPos U; const int bh = un / 34; U.cs = un % 34; U.b = bh >> 2; U.h = bh & 3; U.isctx = U.cs < 2;
    U.t0 = U.isctx ? 0 : (U.cs - 2) * 128; U.rbase = U.isctx ? (long)RL + U.b * CTXL + U.cs * 128 : (long)U.b * SEQ + U.t0; return U; }
}
__device__ __forceinline__ void ret_r1_unit(const Ctx& F, int layer, int un) {
    using namespace ret2;
    PP P = getpp(); unsigned char* ws = P->ws;
    const bf16_t* u = (const bf16_t*)(ws + D_URET); bf16_t* kv = (bf16_t*)(ws + D_KV);
    const float* cr = (const float*)(ws + WS_ROPE_R); const float* sr = cr + 4096 * 32;
    const UnitPos U = unit_pos(un);
    const float lgf = -__expf(P->in[I_RDEC][(layer * 2 + 0) * 4 + U.h]) * 1.4426950408889634f, lgb = -__expf(P->in[I_RDEC][(layer * 2 + 1) * 4 + U.h]) * 1.4426950408889634f;
    LAS bf16_t* Vt = (LAS bf16_t*)F.lds; LAS bf16_t* kzf = Vt + 128 * VP; LAS bf16_t* kzb = kzf + 128 * QP; LAS bf16_t* St = kzb + 128 * QP;
    const int tid = F.tid, lane = F.lane, w = F.wave;
    {
        const int tk = tid >> 2, pc = tid & 3; float k1[8], k2[8], a[8], c[8];
        u32x4 vv[4], kr[2]; f32x4 rc[2], rs[2];
#pragma unroll
        for (int k4 = 0; k4 < 4; ++k4) { const int it = tid + 512 * k4, tv = it >> 4, ch = it & 15; vv[k4] = *(const u32x4*)(u + (U.rbase + tv) * REC + 512 + U.h * 128 + ch * 8); }
        { const bf16_t* kp = u + (U.rbase + tk) * REC + 256 + U.h * 64 + pc * 8; kr[0] = *(const u32x4*)kp; kr[1] = *(const u32x4*)(kp + 32);
          const int ro = (U.t0 + tk) * 32 + pc * 8; rc[0] = *(const f32x4*)(cr + ro); rc[1] = *(const f32x4*)(cr + ro + 4); rs[0] = *(const f32x4*)(sr + ro); rs[1] = *(const f32x4*)(sr + ro + 4); }
        __builtin_amdgcn_sched_barrier(0);
        unpack8(kr[0], k1); unpack8(kr[1], k2);
#pragma unroll
        for (int j = 0; j < 8; ++j) { const float cs = U.isctx ? 1.0f : rc[j >> 2][j & 3], sn = U.isctx ? 0.0f : rs[j >> 2][j & 3];
            const float ka_ = k1[j] * cs - k2[j] * sn, kb_ = k1[j] * sn + k2[j] * cs; k1[j] = ka_; k2[j] = kb_; }
        const float zf = 0.125f * __builtin_amdgcn_exp2f((float)(127 - tk) * lgf), zb = 0.125f * __builtin_amdgcn_exp2f((float)tk * lgb);
#pragma unroll
        for (int j = 0; j < 8; ++j) { a[j] = k1[j] * zf; c[j] = k2[j] * zf; }
        *(LAS u32x4*)(kzf + tk * QP + pc * 8) = pack8(a); *(LAS u32x4*)(kzf + tk * QP + 32 + pc * 8) = pack8(c);
#pragma unroll
        for (int j = 0; j < 8; ++j) { a[j] = k1[j] * zb; c[j] = k2[j] * zb; }
        *(LAS u32x4*)(kzb + tk * QP + pc * 8) = pack8(a); *(LAS u32x4*)(kzb + tk * QP + 32 + pc * 8) = pack8(c);
#pragma unroll
        for (int k4 = 0; k4 < 4; ++k4) { const int it = tid + 512 * k4, tv = it >> 4, ch = it & 15; *(LAS u32x4*)(Vt + tv * VP + ch * 8) = vv[k4]; }
    }
    __syncthreads();
    {
        const int fr = lane & 15, fq = lane >> 4;
        f32x4 acc[2][4];
#pragma unroll
        for (int dd = 0; dd < 2; ++dd)
#pragma unroll
            for (int tj = 0; tj < 4; ++tj) acc[dd][tj] = (f32x4){0.f, 0.f, 0.f, 0.f};
#pragma unroll
        for (int ks = 0; ks < 4; ++ks) { const bf16x8 a = tr8(Vt, VP, 32 * ks, 16 * w, lane);
#pragma unroll
            for (int tj = 0; tj < 4; ++tj) { acc[0][tj] = mm32(a, tr8(kzf, QP, 32 * ks, 16 * tj, lane), acc[0][tj]); acc[1][tj] = mm32(a, tr8(kzb, QP, 32 * ks, 16 * tj, lane), acc[1][tj]); } }
#pragma unroll
        for (int dd = 0; dd < 2; ++dd)
#pragma unroll
            for (int tj = 0; tj < 4; ++tj)
#pragma unroll
                for (int j = 0; j < 4; ++j) St[dd * 128 * QP + (16 * w + 4 * fq + j) * QP + 16 * tj + fr] = (bf16_t)f2bf(acc[dd][tj][j]);
    }
    __syncthreads();
#pragma unroll
    for (int k4 = 0; k4 < 4; ++k4) { const int it = tid + 512 * k4, dd = it >> 10, e = (it >> 3) & 127, ch = it & 7;
        *(u32x4*)(kv + ((size_t)un * 2 + dd) * 8192 + e * 64 + ch * 8) = *(const LAS u32x4*)(St + dd * 128 * QP + e * QP + ch * 8); }
    __syncthreads();
}
__device__ __forceinline__ void ret_r2(const Ctx& F, int layer, int b0, int nb) {
    using namespace ret2;
    PP P = getpp(); bf16_t* kv = (bf16_t*)(P->ws + D_KV);
    for (int item = (F.bid - b0) * NTHREADS + F.tid; item < 65536; item += nb * NTHREADS) {
        const int bh = item >> 11, dd = (item >> 10) & 1, off = (item & 1023) * 8;
        const float g = __builtin_amdgcn_exp2f(-128.0f * __expf(P->in[I_RDEC][(layer * 2 + dd) * 4 + (bh & 3)]) * 1.4426950408889634f);
        float st[8];
#pragma unroll
        for (int j = 0; j < 8; ++j) st[j] = 0.f;
#pragma unroll
        for (int half = 0; half < 2; ++half) {
            asm volatile("" ::: "memory");
            u32x4 xv[17];
#pragma unroll
            for (int q = 0; q < 17; ++q) { const int i = half * 17 + q; const int cs = dd ? (i < 2 ? 1 - i : 35 - i) : i;
                xv[q] = *(const u32x4*)(kv + ((size_t)(bh * 34 + cs) * 2 + dd) * 8192 + off); }
#pragma unroll
            for (int q = 0; q < 17; ++q) { const int i = half * 17 + q; const int cs = dd ? (i < 2 ? 1 - i : 35 - i) : i;
                float x[8]; unpack8(xv[q], x);
                *(u32x4*)(kv + ((size_t)(bh * 34 + cs) * 2 + dd) * 8192 + off) = pack8(st);
#pragma unroll
                for (int j = 0; j < 8; ++j) st[j] = st[j] * g + x[j]; }
        }
    }
}
__device__ __forceinline__ void ret_r3_unit(const Ctx& F, int layer, int un) {
    using namespace ret2;
    PP P = getpp(); unsigned char* ws = P->ws;
    const bf16_t* u = (const bf16_t*)(ws + D_URET); const bf16_t* kv = (const bf16_t*)(ws + D_KV); bf16_t* y = (bf16_t*)(ws + D_YRET);
    const float* cr = (const float*)(ws + WS_ROPE_R); const float* sr = cr + 4096 * 32;
    const UnitPos U = unit_pos(un);
    const float* lng = P->in[I_RLNG] + layer * 512 + U.h * 128; const float* lnb = P->in[I_RLNB] + layer * 512 + U.h * 128;
    const float lgf = -__expf(P->in[I_RDEC][(layer * 2 + 0) * 4 + U.h]) * 1.4426950408889634f, lgb = -__expf(P->in[I_RDEC][(layer * 2 + 1) * 4 + U.h]) * 1.4426950408889634f;
    LAS bf16_t* qf = (LAS bf16_t*)F.lds; LAS bf16_t* qb = qf + 128 * QP; LAS bf16_t* qn = qb + 128 * QP; LAS bf16_t* ks = qn + 128 * QP; LAS bf16_t* Sm = qn;
    LAS bf16_t* Vt = (LAS bf16_t*)(F.lds + 73728); LAS bf16_t* Rf = (LAS bf16_t*)(F.lds + 108544); LAS bf16_t* Rb = Rf + 128 * QP; LAS bf16_t* Yst = qf;
    const int tid = F.tid, lane = F.lane, w = F.wave, fr = lane & 15, fq = lane >> 4;
    const int n0 = 16 * w;
    u32x4 vv[4], rr[4], gq[4]; float lgv[8], lbv[8];
#pragma unroll
    for (int k4 = 0; k4 < 4; ++k4) { const int it = tid + 512 * k4, tv = it >> 4, ch = it & 15; vv[k4] = *(const u32x4*)(u + (U.rbase + tv) * REC + 512 + U.h * 128 + ch * 8); }
#pragma unroll
    for (int k4 = 0; k4 < 4; ++k4) { const int it = tid + 512 * k4, dd = it >> 10, e = (it >> 3) & 127, ch = it & 7; rr[k4] = *(const u32x4*)(kv + ((size_t)un * 2 + dd) * 8192 + e * 64 + ch * 8); }
#pragma unroll
    for (int k4 = 0; k4 < 4; ++k4) { const int it = lane + 64 * k4, r = it >> 4, ch = it & 15; gq[k4] = *(const u32x4*)(u + (U.rbase + n0 + r) * REC + 1024 + U.h * 128 + ch * 8); }
#pragma unroll
    for (int te = 0; te < 8; ++te) { lgv[te] = lng[16 * te + fr]; lbv[te] = lnb[16 * te + fr]; }
    const int tk = tid >> 2, pc = tid & 3;
    u32x4 qr[2], kr[2]; f32x4 rc[2], rs[2];
    { const bf16_t* qp = u + (U.rbase + tk) * REC + U.h * 64 + pc * 8; qr[0] = *(const u32x4*)qp; qr[1] = *(const u32x4*)(qp + 32); kr[0] = *(const u32x4*)(qp + 256); kr[1] = *(const u32x4*)(qp + 288);
      const int ro = (U.t0 + tk) * 32 + pc * 8; rc[0] = *(const f32x4*)(cr + ro); rc[1] = *(const f32x4*)(cr + ro + 4); rs[0] = *(const f32x4*)(sr + ro); rs[1] = *(const f32x4*)(sr + ro + 4); }
    __builtin_amdgcn_sched_barrier(0);
    {
        float q1[8], q2[8], k1[8], k2[8], a[8], c[8];
        unpack8(qr[0], q1); unpack8(qr[1], q2); unpack8(kr[0], k1); unpack8(kr[1], k2);
#pragma unroll
        for (int j = 0; j < 8; ++j) { const float cs = U.isctx ? 1.0f : rc[j >> 2][j & 3], sn = U.isctx ? 0.0f : rs[j >> 2][j & 3];
            const float qa_ = q1[j] * cs - q2[j] * sn, qb_ = q1[j] * sn + q2[j] * cs, ka_ = k1[j] * cs - k2[j] * sn, kb_ = k1[j] * sn + k2[j] * cs;
            q1[j] = qa_; q2[j] = qb_; k1[j] = ka_; k2[j] = kb_; }
        *(LAS u32x4*)(qn + tk * QP + pc * 8) = pack8(q1); *(LAS u32x4*)(qn + tk * QP + 32 + pc * 8) = pack8(q2);
        const float xf = __builtin_amdgcn_exp2f((float)(tk + 1) * lgf), xb = __builtin_amdgcn_exp2f((float)(128 - tk) * lgb);
#pragma unroll
        for (int j = 0; j < 8; ++j) { a[j] = q1[j] * xf; c[j] = q2[j] * xf; }
        *(LAS u32x4*)(qf + tk * QP + pc * 8) = pack8(a); *(LAS u32x4*)(qf + tk * QP + 32 + pc * 8) = pack8(c);
#pragma unroll
        for (int j = 0; j < 8; ++j) { a[j] = q1[j] * xb; c[j] = q2[j] * xb; }
        *(LAS u32x4*)(qb + tk * QP + pc * 8) = pack8(a); *(LAS u32x4*)(qb + tk * QP + 32 + pc * 8) = pack8(c);
#pragma unroll
        for (int j = 0; j < 8; ++j) { a[j] = k1[j] * 0.125f; c[j] = k2[j] * 0.125f; }
        *(LAS u32x4*)(ks + tk * QP + pc * 8) = pack8(a); *(LAS u32x4*)(ks + tk * QP + 32 + pc * 8) = pack8(c);
#pragma unroll
        for (int k4 = 0; k4 < 4; ++k4) { const int it = tid + 512 * k4, tv = it >> 4, ch = it & 15; *(LAS u32x4*)(Vt + tv * VP + ch * 8) = vv[k4]; }
#pragma unroll
        for (int k4 = 0; k4 < 4; ++k4) { const int it = tid + 512 * k4, dd = it >> 10, e = (it >> 3) & 127, ch = it & 7; *(LAS u32x4*)((dd ? Rb : Rf) + e * QP + ch * 8) = rr[k4]; }
    }
    __syncthreads();
    f32x4 ST[8];
    {
        bf16x8 qa[2];
#pragma unroll
        for (int k2 = 0; k2 < 2; ++k2) qa[k2] = *(const LAS bf16x8*)(qn + (n0 + fr) * QP + k2 * 32 + fq * 8);
#pragma unroll
        for (int tm = 0; tm < 8; ++tm) { ST[tm] = (f32x4){0.f, 0.f, 0.f, 0.f};
#pragma unroll
            for (int k2 = 0; k2 < 2; ++k2) ST[tm] = mm32(*(const LAS bf16x8*)(ks + (16 * tm + fr) * QP + k2 * 32 + fq * 8), qa[k2], ST[tm]); }
    }
    s16x4 cst[8];
#pragma unroll
    for (int tm = 0; tm < 8; ++tm) { f32x4 t;
#pragma unroll
        for (int j = 0; j < 4; ++j) { const int n = n0 + fr, m = 16 * tm + 4 * fq + j; const int dd = n - m;
            const float ex = __builtin_amdgcn_exp2f((float)(dd < 0 ? -dd : dd) * (dd > 0 ? lgf : lgb));
            t[j] = ST[tm][j] * ((dd == 0) ? 2.0f : ex); }
        u32x2 pw; pw.x = pk2(t[0], t[1]); pw.y = pk2(t[2], t[3]); cst[tm] = __builtin_bit_cast(s16x4, pw); }
    f32x4 Y[8];
#pragma unroll
    for (int te = 0; te < 8; ++te) Y[te] = (f32x4){0.f, 0.f, 0.f, 0.f};
    {
        const int g = lane >> 4, i = lane & 15, q = i >> 2, pp = i & 3;
#pragma unroll
        for (int p = 0; p < 4; ++p) { const bf16x8 a = (bf16x8){cst[2 * p][0], cst[2 * p][1], cst[2 * p][2], cst[2 * p][3], cst[2 * p + 1][0], cst[2 * p + 1][1], cst[2 * p + 1][2], cst[2 * p + 1][3]};
#pragma unroll
            for (int te = 0; te < 8; ++te) {
                const LAS bf16_t* va = Vt + (32 * p + 4 * g + q) * VP + 16 * te + 4 * pp;
                const s16x4 lo = __builtin_bit_cast(s16x4, __builtin_amdgcn_ds_read_tr16_b64_v4i16((LAS v4i16_t*)va));
                const s16x4 hi = __builtin_bit_cast(s16x4, __builtin_amdgcn_ds_read_tr16_b64_v4i16((LAS v4i16_t*)(va + 16 * VP)));
                Y[te] = mm32(a, (bf16x8){lo[0], lo[1], lo[2], lo[3], hi[0], hi[1], hi[2], hi[3]}, Y[te]); } }
    }
#pragma unroll
    for (int k2 = 0; k2 < 2; ++k2) { const bf16x8 af = *(const LAS bf16x8*)(qf + (n0 + fr) * QP + k2 * 32 + fq * 8), ab = *(const LAS bf16x8*)(qb + (n0 + fr) * QP + k2 * 32 + fq * 8);
#pragma unroll
        for (int te = 0; te < 8; ++te) { Y[te] = mm32(af, *(const LAS bf16x8*)(Rf + (16 * te + fr) * QP + k2 * 32 + fq * 8), Y[te]); Y[te] = mm32(ab, *(const LAS bf16x8*)(Rb + (16 * te + fr) * QP + k2 * 32 + fq * 8), Y[te]); } }
    __syncthreads();
#pragma unroll
    for (int j = 0; j < 4; ++j) { float s = 0.f;
#pragma unroll
        for (int te = 0; te < 8; ++te) s += Y[te][j];
        s += shx(s, 1, lane); s += shx(s, 2, lane); s += shx(s, 4, lane); s += shx(s, 8, lane);
        const float mean = s * (1.0f / 128.0f); float vs = 0.f;
#pragma unroll
        for (int te = 0; te < 8; ++te) { const float dd = Y[te][j] - mean; vs += dd * dd; }
        vs += shx(vs, 1, lane); vs += shx(vs, 2, lane); vs += shx(vs, 4, lane); vs += shx(vs, 8, lane);
        const float rstd = rsqrtf(vs * (1.0f / 128.0f) + 1e-5f);
        const int r = 4 * fq + j; LAS bf16_t* yst = (r < 8 ? qf + n0 * QP + r * VP : qb + n0 * QP + (r - 8) * VP);
#pragma unroll
        for (int te = 0; te < 8; ++te) { const int e = 16 * te + fr; yst[e] = (bf16_t)f2bf((Y[te][j] - mean) * rstd * lgv[te] + lbv[te]); } }
    __syncthreads();
#pragma unroll
    for (int k4 = 0; k4 < 4; ++k4) { const int it = lane + 64 * k4, r = it >> 4, ch = it & 15; const long row = U.rbase + n0 + r;
        const LAS bf16_t* yst = (r < 8 ? qf + n0 * QP + r * VP : qb + n0 * QP + (r - 8) * VP);
        float yv[8], gv[8]; unpack8(*(const LAS u32x4*)(yst + ch * 8), yv); unpack8(gq[k4], gv);
#pragma unroll
        for (int j = 0; j < 8; ++j) yv[j] *= siluf_(gv[j]);
        *(u32x4*)(y + row * 512 + U.h * 128 + ch * 8) = pack8(yv); }
    __syncthreads();
}
__device__ __forceinline__ void ret_r3_phase(const Ctx& F, int layer) {
    for (int un = F.bid; un < ret2::NUNITS; un += F.G) { if (layer != 0 && (un % 34) < 2) continue; ret_r3_unit(F, layer, un); }
}
__device__ __forceinline__ void ret_r1_phase(const Ctx& F, int layer) { for (int un = F.bid; un < ret2::NUNITS; un += F.G) ret_r1_unit(F, layer, un); }
__device__ __forceinline__ void rw_phase(const Ctx& F, int layer) {
    unsigned char* ws = getpp()->ws;
    if (F.G >= 160) {
        if (F.bid < 128) rwkv_chain4(F, layer, F.bid >> 4, (F.bid >> 1) & 7, F.bid & 1);
        unsigned* ctr = (unsigned*)(ws + WS_CTL) + 192 + 64 * layer; LAS unsigned* bc = (LAS unsigned*)(F.lds + LDS_BYTES - 32);
        for (;;) {
            __syncthreads();
            if (F.tid == 0) *bc = __hip_atomic_fetch_add(ctr, 1u, __ATOMIC_RELAXED, __HIP_MEMORY_SCOPE_AGENT);
            __syncthreads();
            const unsigned u = *bc; if (u >= 512u) break;
            const int bh = (int)u >> 4; attn_latent_unit(F, ws, half_a_base(layer), bh >> 3, bh & 7, (int)u & 15);
        }
    } else {
        for (int un = F.bid; un < 128; un += F.G) { rwkv_chain4(F, layer, un >> 4, (un >> 1) & 7, un & 1); __syncthreads(); }
        for (int u = F.bid; u < 512; u += F.G) { const int bh = u >> 4; attn_latent_unit(F, ws, half_a_base(layer), bh >> 3, bh & 7, u & 15); }
    }
}

template <int NB> __device__ __forceinline__ void rows_norm(int lane, const float* hbase, const int* rows, const float* gain, const float* mod, f32x4 (*y)[4]) {
    float ss[NB];
#pragma unroll
    for (int b = 0; b < NB; ++b) { const float* src = hbase + (size_t)rows[b] * 1024; ss[b] = 0.f;
#pragma unroll
        for (int j = 0; j < 4; ++j) { y[b][j] = *(const f32x4*)(src + 4 * lane + 256 * j); ss[b] += y[b][j].x * y[b][j].x + y[b][j].y * y[b][j].y + y[b][j].z * y[b][j].z + y[b][j].w * y[b][j].w; } }
#pragma unroll
    for (int b = 0; b < NB; ++b) ss[b] = wave_sum(ss[b], lane);
#pragma unroll
    for (int b = 0; b < NB; ++b) { const float rstd = rsqrtf(ss[b] * (1.0f / 1024.0f) + 1e-6f); const float* sh = mod + (rows[b] >> 12) * 6144; const float* sc = sh + 1024;
#pragma unroll
        for (int j = 0; j < 4; ++j) { const int c = 4 * lane + 256 * j; y[b][j] = y[b][j] * rstd * *(const f32x4*)(gain + c) * (*(const f32x4*)(sc + c) + 1.0f) + *(const f32x4*)(sh + c); } }
}
__device__ __forceinline__ void moe_route_pass(const Ctx& F, int layer) {
    PP P = getpp(); unsigned char* ws = P->ws;
    const float* gain = P->in[I_NFFN] + layer * 1024; const float* mod = (const float*)(ws + WS_MOD) + (size_t)layer * 9 * 6144 + 3072;
    const float* router = P->in[I_ROUTER];
    unsigned* cnt = (unsigned*)(ws + WS_CTL); int* route = (int*)(ws + WS_ROUTE);
    LAS float* rl = (LAS float*)F.lds;
    LAS unsigned* lc = (LAS unsigned*)(F.lds + 32768);
    for (int i = F.tid; i < 8192; i += NTHREADS) rl[(i & 7) * 1024 + (i >> 3)] = router[i];
    if (F.tid < 16) lc[F.tid] = 0u;
    __syncthreads();
    const int rpb = (RL + F.G - 1) / F.G, rpw = (rpb + 7) / 8;
    const int b0 = F.bid * rpb, b1 = (b0 + rpb < RL) ? b0 + rpb : RL;
    const int r0 = b0 + F.wave * rpw, r1 = (r0 + rpw < b1) ? r0 + rpw : b1;
    constexpr int NB = 2;
    for (int rb = r0; rb < r1; rb += NB) {
        int lane = F.lane; asm volatile("" : "+v"(lane));
        int rows[NB]; f32x4 y[NB][4];
#pragma unroll
        for (int b = 0; b < NB; ++b) rows[b] = (rb + b < r1) ? rb + b : r1 - 1;
        rows_norm<NB>(lane, P->out, rows, gain, mod, y);
        float lg[NB][8];
#pragma unroll
        for (int b = 0; b < NB; ++b)
#pragma unroll
            for (int e = 0; e < 8; ++e) lg[b][e] = 0.f;
#pragma unroll
        for (int j = 0; j < 4; ++j)
#pragma unroll
            for (int e = 0; e < 8; ++e) { const f32x4 r4 = *(const LAS f32x4*)(rl + e * 1024 + 4 * lane + 256 * j);
#pragma unroll
                for (int b = 0; b < NB; ++b) lg[b][e] += y[b][j][0] * r4[0] + y[b][j][1] * r4[1] + y[b][j][2] * r4[2] + y[b][j][3] * r4[3]; }
#pragma unroll
        for (int b = 0; b < NB; ++b)
#pragma unroll
            for (int e = 0; e < 8; ++e) lg[b][e] = wave_sum(lg[b][e], lane);
        if (lane == 0) {
#pragma unroll
            for (int b = 0; b < NB; ++b) if (rb + b < r1) {
                int i0 = 0; float v0 = lg[b][0];
#pragma unroll
                for (int e = 1; e < 8; ++e) if (lg[b][e] > v0) { v0 = lg[b][e]; i0 = e; }
                int i1 = -1; float v1 = -3.0e38f;
#pragma unroll
                for (int e = 0; e < 8; ++e) if (e != i0 && lg[b][e] > v1) { v1 = lg[b][e]; i1 = e; }
                const float w0 = 1.0f / (1.0f + __expf(v1 - v0)), w1 = 1.0f - w0;
                const unsigned p0 = __hip_atomic_fetch_add(&lc[i0], 1u, __ATOMIC_RELAXED, __HIP_MEMORY_SCOPE_WORKGROUP), p1 = __hip_atomic_fetch_add(&lc[i1], 1u, __ATOMIC_RELAXED, __HIP_MEMORY_SCOPE_WORKGROUP);
                int* r = route + (size_t)rows[b] * 8; r[0] = i0; r[1] = i1; r[2] = __float_as_int(w0); r[3] = __float_as_int(w1); r[4] = (int)p0; r[5] = (int)p1;
            }
        }
    }
    __syncthreads();
    if (F.tid < 8) lc[8 + F.tid] = atomicAdd(&cnt[F.tid], lc[F.tid]);
    __syncthreads();
    for (int row = r0 + F.lane; row < r1; row += 64) { int* r = route + (size_t)row * 8; const int e0 = r[0], e1 = r[1], p0 = r[4], p1 = r[5]; r[4] = p0 + (int)lc[8 + e0]; r[5] = p1 + (int)lc[8 + e1]; }
    __syncthreads();
}
__device__ __forceinline__ void moe_gather_pass(const Ctx& F, int layer) {
    PP P = getpp(); unsigned char* ws = P->ws;
    const float* gain = P->in[I_NFFN] + layer * 1024; const float* mod = (const float*)(ws + WS_MOD) + (size_t)layer * 9 * 6144 + 3072;
    const unsigned* cnt = (const unsigned*)(ws + WS_CTL); const int* route = (const int*)(ws + WS_ROUTE);
    bf16_t* xlo = (bf16_t*)(ws + D_XG); bf16_t* xhi = xlo + (size_t)RG * 512;
    const MoeTiles T = moe_tiles(cnt);
    const int rpw = (RL + NGW(F) - 1) / NGW(F); const int r0 = GW(F) * rpw; const int r1 = (r0 + rpw < RL) ? r0 + rpw : RL;
    constexpr int NB = 2;
    for (int rb = r0; rb < r1; rb += NB) {
        int lane = F.lane; asm volatile("" : "+v"(lane));
        int rows[NB]; f32x4 y[NB][4];
#pragma unroll
        for (int b = 0; b < NB; ++b) rows[b] = (rb + b < r1) ? rb + b : r1 - 1;
        rows_norm<NB>(lane, P->out, rows, gain, mod, y);
#pragma unroll
        for (int b = 0; b < NB; ++b) {
            const int* r = route + (size_t)rows[b] * 8; const int e0 = r[0], e1 = r[1];
            int t0 = 0, t1 = 0;
#pragma unroll
            for (int e = 0; e < 8; ++e) { if (e == e0) t0 = T.tstart[e]; if (e == e1) t1 = T.tstart[e]; }
            const size_t s0 = (size_t)t0 * 256 + r[4], s1 = (size_t)t1 * 256 + r[5];
#pragma unroll
            for (int j = 0; j < 4; ++j) { const int c = 4 * lane + 256 * j; u32x2 o; o.x = pk2(y[b][j].x, y[b][j].y); o.y = pk2(y[b][j].z, y[b][j].w);
                bf16_t* bp = (c < 512) ? xlo + c : xhi + (c - 512);
                *(u32x2*)(bp + s0 * 512) = o; *(u32x2*)(bp + s1 * 512) = o; } }
    }
}
__device__ __forceinline__ void moe_final_pass(const Ctx& F, int layer) {
    PP P = getpp(); unsigned char* ws = P->ws;
    const float* mod = (const float*)(ws + WS_MOD) + (size_t)layer * 9 * 6144 + 5120;
    const unsigned* cnt = (const unsigned*)(ws + WS_CTL); const int* route = (const int*)(ws + WS_ROUTE);
    const bf16_t* ym = (const bf16_t*)(ws + D_XG); const float* fn = P->in[I_FNORM];
    const MoeTiles T = moe_tiles(cnt);
    const int rpw = (RL + NGW(F) - 1) / NGW(F); const int r0 = GW(F) * rpw; const int r1 = (r0 + rpw < RL) ? r0 + rpw : RL;
    constexpr int NB = 2;
    for (int rb = r0; rb < r1; rb += NB) {
        int lane = F.lane; asm volatile("" : "+v"(lane));
        f32x4 v[NB][4]; float ss[NB]; int rows[NB];
#pragma unroll
        for (int b = 0; b < NB; ++b) { const int row = (rb + b < r1) ? rb + b : r1 - 1; rows[b] = row;
            const int* r = route + (size_t)row * 8; const int e0 = r[0], e1 = r[1]; const float w0 = __int_as_float(r[2]), w1 = __int_as_float(r[3]);
            int t0 = 0, t1 = 0;
#pragma unroll
            for (int e = 0; e < 8; ++e) { if (e == e0) t0 = T.tstart[e]; if (e == e1) t1 = T.tstart[e]; }
            const size_t s0 = (size_t)t0 * 256 + r[4], s1 = (size_t)t1 * 256 + r[5];
            const float* g = mod + (row >> 12) * 6144; const float* hp = P->out + (size_t)row * 1024; ss[b] = 0.f;
#pragma unroll
            for (int j = 0; j < 4; ++j) { const int c = 4 * lane + 256 * j; const u32x2 a = *(const u32x2*)(ym + s0 * 1024 + c), bq = *(const u32x2*)(ym + s1 * 1024 + c);
                const f32x4 ya = {bflo(a.x), bfhi(a.x), bflo(a.y), bfhi(a.y)}, yb = {bflo(bq.x), bfhi(bq.x), bflo(bq.y), bfhi(bq.y)};
                v[b][j] = *(const f32x4*)(hp + c) + *(const f32x4*)(g + c) * (ya * w0 + yb * w1);
                ss[b] += v[b][j].x * v[b][j].x + v[b][j].y * v[b][j].y + v[b][j].z * v[b][j].z + v[b][j].w * v[b][j].w; } }
#pragma unroll
        for (int b = 0; b < NB; ++b) ss[b] = wave_sum(ss[b], lane);
#pragma unroll
        for (int b = 0; b < NB; ++b) { const float rstd = rsqrtf(ss[b] * (1.0f / 1024.0f) + 1e-6f); float* hp = P->out + (size_t)rows[b] * 1024;
#pragma unroll
            for (int j = 0; j < 4; ++j) { const int c = 4 * lane + 256 * j; *(f32x4*)(hp + c) = v[b][j] * rstd * *(const f32x4*)(fn + c); } }
    }
}

#define XB_TMO      128
#define XB_XCNT(j)  (256  + 64 * (j))
#define XB_XSUB(j)  (1280 + 64 * (j))
#define XB_XGEN(j)  (2304 + 64 * (j))
#define XB_TOP      3328
#define XB_TOPGEN   3392
#define XCD_BAR_WORDS 3456
#define XB_SPIN_CAP (1u << 18)
constexpr int CW_BAR = 4096;
constexpr int LDS_BARST = LDS_BYTES - 16;
__device__ __forceinline__ unsigned xb_ld(unsigned* p)              { return __hip_atomic_load(p, __ATOMIC_RELAXED, __HIP_MEMORY_SCOPE_AGENT); }
__device__ __forceinline__ unsigned xb_add(unsigned* p, unsigned v) { return __hip_atomic_fetch_add(p, v, __ATOMIC_RELAXED, __HIP_MEMORY_SCOPE_AGENT); }
__device__ __forceinline__ unsigned xb_xcc_id() { return (unsigned)__builtin_amdgcn_s_getreg((3 << 11) | 20) & 0xFu; }
#define XB_SPIN(cond, bar) do { unsigned _sp = 0; while (cond) { __builtin_amdgcn_s_sleep(1); \
    if ((++_sp & 255u) == 0u) { if (xb_ld(&(bar)[XB_TMO])) break; if (_sp > XB_SPIN_CAP) { atomicAdd(&(bar)[XB_TMO], 1u); break; } } } } while (0)
__device__ __forceinline__ void xcd_barrier_complete(unsigned* bar, unsigned x, unsigned& nloc, unsigned& nx) {
    const unsigned G = gridDim.x * gridDim.y * gridDim.z;
    unsigned sum, cnt, mine, sp = 0u;
    for (;;) {
        sum = 0u; cnt = 0u; mine = 0u;
#pragma unroll
        for (unsigned j = 0; j < 16; ++j) { const unsigned c = xb_ld(&bar[XB_XCNT(j)]); sum += c; cnt += (c > 0u) ? 1u : 0u; mine = (j == x) ? c : mine; }
        if (sum == G) break;
        __builtin_amdgcn_s_sleep(1);
        if ((++sp & 255u) == 0u) { if (xb_ld(&bar[XB_TMO])) break; if (sp > XB_SPIN_CAP) { atomicAdd(&bar[XB_TMO], 1u); break; } }
    }
    nloc = mine > 0u ? mine : 1u; nx = cnt > 0u ? cnt : 1u;
}
__device__ __forceinline__ void xcd_barrier(LAS unsigned char* lds) {
    asm volatile("s_waitcnt vmcnt(0)" ::: "memory");
    __syncthreads();
    if (threadIdx.x == 0) {
        unsigned* bar = (unsigned*)(getpp()->ws + WS_CTL) + CW_BAR;
        volatile LAS unsigned* st = (volatile LAS unsigned*)(lds + LDS_BARST);
        const unsigned x = xb_xcc_id();
        __builtin_amdgcn_s_waitcnt(0);
        unsigned nloc = st[0], nx = st[1];
        if (nloc == 0u) { xcd_barrier_complete(bar, x, nloc, nx); st[0] = nloc; st[1] = nx; }
        const unsigned old = xb_add(&bar[XB_XSUB(x)], 1u);
        const unsigned gen = old / nloc;
        if (old + 1u == (gen + 1u) * nloc) {
            __builtin_amdgcn_fence(__ATOMIC_RELEASE, "agent");
            asm volatile("s_waitcnt vmcnt(0)" ::: "memory");
            const unsigned og = xb_add(&bar[XB_TOP], 1u);
            const unsigned tg = og / nx;
            if (og + 1u == (tg + 1u) * nx) xb_add(&bar[XB_TOPGEN], 1u);
            else XB_SPIN(xb_ld(&bar[XB_TOPGEN]) == tg, bar);
            __builtin_amdgcn_fence(__ATOMIC_ACQUIRE, "agent");
            xb_add(&bar[XB_XGEN(x)], 1u);
            asm volatile("s_waitcnt vmcnt(0)" ::: "memory");
        } else {
            XB_SPIN(xb_ld(&bar[XB_XGEN(x)]) == gen, bar);
            __builtin_amdgcn_fence(__ATOMIC_ACQUIRE, "agent");
            asm volatile("s_waitcnt vmcnt(0)" ::: "memory");
        }
    }
    __syncthreads();
}
#define FRESH() do { int t_ = threadIdx.x; asm volatile("" : "+v"(t_)); F.tid = t_; F.lane = t_ & 63; F.wave = __builtin_amdgcn_readfirstlane(t_ >> 6); \
    int g_ = gridDim.x, b_ = blockIdx.x; asm volatile("" : "+s"(g_), "+s"(b_)); F.G = g_; F.bid = b_; } while (0)
#define PHASE_VARS FRESH(); const int G = F.G, c = F.bid; (void)G; (void)c; PP P = getpp(); unsigned char* ws = P->ws; const bool L0 = (layer == 0); \
    const float* hl = L0 ? P->in[I_X] : P->out; const float* hcx = L0 ? P->in[I_CTX] : (const float*)(ws + WS_HC); float* hc = (float*)(ws + WS_HC); \
    const char* wl = (const char*)(ws + WS_W + (size_t)layer * WL_STRIDE); const float* mod = (const float*)(ws + WS_MOD) + (size_t)layer * 9 * 6144; \
    const int nMm = L0 ? RT / 256 : RL / 256; (void)hl; (void)hcx; (void)hc; (void)wl; (void)mod; (void)nMm;

template <int layer> __device__ __forceinline__ void layer_fwd(Ctx& F, cg::grid_group& grid) {

        { PHASE_VARS norm_pass(F, layer, 0, hl, hcx, RT, (bf16_t*)(ws + D_XN1), (bf16_t*)(ws + D_XN1 + Y34), layer != 0); }
        xcd_barrier(F.lds);
        { PHASE_VARS SchedSplit2 S{(const char*)(ws + D_XN1), (const char*)(ws + D_XN1 + Y34), wl + WL_WINLO, wl + WL_WINHI, RT / 256, MIXP / 256, G, c, true};
          EpiInproj E{ws};
          pg8::gemm_phase<512, 512, true>(F.lds, S, E); }
        xcd_barrier(F.lds);
        FRESH(); ctx_krope_proj(F, layer);
        FRESH(); mla_stats_pass(F, 0, F.G * 8);
        FRESH(); ret_r1_phase(F, layer);
        xcd_barrier(F.lds);
        FRESH(); ret_r2(F, layer, 0, F.G);
        FRESH(); krope_pass(F, 0, layer);
        { PHASE_VARS SchedHalf S{(const char*)(ws + D_UMLA), wl + WL_WQ, (size_t)256 * MLC * 2, (size_t)256 * 384 * 2, 6, 3, 0, G, (c + G - 128 % G) % G};
          EpiQup E{(bf16_t*)(half_a_base(layer) + HA_Q), (const float*)(ws + WS_RSTD), (const float*)(ws + WS_ROPE_M), (const float*)(ws + WS_ROPE_M) + 4096 * 16, 1};
          pg8::gemm_phase<MLC, 384, false>(F.lds, S, E); }
        { PHASE_VARS SchedHalf S{(const char*)(ws + D_UMLA) + 384 * 2, wl + WL_WKV, (size_t)256 * MLC * 2, (size_t)256 * 256 * 2, 4, 4, 0, G, (c + G - 24 % G) % G};
          EpiKVup E{(bf16_t*)(half_a_base(layer) + HA_K), (bf16_t*)(half_a_base(layer) + HA_V), (const float*)(ws + WS_RSTD) + RT, 1};
          pg8::gemm_phase<MLC, 256, true>(F.lds, S, E); }
        xcd_barrier(F.lds);
        FRESH(); rw_phase(F, layer);
        xcd_barrier(F.lds);
        FRESH(); rwkv_post_phase(F, layer, layer == 0 ? RT : RL);
        xcd_barrier(F.lds);
        FRESH(); krope_pass(F, 1, layer);
        FRESH(); ret_r3_phase(F, layer);
        { PHASE_VARS SchedHalf S{(const char*)(ws + D_UMLA), wl + WL_WQ, (size_t)256 * MLC * 2, (size_t)256 * 384 * 2, 6, 3, 1, G, (c + G - 64 % G) % G};
          EpiQup E{(bf16_t*)(ws + D_Q), (const float*)(ws + WS_RSTD), (const float*)(ws + WS_ROPE_M), (const float*)(ws + WS_ROPE_M) + 4096 * 16, 0};
          pg8::gemm_phase<MLC, 384, false>(F.lds, S, E); }
        { PHASE_VARS SchedHalf S{(const char*)(ws + D_UMLA) + 384 * 2, wl + WL_WKV, (size_t)256 * MLC * 2, (size_t)256 * 256 * 2, 4, 4, 1, G, (c + G - 216 % G) % G};
          EpiKVup E{(bf16_t*)(ws + D_K), (bf16_t*)(ws + D_V), (const float*)(ws + WS_RSTD) + RT, 0};
          pg8::gemm_phase<MLC, 256, true>(F.lds, S, E); }
        xcd_barrier(F.lds);
        FRESH(); attn_phase(F, layer);
        xcd_barrier(F.lds);
        if (layer != 0) { { PHASE_VARS norm_pass(F, layer, 0, hl, hcx, nMm * 256, (bf16_t*)(ws + D_XN1), (bf16_t*)(ws + D_XN1 + Y34)); }
        xcd_barrier(F.lds); }
        { PHASE_VARS SchedMerge S; S.XNlo = (const char*)(ws + D_XN1); S.XNhi = (const char*)(ws + D_XN1 + Y34); S.WgLo = wl + WL_WGLO; S.WgHi = wl + WL_WGHI;
          S.wsb = (const char*)ws; S.Wb = wl + WL_WB; S.nM = nMm; S.G = G; S.c = c; S.ctx3 = L0 && G > 64;
          EpiMerge E{(u32x4*)(ws + D_SCR + (size_t)c * 131072), (bf16_t*)(ws + D_M), (bf16_t*)(ws + D_P12)};
          pg8::gemm_phase<512, 512, true>(F.lds, S, E); }
        xcd_barrier(F.lds);
        if (layer == 0 && F.G > 64) { PHASE_VARS SchedWout0 S{(const char*)(ws + D_M), wl + WL_WO, (const char*)ws, G, c};
          EpiResid E{hl, hcx, P->out, hc, mod, 2048, nullptr};
          pg8::gemm_phase<1024, 1024, false>(F.lds, S, E); }
        else { PHASE_VARS Sched1 S{(const char*)(ws + D_M), wl + WL_WO, (size_t)256 * 1024 * 2, (size_t)256 * 1024 * 2, 16, nMm, 4, G, c};
          EpiResid E{hl, hcx, P->out, hc, mod, 2048, nullptr};
          pg8::gemm_phase<1024, 1024, false>(F.lds, S, E); }
        xcd_barrier(F.lds);
        if (layer == 0) {
            { PHASE_VARS norm_pass(F, layer, 1, P->out, hc, RT, (bf16_t*)(ws + D_XN2), (bf16_t*)(ws + D_XN2 + Y34)); }
            FRESH(); convert_ffn0(F);
            xcd_barrier(F.lds);
            { PHASE_VARS SchedSplit2 S{(const char*)(ws + D_XN2), (const char*)(ws + D_XN2 + Y34), (const char*)(ws + D_FFW), (const char*)(ws + D_FFW) + (size_t)5632 * 1024, RT / 256, 22, G, c, false};
              EpiSwiglu E{(bf16_t*)(ws + D_H), DFF};
              pg8::gemm_phase<512, 512, true>(F.lds, S, E); }
            xcd_barrier(F.lds);
            { PHASE_VARS SchedDown0 S{(const char*)(ws + D_H), (const char*)(ws + D_FFW) + (size_t)2 * 5632 * 1024, G, c};
              EpiResid E{P->out, hc, P->out, hc, mod, 5120, (float*)(ws + D_PART)};
              pg8::gemm_phase<DFF, DFF, false>(F.lds, S, E); }
            xcd_barrier(F.lds);
        } else {
            FRESH(); moe_route_pass(F, layer);
            FRESH(); convert_moe(F);
            xcd_barrier(F.lds);
            FRESH(); moe_gather_pass(F, layer);
            xcd_barrier(F.lds);
            { PHASE_VARS const MoeTiles T = moe_tiles((const unsigned*)(ws + WS_CTL));
              SchedMoeUp S{(const char*)(ws + D_XG), (const char*)(ws + D_XG) + (size_t)RG * 1024, (const char*)(ws + D_MOEW), T, G, c};
              EpiSwiglu E{(bf16_t*)(ws + D_HM), DFE};
              pg8::gemm_phase<512, 512, true>(F.lds, S, E); }
            xcd_barrier(F.lds);
            { PHASE_VARS const MoeTiles T = moe_tiles((const unsigned*)(ws + WS_CTL));
              SchedMoeDown S{(const char*)(ws + D_HM), (const char*)(ws + D_MOEW), T, G, c};
              EpiBf16 E{(bf16_t*)(ws + D_XG), 1024};
              pg8::gemm_phase<DFE, DFE, true>(F.lds, S, E); }
            xcd_barrier(F.lds);
            FRESH(); moe_final_pass(F, layer);
        }
    }
#undef PHASE_VARS
#undef FRESH

__global__ void __launch_bounds__(NTHREADS, 2) mega_fwd(Params prm) {
    extern __shared__ __attribute__((aligned(16))) unsigned char lds_raw[];
    cg::grid_group grid = cg::this_grid();
    Ctx F; F.lds = (LAS unsigned char*)lds_raw; F.tid = threadIdx.x; F.lane = F.tid & 63; F.wave = __builtin_amdgcn_readfirstlane(F.tid >> 6); F.G = gridDim.x; F.bid = blockIdx.x;
    if (F.tid < 4) ((LAS unsigned*)(F.lds + LDS_BARST))[F.tid] = 0u;
    __syncthreads();
    if (F.tid == 0) (void)xb_add((unsigned*)(prm.ws + WS_CTL) + CW_BAR + XB_XCNT(xb_xcc_id()), 1u);
    phase0(F);
    grid.sync();
    layer_fwd<0>(F, grid);
    layer_fwd<1>(F, grid);
}

extern "C" void kernel_launch(void* const* d_in, const int* in_sizes, int n_in, void* d_out, int out_size, void* d_ws, size_t ws_size, hipStream_t stream) {
    static int grid_blocks = 0;
    if (grid_blocks == 0) {
        if (n_in != 37 || ws_size < WS_NEED) { fprintf(stderr, "kernel_launch: unexpected n_in %d / ws %zu\n", n_in, ws_size); grid_blocks = -1; return; }
        int dev = 0, cus = 0, per_cu = 0;
        hipGetDevice(&dev); hipDeviceGetAttribute(&cus, hipDeviceAttributeMultiprocessorCount, dev);
        hipFuncSetAttribute((const void*)mega_fwd, hipFuncAttributeMaxDynamicSharedMemorySize, LDS_BYTES);
        hipOccupancyMaxActiveBlocksPerMultiprocessor(&per_cu, (const void*)mega_fwd, NTHREADS, LDS_BYTES);
        if (per_cu < 1) { fprintf(stderr, "kernel_launch: occupancy query says %d blocks/CU\n", per_cu); per_cu = 1; }
        grid_blocks = cus;
        (void)hipGetLastError();
    }
    if (grid_blocks < 0) return;
    (void)hipMemsetAsync((char*)d_ws + WS_CTL, 0, 65536, stream);
    Params p{};
    for (int i = 0; i < 37; ++i) p.in[i] = (const float*)d_in[i];
    p.out = (float*)d_out; p.ws = (unsigned char*)d_ws;
    void* args[] = {&p};
    hipError_t e = hipLaunchCooperativeKernel((const void*)mega_fwd, dim3(grid_blocks), dim3(NTHREADS), args, LDS_BYTES, stream);
    if (e != hipSuccess) fprintf(stderr, "cooperative launch failed: %s (grid %d)\n", hipGetErrorString(e), grid_blocks);
}
```

```cpp
#include <hip/hip_runtime.h>
#include <hip/hip_cooperative_groups.h>
#include <cstdio>
#include <cstdint>
namespace cg = cooperative_groups;

#define LAS __attribute__((address_space(3)))
typedef unsigned short bf16_t;
typedef short bf16x8 __attribute__((ext_vector_type(8)));
typedef short s16x4 __attribute__((ext_vector_type(4)));
typedef float f32x4 __attribute__((ext_vector_type(4)));
typedef float f32x2 __attribute__((ext_vector_type(2)));
typedef float f32x16 __attribute__((ext_vector_type(16)));
typedef unsigned u32x4 __attribute__((ext_vector_type(4)));
typedef unsigned u32x2 __attribute__((ext_vector_type(2)));

constexpr int DM = 1024, NBATCH = 8, SEQ = 4096, CTXL = 256;
constexpr int RL = NBATCH * SEQ, RC = NBATCH * CTXL, RT = RL + RC;
constexpr int RWC = 1920, REC = 1536, MLC = 672, MIXC = 4128, MIXP = 4352, GATEC = 3072, NIN = 7200;
constexpr int DFF = 2816, NEXP = 8, DFE = 1408;
constexpr int RG = 2 * RL + NEXP * 256;
constexpr int NTHREADS = 512;
constexpr int LDS_BYTES = 147456;

constexpr size_t MiB = 1u << 20;
constexpr size_t WS_CTL = 0;
constexpr size_t WS_MOD = 1 * MiB;
constexpr size_t WS_ROPE_R = 3 * MiB / 2;
constexpr size_t WS_ROPE_M = 5 * MiB / 2;
constexpr size_t WS_RSTD = 3 * MiB;
constexpr size_t WS_BSC = 7 * MiB / 2;
constexpr size_t WS_ROUTE = 6 * MiB;
constexpr size_t WS_WG2 = 7 * MiB;
constexpr size_t WS_W2T = 15 * MiB / 2;
constexpr size_t WS_HC = 8 * MiB;
constexpr size_t WS_W = 16 * MiB;
constexpr size_t WL_WINLO = 0, WL_WINHI = 4456448, WL_WGLO = 8912896, WL_WGHI = 12058624, WL_WQ = 15204352, WL_WKV = 15794176, WL_WB = 16318464, WL_WO = 19464192, WL_STRIDE = 21 * MiB;
constexpr size_t WS_DYN = 58 * MiB;
constexpr size_t Y34 = 34 * MiB;
constexpr size_t D_URWKV = WS_DYN, D_URET = WS_DYN + 255 * MiB / 2, D_UMLA = D_URET + 102 * MiB, D_XN1 = D_UMLA + 357 * MiB / 8, D_OF = D_XN1 + 2 * Y34, D_OB = D_OF + Y34, D_END1 = D_OB + Y34;
constexpr size_t D_YRWKV = D_OF, D_YRET = D_OB;
constexpr size_t D_K = WS_DYN, D_V = D_K + 289 * MiB / 8, D_Q = D_V + Y34;
constexpr size_t D_YMLA = D_UMLA;
constexpr int HROWS = 4 * SEQ + 4 * CTXL;
constexpr size_t HA_K = 0, HA_V = HA_K + (size_t)HROWS * 544 * 2, HA_Q = HA_V + (size_t)HROWS * 512 * 2;
static_assert(HA_Q + (size_t)HROWS * 768 * 2 <= 2 * Y34, "half-A K/V/Q fit the xn region / d_out");

constexpr size_t D_SCR = WS_DYN + 68 * MiB;
constexpr size_t D_P12 = WS_DYN + 100 * MiB;
constexpr size_t D_M = WS_DYN;
constexpr size_t D_FFW = WS_DYN;
constexpr size_t D_XN2 = WS_DYN + 17 * MiB;
constexpr size_t D_H = D_URET;
constexpr size_t D_PART = WS_DYN + 17 * MiB;
constexpr size_t D_XG = WS_DYN;
constexpr size_t D_HM = WS_DYN + 132 * MiB;
constexpr size_t D_MOEW = D_HM + 363 * MiB / 2;
constexpr size_t WS_NEED = 512 * MiB;
static_assert(D_END1 <= WS_NEED && D_MOEW + 66 * MiB <= WS_NEED && D_H + 187 * MiB <= WS_NEED && D_Q + 51 * MiB <= D_URET, "ws map");

struct Params { const float* in[37]; float* out; unsigned char* ws; };
enum { I_X = 0, I_C, I_CTX, I_CCTX, I_NMIX, I_NFFN, I_WMOD, I_BMOD, I_WIN, I_MU, I_W0, I_W2, I_A0, I_A2, I_G2, I_KK, I_KA, I_RK, I_LNG, I_LNB,
       I_RDEC, I_RLNG, I_RLNB, I_QN, I_QUP, I_KVN, I_KVUP, I_WBR, I_WOUT, I_FG, I_FU, I_FD, I_ROUTER, I_MG, I_MU2, I_MD, I_FNORM };

__device__ __forceinline__ unsigned f2bf(float f) { unsigned u = __builtin_bit_cast(unsigned, f); return (u + 0x7fffu + ((u >> 16) & 1u)) >> 16; }
typedef __bf16 bf16x2_t __attribute__((ext_vector_type(2)));
__device__ __forceinline__ unsigned pk2(float lo, float hi) { const f32x2 v = {lo, hi}; return __builtin_bit_cast(unsigned, __builtin_convertvector(v, bf16x2_t)); }
__device__ __forceinline__ float bf2f(unsigned short b) { return __builtin_bit_cast(float, (unsigned)b << 16); }
__device__ __forceinline__ float bflo(unsigned w) { return __builtin_bit_cast(float, w << 16); }
__device__ __forceinline__ float bfhi(unsigned w) { return __builtin_bit_cast(float, w & 0xffff0000u); }
__device__ __forceinline__ float shx(float v, int m, int lane) { return __int_as_float(__builtin_amdgcn_ds_bpermute((lane ^ m) << 2, __float_as_int(v))); }
__device__ __forceinline__ float wave_sum(float v, int lane) {
#pragma unroll
    for (int o = 1; o < 64; o <<= 1) v += shx(v, o, lane);
    return v;
}
__device__ __forceinline__ float sigmoidf_(float x) { return __builtin_amdgcn_rcpf(1.0f + __builtin_amdgcn_exp2f(-1.4426950408889634f * x)); }
__device__ __forceinline__ float siluf_(float x) { return x * __builtin_amdgcn_rcpf(1.0f + __builtin_amdgcn_exp2f(-1.4426950408889634f * x)); }
__device__ __forceinline__ void unpack8(u32x4 w, float* f) { f[0] = bflo(w.x); f[1] = bfhi(w.x); f[2] = bflo(w.y); f[3] = bfhi(w.y); f[4] = bflo(w.z); f[5] = bfhi(w.z); f[6] = bflo(w.w); f[7] = bfhi(w.w); }
__device__ __forceinline__ u32x4 pack8(const float* f) { u32x4 w; w.x = pk2(f[0], f[1]); w.y = pk2(f[2], f[3]); w.z = pk2(f[4], f[5]); w.w = pk2(f[6], f[7]); return w; }

namespace pg8 {
constexpr int BM = 256, BK = 64, HALF = 128, HTB = HALF * BK * 2, STAGE_BYTES = 8 * HTB, NXCD = 8, WGM = 4;
__host__ __device__ __forceinline__ int lds_byte(int r, int c) { const int st = (r >> 4) * 2 + (c >> 5), rr = r & 15, cc = c & 31, ob = rr * 64 + cc * 2; return st * 1024 + (ob ^ (((ob >> 9) & 1) << 5)); }
__host__ __device__ __forceinline__ void stage_rc(int b, int& R, int& C) { const int st = b / 1024, sb = b % 1024, swz = sb ^ (((sb >> 9) & 1) << 5); R = (st >> 1) * 16 + swz / 64; C = (st & 1) * 32 + (swz % 64) / 2; }
__host__ __device__ __forceinline__ int perm32(int rho) { const int n = rho >> 4, i = rho & 15; return 8 * (i >> 2) + 4 * n + (i & 3); }

struct Seg { const char* A; const char* B; int nt; int pm, pn, aux; bool first, last; };

__device__ __forceinline__ void tile_order(int L, int nM, int nN, int& pm, int& pn) {
    const int nwg = nM * nN; int wgid = L;
    { const int q = nwg / NXCD, r = nwg % NXCD, xcd = wgid % NXCD, off = wgid / NXCD; wgid = (xcd < r ? xcd * (q + 1) : r * (q + 1) + (xcd - r) * q) + off; }
    const int nig = WGM * nN, gid = wgid / nig, fm = gid * WGM, gsz = (nM - fm) < WGM ? (nM - fm) : WGM;
    pm = fm + ((wgid % nig) % gsz); pn = (wgid % nig) / gsz;
}

template <int LDA, int LDB, bool PERM, class Sched, class Epi>
__device__ __forceinline__ void gemm_phase(LAS unsigned char* lds, const Sched& S, const Epi& E) {
    int tid_ = threadIdx.x; asm volatile("" : "+v"(tid_));
    const int tid = tid_, wid = __builtin_amdgcn_readfirstlane(tid >> 6), lane = tid & 63, wr = wid >> 2, wc = wid & 3, fr = lane & 15, fq = lane >> 4;
    unsigned voffA[2], voffB[2];
#pragma unroll
    for (int i = 0; i < 2; ++i) { int R, C; stage_rc(tid * 16 + i * 8192, R, C); const int Rb = PERM ? ((R & ~31) + perm32(R & 31)) : R;
        voffA[i] = (unsigned)(R * LDA + C) * 2u; voffB[i] = (unsigned)(Rb * LDB + C) * 2u; }
    constexpr size_t kstep = (size_t)(BK * 2);
    constexpr size_t hstepA = (size_t)HALF * LDA * 2, hstepB = (size_t)HALF * LDB * 2;
    const unsigned ldsw = (unsigned)wid * 1024u;
    const int aoff = lds_byte(wr * 64 + fr, fq * 8), boff = lds_byte(wc * 32 + fr, fq * 8);
#define PG8_SA(b, h) (((b) * 2 + (h)) * HTB)
#define PG8_SB(b, h) ((4 + (b) * 2 + (h)) * HTB)
#define PG8_STAGE(bufoff, gbase, voff) do { _Pragma("unroll") for (int _i = 0; _i < 2; ++_i) \
        __builtin_amdgcn_global_load_lds((const unsigned*)((const char*)(gbase) + (voff)[_i]), (LAS unsigned*)(lds + (bufoff) + ldsw + _i * 8192), 16, 0, 0); } while (0)
#define PG8_LDA(dst, b, h) do { _Pragma("unroll") for (int m = 0; m < 4; ++m) _Pragma("unroll") for (int k = 0; k < 2; ++k) dst[m][k] = *(const LAS bf16x8*)(lds + PG8_SA(b, h) + aoff + m * 2048 + k * 1024); } while (0)
#define PG8_LDB(dst, b, h) do { _Pragma("unroll") for (int n = 0; n < 2; ++n) _Pragma("unroll") for (int k = 0; k < 2; ++k) dst[n][k] = *(const LAS bf16x8*)(lds + PG8_SB(b, h) + boff + n * 2048 + k * 1024); } while (0)
#define PG8_MMA(ai, bj, At, Bt) do { __builtin_amdgcn_s_setprio(1); _Pragma("unroll") for (int m = 0; m < 4; ++m) _Pragma("unroll") for (int n = 0; n < 2; ++n) _Pragma("unroll") for (int k = 0; k < 2; ++k) \
        acc[ai][bj][m][n] = __builtin_amdgcn_mfma_f32_16x16x32_bf16(Bt[n][k], At[m][k], acc[ai][bj][m][n], 0, 0, 0); __builtin_amdgcn_s_setprio(0); } while (0)
#define PG8_WAIT_V(n) asm volatile("s_waitcnt vmcnt(" #n ")" ::: "memory")
#define PG8_WAIT_L(n) asm volatile("s_waitcnt lgkmcnt(" #n ")" ::: "memory")
#define PG8_BAR __builtin_amdgcn_s_barrier()
#define PG8_SCHED __builtin_amdgcn_sched_barrier(0)
    Seg cur, nxt; int ui = 0;
    if (!S.next(0, cur)) return;
    f32x4 acc[2][2][4][2];
#pragma unroll
    for (int a = 0; a < 2; ++a)
#pragma unroll
        for (int b = 0; b < 2; ++b)
#pragma unroll
            for (int m = 0; m < 4; ++m)
#pragma unroll
                for (int n = 0; n < 2; ++n) acc[a][b][m][n] = (f32x4){0.f, 0.f, 0.f, 0.f};
    bf16x8 At[4][2], B0[2][2], B1[2][2];
    const char* cA = cur.A; const char* cB = cur.B;
    PG8_STAGE(PG8_SB(0, 0), cB, voffB); PG8_STAGE(PG8_SB(0, 1), cB + hstepB, voffB); PG8_STAGE(PG8_SA(0, 0), cA, voffA); PG8_STAGE(PG8_SA(0, 1), cA + hstepA, voffA);
    if (wr == 1) PG8_BAR;
    PG8_WAIT_V(2); PG8_BAR;
    PG8_STAGE(PG8_SB(1, 0), cB + kstep, voffB); PG8_STAGE(PG8_SA(1, 0), cA + kstep, voffA); PG8_STAGE(PG8_SB(1, 1), cB + hstepB + kstep, voffB);
    PG8_WAIT_V(6); PG8_BAR;
    for (;;) {
        const bool has_next = S.next(ui + 1, nxt);
        const char* nA = has_next ? nxt.A : cA; const char* nB = has_next ? nxt.B : cB;
        const int nt = cur.nt;
        for (int t = 0; t < nt; t += 2) {
            const bool last = (t == nt - 2);
            const char* a1 = cA + (size_t)(t + 1) * kstep;
            const char* a2 = last ? nA : cA + (size_t)(t + 2) * kstep; const char* b2 = last ? nB : cB + (size_t)(t + 2) * kstep;
            const char* a3 = a2 + kstep; const char* b3 = b2 + kstep;
            PG8_LDB(B0, 0, 0); PG8_LDB(B1, 0, 1); PG8_SCHED; PG8_LDA(At, 0, 0); PG8_STAGE(PG8_SA(1, 1), a1 + hstepA, voffA);
            PG8_WAIT_V(8); PG8_WAIT_L(0); PG8_BAR; PG8_MMA(0, 0, At, B0); PG8_MMA(0, 1, At, B1); PG8_BAR; PG8_SCHED;
            PG8_LDA(At, 0, 1); PG8_STAGE(PG8_SB(0, 0), b2, voffB); PG8_STAGE(PG8_SB(0, 1), b2 + hstepB, voffB); PG8_STAGE(PG8_SA(0, 0), a2, voffA);
            PG8_WAIT_V(8); PG8_WAIT_L(0); PG8_BAR; PG8_MMA(1, 0, At, B0); PG8_MMA(1, 1, At, B1); PG8_BAR; PG8_SCHED;
            PG8_LDB(B0, 1, 0); PG8_LDB(B1, 1, 1); PG8_SCHED; PG8_LDA(At, 1, 0); PG8_STAGE(PG8_SA(0, 1), a2 + hstepA, voffA);
            PG8_WAIT_V(8); PG8_WAIT_L(0); PG8_BAR; PG8_MMA(0, 0, At, B0); PG8_MMA(0, 1, At, B1); PG8_BAR; PG8_SCHED;
            PG8_LDA(At, 1, 1); PG8_STAGE(PG8_SB(1, 0), b3, voffB); PG8_STAGE(PG8_SB(1, 1), b3 + hstepB, voffB); PG8_STAGE(PG8_SA(1, 0), a3, voffA);
            PG8_WAIT_V(8); PG8_WAIT_L(0); PG8_BAR; PG8_MMA(1, 0, At, B0); PG8_MMA(1, 1, At, B1); PG8_BAR; PG8_SCHED;
        }
        const bool was_last = cur.last;
        if (was_last) { if (wr == 0) PG8_BAR; E(acc, cur, wr, wc, fr, fq); }
        if (!has_next) break;
        if (nxt.first) {
#pragma unroll
            for (int a = 0; a < 2; ++a)
#pragma unroll
                for (int b = 0; b < 2; ++b)
#pragma unroll
                    for (int m = 0; m < 4; ++m)
#pragma unroll
                        for (int n = 0; n < 2; ++n) acc[a][b][m][n] = (f32x4){0.f, 0.f, 0.f, 0.f};
        }
        cur = nxt; cA = nA; cB = nB; ++ui;
        if (was_last) { if (wr == 1) PG8_BAR; }
    }
    PG8_WAIT_V(0);
    PG8_BAR;
#undef PG8_SA
#undef PG8_SB
#undef PG8_STAGE
#undef PG8_LDA
#undef PG8_LDB
#undef PG8_MMA
#undef PG8_WAIT_V
#undef PG8_WAIT_L
#undef PG8_BAR
#undef PG8_SCHED
}
}
using pg8::Seg;

struct Ctx {
    LAS unsigned char* lds; int tid, lane, wave, G, bid;
};
typedef const __attribute__((address_space(4))) Params* PP;
__device__ __forceinline__ PP getpp() { PP p = (PP)__builtin_amdgcn_kernarg_segment_ptr(); asm volatile("" : "+s"(p)); return p; }
__device__ __forceinline__ unsigned char* half_a_base(int layer) { PP p = getpp(); return layer == 0 ? (unsigned char*)p->out : p->ws + D_XN1; }
#define GW(F) ((F).bid * 8 + (F).wave)
#define NGW(F) ((F).G * 8)
#define LDS_WAIT() asm volatile("s_waitcnt lgkmcnt(0)" ::: "memory")

struct TrJob {
    const float* s0; const float* s1; int spitch; int K; int nd; int mode; int c0; int nvalid; const float* ks;
    bf16_t* dlo; bf16_t* dhi; int dpitch; int ksplit;
};
__device__ __forceinline__ void tr_load(const TrJob& J, int item, int lane, float* v, bool& valid) {
    const int nblk = J.nd / 32, kb = item / nblk, nb = item % nblk, k0 = 64 * kb, n0 = 32 * nb;
    const int np = n0 + (lane & 31);
    const float* src = J.s0; int col = 0; valid = true;
    if (J.mode == 0) { col = J.c0 + np; valid = np < J.nvalid; }
    else if (J.mode == 1) { if (np < 512) col = (np >> 6) * 128 + (np & 63); else col = ((np - 512) >> 6) * 128 + 64 + (np & 63); }
    else { const int tile = np >> 8, w = np & 255; if (w < 128) col = tile * 128 + w; else { col = tile * 128 + (w - 128); src = J.s1; } }
    if (!valid) col = J.c0;
    const float* sp = src + (size_t)(k0 + (lane >> 5)) * J.spitch + col;
#pragma unroll
    for (int i = 0; i < 32; ++i) v[i] = __builtin_nontemporal_load(sp + (size_t)(2 * i) * J.spitch);
    if (J.ks) {
#pragma unroll
        for (int i = 0; i < 32; ++i) v[i] *= J.ks[k0 + 2 * i + (lane >> 5)]; }
}
__device__ __forceinline__ void tr_store(const TrJob& J, LAS float* scr, int item, int lane, const float* v, bool valid) {
    const int nblk = J.nd / 32, kb = item / nblk, nb = item % nblk, k0 = 64 * kb, n0 = 32 * nb;
#pragma unroll
    for (int i = 0; i < 32; ++i) scr[(2 * i + (lane >> 5)) * 33 + (lane & 31)] = valid ? v[i] : 0.f;
    LDS_WAIT(); asm volatile("" ::: "memory");
    const int c = lane & 7;
    bf16_t* dst = (k0 < J.ksplit) ? J.dlo : J.dhi; const int kd = (k0 < J.ksplit) ? k0 : k0 - J.ksplit;
#pragma unroll
    for (int j = 0; j < 4; ++j) { const int n = (lane >> 3) + 8 * j; const LAS float* s = scr + (8 * c) * 33 + n;
        u32x4 o; o.x = pk2(s[0 * 33], s[1 * 33]); o.y = pk2(s[2 * 33], s[3 * 33]); o.z = pk2(s[4 * 33], s[5 * 33]); o.w = pk2(s[6 * 33], s[7 * 33]);
        *(u32x4*)(dst + (size_t)(n0 + n) * J.dpitch + kd + 8 * c) = o; }
    LDS_WAIT(); asm volatile("" ::: "memory");
}
__device__ __forceinline__ void tr_job(const Ctx& F, const TrJob& J, int& rot) {
    LAS float* scr = (LAS float*)(F.lds + F.wave * 8704);
    const int nitems = (J.K / 64) * (J.nd / 32); const int ngw = NGW(F);
    int it = (GW(F) - rot % ngw); if (it < 0) it += ngw;
    rot += nitems;
    if (it >= nitems) return;
    float v[32]; bool valid; tr_load(J, it, F.lane, v, valid);
    for (;;) {
        const int nx = it + ngw; const bool more = nx < nitems; float vn[32]; bool validn = false;
        if (more) tr_load(J, nx, F.lane, vn, validn);
        tr_store(J, scr, it, F.lane, v, valid);
        if (!more) break;
#pragma unroll
        for (int i = 0; i < 32; ++i) v[i] = vn[i];
        valid = validn; it = nx;
    }
}
__device__ __forceinline__ TrJob mk_job(const float* s0, int spitch, int K, int nd, int c0, int nvalid, bf16_t* dst, int dpitch) {
    TrJob J; J.s0 = s0; J.s1 = nullptr; J.spitch = spitch; J.K = K; J.nd = nd; J.mode = 0; J.c0 = c0; J.nvalid = nvalid; J.ks = nullptr; J.dlo = dst; J.dhi = dst; J.dpitch = dpitch; J.ksplit = 1 << 30; return J;
}

__device__ __forceinline__ void phase0(const Ctx& F) {
    PP P = getpp(); unsigned char* ws = P->ws;
    {
        float* cr = (float*)(ws + WS_ROPE_R); float* sr = cr + 4096 * 32; float* cm = (float*)(ws + WS_ROPE_M); float* sm = cm + 4096 * 16;
        for (int i = F.bid * NTHREADS + F.tid; i < 4096 * 48; i += F.G * NTHREADS) {
            const int t = i / 48, j = i % 48; const float row = (float)(t >> 6), colp = (float)(t & 63);
            if (j < 32) { const int f = j & 15; const float inv = powf(10000.0f, -(float)f / 16.0f); const float ang = (j < 16 ? row : colp) * inv; cr[t * 32 + j] = cosf(ang); sr[t * 32 + j] = sinf(ang); }
            else { const int jj = j - 32, f = jj & 7; const float inv = powf(10000.0f, -(float)f / 8.0f); const float ang = (jj < 8 ? row : colp) * inv; cm[t * 16 + jj] = cosf(ang); sm[t * 16 + jj] = sinf(ang); }
        }
        if (F.bid == 0 && F.tid < 64) ((unsigned*)(ws + WS_CTL))[F.tid] = 0u;
    }
    {
        LAS float* sc = (LAS float*)(F.lds + 70000);
        LAS float* red = (LAS float*)(F.lds + 70000 + 36864);
        for (int i = F.tid; i < 9 * 1024; i += NTHREADS) { const int v = i >> 10, k = i & 1023; const float x = v < 8 ? P->in[I_C][v * 1024 + k] : P->in[I_CCTX][k]; sc[i] = siluf_(x); }
        __syncthreads();
        for (int it = F.bid; it < 2 * 96; it += F.G) {
            const int l = it / 96, jc = F.tid & 63, j = (it % 96) * 64 + jc, ksl = F.tid >> 6;
            const float* w = P->in[I_WMOD] + (size_t)l * 1024 * 6144 + j + (size_t)(ksl * 128) * 6144;
            float a[9];
#pragma unroll
            for (int v = 0; v < 9; ++v) a[v] = 0.f;
#pragma unroll 1
            for (int k0 = 0; k0 < 128; k0 += 32) { float wv[32];
#pragma unroll
                for (int q = 0; q < 32; ++q) wv[q] = w[(size_t)(k0 + q) * 6144];
                __builtin_amdgcn_sched_barrier(0);
#pragma unroll
                for (int qh = 0; qh < 32; qh += 16) {
#pragma unroll
                    for (int q = qh; q < qh + 16; ++q)
#pragma unroll
                        for (int v = 0; v < 9; ++v) a[v] += sc[v * 1024 + ksl * 128 + k0 + q] * wv[q];
                    __builtin_amdgcn_sched_barrier(0); } }
#pragma unroll
            for (int v = 0; v < 9; ++v) red[(ksl * 64 + jc) * 9 + v] = a[v];
            __syncthreads();
            if (F.tid < 64) {
                float* mo = (float*)(ws + WS_MOD) + (size_t)l * 9 * 6144;
#pragma unroll
                for (int v = 0; v < 9; ++v) { float s = 0.f;
#pragma unroll
                    for (int q = 0; q < 8; ++q) s += red[(q * 64 + F.tid) * 9 + v];
                    mo[v * 6144 + j] = s + P->in[I_BMOD][l * 6144 + j]; }
            }
            __syncthreads();
        }
    }
    int rot = (192 * 8) % NGW(F);
    for (int l = 0; l < 2; ++l) {
        unsigned char* wb = ws + WS_W + (size_t)l * WL_STRIDE;
        const float* win = P->in[I_WIN] + (size_t)l * 1024 * NIN;
        { TrJob J = mk_job(win, NIN, 1024, MIXP, 0, MIXC, (bf16_t*)(wb + WL_WINLO), 512); J.dhi = (bf16_t*)(wb + WL_WINHI); J.ksplit = 512; tr_job(F, J, rot); }
        { TrJob J = mk_job(win, NIN, 1024, GATEC, MIXC, GATEC, (bf16_t*)(wb + WL_WGLO), 512); J.dhi = (bf16_t*)(wb + WL_WGHI); J.ksplit = 512; tr_job(F, J, rot); }
        { TrJob J = mk_job(P->in[I_QUP] + (size_t)l * 384 * 768, 768, 384, 768, 0, 768, (bf16_t*)(wb + WL_WQ), 384); J.ks = P->in[I_QN] + l * 384; tr_job(F, J, rot); }
        { TrJob J = mk_job(P->in[I_KVUP] + (size_t)l * 256 * 1024, 1024, 256, 1024, 0, 1024, (bf16_t*)(wb + WL_WKV), 256); J.mode = 1; J.ks = P->in[I_KVN] + l * 256; tr_job(F, J, rot); }
        for (int n = 0; n < 3; ++n) { TrJob J = mk_job(P->in[I_WBR] + ((size_t)l * 3 + n) * 512 * 1024, 1024, 512, 1024, 0, 1024, (bf16_t*)(wb + WL_WB) + (size_t)n * 1024 * 512, 512); tr_job(F, J, rot); }
        { TrJob J = mk_job(P->in[I_WOUT] + (size_t)l * 1024 * 1024, 1024, 1024, 1024, 0, 1024, (bf16_t*)(wb + WL_WO), 1024); tr_job(F, J, rot); }
        { TrJob J = mk_job(P->in[I_G2] + (size_t)l * 128 * 512, 512, 128, 512, 0, 512, (bf16_t*)(ws + WS_WG2) + (size_t)l * 512 * 128, 128); tr_job(F, J, rot); }
        for (int dd = 0; dd < 2; ++dd) {
            { TrJob J = mk_job(P->in[I_W2] + (size_t)(l * 2 + dd) * 64 * 512, 512, 64, 512, 0, 512, (bf16_t*)(ws + WS_W2T) + (size_t)((l * 2 + dd) * 2 + 0) * 512 * 64, 64); tr_job(F, J, rot); }
            { TrJob J = mk_job(P->in[I_A2] + (size_t)(l * 2 + dd) * 64 * 512, 512, 64, 512, 0, 512, (bf16_t*)(ws + WS_W2T) + (size_t)((l * 2 + dd) * 2 + 1) * 512 * 64, 64); tr_job(F, J, rot); }
        }
    }
}
__device__ __forceinline__ void convert_ffn0(const Ctx& F) {
    PP P = getpp(); unsigned char* ws = P->ws;
    bf16_t* glo = (bf16_t*)(ws + D_FFW); bf16_t* ghi = glo + (size_t)5632 * 512; bf16_t* wd = ghi + (size_t)5632 * 512;
    int rot = 0;
    { TrJob J = mk_job(P->in[I_FG], DFF, 1024, 5632, 0, 5632, glo, 512); J.s1 = P->in[I_FU]; J.mode = 2; J.dhi = ghi; J.ksplit = 512; tr_job(F, J, rot); }
    { TrJob J = mk_job(P->in[I_FD], 1024, DFF, 1024, 0, 1024, wd, DFF); tr_job(F, J, rot); }
}
__device__ __forceinline__ void convert_moe(const Ctx& F) {
    PP P = getpp(); unsigned char* ws = P->ws;
    int rot = 0;
    for (int e = 0; e < NEXP; ++e) {
        bf16_t* glo = (bf16_t*)(ws + D_MOEW + (size_t)e * (33 * MiB / 4)); bf16_t* ghi = glo + (size_t)2816 * 512; bf16_t* wd = ghi + (size_t)2816 * 512;
        { TrJob J = mk_job(P->in[I_MG] + (size_t)e * 1024 * DFE, DFE, 1024, 2816, 0, 2816, glo, 512); J.s1 = P->in[I_MU2] + (size_t)e * 1024 * DFE; J.mode = 2; J.dhi = ghi; J.ksplit = 512; tr_job(F, J, rot); }
        { TrJob J = mk_job(P->in[I_MD] + (size_t)e * DFE * 1024, 1024, DFE, 1024, 0, 1024, wd, DFE); tr_job(F, J, rot); }
    }
}

__device__ __forceinline__ void norm_pass(const Ctx& F, int layer, int which, const float* hl, const float* hcx, int nrows, bf16_t* xlo, bf16_t* xhi, bool ctxpart = false) {
    PP P = getpp();
    const float* gain = P->in[which ? I_NFFN : I_NMIX] + layer * 1024;
    const float* mod = (const float*)(P->ws + WS_MOD) + (size_t)layer * 9 * 6144 + (which ? 3072 : 0);
    const float* part = (const float*)(P->ws + D_PART); const float* g2c = (const float*)(P->ws + WS_MOD) + 8 * 6144 + 5120;
    const int rpw = (nrows + NGW(F) - 1) / NGW(F); const int r0 = GW(F) * rpw; const int r1 = (r0 + rpw < nrows) ? r0 + rpw : nrows;
    const bool dealt = ctxpart && NGW(F) == 2048 && nrows == RT;
    int vprev = -1; f32x4 gs[4], sh4[4];
    constexpr int NB = 4;
#define NP_LOAD(X_, RWS_, rb_) do { _Pragma("unroll") for (int b = 0; b < NB; ++b) { const int v_ = ((rb_) + b < r1) ? (rb_) + b : r1 - 1; \
            const int row_ = dealt ? ((v_ % 17) < 16 ? (v_ / 17) * 16 + (v_ % 17) : RL + v_ / 17) : v_; RWS_[b] = row_; \
            const float* src_ = row_ < RL ? hl + (size_t)row_ * 1024 : hcx + (size_t)(row_ - RL) * 1024; \
            _Pragma("unroll") for (int j = 0; j < 4; ++j) X_[b][j] = *(const f32x4*)(src_ + 4 * F.lane + 256 * j); \
            if (ctxpart && row_ >= RL) { \
                _Pragma("unroll") for (int j = 0; j < 4; ++j) { const int c_ = 4 * F.lane + 256 * j; const float* pp_ = part + (size_t)(row_ - RL) * 1024 + c_; \
                    const f32x4 s4_ = ((*(const f32x4*)pp_ + *(const f32x4*)(pp_ + (size_t)RC * 1024)) + *(const f32x4*)(pp_ + (size_t)2 * RC * 1024)) + *(const f32x4*)(pp_ + (size_t)3 * RC * 1024); \
                    X_[b][j] = X_[b][j] + *(const f32x4*)(g2c + c_) * s4_; } } } } while (0)
    f32x4 x[NB][4], xn[NB][4]; int rows[NB], rowsn[NB];
    if (r0 < r1) NP_LOAD(x, rows, r0);
    for (int rb = r0; rb < r1; rb += NB) {
        float ss[NB]; const bool more = rb + NB < r1;
        if (more) NP_LOAD(xn, rowsn, rb + NB);
#pragma unroll
        for (int b = 0; b < NB; ++b) { ss[b] = 0.f;
#pragma unroll
            for (int j = 0; j < 4; ++j) ss[b] += x[b][j].x * x[b][j].x + x[b][j].y * x[b][j].y + x[b][j].z * x[b][j].z + x[b][j].w * x[b][j].w; }
#pragma unroll
        for (int b = 0; b < NB; ++b) ss[b] = wave_sum(ss[b], F.lane);
#pragma unroll
        for (int b = 0; b < NB; ++b) { const int row = rows[b];
            const int v = row < RL ? (row >> 12) : 8;
            if (v != vprev) { const float* sh = mod + v * 6144; const float* sc = sh + 1024;
#pragma unroll
                for (int j = 0; j < 4; ++j) { const int c = 4 * F.lane + 256 * j; gs[j] = *(const f32x4*)(gain + c) * (*(const f32x4*)(sc + c) + 1.0f); sh4[j] = *(const f32x4*)(sh + c); }
                vprev = v; }
            const float rstd = rsqrtf(ss[b] * (1.0f / 1024.0f) + 1e-6f);
#pragma unroll
            for (int j = 0; j < 4; ++j) { const int c = 4 * F.lane + 256 * j;
                const f32x4 y = x[b][j] * rstd * gs[j] + sh4[j];
                u32x2 o; o.x = pk2(y.x, y.y); o.y = pk2(y.z, y.w);
                bf16_t* d = (c < 512) ? xlo + (size_t)row * 512 + c : xhi + (size_t)row * 512 + (c - 512);
                *(u32x2*)d = o; } }
        if (more) {
#pragma unroll
            for (int b = 0; b < NB; ++b) { rows[b] = rowsn[b];
#pragma unroll
                for (int j = 0; j < 4; ++j) x[b][j] = xn[b][j]; } }
    }
#undef NP_LOAD
}

struct SchedSplit2 {
    const char *Alo, *Ahi, *Blo, *Bhi; int nM, nN, G, c; bool skipc;
    __device__ __forceinline__ bool next(int i, Seg& s) const {
        const int iu = i >> 1, h = i & 1; const long L = (long)iu * G + c;
        const int nlat = skipc ? (nM - 8) * nN : nM * nN, ntot = skipc ? nlat + 8 * (nN - 1) : nlat;
        if (L >= (long)ntot) return false;
        int pm, pn;
        if (L < nlat) pg8::tile_order((int)L, skipc ? nM - 8 : nM, nN, pm, pn); else { pg8::tile_order((int)L - nlat, 8, nN - 1, pm, pn); pm += nM - 8; }
        s.A = (h ? Ahi : Alo) + (size_t)pm * 256 * 1024; s.B = (h ? Bhi : Blo) + (size_t)pn * 256 * 1024; s.nt = 8; s.pm = pm; s.pn = pn; s.aux = 0; s.first = (h == 0); s.last = (h == 1); return true;
    }
};
struct Sched1 {
    const char *A, *B; size_t astride, bstride; int nt, nM, nN, G, c;
    __device__ __forceinline__ bool next(int i, Seg& s) const {
        const long L = (long)i * G + c; if (L >= (long)nM * nN) return false;
        int pm, pn; pg8::tile_order((int)L, nM, nN, pm, pn);
        s.A = A + (size_t)pm * astride; s.B = B + (size_t)pn * bstride; s.nt = nt; s.pm = pm; s.pn = pn; s.aux = 0; s.first = true; s.last = true; return true;
    }
};
struct SchedDown0 {
    const char *A, *B; int G, c;
    __device__ __forceinline__ bool next(int i, Seg& s) const {
        const long L = (long)i * G + c; s.first = true; s.last = true;
        if (L < 512) { int pm, pn; pg8::tile_order((int)L, RL / 256, 4, pm, pn);
            s.A = A + (size_t)pm * 256 * DFF * 2; s.B = B + (size_t)pn * 256 * DFF * 2; s.nt = 44; s.pm = pm; s.pn = pn; s.aux = 0; return true; }
        const int q = (int)L - 512; if (q >= 128) return false;
        const int tile = q >> 2, sl = q & 3, pmc = tile & 7, pn = tile >> 3; const int k0 = sl < 2 ? 12 * sl : 24 + 10 * (sl - 2);
        s.A = A + (size_t)(RL / 256 + pmc) * 256 * DFF * 2 + (size_t)k0 * 128; s.B = B + (size_t)pn * 256 * DFF * 2 + (size_t)k0 * 128;
        s.nt = sl < 2 ? 12 : 10; s.pm = RL / 256 + pmc; s.pn = pn; s.aux = 1 + sl; return true;
    }
};
struct SchedHalf {
    const char *A, *B; size_t astride, bstride; int nt, nN, half, G, c;
    __device__ __forceinline__ bool next(int i, Seg& s) const {
        const long L = (long)i * G + c; if (L >= (long)68 * nN) return false;
        int mi, pn; pg8::tile_order((int)L, 68, nN, mi, pn);
        const int pm = mi < 64 ? 64 * half + mi : 128 + 4 * half + (mi - 64);
        s.A = A + (size_t)pm * astride; s.B = B + (size_t)pn * bstride; s.nt = nt; s.pm = pm; s.pn = pn; s.aux = 0; s.first = true; s.last = true; return true;
    }
};
struct SchedMerge {
    const char *XNlo, *XNhi, *WgLo, *WgHi, *wsb, *Wb; int nM, G, c; bool ctx3;
    __device__ __forceinline__ void fill(Seg& s, int pm, int pn, int n, int k, int ctxbit) const {
        s.pm = pm; s.pn = pn; s.nt = 8;
        if (k == 0) { s.A = XNlo + (size_t)pm * 256 * 1024; s.B = WgLo + (size_t)(n * 1024 + pn * 256) * 1024; s.first = true; s.last = false; s.aux = n * 2; }
        else if (k == 1) { s.A = XNhi + (size_t)pm * 256 * 1024; s.B = WgHi + (size_t)(n * 1024 + pn * 256) * 1024; s.first = false; s.last = true; s.aux = n * 2; }
        else { const size_t yo = (n == 0) ? D_YRWKV : ((n == 1) ? D_YRET : D_YMLA); s.A = wsb + yo + (size_t)pm * 256 * 1024; s.B = Wb + (size_t)(n * 1024 + pn * 256) * 1024; s.first = true; s.last = true; s.aux = n * 2 + 1 + ctxbit; }
    }
    __device__ __forceinline__ bool next(int i, Seg& s) const {
        const int nMl = ctx3 ? RL / 256 : nM; const int NL = nMl * 4;
        const int kmax = (NL - c + G - 1) / G;
        if (i < 9 * kmax) { const int su = i / 9, r = i % 9; const long L = (long)su * G + c; int pm, pn; pg8::tile_order((int)L, nMl, 4, pm, pn); fill(s, pm, pn, r / 3, r % 3, 0); return true; }
        if (!ctx3) return false;
        const int j = i - 9 * kmax, t = j / 3, k = j % 3; const long idx = (long)t * G + c; if (idx >= 96) return false;
        const int tile = (int)idx / 3, n = (int)idx % 3; fill(s, RL / 256 + (tile & 7), tile >> 3, n, k, 8); return true;
    }
};
struct SchedWout0 {
    const char *A, *B, *wsb; int G, c;
    __device__ __forceinline__ bool next(int i, Seg& s) const {
        if (c < 32) { if (i >= 3) return false; const int pmc = c & 7, pn = c >> 3;
            const size_t ao = (i == 0) ? D_M + (size_t)RL * 1024 * 2 : ((i == 1) ? D_P12 : D_P12 + (size_t)RC * 1024 * 2);
            s.A = wsb + ao + (size_t)pmc * 256 * 1024 * 2; s.B = B + (size_t)pn * 256 * 1024 * 2; s.nt = 16; s.pm = RL / 256 + pmc; s.pn = pn; s.aux = 0; s.first = (i == 0); s.last = (i == 2); return true; }
        const long L = (long)i * (G - 32) + (c - 32); if (L >= (RL / 256) * 4) return false;
        int pm, pn; pg8::tile_order((int)L, RL / 256, 4, pm, pn);
        s.A = A + (size_t)pm * 256 * 1024 * 2; s.B = B + (size_t)pn * 256 * 1024 * 2; s.nt = 16; s.pm = pm; s.pn = pn; s.aux = 0; s.first = true; s.last = true; return true;
    }
};
struct MoeTiles { int tstart[NEXP + 1]; };
__device__ __forceinline__ MoeTiles moe_tiles(const unsigned* cnt) {
    MoeTiles T; int a = 0;
#pragma unroll
    for (int e = 0; e < NEXP; ++e) { T.tstart[e] = a; a += (int)((__builtin_amdgcn_readfirstlane(cnt[e]) + 255u) >> 8); }
    T.tstart[NEXP] = a; return T;
}
__device__ __forceinline__ int moe_expert_of(const MoeTiles& T, int mt) { int e = 0;
#pragma unroll
    for (int k = 1; k < NEXP; ++k) e += (mt >= T.tstart[k]) ? 1 : 0;
    return e; }
struct SchedMoeUp {
    const char *Alo, *Ahi, *W; MoeTiles T; int G, c;
    __device__ __forceinline__ bool next(int i, Seg& s) const {
        const int iu = i >> 1, h = i & 1; const int nM = T.tstart[NEXP]; const long L = (long)iu * G + c; if (L >= (long)nM * 11) return false;
        int pm, pn; pg8::tile_order((int)L, nM, 11, pm, pn);
        const int e = moe_expert_of(T, pm); const char* we = W + (size_t)e * (33 * MiB / 4);
        s.A = (h ? Ahi : Alo) + (size_t)pm * 256 * 1024; s.B = we + (h ? (size_t)2816 * 1024 : 0) + (size_t)pn * 256 * 1024; s.nt = 8; s.pm = pm; s.pn = pn; s.aux = e; s.first = (h == 0); s.last = (h == 1); return true;
    }
};
struct SchedMoeDown {
    const char *A, *W; MoeTiles T; int G, c;
    __device__ __forceinline__ bool next(int i, Seg& s) const {
        const int nM = T.tstart[NEXP]; const long L = (long)i * G + c; if (L >= (long)nM * 4) return false;
        int pm, pn; pg8::tile_order((int)L, nM, 4, pm, pn);
        const int e = moe_expert_of(T, pm); const char* we = W + (size_t)e * (33 * MiB / 4) + (size_t)2 * 2816 * 1024;
        s.A = A + (size_t)pm * 256 * DFE * 2; s.B = we + (size_t)pn * 256 * DFE * 2; s.nt = 22; s.pm = pm; s.pn = pn; s.aux = e; s.first = true; s.last = true; return true;
    }
};

typedef f32x4 Acc[2][2][4][2];
struct EpiInproj {
    unsigned char* ws;
    __device__ __forceinline__ void operator()(const Acc& acc, const Seg& u, int wr, int wc, int fr, int fq) const {
        const int row0 = u.pm * 256 + wr * 64 + fr;
#pragma unroll
        for (int bj = 0; bj < 2; ++bj) {
            const int c0 = u.pn * 256 + bj * 128 + wc * 32 + 8 * fq;
            const bool a = c0 < RWC, b = c0 < RWC + REC;
            const size_t boff = a ? D_URWKV : (b ? D_URET : D_UMLA); const int pitch = a ? RWC : (b ? REC : MLC); const int col = c0 - (a ? 0 : (b ? RWC : RWC + REC));
            bf16_t* base = (bf16_t*)(ws + boff);
            if (c0 < MIXC) {
#pragma unroll
                for (int ai = 0; ai < 2; ++ai)
#pragma unroll
                    for (int m = 0; m < 4; ++m) { const int row = row0 + ai * 128 + m * 16; const f32x4 v0 = acc[ai][bj][m][0], v1 = acc[ai][bj][m][1];
                        u32x4 w; w.x = pk2(v0[0], v0[1]); w.y = pk2(v0[2], v0[3]); w.z = pk2(v1[0], v1[1]); w.w = pk2(v1[2], v1[3]);
                        *(u32x4*)(base + (size_t)row * pitch + col) = w; }
            }
        }
    }
};
struct EpiQup {
    bf16_t* Q; const float* rstd; const float* cosm; const float* sinm; int compact;
    __device__ __forceinline__ void operator()(const Acc& acc, const Seg& u, int wr, int wc, int fr, int fq) const {
        const int row0 = u.pm * 256 + wr * 64 + fr; const bool lat = u.pm * 256 < RL;
        const int cbA = u.pn * 256 + wc * 32; const bool ropeA = lat && ((cbA % 96) == 64), ropeB = lat && (((cbA + 128) % 96) == 64);
        float rsv[8]; f32x4 cs[8], sn[8];
#pragma unroll
        for (int r = 0; r < 8; ++r) rsv[r] = rstd[row0 + (r >> 2) * 128 + (r & 3) * 16];
        if (ropeA || ropeB) {
#pragma unroll
            for (int r = 0; r < 8; ++r) { const int t = (row0 + (r >> 2) * 128 + (r & 3) * 16) & 4095; cs[r] = *(const f32x4*)(cosm + t * 16 + 4 * fq); sn[r] = *(const f32x4*)(sinm + t * 16 + 4 * fq); }
        } else {
#pragma unroll
            for (int r = 0; r < 8; ++r) { cs[r] = (f32x4){1.f, 1.f, 1.f, 1.f}; sn[r] = (f32x4){0.f, 0.f, 0.f, 0.f}; }
        }
        __builtin_amdgcn_sched_barrier(0);
#pragma unroll
        for (int ai = 0; ai < 2; ++ai)
#pragma unroll
            for (int m = 0; m < 4; ++m) { const int row = row0 + ai * 128 + m * 16; const float rs = rsv[ai * 4 + m];
#pragma unroll
                for (int bj = 0; bj < 2; ++bj) { const int cb = cbA + bj * 128; const bool rope = bj ? ropeB : ropeA;
                    f32x4 x1 = acc[ai][bj][m][0] * rs, x2 = acc[ai][bj][m][1] * rs;
                    if (rope) { const f32x4 o1 = x1 * cs[ai * 4 + m] - x2 * sn[ai * 4 + m], o2 = x1 * sn[ai * 4 + m] + x2 * cs[ai * 4 + m]; x1 = o1; x2 = o2; }
                    u32x2 a, b; a.x = pk2(x1[0], x1[1]); a.y = pk2(x1[2], x1[3]); b.x = pk2(x2[0], x2[1]); b.y = pk2(x2[2], x2[3]);
                    const int orow = compact ? (lat ? row : row - RL + 4 * SEQ) : row;
                    bf16_t* d = Q + (size_t)orow * 768 + cb + 4 * fq; *(u32x2*)d = a; *(u32x2*)(d + 16) = b; } }
    }
};
struct EpiKVup {
    bf16_t *Kb, *Vb; const float* rstd; int compact;
    __device__ __forceinline__ void operator()(const Acc& acc, const Seg& u, int wr, int wc, int fr, int fq) const {
        const int row0 = u.pm * 256 + wr * 64 + fr;
        float rsv[8];
#pragma unroll
        for (int r = 0; r < 8; ++r) rsv[r] = rstd[row0 + (r >> 2) * 128 + (r & 3) * 16];
        __builtin_amdgcn_sched_barrier(0);
#pragma unroll
        for (int ai = 0; ai < 2; ++ai)
#pragma unroll
            for (int m = 0; m < 4; ++m) { const int row = row0 + ai * 128 + m * 16; const float rs = rsv[ai * 4 + m];
#pragma unroll
                for (int bj = 0; bj < 2; ++bj) { const int c0 = u.pn * 256 + bj * 128 + wc * 32 + 8 * fq; const f32x4 v0 = acc[ai][bj][m][0] * rs, v1 = acc[ai][bj][m][1] * rs;
                    u32x4 w; w.x = pk2(v0[0], v0[1]); w.y = pk2(v0[2], v0[3]); w.z = pk2(v1[0], v1[1]); w.w = pk2(v1[2], v1[3]);
                    const int orow = compact ? (row < RL ? row : row - RL + 4 * SEQ) : row;
                    bf16_t* d = (u.pn < 2) ? Kb + (size_t)orow * 544 + c0 : Vb + (size_t)orow * 512 + (c0 - 512);
                    *(u32x4*)d = w; } }
    }
};
struct EpiMerge {
    u32x4* scr; bf16_t* M; bf16_t* P12;
    __device__ __forceinline__ void operator()(const Acc& acc, const Seg& u, int wr, int wc, int fr, int fq) const {
        int tid = threadIdx.x; asm volatile("" : "+v"(tid));
        if ((u.aux & 1) == 0) {
#pragma unroll
            for (int ai = 0; ai < 2; ++ai)
#pragma unroll
                for (int bj = 0; bj < 2; ++bj)
#pragma unroll
                    for (int m = 0; m < 4; ++m) { const f32x4 v0 = acc[ai][bj][m][0], v1 = acc[ai][bj][m][1];
                        u32x4 w; w.x = pk2(sigmoidf_(v0[0]), sigmoidf_(v0[1])); w.y = pk2(sigmoidf_(v0[2]), sigmoidf_(v0[3])); w.z = pk2(sigmoidf_(v1[0]), sigmoidf_(v1[1])); w.w = pk2(sigmoidf_(v1[2]), sigmoidf_(v1[3]));
                        scr[((ai * 2 + bj) * 4 + m) * 512 + tid] = w; }
        } else {
            const int n = (u.aux & 7) >> 1; const bool part = (u.aux & 8) != 0; const int row0 = u.pm * 256 + wr * 64 + fr; const bool accum = n > 0 && !part;
            u32x4 gq[2][4], pq[2][4];
#pragma unroll
            for (int k = 0; k < 5; ++k) {
                if (k < 4) { const int ai = k >> 1, bj = k & 1;
#pragma unroll
                    for (int m = 0; m < 4; ++m) { const int row = row0 + ai * 128 + m * 16; const int c0 = u.pn * 256 + bj * 128 + wc * 32 + 8 * fq;
                        gq[k & 1][m] = scr[((ai * 2 + bj) * 4 + m) * 512 + tid];
                        if (accum) pq[k & 1][m] = *(const u32x4*)(M + (size_t)row * 1024 + c0); else pq[k & 1][m] = (u32x4){0u, 0u, 0u, 0u}; } }
                if (k > 0) { const int kk = k - 1, ai = kk >> 1, bj = kk & 1;
#pragma unroll
                    for (int m = 0; m < 4; ++m) { const int row = row0 + ai * 128 + m * 16; const int c0 = u.pn * 256 + bj * 128 + wc * 32 + 8 * fq;
                        float gf[8], pf[8]; unpack8(gq[kk & 1][m], gf); unpack8(pq[kk & 1][m], pf);
                        const f32x4 v0 = acc[ai][bj][m][0], v1 = acc[ai][bj][m][1];
                        bf16_t* d = (part && n > 0) ? P12 + (size_t)(n - 1) * RC * 1024 + (size_t)(row - RL) * 1024 + c0 : M + (size_t)row * 1024 + c0;
#pragma unroll
                        for (int j = 0; j < 4; ++j) { pf[j] += gf[j] * v0[j]; pf[4 + j] += gf[4 + j] * v1[j]; }
                        *(u32x4*)d = pack8(pf); } }
            }
        }
    }
};
struct EpiResid {
    const float *srcl, *srcc; float *dstl, *dstc; const float* mod; int goff; float* part;
    __device__ __forceinline__ void operator()(const Acc& acc, const Seg& u, int wr, int wc, int fr, int fq) const {
        const int row0 = u.pm * 256 + wr * 64 + fr; const bool lat = u.pm * 256 < RL;
        if (u.aux != 0) {
            float* pb = part + (size_t)(u.aux - 1) * RC * 1024;
#pragma unroll
            for (int ai = 0; ai < 2; ++ai)
#pragma unroll
                for (int m = 0; m < 4; ++m) { float* d = pb + (size_t)(row0 + ai * 128 + m * 16 - RL) * 1024;
#pragma unroll
                    for (int bj = 0; bj < 2; ++bj)
#pragma unroll
                        for (int n = 0; n < 2; ++n) *(f32x4*)(d + u.pn * 256 + bj * 128 + wc * 32 + 16 * n + 4 * fq) = acc[ai][bj][m][n]; }
            return; }
        const float* sb = lat ? srcl : srcc; float* db = lat ? dstl : dstc; const size_t rsub = lat ? 0 : (size_t)RL;
        const float* g = mod + (lat ? ((u.pm * 256) >> 12) : 8) * 6144 + goff;
        f32x4 gv[2][2];
#pragma unroll
        for (int bj = 0; bj < 2; ++bj)
#pragma unroll
            for (int n = 0; n < 2; ++n) gv[bj][n] = *(const f32x4*)(g + u.pn * 256 + bj * 128 + wc * 32 + 16 * n + 4 * fq);
        f32x4 sv[2][2][2][2];
#pragma unroll
        for (int k = 0; k < 5; ++k) {
            if (k < 4) {
#pragma unroll
                for (int mm = 0; mm < 2; ++mm) { const int row = row0 + (k >> 1) * 128 + ((k & 1) * 2 + mm) * 16; const float* s = sb + ((size_t)row - rsub) * 1024;
#pragma unroll
                    for (int bj = 0; bj < 2; ++bj)
#pragma unroll
                        for (int n = 0; n < 2; ++n) sv[k & 1][mm][bj][n] = *(const f32x4*)(s + u.pn * 256 + bj * 128 + wc * 32 + 16 * n + 4 * fq); } }
            if (k > 0) { const int kk = k - 1, ai = kk >> 1;
#pragma unroll
                for (int mm = 0; mm < 2; ++mm) { const int m = (kk & 1) * 2 + mm; const int row = row0 + ai * 128 + m * 16; float* d = db + ((size_t)row - rsub) * 1024;
#pragma unroll
                    for (int bj = 0; bj < 2; ++bj)
#pragma unroll
                        for (int n = 0; n < 2; ++n) *(f32x4*)(d + u.pn * 256 + bj * 128 + wc * 32 + 16 * n + 4 * fq) = sv[kk & 1][mm][bj][n] + gv[bj][n] * acc[ai][bj][m][n]; } }
        }
    }
};
struct EpiSwiglu {
    bf16_t* H; int pitch;
    __device__ __forceinline__ void operator()(const Acc& acc, const Seg& u, int wr, int wc, int fr, int fq) const {
        const int row0 = u.pm * 256 + wr * 64 + fr; const int c0 = u.pn * 128 + wc * 32 + 8 * fq;
#pragma unroll
        for (int ai = 0; ai < 2; ++ai)
#pragma unroll
            for (int m = 0; m < 4; ++m) { const int row = row0 + ai * 128 + m * 16; float o[8];
#pragma unroll
                for (int n = 0; n < 2; ++n)
#pragma unroll
                    for (int j = 0; j < 4; ++j) o[4 * n + j] = siluf_(acc[ai][0][m][n][j]) * acc[ai][1][m][n][j];
                *(u32x4*)(H + (size_t)row * pitch + c0) = pack8(o); }
    }
};
struct EpiBf16 {
    bf16_t* O; int pitch;
    __device__ __forceinline__ void operator()(const Acc& acc, const Seg& u, int wr, int wc, int fr, int fq) const {
        const int row0 = u.pm * 256 + wr * 64 + fr;
#pragma unroll
        for (int ai = 0; ai < 2; ++ai)
#pragma unroll
            for (int m = 0; m < 4; ++m) { const int row = row0 + ai * 128 + m * 16;
#pragma unroll
                for (int bj = 0; bj < 2; ++bj) { const int c0 = u.pn * 256 + bj * 128 + wc * 32 + 8 * fq; const f32x4 v0 = acc[ai][bj][m][0], v1 = acc[ai][bj][m][1];
                    u32x4 w; w.x = pk2(v0[0], v0[1]); w.y = pk2(v0[2], v0[3]); w.z = pk2(v1[0], v1[1]); w.w = pk2(v1[2], v1[3]);
                    *(u32x4*)(O + (size_t)row * pitch + c0) = w; } }
    }
};

namespace attn {
constexpr float SCALE = 0.10206207261596577f;
constexpr float THR = 8.f;
constexpr int KP = 208;
constexpr int SHM_V = 8192, SHM_K = 64 * KP;
constexpr int OFF_V = 0, OFF_K = 2 * SHM_V, OFF_WS = OFF_K + 2 * SHM_K, SHM_TOTAL = OFF_WS + 8 * 64 * 4;
#define SBAR() __builtin_amdgcn_sched_barrier(0)
__device__ __forceinline__ int crow(int r, int hi) { return (r & 3) + 8 * (r >> 2) + 4 * hi; }
__device__ __forceinline__ unsigned cvtpk(float lo, float hi) { unsigned r; asm volatile("v_cvt_pk_bf16_f32 %0, %1, %2" : "=v"(r) : "v"(lo), "v"(hi)); return r; }
__device__ __forceinline__ void partialSM(f32x16& p0, f32x16& p1, float& m_reg, float& mn, float& alpha) {
    constexpr float C = SCALE * 1.4426950408889634f;
    float pmax = p0[0];
#pragma unroll
    for (int r = 1; r < 16; ++r) pmax = fmaxf(pmax, p0[r]);
#pragma unroll
    for (int r = 0; r < 16; ++r) pmax = fmaxf(pmax, p1[r]);
    { auto rr = __builtin_amdgcn_permlane32_swap(__float_as_uint(pmax), __float_as_uint(pmax), false, false); pmax = fmaxf(__uint_as_float(rr[0]), __uint_as_float(rr[1])); }
    if (__builtin_expect(__all(pmax - m_reg <= THR / SCALE), 1)) { mn = m_reg; alpha = 1.f; }
    else { mn = fmaxf(m_reg, pmax); alpha = __builtin_amdgcn_exp2f((m_reg - mn) * C); m_reg = mn; }
    const float mnC = -mn * C;
#pragma unroll
    for (int r = 0; r < 16; ++r) p0[r] = fmaf(p0[r], C, mnC);
#pragma unroll
    for (int r = 0; r < 16; ++r) p1[r] = fmaf(p1[r], C, mnC);
#pragma unroll
    for (int r = 0; r < 16; ++r) p0[r] = __builtin_amdgcn_exp2f(p0[r]);
}
__device__ __forceinline__ void finishSM(f32x16& p0, f32x16& p1, float alpha, float& l_reg, bf16x8& pa0, bf16x8& pa1, bf16x8& pa2, bf16x8& pa3) {
#pragma unroll
    for (int r = 0; r < 16; ++r) p1[r] = __builtin_amdgcn_exp2f(p1[r]);
    float ps = 0;
#pragma unroll
    for (int r = 0; r < 16; ++r) ps += p0[r];
#pragma unroll
    for (int r = 0; r < 16; ++r) ps += p1[r];
    { auto rr = __builtin_amdgcn_permlane32_swap(__float_as_uint(ps), __float_as_uint(ps), false, false); ps = __uint_as_float(rr[0]) + __uint_as_float(rr[1]); }
    l_reg = l_reg * alpha + ps;
#define PK4(P, BASE, OUT) do { unsigned a0 = cvtpk(P[BASE + 0], P[BASE + 1]), a1 = cvtpk(P[BASE + 2], P[BASE + 3]);   \
    unsigned b0 = cvtpk(P[BASE + 4], P[BASE + 5]), b1 = cvtpk(P[BASE + 6], P[BASE + 7]);                              \
    auto r0 = __builtin_amdgcn_permlane32_swap(a0, b0, false, false); auto r1 = __builtin_amdgcn_permlane32_swap(a1, b1, false, false); \
    u32x4 w = {r0[0], r1[0], r0[1], r1[1]}; OUT = __builtin_bit_cast(bf16x8, w); } while (0)
    PK4(p0, 0, pa0); PK4(p0, 8, pa1); PK4(p1, 0, pa2); PK4(p1, 8, pa3);
#undef PK4
}
__device__ __forceinline__ void qkt(f32x16& p0, f32x16& p1, const LAS unsigned char* Ks, const bf16x8* qr, int r32, int hi) {
    p0 = f32x16{}; p1 = f32x16{};
#pragma unroll
    for (int d0 = 0; d0 < 6; ++d0) { const int cb = (d0 * 16 + hi * 8) * 2;
        const bf16x8 b0 = *(const LAS bf16x8*)(Ks + r32 * KP + cb);
        const bf16x8 b1 = *(const LAS bf16x8*)(Ks + (32 + r32) * KP + cb);
        p0 = __builtin_amdgcn_mfma_f32_32x32x16_bf16(b0, qr[d0], p0, 0, 0, 0);
        p1 = __builtin_amdgcn_mfma_f32_32x32x16_bf16(b1, qr[d0], p1, 0, 0, 0); }
}
__device__ __forceinline__ int v_st(int k, int c) { const int kk = (k & ~0xC) | ((k & 4) << 1) | ((k & 8) >> 1); return ((kk >> 3) * 2 + (c >> 5)) * 512 + ((kk & 7) * 32 + (c & 31)) * 2; }
__device__ __forceinline__ int v_rd_base(int lane) { return ((lane & 3) << 3) | (((lane >> 2) & 3) << 6) | (((lane >> 4) & 1) << 5) | (((lane >> 5) & 1) << 8); }
constexpr int v_rd_off(int d0, int ks, int half) { return d0 * 512 + ks * 2048 + half * 1024; }
template <int OFF> __device__ __forceinline__ s16x4 tr_read(int vb) { s16x4 r; asm volatile("ds_read_b64_tr_b16 %0, %1 offset:%2" : "=&v"(r) : "v"(vb), "i"(OFF) : "memory"); return r; }
template <int D0> __device__ __forceinline__ void pv_one(f32x16& od, int vb, bf16x8 pa0, bf16x8 pa1, bf16x8 pa2, bf16x8 pa3) {
    const s16x4 l0 = tr_read<v_rd_off(D0, 0, 0)>(vb), h0 = tr_read<v_rd_off(D0, 0, 1)>(vb), l1 = tr_read<v_rd_off(D0, 1, 0)>(vb), h1 = tr_read<v_rd_off(D0, 1, 1)>(vb);
    const s16x4 l2 = tr_read<v_rd_off(D0, 2, 0)>(vb), h2 = tr_read<v_rd_off(D0, 2, 1)>(vb), l3 = tr_read<v_rd_off(D0, 3, 0)>(vb), h3 = tr_read<v_rd_off(D0, 3, 1)>(vb);
    asm volatile("s_waitcnt lgkmcnt(0)" ::: "memory"); SBAR();
#define PK(L, H) (bf16x8){L[0], L[1], L[2], L[3], H[0], H[1], H[2], H[3]}
    od = __builtin_amdgcn_mfma_f32_32x32x16_bf16(pa0, PK(l0, h0), od, 0, 0, 0);
    od = __builtin_amdgcn_mfma_f32_32x32x16_bf16(pa1, PK(l1, h1), od, 0, 0, 0);
    od = __builtin_amdgcn_mfma_f32_32x32x16_bf16(pa2, PK(l2, h2), od, 0, 0, 0);
    od = __builtin_amdgcn_mfma_f32_32x32x16_bf16(pa3, PK(l3, h3), od, 0, 0, 0);
#undef PK
}
__device__ __forceinline__ void pv_d0(f32x16* o, int vb, bf16x8 pa0, bf16x8 pa1, bf16x8 pa2, bf16x8 pa3) { pv_one<0>(o[0], vb, pa0, pa1, pa2, pa3); pv_one<1>(o[1], vb, pa0, pa1, pa2, pa3); }

__device__ __forceinline__ void attn_unit(const bf16_t* __restrict__ Qb, const bf16_t* __restrict__ Kn, const bf16_t* __restrict__ Kr, const bf16_t* __restrict__ Vh,
                                          bf16_t* __restrict__ Ob, long lat0, long ctx0, int nlat, int NT, LAS unsigned char* lds) {
    int tid_ = threadIdx.x; asm volatile("" : "+v"(tid_));
    const int tid = tid_, wid = tid >> 6, lane = tid & 63, r32 = lane & 31, hi = lane >> 5;
    LAS unsigned char* V_lds = lds + OFF_V; LAS unsigned char* K_lds = lds + OFF_K;
    LAS float* ws = (LAS float*)(lds + OFF_WS) + wid * 64; LAS float* li_l = ws; LAS float* al_l = ws + 32;
    float m_reg = -1e30f, l_reg = 0; f32x16 o[2] = {}; bf16x8 qr[6];
    const bf16_t* Qw = Qb + (long)(wid * 32 + r32) * 768 + hi * 8;
#pragma unroll
    for (int d0 = 0; d0 < 6; ++d0) qr[d0] = *(const bf16x8*)(Qw + d0 * 16);
    const int sr = tid >> 3, sc = (tid & 7) * 8, vst = v_st(sr, sc);
    const int kr_ = (tid & 255) >> 2, kc_ = (tid & 3) * 8;
    const int vb0 = (int)(uintptr_t)V_lds + v_rd_base(lane);
    struct { bf16x8 vs, kn, kp; } sr_[2];
#define KROW(j, kk) (((j) < nlat) ? (lat0 + (long)(j) * 64 + (kk)) : (ctx0 + (long)((j) - nlat) * 64 + (kk)))
#define SLOAD(i, j) do { const long r0_ = KROW(j, sr), r1_ = KROW(j, kr_); sr_[i].vs = *(const bf16x8*)(Vh + r0_ * 512 + sc); sr_[i].kn = *(const bf16x8*)(Kn + r0_ * 544 + sc); sr_[i].kp = *(const bf16x8*)(Kr + r1_ * 544 + kc_); } while (0)
#define SWRITE(b, i) do { *(LAS bf16x8*)(V_lds + (b) * SHM_V + vst) = sr_[i].vs; *(LAS bf16x8*)(K_lds + (b) * SHM_K + sr * KP + sc * 2) = sr_[i].kn; \
    *(LAS bf16x8*)(K_lds + (b) * SHM_K + kr_ * KP + 128 + kc_ * 2) = sr_[i].kp; } while (0)
#define SWAIT() asm volatile("s_waitcnt vmcnt(3)" ::: "memory")
#define RESC(a) do { if (__any((a) < 1.f)) { if (hi == 0) al_l[r32] = (a); asm volatile("s_waitcnt lgkmcnt(0)" ::: "memory"); \
    _Pragma("unroll") for (int d = 0; d < 2; ++d) _Pragma("unroll") for (int r = 0; r < 16; ++r) o[d][r] *= al_l[crow(r, hi)]; } } while (0)
    f32x16 pA0, pA1, pB0, pB1; float mnA, mnB, alA, alB; bf16x8 pa0, pa1, pa2, pa3;
    constexpr int SE = 0, SO = 1;
    SLOAD(SE, 0); asm volatile("s_waitcnt vmcnt(0)" ::: "memory"); SWRITE(0, SE); __syncthreads();
    qkt(pA0, pA1, K_lds, qr, r32, hi); partialSM(pA0, pA1, m_reg, mnA, alA);
    SLOAD(SO, 1); if (2 < NT) SLOAD(SE, 2);
    SWAIT(); SWRITE(1, SO); __syncthreads();
    for (int j = 1; j + 1 < NT; j += 2) {
        SBAR(); qkt(pB0, pB1, K_lds + SHM_K, qr, r32, hi);
        finishSM(pA0, pA1, alA, l_reg, pa0, pa1, pa2, pa3); SBAR();
        SLOAD(SO, j + 2); SBAR();
        pv_d0(o, vb0, pa0, pa1, pa2, pa3); partialSM(pB0, pB1, m_reg, mnB, alB);
        __syncthreads(); SWAIT(); SWRITE(0, SE);
        RESC(alB); __syncthreads();
        SBAR(); qkt(pA0, pA1, K_lds, qr, r32, hi);
        finishSM(pB0, pB1, alB, l_reg, pa0, pa1, pa2, pa3); SBAR();
        if (j + 3 < NT) SLOAD(SE, j + 3); SBAR();
        pv_d0(o, vb0 + SHM_V, pa0, pa1, pa2, pa3); partialSM(pA0, pA1, m_reg, mnA, alA);
        __syncthreads(); SWAIT(); SWRITE(1, SO);
        RESC(alA); __syncthreads();
    }
    SBAR(); qkt(pB0, pB1, K_lds + SHM_K, qr, r32, hi);
    finishSM(pA0, pA1, alA, l_reg, pa0, pa1, pa2, pa3); SBAR();
    pv_d0(o, vb0, pa0, pa1, pa2, pa3); partialSM(pB0, pB1, m_reg, mnB, alB);
    __syncthreads(); RESC(alB);
    finishSM(pB0, pB1, alB, l_reg, pa0, pa1, pa2, pa3); SBAR();
    pv_d0(o, vb0 + SHM_V, pa0, pa1, pa2, pa3);
    if (hi == 0) li_l[r32] = l_reg; asm volatile("s_waitcnt lgkmcnt(0)" ::: "memory");
    float rli[16];
#pragma unroll
    for (int r = 0; r < 16; ++r) rli[r] = __builtin_amdgcn_rcpf(li_l[crow(r, hi)]);
    bf16_t* Ow = Ob + (long)(wid * 32) * 512;
#pragma unroll
    for (int r = 0; r < 16; ++r) { const int orow = crow(r, hi);
#pragma unroll
        for (int d0 = 0; d0 < 2; ++d0) Ow[(long)orow * 512 + d0 * 32 + r32] = (bf16_t)f2bf(o[d0][r] * rli[r]); }
    __syncthreads();
#undef KROW
#undef SLOAD
#undef SWRITE
#undef SWAIT
#undef RESC
}
#undef SBAR
}

__device__ __forceinline__ void attn_latent_unit(const Ctx& F, unsigned char* ws, unsigned char* ha, int b, int h, int qb) {
    bf16_t* Y = (bf16_t*)(ws + D_YMLA); const long q0 = (long)b * SEQ + qb * 256;
    if (b < 4) { const bf16_t* Q = (const bf16_t*)(ha + HA_Q); const bf16_t* K = (const bf16_t*)(ha + HA_K); const bf16_t* V = (const bf16_t*)(ha + HA_V);
        attn::attn_unit(Q + q0 * 768 + h * 96, K + h * 64, K + 512, V + h * 64, Y + q0 * 512 + h * 64, (long)b * SEQ, (long)4 * SEQ + b * CTXL, 64, 68, F.lds); }
    else { const bf16_t* Q = (const bf16_t*)(ws + D_Q); const bf16_t* K = (const bf16_t*)(ws + D_K); const bf16_t* V = (const bf16_t*)(ws + D_V);
        attn::attn_unit(Q + q0 * 768 + h * 96, K + h * 64, K + 512, V + h * 64, Y + q0 * 512 + h * 64, (long)b * SEQ, (long)RL + b * CTXL, 64, 68, F.lds); }
}
__device__ __forceinline__ void attn_phase(const Ctx& F, int layer) {
    unsigned char* ws = getpp()->ws; unsigned char* ha = half_a_base(layer); const bool with_ctx_q = (layer == 0);
    const int vcu = (F.G % 8 == 0) ? (F.bid % 8) * (F.G / 8) + F.bid / 8 : F.bid;
    const int nlat_units = 4 * 8 * 16, nunits = nlat_units + (with_ctx_q ? NBATCH * 8 : 0);
    for (int u = vcu; u < nunits; u += F.G) {
        if (u < nlat_units) { const int bh = u >> 4, qb = u & 15; attn_latent_unit(F, ws, ha, 4 + (bh >> 3), bh & 7, qb); }
        else { const int bh = u - nlat_units, b = bh >> 3, h = bh & 7; bf16_t* Y = (bf16_t*)(ws + D_YMLA); const long yrow = (long)RL + b * CTXL;
            if (b < 4) { const bf16_t* Q = (const bf16_t*)(ha + HA_Q); const bf16_t* K = (const bf16_t*)(ha + HA_K); const bf16_t* V = (const bf16_t*)(ha + HA_V); const long q0 = (long)4 * SEQ + b * CTXL;
                attn::attn_unit(Q + q0 * 768 + h * 96, K + h * 64, K + 512, V + h * 64, Y + yrow * 512 + h * 64, 0, q0, 0, 4, F.lds); }
            else { const bf16_t* Q = (const bf16_t*)(ws + D_Q); const bf16_t* K = (const bf16_t*)(ws + D_K); const bf16_t* V = (const bf16_t*)(ws + D_V);
                attn::attn_unit(Q + yrow * 768 + h * 96, K + h * 64, K + 512, V + h * 64, Y + yrow * 512 + h * 64, 0, yrow, 0, 4, F.lds); } }
    }
}

__device__ __forceinline__ void load8_shift(const bf16_t* u, long row, int t, int T, int col, const float* mu, float* out) {
    float x[8], p[8], n[8];
    const bool hp = t > 0, hn = t < T - 1;
    const u32x4 wx = *(const u32x4*)(u + row * RWC + col), wp = *(const u32x4*)(u + (row - (hp ? 1 : 0)) * RWC + col), wn = *(const u32x4*)(u + (row + (hn ? 1 : 0)) * RWC + col);
    unpack8(wx, x); unpack8(wp, p); unpack8(wn, n);
    const float mp = hp ? 0.5f : 0.f, mn = hn ? 0.5f : 0.f;
    const f32x4 m0 = *(const f32x4*)(mu + col), m1 = *(const f32x4*)(mu + col + 4);
#pragma unroll
    for (int j = 0; j < 8; ++j) out[j] = x[j] + (j < 4 ? m0[j & 3] : m1[j & 3]) * (mp * p[j] + mn * n[j] - x[j]);
}
__device__ __forceinline__ void load8_shift_l(const bf16_t* u, long row, int t, int T, int col, const LAS float* mu8, float* out) {
    float x[8], p[8], n[8];
    const bool hp = t > 0, hn = t < T - 1;
    const u32x4 wx = *(const u32x4*)(u + row * RWC + col), wp = *(const u32x4*)(u + (row - (hp ? 1 : 0)) * RWC + col), wn = *(const u32x4*)(u + (row + (hn ? 1 : 0)) * RWC + col);
    unpack8(wx, x); unpack8(wp, p); unpack8(wn, n);
    const float mp = hp ? 0.5f : 0.f, mn = hn ? 0.5f : 0.f;
    const f32x4 m0 = *(const LAS f32x4*)(mu8), m1 = *(const LAS f32x4*)(mu8 + 4);
#pragma unroll
    for (int j = 0; j < 8; ++j) out[j] = x[j] + (j < 4 ? m0[j & 3] : m1[j & 3]) * (mp * p[j] + mn * n[j] - x[j]);
}
namespace rw2 {
constexpr int PT = 72;
constexpr int O_W2T = 0, O_A2T = 9216, O_ZL = 18432, O_AL = 34816, O_XWD = 51200, O_XAD = 60416, O_RING = 18432;
constexpr int O_TA = 69632, O_TB = O_TA + 9216, O_TK = O_TB + 9216, O_TR = O_TK + 9216, O_OUT = 69632;
constexpr int O_BH = 106496, O_KH = O_BH + 9216, O_V = O_KH + 9216, O_TOT = 134144, O_PL = 136192, O_PRM = 137216;
__device__ __forceinline__ s16x4 cv4(f32x4 v) { u32x2 w; w.x = pk2(v[0], v[1]); w.y = pk2(v[2], v[3]); return __builtin_bit_cast(s16x4, w); }
__device__ __forceinline__ f32x4 mm16(s16x4 a, s16x4 b, f32x4 c) { return __builtin_amdgcn_mfma_f32_16x16x16bf16_1k(a, b, c, 0, 0, 0); }
__device__ __forceinline__ f32x4 mm32(bf16x8 a, bf16x8 b, f32x4 c) { return __builtin_amdgcn_mfma_f32_16x16x32_bf16(a, b, c, 0, 0, 0); }
__device__ __forceinline__ f32x4 bf4_to_f(s16x4 s) { const u32x2 w = __builtin_bit_cast(u32x2, s); return (f32x4){bflo(w.x), bfhi(w.x), bflo(w.y), bfhi(w.y)}; }
typedef short v4i16_t __attribute__((ext_vector_type(4)));
__device__ __forceinline__ s16x4 trd(const LAS bf16_t* base, int row0, int col0, int lane) {
    const int g = lane >> 4, i = lane & 15, q = i >> 2, p = i & 3;
    return __builtin_bit_cast(s16x4, __builtin_amdgcn_ds_read_tr16_b64_v4i16((LAS v4i16_t*)(base + (row0 + 4 * g + q) * PT + col0 + 4 * p)));
}
__device__ __forceinline__ float fast_tanh(float x) { return 1.0f - 2.0f * __builtin_amdgcn_rcpf(__builtin_amdgcn_exp2f(2.8853900817779268f * x) + 1.0f); }
}
__device__ __forceinline__ void rwkv_chain2(const Ctx& F, int layer, int b, int h, int d) {
    using namespace rw2;
    PP P = getpp(); unsigned char* ws = P->ws;
    const bf16_t* u = (const bf16_t*)(ws + D_URWKV);
    bf16_t* od = (bf16_t*)(ws + (d ? D_OB : D_OF));
    float* bsc = (float*)(ws + WS_BSC) + (size_t)d * RT * 8;
    LAS unsigned char* L = F.lds;
    LAS bf16_t* w2t = (LAS bf16_t*)(L + O_W2T); LAS bf16_t* a2t = (LAS bf16_t*)(L + O_A2T);
    LAS float* Zl = (LAS float*)(L + O_ZL); LAS float* Al = (LAS float*)(L + O_AL);
    LAS bf16_t* Xwd = (LAS bf16_t*)(L + O_XWD); LAS bf16_t* Xad = (LAS bf16_t*)(L + O_XAD);
    LAS bf16_t* TA = (LAS bf16_t*)(L + O_TA); LAS bf16_t* TB = (LAS bf16_t*)(L + O_TB); LAS bf16_t* TK = (LAS bf16_t*)(L + O_TK); LAS bf16_t* TR = (LAS bf16_t*)(L + O_TR);
    LAS bf16_t* BH = (LAS bf16_t*)(L + O_BH); LAS bf16_t* KH = (LAS bf16_t*)(L + O_KH); LAS bf16_t* Vm = (LAS bf16_t*)(L + O_V);
    LAS float* tot = (LAS float*)(L + O_TOT); LAS float* pLs = (LAS float*)(L + O_PL); LAS float* Out = (LAS float*)(L + O_OUT);
    LAS float* prm = (LAS float*)(L + O_PRM);
    const int tid0 = F.tid, w = F.wave;
    {
        const int tid = tid0;
        const float* mu = P->in[I_MU] + layer * RWC;
        const float* w0 = P->in[I_W0] + (layer * 2 + d) * 512 + h * 64;
        const float* w2 = P->in[I_W2] + (size_t)(layer * 2 + d) * 64 * 512 + h * 64;
        const float* a0 = P->in[I_A0] + (layer * 2 + d) * 512 + h * 64;
        const float* a2 = P->in[I_A2] + (size_t)(layer * 2 + d) * 64 * 512 + h * 64;
        const float* k_k = P->in[I_KK] + layer * 512 + h * 64; const float* k_a = P->in[I_KA] + layer * 512 + h * 64; const float* r_k = P->in[I_RK] + layer * 512 + h * 64;
        for (int i = tid; i < 640; i += NTHREADS) { const int rr = i >> 6, cc = i & 63; float v;
            if (rr == 0) v = mu[h * 64 + cc]; else if (rr == 1) v = mu[512 + h * 64 + cc]; else if (rr == 2) v = mu[1024 + h * 64 + cc]; else if (rr == 3) v = mu[1536 + d * 64 + cc]; else if (rr == 4) v = mu[1664 + d * 64 + cc];
            else if (rr == 5) v = w0[cc]; else if (rr == 6) v = a0[cc]; else if (rr == 7) v = k_k[cc]; else if (rr == 8) v = k_a[cc]; else v = r_k[cc];
            prm[i] = v; }
        for (int i = tid; i < 4096; i += NTHREADS) { const int k = i >> 6, cc = i & 63; w2t[cc * PT + k] = (bf16_t)f2bf(w2[(size_t)k * 512 + cc]); a2t[cc * PT + k] = (bf16_t)f2bf(a2[(size_t)k * 512 + cc]); }
    }
    f32x4 Z[4];
#pragma unroll
    for (int j = 0; j < 4; ++j) Z[j] = (f32x4){0.f, 0.f, 0.f, 0.f};
    __syncthreads();
    for (int seq = 0; seq < 2; ++seq) {
        const int T = seq ? SEQ : CTXL; const long rbase = seq ? (long)b * SEQ : (long)RL + b * CTXL; const int nch = T / 64;
        for (int ci = 0; ci < nch; ++ci) {
            int tid = tid0; asm volatile("" : "+v"(tid));
            const int lane = tid & 63, fr = lane & 15, fq = lane >> 4, tt = tid >> 3, c8 = (tid & 7) * 8;
            const int tpos = d ? (T - 1 - (ci * 64 + tt)) : (ci * 64 + tt); const long row = rbase + tpos;
            float r[8], k[8], kk[8], av[8], kd[8], lw[8];
            {
                float v[8], x[8];
                load8_shift_l(u, row, tpos, T, h * 64 + c8, prm + c8, r);
                load8_shift_l(u, row, tpos, T, 512 + h * 64 + c8, prm + 64 + c8, k);
                load8_shift_l(u, row, tpos, T, 1024 + h * 64 + c8, prm + 128 + c8, v);
                *(LAS u32x4*)(Vm + tt * PT + c8) = pack8(v);
                load8_shift_l(u, row, tpos, T, 1536 + d * 64 + c8, prm + 192 + c8, x);
#pragma unroll
                for (int e = 0; e < 8; ++e) x[e] = fast_tanh(x[e]);
                *(LAS u32x4*)(Xwd + tt * PT + c8) = pack8(x);
                load8_shift_l(u, row, tpos, T, 1664 + d * 64 + c8, prm + 256 + c8, x);
                *(LAS u32x4*)(Xad + tt * PT + c8) = pack8(x);
            }
            __syncthreads();
            {
#pragma unroll
                for (int q = 0; q < 2; ++q) { const int id = 2 * w + q, tm = id >> 2, tn = id & 3;
                    f32x4 az = {0.f, 0.f, 0.f, 0.f}, aa = {0.f, 0.f, 0.f, 0.f};
#pragma unroll
                    for (int ks = 0; ks < 2; ++ks) {
                        az = mm32(*(const LAS bf16x8*)(Xwd + (16 * tm + fr) * PT + ks * 32 + fq * 8), *(const LAS bf16x8*)(w2t + (16 * tn + fr) * PT + ks * 32 + fq * 8), az);
                        aa = mm32(*(const LAS bf16x8*)(Xad + (16 * tm + fr) * PT + ks * 32 + fq * 8), *(const LAS bf16x8*)(a2t + (16 * tn + fr) * PT + ks * 32 + fq * 8), aa); }
#pragma unroll
                    for (int e = 0; e < 4; ++e) { Zl[(16 * tm + 4 * fq + e) * 64 + 16 * tn + fr] = az[e]; Al[(16 * tm + 4 * fq + e) * 64 + 16 * tn + fr] = aa[e]; } }
            }
            __syncthreads();
            {
                float ss = 0.f, bs = 0.f;
#pragma unroll
                for (int e = 0; e < 8; ++e) { kk[e] = k[e] * prm[448 + c8 + e]; ss += kk[e] * kk[e]; }
                ss += shx(ss, 1, lane); ss += shx(ss, 2, lane); ss += shx(ss, 4, lane);
                const float inv = __builtin_amdgcn_rsqf(fmaxf(ss, 1e-24f));
#pragma unroll
                for (int e = 0; e < 8; ++e) {
                    kk[e] *= inv;
                    const float z = Zl[tt * 64 + c8 + e] + prm[320 + c8 + e];
                    lw[e] = -sigmoidf_(z) * 0.8750612633917001f;
                    av[e] = sigmoidf_(Al[tt * 64 + c8 + e] + prm[384 + c8 + e]);
                    kd[e] = k[e] * (1.0f + (av[e] - 1.0f) * prm[512 + c8 + e]);
                    bs += r[e] * kd[e] * prm[576 + c8 + e];
                }
                bs += shx(bs, 1, lane); bs += shx(bs, 2, lane); bs += shx(bs, 4, lane);
                if ((tid & 7) == 0) bsc[(size_t)row * 8 + h] = bs;
            }
            float cum[8];
            {
#pragma unroll
                for (int e = 0; e < 8; ++e) cum[e] = lw[e];
#pragma unroll
                for (int off = 8; off < 64; off <<= 1) {
#pragma unroll
                    for (int e = 0; e < 8; ++e) { const float t = __int_as_float(__builtin_amdgcn_ds_bpermute(((lane - off) & 63) << 2, __float_as_int(cum[e]))); cum[e] += (lane >= off) ? t : 0.f; } }
                if (lane >= 56) {
#pragma unroll
                    for (int e = 0; e < 8; ++e) tot[w * 64 + c8 + e] = cum[e]; }
            }
            __syncthreads();
            {
                float ta[8], tb[8], tk[8], tr[8], bh[8], kh[8];
                const int w0i = (w & ~1) * 64 + c8;
#pragma unroll
                for (int e = 0; e < 8; ++e) {
                    const float t0 = tot[w0i + e], t1 = tot[w0i + 64 + e];
                    const float cm = cum[e] + ((w & 1) ? t0 : 0.f), cumL = t0 + t1;
                    const float e1 = __builtin_amdgcn_exp2f(cm - lw[e]), e2 = __builtin_amdgcn_exp2f(-cm), e3 = __builtin_amdgcn_exp2f(cm), e4 = __builtin_amdgcn_exp2f(cumL - cm);
                    const float ka = kk[e] * av[e];
                    ta[e] = -kk[e] * e1; tb[e] = ka * e2; tk[e] = kd[e] * e2; tr[e] = r[e] * e3; bh[e] = ka * e4; kh[e] = kd[e] * e4;
                    if ((tt & 15) == 15) pLs[(tt >> 4) * 64 + c8 + e] = e3;
                }
                *(LAS u32x4*)(TA + tt * PT + c8) = pack8(ta); *(LAS u32x4*)(TB + tt * PT + c8) = pack8(tb); *(LAS u32x4*)(TK + tt * PT + c8) = pack8(tk); *(LAS u32x4*)(TR + tt * PT + c8) = pack8(tr);
                *(LAS u32x4*)(BH + tt * PT + c8) = pack8(bh); *(LAS u32x4*)(KH + tt * PT + c8) = pack8(kh);
            }
            __syncthreads();
            if (w < 4) {
                const int s = w; const int rowf = (16 * s + fr) * PT;
                f32x4 Mab = {0.f, 0.f, 0.f, 0.f}, MabT = Mab, MakT = Mab, Mbr = Mab, Mkr = Mab;
#pragma unroll
                for (int ks = 0; ks < 2; ++ks) { const int o = rowf + ks * 32 + fq * 8;
                    const bf16x8 fa = *(const LAS bf16x8*)(TA + o), fb = *(const LAS bf16x8*)(TB + o), fk = *(const LAS bf16x8*)(TK + o), frr = *(const LAS bf16x8*)(TR + o);
                    Mab = mm32(fb, fa, Mab); MabT = mm32(fa, fb, MabT); MakT = mm32(fa, fk, MakT); Mbr = mm32(fb, frr, Mbr); Mkr = mm32(fk, frr, Mkr); }
                f32x4 Pm, Pt;
#pragma unroll
                for (int e = 0; e < 4; ++e) { const int m = 4 * fq + e, n = fr;
                    Mab[e] = (m < n) ? Mab[e] : 0.f; MabT[e] = (n < m) ? MabT[e] : 0.f; MakT[e] = (n < m) ? MakT[e] : 0.f; Mbr[e] = (m <= n) ? Mbr[e] : 0.f; Mkr[e] = (m <= n) ? Mkr[e] : 0.f;
                    const float id = (m == n) ? 1.f : 0.f; Pm[e] = Mab[e] + id; Pt[e] = MabT[e] + id; }
                f32x4 Nn = Mab, Nt = MabT; const f32x4 zero = {0.f, 0.f, 0.f, 0.f};
#pragma unroll
                for (int it = 0; it < 3; ++it) {
                    const s16x4 cn = cv4(Nn), cnt = cv4(Nt);
                    const f32x4 N2 = mm16(cnt, cn, zero), Nt2 = mm16(cn, cnt, zero);
                    const s16x4 cp = cv4(Pm), cpt = cv4(Pt), cn2 = cv4(N2);
                    const f32x4 Pn = mm16(cpt, cn2, Pm), Ptn = mm16(cn2, cpt, Pt);
                    Nn = N2; Nt = Nt2; Pm = Pn; Pt = Ptn; (void)cp;
                }
                const s16x4 cT = cv4(Pm), cMakT = cv4(MakT), cMbr = cv4(Mbr);
                const f32x4 Q1T = mm16(cT, cMakT, zero);
                const s16x4 cQ1T = cv4(Q1T);
                const f32x4 Hy = mm16(cQ1T, cMbr, Mkr);
                LAS unsigned char* ring = L + O_RING + s * 12800 + lane * 8;
                *(LAS s16x4*)(ring + 20 * 512) = cv4(Hy);
                s16x4 bhf[4];
#pragma unroll
                for (int jt = 0; jt < 4; ++jt) bhf[jt] = trd(BH, 16 * s, 16 * jt, lane);
#pragma unroll
                for (int jt = 0; jt < 4; ++jt) {
                    const s16x4 atf = trd(TA, 16 * s, 16 * jt, lane);
                    const f32x4 P1T = mm16(cT, atf, zero); const s16x4 cP1T = cv4(P1T);
                    const f32x4 rinit = bf4_to_f(*(const LAS s16x4*)(TR + (16 * s + fr) * PT + 16 * jt + 4 * fq));
                    const f32x4 Gy = mm16(cP1T, cMbr, rinit);
                    *(LAS s16x4*)(ring + jt * 512) = cv4(Gy);
#pragma unroll
                    for (int j2 = 0; j2 < 4; ++j2) { const f32x4 Gs = mm16(cP1T, bhf[j2], zero); *(LAS s16x4*)(ring + (4 + jt * 4 + j2) * 512) = cv4(Gs); }
                    const f32x4 kinit = bf4_to_f(trd(KH, 16 * s, 16 * jt, lane));
                    const f32x4 Hs = mm16(cQ1T, bhf[jt], kinit);
                    *(LAS s16x4*)(ring + (21 + jt) * 512) = cv4(Hs);
                }
            }
            __syncthreads();
            if (w < 4) {
                const int it = w;
#pragma unroll 1
                for (int s = 0; s < 4; ++s) {
                    const LAS unsigned char* ring = L + O_RING + s * 12800 + lane * 8;
                    const s16x4 vb = trd(Vm, 16 * s, 16 * it, lane);
                    s16x4 zb[4];
#pragma unroll
                    for (int jt = 0; jt < 4; ++jt) zb[jt] = cv4(Z[jt]);
                    f32x4 Yt = mm16(*(const LAS s16x4*)(ring + 20 * 512), vb, (f32x4){0.f, 0.f, 0.f, 0.f});
#pragma unroll
                    for (int jt = 0; jt < 4; ++jt) Yt = mm16(*(const LAS s16x4*)(ring + jt * 512), zb[jt], Yt);
#pragma unroll
                    for (int e = 0; e < 4; ++e) Out[(16 * s + 4 * fq + e) * 64 + 16 * it + fr] = Yt[e];
                    f32x4 Zn[4];
#pragma unroll
                    for (int j2 = 0; j2 < 4; ++j2) {
                        const f32x4 pv = *(const LAS f32x4*)(pLs + s * 64 + 16 * j2 + 4 * fq);
                        f32x4 zn = Z[j2] * pv;
                        zn = mm16(*(const LAS s16x4*)(ring + (21 + j2) * 512), vb, zn);
#pragma unroll
                        for (int jt = 0; jt < 4; ++jt) zn = mm16(*(const LAS s16x4*)(ring + (4 + jt * 4 + j2) * 512), zb[jt], zn);
                        Zn[j2] = zn;
                    }
#pragma unroll
                    for (int j2 = 0; j2 < 4; ++j2) Z[j2] = Zn[j2];
                }
            }
            __syncthreads();
            {
                float v[8];
#pragma unroll
                for (int e = 0; e < 8; ++e) v[e] = Out[tt * 64 + c8 + e];
                *(u32x4*)(od + (size_t)row * 512 + h * 64 + c8) = pack8(v);
            }
            __syncthreads();
        }
    }
}

namespace rw4 {
using namespace rw2;
constexpr int RGN = 16384, R_TA = 0, R_TB = 2304, R_TK = 4608, R_TR = 6912, R_BH = 9216, R_KH = 11520, R_V = 13824, R_PL = 16128;
constexpr int R_XWD = 0, R_XAD = 2304, R_ZL = 4608, R_AL = 8704;
constexpr int O_PRM4 = 8 * RGN;
}
__device__ __forceinline__ void rwkv_chain4(const Ctx& F, int layer, int b, int h, int d) {
    using namespace rw4;
    PP P = getpp(); unsigned char* ws = P->ws;
    const bf16_t* u = (const bf16_t*)(ws + D_URWKV);
    bf16_t* od = (bf16_t*)(ws + (d ? D_OB : D_OF));
    float* bsc = (float*)(ws + WS_BSC) + (size_t)d * RT * 8;
    const bf16_t* w2g = (const bf16_t*)(ws + WS_W2T) + (size_t)((layer * 2 + d) * 2 + 0) * 512 * 64 + (size_t)h * 64 * 64;
    const bf16_t* a2g = (const bf16_t*)(ws + WS_W2T) + (size_t)((layer * 2 + d) * 2 + 1) * 512 * 64 + (size_t)h * 64 * 64;
    LAS unsigned char* L = F.lds;
    LAS float* prm = (LAS float*)(L + O_PRM4);
    volatile LAS unsigned* rdy = (volatile LAS unsigned*)(L + O_PRM4 + 2560); LAS unsigned* dne = (LAS unsigned*)(L + O_PRM4 + 2560 + 64);
    unsigned gseq = 0;
    const int tid0 = F.tid, w = F.wave;
    {
        const float* mu = P->in[I_MU] + layer * RWC;
        const float* w0 = P->in[I_W0] + (layer * 2 + d) * 512 + h * 64; const float* a0 = P->in[I_A0] + (layer * 2 + d) * 512 + h * 64;
        const float* k_k = P->in[I_KK] + layer * 512 + h * 64; const float* k_a = P->in[I_KA] + layer * 512 + h * 64; const float* r_k = P->in[I_RK] + layer * 512 + h * 64;
        for (int i = tid0; i < 640; i += NTHREADS) { const int rr = i >> 6, cc = i & 63; float v;
            if (rr == 0) v = mu[h * 64 + cc]; else if (rr == 1) v = mu[512 + h * 64 + cc]; else if (rr == 2) v = mu[1024 + h * 64 + cc]; else if (rr == 3) v = mu[1536 + d * 64 + cc]; else if (rr == 4) v = mu[1664 + d * 64 + cc];
            else if (rr == 5) v = w0[cc]; else if (rr == 6) v = a0[cc]; else if (rr == 7) v = k_k[cc]; else if (rr == 8) v = k_a[cc]; else v = r_k[cc];
            prm[i] = v; }
        if (tid0 < 8) { rdy[tid0] = 0u; dne[tid0] = 0u; }
    }
    f32x4 Z[4];
#pragma unroll
    for (int j = 0; j < 4; ++j) Z[j] = (f32x4){0.f, 0.f, 0.f, 0.f};
    u32x4 raw[2][5][3];
#define RW4_PREFETCH(T_, rbase_, gi_) do { int t0_ = tid0; asm volatile("" : "+v"(t0_)); const int lane_ = t0_ & 63, tk_ = lane_ >> 2, cg_ = lane_ & 3; const int pi_ = (gi_) * 128 + 16 * w + tk_; const int tp_ = d ? ((T_) - 1 - pi_) : pi_; \
        const long row_ = (rbase_) + tp_; const long rp_ = row_ - (tp_ > 0 ? 1 : 0), rn_ = row_ + (tp_ < (T_) - 1 ? 1 : 0); \
        _Pragma("unroll") for (int q_ = 0; q_ < 2; ++q_) _Pragma("unroll") for (int g_ = 0; g_ < 5; ++g_) { \
            const int col_ = (g_ == 0 ? h * 64 : g_ == 1 ? 512 + h * 64 : g_ == 2 ? 1024 + h * 64 : g_ == 3 ? 1536 + d * 64 : 1664 + d * 64) + q_ * 32 + cg_ * 8; \
            raw[q_][g_][0] = *(const u32x4*)(u + row_ * RWC + col_); raw[q_][g_][1] = *(const u32x4*)(u + rp_ * RWC + col_); raw[q_][g_][2] = *(const u32x4*)(u + rn_ * RWC + col_); } } while (0)
    RW4_PREFETCH(CTXL, (long)RL + b * CTXL, 0);
    __syncthreads();
    for (int seq = 0; seq < 2; ++seq) {
        const int T = seq ? SEQ : CTXL; const long rbase = seq ? (long)b * SEQ : (long)RL + b * CTXL; const int ngr = T / 128;
        for (int gi = 0; gi < ngr; ++gi) {
            int tid = tid0; asm volatile("" : "+v"(tid));
            const int lane = tid & 63, fr = lane & 15, fq = lane >> 4, tk = lane >> 2, cg = lane & 3;
            LAS unsigned char* R = L + w * RGN;
            { unsigned sp = 0; while (*(volatile LAS unsigned*)(dne + w) != 4u * gseq) { __builtin_amdgcn_s_sleep(1); if (++sp > (1u << 24)) break; } }
            asm volatile("" ::: "memory");
            {
                const int pi = gi * 128 + 16 * w + tk; const int tpos = d ? (T - 1 - pi) : pi; const long row = rbase + tpos;
                float r[16], k[16], kk[16], av[16], kd[16], lw[16];
                {
                    const float mp = (tpos > 0) ? 0.5f : 0.f, mn = (tpos < T - 1) ? 0.5f : 0.f;
#pragma unroll
                    for (int q = 0; q < 2; ++q) { const int c8 = q * 32 + cg * 8;
#pragma unroll
                        for (int g5 = 0; g5 < 5; ++g5) {
                            float x[8], p[8], n[8], o[8];
                            unpack8(raw[q][g5][0], x); unpack8(raw[q][g5][1], p); unpack8(raw[q][g5][2], n);
                            const f32x4 m0 = *(const LAS f32x4*)(prm + g5 * 64 + c8), m1 = *(const LAS f32x4*)(prm + g5 * 64 + c8 + 4);
#pragma unroll
                            for (int j = 0; j < 8; ++j) o[j] = x[j] + (j < 4 ? m0[j & 3] : m1[j & 3]) * (mp * p[j] + mn * n[j] - x[j]);
                            if (g5 == 0) {
#pragma unroll
                                for (int j = 0; j < 8; ++j) r[8 * q + j] = o[j]; }
                            else if (g5 == 1) {
#pragma unroll
                                for (int j = 0; j < 8; ++j) k[8 * q + j] = o[j]; }
                            else if (g5 == 2) *(LAS u32x4*)(R + R_V + (tk * PT + c8) * 2) = pack8(o);
                            else if (g5 == 3) {
#pragma unroll
                                for (int j = 0; j < 8; ++j) o[j] = fast_tanh(o[j]);
                                *(LAS u32x4*)(R + R_XWD + (tk * PT + c8) * 2) = pack8(o); }
                            else *(LAS u32x4*)(R + R_XAD + (tk * PT + c8) * 2) = pack8(o);
                        } }
                }
                {
                    const LAS bf16_t* Xwd = (const LAS bf16_t*)(R + R_XWD); const LAS bf16_t* Xad = (const LAS bf16_t*)(R + R_XAD);
                    LAS float* Zl = (LAS float*)(R + R_ZL); LAS float* Al = (LAS float*)(R + R_AL);
                    bf16x8 fw[2], fa[2];
#pragma unroll
                    for (int ks = 0; ks < 2; ++ks) { fw[ks] = *(const LAS bf16x8*)(Xwd + fr * PT + ks * 32 + fq * 8); fa[ks] = *(const LAS bf16x8*)(Xad + fr * PT + ks * 32 + fq * 8); }
#pragma unroll
                    for (int tn = 0; tn < 4; ++tn) { f32x4 az = {0.f, 0.f, 0.f, 0.f}, aa = {0.f, 0.f, 0.f, 0.f};
#pragma unroll
                        for (int ks = 0; ks < 2; ++ks) { az = mm32(fw[ks], *(const bf16x8*)(w2g + (16 * tn + fr) * 64 + ks * 32 + fq * 8), az); aa = mm32(fa[ks], *(const bf16x8*)(a2g + (16 * tn + fr) * 64 + ks * 32 + fq * 8), aa); }
#pragma unroll
                        for (int e = 0; e < 4; ++e) { Zl[(4 * fq + e) * 64 + 16 * tn + fr] = az[e]; Al[(4 * fq + e) * 64 + 16 * tn + fr] = aa[e]; } }
                }
                {
                    const LAS float* Zl = (const LAS float*)(R + R_ZL); const LAS float* Al = (const LAS float*)(R + R_AL);
                    float ss = 0.f, bs = 0.f;
                    float pkk[16], pw0[16], pa0[16], pka[16], prk[16], zz[16], aa2[16];
#pragma unroll
                    for (int q = 0; q < 2; ++q) { const int c8 = q * 32 + cg * 8;
#pragma unroll
                        for (int hh = 0; hh < 2; ++hh) { const int o4 = c8 + 4 * hh, i4 = 8 * q + 4 * hh;
                            const f32x4 a = *(const LAS f32x4*)(prm + 448 + o4), b2 = *(const LAS f32x4*)(prm + 320 + o4), c = *(const LAS f32x4*)(prm + 384 + o4), d2 = *(const LAS f32x4*)(prm + 512 + o4), e2 = *(const LAS f32x4*)(prm + 576 + o4);
                            const f32x4 z4 = *(const LAS f32x4*)(Zl + tk * 64 + o4), a4 = *(const LAS f32x4*)(Al + tk * 64 + o4);
#pragma unroll
                            for (int j = 0; j < 4; ++j) { pkk[i4 + j] = a[j]; pw0[i4 + j] = b2[j]; pa0[i4 + j] = c[j]; pka[i4 + j] = d2[j]; prk[i4 + j] = e2[j]; zz[i4 + j] = z4[j]; aa2[i4 + j] = a4[j]; } } }
#pragma unroll
                    for (int i = 0; i < 16; ++i) { kk[i] = k[i] * pkk[i]; ss += kk[i] * kk[i]; }
                    ss += shx(ss, 1, lane); ss += shx(ss, 2, lane);
                    const float inv = __builtin_amdgcn_rsqf(fmaxf(ss, 1e-24f));
#pragma unroll
                    for (int i = 0; i < 16; ++i) {
                        kk[i] *= inv;
                        lw[i] = -sigmoidf_(zz[i] + pw0[i]) * 0.8750612633917001f;
                        av[i] = sigmoidf_(aa2[i] + pa0[i]);
                        kd[i] = k[i] * (1.0f + (av[i] - 1.0f) * pka[i]);
                        bs += r[i] * kd[i] * prk[i]; }
                    bs += shx(bs, 1, lane); bs += shx(bs, 2, lane);
                    if (cg == 0) bsc[(size_t)row * 8 + h] = bs;
                }
                float cum[16], cumL[16];
                {
                    LAS float* Sc = (LAS float*)(R + R_ZL);
#pragma unroll
                    for (int q = 0; q < 2; ++q) { *(LAS f32x4*)(Sc + tk * 64 + q * 32 + cg * 8) = (f32x4){lw[8 * q], lw[8 * q + 1], lw[8 * q + 2], lw[8 * q + 3]}; *(LAS f32x4*)(Sc + tk * 64 + q * 32 + cg * 8 + 4) = (f32x4){lw[8 * q + 4], lw[8 * q + 5], lw[8 * q + 6], lw[8 * q + 7]}; }
                    float a = 0.f;
#pragma unroll
                    for (int t = 0; t < 16; ++t) { a += Sc[t * 64 + lane]; Sc[t * 64 + lane] = a; }
#pragma unroll
                    for (int q = 0; q < 2; ++q) { const f32x4 c0 = *(const LAS f32x4*)(Sc + tk * 64 + q * 32 + cg * 8), c1 = *(const LAS f32x4*)(Sc + tk * 64 + q * 32 + cg * 8 + 4);
                        const f32x4 l0 = *(const LAS f32x4*)(Sc + 15 * 64 + q * 32 + cg * 8), l1 = *(const LAS f32x4*)(Sc + 15 * 64 + q * 32 + cg * 8 + 4);
#pragma unroll
                        for (int e = 0; e < 4; ++e) { cum[8 * q + e] = c0[e]; cum[8 * q + 4 + e] = c1[e]; cumL[8 * q + e] = l0[e]; cumL[8 * q + 4 + e] = l1[e]; } }
                }
                {
#pragma unroll
                    for (int q = 0; q < 2; ++q) { float ta[8], tb[8], tkk[8], tr[8], bh[8], kh[8], plv[8]; const int c8 = q * 32 + cg * 8;
#pragma unroll
                        for (int e = 0; e < 8; ++e) { const int i = 8 * q + e;
                            const float e3 = __builtin_amdgcn_exp2f(cum[i]), e2 = __builtin_amdgcn_rcpf(e3), e1 = __builtin_amdgcn_exp2f(cum[i] - lw[i]), e4 = __builtin_amdgcn_exp2f(cumL[i] - cum[i]);
                            const float ka = kk[i] * av[i];
                            ta[e] = -kk[i] * e1; tb[e] = ka * e2; tkk[e] = kd[i] * e2; tr[e] = r[i] * e3; bh[e] = ka * e4; kh[e] = kd[i] * e4;
                            plv[e] = e3; }
                        *(LAS u32x4*)(R + R_TA + (tk * PT + c8) * 2) = pack8(ta); *(LAS u32x4*)(R + R_TB + (tk * PT + c8) * 2) = pack8(tb); *(LAS u32x4*)(R + R_TK + (tk * PT + c8) * 2) = pack8(tkk);
                        *(LAS u32x4*)(R + R_TR + (tk * PT + c8) * 2) = pack8(tr); *(LAS u32x4*)(R + R_BH + (tk * PT + c8) * 2) = pack8(bh); *(LAS u32x4*)(R + R_KH + (tk * PT + c8) * 2) = pack8(kh);
                        if (tk == 15) { LAS float* pp = (LAS float*)(R + R_PL) + c8; *(LAS f32x4*)pp = (f32x4){plv[0], plv[1], plv[2], plv[3]}; *(LAS f32x4*)(pp + 4) = (f32x4){plv[4], plv[5], plv[6], plv[7]}; } }
                }
                {
                    const LAS bf16_t* TA = (const LAS bf16_t*)(R + R_TA); const LAS bf16_t* TB = (const LAS bf16_t*)(R + R_TB); const LAS bf16_t* TK = (const LAS bf16_t*)(R + R_TK);
                    const LAS bf16_t* TR = (const LAS bf16_t*)(R + R_TR); const LAS bf16_t* BH = (const LAS bf16_t*)(R + R_BH); const LAS bf16_t* KH = (const LAS bf16_t*)(R + R_KH);
                    f32x4 Mab = {0.f, 0.f, 0.f, 0.f}, MabT = Mab, MakT = Mab, Mbr = Mab, Mkr = Mab;
#pragma unroll
                    for (int ks = 0; ks < 2; ++ks) { const int o = fr * PT + ks * 32 + fq * 8;
                        const bf16x8 fa = *(const LAS bf16x8*)(TA + o), fb = *(const LAS bf16x8*)(TB + o), fk = *(const LAS bf16x8*)(TK + o), frr = *(const LAS bf16x8*)(TR + o);
                        Mab = mm32(fb, fa, Mab); MabT = mm32(fa, fb, MabT); MakT = mm32(fa, fk, MakT); Mbr = mm32(fb, frr, Mbr); Mkr = mm32(fk, frr, Mkr); }
                    s16x4 bhf[4], atf[4], rin[4], kin[4];
#pragma unroll
                    for (int jt = 0; jt < 4; ++jt) { bhf[jt] = trd(BH, 0, 16 * jt, lane); atf[jt] = trd(TA, 0, 16 * jt, lane); kin[jt] = trd(KH, 0, 16 * jt, lane); rin[jt] = *(const LAS s16x4*)(TR + fr * PT + 16 * jt + 4 * fq); }
                    f32x4 Pm, Pt;
#pragma unroll
                    for (int e = 0; e < 4; ++e) { const int m = 4 * fq + e, n = fr;
                        Mab[e] = (m < n) ? Mab[e] : 0.f; MabT[e] = (n < m) ? MabT[e] : 0.f; MakT[e] = (n < m) ? MakT[e] : 0.f; Mbr[e] = (m <= n) ? Mbr[e] : 0.f; Mkr[e] = (m <= n) ? Mkr[e] : 0.f;
                        const float id = (m == n) ? 1.f : 0.f; Pm[e] = Mab[e] + id; Pt[e] = MabT[e] + id; }
                    f32x4 Nn = Mab, Nt = MabT; const f32x4 zero = {0.f, 0.f, 0.f, 0.f};
#pragma unroll
                    for (int it = 0; it < 3; ++it) {
                        const s16x4 cn = cv4(Nn), cnt = cv4(Nt);
                        const f32x4 N2 = mm16(cnt, cn, zero), Nt2 = mm16(cn, cnt, zero);
                        const s16x4 cpt = cv4(Pt), cn2 = cv4(N2);
                        const f32x4 Pn = mm16(cpt, cn2, Pm), Ptn = mm16(cn2, cpt, Pt);
                        Nn = N2; Nt = Nt2; Pm = Pn; Pt = Ptn;
                    }
                    const s16x4 cT = cv4(Pm), cMakT = cv4(MakT), cMbr = cv4(Mbr);
                    const f32x4 Q1T = mm16(cT, cMakT, zero);
                    const s16x4 cQ1T = cv4(Q1T);
                    const f32x4 Hy = mm16(cQ1T, cMbr, Mkr);
                    asm volatile("s_waitcnt lgkmcnt(0)" ::: "memory");
                    LAS unsigned char* ring = R + lane * 8;
                    *(LAS s16x4*)(ring + 20 * 512) = cv4(Hy);
#pragma unroll
                    for (int jt = 0; jt < 4; ++jt) {
                        const f32x4 P1T = mm16(cT, atf[jt], zero); const s16x4 cP1T = cv4(P1T);
                        const f32x4 Gy = mm16(cP1T, cMbr, bf4_to_f(rin[jt]));
                        *(LAS s16x4*)(ring + jt * 512) = cv4(Gy);
#pragma unroll
                        for (int j2 = 0; j2 < 4; ++j2) { const f32x4 Gs = mm16(cP1T, bhf[j2], zero); *(LAS s16x4*)(ring + (4 + jt * 4 + j2) * 512) = cv4(Gs); }
                        const f32x4 Hs = mm16(cQ1T, bhf[jt], bf4_to_f(kin[jt]));
                        *(LAS s16x4*)(ring + (21 + jt) * 512) = cv4(Hs);
                    }
                }
            }
            {
                const bool more = gi + 1 < ngr; const bool nseq = !more && seq == 0;
                const int nT = nseq ? SEQ : T; const long nrb = nseq ? (long)b * SEQ : rbase; const int ngi = more ? gi + 1 : (nseq ? 0 : gi);
                RW4_PREFETCH(nT, nrb, ngi);
            }
            ++gseq;
            asm volatile("s_waitcnt lgkmcnt(0)" ::: "memory");
            if (lane == 0) rdy[w] = gseq;
            asm volatile("" ::: "memory");
            if (w < 4) {
                const int it = w;
#pragma unroll 1
                for (int s = 0; s < 8; ++s) {
                    { unsigned sp = 0; while (rdy[s] != gseq) { __builtin_amdgcn_s_sleep(1); if (++sp > (1u << 24)) break; } }
                    asm volatile("" ::: "memory");
                    const LAS unsigned char* Rs = L + s * RGN; const LAS unsigned char* ring = Rs + lane * 8;
                    const s16x4 vb = trd((const LAS bf16_t*)(Rs + R_V), 0, 16 * it, lane);
                    s16x4 zb[4];
#pragma unroll
                    for (int jt = 0; jt < 4; ++jt) zb[jt] = cv4(Z[jt]);
                    f32x4 Yt = mm16(*(const LAS s16x4*)(ring + 20 * 512), vb, (f32x4){0.f, 0.f, 0.f, 0.f});
#pragma unroll
                    for (int jt = 0; jt < 4; ++jt) Yt = mm16(*(const LAS s16x4*)(ring + jt * 512), zb[jt], Yt);
#pragma unroll
                    for (int e = 0; e < 4; ++e) { const int pi = gi * 128 + 16 * s + 4 * fq + e; const int tp = d ? (T - 1 - pi) : pi;
                        od[(size_t)(rbase + tp) * 512 + h * 64 + 16 * it + fr] = (bf16_t)f2bf(Yt[e]); }
                    f32x4 Zn[4];
#pragma unroll
                    for (int j2 = 0; j2 < 4; ++j2) {
                        const f32x4 pv = *(const LAS f32x4*)((const LAS float*)(Rs + R_PL) + 16 * j2 + 4 * fq);
                        f32x4 zn = Z[j2] * pv;
                        zn = mm16(*(const LAS s16x4*)(ring + (21 + j2) * 512), vb, zn);
#pragma unroll
                        for (int jt = 0; jt < 4; ++jt) zn = mm16(*(const LAS s16x4*)(ring + (4 + jt * 4 + j2) * 512), zb[jt], zn);
                        Zn[j2] = zn;
                    }
#pragma unroll
                    for (int j2 = 0; j2 < 4; ++j2) Z[j2] = Zn[j2];
                    asm volatile("s_waitcnt lgkmcnt(0)" ::: "memory");
                    if (lane == 0) (void)__hip_atomic_fetch_add(dne + s, 1u, __ATOMIC_RELAXED, __HIP_MEMORY_SCOPE_WORKGROUP);
                }
            }
        }
    }
#undef RW4_PREFETCH
}

__device__ __forceinline__ void rwkv_post_phase(const Ctx& F, int layer, int nrows_y) {
    PP P = getpp(); unsigned char* ws = P->ws;
    const bf16_t* u = (const bf16_t*)(ws + D_URWKV); const bf16_t* of = (const bf16_t*)(ws + D_OF); const bf16_t* ob = (const bf16_t*)(ws + D_OB);
    bf16_t* y = (bf16_t*)(ws + D_YRWKV);
    const float* bf_ = (const float*)(ws + WS_BSC); const float* bb_ = bf_ + (size_t)RT * 8;
    const float* mu = P->in[I_MU] + layer * RWC; const float* lng = P->in[I_LNG] + layer * 512; const float* lnb = P->in[I_LNB] + layer * 512;
    const bf16_t* wg2 = (const bf16_t*)(ws + WS_WG2) + (size_t)layer * 512 * 128;
    LAS bf16_t* sg = (LAS bf16_t*)F.lds;
    LAS bf16_t* gt = (LAS bf16_t*)(F.lds + 64 * 136 * 2);
    const int tid0 = F.tid, wave = F.wave; const int lane = F.lane;
    const int nunits = nrows_y / 64;
    for (int un = F.bid; un < nunits; un += F.G) {
        int tid = tid0; asm volatile("" : "+v"(tid)); const int lane = tid & 63;
        const long r0 = (long)un * 64; const bool lat = r0 < RL; const int T = lat ? SEQ : CTXL; const int tbase = lat ? (int)(r0 & (SEQ - 1)) : (int)((r0 - RL) & (CTXL - 1));
        for (int it = tid; it < 1024; it += NTHREADS) { const int tk = it >> 4, q = it & 15; float v[8]; load8_shift(u, r0 + tk, tbase + tk, T, 1792 + q * 8, mu, v);
#pragma unroll
            for (int j = 0; j < 8; ++j) v[j] = sigmoidf_(v[j]);
            *(LAS u32x4*)(sg + tk * 136 + q * 8) = pack8(v); }
        __syncthreads();
        {
            const int fr = lane & 15, fq = lane >> 4;
#pragma unroll
            for (int tn = 0; tn < 4; ++tn) { const int cn = (wave * 4 + tn) * 16;
                bf16x8 bfrag[4];
#pragma unroll
                for (int k = 0; k < 4; ++k) bfrag[k] = *(const bf16x8*)(wg2 + (size_t)(cn + fr) * 128 + k * 32 + fq * 8);
#pragma unroll
                for (int tm = 0; tm < 4; ++tm) { f32x4 acc = {0.f, 0.f, 0.f, 0.f};
#pragma unroll
                    for (int k = 0; k < 4; ++k) { const bf16x8 afrag = *(const LAS bf16x8*)(sg + (tm * 16 + fr) * 136 + k * 32 + fq * 8); acc = __builtin_amdgcn_mfma_f32_16x16x32_bf16(afrag, bfrag[k], acc, 0, 0, 0); }
#pragma unroll
                    for (int j = 0; j < 4; ++j) gt[(tm * 16 + fq * 4 + j) * 520 + cn + fr] = (bf16_t)f2bf(acc[j]); } }
        }
        __syncthreads();
        {
            const int tk = tid >> 3, hh = tid & 7; const long row = r0 + tk; const int t = tbase + tk;
            const float bsum = bf_[row * 8 + hh] + bb_[row * 8 + hh];
            float o[64]; float s = 0.f;
#pragma unroll
            for (int q = 0; q < 8; ++q) { float a[8], c[8]; unpack8(*(const u32x4*)(of + row * 512 + hh * 64 + q * 8), a); unpack8(*(const u32x4*)(ob + row * 512 + hh * 64 + q * 8), c);
#pragma unroll
                for (int j = 0; j < 8; ++j) { o[q * 8 + j] = a[j] + c[j]; s += o[q * 8 + j]; } }
            const float mean = s * (1.0f / 64.0f); float vs = 0.f;
#pragma unroll
            for (int j = 0; j < 64; ++j) { const float dd = o[j] - mean; vs += dd * dd; }
            const float rstd = rsqrtf(vs * (1.0f / 64.0f) + 64e-5f);
            const bool hp = t > 0, hn = t < T - 1; const float mp = hp ? 0.5f : 0.f, mn = hn ? 0.5f : 0.f;
            const bf16_t* ux = u + row * RWC + 1024 + hh * 64; const bf16_t* up = u + (row - (hp ? 1 : 0)) * RWC + 1024 + hh * 64; const bf16_t* un = u + (row + (hn ? 1 : 0)) * RWC + 1024 + hh * 64;
            u32x4 rw[2][3]; f32x4 mq[2][2], lq[2][2], bq[2][2];
#define RP_LOAD(s_, q_) do { rw[s_][0] = *(const u32x4*)(ux + (q_) * 8); rw[s_][1] = *(const u32x4*)(up + (q_) * 8); rw[s_][2] = *(const u32x4*)(un + (q_) * 8); \
                const int c_ = hh * 64 + (q_) * 8; mq[s_][0] = *(const f32x4*)(mu + 1024 + c_); mq[s_][1] = *(const f32x4*)(mu + 1024 + c_ + 4); \
                lq[s_][0] = *(const f32x4*)(lng + c_); lq[s_][1] = *(const f32x4*)(lng + c_ + 4); bq[s_][0] = *(const f32x4*)(lnb + c_); bq[s_][1] = *(const f32x4*)(lnb + c_ + 4); } while (0)
            RP_LOAD(0, 0);
#pragma unroll
            for (int q = 0; q < 8; ++q) { const int s = q & 1;
                if (q < 7) RP_LOAD((q + 1) & 1, q + 1);
                float x[8], p[8], n[8], res[8], g8[8]; unpack8(rw[s][0], x); unpack8(rw[s][1], p); unpack8(rw[s][2], n);
                unpack8(*(const LAS u32x4*)(gt + tk * 520 + hh * 64 + q * 8), g8);
#pragma unroll
                for (int j = 0; j < 8; ++j) { const float vv = x[j] + mq[s][j >> 2][j & 3] * (mp * p[j] + mn * n[j] - x[j]);
                    res[j] = ((o[q * 8 + j] - mean) * rstd * lq[s][j >> 2][j & 3] + bq[s][j >> 2][j & 3] + bsum * vv) * g8[j]; }
                *(u32x4*)(y + row * 512 + hh * 64 + q * 8) = pack8(res); }
#undef RP_LOAD
        }
        __syncthreads();
    }
}
__device__ __forceinline__ void ctx_krope_proj(const Ctx& F, int layer) {
    unsigned char* ws = getpp()->ws;
    const bf16_t* xlo = (const bf16_t*)(ws + D_XN1); const bf16_t* xhi = (const bf16_t*)(ws + D_XN1 + Y34);
    const bf16_t* wlo = (const bf16_t*)(ws + WS_W + (size_t)layer * WL_STRIDE + WL_WINLO); const bf16_t* whi = (const bf16_t*)(ws + WS_W + (size_t)layer * WL_STRIDE + WL_WINHI);
    bf16_t* um = (bf16_t*)(ws + D_UMLA);
    LAS float* part = (LAS float*)F.lds;
    const int lane = F.lane, w = F.wave, fr = lane & 15, fq = lane >> 4;
    for (int task = (F.bid + F.G - 128 % F.G) % F.G; task < RC / 16; task += F.G) {
        const long r0 = (long)RL + task * 16;
        const bf16_t* xa = (w < 4 ? xlo : xhi) + (r0 + fr) * 512 + (w & 3) * 128 + fq * 8;
        const bf16_t* wb = (w < 4 ? wlo : whi) + (size_t)(4096 + fr) * 512 + (w & 3) * 128 + fq * 8;
        bf16x8 a[4], b0[4], b1[4];
#pragma unroll
        for (int ks = 0; ks < 4; ++ks) { a[ks] = *(const bf16x8*)(xa + ks * 32); b0[ks] = *(const bf16x8*)(wb + ks * 32); b1[ks] = *(const bf16x8*)(wb + 16 * 512 + ks * 32); }
        f32x4 c0 = {0.f, 0.f, 0.f, 0.f}, c1 = {0.f, 0.f, 0.f, 0.f};
#pragma unroll
        for (int ks = 0; ks < 4; ++ks) { c0 = __builtin_amdgcn_mfma_f32_16x16x32_bf16(a[ks], b0[ks], c0, 0, 0, 0); c1 = __builtin_amdgcn_mfma_f32_16x16x32_bf16(a[ks], b1[ks], c1, 0, 0, 0); }
#pragma unroll
        for (int j = 0; j < 4; ++j) { part[(w * 16 + 4 * fq + j) * 33 + fr] = c0[j]; part[(w * 16 + 4 * fq + j) * 33 + 16 + fr] = c1[j]; }
        __syncthreads();
        { const int row = F.tid >> 5, col = F.tid & 31; float s = 0.f;
#pragma unroll
          for (int ww = 0; ww < 8; ++ww) s += part[(ww * 16 + row) * 33 + col];
          um[(r0 + row) * MLC + 640 + col] = (bf16_t)f2bf(s); }
        __syncthreads();
    }
}
__device__ __forceinline__ void mla_stats_pass(const Ctx& F, int w0, int nw) {
    unsigned char* ws = getpp()->ws; const int lane = F.lane;
    const bf16_t* um = (const bf16_t*)(ws + D_UMLA); float* rq = (float*)(ws + WS_RSTD); float* rkv = rq + RT;
    constexpr int NBS = 4;
    for (int rb = GW(F) - w0; rb < RT; rb += nw * NBS) {
        u32x4 a[NBS], c[NBS];
#pragma unroll
        for (int b = 0; b < NBS; ++b) { const int row = (rb + b * nw < RT) ? rb + b * nw : rb; const bf16_t* ur = um + (size_t)row * MLC;
            a[b] = *(const u32x4*)(ur + lane * 8); c[b] = *(const u32x4*)(ur + 512 + (lane & 15) * 8); }
        __builtin_amdgcn_sched_barrier(0);
        float sq[NBS], skv[NBS];
#pragma unroll
        for (int b = 0; b < NBS; ++b) { float v[8], s = 0.f, s2 = 0.f; unpack8(a[b], v);
#pragma unroll
            for (int j = 0; j < 8; ++j) s += v[j] * v[j];
            unpack8(c[b], v);
#pragma unroll
            for (int j = 0; j < 8; ++j) s2 += v[j] * v[j];
            sq[b] = (lane < 48) ? s : 0.f; skv[b] = ((lane < 48) ? 0.f : s) + ((lane < 16) ? s2 : 0.f); }
#pragma unroll
        for (int b = 0; b < NBS; ++b) { sq[b] = wave_sum(sq[b], lane); skv[b] = wave_sum(skv[b], lane); }
#pragma unroll
        for (int b = 0; b < NBS; ++b) { const int row = rb + b * nw;
            if (lane == 0 && row < RT) { rq[row] = rsqrtf(sq[b] * (1.0f / 384.0f) + 1e-6f); rkv[row] = rsqrtf(skv[b] * (1.0f / 256.0f) + 1e-6f); } }
    }
}
__device__ __forceinline__ void krope_pass(const Ctx& F, int half, int layer) {
    unsigned char* ws = getpp()->ws; const int lane = F.lane;
    const bf16_t* um = (const bf16_t*)(ws + D_UMLA); bf16_t* Kb = half ? (bf16_t*)(ws + D_K) : (bf16_t*)(half_a_base(layer) + HA_K);
    const float* cm = (const float*)(ws + WS_ROPE_M); const float* sm = cm + 4096 * 16;
    for (int ci = GW(F) * 4 + (lane >> 4); ci < HROWS; ci += NGW(F) * 4) {
        const int row = ci < 4 * SEQ ? 4 * SEQ * half + ci : RL + 4 * CTXL * half + (ci - 4 * SEQ);
        const int orow = half ? row : ci;
        const bf16_t* ur = um + (size_t)row * MLC; const int l = lane & 15;
        float x1 = bf2f(ur[640 + l]), x2 = bf2f(ur[656 + l]);
        if (row < RL) { const int t = row & (SEQ - 1); const float cs = cm[t * 16 + l], sn = sm[t * 16 + l]; const float o1 = x1 * cs - x2 * sn, o2 = x1 * sn + x2 * cs; x1 = o1; x2 = o2; }
        Kb[(size_t)orow * 544 + 512 + l] = (bf16_t)f2bf(x1); Kb[(size_t)orow * 544 + 528 + l] = (bf16_t)f2bf(x2);
    }
}

constexpr size_t D_KV = D_END1;
static_assert(D_KV + 34 * MiB <= WS_NEED, "retention state buffer");
namespace ret2 {
constexpr int QP = 72, VP = 136, NUNITS = NBATCH * 4 * 34;
typedef short v4i16_t __attribute__((ext_vector_type(4)));
__device__ __forceinline__ bf16x8 tr8(const LAS bf16_t* base, int pitch, int row0, int col0, int lane) {
    const int g = lane >> 4, i = lane & 15, q = i >> 2, p = i & 3;
    const LAS bf16_t* a = base + (row0 + 8 * g + q) * pitch + col0 + 4 * p;
    const s16x4 lo = __builtin_bit_cast(s16x4, __builtin_amdgcn_ds_read_tr16_b64_v4i16((LAS v4i16_t*)a));
    const s16x4 hi = __builtin_bit_cast(s16x4, __builtin_amdgcn_ds_read_tr16_b64_v4i16((LAS v4i16_t*)(a + 4 * pitch)));
    return (bf16x8){lo[0], lo[1], lo[2], lo[3], hi[0], hi[1], hi[2], hi[3]};
}
__device__ __forceinline__ f32x4 mm32(bf16x8 a, bf16x8 b, f32x4 c) { return __builtin_amdgcn_mfma_f32_16x16x32_bf16(a, b, c, 0, 0, 0); }
struct UnitPos { int b, h, cs; long rbase; bool isctx; int t0; };
__device__ __forceinline__ UnitPos unit_pos(int un) { UnitPos U; const int bh = un / 34; U.cs = un % 34; U.b = bh >> 2; U.h = bh & 3; U.isctx = U.cs < 2;
    U.t0 = U.isctx ? 0 : (U.cs - 2) * 128; U.rbase = U.isctx ? (long)RL + U.b * CTXL + U.cs * 128 : (long)U.b * SEQ + U.t0; return U; }
}
__device__ __forceinline__ void ret_r1_unit(const Ctx& F, int layer, int un) {
    using namespace ret2;
    PP P = getpp(); unsigned char* ws = P->ws;
    const bf16_t* u = (const bf16_t*)(ws + D_URET); bf16_t* kv = (bf16_t*)(ws + D_KV);
    const float* cr = (const float*)(ws + WS_ROPE_R); const float* sr = cr + 4096 * 32;
    const UnitPos U = unit_pos(un);
    const float lgf = -__expf(P->in[I_RDEC][(layer * 2 + 0) * 4 + U.h]) * 1.4426950408889634f, lgb = -__expf(P->in[I_RDEC][(layer * 2 + 1) * 4 + U.h]) * 1.4426950408889634f;
    LAS bf16_t* Vt = (LAS bf16_t*)F.lds; LAS bf16_t* kzf = Vt + 128 * VP; LAS bf16_t* kzb = kzf + 128 * QP; LAS bf16_t* St = kzb + 128 * QP;
    const int tid = F.tid, lane = F.lane, w = F.wave;
    {
        const int tk = tid >> 2, pc = tid & 3; float k1[8], k2[8], a[8], c[8];
        u32x4 vv[4], kr[2]; f32x4 rc[2], rs[2];
#pragma unroll
        for (int k4 = 0; k4 < 4; ++k4) { const int it = tid + 512 * k4, tv = it >> 4, ch = it & 15; vv[k4] = *(const u32x4*)(u + (U.rbase + tv) * REC + 512 + U.h * 128 + ch * 8); }
        { const bf16_t* kp = u + (U.rbase + tk) * REC + 256 + U.h * 64 + pc * 8; kr[0] = *(const u32x4*)kp; kr[1] = *(const u32x4*)(kp + 32);
          const int ro = (U.t0 + tk) * 32 + pc * 8; rc[0] = *(const f32x4*)(cr + ro); rc[1] = *(const f32x4*)(cr + ro + 4); rs[0] = *(const f32x4*)(sr + ro); rs[1] = *(const f32x4*)(sr + ro + 4); }
        __builtin_amdgcn_sched_barrier(0);
        unpack8(kr[0], k1); unpack8(kr[1], k2);
#pragma unroll
        for (int j = 0; j < 8; ++j) { const float cs = U.isctx ? 1.0f : rc[j >> 2][j & 3], sn = U.isctx ? 0.0f : rs[j >> 2][j & 3];
            const float ka_ = k1[j] * cs - k2[j] * sn, kb_ = k1[j] * sn + k2[j] * cs; k1[j] = ka_; k2[j] = kb_; }
        const float zf = 0.125f * __builtin_amdgcn_exp2f((float)(127 - tk) * lgf), zb = 0.125f * __builtin_amdgcn_exp2f((float)tk * lgb);
#pragma unroll
        for (int j = 0; j < 8; ++j) { a[j] = k1[j] * zf; c[j] = k2[j] * zf; }
        *(LAS u32x4*)(kzf + tk * QP + pc * 8) = pack8(a); *(LAS u32x4*)(kzf + tk * QP + 32 + pc * 8) = pack8(c);
#pragma unroll
        for (int j = 0; j < 8; ++j) { a[j] = k1[j] * zb; c[j] = k2[j] * zb; }
        *(LAS u32x4*)(kzb + tk * QP + pc * 8) = pack8(a); *(LAS u32x4*)(kzb + tk * QP + 32 + pc * 8) = pack8(c);
#pragma unroll
        for (int k4 = 0; k4 < 4; ++k4) { const int it = tid + 512 * k4, tv = it >> 4, ch = it & 15; *(LAS u32x4*)(Vt + tv * VP + ch * 8) = vv[k4]; }
    }
    __syncthreads();
    {
        const int fr = lane & 15, fq = lane >> 4;
        f32x4 acc[2][4];
#pragma unroll
        for (int dd = 0; dd < 2; ++dd)
#pragma unroll
            for (int tj = 0; tj < 4; ++tj) acc[dd][tj] = (f32x4){0.f, 0.f, 0.f, 0.f};
#pragma unroll
        for (int ks = 0; ks < 4; ++ks) { const bf16x8 a = tr8(Vt, VP, 32 * ks, 16 * w, lane);
#pragma unroll
            for (int tj = 0; tj < 4; ++tj) { acc[0][tj] = mm32(a, tr8(kzf, QP, 32 * ks, 16 * tj, lane), acc[0][tj]); acc[1][tj] = mm32(a, tr8(kzb, QP, 32 * ks, 16 * tj, lane), acc[1][tj]); } }
#pragma unroll
        for (int dd = 0; dd < 2; ++dd)
#pragma unroll
            for (int tj = 0; tj < 4; ++tj)
#pragma unroll
                for (int j = 0; j < 4; ++j) St[dd * 128 * QP + (16 * w + 4 * fq + j) * QP + 16 * tj + fr] = (bf16_t)f2bf(acc[dd][tj][j]);
    }
    __syncthreads();
#pragma unroll
    for (int k4 = 0; k4 < 4; ++k4) { const int it = tid + 512 * k4, dd = it >> 10, e = (it >> 3) & 127, ch = it & 7;
        *(u32x4*)(kv + ((size_t)un * 2 + dd) * 8192 + e * 64 + ch * 8) = *(const LAS u32x4*)(St + dd * 128 * QP + e * QP + ch * 8); }
    __syncthreads();
}
__device__ __forceinline__ void ret_r2(const Ctx& F, int layer, int b0, int nb) {
    using namespace ret2;
    PP P = getpp(); bf16_t* kv = (bf16_t*)(P->ws + D_KV);
    for (int item = (F.bid - b0) * NTHREADS + F.tid; item < 65536; item += nb * NTHREADS) {
        const int bh = item >> 11, dd = (item >> 10) & 1, off = (item & 1023) * 8;
        const float g = __builtin_amdgcn_exp2f(-128.0f * __expf(P->in[I_RDEC][(layer * 2 + dd) * 4 + (bh & 3)]) * 1.4426950408889634f);
        float st[8];
#pragma unroll
        for (int j = 0; j < 8; ++j) st[j] = 0.f;
#pragma unroll
        for (int half = 0; half < 2; ++half) {
            asm volatile("" ::: "memory");
            u32x4 xv[17];
#pragma unroll
            for (int q = 0; q < 17; ++q) { const int i = half * 17 + q; const int cs = dd ? (i < 2 ? 1 - i : 35 - i) : i;
                xv[q] = *(const u32x4*)(kv + ((size_t)(bh * 34 + cs) * 2 + dd) * 8192 + off); }
#pragma unroll
            for (int q = 0; q < 17; ++q) { const int i = half * 17 + q; const int cs = dd ? (i < 2 ? 1 - i : 35 - i) : i;
                float x[8]; unpack8(xv[q], x);
                *(u32x4*)(kv + ((size_t)(bh * 34 + cs) * 2 + dd) * 8192 + off) = pack8(st);
#pragma unroll
                for (int j = 0; j < 8; ++j) st[j] = st[j] * g + x[j]; }
        }
    }
}
__device__ __forceinline__ void ret_r3_unit(const Ctx& F, int layer, int un) {
    using namespace ret2;
    PP P = getpp(); unsigned char* ws = P->ws;
    const bf16_t* u = (const bf16_t*)(ws + D_URET); const bf16_t* kv = (const bf16_t*)(ws + D_KV); bf16_t* y = (bf16_t*)(ws + D_YRET);
    const float* cr = (const float*)(ws + WS_ROPE_R); const float* sr = cr + 4096 * 32;
    const UnitPos U = unit_pos(un);
    const float* lng = P->in[I_RLNG] + layer * 512 + U.h * 128; const float* lnb = P->in[I_RLNB] + layer * 512 + U.h * 128;
    const float lgf = -__expf(P->in[I_RDEC][(layer * 2 + 0) * 4 + U.h]) * 1.4426950408889634f, lgb = -__expf(P->in[I_RDEC][(layer * 2 + 1) * 4 + U.h]) * 1.4426950408889634f;
    LAS bf16_t* qf = (LAS bf16_t*)F.lds; LAS bf16_t* qb = qf + 128 * QP; LAS bf16_t* qn = qb + 128 * QP; LAS bf16_t* ks = qn + 128 * QP; LAS bf16_t* Sm = qn;
    LAS bf16_t* Vt = (LAS bf16_t*)(F.lds + 73728); LAS bf16_t* Rf = (LAS bf16_t*)(F.lds + 108544); LAS bf16_t* Rb = Rf + 128 * QP; LAS bf16_t* Yst = qf;
    const int tid = F.tid, lane = F.lane, w = F.wave, fr = lane & 15, fq = lane >> 4;
    const int n0 = 16 * w;
    u32x4 vv[4], rr[4], gq[4]; float lgv[8], lbv[8];
#pragma unroll
    for (int k4 = 0; k4 < 4; ++k4) { const int it = tid + 512 * k4, tv = it >> 4, ch = it & 15; vv[k4] = *(const u32x4*)(u + (U.rbase + tv) * REC + 512 + U.h * 128 + ch * 8); }
#pragma unroll
    for (int k4 = 0; k4 < 4; ++k4) { const int it = tid + 512 * k4, dd = it >> 10, e = (it >> 3) & 127, ch = it & 7; rr[k4] = *(const u32x4*)(kv + ((size_t)un * 2 + dd) * 8192 + e * 64 + ch * 8); }
#pragma unroll
    for (int k4 = 0; k4 < 4; ++k4) { const int it = lane + 64 * k4, r = it >> 4, ch = it & 15; gq[k4] = *(const u32x4*)(u + (U.rbase + n0 + r) * REC + 1024 + U.h * 128 + ch * 8); }
#pragma unroll
    for (int te = 0; te < 8; ++te) { lgv[te] = lng[16 * te + fr]; lbv[te] = lnb[16 * te + fr]; }
    const int tk = tid >> 2, pc = tid & 3;
    u32x4 qr[2], kr[2]; f32x4 rc[2], rs[2];
    { const bf16_t* qp = u + (U.rbase + tk) * REC + U.h * 64 + pc * 8; qr[0] = *(const u32x4*)qp; qr[1] = *(const u32x4*)(qp + 32); kr[0] = *(const u32x4*)(qp + 256); kr[1] = *(const u32x4*)(qp + 288);
      const int ro = (U.t0 + tk) * 32 + pc * 8; rc[0] = *(const f32x4*)(cr + ro); rc[1] = *(const f32x4*)(cr + ro + 4); rs[0] = *(const f32x4*)(sr + ro); rs[1] = *(const f32x4*)(sr + ro + 4); }
    __builtin_amdgcn_sched_barrier(0);
    {
        float q1[8], q2[8], k1[8], k2[8], a[8], c[8];
        unpack8(qr[0], q1); unpack8(qr[1], q2); unpack8(kr[0], k1); unpack8(kr[1], k2);
#pragma unroll
        for (int j = 0; j < 8; ++j) { const float cs = U.isctx ? 1.0f : rc[j >> 2][j & 3], sn = U.isctx ? 0.0f : rs[j >> 2][j & 3];
            const float qa_ = q1[j] * cs - q2[j] * sn, qb_ = q1[j] * sn + q2[j] * cs, ka_ = k1[j] * cs - k2[j] * sn, kb_ = k1[j] * sn + k2[j] * cs;
            q1[j] = qa_; q2[j] = qb_; k1[j] = ka_; k2[j] = kb_; }
        *(LAS u32x4*)(qn + tk * QP + pc * 8) = pack8(q1); *(LAS u32x4*)(qn + tk * QP + 32 + pc * 8) = pack8(q2);
        const float xf = __builtin_amdgcn_exp2f((float)(tk + 1) * lgf), xb = __builtin_amdgcn_exp2f((float)(128 - tk) * lgb);
#pragma unroll
        for (int j = 0; j < 8; ++j) { a[j] = q1[j] * xf; c[j] = q2[j] * xf; }
        *(LAS u32x4*)(qf + tk * QP + pc * 8) = pack8(a); *(LAS u32x4*)(qf + tk * QP + 32 + pc * 8) = pack8(c);
#pragma unroll
        for (int j = 0; j < 8; ++j) { a[j] = q1[j] * xb; c[j] = q2[j] * xb; }
        *(LAS u32x4*)(qb + tk * QP + pc * 8) = pack8(a); *(LAS u32x4*)(qb + tk * QP + 32 + pc * 8) = pack8(c);
#pragma unroll
        for (int j = 0; j < 8; ++j) { a[j] = k1[j] * 0.125f; c[j] = k2[j] * 0.125f; }
        *(LAS u32x4*)(ks + tk * QP + pc * 8) = pack8(a); *(LAS u32x4*)(ks + tk * QP + 32 + pc * 8) = pack8(c);
#pragma unroll
        for (int k4 = 0; k4 < 4; ++k4) { const int it = tid + 512 * k4, tv = it >> 4, ch = it & 15; *(LAS u32x4*)(Vt + tv * VP + ch * 8) = vv[k4]; }
#pragma unroll
        for (int k4 = 0; k4 < 4; ++k4) { const int it = tid + 512 * k4, dd = it >> 10, e = (it >> 3) & 127, ch = it & 7; *(LAS u32x4*)((dd ? Rb : Rf) + e * QP + ch * 8) = rr[k4]; }
    }
    __syncthreads();
    f32x4 ST[8];
    {
        bf16x8 qa[2];
#pragma unroll
        for (int k2 = 0; k2 < 2; ++k2) qa[k2] = *(const LAS bf16x8*)(qn + (n0 + fr) * QP + k2 * 32 + fq * 8);
#pragma unroll
        for (int tm = 0; tm < 8; ++tm) { ST[tm] = (f32x4){0.f, 0.f, 0.f, 0.f};
#pragma unroll
            for (int k2 = 0; k2 < 2; ++k2) ST[tm] = mm32(*(const LAS bf16x8*)(ks + (16 * tm + fr) * QP + k2 * 32 + fq * 8), qa[k2], ST[tm]); }
    }
    s16x4 cst[8];
#pragma unroll
    for (int tm = 0; tm < 8; ++tm) { f32x4 t;
#pragma unroll
        for (int j = 0; j < 4; ++j) { const int n = n0 + fr, m = 16 * tm + 4 * fq + j; const int dd = n - m;
            const float ex = __builtin_amdgcn_exp2f((float)(dd < 0 ? -dd : dd) * (dd > 0 ? lgf : lgb));
            t[j] = ST[tm][j] * ((dd == 0) ? 2.0f : ex); }
        u32x2 pw; pw.x = pk2(t[0], t[1]); pw.y = pk2(t[2], t[3]); cst[tm] = __builtin_bit_cast(s16x4, pw); }
    f32x4 Y[8];
#pragma unroll
    for (int te = 0; te < 8; ++te) Y[te] = (f32x4){0.f, 0.f, 0.f, 0.f};
    {
        const int g = lane >> 4, i = lane & 15, q = i >> 2, pp = i & 3;
#pragma unroll
        for (int p = 0; p < 4; ++p) { const bf16x8 a = (bf16x8){cst[2 * p][0], cst[2 * p][1], cst[2 * p][2], cst[2 * p][3], cst[2 * p + 1][0], cst[2 * p + 1][1], cst[2 * p + 1][2], cst[2 * p + 1][3]};
#pragma unroll
            for (int te = 0; te < 8; ++te) {
                const LAS bf16_t* va = Vt + (32 * p + 4 * g + q) * VP + 16 * te + 4 * pp;
                const s16x4 lo = __builtin_bit_cast(s16x4, __builtin_amdgcn_ds_read_tr16_b64_v4i16((LAS v4i16_t*)va));
                const s16x4 hi = __builtin_bit_cast(s16x4, __builtin_amdgcn_ds_read_tr16_b64_v4i16((LAS v4i16_t*)(va + 16 * VP)));
                Y[te] = mm32(a, (bf16x8){lo[0], lo[1], lo[2], lo[3], hi[0], hi[1], hi[2], hi[3]}, Y[te]); } }
    }
#pragma unroll
    for (int k2 = 0; k2 < 2; ++k2) { const bf16x8 af = *(const LAS bf16x8*)(qf + (n0 + fr) * QP + k2 * 32 + fq * 8), ab = *(const LAS bf16x8*)(qb + (n0 + fr) * QP + k2 * 32 + fq * 8);
#pragma unroll
        for (int te = 0; te < 8; ++te) { Y[te] = mm32(af, *(const LAS bf16x8*)(Rf + (16 * te + fr) * QP + k2 * 32 + fq * 8), Y[te]); Y[te] = mm32(ab, *(const LAS bf16x8*)(Rb + (16 * te + fr) * QP + k2 * 32 + fq * 8), Y[te]); } }
    __syncthreads();
#pragma unroll
    for (int j = 0; j < 4; ++j) { float s = 0.f;
#pragma unroll
        for (int te = 0; te < 8; ++te) s += Y[te][j];
        s += shx(s, 1, lane); s += shx(s, 2, lane); s += shx(s, 4, lane); s += shx(s, 8, lane);
        const float mean = s * (1.0f / 128.0f); float vs = 0.f;
#pragma unroll
        for (int te = 0; te < 8; ++te) { const float dd = Y[te][j] - mean; vs += dd * dd; }
        vs += shx(vs, 1, lane); vs += shx(vs, 2, lane); vs += shx(vs, 4, lane); vs += shx(vs, 8, lane);
        const float rstd = rsqrtf(vs * (1.0f / 128.0f) + 1e-5f);
        const int r = 4 * fq + j; LAS bf16_t* yst = (r < 8 ? qf + n0 * QP + r * VP : qb + n0 * QP + (r - 8) * VP);
#pragma unroll
        for (int te = 0; te < 8; ++te) { const int e = 16 * te + fr; yst[e] = (bf16_t)f2bf((Y[te][j] - mean) * rstd * lgv[te] + lbv[te]); } }
    __syncthreads();
#pragma unroll
    for (int k4 = 0; k4 < 4; ++k4) { const int it = lane + 64 * k4, r = it >> 4, ch = it & 15; const long row = U.rbase + n0 + r;
        const LAS bf16_t* yst = (r < 8 ? qf + n0 * QP + r * VP : qb + n0 * QP + (r - 8) * VP);
        float yv[8], gv[8]; unpack8(*(const LAS u32x4*)(yst + ch * 8), yv); unpack8(gq[k4], gv);
#pragma unroll
        for (int j = 0; j < 8; ++j) yv[j] *= siluf_(gv[j]);
        *(u32x4*)(y + row * 512 + U.h * 128 + ch * 8) = pack8(yv); }
    __syncthreads();
}
__device__ __forceinline__ void ret_r3_phase(const Ctx& F, int layer) {
    for (int un = F.bid; un < ret2::NUNITS; un += F.G) { if (layer != 0 && (un % 34) < 2) continue; ret_r3_unit(F, layer, un); }
}
__device__ __forceinline__ void ret_r1_phase(const Ctx& F, int layer) { for (int un = F.bid; un < ret2::NUNITS; un += F.G) ret_r1_unit(F, layer, un); }
__device__ __forceinline__ void rw_phase(const Ctx& F, int layer) {
    unsigned char* ws = getpp()->ws;
    if (F.G >= 160) {
        if (F.bid < 128) rwkv_chain4(F, layer, F.bid >> 4, (F.bid >> 1) & 7, F.bid & 1);
        unsigned* ctr = (unsigned*)(ws + WS_CTL) + 192 + 64 * layer; LAS unsigned* bc = (LAS unsigned*)(F.lds + LDS_BYTES - 32);
        for (;;) {
            __syncthreads();
            if (F.tid == 0) *bc = __hip_atomic_fetch_add(ctr, 1u, __ATOMIC_RELAXED, __HIP_MEMORY_SCOPE_AGENT);
            __syncthreads();
            const unsigned u = *bc; if (u >= 512u) break;
            const int bh = (int)u >> 4; attn_latent_unit(F, ws, half_a_base(layer), bh >> 3, bh & 7, (int)u & 15);
        }
    } else {
        for (int un = F.bid; un < 128; un += F.G) { rwkv_chain4(F, layer, un >> 4, (un >> 1) & 7, un & 1); __syncthreads(); }
        for (int u = F.bid; u < 512; u += F.G) { const int bh = u >> 4; attn_latent_unit(F, ws, half_a_base(layer), bh >> 3, bh & 7, u & 15); }
    }
}

template <int NB> __device__ __forceinline__ void rows_norm(int lane, const float* hbase, const int* rows, const float* gain, const float* mod, f32x4 (*y)[4]) {
    float ss[NB];
#pragma unroll
    for (int b = 0; b < NB; ++b) { const float* src = hbase + (size_t)rows[b] * 1024; ss[b] = 0.f;
#pragma unroll
        for (int j = 0; j < 4; ++j) { y[b][j] = *(const f32x4*)(src + 4 * lane + 256 * j); ss[b] += y[b][j].x * y[b][j].x + y[b][j].y * y[b][j].y + y[b][j].z * y[b][j].z + y[b][j].w * y[b][j].w; } }
#pragma unroll
    for (int b = 0; b < NB; ++b) ss[b] = wave_sum(ss[b], lane);
#pragma unroll
    for (int b = 0; b < NB; ++b) { const float rstd = rsqrtf(ss[b] * (1.0f / 1024.0f) + 1e-6f); const float* sh = mod + (rows[b] >> 12) * 6144; const float* sc = sh + 1024;
#pragma unroll
        for (int j = 0; j < 4; ++j) { const int c = 4 * lane + 256 * j; y[b][j] = y[b][j] * rstd * *(const f32x4*)(gain + c) * (*(const f32x4*)(sc + c) + 1.0f) + *(const f32x4*)(sh + c); } }
}
template <int NB> __device__ __forceinline__ void rows_norm_pre(int lane, const int* rows, const float* gain, const float* mod, f32x4 (*y)[4]) {
    float ss[NB];
#pragma unroll
    for (int b = 0; b < NB; ++b) { ss[b] = 0.f;
#pragma unroll
        for (int j = 0; j < 4; ++j) ss[b] += y[b][j].x * y[b][j].x + y[b][j].y * y[b][j].y + y[b][j].z * y[b][j].z + y[b][j].w * y[b][j].w; }
#pragma unroll
    for (int b = 0; b < NB; ++b) ss[b] = wave_sum(ss[b], lane);
#pragma unroll
    for (int b = 0; b < NB; ++b) { const float rstd = rsqrtf(ss[b] * (1.0f / 1024.0f) + 1e-6f); const float* sh = mod + (rows[b] >> 12) * 6144; const float* sc = sh + 1024;
#pragma unroll
        for (int j = 0; j < 4; ++j) { const int c = 4 * lane + 256 * j; y[b][j] = y[b][j] * rstd * *(const f32x4*)(gain + c) * (*(const f32x4*)(sc + c) + 1.0f) + *(const f32x4*)(sh + c); } }
}
__device__ __forceinline__ void moe_route_pass(const Ctx& F, int layer) {
    PP P = getpp(); unsigned char* ws = P->ws;
    const float* gain = P->in[I_NFFN] + layer * 1024; const float* mod = (const float*)(ws + WS_MOD) + (size_t)layer * 9 * 6144 + 3072;
    const float* router = P->in[I_ROUTER];
    unsigned* cnt = (unsigned*)(ws + WS_CTL); int* route = (int*)(ws + WS_ROUTE);
    LAS float* rl = (LAS float*)F.lds;
    LAS unsigned* lc = (LAS unsigned*)(F.lds + 32768);
    for (int i = F.tid; i < 8192; i += NTHREADS) rl[(i & 7) * 1024 + (i >> 3)] = router[i];
    if (F.tid < 16) lc[F.tid] = 0u;
    __syncthreads();
    const int rpb = (RL + F.G - 1) / F.G, rpw = (rpb + 7) / 8;
    const int b0 = F.bid * rpb, b1 = (b0 + rpb < RL) ? b0 + rpb : RL;
    const int r0 = b0 + F.wave * rpw, r1 = (r0 + rpw < b1) ? r0 + rpw : b1;
    constexpr int NB = 2;
    f32x4 xr[NB][4];
#pragma unroll
    for (int b = 0; b < NB; ++b) { const int row = (r0 + b < r1) ? r0 + b : r1 - 1;
#pragma unroll
        for (int j = 0; j < 4; ++j) xr[b][j] = *(const f32x4*)(P->out + (size_t)row * 1024 + 4 * F.lane + 256 * j); }
    for (int rb = r0; rb < r1; rb += NB) {
        int lane = F.lane; asm volatile("" : "+v"(lane));
        int rows[NB]; f32x4 y[NB][4];
#pragma unroll
        for (int b = 0; b < NB; ++b) { rows[b] = (rb + b < r1) ? rb + b : r1 - 1;
#pragma unroll
            for (int j = 0; j < 4; ++j) y[b][j] = xr[b][j]; }
        if (rb + NB < r1) {
#pragma unroll
            for (int b = 0; b < NB; ++b) { const int row = (rb + NB + b < r1) ? rb + NB + b : r1 - 1;
#pragma unroll
                for (int j = 0; j < 4; ++j) xr[b][j] = *(const f32x4*)(P->out + (size_t)row * 1024 + 4 * lane + 256 * j); } }
        rows_norm_pre<NB>(lane, rows, gain, mod, y);
        float lg[NB][8];
#pragma unroll
        for (int b = 0; b < NB; ++b)
#pragma unroll
            for (int e = 0; e < 8; ++e) lg[b][e] = 0.f;
#pragma unroll
        for (int j = 0; j < 4; ++j)
#pragma unroll
            for (int e = 0; e < 8; ++e) { const f32x4 r4 = *(const LAS f32x4*)(rl + e * 1024 + 4 * lane + 256 * j);
#pragma unroll
                for (int b = 0; b < NB; ++b) lg[b][e] += y[b][j][0] * r4[0] + y[b][j][1] * r4[1] + y[b][j][2] * r4[2] + y[b][j][3] * r4[3]; }
#pragma unroll
        for (int b = 0; b < NB; ++b)
#pragma unroll
            for (int e = 0; e < 8; ++e) lg[b][e] = wave_sum(lg[b][e], lane);
        if (lane == 0) {
#pragma unroll
            for (int b = 0; b < NB; ++b) if (rb + b < r1) {
                int i0 = 0; float v0 = lg[b][0];
#pragma unroll
                for (int e = 1; e < 8; ++e) if (lg[b][e] > v0) { v0 = lg[b][e]; i0 = e; }
                int i1 = -1; float v1 = -3.0e38f;
#pragma unroll
                for (int e = 0; e < 8; ++e) if (e != i0 && lg[b][e] > v1) { v1 = lg[b][e]; i1 = e; }
                const float w0 = 1.0f / (1.0f + __expf(v1 - v0)), w1 = 1.0f - w0;
                const unsigned p0 = __hip_atomic_fetch_add(&lc[i0], 1u, __ATOMIC_RELAXED, __HIP_MEMORY_SCOPE_WORKGROUP), p1 = __hip_atomic_fetch_add(&lc[i1], 1u, __ATOMIC_RELAXED, __HIP_MEMORY_SCOPE_WORKGROUP);
                int* r = route + (size_t)rows[b] * 8; r[0] = i0; r[1] = i1; r[2] = __float_as_int(w0); r[3] = __float_as_int(w1); r[4] = (int)p0; r[5] = (int)p1;
            }
        }
    }
    __syncthreads();
    if (F.tid < 8) lc[8 + F.tid] = atomicAdd(&cnt[F.tid], lc[F.tid]);
    __syncthreads();
    for (int row = r0 + F.lane; row < r1; row += 64) { int* r = route + (size_t)row * 8; const int e0 = r[0], e1 = r[1], p0 = r[4], p1 = r[5]; r[4] = p0 + (int)lc[8 + e0]; r[5] = p1 + (int)lc[8 + e1]; }
    __syncthreads();
}
__device__ __forceinline__ void moe_gather_pass(const Ctx& F, int layer) {
    PP P = getpp(); unsigned char* ws = P->ws;
    const float* gain = P->in[I_NFFN] + layer * 1024; const float* mod = (const float*)(ws + WS_MOD) + (size_t)layer * 9 * 6144 + 3072;
    const unsigned* cnt = (const unsigned*)(ws + WS_CTL); const int* route = (const int*)(ws + WS_ROUTE);
    bf16_t* xlo = (bf16_t*)(ws + D_XG); bf16_t* xhi = xlo + (size_t)RG * 512;
    const MoeTiles T = moe_tiles(cnt);
    const int rpw = (RL + NGW(F) - 1) / NGW(F); const int r0 = GW(F) * rpw; const int r1 = (r0 + rpw < RL) ? r0 + rpw : RL;
    constexpr int NB = 2;
    f32x4 xr[NB][4]; int rt[NB][4];
#pragma unroll
    for (int b = 0; b < NB; ++b) { const int row = (r0 + b < r1) ? r0 + b : r1 - 1; const int* r = route + (size_t)row * 8; rt[b][0] = r[0]; rt[b][1] = r[1]; rt[b][2] = r[4]; rt[b][3] = r[5];
#pragma unroll
        for (int j = 0; j < 4; ++j) xr[b][j] = *(const f32x4*)(P->out + (size_t)row * 1024 + 4 * F.lane + 256 * j); }
    for (int rb = r0; rb < r1; rb += NB) {
        int lane = F.lane; asm volatile("" : "+v"(lane));
        int rows[NB]; f32x4 y[NB][4]; int rc[NB][4];
#pragma unroll
        for (int b = 0; b < NB; ++b) { rows[b] = (rb + b < r1) ? rb + b : r1 - 1;
#pragma unroll
            for (int j = 0; j < 4; ++j) { y[b][j] = xr[b][j]; rc[b][j] = rt[b][j]; } }
        if (rb + NB < r1) {
#pragma unroll
            for (int b = 0; b < NB; ++b) { const int row = (rb + NB + b < r1) ? rb + NB + b : r1 - 1; const int* r = route + (size_t)row * 8; rt[b][0] = r[0]; rt[b][1] = r[1]; rt[b][2] = r[4]; rt[b][3] = r[5];
#pragma unroll
                for (int j = 0; j < 4; ++j) xr[b][j] = *(const f32x4*)(P->out + (size_t)row * 1024 + 4 * lane + 256 * j); } }
        rows_norm_pre<NB>(lane, rows, gain, mod, y);
#pragma unroll
        for (int b = 0; b < NB; ++b) {
            const int e0 = rc[b][0], e1 = rc[b][1];
            int t0 = 0, t1 = 0;
#pragma unroll
            for (int e = 0; e < 8; ++e) { if (e == e0) t0 = T.tstart[e]; if (e == e1) t1 = T.tstart[e]; }
            const size_t s0 = (size_t)t0 * 256 + rc[b][2], s1 = (size_t)t1 * 256 + rc[b][3];
#pragma unroll
            for (int j = 0; j < 4; ++j) { const int c = 4 * lane + 256 * j; u32x2 o; o.x = pk2(y[b][j].x, y[b][j].y); o.y = pk2(y[b][j].z, y[b][j].w);
                bf16_t* bp = (c < 512) ? xlo + c : xhi + (c - 512);
                *(u32x2*)(bp + s0 * 512) = o; *(u32x2*)(bp + s1 * 512) = o; } }
    }
}
__device__ __forceinline__ void moe_final_pass(const Ctx& F, int layer) {
    PP P = getpp(); unsigned char* ws = P->ws;
    const float* mod = (const float*)(ws + WS_MOD) + (size_t)layer * 9 * 6144 + 5120;
    const unsigned* cnt = (const unsigned*)(ws + WS_CTL); const int* route = (const int*)(ws + WS_ROUTE);
    const bf16_t* ym = (const bf16_t*)(ws + D_XG); const float* fn = P->in[I_FNORM];
    const MoeTiles T = moe_tiles(cnt);
    const int rpw = (RL + NGW(F) - 1) / NGW(F); const int r0 = GW(F) * rpw; const int r1 = (r0 + rpw < RL) ? r0 + rpw : RL;
    constexpr int NB = 2;
    int rt[NB][6];
#pragma unroll
    for (int b = 0; b < NB; ++b) { const int row = (r0 + b < r1) ? r0 + b : r1 - 1; const int* r = route + (size_t)row * 8;
#pragma unroll
        for (int k = 0; k < 6; ++k) rt[b][k] = r[k]; }
    for (int rb = r0; rb < r1; rb += NB) {
        int lane = F.lane; asm volatile("" : "+v"(lane));
        f32x4 v[NB][4]; float ss[NB]; int rows[NB]; int rc[NB][6];
#pragma unroll
        for (int b = 0; b < NB; ++b)
#pragma unroll
            for (int k = 0; k < 6; ++k) rc[b][k] = rt[b][k];
        if (rb + NB < r1) {
#pragma unroll
            for (int b = 0; b < NB; ++b) { const int row = (rb + NB + b < r1) ? rb + NB + b : r1 - 1; const int* r = route + (size_t)row * 8;
#pragma unroll
                for (int k = 0; k < 6; ++k) rt[b][k] = r[k]; } }
#pragma unroll
        for (int b = 0; b < NB; ++b) { const int row = (rb + b < r1) ? rb + b : r1 - 1; rows[b] = row;
            const int e0 = rc[b][0], e1 = rc[b][1]; const float w0 = __int_as_float(rc[b][2]), w1 = __int_as_float(rc[b][3]);
            int t0 = 0, t1 = 0;
#pragma unroll
            for (int e = 0; e < 8; ++e) { if (e == e0) t0 = T.tstart[e]; if (e == e1) t1 = T.tstart[e]; }
            const size_t s0 = (size_t)t0 * 256 + rc[b][4], s1 = (size_t)t1 * 256 + rc[b][5];
            const float* g = mod + (row >> 12) * 6144; const float* hp = P->out + (size_t)row * 1024; ss[b] = 0.f;
#pragma unroll
            for (int j = 0; j < 4; ++j) { const int c = 4 * lane + 256 * j; const u32x2 a = *(const u32x2*)(ym + s0 * 1024 + c), bq = *(const u32x2*)(ym + s1 * 1024 + c);
                const f32x4 ya = {bflo(a.x), bfhi(a.x), bflo(a.y), bfhi(a.y)}, yb = {bflo(bq.x), bfhi(bq.x), bflo(bq.y), bfhi(bq.y)};
                v[b][j] = *(const f32x4*)(hp + c) + *(const f32x4*)(g + c) * (ya * w0 + yb * w1);
                ss[b] += v[b][j].x * v[b][j].x + v[b][j].y * v[b][j].y + v[b][j].z * v[b][j].z + v[b][j].w * v[b][j].w; } }
#pragma unroll
        for (int b = 0; b < NB; ++b) ss[b] = wave_sum(ss[b], lane);
#pragma unroll
        for (int b = 0; b < NB; ++b) { const float rstd = rsqrtf(ss[b] * (1.0f / 1024.0f) + 1e-6f); float* hp = P->out + (size_t)rows[b] * 1024;
#pragma unroll
            for (int j = 0; j < 4; ++j) { const int c = 4 * lane + 256 * j; *(f32x4*)(hp + c) = v[b][j] * rstd * *(const f32x4*)(fn + c); } }
    }
}

#define XB_TMO      128
#define XB_XCNT(j)  (256  + 64 * (j))
#define XB_XSUB(j)  (1280 + 64 * (j))
#define XB_XGEN(j)  (2304 + 64 * (j))
#define XB_TOP      3328
#define XB_TOPGEN   3392
#define XCD_BAR_WORDS 3456
#define XB_SPIN_CAP (1u << 18)
constexpr int CW_BAR = 4096;
constexpr int LDS_BARST = LDS_BYTES - 16;
__device__ __forceinline__ unsigned xb_ld(unsigned* p)              { return __hip_atomic_load(p, __ATOMIC_RELAXED, __HIP_MEMORY_SCOPE_AGENT); }
__device__ __forceinline__ unsigned xb_add(unsigned* p, unsigned v) { return __hip_atomic_fetch_add(p, v, __ATOMIC_RELAXED, __HIP_MEMORY_SCOPE_AGENT); }
__device__ __forceinline__ unsigned xb_xcc_id() { return (unsigned)__builtin_amdgcn_s_getreg((3 << 11) | 20) & 0xFu; }
#define XB_SPIN(cond, bar) do { unsigned _sp = 0; while (cond) { __builtin_amdgcn_s_sleep(1); \
    if ((++_sp & 255u) == 0u) { if (xb_ld(&(bar)[XB_TMO])) break; if (_sp > XB_SPIN_CAP) { atomicAdd(&(bar)[XB_TMO], 1u); break; } } } } while (0)
__device__ __forceinline__ void xcd_barrier_complete(unsigned* bar, unsigned x, unsigned& nloc, unsigned& nx) {
    const unsigned G = gridDim.x * gridDim.y * gridDim.z;
    unsigned sum, cnt, mine, sp = 0u;
    for (;;) {
        sum = 0u; cnt = 0u; mine = 0u;
#pragma unroll
        for (unsigned j = 0; j < 16; ++j) { const unsigned c = xb_ld(&bar[XB_XCNT(j)]); sum += c; cnt += (c > 0u) ? 1u : 0u; mine = (j == x) ? c : mine; }
        if (sum == G) break;
        __builtin_amdgcn_s_sleep(1);
        if ((++sp & 255u) == 0u) { if (xb_ld(&bar[XB_TMO])) break; if (sp > XB_SPIN_CAP) { atomicAdd(&bar[XB_TMO], 1u); break; } }
    }
    nloc = mine > 0u ? mine : 1u; nx = cnt > 0u ? cnt : 1u;
}
__device__ __forceinline__ void xcd_barrier(LAS unsigned char* lds) {
    asm volatile("s_waitcnt vmcnt(0)" ::: "memory");
    __syncthreads();
    if (threadIdx.x == 0) {
        unsigned* bar = (unsigned*)(getpp()->ws + WS_CTL) + CW_BAR;
        volatile LAS unsigned* st = (volatile LAS unsigned*)(lds + LDS_BARST);
        const unsigned x = xb_xcc_id();
        __builtin_amdgcn_s_waitcnt(0);
        unsigned nloc = st[0], nx = st[1];
        if (nloc == 0u) { xcd_barrier_complete(bar, x, nloc, nx); st[0] = nloc; st[1] = nx; }
        const unsigned old = xb_add(&bar[XB_XSUB(x)], 1u);
        const unsigned gen = old / nloc;
        if (old + 1u == (gen + 1u) * nloc) {
            __builtin_amdgcn_fence(__ATOMIC_RELEASE, "agent");
            asm volatile("s_waitcnt vmcnt(0)" ::: "memory");
            const unsigned og = xb_add(&bar[XB_TOP], 1u);
            const unsigned tg = og / nx;
            if (og + 1u == (tg + 1u) * nx) xb_add(&bar[XB_TOPGEN], 1u);
            else XB_SPIN(xb_ld(&bar[XB_TOPGEN]) == tg, bar);
            __builtin_amdgcn_fence(__ATOMIC_ACQUIRE, "agent");
            xb_add(&bar[XB_XGEN(x)], 1u);
            asm volatile("s_waitcnt vmcnt(0)" ::: "memory");
        } else {
            XB_SPIN(xb_ld(&bar[XB_XGEN(x)]) == gen, bar);
            __builtin_amdgcn_fence(__ATOMIC_ACQUIRE, "agent");
            asm volatile("s_waitcnt vmcnt(0)" ::: "memory");
        }
    }
    __syncthreads();
}
#define FRESH() do { int t_ = threadIdx.x; asm volatile("" : "+v"(t_)); F.tid = t_; F.lane = t_ & 63; F.wave = __builtin_amdgcn_readfirstlane(t_ >> 6); \
    int g_ = gridDim.x, b_ = blockIdx.x; asm volatile("" : "+s"(g_), "+s"(b_)); F.G = g_; F.bid = b_; } while (0)
#define PHASE_VARS FRESH(); const int G = F.G, c = F.bid; (void)G; (void)c; PP P = getpp(); unsigned char* ws = P->ws; const bool L0 = (layer == 0); \
    const float* hl = L0 ? P->in[I_X] : P->out; const float* hcx = L0 ? P->in[I_CTX] : (const float*)(ws + WS_HC); float* hc = (float*)(ws + WS_HC); \
    const char* wl = (const char*)(ws + WS_W + (size_t)layer * WL_STRIDE); const float* mod = (const float*)(ws + WS_MOD) + (size_t)layer * 9 * 6144; \
    const int nMm = L0 ? RT / 256 : RL / 256; (void)hl; (void)hcx; (void)hc; (void)wl; (void)mod; (void)nMm;

template <int layer> __device__ __forceinline__ void layer_fwd(Ctx& F, cg::grid_group& grid) {

        { PHASE_VARS norm_pass(F, layer, 0, hl, hcx, RT, (bf16_t*)(ws + D_XN1), (bf16_t*)(ws + D_XN1 + Y34), layer != 0); }
        xcd_barrier(F.lds);
        { PHASE_VARS SchedSplit2 S{(const char*)(ws + D_XN1), (const char*)(ws + D_XN1 + Y34), wl + WL_WINLO, wl + WL_WINHI, RT / 256, MIXP / 256, G, c, true};
          EpiInproj E{ws};
          pg8::gemm_phase<512, 512, true>(F.lds, S, E); }
        xcd_barrier(F.lds);
        FRESH(); ctx_krope_proj(F, layer);
        FRESH(); mla_stats_pass(F, 0, F.G * 8);
        FRESH(); ret_r1_phase(F, layer);
        xcd_barrier(F.lds);
        FRESH(); ret_r2(F, layer, 0, F.G);
        FRESH(); krope_pass(F, 0, layer);
        { PHASE_VARS SchedHalf S{(const char*)(ws + D_UMLA), wl + WL_WQ, (size_t)256 * MLC * 2, (size_t)256 * 384 * 2, 6, 3, 0, G, (c + G - 128 % G) % G};
          EpiQup E{(bf16_t*)(half_a_base(layer) + HA_Q), (const float*)(ws + WS_RSTD), (const float*)(ws + WS_ROPE_M), (const float*)(ws + WS_ROPE_M) + 4096 * 16, 1};
          pg8::gemm_phase<MLC, 384, false>(F.lds, S, E); }
        { PHASE_VARS SchedHalf S{(const char*)(ws + D_UMLA) + 384 * 2, wl + WL_WKV, (size_t)256 * MLC * 2, (size_t)256 * 256 * 2, 4, 4, 0, G, (c + G - 24 % G) % G};
          EpiKVup E{(bf16_t*)(half_a_base(layer) + HA_K), (bf16_t*)(half_a_base(layer) + HA_V), (const float*)(ws + WS_RSTD) + RT, 1};
          pg8::gemm_phase<MLC, 256, true>(F.lds, S, E); }
        xcd_barrier(F.lds);
        FRESH(); rw_phase(F, layer);
        xcd_barrier(F.lds);
        FRESH(); rwkv_post_phase(F, layer, layer == 0 ? RT : RL);
        xcd_barrier(F.lds);
        FRESH(); krope_pass(F, 1, layer);
        FRESH(); ret_r3_phase(F, layer);
        { PHASE_VARS SchedHalf S{(const char*)(ws + D_UMLA), wl + WL_WQ, (size_t)256 * MLC * 2, (size_t)256 * 384 * 2, 6, 3, 1, G, (c + G - 64 % G) % G};
          EpiQup E{(bf16_t*)(ws + D_Q), (const float*)(ws + WS_RSTD), (const float*)(ws + WS_ROPE_M), (const float*)(ws + WS_ROPE_M) + 4096 * 16, 0};
          pg8::gemm_phase<MLC, 384, false>(F.lds, S, E); }
        { PHASE_VARS SchedHalf S{(const char*)(ws + D_UMLA) + 384 * 2, wl + WL_WKV, (size_t)256 * MLC * 2, (size_t)256 * 256 * 2, 4, 4, 1, G, (c + G - 216 % G) % G};
          EpiKVup E{(bf16_t*)(ws + D_K), (bf16_t*)(ws + D_V), (const float*)(ws + WS_RSTD) + RT, 0};
          pg8::gemm_phase<MLC, 256, true>(F.lds, S, E); }
        xcd_barrier(F.lds);
        FRESH(); attn_phase(F, layer);
        xcd_barrier(F.lds);
        if (layer != 0) { { PHASE_VARS norm_pass(F, layer, 0, hl, hcx, nMm * 256, (bf16_t*)(ws + D_XN1), (bf16_t*)(ws + D_XN1 + Y34)); }
        xcd_barrier(F.lds); }
        { PHASE_VARS SchedMerge S; S.XNlo = (const char*)(ws + D_XN1); S.XNhi = (const char*)(ws + D_XN1 + Y34); S.WgLo = wl + WL_WGLO; S.WgHi = wl + WL_WGHI;
          S.wsb = (const char*)ws; S.Wb = wl + WL_WB; S.nM = nMm; S.G = G; S.c = c; S.ctx3 = L0 && G > 64;
          EpiMerge E{(u32x4*)(ws + D_SCR + (size_t)c * 131072), (bf16_t*)(ws + D_M), (bf16_t*)(ws + D_P12)};
          pg8::gemm_phase<512, 512, true>(F.lds, S, E); }
        xcd_barrier(F.lds);
        if (layer == 0 && F.G > 64) { PHASE_VARS SchedWout0 S{(const char*)(ws + D_M), wl + WL_WO, (const char*)ws, G, c};
          EpiResid E{hl, hcx, P->out, hc, mod, 2048, nullptr};
          pg8::gemm_phase<1024, 1024, false>(F.lds, S, E); }
        else { PHASE_VARS Sched1 S{(const char*)(ws + D_M), wl + WL_WO, (size_t)256 * 1024 * 2, (size_t)256 * 1024 * 2, 16, nMm, 4, G, c};
          EpiResid E{hl, hcx, P->out, hc, mod, 2048, nullptr};
          pg8::gemm_phase<1024, 1024, false>(F.lds, S, E); }
        xcd_barrier(F.lds);
        if (layer == 0) {
            { PHASE_VARS norm_pass(F, layer, 1, P->out, hc, RT, (bf16_t*)(ws + D_XN2), (bf16_t*)(ws + D_XN2 + Y34)); }
            FRESH(); convert_ffn0(F);
            xcd_barrier(F.lds);
            { PHASE_VARS SchedSplit2 S{(const char*)(ws + D_XN2), (const char*)(ws + D_XN2 + Y34), (const char*)(ws + D_FFW), (const char*)(ws + D_FFW) + (size_t)5632 * 1024, RT / 256, 22, G, c, false};
              EpiSwiglu E{(bf16_t*)(ws + D_H), DFF};
              pg8::gemm_phase<512, 512, true>(F.lds, S, E); }
            xcd_barrier(F.lds);
            { PHASE_VARS SchedDown0 S{(const char*)(ws + D_H), (const char*)(ws + D_FFW) + (size_t)2 * 5632 * 1024, G, c};
              EpiResid E{P->out, hc, P->out, hc, mod, 5120, (float*)(ws + D_PART)};
              pg8::gemm_phase<DFF, DFF, false>(F.lds, S, E); }
            xcd_barrier(F.lds);
        } else {
            FRESH(); moe_route_pass(F, layer);
            FRESH(); convert_moe(F);
            xcd_barrier(F.lds);
            FRESH(); moe_gather_pass(F, layer);
            xcd_barrier(F.lds);
            { PHASE_VARS const MoeTiles T = moe_tiles((const unsigned*)(ws + WS_CTL));
              SchedMoeUp S{(const char*)(ws + D_XG), (const char*)(ws + D_XG) + (size_t)RG * 1024, (const char*)(ws + D_MOEW), T, G, c};
              EpiSwiglu E{(bf16_t*)(ws + D_HM), DFE};
              pg8::gemm_phase<512, 512, true>(F.lds, S, E); }
            xcd_barrier(F.lds);
            { PHASE_VARS const MoeTiles T = moe_tiles((const unsigned*)(ws + WS_CTL));
              SchedMoeDown S{(const char*)(ws + D_HM), (const char*)(ws + D_MOEW), T, G, c};
              EpiBf16 E{(bf16_t*)(ws + D_XG), 1024};
              pg8::gemm_phase<DFE, DFE, true>(F.lds, S, E); }
            xcd_barrier(F.lds);
            FRESH(); moe_final_pass(F, layer);
        }
    }
#undef PHASE_VARS
#undef FRESH

__global__ void __launch_bounds__(NTHREADS, 2) mega_fwd(Params prm) {
    extern __shared__ __attribute__((aligned(16))) unsigned char lds_raw[];
    cg::grid_group grid = cg::this_grid();
    Ctx F; F.lds = (LAS unsigned char*)lds_raw; F.tid = threadIdx.x; F.lane = F.tid & 63; F.wave = __builtin_amdgcn_readfirstlane(F.tid >> 6); F.G = gridDim.x; F.bid = blockIdx.x;
    if (F.tid < 4) ((LAS unsigned*)(F.lds + LDS_BARST))[F.tid] = 0u;
    __syncthreads();
    if (F.tid == 0) (void)xb_add((unsigned*)(prm.ws + WS_CTL) + CW_BAR + XB_XCNT(xb_xcc_id()), 1u);
    phase0(F);
    grid.sync();
    layer_fwd<0>(F, grid);
    layer_fwd<1>(F, grid);
}

extern "C" void kernel_launch(void* const* d_in, const int* in_sizes, int n_in, void* d_out, int out_size, void* d_ws, size_t ws_size, hipStream_t stream) {
    static int grid_blocks = 0;
    if (grid_blocks == 0) {
        if (n_in != 37 || ws_size < WS_NEED) { fprintf(stderr, "kernel_launch: unexpected n_in %d / ws %zu\n", n_in, ws_size); grid_blocks = -1; return; }
        int dev = 0, cus = 0, per_cu = 0;
        hipGetDevice(&dev); hipDeviceGetAttribute(&cus, hipDeviceAttributeMultiprocessorCount, dev);
        hipFuncSetAttribute((const void*)mega_fwd, hipFuncAttributeMaxDynamicSharedMemorySize, LDS_BYTES);
        hipOccupancyMaxActiveBlocksPerMultiprocessor(&per_cu, (const void*)mega_fwd, NTHREADS, LDS_BYTES);
        if (per_cu < 1) { fprintf(stderr, "kernel_launch: occupancy query says %d blocks/CU\n", per_cu); per_cu = 1; }
        grid_blocks = cus;
        (void)hipGetLastError();
    }
    if (grid_blocks < 0) return;
    (void)hipMemsetAsync((char*)d_ws + WS_CTL, 0, 65536, stream);
    Params p{};
    for (int i = 0; i < 37; ++i) p.in[i] = (const float*)d_in[i];
    p.out = (float*)d_out; p.ws = (unsigned char*)d_ws;
    void* args[] = {&p};
    hipError_t e = hipLaunchCooperativeKernel((const void*)mega_fwd, dim3(grid_blocks), dim3(NTHREADS), args, LDS_BYTES, stream);
    if (e != hipSuccess) fprintf(stderr, "cooperative launch failed: %s (grid %d)\n", hipGetErrorString(e), grid_blocks);
}
```

```cpp
#include <hip/hip_runtime.h>
#include <hip/hip_cooperative_groups.h>
#include <cstdio>
#include <cstdint>
namespace cg = cooperative_groups;

#define LAS __attribute__((address_space(3)))
typedef unsigned short bf16_t;
typedef short bf16x8 __attribute__((ext_vector_type(8)));
typedef short s16x4 __attribute__((ext_vector_type(4)));
typedef float f32x4 __attribute__((ext_vector_type(4)));
typedef float f32x2 __attribute__((ext_vector_type(2)));
typedef float f32x16 __attribute__((ext_vector_type(16)));
typedef unsigned u32x4 __attribute__((ext_vector_type(4)));
typedef unsigned u32x2 __attribute__((ext_vector_type(2)));

constexpr int DM = 1024, NBATCH = 8, SEQ = 4096, CTXL = 256;
constexpr int RL = NBATCH * SEQ, RC = NBATCH * CTXL, RT = RL + RC;
constexpr int RWC = 1920, REC = 1536, MLC = 672, MIXC = 4128, MIXP = 4352, GATEC = 3072, NIN = 7200;
constexpr int DFF = 2816, NEXP = 8, DFE = 1408;
constexpr int RG = 2 * RL + NEXP * 256;
constexpr int NTHREADS = 512;
constexpr int LDS_BYTES = 147456;

constexpr size_t MiB = 1u << 20;
constexpr size_t WS_CTL = 0;
constexpr size_t WS_MOD = 1 * MiB;
constexpr size_t WS_ROPE_R = 3 * MiB / 2;
constexpr size_t WS_ROPE_M = 5 * MiB / 2;
constexpr size_t WS_RSTD = 3 * MiB;
constexpr size_t WS_BSC = 7 * MiB / 2;
constexpr size_t WS_ROUTE = 6 * MiB;
constexpr size_t WS_WG2 = 7 * MiB;
constexpr size_t WS_W2T = 15 * MiB / 2;
constexpr size_t WS_HC = 8 * MiB;
constexpr size_t WS_W = 16 * MiB;
constexpr size_t WL_WINLO = 0, WL_WINHI = 4456448, WL_WGLO = 8912896, WL_WGHI = 12058624, WL_WQ = 15204352, WL_WKV = 15794176, WL_WB = 16318464, WL_WO = 19464192, WL_STRIDE = 21 * MiB;
constexpr size_t WS_DYN = 58 * MiB;
constexpr size_t Y34 = 34 * MiB;
constexpr size_t D_URWKV = WS_DYN, D_URET = WS_DYN + 255 * MiB / 2, D_UMLA = D_URET + 102 * MiB, D_XN1 = D_UMLA + 357 * MiB / 8, D_OF = D_XN1 + 2 * Y34, D_OB = D_OF + Y34, D_END1 = D_OB + Y34;
constexpr size_t D_YRWKV = D_OF, D_YRET = D_OB;
constexpr size_t D_K = WS_DYN, D_V = D_K + 289 * MiB / 8, D_Q = D_V + Y34;
constexpr size_t D_YMLA = D_UMLA;
constexpr int HROWS = 4 * SEQ + 4 * CTXL;
constexpr size_t HA_K = 0, HA_V = HA_K + (size_t)HROWS * 544 * 2, HA_Q = HA_V + (size_t)HROWS * 512 * 2;
static_assert(HA_Q + (size_t)HROWS * 768 * 2 <= 64 * MiB, "half-A K/V/Q fit the first half of d_out");

constexpr size_t D_SCR = WS_DYN + 68 * MiB;
constexpr size_t D_P12 = WS_DYN + 100 * MiB;
constexpr size_t D_M = WS_DYN;
constexpr size_t D_FFW = WS_DYN;
constexpr size_t D_XN2 = WS_DYN + 17 * MiB;
constexpr size_t D_H = D_URET;
constexpr size_t D_H1 = WS_DYN + 380 * MiB;
constexpr size_t D_PART = WS_DYN + 17 * MiB;
constexpr size_t D_XG = WS_DYN;
constexpr size_t D_HM = WS_DYN + 132 * MiB;
constexpr size_t D_MOEW = D_HM + 363 * MiB / 2;
constexpr size_t WS_NEED = 512 * MiB;
static_assert(D_MOEW + 66 * MiB <= D_H1 && D_H1 + 64 * MiB <= WS_NEED, "h1 region");
static_assert(D_END1 <= WS_NEED && D_MOEW + 66 * MiB <= WS_NEED && D_H + 187 * MiB <= WS_NEED && D_Q + 51 * MiB <= D_URET, "ws map");

struct Params { const float* in[37]; float* out; unsigned char* ws; };
enum { I_X = 0, I_C, I_CTX, I_CCTX, I_NMIX, I_NFFN, I_WMOD, I_BMOD, I_WIN, I_MU, I_W0, I_W2, I_A0, I_A2, I_G2, I_KK, I_KA, I_RK, I_LNG, I_LNB,
       I_RDEC, I_RLNG, I_RLNB, I_QN, I_QUP, I_KVN, I_KVUP, I_WBR, I_WOUT, I_FG, I_FU, I_FD, I_ROUTER, I_MG, I_MU2, I_MD, I_FNORM };

__device__ __forceinline__ unsigned f2bf(float f) { unsigned u = __builtin_bit_cast(unsigned, f); return (u + 0x7fffu + ((u >> 16) & 1u)) >> 16; }
typedef __bf16 bf16x2_t __attribute__((ext_vector_type(2)));
__device__ __forceinline__ unsigned pk2(float lo, float hi) { const f32x2 v = {lo, hi}; return __builtin_bit_cast(unsigned, __builtin_convertvector(v, bf16x2_t)); }
__device__ __forceinline__ float bf2f(unsigned short b) { return __builtin_bit_cast(float, (unsigned)b << 16); }
__device__ __forceinline__ float bflo(unsigned w) { return __builtin_bit_cast(float, w << 16); }
__device__ __forceinline__ float bfhi(unsigned w) { return __builtin_bit_cast(float, w & 0xffff0000u); }
__device__ __forceinline__ float shx(float v, int m, int lane) { return __int_as_float(__builtin_amdgcn_ds_bpermute((lane ^ m) << 2, __float_as_int(v))); }
__device__ __forceinline__ float wave_sum(float v, int lane) {
#pragma unroll
    for (int o = 1; o < 64; o <<= 1) v += shx(v, o, lane);
    return v;
}
__device__ __forceinline__ float sigmoidf_(float x) { return __builtin_amdgcn_rcpf(1.0f + __builtin_amdgcn_exp2f(-1.4426950408889634f * x)); }
__device__ __forceinline__ float siluf_(float x) { return x * __builtin_amdgcn_rcpf(1.0f + __builtin_amdgcn_exp2f(-1.4426950408889634f * x)); }
__device__ __forceinline__ void unpack8(u32x4 w, float* f) { f[0] = bflo(w.x); f[1] = bfhi(w.x); f[2] = bflo(w.y); f[3] = bfhi(w.y); f[4] = bflo(w.z); f[5] = bfhi(w.z); f[6] = bflo(w.w); f[7] = bfhi(w.w); }
__device__ __forceinline__ u32x4 pack8(const float* f) { u32x4 w; w.x = pk2(f[0], f[1]); w.y = pk2(f[2], f[3]); w.z = pk2(f[4], f[5]); w.w = pk2(f[6], f[7]); return w; }

namespace pg8 {
constexpr int BM = 256, BK = 64, HALF = 128, HTB = HALF * BK * 2, STAGE_BYTES = 8 * HTB, NXCD = 8, WGM = 4;
__host__ __device__ __forceinline__ int lds_byte(int r, int c) { const int st = (r >> 4) * 2 + (c >> 5), rr = r & 15, cc = c & 31, ob = rr * 64 + cc * 2; return st * 1024 + (ob ^ (((ob >> 9) & 1) << 5)); }
__host__ __device__ __forceinline__ void stage_rc(int b, int& R, int& C) { const int st = b / 1024, sb = b % 1024, swz = sb ^ (((sb >> 9) & 1) << 5); R = (st >> 1) * 16 + swz / 64; C = (st & 1) * 32 + (swz % 64) / 2; }
__host__ __device__ __forceinline__ int perm32(int rho) { const int n = rho >> 4, i = rho & 15; return 8 * (i >> 2) + 4 * n + (i & 3); }

struct Seg { const char* A; const char* B; int nt; int pm, pn, aux; bool first, last; };

__device__ __forceinline__ void tile_order(int L, int nM, int nN, int& pm, int& pn) {
    const int nwg = nM * nN; int wgid = L;
    { const int q = nwg / NXCD, r = nwg % NXCD, xcd = wgid % NXCD, off = wgid / NXCD; wgid = (xcd < r ? xcd * (q + 1) : r * (q + 1) + (xcd - r) * q) + off; }
    const int nig = WGM * nN, gid = wgid / nig, fm = gid * WGM, gsz = (nM - fm) < WGM ? (nM - fm) : WGM;
    pm = fm + ((wgid % nig) % gsz); pn = (wgid % nig) / gsz;
}

template <int LDA, int LDB, bool PERM, class Sched, class Epi>
__device__ __forceinline__ void gemm_phase(LAS unsigned char* lds, const Sched& S, const Epi& E) {
    int tid_ = threadIdx.x; asm volatile("" : "+v"(tid_));
    const int tid = tid_, wid = __builtin_amdgcn_readfirstlane(tid >> 6), lane = tid & 63, wr = wid >> 2, wc = wid & 3, fr = lane & 15, fq = lane >> 4;
    unsigned voffA[2], voffB[2];
#pragma unroll
    for (int i = 0; i < 2; ++i) { int R, C; stage_rc(tid * 16 + i * 8192, R, C); const int Rb = PERM ? ((R & ~31) + perm32(R & 31)) : R;
        voffA[i] = (unsigned)(R * LDA + C) * 2u; voffB[i] = (unsigned)(Rb * LDB + C) * 2u; }
    constexpr size_t kstep = (size_t)(BK * 2);
    constexpr size_t hstepA = (size_t)HALF * LDA * 2, hstepB = (size_t)HALF * LDB * 2;
    const unsigned ldsw = (unsigned)wid * 1024u;
    const int aoff = lds_byte(wr * 64 + fr, fq * 8), boff = lds_byte(wc * 32 + fr, fq * 8);
#define PG8_SA(b, h) (((b) * 2 + (h)) * HTB)
#define PG8_SB(b, h) ((4 + (b) * 2 + (h)) * HTB)
#define PG8_STAGE(bufoff, gbase, voff) do { _Pragma("unroll") for (int _i = 0; _i < 2; ++_i) \
        __builtin_amdgcn_global_load_lds((const unsigned*)((const char*)(gbase) + (voff)[_i]), (LAS unsigned*)(lds + (bufoff) + ldsw + _i * 8192), 16, 0, 0); } while (0)
#define PG8_LDA(dst, b, h) do { _Pragma("unroll") for (int m = 0; m < 4; ++m) _Pragma("unroll") for (int k = 0; k < 2; ++k) dst[m][k] = *(const LAS bf16x8*)(lds + PG8_SA(b, h) + aoff + m * 2048 + k * 1024); } while (0)
#define PG8_LDB(dst, b, h) do { _Pragma("unroll") for (int n = 0; n < 2; ++n) _Pragma("unroll") for (int k = 0; k < 2; ++k) dst[n][k] = *(const LAS bf16x8*)(lds + PG8_SB(b, h) + boff + n * 2048 + k * 1024); } while (0)
#define PG8_MMA(ai, bj, At, Bt) do { __builtin_amdgcn_s_setprio(1); _Pragma("unroll") for (int m = 0; m < 4; ++m) _Pragma("unroll") for (int n = 0; n < 2; ++n) _Pragma("unroll") for (int k = 0; k < 2; ++k) \
        acc[ai][bj][m][n] = __builtin_amdgcn_mfma_f32_16x16x32_bf16(Bt[n][k], At[m][k], acc[ai][bj][m][n], 0, 0, 0); __builtin_amdgcn_s_setprio(0); } while (0)
#define PG8_WAIT_V(n) asm volatile("s_waitcnt vmcnt(" #n ")" ::: "memory")
#define PG8_WAIT_L(n) asm volatile("s_waitcnt lgkmcnt(" #n ")" ::: "memory")
#define PG8_BAR __builtin_amdgcn_s_barrier()
#define PG8_SCHED __builtin_amdgcn_sched_barrier(0)
    Seg cur, nxt; int ui = 0;
    if (!S.next(0, cur)) return;
    f32x4 acc[2][2][4][2];
#pragma unroll
    for (int a = 0; a < 2; ++a)
#pragma unroll
        for (int b = 0; b < 2; ++b)
#pragma unroll
            for (int m = 0; m < 4; ++m)
#pragma unroll
                for (int n = 0; n < 2; ++n) acc[a][b][m][n] = (f32x4){0.f, 0.f, 0.f, 0.f};
    bf16x8 At[4][2], B0[2][2], B1[2][2];
    const char* cA = cur.A; const char* cB = cur.B;
    PG8_STAGE(PG8_SB(0, 0), cB, voffB); PG8_STAGE(PG8_SB(0, 1), cB + hstepB, voffB); PG8_STAGE(PG8_SA(0, 0), cA, voffA); PG8_STAGE(PG8_SA(0, 1), cA + hstepA, voffA);
    if (wr == 1) PG8_BAR;
    PG8_WAIT_V(2); PG8_BAR;
    PG8_STAGE(PG8_SB(1, 0), cB + kstep, voffB); PG8_STAGE(PG8_SA(1, 0), cA + kstep, voffA); PG8_STAGE(PG8_SB(1, 1), cB + hstepB + kstep, voffB);
    PG8_WAIT_V(6); PG8_BAR;
    for (;;) {
        const bool has_next = S.next(ui + 1, nxt);
        const char* nA = has_next ? nxt.A : cA; const char* nB = has_next ? nxt.B : cB;
        const int nt = cur.nt;
        for (int t = 0; t < nt; t += 2) {
            const bool last = (t == nt - 2);
            const char* a1 = cA + (size_t)(t + 1) * kstep;
            const char* a2 = last ? nA : cA + (size_t)(t + 2) * kstep; const char* b2 = last ? nB : cB + (size_t)(t + 2) * kstep;
            const char* a3 = a2 + kstep; const char* b3 = b2 + kstep;
            PG8_LDB(B0, 0, 0); PG8_LDB(B1, 0, 1); PG8_SCHED; PG8_LDA(At, 0, 0); PG8_STAGE(PG8_SA(1, 1), a1 + hstepA, voffA);
            PG8_WAIT_V(8); PG8_WAIT_L(0); PG8_BAR; PG8_MMA(0, 0, At, B0); PG8_MMA(0, 1, At, B1); PG8_BAR; PG8_SCHED;
            PG8_LDA(At, 0, 1); PG8_STAGE(PG8_SB(0, 0), b2, voffB); PG8_STAGE(PG8_SB(0, 1), b2 + hstepB, voffB); PG8_STAGE(PG8_SA(0, 0), a2, voffA);
            PG8_WAIT_V(8); PG8_WAIT_L(0); PG8_BAR; PG8_MMA(1, 0, At, B0); PG8_MMA(1, 1, At, B1); PG8_BAR; PG8_SCHED;
            PG8_LDB(B0, 1, 0); PG8_LDB(B1, 1, 1); PG8_SCHED; PG8_LDA(At, 1, 0); PG8_STAGE(PG8_SA(0, 1), a2 + hstepA, voffA);
            PG8_WAIT_V(8); PG8_WAIT_L(0); PG8_BAR; PG8_MMA(0, 0, At, B0); PG8_MMA(0, 1, At, B1); PG8_BAR; PG8_SCHED;
            PG8_LDA(At, 1, 1); PG8_STAGE(PG8_SB(1, 0), b3, voffB); PG8_STAGE(PG8_SB(1, 1), b3 + hstepB, voffB); PG8_STAGE(PG8_SA(1, 0), a3, voffA);
            PG8_WAIT_V(8); PG8_WAIT_L(0); PG8_BAR; PG8_MMA(1, 0, At, B0); PG8_MMA(1, 1, At, B1); PG8_BAR; PG8_SCHED;
        }
        const bool was_last = cur.last;
        if (was_last) { if (wr == 0) PG8_BAR; E(acc, cur, wr, wc, fr, fq); }
        if (!has_next) break;
        if (nxt.first) {
#pragma unroll
            for (int a = 0; a < 2; ++a)
#pragma unroll
                for (int b = 0; b < 2; ++b)
#pragma unroll
                    for (int m = 0; m < 4; ++m)
#pragma unroll
                        for (int n = 0; n < 2; ++n) acc[a][b][m][n] = (f32x4){0.f, 0.f, 0.f, 0.f};
        }
        cur = nxt; cA = nA; cB = nB; ++ui;
        if (was_last) { if (wr == 1) PG8_BAR; }
    }
    PG8_WAIT_V(0);
    PG8_BAR;
#undef PG8_SA
#undef PG8_SB
#undef PG8_STAGE
#undef PG8_LDA
#undef PG8_LDB
#undef PG8_MMA
#undef PG8_WAIT_V
#undef PG8_WAIT_L
#undef PG8_BAR
#undef PG8_SCHED
}
}
using pg8::Seg;

struct Ctx {
    LAS unsigned char* lds; int tid, lane, wave, G, bid;
};
typedef const __attribute__((address_space(4))) Params* PP;
__device__ __forceinline__ PP getpp() { PP p = (PP)__builtin_amdgcn_kernarg_segment_ptr(); asm volatile("" : "+s"(p)); return p; }
__device__ __forceinline__ unsigned char* half_a_base(int layer) { (void)layer; PP p = getpp(); return (unsigned char*)p->out; }
__device__ __forceinline__ bf16_t* h0_base() { PP p = getpp(); return (bf16_t*)((unsigned char*)p->out + 64 * MiB); }
__device__ __forceinline__ f32x4 ldh4(const bf16_t* p) { const u32x2 w = *(const u32x2*)p; return (f32x4){bflo(w.x), bfhi(w.x), bflo(w.y), bfhi(w.y)}; }
#define GW(F) ((F).bid * 8 + (F).wave)
#define NGW(F) ((F).G * 8)
#define LDS_WAIT() asm volatile("s_waitcnt lgkmcnt(0)" ::: "memory")

struct TrJob {
    const float* s0; const float* s1; int spitch; int K; int nd; int mode; int c0; int nvalid; const float* ks;
    bf16_t* dlo; bf16_t* dhi; int dpitch; int ksplit;
};
__device__ __forceinline__ void tr_load(const TrJob& J, int item, int lane, float* v, bool& valid) {
    const int nblk = J.nd / 32, kb = item / nblk, nb = item % nblk, k0 = 64 * kb, n0 = 32 * nb;
    const int np = n0 + (lane & 31);
    const float* src = J.s0; int col = 0; valid = true;
    if (J.mode == 0) { col = J.c0 + np; valid = np < J.nvalid; }
    else if (J.mode == 1) { if (np < 512) col = (np >> 6) * 128 + (np & 63); else col = ((np - 512) >> 6) * 128 + 64 + (np & 63); }
    else { const int tile = np >> 8, w = np & 255; if (w < 128) col = tile * 128 + w; else { col = tile * 128 + (w - 128); src = J.s1; } }
    if (!valid) col = J.c0;
    const float* sp = src + (size_t)(k0 + (lane >> 5)) * J.spitch + col;
#pragma unroll
    for (int i = 0; i < 32; ++i) v[i] = __builtin_nontemporal_load(sp + (size_t)(2 * i) * J.spitch);
    if (J.ks) {
#pragma unroll
        for (int i = 0; i < 32; ++i) v[i] *= J.ks[k0 + 2 * i + (lane >> 5)]; }
}
__device__ __forceinline__ void tr_store(const TrJob& J, LAS float* scr, int item, int lane, const float* v, bool valid) {
    const int nblk = J.nd / 32, kb = item / nblk, nb = item % nblk, k0 = 64 * kb, n0 = 32 * nb;
#pragma unroll
    for (int i = 0; i < 32; ++i) scr[(2 * i + (lane >> 5)) * 33 + (lane & 31)] = valid ? v[i] : 0.f;
    LDS_WAIT(); asm volatile("" ::: "memory");
    const int c = lane & 7;
    bf16_t* dst = (k0 < J.ksplit) ? J.dlo : J.dhi; const int kd = (k0 < J.ksplit) ? k0 : k0 - J.ksplit;
#pragma unroll
    for (int j = 0; j < 4; ++j) { const int n = (lane >> 3) + 8 * j; const LAS float* s = scr + (8 * c) * 33 + n;
        u32x4 o; o.x = pk2(s[0 * 33], s[1 * 33]); o.y = pk2(s[2 * 33], s[3 * 33]); o.z = pk2(s[4 * 33], s[5 * 33]); o.w = pk2(s[6 * 33], s[7 * 33]);
        *(u32x4*)(dst + (size_t)(n0 + n) * J.dpitch + kd + 8 * c) = o; }
    LDS_WAIT(); asm volatile("" ::: "memory");
}
__device__ __forceinline__ void tr_job(const Ctx& F, const TrJob& J, int& rot) {
    LAS float* scr = (LAS float*)(F.lds + F.wave * 8704);
    const int nitems = (J.K / 64) * (J.nd / 32); const int ngw = NGW(F);
    int it = (GW(F) - rot % ngw); if (it < 0) it += ngw;
    rot += nitems;
    if (it >= nitems) return;
    float v[32]; bool valid; tr_load(J, it, F.lane, v, valid);
    for (;;) {
        const int nx = it + ngw; const bool more = nx < nitems; float vn[32]; bool validn = false;
        if (more) tr_load(J, nx, F.lane, vn, validn);
        tr_store(J, scr, it, F.lane, v, valid);
        if (!more) break;
#pragma unroll
        for (int i = 0; i < 32; ++i) v[i] = vn[i];
        valid = validn; it = nx;
    }
}
__device__ __forceinline__ TrJob mk_job(const float* s0, int spitch, int K, int nd, int c0, int nvalid, bf16_t* dst, int dpitch) {
    TrJob J; J.s0 = s0; J.s1 = nullptr; J.spitch = spitch; J.K = K; J.nd = nd; J.mode = 0; J.c0 = c0; J.nvalid = nvalid; J.ks = nullptr; J.dlo = dst; J.dhi = dst; J.dpitch = dpitch; J.ksplit = 1 << 30; return J;
}

__device__ __forceinline__ void phase0(const Ctx& F) {
    PP P = getpp(); unsigned char* ws = P->ws;
    {
        float* cr = (float*)(ws + WS_ROPE_R); float* sr = cr + 4096 * 32; float* cm = (float*)(ws + WS_ROPE_M); float* sm = cm + 4096 * 16;
        for (int i = F.bid * NTHREADS + F.tid; i < 4096 * 48; i += F.G * NTHREADS) {
            const int t = i / 48, j = i % 48; const float row = (float)(t >> 6), colp = (float)(t & 63);
            if (j < 32) { const int f = j & 15; const float inv = powf(10000.0f, -(float)f / 16.0f); const float ang = (j < 16 ? row : colp) * inv; cr[t * 32 + j] = cosf(ang); sr[t * 32 + j] = sinf(ang); }
            else { const int jj = j - 32, f = jj & 7; const float inv = powf(10000.0f, -(float)f / 8.0f); const float ang = (jj < 8 ? row : colp) * inv; cm[t * 16 + jj] = cosf(ang); sm[t * 16 + jj] = sinf(ang); }
        }
        if (F.bid == 0 && F.tid < 64) ((unsigned*)(ws + WS_CTL))[F.tid] = 0u;
    }
    {
        LAS float* sc = (LAS float*)(F.lds + 70000);
        LAS float* red = (LAS float*)(F.lds + 70000 + 36864);
        for (int i = F.tid; i < 9 * 1024; i += NTHREADS) { const int v = i >> 10, k = i & 1023; const float x = v < 8 ? P->in[I_C][v * 1024 + k] : P->in[I_CCTX][k]; sc[i] = siluf_(x); }
        __syncthreads();
        for (int it = F.bid; it < 2 * 96; it += F.G) {
            const int l = it / 96, jc = F.tid & 63, j = (it % 96) * 64 + jc, ksl = F.tid >> 6;
            const float* w = P->in[I_WMOD] + (size_t)l * 1024 * 6144 + j + (size_t)(ksl * 128) * 6144;
            float a[9];
#pragma unroll
            for (int v = 0; v < 9; ++v) a[v] = 0.f;
#pragma unroll 1
            for (int k0 = 0; k0 < 128; k0 += 32) { float wv[32];
#pragma unroll
                for (int q = 0; q < 32; ++q) wv[q] = w[(size_t)(k0 + q) * 6144];
                __builtin_amdgcn_sched_barrier(0);
#pragma unroll
                for (int qh = 0; qh < 32; qh += 16) {
#pragma unroll
                    for (int q = qh; q < qh + 16; ++q)
#pragma unroll
                        for (int v = 0; v < 9; ++v) a[v] += sc[v * 1024 + ksl * 128 + k0 + q] * wv[q];
                    __builtin_amdgcn_sched_barrier(0); } }
#pragma unroll
            for (int v = 0; v < 9; ++v) red[(ksl * 64 + jc) * 9 + v] = a[v];
            __syncthreads();
            if (F.tid < 64) {
                float* mo = (float*)(ws + WS_MOD) + (size_t)l * 9 * 6144;
#pragma unroll
                for (int v = 0; v < 9; ++v) { float s = 0.f;
#pragma unroll
                    for (int q = 0; q < 8; ++q) s += red[(q * 64 + F.tid) * 9 + v];
                    mo[v * 6144 + j] = s + P->in[I_BMOD][l * 6144 + j]; }
            }
            __syncthreads();
        }
    }
    int rot = (192 * 8) % NGW(F);
    for (int l = 0; l < 2; ++l) {
        unsigned char* wb = ws + WS_W + (size_t)l * WL_STRIDE;
        const float* win = P->in[I_WIN] + (size_t)l * 1024 * NIN;
        { TrJob J = mk_job(win, NIN, 1024, MIXP, 0, MIXC, (bf16_t*)(wb + WL_WINLO), 512); J.dhi = (bf16_t*)(wb + WL_WINHI); J.ksplit = 512; tr_job(F, J, rot); }
        { TrJob J = mk_job(win, NIN, 1024, GATEC, MIXC, GATEC, (bf16_t*)(wb + WL_WGLO), 512); J.dhi = (bf16_t*)(wb + WL_WGHI); J.ksplit = 512; tr_job(F, J, rot); }
        { TrJob J = mk_job(P->in[I_QUP] + (size_t)l * 384 * 768, 768, 384, 768, 0, 768, (bf16_t*)(wb + WL_WQ), 384); J.ks = P->in[I_QN] + l * 384; tr_job(F, J, rot); }
        { TrJob J = mk_job(P->in[I_KVUP] + (size_t)l * 256 * 1024, 1024, 256, 1024, 0, 1024, (bf16_t*)(wb + WL_WKV), 256); J.mode = 1; J.ks = P->in[I_KVN] + l * 256; tr_job(F, J, rot); }
        for (int n = 0; n < 3; ++n) { TrJob J = mk_job(P->in[I_WBR] + ((size_t)l * 3 + n) * 512 * 1024, 1024, 512, 1024, 0, 1024, (bf16_t*)(wb + WL_WB) + (size_t)n * 1024 * 512, 512); tr_job(F, J, rot); }
        { TrJob J = mk_job(P->in[I_WOUT] + (size_t)l * 1024 * 1024, 1024, 1024, 1024, 0, 1024, (bf16_t*)(wb + WL_WO), 1024); tr_job(F, J, rot); }
        { TrJob J = mk_job(P->in[I_G2] + (size_t)l * 128 * 512, 512, 128, 512, 0, 512, (bf16_t*)(ws + WS_WG2) + (size_t)l * 512 * 128, 128); tr_job(F, J, rot); }
        for (int dd = 0; dd < 2; ++dd) {
            { TrJob J = mk_job(P->in[I_W2] + (size_t)(l * 2 + dd) * 64 * 512, 512, 64, 512, 0, 512, (bf16_t*)(ws + WS_W2T) + (size_t)((l * 2 + dd) * 2 + 0) * 512 * 64, 64); tr_job(F, J, rot); }
            { TrJob J = mk_job(P->in[I_A2] + (size_t)(l * 2 + dd) * 64 * 512, 512, 64, 512, 0, 512, (bf16_t*)(ws + WS_W2T) + (size_t)((l * 2 + dd) * 2 + 1) * 512 * 64, 64); tr_job(F, J, rot); }
        }
    }
}
__device__ __forceinline__ void convert_ffn0(const Ctx& F) {
    PP P = getpp(); unsigned char* ws = P->ws;
    bf16_t* glo = (bf16_t*)(ws + D_FFW); bf16_t* ghi = glo + (size_t)5632 * 512; bf16_t* wd = ghi + (size_t)5632 * 512;
    int rot = 0;
    { TrJob J = mk_job(P->in[I_FG], DFF, 1024, 5632, 0, 5632, glo, 512); J.s1 = P->in[I_FU]; J.mode = 2; J.dhi = ghi; J.ksplit = 512; tr_job(F, J, rot); }
    { TrJob J = mk_job(P->in[I_FD], 1024, DFF, 1024, 0, 1024, wd, DFF); tr_job(F, J, rot); }
}
__device__ __forceinline__ void convert_moe(const Ctx& F) {
    PP P = getpp(); unsigned char* ws = P->ws;
    int rot = 0;
    for (int e = 0; e < NEXP; ++e) {
        bf16_t* glo = (bf16_t*)(ws + D_MOEW + (size_t)e * (33 * MiB / 4)); bf16_t* ghi = glo + (size_t)2816 * 512; bf16_t* wd = ghi + (size_t)2816 * 512;
        { TrJob J = mk_job(P->in[I_MG] + (size_t)e * 1024 * DFE, DFE, 1024, 2816, 0, 2816, glo, 512); J.s1 = P->in[I_MU2] + (size_t)e * 1024 * DFE; J.mode = 2; J.dhi = ghi; J.ksplit = 512; tr_job(F, J, rot); }
        { TrJob J = mk_job(P->in[I_MD] + (size_t)e * DFE * 1024, 1024, DFE, 1024, 0, 1024, wd, DFE); tr_job(F, J, rot); }
    }
}

__device__ __forceinline__ void norm_pass(const Ctx& F, int layer, int which, const float* hl, const bf16_t* hb, const float* hcx, int nrows, bf16_t* xlo, bf16_t* xhi, bool ctxpart = false) {
    PP P = getpp();
    const float* gain = P->in[which ? I_NFFN : I_NMIX] + layer * 1024;
    const float* mod = (const float*)(P->ws + WS_MOD) + (size_t)layer * 9 * 6144 + (which ? 3072 : 0);
    const float* part = (const float*)(P->ws + D_PART); const float* g2c = (const float*)(P->ws + WS_MOD) + 8 * 6144 + 5120;
    const int rpw = (nrows + NGW(F) - 1) / NGW(F); const int r0 = GW(F) * rpw; const int r1 = (r0 + rpw < nrows) ? r0 + rpw : nrows;
    const bool dealt = ctxpart && NGW(F) == 2048 && nrows == RT;
    int vprev = -1; f32x4 gs[4], sh4[4];
    constexpr int NB = 4;
#define NP_LOAD(X_, RWS_, rb_) do { _Pragma("unroll") for (int b = 0; b < NB; ++b) { const int v_ = ((rb_) + b < r1) ? (rb_) + b : r1 - 1; \
            const int row_ = dealt ? ((v_ % 17) < 16 ? (v_ / 17) * 16 + (v_ % 17) : RL + v_ / 17) : v_; RWS_[b] = row_; \
            if (hb != nullptr && row_ < RL) { _Pragma("unroll") for (int j = 0; j < 4; ++j) X_[b][j] = ldh4(hb + (size_t)row_ * 1024 + 4 * F.lane + 256 * j); } \
            else { const float* src_ = row_ < RL ? hl + (size_t)row_ * 1024 : hcx + (size_t)(row_ - RL) * 1024; \
                _Pragma("unroll") for (int j = 0; j < 4; ++j) X_[b][j] = *(const f32x4*)(src_ + 4 * F.lane + 256 * j); } \
            if (ctxpart && row_ >= RL) { \
                _Pragma("unroll") for (int j = 0; j < 4; ++j) { const int c_ = 4 * F.lane + 256 * j; const float* pp_ = part + (size_t)(row_ - RL) * 1024 + c_; \
                    const f32x4 s4_ = ((*(const f32x4*)pp_ + *(const f32x4*)(pp_ + (size_t)RC * 1024)) + *(const f32x4*)(pp_ + (size_t)2 * RC * 1024)) + *(const f32x4*)(pp_ + (size_t)3 * RC * 1024); \
                    X_[b][j] = X_[b][j] + *(const f32x4*)(g2c + c_) * s4_; } } } } while (0)
    f32x4 x[NB][4], xn[NB][4]; int rows[NB], rowsn[NB];
    if (r0 < r1) NP_LOAD(x, rows, r0);
    for (int rb = r0; rb < r1; rb += NB) {
        float ss[NB]; const bool more = rb + NB < r1;
        if (more) NP_LOAD(xn, rowsn, rb + NB);
#pragma unroll
        for (int b = 0; b < NB; ++b) { ss[b] = 0.f;
#pragma unroll
            for (int j = 0; j < 4; ++j) ss[b] += x[b][j].x * x[b][j].x + x[b][j].y * x[b][j].y + x[b][j].z * x[b][j].z + x[b][j].w * x[b][j].w; }
#pragma unroll
        for (int b = 0; b < NB; ++b) ss[b] = wave_sum(ss[b], F.lane);
#pragma unroll
        for (int b = 0; b < NB; ++b) { const int row = rows[b];
            const int v = row < RL ? (row >> 12) : 8;
            if (v != vprev) { const float* sh = mod + v * 6144; const float* sc = sh + 1024;
#pragma unroll
                for (int j = 0; j < 4; ++j) { const int c = 4 * F.lane + 256 * j; gs[j] = *(const f32x4*)(gain + c) * (*(const f32x4*)(sc + c) + 1.0f); sh4[j] = *(const f32x4*)(sh + c); }
                vprev = v; }
            const float rstd = rsqrtf(ss[b] * (1.0f / 1024.0f) + 1e-6f);
#pragma unroll
            for (int j = 0; j < 4; ++j) { const int c = 4 * F.lane + 256 * j;
                const f32x4 y = x[b][j] * rstd * gs[j] + sh4[j];
                u32x2 o; o.x = pk2(y.x, y.y); o.y = pk2(y.z, y.w);
                bf16_t* d = (c < 512) ? xlo + (size_t)row * 512 + c : xhi + (size_t)row * 512 + (c - 512);
                *(u32x2*)d = o; } }
        if (more) {
#pragma unroll
            for (int b = 0; b < NB; ++b) { rows[b] = rowsn[b];
#pragma unroll
                for (int j = 0; j < 4; ++j) x[b][j] = xn[b][j]; } }
    }
#undef NP_LOAD
}

struct SchedSplit2 {
    const char *Alo, *Ahi, *Blo, *Bhi; int nM, nN, G, c; bool skipc;
    __device__ __forceinline__ bool next(int i, Seg& s) const {
        const int iu = i >> 1, h = i & 1; const long L = (long)iu * G + c;
        const int nlat = skipc ? (nM - 8) * nN : nM * nN, ntot = skipc ? nlat + 8 * (nN - 1) : nlat;
        if (L >= (long)ntot) return false;
        int pm, pn;
        if (L < nlat) pg8::tile_order((int)L, skipc ? nM - 8 : nM, nN, pm, pn); else { pg8::tile_order((int)L - nlat, 8, nN - 1, pm, pn); pm += nM - 8; }
        s.A = (h ? Ahi : Alo) + (size_t)pm * 256 * 1024; s.B = (h ? Bhi : Blo) + (size_t)pn * 256 * 1024; s.nt = 8; s.pm = pm; s.pn = pn; s.aux = 0; s.first = (h == 0); s.last = (h == 1); return true;
    }
};
struct Sched1 {
    const char *A, *B; size_t astride, bstride; int nt, nM, nN, G, c;
    __device__ __forceinline__ bool next(int i, Seg& s) const {
        const long L = (long)i * G + c; if (L >= (long)nM * nN) return false;
        int pm, pn; pg8::tile_order((int)L, nM, nN, pm, pn);
        s.A = A + (size_t)pm * astride; s.B = B + (size_t)pn * bstride; s.nt = nt; s.pm = pm; s.pn = pn; s.aux = 0; s.first = true; s.last = true; return true;
    }
};
struct SchedDown0 {
    const char *A, *B; int G, c;
    __device__ __forceinline__ bool next(int i, Seg& s) const {
        const long L = (long)i * G + c; s.first = true; s.last = true;
        if (L < 512) { int pm, pn; pg8::tile_order((int)L, RL / 256, 4, pm, pn);
            s.A = A + (size_t)pm * 256 * DFF * 2; s.B = B + (size_t)pn * 256 * DFF * 2; s.nt = 44; s.pm = pm; s.pn = pn; s.aux = 0; return true; }
        const int q = (int)L - 512; if (q >= 128) return false;
        const int tile = q >> 2, sl = q & 3, pmc = tile & 7, pn = tile >> 3; const int k0 = sl < 2 ? 12 * sl : 24 + 10 * (sl - 2);
        s.A = A + (size_t)(RL / 256 + pmc) * 256 * DFF * 2 + (size_t)k0 * 128; s.B = B + (size_t)pn * 256 * DFF * 2 + (size_t)k0 * 128;
        s.nt = sl < 2 ? 12 : 10; s.pm = RL / 256 + pmc; s.pn = pn; s.aux = 1 + sl; return true;
    }
};
struct SchedHalf {
    const char *A, *B; size_t astride, bstride; int nt, nN, half, G, c;
    __device__ __forceinline__ bool next(int i, Seg& s) const {
        const long L = (long)i * G + c; if (L >= (long)68 * nN) return false;
        int mi, pn; pg8::tile_order((int)L, 68, nN, mi, pn);
        const int pm = mi < 64 ? 64 * half + mi : 128 + 4 * half + (mi - 64);
        s.A = A + (size_t)pm * astride; s.B = B + (size_t)pn * bstride; s.nt = nt; s.pm = pm; s.pn = pn; s.aux = 0; s.first = true; s.last = true; return true;
    }
};
struct SchedMerge {
    const char *XNlo, *XNhi, *WgLo, *WgHi, *wsb, *Wb; int nM, G, c; bool ctx3;
    __device__ __forceinline__ void fill(Seg& s, int pm, int pn, int n, int k, int ctxbit) const {
        s.pm = pm; s.pn = pn; s.nt = 8;
        if (k == 0) { s.A = XNlo + (size_t)pm * 256 * 1024; s.B = WgLo + (size_t)(n * 1024 + pn * 256) * 1024; s.first = true; s.last = false; s.aux = n * 2; }
        else if (k == 1) { s.A = XNhi + (size_t)pm * 256 * 1024; s.B = WgHi + (size_t)(n * 1024 + pn * 256) * 1024; s.first = false; s.last = true; s.aux = n * 2; }
        else { const size_t yo = (n == 0) ? D_YRWKV : ((n == 1) ? D_YRET : D_YMLA); s.A = wsb + yo + (size_t)pm * 256 * 1024; s.B = Wb + (size_t)(n * 1024 + pn * 256) * 1024; s.first = true; s.last = true; s.aux = n * 2 + 1 + ctxbit; }
    }
    __device__ __forceinline__ bool next(int i, Seg& s) const {
        const int nMl = ctx3 ? RL / 256 : nM; const int NL = nMl * 4;
        const int kmax = (NL - c + G - 1) / G;
        if (i < 9 * kmax) { const int su = i / 9, r = i % 9; const long L = (long)su * G + c; int pm, pn; pg8::tile_order((int)L, nMl, 4, pm, pn); fill(s, pm, pn, r / 3, r % 3, 0); return true; }
        if (!ctx3) return false;
        const int j = i - 9 * kmax, t = j / 3, k = j % 3; const long idx = (long)t * G + c; if (idx >= 96) return false;
        const int tile = (int)idx / 3, n = (int)idx % 3; fill(s, RL / 256 + (tile & 7), tile >> 3, n, k, 8); return true;
    }
};
struct SchedWout0 {
    const char *A, *B, *wsb; int G, c;
    __device__ __forceinline__ bool next(int i, Seg& s) const {
        if (c < 32) { if (i >= 3) return false; const int pmc = c & 7, pn = c >> 3;
            const size_t ao = (i == 0) ? D_M + (size_t)RL * 1024 * 2 : ((i == 1) ? D_P12 : D_P12 + (size_t)RC * 1024 * 2);
            s.A = wsb + ao + (size_t)pmc * 256 * 1024 * 2; s.B = B + (size_t)pn * 256 * 1024 * 2; s.nt = 16; s.pm = RL / 256 + pmc; s.pn = pn; s.aux = 0; s.first = (i == 0); s.last = (i == 2); return true; }
        const long L = (long)i * (G - 32) + (c - 32); if (L >= (RL / 256) * 4) return false;
        int pm, pn; pg8::tile_order((int)L, RL / 256, 4, pm, pn);
        s.A = A + (size_t)pm * 256 * 1024 * 2; s.B = B + (size_t)pn * 256 * 1024 * 2; s.nt = 16; s.pm = pm; s.pn = pn; s.aux = 0; s.first = true; s.last = true; return true;
    }
};
struct MoeTiles { int tstart[NEXP + 1]; };
__device__ __forceinline__ MoeTiles moe_tiles(const unsigned* cnt) {
    MoeTiles T; int a = 0;
#pragma unroll
    for (int e = 0; e < NEXP; ++e) { T.tstart[e] = a; a += (int)((__builtin_amdgcn_readfirstlane(cnt[e]) + 255u) >> 8); }
    T.tstart[NEXP] = a; return T;
}
__device__ __forceinline__ int moe_expert_of(const MoeTiles& T, int mt) { int e = 0;
#pragma unroll
    for (int k = 1; k < NEXP; ++k) e += (mt >= T.tstart[k]) ? 1 : 0;
    return e; }
struct SchedMoeUp {
    const char *Alo, *Ahi, *W; MoeTiles T; int G, c;
    __device__ __forceinline__ bool next(int i, Seg& s) const {
        const int iu = i >> 1, h = i & 1; const int nM = T.tstart[NEXP]; const long L = (long)iu * G + c; if (L >= (long)nM * 11) return false;
        int pm, pn; pg8::tile_order((int)L, nM, 11, pm, pn);
        const int e = moe_expert_of(T, pm); const char* we = W + (size_t)e * (33 * MiB / 4);
        s.A = (h ? Ahi : Alo) + (size_t)pm * 256 * 1024; s.B = we + (h ? (size_t)2816 * 1024 : 0) + (size_t)pn * 256 * 1024; s.nt = 8; s.pm = pm; s.pn = pn; s.aux = e; s.first = (h == 0); s.last = (h == 1); return true;
    }
};
struct SchedMoeDown {
    const char *A, *W; MoeTiles T; int G, c;
    __device__ __forceinline__ bool next(int i, Seg& s) const {
        const int nM = T.tstart[NEXP]; const long L = (long)i * G + c; if (L >= (long)nM * 4) return false;
        int pm, pn; pg8::tile_order((int)L, nM, 4, pm, pn);
        const int e = moe_expert_of(T, pm); const char* we = W + (size_t)e * (33 * MiB / 4) + (size_t)2 * 2816 * 1024;
        s.A = A + (size_t)pm * 256 * DFE * 2; s.B = we + (size_t)pn * 256 * DFE * 2; s.nt = 22; s.pm = pm; s.pn = pn; s.aux = e; s.first = true; s.last = true; return true;
    }
};

typedef f32x4 Acc[2][2][4][2];
struct EpiInproj {
    unsigned char* ws;
    __device__ __forceinline__ void operator()(const Acc& acc, const Seg& u, int wr, int wc, int fr, int fq) const {
        const int row0 = u.pm * 256 + wr * 64 + fr;
#pragma unroll
        for (int bj = 0; bj < 2; ++bj) {
            const int c0 = u.pn * 256 + bj * 128 + wc * 32 + 8 * fq;
            const bool a = c0 < RWC, b = c0 < RWC + REC;
            const size_t boff = a ? D_URWKV : (b ? D_URET : D_UMLA); const int pitch = a ? RWC : (b ? REC : MLC); const int col = c0 - (a ? 0 : (b ? RWC : RWC + REC));
            bf16_t* base = (bf16_t*)(ws + boff);
            if (c0 < MIXC) {
#pragma unroll
                for (int ai = 0; ai < 2; ++ai)
#pragma unroll
                    for (int m = 0; m < 4; ++m) { const int row = row0 + ai * 128 + m * 16; const f32x4 v0 = acc[ai][bj][m][0], v1 = acc[ai][bj][m][1];
                        u32x4 w; w.x = pk2(v0[0], v0[1]); w.y = pk2(v0[2], v0[3]); w.z = pk2(v1[0], v1[1]); w.w = pk2(v1[2], v1[3]);
                        *(u32x4*)(base + (size_t)row * pitch + col) = w; }
            }
        }
    }
};
struct EpiQup {
    bf16_t* Q; const float* rstd; const float* cosm; const float* sinm; int compact;
    __device__ __forceinline__ void operator()(const Acc& acc, const Seg& u, int wr, int wc, int fr, int fq) const {
        const int row0 = u.pm * 256 + wr * 64 + fr; const bool lat = u.pm * 256 < RL;
        const int cbA = u.pn * 256 + wc * 32; const bool ropeA = lat && ((cbA % 96) == 64), ropeB = lat && (((cbA + 128) % 96) == 64);
        float rsv[8]; f32x4 cs[8], sn[8];
#pragma unroll
        for (int r = 0; r < 8; ++r) rsv[r] = rstd[row0 + (r >> 2) * 128 + (r & 3) * 16];
        if (ropeA || ropeB) {
#pragma unroll
            for (int r = 0; r < 8; ++r) { const int t = (row0 + (r >> 2) * 128 + (r & 3) * 16) & 4095; cs[r] = *(const f32x4*)(cosm + t * 16 + 4 * fq); sn[r] = *(const f32x4*)(sinm + t * 16 + 4 * fq); }
        } else {
#pragma unroll
            for (int r = 0; r < 8; ++r) { cs[r] = (f32x4){1.f, 1.f, 1.f, 1.f}; sn[r] = (f32x4){0.f, 0.f, 0.f, 0.f}; }
        }
        __builtin_amdgcn_sched_barrier(0);
#pragma unroll
        for (int ai = 0; ai < 2; ++ai)
#pragma unroll
            for (int m = 0; m < 4; ++m) { const int row = row0 + ai * 128 + m * 16; const float rs = rsv[ai * 4 + m];
#pragma unroll
                for (int bj = 0; bj < 2; ++bj) { const int cb = cbA + bj * 128; const bool rope = bj ? ropeB : ropeA;
                    f32x4 x1 = acc[ai][bj][m][0] * rs, x2 = acc[ai][bj][m][1] * rs;
                    if (rope) { const f32x4 o1 = x1 * cs[ai * 4 + m] - x2 * sn[ai * 4 + m], o2 = x1 * sn[ai * 4 + m] + x2 * cs[ai * 4 + m]; x1 = o1; x2 = o2; }
                    u32x2 a, b; a.x = pk2(x1[0], x1[1]); a.y = pk2(x1[2], x1[3]); b.x = pk2(x2[0], x2[1]); b.y = pk2(x2[2], x2[3]);
                    const int orow = compact ? (lat ? row : row - RL + 4 * SEQ) : row;
                    bf16_t* d = Q + (size_t)orow * 768 + cb + 4 * fq; *(u32x2*)d = a; *(u32x2*)(d + 16) = b; } }
    }
};
struct EpiKVup {
    bf16_t *Kb, *Vb; const float* rstd; int compact;
    __device__ __forceinline__ void operator()(const Acc& acc, const Seg& u, int wr, int wc, int fr, int fq) const {
        const int row0 = u.pm * 256 + wr * 64 + fr;
        float rsv[8];
#pragma unroll
        for (int r = 0; r < 8; ++r) rsv[r] = rstd[row0 + (r >> 2) * 128 + (r & 3) * 16];
        __builtin_amdgcn_sched_barrier(0);
#pragma unroll
        for (int ai = 0; ai < 2; ++ai)
#pragma unroll
            for (int m = 0; m < 4; ++m) { const int row = row0 + ai * 128 + m * 16; const float rs = rsv[ai * 4 + m];
#pragma unroll
                for (int bj = 0; bj < 2; ++bj) { const int c0 = u.pn * 256 + bj * 128 + wc * 32 + 8 * fq; const f32x4 v0 = acc[ai][bj][m][0] * rs, v1 = acc[ai][bj][m][1] * rs;
                    u32x4 w; w.x = pk2(v0[0], v0[1]); w.y = pk2(v0[2], v0[3]); w.z = pk2(v1[0], v1[1]); w.w = pk2(v1[2], v1[3]);
                    const int orow = compact ? (row < RL ? row : row - RL + 4 * SEQ) : row;
                    bf16_t* d = (u.pn < 2) ? Kb + (size_t)orow * 544 + c0 : Vb + (size_t)orow * 512 + (c0 - 512);
                    *(u32x4*)d = w; } }
    }
};
struct EpiMerge {
    u32x4* scr; bf16_t* M; bf16_t* P12;
    __device__ __forceinline__ void operator()(const Acc& acc, const Seg& u, int wr, int wc, int fr, int fq) const {
        int tid = threadIdx.x; asm volatile("" : "+v"(tid));
        if ((u.aux & 1) == 0) {
#pragma unroll
            for (int ai = 0; ai < 2; ++ai)
#pragma unroll
                for (int bj = 0; bj < 2; ++bj)
#pragma unroll
                    for (int m = 0; m < 4; ++m) { const f32x4 v0 = acc[ai][bj][m][0], v1 = acc[ai][bj][m][1];
                        u32x4 w; w.x = pk2(sigmoidf_(v0[0]), sigmoidf_(v0[1])); w.y = pk2(sigmoidf_(v0[2]), sigmoidf_(v0[3])); w.z = pk2(sigmoidf_(v1[0]), sigmoidf_(v1[1])); w.w = pk2(sigmoidf_(v1[2]), sigmoidf_(v1[3]));
                        scr[((ai * 2 + bj) * 4 + m) * 512 + tid] = w; }
        } else {
            const int n = (u.aux & 7) >> 1; const bool part = (u.aux & 8) != 0; const int row0 = u.pm * 256 + wr * 64 + fr; const bool accum = n > 0 && !part;
            u32x4 gq[2][4], pq[2][4];
#pragma unroll
            for (int k = 0; k < 5; ++k) {
                if (k < 4) { const int ai = k >> 1, bj = k & 1;
#pragma unroll
                    for (int m = 0; m < 4; ++m) { const int row = row0 + ai * 128 + m * 16; const int c0 = u.pn * 256 + bj * 128 + wc * 32 + 8 * fq;
                        gq[k & 1][m] = scr[((ai * 2 + bj) * 4 + m) * 512 + tid];
                        if (accum) pq[k & 1][m] = *(const u32x4*)(M + (size_t)row * 1024 + c0); else pq[k & 1][m] = (u32x4){0u, 0u, 0u, 0u}; } }
                if (k > 0) { const int kk = k - 1, ai = kk >> 1, bj = kk & 1;
#pragma unroll
                    for (int m = 0; m < 4; ++m) { const int row = row0 + ai * 128 + m * 16; const int c0 = u.pn * 256 + bj * 128 + wc * 32 + 8 * fq;
                        float gf[8], pf[8]; unpack8(gq[kk & 1][m], gf); unpack8(pq[kk & 1][m], pf);
                        const f32x4 v0 = acc[ai][bj][m][0], v1 = acc[ai][bj][m][1];
                        bf16_t* d = (part && n > 0) ? P12 + (size_t)(n - 1) * RC * 1024 + (size_t)(row - RL) * 1024 + c0 : M + (size_t)row * 1024 + c0;
#pragma unroll
                        for (int j = 0; j < 4; ++j) { pf[j] += gf[j] * v0[j]; pf[4 + j] += gf[4 + j] * v1[j]; }
                        *(u32x4*)d = pack8(pf); } }
            }
        }
    }
};
struct EpiResid {
    const void* srcl; bool srcbf; const float* srcc; bf16_t* dstl; float* dstc; const float* mod; int goff; float* part;
    __device__ __forceinline__ void operator()(const Acc& acc, const Seg& u, int wr, int wc, int fr, int fq) const {
        const int row0 = u.pm * 256 + wr * 64 + fr; const bool lat = u.pm * 256 < RL;
        const int cb0 = u.pn * 256 + wc * 32 + 8 * fq;
        if (u.aux != 0) {
            float* pb = part + (size_t)(u.aux - 1) * RC * 1024;
#pragma unroll
            for (int ai = 0; ai < 2; ++ai)
#pragma unroll
                for (int m = 0; m < 4; ++m) { float* d = pb + (size_t)(row0 + ai * 128 + m * 16 - RL) * 1024;
#pragma unroll
                    for (int bj = 0; bj < 2; ++bj)
#pragma unroll
                        for (int n = 0; n < 2; ++n) *(f32x4*)(d + cb0 + 128 * bj + 4 * n) = acc[ai][bj][m][n]; }
            return; }
        const float* g = mod + (lat ? ((u.pm * 256) >> 12) : 8) * 6144 + goff;
        f32x4 gv[2][2];
#pragma unroll
        for (int bj = 0; bj < 2; ++bj)
#pragma unroll
            for (int n = 0; n < 2; ++n) gv[bj][n] = *(const f32x4*)(g + cb0 + 128 * bj + 4 * n);
        if (lat && srcbf) {
            const bf16_t* sb = (const bf16_t*)srcl; u32x4 sv[2][2][2];
#pragma unroll
            for (int k = 0; k < 5; ++k) {
                if (k < 4) {
#pragma unroll
                    for (int mm = 0; mm < 2; ++mm) { const int row = row0 + (k >> 1) * 128 + ((k & 1) * 2 + mm) * 16;
#pragma unroll
                        for (int bj = 0; bj < 2; ++bj) sv[k & 1][mm][bj] = *(const u32x4*)(sb + (size_t)row * 1024 + cb0 + 128 * bj); } }
                if (k > 0) { const int kk = k - 1, ai = kk >> 1;
#pragma unroll
                    for (int mm = 0; mm < 2; ++mm) { const int m = (kk & 1) * 2 + mm; const int row = row0 + ai * 128 + m * 16;
#pragma unroll
                        for (int bj = 0; bj < 2; ++bj) { float s8[8]; unpack8(sv[kk & 1][mm][bj], s8);
#pragma unroll
                            for (int j = 0; j < 8; ++j) s8[j] += gv[bj][j >> 2][j & 3] * acc[ai][bj][m][j >> 2][j & 3];
                            *(u32x4*)(dstl + (size_t)row * 1024 + cb0 + 128 * bj) = pack8(s8); } } }
            }
        } else {
            const float* sb = lat ? (const float*)srcl : srcc; const size_t rsub = lat ? 0 : (size_t)RL; f32x4 sv[2][2][2];
#pragma unroll
            for (int k = 0; k < 9; ++k) {
                if (k < 8) { const int row = row0 + (k >> 2) * 128 + (k & 3) * 16; const float* s = sb + ((size_t)row - rsub) * 1024;
#pragma unroll
                    for (int bj = 0; bj < 2; ++bj)
#pragma unroll
                        for (int n = 0; n < 2; ++n) sv[k & 1][bj][n] = *(const f32x4*)(s + cb0 + 128 * bj + 4 * n); }
                if (k > 0) { const int kk = k - 1, ai = kk >> 2, m = kk & 3; const int row = row0 + ai * 128 + m * 16;
#pragma unroll
                    for (int bj = 0; bj < 2; ++bj) { const f32x4 o0 = sv[kk & 1][bj][0] + gv[bj][0] * acc[ai][bj][m][0], o1 = sv[kk & 1][bj][1] + gv[bj][1] * acc[ai][bj][m][1];
                        if (lat) { u32x4 w; w.x = pk2(o0[0], o0[1]); w.y = pk2(o0[2], o0[3]); w.z = pk2(o1[0], o1[1]); w.w = pk2(o1[2], o1[3]); *(u32x4*)(dstl + (size_t)row * 1024 + cb0 + 128 * bj) = w; }
                        else { float* d = dstc + ((size_t)row - RL) * 1024 + cb0 + 128 * bj; *(f32x4*)d = o0; *(f32x4*)(d + 4) = o1; } } }
            }
        }
    }
};
struct EpiSwiglu {
    bf16_t* H; int pitch;
    __device__ __forceinline__ void operator()(const Acc& acc, const Seg& u, int wr, int wc, int fr, int fq) const {
        const int row0 = u.pm * 256 + wr * 64 + fr; const int c0 = u.pn * 128 + wc * 32 + 8 * fq;
#pragma unroll
        for (int ai = 0; ai < 2; ++ai)
#pragma unroll
            for (int m = 0; m < 4; ++m) { const int row = row0 + ai * 128 + m * 16; float o[8];
#pragma unroll
                for (int n = 0; n < 2; ++n)
#pragma unroll
                    for (int j = 0; j < 4; ++j) o[4 * n + j] = siluf_(acc[ai][0][m][n][j]) * acc[ai][1][m][n][j];
                *(u32x4*)(H + (size_t)row * pitch + c0) = pack8(o); }
    }
};
struct EpiBf16 {
    bf16_t* O; int pitch;
    __device__ __forceinline__ void operator()(const Acc& acc, const Seg& u, int wr, int wc, int fr, int fq) const {
        const int row0 = u.pm * 256 + wr * 64 + fr;
#pragma unroll
        for (int ai = 0; ai < 2; ++ai)
#pragma unroll
            for (int m = 0; m < 4; ++m) { const int row = row0 + ai * 128 + m * 16;
#pragma unroll
                for (int bj = 0; bj < 2; ++bj) { const int c0 = u.pn * 256 + bj * 128 + wc * 32 + 8 * fq; const f32x4 v0 = acc[ai][bj][m][0], v1 = acc[ai][bj][m][1];
                    u32x4 w; w.x = pk2(v0[0], v0[1]); w.y = pk2(v0[2], v0[3]); w.z = pk2(v1[0], v1[1]); w.w = pk2(v1[2], v1[3]);
                    *(u32x4*)(O + (size_t)row * pitch + c0) = w; } }
    }
};

namespace attn {
constexpr float SCALE = 0.10206207261596577f;
constexpr float THR = 8.f;
constexpr int KP = 208;
constexpr int SHM_V = 8192, SHM_K = 64 * KP;
constexpr int OFF_V = 0, OFF_K = 2 * SHM_V, OFF_WS = OFF_K + 2 * SHM_K, SHM_TOTAL = OFF_WS + 8 * 64 * 4;
#define SBAR() __builtin_amdgcn_sched_barrier(0)
__device__ __forceinline__ int crow(int r, int hi) { return (r & 3) + 8 * (r >> 2) + 4 * hi; }
__device__ __forceinline__ unsigned cvtpk(float lo, float hi) { unsigned r; asm volatile("v_cvt_pk_bf16_f32 %0, %1, %2" : "=v"(r) : "v"(lo), "v"(hi)); return r; }
__device__ __forceinline__ void partialSM(f32x16& p0, f32x16& p1, float& m_reg, float& mn, float& alpha) {
    constexpr float C = SCALE * 1.4426950408889634f;
    float pmax = p0[0];
#pragma unroll
    for (int r = 1; r < 16; ++r) pmax = fmaxf(pmax, p0[r]);
#pragma unroll
    for (int r = 0; r < 16; ++r) pmax = fmaxf(pmax, p1[r]);
    { auto rr = __builtin_amdgcn_permlane32_swap(__float_as_uint(pmax), __float_as_uint(pmax), false, false); pmax = fmaxf(__uint_as_float(rr[0]), __uint_as_float(rr[1])); }
    if (__builtin_expect(__all(pmax - m_reg <= THR / SCALE), 1)) { mn = m_reg; alpha = 1.f; }
    else { mn = fmaxf(m_reg, pmax); alpha = __builtin_amdgcn_exp2f((m_reg - mn) * C); m_reg = mn; }
    const float mnC = -mn * C;
#pragma unroll
    for (int r = 0; r < 16; ++r) p0[r] = fmaf(p0[r], C, mnC);
#pragma unroll
    for (int r = 0; r < 16; ++r) p1[r] = fmaf(p1[r], C, mnC);
#pragma unroll
    for (int r = 0; r < 16; ++r) p0[r] = __builtin_amdgcn_exp2f(p0[r]);
}
__device__ __forceinline__ void finishSM(f32x16& p0, f32x16& p1, float alpha, float& l_reg, bf16x8& pa0, bf16x8& pa1, bf16x8& pa2, bf16x8& pa3) {
#pragma unroll
    for (int r = 0; r < 16; ++r) p1[r] = __builtin_amdgcn_exp2f(p1[r]);
    float ps = 0;
#pragma unroll
    for (int r = 0; r < 16; ++r) ps += p0[r];
#pragma unroll
    for (int r = 0; r < 16; ++r) ps += p1[r];
    { auto rr = __builtin_amdgcn_permlane32_swap(__float_as_uint(ps), __float_as_uint(ps), false, false); ps = __uint_as_float(rr[0]) + __uint_as_float(rr[1]); }
    l_reg = l_reg * alpha + ps;
#define PK4(P, BASE, OUT) do { unsigned a0 = cvtpk(P[BASE + 0], P[BASE + 1]), a1 = cvtpk(P[BASE + 2], P[BASE + 3]);   \
    unsigned b0 = cvtpk(P[BASE + 4], P[BASE + 5]), b1 = cvtpk(P[BASE + 6], P[BASE + 7]);                              \
    auto r0 = __builtin_amdgcn_permlane32_swap(a0, b0, false, false); auto r1 = __builtin_amdgcn_permlane32_swap(a1, b1, false, false); \
    u32x4 w = {r0[0], r1[0], r0[1], r1[1]}; OUT = __builtin_bit_cast(bf16x8, w); } while (0)
    PK4(p0, 0, pa0); PK4(p0, 8, pa1); PK4(p1, 0, pa2); PK4(p1, 8, pa3);
#undef PK4
}
__device__ __forceinline__ void qkt(f32x16& p0, f32x16& p1, const LAS unsigned char* Ks, const bf16x8* qr, int r32, int hi) {
    p0 = f32x16{}; p1 = f32x16{};
#pragma unroll
    for (int d0 = 0; d0 < 6; ++d0) { const int cb = (d0 * 16 + hi * 8) * 2;
        const bf16x8 b0 = *(const LAS bf16x8*)(Ks + r32 * KP + cb);
        const bf16x8 b1 = *(const LAS bf16x8*)(Ks + (32 + r32) * KP + cb);
        p0 = __builtin_amdgcn_mfma_f32_32x32x16_bf16(b0, qr[d0], p0, 0, 0, 0);
        p1 = __builtin_amdgcn_mfma_f32_32x32x16_bf16(b1, qr[d0], p1, 0, 0, 0); }
}
__device__ __forceinline__ int v_st(int k, int c) { const int kk = (k & ~0xC) | ((k & 4) << 1) | ((k & 8) >> 1); return ((kk >> 3) * 2 + (c >> 5)) * 512 + ((kk & 7) * 32 + (c & 31)) * 2; }
__device__ __forceinline__ int v_rd_base(int lane) { return ((lane & 3) << 3) | (((lane >> 2) & 3) << 6) | (((lane >> 4) & 1) << 5) | (((lane >> 5) & 1) << 8); }
constexpr int v_rd_off(int d0, int ks, int half) { return d0 * 512 + ks * 2048 + half * 1024; }
template <int OFF> __device__ __forceinline__ s16x4 tr_read(int vb) { s16x4 r; asm volatile("ds_read_b64_tr_b16 %0, %1 offset:%2" : "=&v"(r) : "v"(vb), "i"(OFF) : "memory"); return r; }
template <int D0> __device__ __forceinline__ void pv_one(f32x16& od, int vb, bf16x8 pa0, bf16x8 pa1, bf16x8 pa2, bf16x8 pa3) {
    const s16x4 l0 = tr_read<v_rd_off(D0, 0, 0)>(vb), h0 = tr_read<v_rd_off(D0, 0, 1)>(vb), l1 = tr_read<v_rd_off(D0, 1, 0)>(vb), h1 = tr_read<v_rd_off(D0, 1, 1)>(vb);
    const s16x4 l2 = tr_read<v_rd_off(D0, 2, 0)>(vb), h2 = tr_read<v_rd_off(D0, 2, 1)>(vb), l3 = tr_read<v_rd_off(D0, 3, 0)>(vb), h3 = tr_read<v_rd_off(D0, 3, 1)>(vb);
    asm volatile("s_waitcnt lgkmcnt(0)" ::: "memory"); SBAR();
#define PK(L, H) (bf16x8){L[0], L[1], L[2], L[3], H[0], H[1], H[2], H[3]}
    od = __builtin_amdgcn_mfma_f32_32x32x16_bf16(pa0, PK(l0, h0), od, 0, 0, 0);
    od = __builtin_amdgcn_mfma_f32_32x32x16_bf16(pa1, PK(l1, h1), od, 0, 0, 0);
    od = __builtin_amdgcn_mfma_f32_32x32x16_bf16(pa2, PK(l2, h2), od, 0, 0, 0);
    od = __builtin_amdgcn_mfma_f32_32x32x16_bf16(pa3, PK(l3, h3), od, 0, 0, 0);
#undef PK
}
__device__ __forceinline__ void pv_d0(f32x16* o, int vb, bf16x8 pa0, bf16x8 pa1, bf16x8 pa2, bf16x8 pa3) { pv_one<0>(o[0], vb, pa0, pa1, pa2, pa3); pv_one<1>(o[1], vb, pa0, pa1, pa2, pa3); }

__device__ __forceinline__ void attn_unit(const bf16_t* __restrict__ Qb, const bf16_t* __restrict__ Kn, const bf16_t* __restrict__ Kr, const bf16_t* __restrict__ Vh,
                                          bf16_t* __restrict__ Ob, long lat0, long ctx0, int nlat, int NT, LAS unsigned char* lds) {
    int tid_ = threadIdx.x; asm volatile("" : "+v"(tid_));
    const int tid = tid_, wid = tid >> 6, lane = tid & 63, r32 = lane & 31, hi = lane >> 5;
    LAS unsigned char* V_lds = lds + OFF_V; LAS unsigned char* K_lds = lds + OFF_K;
    LAS float* ws = (LAS float*)(lds + OFF_WS) + wid * 64; LAS float* li_l = ws; LAS float* al_l = ws + 32;
    float m_reg = -1e30f, l_reg = 0; f32x16 o[2] = {}; bf16x8 qr[6];
    const bf16_t* Qw = Qb + (long)(wid * 32 + r32) * 768 + hi * 8;
#pragma unroll
    for (int d0 = 0; d0 < 6; ++d0) qr[d0] = *(const bf16x8*)(Qw + d0 * 16);
    const int sr = tid >> 3, sc = (tid & 7) * 8, vst = v_st(sr, sc);
    const int kr_ = (tid & 255) >> 2, kc_ = (tid & 3) * 8;
    const int vb0 = (int)(uintptr_t)V_lds + v_rd_base(lane);
    struct { bf16x8 vs, kn, kp; } sr_[2];
#define KROW(j, kk) (((j) < nlat) ? (lat0 + (long)(j) * 64 + (kk)) : (ctx0 + (long)((j) - nlat) * 64 + (kk)))
#define SLOAD(i, j) do { const long r0_ = KROW(j, sr), r1_ = KROW(j, kr_); sr_[i].vs = *(const bf16x8*)(Vh + r0_ * 512 + sc); sr_[i].kn = *(const bf16x8*)(Kn + r0_ * 544 + sc); sr_[i].kp = *(const bf16x8*)(Kr + r1_ * 544 + kc_); } while (0)
#define SWRITE(b, i) do { *(LAS bf16x8*)(V_lds + (b) * SHM_V + vst) = sr_[i].vs; *(LAS bf16x8*)(K_lds + (b) * SHM_K + sr * KP + sc * 2) = sr_[i].kn; \
    *(LAS bf16x8*)(K_lds + (b) * SHM_K + kr_ * KP + 128 + kc_ * 2) = sr_[i].kp; } while (0)
#define SWAIT() asm volatile("s_waitcnt vmcnt(3)" ::: "memory")
#define RESC(a) do { if (__any((a) < 1.f)) { if (hi == 0) al_l[r32] = (a); asm volatile("s_waitcnt lgkmcnt(0)" ::: "memory"); \
    _Pragma("unroll") for (int d = 0; d < 2; ++d) _Pragma("unroll") for (int r = 0; r < 16; ++r) o[d][r] *= al_l[crow(r, hi)]; } } while (0)
    f32x16 pA0, pA1, pB0, pB1; float mnA, mnB, alA, alB; bf16x8 pa0, pa1, pa2, pa3;
    constexpr int SE = 0, SO = 1;
    SLOAD(SE, 0); asm volatile("s_waitcnt vmcnt(0)" ::: "memory"); SWRITE(0, SE); __syncthreads();
    qkt(pA0, pA1, K_lds, qr, r32, hi); partialSM(pA0, pA1, m_reg, mnA, alA);
    SLOAD(SO, 1); if (2 < NT) SLOAD(SE, 2);
    SWAIT(); SWRITE(1, SO); __syncthreads();
    for (int j = 1; j + 1 < NT; j += 2) {
        SBAR(); qkt(pB0, pB1, K_lds + SHM_K, qr, r32, hi);
        finishSM(pA0, pA1, alA, l_reg, pa0, pa1, pa2, pa3); SBAR();
        SLOAD(SO, j + 2); SBAR();
        pv_d0(o, vb0, pa0, pa1, pa2, pa3); partialSM(pB0, pB1, m_reg, mnB, alB);
        __syncthreads(); SWAIT(); SWRITE(0, SE);
        RESC(alB); __syncthreads();
        SBAR(); qkt(pA0, pA1, K_lds, qr, r32, hi);
        finishSM(pB0, pB1, alB, l_reg, pa0, pa1, pa2, pa3); SBAR();
        if (j + 3 < NT) SLOAD(SE, j + 3); SBAR();
        pv_d0(o, vb0 + SHM_V, pa0, pa1, pa2, pa3); partialSM(pA0, pA1, m_reg, mnA, alA);
        __syncthreads(); SWAIT(); SWRITE(1, SO);
        RESC(alA); __syncthreads();
    }
    SBAR(); qkt(pB0, pB1, K_lds + SHM_K, qr, r32, hi);
    finishSM(pA0, pA1, alA, l_reg, pa0, pa1, pa2, pa3); SBAR();
    pv_d0(o, vb0, pa0, pa1, pa2, pa3); partialSM(pB0, pB1, m_reg, mnB, alB);
    __syncthreads(); RESC(alB);
    finishSM(pB0, pB1, alB, l_reg, pa0, pa1, pa2, pa3); SBAR();
    pv_d0(o, vb0 + SHM_V, pa0, pa1, pa2, pa3);
    if (hi == 0) li_l[r32] = l_reg; asm volatile("s_waitcnt lgkmcnt(0)" ::: "memory");
    float rli[16];
#pragma unroll
    for (int r = 0; r < 16; ++r) rli[r] = __builtin_amdgcn_rcpf(li_l[crow(r, hi)]);
    bf16_t* Ow = Ob + (long)(wid * 32) * 512;
#pragma unroll
    for (int r = 0; r < 16; ++r) { const int orow = crow(r, hi);
#pragma unroll
        for (int d0 = 0; d0 < 2; ++d0) Ow[(long)orow * 512 + d0 * 32 + r32] = (bf16_t)f2bf(o[d0][r] * rli[r]); }
    __syncthreads();
#undef KROW
#undef SLOAD
#undef SWRITE
#undef SWAIT
#undef RESC
}
#undef SBAR
}

__device__ __forceinline__ void attn_latent_unit(const Ctx& F, unsigned char* ws, unsigned char* ha, int b, int h, int qb) {
    bf16_t* Y = (bf16_t*)(ws + D_YMLA); const long q0 = (long)b * SEQ + qb * 256;
    if (b < 4) { const bf16_t* Q = (const bf16_t*)(ha + HA_Q); const bf16_t* K = (const bf16_t*)(ha + HA_K); const bf16_t* V = (const bf16_t*)(ha + HA_V);
        attn::attn_unit(Q + q0 * 768 + h * 96, K + h * 64, K + 512, V + h * 64, Y + q0 * 512 + h * 64, (long)b * SEQ, (long)4 * SEQ + b * CTXL, 64, 68, F.lds); }
    else { const bf16_t* Q = (const bf16_t*)(ws + D_Q); const bf16_t* K = (const bf16_t*)(ws + D_K); const bf16_t* V = (const bf16_t*)(ws + D_V);
        attn::attn_unit(Q + q0 * 768 + h * 96, K + h * 64, K + 512, V + h * 64, Y + q0 * 512 + h * 64, (long)b * SEQ, (long)RL + b * CTXL, 64, 68, F.lds); }
}
__device__ __forceinline__ void attn_phase(const Ctx& F, int layer) {
    unsigned char* ws = getpp()->ws; unsigned char* ha = half_a_base(layer); const bool with_ctx_q = (layer == 0);
    const int vcu = (F.G % 8 == 0) ? (F.bid % 8) * (F.G / 8) + F.bid / 8 : F.bid;
    const int nlat_units = 4 * 8 * 16, nunits = nlat_units + (with_ctx_q ? NBATCH * 8 : 0);
    for (int u = vcu; u < nunits; u += F.G) {
        if (u < nlat_units) { const int bh = u >> 4, qb = u & 15; attn_latent_unit(F, ws, ha, 4 + (bh >> 3), bh & 7, qb); }
        else { const int bh = u - nlat_units, b = bh >> 3, h = bh & 7; bf16_t* Y = (bf16_t*)(ws + D_YMLA); const long yrow = (long)RL + b * CTXL;
            if (b < 4) { const bf16_t* Q = (const bf16_t*)(ha + HA_Q); const bf16_t* K = (const bf16_t*)(ha + HA_K); const bf16_t* V = (const bf16_t*)(ha + HA_V); const long q0 = (long)4 * SEQ + b * CTXL;
                attn::attn_unit(Q + q0 * 768 + h * 96, K + h * 64, K + 512, V + h * 64, Y + yrow * 512 + h * 64, 0, q0, 0, 4, F.lds); }
            else { const bf16_t* Q = (const bf16_t*)(ws + D_Q); const bf16_t* K = (const bf16_t*)(ws + D_K); const bf16_t* V = (const bf16_t*)(ws + D_V);
                attn::attn_unit(Q + yrow * 768 + h * 96, K + h * 64, K + 512, V + h * 64, Y + yrow * 512 + h * 64, 0, yrow, 0, 4, F.lds); } }
    }
}

__device__ __forceinline__ void load8_shift(const bf16_t* u, long row, int t, int T, int col, const float* mu, float* out) {
    float x[8], p[8], n[8];
    const bool hp = t > 0, hn = t < T - 1;
    const u32x4 wx = *(const u32x4*)(u + row * RWC + col), wp = *(const u32x4*)(u + (row - (hp ? 1 : 0)) * RWC + col), wn = *(const u32x4*)(u + (row + (hn ? 1 : 0)) * RWC + col);
    unpack8(wx, x); unpack8(wp, p); unpack8(wn, n);
    const float mp = hp ? 0.5f : 0.f, mn = hn ? 0.5f : 0.f;
    const f32x4 m0 = *(const f32x4*)(mu + col), m1 = *(const f32x4*)(mu + col + 4);
#pragma unroll
    for (int j = 0; j < 8; ++j) out[j] = x[j] + (j < 4 ? m0[j & 3] : m1[j & 3]) * (mp * p[j] + mn * n[j] - x[j]);
}
__device__ __forceinline__ void load8_shift_l(const bf16_t* u, long row, int t, int T, int col, const LAS float* mu8, float* out) {
    float x[8], p[8], n[8];
    const bool hp = t > 0, hn = t < T - 1;
    const u32x4 wx = *(const u32x4*)(u + row * RWC + col), wp = *(const u32x4*)(u + (row - (hp ? 1 : 0)) * RWC + col), wn = *(const u32x4*)(u + (row + (hn ? 1 : 0)) * RWC + col);
    unpack8(wx, x); unpack8(wp, p); unpack8(wn, n);
    const float mp = hp ? 0.5f : 0.f, mn = hn ? 0.5f : 0.f;
    const f32x4 m0 = *(const LAS f32x4*)(mu8), m1 = *(const LAS f32x4*)(mu8 + 4);
#pragma unroll
    for (int j = 0; j < 8; ++j) out[j] = x[j] + (j < 4 ? m0[j & 3] : m1[j & 3]) * (mp * p[j] + mn * n[j] - x[j]);
}
namespace rw2 {
constexpr int PT = 72;
constexpr int O_W2T = 0, O_A2T = 9216, O_ZL = 18432, O_AL = 34816, O_XWD = 51200, O_XAD = 60416, O_RING = 18432;
constexpr int O_TA = 69632, O_TB = O_TA + 9216, O_TK = O_TB + 9216, O_TR = O_TK + 9216, O_OUT = 69632;
constexpr int O_BH = 106496, O_KH = O_BH + 9216, O_V = O_KH + 9216, O_TOT = 134144, O_PL = 136192, O_PRM = 137216;
__device__ __forceinline__ s16x4 cv4(f32x4 v) { u32x2 w; w.x = pk2(v[0], v[1]); w.y = pk2(v[2], v[3]); return __builtin_bit_cast(s16x4, w); }
__device__ __forceinline__ f32x4 mm16(s16x4 a, s16x4 b, f32x4 c) { return __builtin_amdgcn_mfma_f32_16x16x16bf16_1k(a, b, c, 0, 0, 0); }
__device__ __forceinline__ f32x4 mm32(bf16x8 a, bf16x8 b, f32x4 c) { return __builtin_amdgcn_mfma_f32_16x16x32_bf16(a, b, c, 0, 0, 0); }
__device__ __forceinline__ f32x4 bf4_to_f(s16x4 s) { const u32x2 w = __builtin_bit_cast(u32x2, s); return (f32x4){bflo(w.x), bfhi(w.x), bflo(w.y), bfhi(w.y)}; }
typedef short v4i16_t __attribute__((ext_vector_type(4)));
__device__ __forceinline__ s16x4 trd(const LAS bf16_t* base, int row0, int col0, int lane) {
    const int g = lane >> 4, i = lane & 15, q = i >> 2, p = i & 3;
    return __builtin_bit_cast(s16x4, __builtin_amdgcn_ds_read_tr16_b64_v4i16((LAS v4i16_t*)(base + (row0 + 4 * g + q) * PT + col0 + 4 * p)));
}
__device__ __forceinline__ float fast_tanh(float x) { return 1.0f - 2.0f * __builtin_amdgcn_rcpf(__builtin_amdgcn_exp2f(2.8853900817779268f * x) + 1.0f); }
}
__device__ __forceinline__ void rwkv_chain2(const Ctx& F, int layer, int b, int h, int d) {
    using namespace rw2;
    PP P = getpp(); unsigned char* ws = P->ws;
    const bf16_t* u = (const bf16_t*)(ws + D_URWKV);
    bf16_t* od = (bf16_t*)(ws + (d ? D_OB : D_OF));
    float* bsc = (float*)(ws + WS_BSC) + (size_t)d * RT * 8;
    LAS unsigned char* L = F.lds;
    LAS bf16_t* w2t = (LAS bf16_t*)(L + O_W2T); LAS bf16_t* a2t = (LAS bf16_t*)(L + O_A2T);
    LAS float* Zl = (LAS float*)(L + O_ZL); LAS float* Al = (LAS float*)(L + O_AL);
    LAS bf16_t* Xwd = (LAS bf16_t*)(L + O_XWD); LAS bf16_t* Xad = (LAS bf16_t*)(L + O_XAD);
    LAS bf16_t* TA = (LAS bf16_t*)(L + O_TA); LAS bf16_t* TB = (LAS bf16_t*)(L + O_TB); LAS bf16_t* TK = (LAS bf16_t*)(L + O_TK); LAS bf16_t* TR = (LAS bf16_t*)(L + O_TR);
    LAS bf16_t* BH = (LAS bf16_t*)(L + O_BH); LAS bf16_t* KH = (LAS bf16_t*)(L + O_KH); LAS bf16_t* Vm = (LAS bf16_t*)(L + O_V);
    LAS float* tot = (LAS float*)(L + O_TOT); LAS float* pLs = (LAS float*)(L + O_PL); LAS float* Out = (LAS float*)(L + O_OUT);
    LAS float* prm = (LAS float*)(L + O_PRM);
    const int tid0 = F.tid, w = F.wave;
    {
        const int tid = tid0;
        const float* mu = P->in[I_MU] + layer * RWC;
        const float* w0 = P->in[I_W0] + (layer * 2 + d) * 512 + h * 64;
        const float* w2 = P->in[I_W2] + (size_t)(layer * 2 + d) * 64 * 512 + h * 64;
        const float* a0 = P->in[I_A0] + (layer * 2 + d) * 512 + h * 64;
        const float* a2 = P->in[I_A2] + (size_t)(layer * 2 + d) * 64 * 512 + h * 64;
        const float* k_k = P->in[I_KK] + layer * 512 + h * 64; const float* k_a = P->in[I_KA] + layer * 512 + h * 64; const float* r_k = P->in[I_RK] + layer * 512 + h * 64;
        for (int i = tid; i < 640; i += NTHREADS) { const int rr = i >> 6, cc = i & 63; float v;
            if (rr == 0) v = mu[h * 64 + cc]; else if (rr == 1) v = mu[512 + h * 64 + cc]; else if (rr == 2) v = mu[1024 + h * 64 + cc]; else if (rr == 3) v = mu[1536 + d * 64 + cc]; else if (rr == 4) v = mu[1664 + d * 64 + cc];
            else if (rr == 5) v = w0[cc]; else if (rr == 6) v = a0[cc]; else if (rr == 7) v = k_k[cc]; else if (rr == 8) v = k_a[cc]; else v = r_k[cc];
            prm[i] = v; }
        for (int i = tid; i < 4096; i += NTHREADS) { const int k = i >> 6, cc = i & 63; w2t[cc * PT + k] = (bf16_t)f2bf(w2[(size_t)k * 512 + cc]); a2t[cc * PT + k] = (bf16_t)f2bf(a2[(size_t)k * 512 + cc]); }
    }
    f32x4 Z[4];
#pragma unroll
    for (int j = 0; j < 4; ++j) Z[j] = (f32x4){0.f, 0.f, 0.f, 0.f};
    __syncthreads();
    for (int seq = 0; seq < 2; ++seq) {
        const int T = seq ? SEQ : CTXL; const long rbase = seq ? (long)b * SEQ : (long)RL + b * CTXL; const int nch = T / 64;
        for (int ci = 0; ci < nch; ++ci) {
            int tid = tid0; asm volatile("" : "+v"(tid));
            const int lane = tid & 63, fr = lane & 15, fq = lane >> 4, tt = tid >> 3, c8 = (tid & 7) * 8;
            const int tpos = d ? (T - 1 - (ci * 64 + tt)) : (ci * 64 + tt); const long row = rbase + tpos;
            float r[8], k[8], kk[8], av[8], kd[8], lw[8];
            {
                float v[8], x[8];
                load8_shift_l(u, row, tpos, T, h * 64 + c8, prm + c8, r);
                load8_shift_l(u, row, tpos, T, 512 + h * 64 + c8, prm + 64 + c8, k);
                load8_shift_l(u, row, tpos, T, 1024 + h * 64 + c8, prm + 128 + c8, v);
                *(LAS u32x4*)(Vm + tt * PT + c8) = pack8(v);
                load8_shift_l(u, row, tpos, T, 1536 + d * 64 + c8, prm + 192 + c8, x);
#pragma unroll
                for (int e = 0; e < 8; ++e) x[e] = fast_tanh(x[e]);
                *(LAS u32x4*)(Xwd + tt * PT + c8) = pack8(x);
                load8_shift_l(u, row, tpos, T, 1664 + d * 64 + c8, prm + 256 + c8, x);
                *(LAS u32x4*)(Xad + tt * PT + c8) = pack8(x);
            }
            __syncthreads();
            {
#pragma unroll
                for (int q = 0; q < 2; ++q) { const int id = 2 * w + q, tm = id >> 2, tn = id & 3;
                    f32x4 az = {0.f, 0.f, 0.f, 0.f}, aa = {0.f, 0.f, 0.f, 0.f};
#pragma unroll
                    for (int ks = 0; ks < 2; ++ks) {
                        az = mm32(*(const LAS bf16x8*)(Xwd + (16 * tm + fr) * PT + ks * 32 + fq * 8), *(const LAS bf16x8*)(w2t + (16 * tn + fr) * PT + ks * 32 + fq * 8), az);
                        aa = mm32(*(const LAS bf16x8*)(Xad + (16 * tm + fr) * PT + ks * 32 + fq * 8), *(const LAS bf16x8*)(a2t + (16 * tn + fr) * PT + ks * 32 + fq * 8), aa); }
#pragma unroll
                    for (int e = 0; e < 4; ++e) { Zl[(16 * tm + 4 * fq + e) * 64 + 16 * tn + fr] = az[e]; Al[(16 * tm + 4 * fq + e) * 64 + 16 * tn + fr] = aa[e]; } }
            }
            __syncthreads();
            {
                float ss = 0.f, bs = 0.f;
#pragma unroll
                for (int e = 0; e < 8; ++e) { kk[e] = k[e] * prm[448 + c8 + e]; ss += kk[e] * kk[e]; }
                ss += shx(ss, 1, lane); ss += shx(ss, 2, lane); ss += shx(ss, 4, lane);
                const float inv = __builtin_amdgcn_rsqf(fmaxf(ss, 1e-24f));
#pragma unroll
                for (int e = 0; e < 8; ++e) {
                    kk[e] *= inv;
                    const float z = Zl[tt * 64 + c8 + e] + prm[320 + c8 + e];
                    lw[e] = -sigmoidf_(z) * 0.8750612633917001f;
                    av[e] = sigmoidf_(Al[tt * 64 + c8 + e] + prm[384 + c8 + e]);
                    kd[e] = k[e] * (1.0f + (av[e] - 1.0f) * prm[512 + c8 + e]);
                    bs += r[e] * kd[e] * prm[576 + c8 + e];
                }
                bs += shx(bs, 1, lane); bs += shx(bs, 2, lane); bs += shx(bs, 4, lane);
                if ((tid & 7) == 0) bsc[(size_t)row * 8 + h] = bs;
            }
            float cum[8];
            {
#pragma unroll
                for (int e = 0; e < 8; ++e) cum[e] = lw[e];
#pragma unroll
                for (int off = 8; off < 64; off <<= 1) {
#pragma unroll
                    for (int e = 0; e < 8; ++e) { const float t = __int_as_float(__builtin_amdgcn_ds_bpermute(((lane - off) & 63) << 2, __float_as_int(cum[e]))); cum[e] += (lane >= off) ? t : 0.f; } }
                if (lane >= 56) {
#pragma unroll
                    for (int e = 0; e < 8; ++e) tot[w * 64 + c8 + e] = cum[e]; }
            }
            __syncthreads();
            {
                float ta[8], tb[8], tk[8], tr[8], bh[8], kh[8];
                const int w0i = (w & ~1) * 64 + c8;
#pragma unroll
                for (int e = 0; e < 8; ++e) {
                    const float t0 = tot[w0i + e], t1 = tot[w0i + 64 + e];
                    const float cm = cum[e] + ((w & 1) ? t0 : 0.f), cumL = t0 + t1;
                    const float e1 = __builtin_amdgcn_exp2f(cm - lw[e]), e2 = __builtin_amdgcn_exp2f(-cm), e3 = __builtin_amdgcn_exp2f(cm), e4 = __builtin_amdgcn_exp2f(cumL - cm);
                    const float ka = kk[e] * av[e];
                    ta[e] = -kk[e] * e1; tb[e] = ka * e2; tk[e] = kd[e] * e2; tr[e] = r[e] * e3; bh[e] = ka * e4; kh[e] = kd[e] * e4;
                    if ((tt & 15) == 15) pLs[(tt >> 4) * 64 + c8 + e] = e3;
                }
                *(LAS u32x4*)(TA + tt * PT + c8) = pack8(ta); *(LAS u32x4*)(TB + tt * PT + c8) = pack8(tb); *(LAS u32x4*)(TK + tt * PT + c8) = pack8(tk); *(LAS u32x4*)(TR + tt * PT + c8) = pack8(tr);
                *(LAS u32x4*)(BH + tt * PT + c8) = pack8(bh); *(LAS u32x4*)(KH + tt * PT + c8) = pack8(kh);
            }
            __syncthreads();
            if (w < 4) {
                const int s = w; const int rowf = (16 * s + fr) * PT;
                f32x4 Mab = {0.f, 0.f, 0.f, 0.f}, MabT = Mab, MakT = Mab, Mbr = Mab, Mkr = Mab;
#pragma unroll
                for (int ks = 0; ks < 2; ++ks) { const int o = rowf + ks * 32 + fq * 8;
                    const bf16x8 fa = *(const LAS bf16x8*)(TA + o), fb = *(const LAS bf16x8*)(TB + o), fk = *(const LAS bf16x8*)(TK + o), frr = *(const LAS bf16x8*)(TR + o);
                    Mab = mm32(fb, fa, Mab); MabT = mm32(fa, fb, MabT); MakT = mm32(fa, fk, MakT); Mbr = mm32(fb, frr, Mbr); Mkr = mm32(fk, frr, Mkr); }
                f32x4 Pm, Pt;
#pragma unroll
                for (int e = 0; e < 4; ++e) { const int m = 4 * fq + e, n = fr;
                    Mab[e] = (m < n) ? Mab[e] : 0.f; MabT[e] = (n < m) ? MabT[e] : 0.f; MakT[e] = (n < m) ? MakT[e] : 0.f; Mbr[e] = (m <= n) ? Mbr[e] : 0.f; Mkr[e] = (m <= n) ? Mkr[e] : 0.f;
                    const float id = (m == n) ? 1.f : 0.f; Pm[e] = Mab[e] + id; Pt[e] = MabT[e] + id; }
                f32x4 Nn = Mab, Nt = MabT; const f32x4 zero = {0.f, 0.f, 0.f, 0.f};
#pragma unroll
                for (int it = 0; it < 3; ++it) {
                    const s16x4 cn = cv4(Nn), cnt = cv4(Nt);
                    const f32x4 N2 = mm16(cnt, cn, zero), Nt2 = mm16(cn, cnt, zero);
                    const s16x4 cp = cv4(Pm), cpt = cv4(Pt), cn2 = cv4(N2);
                    const f32x4 Pn = mm16(cpt, cn2, Pm), Ptn = mm16(cn2, cpt, Pt);
                    Nn = N2; Nt = Nt2; Pm = Pn; Pt = Ptn; (void)cp;
                }
                const s16x4 cT = cv4(Pm), cMakT = cv4(MakT), cMbr = cv4(Mbr);
                const f32x4 Q1T = mm16(cT, cMakT, zero);
                const s16x4 cQ1T = cv4(Q1T);
                const f32x4 Hy = mm16(cQ1T, cMbr, Mkr);
                LAS unsigned char* ring = L + O_RING + s * 12800 + lane * 8;
                *(LAS s16x4*)(ring + 20 * 512) = cv4(Hy);
                s16x4 bhf[4];
#pragma unroll
                for (int jt = 0; jt < 4; ++jt) bhf[jt] = trd(BH, 16 * s, 16 * jt, lane);
#pragma unroll
                for (int jt = 0; jt < 4; ++jt) {
                    const s16x4 atf = trd(TA, 16 * s, 16 * jt, lane);
                    const f32x4 P1T = mm16(cT, atf, zero); const s16x4 cP1T = cv4(P1T);
                    const f32x4 rinit = bf4_to_f(*(const LAS s16x4*)(TR + (16 * s + fr) * PT + 16 * jt + 4 * fq));
                    const f32x4 Gy = mm16(cP1T, cMbr, rinit);
                    *(LAS s16x4*)(ring + jt * 512) = cv4(Gy);
#pragma unroll
                    for (int j2 = 0; j2 < 4; ++j2) { const f32x4 Gs = mm16(cP1T, bhf[j2], zero); *(LAS s16x4*)(ring + (4 + jt * 4 + j2) * 512) = cv4(Gs); }
                    const f32x4 kinit = bf4_to_f(trd(KH, 16 * s, 16 * jt, lane));
                    const f32x4 Hs = mm16(cQ1T, bhf[jt], kinit);
                    *(LAS s16x4*)(ring + (21 + jt) * 512) = cv4(Hs);
                }
            }
            __syncthreads();
            if (w < 4) {
                const int it = w;
#pragma unroll 1
                for (int s = 0; s < 4; ++s) {
                    const LAS unsigned char* ring = L + O_RING + s * 12800 + lane * 8;
                    const s16x4 vb = trd(Vm, 16 * s, 16 * it, lane);
                    s16x4 zb[4];
#pragma unroll
                    for (int jt = 0; jt < 4; ++jt) zb[jt] = cv4(Z[jt]);
                    f32x4 Yt = mm16(*(const LAS s16x4*)(ring + 20 * 512), vb, (f32x4){0.f, 0.f, 0.f, 0.f});
#pragma unroll
                    for (int jt = 0; jt < 4; ++jt) Yt = mm16(*(const LAS s16x4*)(ring + jt * 512), zb[jt], Yt);
#pragma unroll
                    for (int e = 0; e < 4; ++e) Out[(16 * s + 4 * fq + e) * 64 + 16 * it + fr] = Yt[e];
                    f32x4 Zn[4];
#pragma unroll
                    for (int j2 = 0; j2 < 4; ++j2) {
                        const f32x4 pv = *(const LAS f32x4*)(pLs + s * 64 + 16 * j2 + 4 * fq);
                        f32x4 zn = Z[j2] * pv;
                        zn = mm16(*(const LAS s16x4*)(ring + (21 + j2) * 512), vb, zn);
#pragma unroll
                        for (int jt = 0; jt < 4; ++jt) zn = mm16(*(const LAS s16x4*)(ring + (4 + jt * 4 + j2) * 512), zb[jt], zn);
                        Zn[j2] = zn;
                    }
#pragma unroll
                    for (int j2 = 0; j2 < 4; ++j2) Z[j2] = Zn[j2];
                }
            }
            __syncthreads();
            {
                float v[8];
#pragma unroll
                for (int e = 0; e < 8; ++e) v[e] = Out[tt * 64 + c8 + e];
                *(u32x4*)(od + (size_t)row * 512 + h * 64 + c8) = pack8(v);
            }
            __syncthreads();
        }
    }
}

namespace rw4 {
using namespace rw2;
constexpr int RGN = 16384, R_TA = 0, R_TB = 2304, R_TK = 4608, R_TR = 6912, R_BH = 9216, R_KH = 11520, R_V = 13824, R_PL = 16128;
constexpr int R_XWD = 0, R_XAD = 2304, R_ZL = 4608, R_AL = 8704;
constexpr int O_PRM4 = 8 * RGN;
}
__device__ __forceinline__ void rwkv_chain4(const Ctx& F, int layer, int b, int h, int d) {
    using namespace rw4;
    PP P = getpp(); unsigned char* ws = P->ws;
    const bf16_t* u = (const bf16_t*)(ws + D_URWKV);
    bf16_t* od = (bf16_t*)(ws + (d ? D_OB : D_OF));
    float* bsc = (float*)(ws + WS_BSC) + (size_t)d * RT * 8;
    const bf16_t* w2g = (const bf16_t*)(ws + WS_W2T) + (size_t)((layer * 2 + d) * 2 + 0) * 512 * 64 + (size_t)h * 64 * 64;
    const bf16_t* a2g = (const bf16_t*)(ws + WS_W2T) + (size_t)((layer * 2 + d) * 2 + 1) * 512 * 64 + (size_t)h * 64 * 64;
    LAS unsigned char* L = F.lds;
    LAS float* prm = (LAS float*)(L + O_PRM4);
    volatile LAS unsigned* rdy = (volatile LAS unsigned*)(L + O_PRM4 + 2560); LAS unsigned* dne = (LAS unsigned*)(L + O_PRM4 + 2560 + 64);
    unsigned gseq = 0;
    const int tid0 = F.tid, w = F.wave;
    {
        const float* mu = P->in[I_MU] + layer * RWC;
        const float* w0 = P->in[I_W0] + (layer * 2 + d) * 512 + h * 64; const float* a0 = P->in[I_A0] + (layer * 2 + d) * 512 + h * 64;
        const float* k_k = P->in[I_KK] + layer * 512 + h * 64; const float* k_a = P->in[I_KA] + layer * 512 + h * 64; const float* r_k = P->in[I_RK] + layer * 512 + h * 64;
        for (int i = tid0; i < 640; i += NTHREADS) { const int rr = i >> 6, cc = i & 63; float v;
            if (rr == 0) v = mu[h * 64 + cc]; else if (rr == 1) v = mu[512 + h * 64 + cc]; else if (rr == 2) v = mu[1024 + h * 64 + cc]; else if (rr == 3) v = mu[1536 + d * 64 + cc]; else if (rr == 4) v = mu[1664 + d * 64 + cc];
            else if (rr == 5) v = w0[cc]; else if (rr == 6) v = a0[cc]; else if (rr == 7) v = k_k[cc]; else if (rr == 8) v = k_a[cc]; else v = r_k[cc];
            prm[i] = v; }
        if (tid0 < 8) { rdy[tid0] = 0u; dne[tid0] = 0u; }
    }
    f32x4 Z[4];
#pragma unroll
    for (int j = 0; j < 4; ++j) Z[j] = (f32x4){0.f, 0.f, 0.f, 0.f};
    u32x4 raw[2][5][3];
#define RW4_PREFETCH(T_, rbase_, gi_) do { int t0_ = tid0; asm volatile("" : "+v"(t0_)); const int lane_ = t0_ & 63, tk_ = lane_ >> 2, cg_ = lane_ & 3; const int pi_ = (gi_) * 128 + 16 * w + tk_; const int tp_ = d ? ((T_) - 1 - pi_) : pi_; \
        const long row_ = (rbase_) + tp_; const long rp_ = row_ - (tp_ > 0 ? 1 : 0), rn_ = row_ + (tp_ < (T_) - 1 ? 1 : 0); \
        _Pragma("unroll") for (int q_ = 0; q_ < 2; ++q_) _Pragma("unroll") for (int g_ = 0; g_ < 5; ++g_) { \
            const int col_ = (g_ == 0 ? h * 64 : g_ == 1 ? 512 + h * 64 : g_ == 2 ? 1024 + h * 64 : g_ == 3 ? 1536 + d * 64 : 1664 + d * 64) + q_ * 32 + cg_ * 8; \
            raw[q_][g_][0] = *(const u32x4*)(u + row_ * RWC + col_); raw[q_][g_][1] = *(const u32x4*)(u + rp_ * RWC + col_); raw[q_][g_][2] = *(const u32x4*)(u + rn_ * RWC + col_); } } while (0)
    RW4_PREFETCH(CTXL, (long)RL + b * CTXL, 0);
    __syncthreads();
    for (int seq = 0; seq < 2; ++seq) {
        const int T = seq ? SEQ : CTXL; const long rbase = seq ? (long)b * SEQ : (long)RL + b * CTXL; const int ngr = T / 128;
        for (int gi = 0; gi < ngr; ++gi) {
            int tid = tid0; asm volatile("" : "+v"(tid));
            const int lane = tid & 63, fr = lane & 15, fq = lane >> 4, tk = lane >> 2, cg = lane & 3;
            LAS unsigned char* R = L + w * RGN;
            { unsigned sp = 0; while (*(volatile LAS unsigned*)(dne + w) != 4u * gseq) { __builtin_amdgcn_s_sleep(1); if (++sp > (1u << 24)) break; } }
            asm volatile("" ::: "memory");
            {
                const int pi = gi * 128 + 16 * w + tk; const int tpos = d ? (T - 1 - pi) : pi; const long row = rbase + tpos;
                float r[16], k[16], kk[16], av[16], kd[16], lw[16];
                {
                    const float mp = (tpos > 0) ? 0.5f : 0.f, mn = (tpos < T - 1) ? 0.5f : 0.f;
#pragma unroll
                    for (int q = 0; q < 2; ++q) { const int c8 = q * 32 + cg * 8;
#pragma unroll
                        for (int g5 = 0; g5 < 5; ++g5) {
                            float x[8], p[8], n[8], o[8];
                            unpack8(raw[q][g5][0], x); unpack8(raw[q][g5][1], p); unpack8(raw[q][g5][2], n);
                            const f32x4 m0 = *(const LAS f32x4*)(prm + g5 * 64 + c8), m1 = *(const LAS f32x4*)(prm + g5 * 64 + c8 + 4);
#pragma unroll
                            for (int j = 0; j < 8; ++j) o[j] = x[j] + (j < 4 ? m0[j & 3] : m1[j & 3]) * (mp * p[j] + mn * n[j] - x[j]);
                            if (g5 == 0) {
#pragma unroll
                                for (int j = 0; j < 8; ++j) r[8 * q + j] = o[j]; }
                            else if (g5 == 1) {
#pragma unroll
                                for (int j = 0; j < 8; ++j) k[8 * q + j] = o[j]; }
                            else if (g5 == 2) *(LAS u32x4*)(R + R_V + (tk * PT + c8) * 2) = pack8(o);
                            else if (g5 == 3) {
#pragma unroll
                                for (int j = 0; j < 8; ++j) o[j] = fast_tanh(o[j]);
                                *(LAS u32x4*)(R + R_XWD + (tk * PT + c8) * 2) = pack8(o); }
                            else *(LAS u32x4*)(R + R_XAD + (tk * PT + c8) * 2) = pack8(o);
                        } }
                }
                {
                    const LAS bf16_t* Xwd = (const LAS bf16_t*)(R + R_XWD); const LAS bf16_t* Xad = (const LAS bf16_t*)(R + R_XAD);
                    LAS float* Zl = (LAS float*)(R + R_ZL); LAS float* Al = (LAS float*)(R + R_AL);
                    bf16x8 fw[2], fa[2];
#pragma unroll
                    for (int ks = 0; ks < 2; ++ks) { fw[ks] = *(const LAS bf16x8*)(Xwd + fr * PT + ks * 32 + fq * 8); fa[ks] = *(const LAS bf16x8*)(Xad + fr * PT + ks * 32 + fq * 8); }
#pragma unroll
                    for (int tn = 0; tn < 4; ++tn) { f32x4 az = {0.f, 0.f, 0.f, 0.f}, aa = {0.f, 0.f, 0.f, 0.f};
#pragma unroll
                        for (int ks = 0; ks < 2; ++ks) { az = mm32(fw[ks], *(const bf16x8*)(w2g + (16 * tn + fr) * 64 + ks * 32 + fq * 8), az); aa = mm32(fa[ks], *(const bf16x8*)(a2g + (16 * tn + fr) * 64 + ks * 32 + fq * 8), aa); }
#pragma unroll
                        for (int e = 0; e < 4; ++e) { Zl[(4 * fq + e) * 64 + 16 * tn + fr] = az[e]; Al[(4 * fq + e) * 64 + 16 * tn + fr] = aa[e]; } }
                }
                {
                    const LAS float* Zl = (const LAS float*)(R + R_ZL); const LAS float* Al = (const LAS float*)(R + R_AL);
                    float ss = 0.f, bs = 0.f;
                    float pkk[16], pw0[16], pa0[16], pka[16], prk[16], zz[16], aa2[16];
#pragma unroll
                    for (int q = 0; q < 2; ++q) { const int c8 = q * 32 + cg * 8;
#pragma unroll
                        for (int hh = 0; hh < 2; ++hh) { const int o4 = c8 + 4 * hh, i4 = 8 * q + 4 * hh;
                            const f32x4 a = *(const LAS f32x4*)(prm + 448 + o4), b2 = *(const LAS f32x4*)(prm + 320 + o4), c = *(const LAS f32x4*)(prm + 384 + o4), d2 = *(const LAS f32x4*)(prm + 512 + o4), e2 = *(const LAS f32x4*)(prm + 576 + o4);
                            const f32x4 z4 = *(const LAS f32x4*)(Zl + tk * 64 + o4), a4 = *(const LAS f32x4*)(Al + tk * 64 + o4);
#pragma unroll
                            for (int j = 0; j < 4; ++j) { pkk[i4 + j] = a[j]; pw0[i4 + j] = b2[j]; pa0[i4 + j] = c[j]; pka[i4 + j] = d2[j]; prk[i4 + j] = e2[j]; zz[i4 + j] = z4[j]; aa2[i4 + j] = a4[j]; } } }
#pragma unroll
                    for (int i = 0; i < 16; ++i) { kk[i] = k[i] * pkk[i]; ss += kk[i] * kk[i]; }
                    ss += shx(ss, 1, lane); ss += shx(ss, 2, lane);
                    const float inv = __builtin_amdgcn_rsqf(fmaxf(ss, 1e-24f));
#pragma unroll
                    for (int i = 0; i < 16; ++i) {
                        kk[i] *= inv;
                        lw[i] = -sigmoidf_(zz[i] + pw0[i]) * 0.8750612633917001f;
                        av[i] = sigmoidf_(aa2[i] + pa0[i]);
                        kd[i] = k[i] * (1.0f + (av[i] - 1.0f) * pka[i]);
                        bs += r[i] * kd[i] * prk[i]; }
                    bs += shx(bs, 1, lane); bs += shx(bs, 2, lane);
                    if (cg == 0) bsc[(size_t)row * 8 + h] = bs;
                }
                float cum[16], cumL[16];
                {
                    LAS float* Sc = (LAS float*)(R + R_ZL);
#pragma unroll
                    for (int q = 0; q < 2; ++q) { *(LAS f32x4*)(Sc + tk * 64 + q * 32 + cg * 8) = (f32x4){lw[8 * q], lw[8 * q + 1], lw[8 * q + 2], lw[8 * q + 3]}; *(LAS f32x4*)(Sc + tk * 64 + q * 32 + cg * 8 + 4) = (f32x4){lw[8 * q + 4], lw[8 * q + 5], lw[8 * q + 6], lw[8 * q + 7]}; }
                    float a = 0.f;
#pragma unroll
                    for (int t = 0; t < 16; ++t) { a += Sc[t * 64 + lane]; Sc[t * 64 + lane] = a; }
#pragma unroll
                    for (int q = 0; q < 2; ++q) { const f32x4 c0 = *(const LAS f32x4*)(Sc + tk * 64 + q * 32 + cg * 8), c1 = *(const LAS f32x4*)(Sc + tk * 64 + q * 32 + cg * 8 + 4);
                        const f32x4 l0 = *(const LAS f32x4*)(Sc + 15 * 64 + q * 32 + cg * 8), l1 = *(const LAS f32x4*)(Sc + 15 * 64 + q * 32 + cg * 8 + 4);
#pragma unroll
                        for (int e = 0; e < 4; ++e) { cum[8 * q + e] = c0[e]; cum[8 * q + 4 + e] = c1[e]; cumL[8 * q + e] = l0[e]; cumL[8 * q + 4 + e] = l1[e]; } }
                }
                {
#pragma unroll
                    for (int q = 0; q < 2; ++q) { float ta[8], tb[8], tkk[8], tr[8], bh[8], kh[8], plv[8]; const int c8 = q * 32 + cg * 8;
#pragma unroll
                        for (int e = 0; e < 8; ++e) { const int i = 8 * q + e;
                            const float e3 = __builtin_amdgcn_exp2f(cum[i]), e2 = __builtin_amdgcn_rcpf(e3), e1 = __builtin_amdgcn_exp2f(cum[i] - lw[i]), e4 = __builtin_amdgcn_exp2f(cumL[i] - cum[i]);
                            const float ka = kk[i] * av[i];
                            ta[e] = -kk[i] * e1; tb[e] = ka * e2; tkk[e] = kd[i] * e2; tr[e] = r[i] * e3; bh[e] = ka * e4; kh[e] = kd[i] * e4;
                            plv[e] = e3; }
                        *(LAS u32x4*)(R + R_TA + (tk * PT + c8) * 2) = pack8(ta); *(LAS u32x4*)(R + R_TB + (tk * PT + c8) * 2) = pack8(tb); *(LAS u32x4*)(R + R_TK + (tk * PT + c8) * 2) = pack8(tkk);
                        *(LAS u32x4*)(R + R_TR + (tk * PT + c8) * 2) = pack8(tr); *(LAS u32x4*)(R + R_BH + (tk * PT + c8) * 2) = pack8(bh); *(LAS u32x4*)(R + R_KH + (tk * PT + c8) * 2) = pack8(kh);
                        if (tk == 15) { LAS float* pp = (LAS float*)(R + R_PL) + c8; *(LAS f32x4*)pp = (f32x4){plv[0], plv[1], plv[2], plv[3]}; *(LAS f32x4*)(pp + 4) = (f32x4){plv[4], plv[5], plv[6], plv[7]}; } }
                }
                {
                    const LAS bf16_t* TA = (const LAS bf16_t*)(R + R_TA); const LAS bf16_t* TB = (const LAS bf16_t*)(R + R_TB); const LAS bf16_t* TK = (const LAS bf16_t*)(R + R_TK);
                    const LAS bf16_t* TR = (const LAS bf16_t*)(R + R_TR); const LAS bf16_t* BH = (const LAS bf16_t*)(R + R_BH); const LAS bf16_t* KH = (const LAS bf16_t*)(R + R_KH);
                    f32x4 Mab = {0.f, 0.f, 0.f, 0.f}, MabT = Mab, MakT = Mab, Mbr = Mab, Mkr = Mab;
#pragma unroll
                    for (int ks = 0; ks < 2; ++ks) { const int o = fr * PT + ks * 32 + fq * 8;
                        const bf16x8 fa = *(const LAS bf16x8*)(TA + o), fb = *(const LAS bf16x8*)(TB + o), fk = *(const LAS bf16x8*)(TK + o), frr = *(const LAS bf16x8*)(TR + o);
                        Mab = mm32(fb, fa, Mab); MabT = mm32(fa, fb, MabT); MakT = mm32(fa, fk, MakT); Mbr = mm32(fb, frr, Mbr); Mkr = mm32(fk, frr, Mkr); }
                    s16x4 bhf[4], atf[4], rin[4], kin[4];
#pragma unroll
                    for (int jt = 0; jt < 4; ++jt) { bhf[jt] = trd(BH, 0, 16 * jt, lane); atf[jt] = trd(TA, 0, 16 * jt, lane); kin[jt] = trd(KH, 0, 16 * jt, lane); rin[jt] = *(const LAS s16x4*)(TR + fr * PT + 16 * jt + 4 * fq); }
                    f32x4 Pm, Pt;
#pragma unroll
                    for (int e = 0; e < 4; ++e) { const int m = 4 * fq + e, n = fr;
                        Mab[e] = (m < n) ? Mab[e] : 0.f; MabT[e] = (n < m) ? MabT[e] : 0.f; MakT[e] = (n < m) ? MakT[e] : 0.f; Mbr[e] = (m <= n) ? Mbr[e] : 0.f; Mkr[e] = (m <= n) ? Mkr[e] : 0.f;
                        const float id = (m == n) ? 1.f : 0.f; Pm[e] = Mab[e] + id; Pt[e] = MabT[e] + id; }
                    f32x4 Nn = Mab, Nt = MabT; const f32x4 zero = {0.f, 0.f, 0.f, 0.f};
#pragma unroll
                    for (int it = 0; it < 3; ++it) {
                        const s16x4 cn = cv4(Nn), cnt = cv4(Nt);
                        const f32x4 N2 = mm16(cnt, cn, zero), Nt2 = mm16(cn, cnt, zero);
                        const s16x4 cpt = cv4(Pt), cn2 = cv4(N2);
                        const f32x4 Pn = mm16(cpt, cn2, Pm), Ptn = mm16(cn2, cpt, Pt);
                        Nn = N2; Nt = Nt2; Pm = Pn; Pt = Ptn;
                    }
                    const s16x4 cT = cv4(Pm), cMakT = cv4(MakT), cMbr = cv4(Mbr);
                    const f32x4 Q1T = mm16(cT, cMakT, zero);
                    const s16x4 cQ1T = cv4(Q1T);
                    const f32x4 Hy = mm16(cQ1T, cMbr, Mkr);
                    asm volatile("s_waitcnt lgkmcnt(0)" ::: "memory");
                    LAS unsigned char* ring = R + lane * 8;
                    *(LAS s16x4*)(ring + 20 * 512) = cv4(Hy);
#pragma unroll
                    for (int jt = 0; jt < 4; ++jt) {
                        const f32x4 P1T = mm16(cT, atf[jt], zero); const s16x4 cP1T = cv4(P1T);
                        const f32x4 Gy = mm16(cP1T, cMbr, bf4_to_f(rin[jt]));
                        *(LAS s16x4*)(ring + jt * 512) = cv4(Gy);
#pragma unroll
                        for (int j2 = 0; j2 < 4; ++j2) { const f32x4 Gs = mm16(cP1T, bhf[j2], zero); *(LAS s16x4*)(ring + (4 + jt * 4 + j2) * 512) = cv4(Gs); }
                        const f32x4 Hs = mm16(cQ1T, bhf[jt], bf4_to_f(kin[jt]));
                        *(LAS s16x4*)(ring + (21 + jt) * 512) = cv4(Hs);
                    }
                }
            }
            {
                const bool more = gi + 1 < ngr; const bool nseq = !more && seq == 0;
                const int nT = nseq ? SEQ : T; const long nrb = nseq ? (long)b * SEQ : rbase; const int ngi = more ? gi + 1 : (nseq ? 0 : gi);
                RW4_PREFETCH(nT, nrb, ngi);
            }
            ++gseq;
            asm volatile("s_waitcnt lgkmcnt(0)" ::: "memory");
            if (lane == 0) rdy[w] = gseq;
            asm volatile("" ::: "memory");
            if (w < 4) {
                const int it = w;
#pragma unroll 1
                for (int s = 0; s < 8; ++s) {
                    { unsigned sp = 0; while (rdy[s] != gseq) { __builtin_amdgcn_s_sleep(1); if (++sp > (1u << 24)) break; } }
                    asm volatile("" ::: "memory");
                    const LAS unsigned char* Rs = L + s * RGN; const LAS unsigned char* ring = Rs + lane * 8;
                    const s16x4 vb = trd((const LAS bf16_t*)(Rs + R_V), 0, 16 * it, lane);
                    s16x4 zb[4];
#pragma unroll
                    for (int jt = 0; jt < 4; ++jt) zb[jt] = cv4(Z[jt]);
                    f32x4 Yt = mm16(*(const LAS s16x4*)(ring + 20 * 512), vb, (f32x4){0.f, 0.f, 0.f, 0.f});
#pragma unroll
                    for (int jt = 0; jt < 4; ++jt) Yt = mm16(*(const LAS s16x4*)(ring + jt * 512), zb[jt], Yt);
#pragma unroll
                    for (int e = 0; e < 4; ++e) { const int pi = gi * 128 + 16 * s + 4 * fq + e; const int tp = d ? (T - 1 - pi) : pi;
                        od[(size_t)(rbase + tp) * 512 + h * 64 + 16 * it + fr] = (bf16_t)f2bf(Yt[e]); }
                    f32x4 Zn[4];
#pragma unroll
                    for (int j2 = 0; j2 < 4; ++j2) {
                        const f32x4 pv = *(const LAS f32x4*)((const LAS float*)(Rs + R_PL) + 16 * j2 + 4 * fq);
                        f32x4 zn = Z[j2] * pv;
                        zn = mm16(*(const LAS s16x4*)(ring + (21 + j2) * 512), vb, zn);
#pragma unroll
                        for (int jt = 0; jt < 4; ++jt) zn = mm16(*(const LAS s16x4*)(ring + (4 + jt * 4 + j2) * 512), zb[jt], zn);
                        Zn[j2] = zn;
                    }
#pragma unroll
                    for (int j2 = 0; j2 < 4; ++j2) Z[j2] = Zn[j2];
                    asm volatile("s_waitcnt lgkmcnt(0)" ::: "memory");
                    if (lane == 0) (void)__hip_atomic_fetch_add(dne + s, 1u, __ATOMIC_RELAXED, __HIP_MEMORY_SCOPE_WORKGROUP);
                }
            }
        }
    }
#undef RW4_PREFETCH
}

__device__ __forceinline__ void rwkv_post_phase(const Ctx& F, int layer, int nrows_y) {
    PP P = getpp(); unsigned char* ws = P->ws;
    const bf16_t* u = (const bf16_t*)(ws + D_URWKV); const bf16_t* of = (const bf16_t*)(ws + D_OF); const bf16_t* ob = (const bf16_t*)(ws + D_OB);
    bf16_t* y = (bf16_t*)(ws + D_YRWKV);
    const float* bf_ = (const float*)(ws + WS_BSC); const float* bb_ = bf_ + (size_t)RT * 8;
    const float* mu = P->in[I_MU] + layer * RWC; const float* lng = P->in[I_LNG] + layer * 512; const float* lnb = P->in[I_LNB] + layer * 512;
    const bf16_t* wg2 = (const bf16_t*)(ws + WS_WG2) + (size_t)layer * 512 * 128;
    LAS bf16_t* sg = (LAS bf16_t*)F.lds;
    LAS bf16_t* gt = (LAS bf16_t*)(F.lds + 64 * 136 * 2);
    const int tid0 = F.tid, wave = F.wave; const int lane = F.lane;
    const int nunits = nrows_y / 64;
    for (int un = F.bid; un < nunits; un += F.G) {
        int tid = tid0; asm volatile("" : "+v"(tid)); const int lane = tid & 63;
        const long r0 = (long)un * 64; const bool lat = r0 < RL; const int T = lat ? SEQ : CTXL; const int tbase = lat ? (int)(r0 & (SEQ - 1)) : (int)((r0 - RL) & (CTXL - 1));
        for (int it = tid; it < 1024; it += NTHREADS) { const int tk = it >> 4, q = it & 15; float v[8]; load8_shift(u, r0 + tk, tbase + tk, T, 1792 + q * 8, mu, v);
#pragma unroll
            for (int j = 0; j < 8; ++j) v[j] = sigmoidf_(v[j]);
            *(LAS u32x4*)(sg + tk * 136 + q * 8) = pack8(v); }
        __syncthreads();
        {
            const int fr = lane & 15, fq = lane >> 4;
#pragma unroll
            for (int tn = 0; tn < 4; ++tn) { const int cn = (wave * 4 + tn) * 16;
                bf16x8 bfrag[4];
#pragma unroll
                for (int k = 0; k < 4; ++k) bfrag[k] = *(const bf16x8*)(wg2 + (size_t)(cn + fr) * 128 + k * 32 + fq * 8);
#pragma unroll
                for (int tm = 0; tm < 4; ++tm) { f32x4 acc = {0.f, 0.f, 0.f, 0.f};
#pragma unroll
                    for (int k = 0; k < 4; ++k) { const bf16x8 afrag = *(const LAS bf16x8*)(sg + (tm * 16 + fr) * 136 + k * 32 + fq * 8); acc = __builtin_amdgcn_mfma_f32_16x16x32_bf16(afrag, bfrag[k], acc, 0, 0, 0); }
#pragma unroll
                    for (int j = 0; j < 4; ++j) gt[(tm * 16 + fq * 4 + j) * 520 + cn + fr] = (bf16_t)f2bf(acc[j]); } }
        }
        __syncthreads();
        {
            const int tk = tid >> 3, hh = tid & 7; const long row = r0 + tk; const int t = tbase + tk;
            const float bsum = bf_[row * 8 + hh] + bb_[row * 8 + hh];
            float o[64]; float s = 0.f;
#pragma unroll
            for (int q = 0; q < 8; ++q) { float a[8], c[8]; unpack8(*(const u32x4*)(of + row * 512 + hh * 64 + q * 8), a); unpack8(*(const u32x4*)(ob + row * 512 + hh * 64 + q * 8), c);
#pragma unroll
                for (int j = 0; j < 8; ++j) { o[q * 8 + j] = a[j] + c[j]; s += o[q * 8 + j]; } }
            const float mean = s * (1.0f / 64.0f); float vs = 0.f;
#pragma unroll
            for (int j = 0; j < 64; ++j) { const float dd = o[j] - mean; vs += dd * dd; }
            const float rstd = rsqrtf(vs * (1.0f / 64.0f) + 64e-5f);
            const bool hp = t > 0, hn = t < T - 1; const float mp = hp ? 0.5f : 0.f, mn = hn ? 0.5f : 0.f;
            const bf16_t* ux = u + row * RWC + 1024 + hh * 64; const bf16_t* up = u + (row - (hp ? 1 : 0)) * RWC + 1024 + hh * 64; const bf16_t* un = u + (row + (hn ? 1 : 0)) * RWC + 1024 + hh * 64;
            u32x4 rw[2][3]; f32x4 mq[2][2], lq[2][2], bq[2][2];
#define RP_LOAD(s_, q_) do { rw[s_][0] = *(const u32x4*)(ux + (q_) * 8); rw[s_][1] = *(const u32x4*)(up + (q_) * 8); rw[s_][2] = *(const u32x4*)(un + (q_) * 8); \
                const int c_ = hh * 64 + (q_) * 8; mq[s_][0] = *(const f32x4*)(mu + 1024 + c_); mq[s_][1] = *(const f32x4*)(mu + 1024 + c_ + 4); \
                lq[s_][0] = *(const f32x4*)(lng + c_); lq[s_][1] = *(const f32x4*)(lng + c_ + 4); bq[s_][0] = *(const f32x4*)(lnb + c_); bq[s_][1] = *(const f32x4*)(lnb + c_ + 4); } while (0)
            RP_LOAD(0, 0);
#pragma unroll
            for (int q = 0; q < 8; ++q) { const int s = q & 1;
                if (q < 7) RP_LOAD((q + 1) & 1, q + 1);
                float x[8], p[8], n[8], res[8], g8[8]; unpack8(rw[s][0], x); unpack8(rw[s][1], p); unpack8(rw[s][2], n);
                unpack8(*(const LAS u32x4*)(gt + tk * 520 + hh * 64 + q * 8), g8);
#pragma unroll
                for (int j = 0; j < 8; ++j) { const float vv = x[j] + mq[s][j >> 2][j & 3] * (mp * p[j] + mn * n[j] - x[j]);
                    res[j] = ((o[q * 8 + j] - mean) * rstd * lq[s][j >> 2][j & 3] + bq[s][j >> 2][j & 3] + bsum * vv) * g8[j]; }
                *(u32x4*)(y + row * 512 + hh * 64 + q * 8) = pack8(res); }
#undef RP_LOAD
        }
        __syncthreads();
    }
}
__device__ __forceinline__ void ctx_krope_proj(const Ctx& F, int layer) {
    unsigned char* ws = getpp()->ws;
    const bf16_t* xlo = (const bf16_t*)(ws + D_XN1); const bf16_t* xhi = (const bf16_t*)(ws + D_XN1 + Y34);
    const bf16_t* wlo = (const bf16_t*)(ws + WS_W + (size_t)layer * WL_STRIDE + WL_WINLO); const bf16_t* whi = (const bf16_t*)(ws + WS_W + (size_t)layer * WL_STRIDE + WL_WINHI);
    bf16_t* um = (bf16_t*)(ws + D_UMLA);
    LAS float* part = (LAS float*)F.lds;
    const int lane = F.lane, w = F.wave, fr = lane & 15, fq = lane >> 4;
    for (int task = (F.bid + F.G - 128 % F.G) % F.G; task < RC / 16; task += F.G) {
        const long r0 = (long)RL + task * 16;
        const bf16_t* xa = (w < 4 ? xlo : xhi) + (r0 + fr) * 512 + (w & 3) * 128 + fq * 8;
        const bf16_t* wb = (w < 4 ? wlo : whi) + (size_t)(4096 + fr) * 512 + (w & 3) * 128 + fq * 8;
        bf16x8 a[4], b0[4], b1[4];
#pragma unroll
        for (int ks = 0; ks < 4; ++ks) { a[ks] = *(const bf16x8*)(xa + ks * 32); b0[ks] = *(const bf16x8*)(wb + ks * 32); b1[ks] = *(const bf16x8*)(wb + 16 * 512 + ks * 32); }
        f32x4 c0 = {0.f, 0.f, 0.f, 0.f}, c1 = {0.f, 0.f, 0.f, 0.f};
#pragma unroll
        for (int ks = 0; ks < 4; ++ks) { c0 = __builtin_amdgcn_mfma_f32_16x16x32_bf16(a[ks], b0[ks], c0, 0, 0, 0); c1 = __builtin_amdgcn_mfma_f32_16x16x32_bf16(a[ks], b1[ks], c1, 0, 0, 0); }
#pragma unroll
        for (int j = 0; j < 4; ++j) { part[(w * 16 + 4 * fq + j) * 33 + fr] = c0[j]; part[(w * 16 + 4 * fq + j) * 33 + 16 + fr] = c1[j]; }
        __syncthreads();
        { const int row = F.tid >> 5, col = F.tid & 31; float s = 0.f;
#pragma unroll
          for (int ww = 0; ww < 8; ++ww) s += part[(ww * 16 + row) * 33 + col];
          um[(r0 + row) * MLC + 640 + col] = (bf16_t)f2bf(s); }
        __syncthreads();
    }
}
__device__ __forceinline__ void mla_stats_pass(const Ctx& F, int w0, int nw) {
    unsigned char* ws = getpp()->ws; const int lane = F.lane;
    const bf16_t* um = (const bf16_t*)(ws + D_UMLA); float* rq = (float*)(ws + WS_RSTD); float* rkv = rq + RT;
    constexpr int NBS = 4;
    for (int rb = GW(F) - w0; rb < RT; rb += nw * NBS) {
        u32x4 a[NBS], c[NBS];
#pragma unroll
        for (int b = 0; b < NBS; ++b) { const int row = (rb + b * nw < RT) ? rb + b * nw : rb; const bf16_t* ur = um + (size_t)row * MLC;
            a[b] = *(const u32x4*)(ur + lane * 8); c[b] = *(const u32x4*)(ur + 512 + (lane & 15) * 8); }
        __builtin_amdgcn_sched_barrier(0);
        float sq[NBS], skv[NBS];
#pragma unroll
        for (int b = 0; b < NBS; ++b) { float v[8], s = 0.f, s2 = 0.f; unpack8(a[b], v);
#pragma unroll
            for (int j = 0; j < 8; ++j) s += v[j] * v[j];
            unpack8(c[b], v);
#pragma unroll
            for (int j = 0; j < 8; ++j) s2 += v[j] * v[j];
            sq[b] = (lane < 48) ? s : 0.f; skv[b] = ((lane < 48) ? 0.f : s) + ((lane < 16) ? s2 : 0.f); }
#pragma unroll
        for (int b = 0; b < NBS; ++b) { sq[b] = wave_sum(sq[b], lane); skv[b] = wave_sum(skv[b], lane); }
#pragma unroll
        for (int b = 0; b < NBS; ++b) { const int row = rb + b * nw;
            if (lane == 0 && row < RT) { rq[row] = rsqrtf(sq[b] * (1.0f / 384.0f) + 1e-6f); rkv[row] = rsqrtf(skv[b] * (1.0f / 256.0f) + 1e-6f); } }
    }
}
__device__ __forceinline__ void krope_pass(const Ctx& F, int half, int layer) {
    unsigned char* ws = getpp()->ws; const int lane = F.lane;
    const bf16_t* um = (const bf16_t*)(ws + D_UMLA); bf16_t* Kb = half ? (bf16_t*)(ws + D_K) : (bf16_t*)(half_a_base(layer) + HA_K);
    const float* cm = (const float*)(ws + WS_ROPE_M); const float* sm = cm + 4096 * 16;
    for (int ci = GW(F) * 4 + (lane >> 4); ci < HROWS; ci += NGW(F) * 4) {
        const int row = ci < 4 * SEQ ? 4 * SEQ * half + ci : RL + 4 * CTXL * half + (ci - 4 * SEQ);
        const int orow = half ? row : ci;
        const bf16_t* ur = um + (size_t)row * MLC; const int l = lane & 15;
        float x1 = bf2f(ur[640 + l]), x2 = bf2f(ur[656 + l]);
        if (row < RL) { const int t = row & (SEQ - 1); const float cs = cm[t * 16 + l], sn = sm[t * 16 + l]; const float o1 = x1 * cs - x2 * sn, o2 = x1 * sn + x2 * cs; x1 = o1; x2 = o2; }
        Kb[(size_t)orow * 544 + 512 + l] = (bf16_t)f2bf(x1); Kb[(size_t)orow * 544 + 528 + l] = (bf16_t)f2bf(x2);
    }
}

constexpr size_t D_KV = D_END1;
static_assert(D_KV + 34 * MiB <= WS_NEED, "retention state buffer");
namespace ret2 {
constexpr int QP = 72, VP = 136, NUNITS = NBATCH * 4 * 34;
typedef short v4i16_t __attribute__((ext_vector_type(4)));
__device__ __forceinline__ bf16x8 tr8(const LAS bf16_t* base, int pitch, int row0, int col0, int lane) {
    const int g = lane >> 4, i = lane & 15, q = i >> 2, p = i & 3;
    const LAS bf16_t* a = base + (row0 + 8 * g + q) * pitch + col0 + 4 * p;
    const s16x4 lo = __builtin_bit_cast(s16x4, __builtin_amdgcn_ds_read_tr16_b64_v4i16((LAS v4i16_t*)a));
    const s16x4 hi = __builtin_bit_cast(s16x4, __builtin_amdgcn_ds_read_tr16_b64_v4i16((LAS v4i16_t*)(a + 4 * pitch)));
    return (bf16x8){lo[0], lo[1], lo[2], lo[3], hi[0], hi[1], hi[2], hi[3]};
}
__device__ __forceinline__ f32x4 mm32(bf16x8 a, bf16x8 b, f32x4 c) { return __builtin_amdgcn_mfma_f32_16x16x32_bf16(a, b, c, 0, 0, 0); }
struct UnitPos { int b, h, cs; long rbase; bool isctx; int t0; };
__device__ __forceinline__ UnitPos unit_pos(int un) { UnitPos U; const int bh = un / 34; U.cs = un % 34; U.b = bh >> 2; U.h = bh & 3; U.isctx = U.cs < 2;
    U.t0 = U.isctx ? 0 : (U.cs - 2) * 128; U.rbase = U.isctx ? (long)RL + U.b * CTXL + U.cs * 128 : (long)U.b * SEQ + U.t0; return U; }
}
__device__ __forceinline__ void ret_r1_unit(const Ctx& F, int layer, int un) {
    using namespace ret2;
    PP P = getpp(); unsigned char* ws = P->ws;
    const bf16_t* u = (const bf16_t*)(ws + D_URET); bf16_t* kv = (bf16_t*)(ws + D_KV);
    const float* cr = (const float*)(ws + WS_ROPE_R); const float* sr = cr + 4096 * 32;
    const UnitPos U = unit_pos(un);
    const float lgf = -__expf(P->in[I_RDEC][(layer * 2 + 0) * 4 + U.h]) * 1.4426950408889634f, lgb = -__expf(P->in[I_RDEC][(layer * 2 + 1) * 4 + U.h]) * 1.4426950408889634f;
    LAS bf16_t* Vt = (LAS bf16_t*)F.lds; LAS bf16_t* kzf = Vt + 128 * VP; LAS bf16_t* kzb = kzf + 128 * QP; LAS bf16_t* St = kzb + 128 * QP;
    const int tid = F.tid, lane = F.lane, w = F.wave;
    {
        const int tk = tid >> 2, pc = tid & 3; float k1[8], k2[8], a[8], c[8];
        u32x4 vv[4], kr[2]; f32x4 rc[2], rs[2];
#pragma unroll
        for (int k4 = 0; k4 < 4; ++k4) { const int it = tid + 512 * k4, tv = it >> 4, ch = it & 15; vv[k4] = *(const u32x4*)(u + (U.rbase + tv) * REC + 512 + U.h * 128 + ch * 8); }
        { const bf16_t* kp = u + (U.rbase + tk) * REC + 256 + U.h * 64 + pc * 8; kr[0] = *(const u32x4*)kp; kr[1] = *(const u32x4*)(kp + 32);
          const int ro = (U.t0 + tk) * 32 + pc * 8; rc[0] = *(const f32x4*)(cr + ro); rc[1] = *(const f32x4*)(cr + ro + 4); rs[0] = *(const f32x4*)(sr + ro); rs[1] = *(const f32x4*)(sr + ro + 4); }
        __builtin_amdgcn_sched_barrier(0);
        unpack8(kr[0], k1); unpack8(kr[1], k2);
#pragma unroll
        for (int j = 0; j < 8; ++j) { const float cs = U.isctx ? 1.0f : rc[j >> 2][j & 3], sn = U.isctx ? 0.0f : rs[j >> 2][j & 3];
            const float ka_ = k1[j] * cs - k2[j] * sn, kb_ = k1[j] * sn + k2[j] * cs; k1[j] = ka_; k2[j] = kb_; }
        const float zf = 0.125f * __builtin_amdgcn_exp2f((float)(127 - tk) * lgf), zb = 0.125f * __builtin_amdgcn_exp2f((float)tk * lgb);
#pragma unroll
        for (int j = 0; j < 8; ++j) { a[j] = k1[j] * zf; c[j] = k2[j] * zf; }
        *(LAS u32x4*)(kzf + tk * QP + pc * 8) = pack8(a); *(LAS u32x4*)(kzf + tk * QP + 32 + pc * 8) = pack8(c);
#pragma unroll
        for (int j = 0; j < 8; ++j) { a[j] = k1[j] * zb; c[j] = k2[j] * zb; }
        *(LAS u32x4*)(kzb + tk * QP + pc * 8) = pack8(a); *(LAS u32x4*)(kzb + tk * QP + 32 + pc * 8) = pack8(c);
#pragma unroll
        for (int k4 = 0; k4 < 4; ++k4) { const int it = tid + 512 * k4, tv = it >> 4, ch = it & 15; *(LAS u32x4*)(Vt + tv * VP + ch * 8) = vv[k4]; }
    }
    __syncthreads();
    {
        const int fr = lane & 15, fq = lane >> 4;
        f32x4 acc[2][4];
#pragma unroll
        for (int dd = 0; dd < 2; ++dd)
#pragma unroll
            for (int tj = 0; tj < 4; ++tj) acc[dd][tj] = (f32x4){0.f, 0.f, 0.f, 0.f};
#pragma unroll
        for (int ks = 0; ks < 4; ++ks) { const bf16x8 a = tr8(Vt, VP, 32 * ks, 16 * w, lane);
#pragma unroll
            for (int tj = 0; tj < 4; ++tj) { acc[0][tj] = mm32(a, tr8(kzf, QP, 32 * ks, 16 * tj, lane), acc[0][tj]); acc[1][tj] = mm32(a, tr8(kzb, QP, 32 * ks, 16 * tj, lane), acc[1][tj]); } }
#pragma unroll
        for (int dd = 0; dd < 2; ++dd)
#pragma unroll
            for (int tj = 0; tj < 4; ++tj)
#pragma unroll
                for (int j = 0; j < 4; ++j) St[dd * 128 * QP + (16 * w + 4 * fq + j) * QP + 16 * tj + fr] = (bf16_t)f2bf(acc[dd][tj][j]);
    }
    __syncthreads();
#pragma unroll
    for (int k4 = 0; k4 < 4; ++k4) { const int it = tid + 512 * k4, dd = it >> 10, e = (it >> 3) & 127, ch = it & 7;
        *(u32x4*)(kv + ((size_t)un * 2 + dd) * 8192 + e * 64 + ch * 8) = *(const LAS u32x4*)(St + dd * 128 * QP + e * QP + ch * 8); }
    __syncthreads();
}
__device__ __forceinline__ void ret_r2(const Ctx& F, int layer, int b0, int nb) {
    using namespace ret2;
    PP P = getpp(); bf16_t* kv = (bf16_t*)(P->ws + D_KV);
    for (int item = (F.bid - b0) * NTHREADS + F.tid; item < 65536; item += nb * NTHREADS) {
        const int bh = item >> 11, dd = (item >> 10) & 1, off = (item & 1023) * 8;
        const float g = __builtin_amdgcn_exp2f(-128.0f * __expf(P->in[I_RDEC][(layer * 2 + dd) * 4 + (bh & 3)]) * 1.4426950408889634f);
        float st[8];
#pragma unroll
        for (int j = 0; j < 8; ++j) st[j] = 0.f;
#pragma unroll
        for (int half = 0; half < 2; ++half) {
            asm volatile("" ::: "memory");
            u32x4 xv[17];
#pragma unroll
            for (int q = 0; q < 17; ++q) { const int i = half * 17 + q; const int cs = dd ? (i < 2 ? 1 - i : 35 - i) : i;
                xv[q] = *(const u32x4*)(kv + ((size_t)(bh * 34 + cs) * 2 + dd) * 8192 + off); }
#pragma unroll
            for (int q = 0; q < 17; ++q) { const int i = half * 17 + q; const int cs = dd ? (i < 2 ? 1 - i : 35 - i) : i;
                float x[8]; unpack8(xv[q], x);
                *(u32x4*)(kv + ((size_t)(bh * 34 + cs) * 2 + dd) * 8192 + off) = pack8(st);
#pragma unroll
                for (int j = 0; j < 8; ++j) st[j] = st[j] * g + x[j]; }
        }
    }
}
__device__ __forceinline__ void ret_r3_unit(const Ctx& F, int layer, int un) {
    using namespace ret2;
    PP P = getpp(); unsigned char* ws = P->ws;
    const bf16_t* u = (const bf16_t*)(ws + D_URET); const bf16_t* kv = (const bf16_t*)(ws + D_KV); bf16_t* y = (bf16_t*)(ws + D_YRET);
    const float* cr = (const float*)(ws + WS_ROPE_R); const float* sr = cr + 4096 * 32;
    const UnitPos U = unit_pos(un);
    const float* lng = P->in[I_RLNG] + layer * 512 + U.h * 128; const float* lnb = P->in[I_RLNB] + layer * 512 + U.h * 128;
    const float lgf = -__expf(P->in[I_RDEC][(layer * 2 + 0) * 4 + U.h]) * 1.4426950408889634f, lgb = -__expf(P->in[I_RDEC][(layer * 2 + 1) * 4 + U.h]) * 1.4426950408889634f;
    LAS bf16_t* qf = (LAS bf16_t*)F.lds; LAS bf16_t* qb = qf + 128 * QP; LAS bf16_t* qn = qb + 128 * QP; LAS bf16_t* ks = qn + 128 * QP; LAS bf16_t* Sm = qn;
    LAS bf16_t* Vt = (LAS bf16_t*)(F.lds + 73728); LAS bf16_t* Rf = (LAS bf16_t*)(F.lds + 108544); LAS bf16_t* Rb = Rf + 128 * QP; LAS bf16_t* Yst = qf;
    const int tid = F.tid, lane = F.lane, w = F.wave, fr = lane & 15, fq = lane >> 4;
    const int n0 = 16 * w;
    u32x4 vv[4], rr[4], gq[4]; float lgv[8], lbv[8];
#pragma unroll
    for (int k4 = 0; k4 < 4; ++k4) { const int it = tid + 512 * k4, tv = it >> 4, ch = it & 15; vv[k4] = *(const u32x4*)(u + (U.rbase + tv) * REC + 512 + U.h * 128 + ch * 8); }
#pragma unroll
    for (int k4 = 0; k4 < 4; ++k4) { const int it = tid + 512 * k4, dd = it >> 10, e = (it >> 3) & 127, ch = it & 7; rr[k4] = *(const u32x4*)(kv + ((size_t)un * 2 + dd) * 8192 + e * 64 + ch * 8); }
#pragma unroll
    for (int k4 = 0; k4 < 4; ++k4) { const int it = lane + 64 * k4, r = it >> 4, ch = it & 15; gq[k4] = *(const u32x4*)(u + (U.rbase + n0 + r) * REC + 1024 + U.h * 128 + ch * 8); }
#pragma unroll
    for (int te = 0; te < 8; ++te) { lgv[te] = lng[16 * te + fr]; lbv[te] = lnb[16 * te + fr]; }
    const int tk = tid >> 2, pc = tid & 3;
    u32x4 qr[2], kr[2]; f32x4 rc[2], rs[2];
    { const bf16_t* qp = u + (U.rbase + tk) * REC + U.h * 64 + pc * 8; qr[0] = *(const u32x4*)qp; qr[1] = *(const u32x4*)(qp + 32); kr[0] = *(const u32x4*)(qp + 256); kr[1] = *(const u32x4*)(qp + 288);
      const int ro = (U.t0 + tk) * 32 + pc * 8; rc[0] = *(const f32x4*)(cr + ro); rc[1] = *(const f32x4*)(cr + ro + 4); rs[0] = *(const f32x4*)(sr + ro); rs[1] = *(const f32x4*)(sr + ro + 4); }
    __builtin_amdgcn_sched_barrier(0);
    {
        float q1[8], q2[8], k1[8], k2[8], a[8], c[8];
        unpack8(qr[0], q1); unpack8(qr[1], q2); unpack8(kr[0], k1); unpack8(kr[1], k2);
#pragma unroll
        for (int j = 0; j < 8; ++j) { const float cs = U.isctx ? 1.0f : rc[j >> 2][j & 3], sn = U.isctx ? 0.0f : rs[j >> 2][j & 3];
            const float qa_ = q1[j] * cs - q2[j] * sn, qb_ = q1[j] * sn + q2[j] * cs, ka_ = k1[j] * cs - k2[j] * sn, kb_ = k1[j] * sn + k2[j] * cs;
            q1[j] = qa_; q2[j] = qb_; k1[j] = ka_; k2[j] = kb_; }
        *(LAS u32x4*)(qn + tk * QP + pc * 8) = pack8(q1); *(LAS u32x4*)(qn + tk * QP + 32 + pc * 8) = pack8(q2);
        const float xf = __builtin_amdgcn_exp2f((float)(tk + 1) * lgf), xb = __builtin_amdgcn_exp2f((float)(128 - tk) * lgb);
#pragma unroll
        for (int j = 0; j < 8; ++j) { a[j] = q1[j] * xf; c[j] = q2[j] * xf; }
        *(LAS u32x4*)(qf + tk * QP + pc * 8) = pack8(a); *(LAS u32x4*)(qf + tk * QP + 32 + pc * 8) = pack8(c);
#pragma unroll
        for (int j = 0; j < 8; ++j) { a[j] = q1[j] * xb; c[j] = q2[j] * xb; }
        *(LAS u32x4*)(qb + tk * QP + pc * 8) = pack8(a); *(LAS u32x4*)(qb + tk * QP + 32 + pc * 8) = pack8(c);
#pragma unroll
        for (int j = 0; j < 8; ++j) { a[j] = k1[j] * 0.125f; c[j] = k2[j] * 0.125f; }
        *(LAS u32x4*)(ks + tk * QP + pc * 8) = pack8(a); *(LAS u32x4*)(ks + tk * QP + 32 + pc * 8) = pack8(c);
#pragma unroll
        for (int k4 = 0; k4 < 4; ++k4) { const int it = tid + 512 * k4, tv = it >> 4, ch = it & 15; *(LAS u32x4*)(Vt + tv * VP + ch * 8) = vv[k4]; }
#pragma unroll
        for (int k4 = 0; k4 < 4; ++k4) { const int it = tid + 512 * k4, dd = it >> 10, e = (it >> 3) & 127, ch = it & 7; *(LAS u32x4*)((dd ? Rb : Rf) + e * QP + ch * 8) = rr[k4]; }
    }
    __syncthreads();
    f32x4 ST[8];
    {
        bf16x8 qa[2];
#pragma unroll
        for (int k2 = 0; k2 < 2; ++k2) qa[k2] = *(const LAS bf16x8*)(qn + (n0 + fr) * QP + k2 * 32 + fq * 8);
#pragma unroll
        for (int tm = 0; tm < 8; ++tm) { ST[tm] = (f32x4){0.f, 0.f, 0.f, 0.f};
#pragma unroll
            for (int k2 = 0; k2 < 2; ++k2) ST[tm] = mm32(*(const LAS bf16x8*)(ks + (16 * tm + fr) * QP + k2 * 32 + fq * 8), qa[k2], ST[tm]); }
    }
    s16x4 cst[8];
#pragma unroll
    for (int tm = 0; tm < 8; ++tm) { f32x4 t;
#pragma unroll
        for (int j = 0; j < 4; ++j) { const int n = n0 + fr, m = 16 * tm + 4 * fq + j; const int dd = n - m;
            const float ex = __builtin_amdgcn_exp2f((float)(dd < 0 ? -dd : dd) * (dd > 0 ? lgf : lgb));
            t[j] = ST[tm][j] * ((dd == 0) ? 2.0f : ex); }
        u32x2 pw; pw.x = pk2(t[0], t[1]); pw.y = pk2(t[2], t[3]); cst[tm] = __builtin_bit_cast(s16x4, pw); }
    f32x4 Y[8];
#pragma unroll
    for (int te = 0; te < 8; ++te) Y[te] = (f32x4){0.f, 0.f, 0.f, 0.f};
    {
        const int g = lane >> 4, i = lane & 15, q = i >> 2, pp = i & 3;
#pragma unroll
        for (int p = 0; p < 4; ++p) { const bf16x8 a = (bf16x8){cst[2 * p][0], cst[2 * p][1], cst[2 * p][2], cst[2 * p][3], cst[2 * p + 1][0], cst[2 * p + 1][1], cst[2 * p + 1][2], cst[2 * p + 1][3]};
#pragma unroll
            for (int te = 0; te < 8; ++te) {
                const LAS bf16_t* va = Vt + (32 * p + 4 * g + q) * VP + 16 * te + 4 * pp;
                const s16x4 lo = __builtin_bit_cast(s16x4, __builtin_amdgcn_ds_read_tr16_b64_v4i16((LAS v4i16_t*)va));
                const s16x4 hi = __builtin_bit_cast(s16x4, __builtin_amdgcn_ds_read_tr16_b64_v4i16((LAS v4i16_t*)(va + 16 * VP)));
                Y[te] = mm32(a, (bf16x8){lo[0], lo[1], lo[2], lo[3], hi[0], hi[1], hi[2], hi[3]}, Y[te]); } }
    }
#pragma unroll
    for (int k2 = 0; k2 < 2; ++k2) { const bf16x8 af = *(const LAS bf16x8*)(qf + (n0 + fr) * QP + k2 * 32 + fq * 8), ab = *(const LAS bf16x8*)(qb + (n0 + fr) * QP + k2 * 32 + fq * 8);
#pragma unroll
        for (int te = 0; te < 8; ++te) { Y[te] = mm32(af, *(const LAS bf16x8*)(Rf + (16 * te + fr) * QP + k2 * 32 + fq * 8), Y[te]); Y[te] = mm32(ab, *(const LAS bf16x8*)(Rb + (16 * te + fr) * QP + k2 * 32 + fq * 8), Y[te]); } }
    __syncthreads();
#pragma unroll
    for (int j = 0; j < 4; ++j) { float s = 0.f;
#pragma unroll
        for (int te = 0; te < 8; ++te) s += Y[te][j];
        s += shx(s, 1, lane); s += shx(s, 2, lane); s += shx(s, 4, lane); s += shx(s, 8, lane);
        const float mean = s * (1.0f / 128.0f); float vs = 0.f;
#pragma unroll
        for (int te = 0; te < 8; ++te) { const float dd = Y[te][j] - mean; vs += dd * dd; }
        vs += shx(vs, 1, lane); vs += shx(vs, 2, lane); vs += shx(vs, 4, lane); vs += shx(vs, 8, lane);
        const float rstd = rsqrtf(vs * (1.0f / 128.0f) + 1e-5f);
        const int r = 4 * fq + j; LAS bf16_t* yst = (r < 8 ? qf + n0 * QP + r * VP : qb + n0 * QP + (r - 8) * VP);
#pragma unroll
        for (int te = 0; te < 8; ++te) { const int e = 16 * te + fr; yst[e] = (bf16_t)f2bf((Y[te][j] - mean) * rstd * lgv[te] + lbv[te]); } }
    __syncthreads();
#pragma unroll
    for (int k4 = 0; k4 < 4; ++k4) { const int it = lane + 64 * k4, r = it >> 4, ch = it & 15; const long row = U.rbase + n0 + r;
        const LAS bf16_t* yst = (r < 8 ? qf + n0 * QP + r * VP : qb + n0 * QP + (r - 8) * VP);
        float yv[8], gv[8]; unpack8(*(const LAS u32x4*)(yst + ch * 8), yv); unpack8(gq[k4], gv);
#pragma unroll
        for (int j = 0; j < 8; ++j) yv[j] *= siluf_(gv[j]);
        *(u32x4*)(y + row * 512 + U.h * 128 + ch * 8) = pack8(yv); }
    __syncthreads();
}
__device__ __forceinline__ void ret_r3_phase(const Ctx& F, int layer) {
    for (int un = F.bid; un < ret2::NUNITS; un += F.G) { if (layer != 0 && (un % 34) < 2) continue; ret_r3_unit(F, layer, un); }
}
__device__ __forceinline__ void ret_r1_phase(const Ctx& F, int layer) { for (int un = F.bid; un < ret2::NUNITS; un += F.G) ret_r1_unit(F, layer, un); }
__device__ __forceinline__ void rw_phase(const Ctx& F, int layer) {
    unsigned char* ws = getpp()->ws;
    if (F.G >= 160) {
        if (F.bid < 128) rwkv_chain4(F, layer, F.bid >> 4, (F.bid >> 1) & 7, F.bid & 1);
        unsigned* ctr = (unsigned*)(ws + WS_CTL) + 192 + 64 * layer; LAS unsigned* bc = (LAS unsigned*)(F.lds + LDS_BYTES - 32);
        for (;;) {
            __syncthreads();
            if (F.tid == 0) *bc = __hip_atomic_fetch_add(ctr, 1u, __ATOMIC_RELAXED, __HIP_MEMORY_SCOPE_AGENT);
            __syncthreads();
            const unsigned u = *bc; if (u >= 512u) break;
            const int bh = (int)u >> 4; attn_latent_unit(F, ws, half_a_base(layer), bh >> 3, bh & 7, (int)u & 15);
        }
    } else {
        for (int un = F.bid; un < 128; un += F.G) { rwkv_chain4(F, layer, un >> 4, (un >> 1) & 7, un & 1); __syncthreads(); }
        for (int u = F.bid; u < 512; u += F.G) { const int bh = u >> 4; attn_latent_unit(F, ws, half_a_base(layer), bh >> 3, bh & 7, u & 15); }
    }
}

template <int NB> __device__ __forceinline__ void rows_norm(int lane, const float* hbase, const int* rows, const float* gain, const float* mod, f32x4 (*y)[4]) {
    float ss[NB];
#pragma unroll
    for (int b = 0; b < NB; ++b) { const float* src = hbase + (size_t)rows[b] * 1024; ss[b] = 0.f;
#pragma unroll
        for (int j = 0; j < 4; ++j) { y[b][j] = *(const f32x4*)(src + 4 * lane + 256 * j); ss[b] += y[b][j].x * y[b][j].x + y[b][j].y * y[b][j].y + y[b][j].z * y[b][j].z + y[b][j].w * y[b][j].w; } }
#pragma unroll
    for (int b = 0; b < NB; ++b) ss[b] = wave_sum(ss[b], lane);
#pragma unroll
    for (int b = 0; b < NB; ++b) { const float rstd = rsqrtf(ss[b] * (1.0f / 1024.0f) + 1e-6f); const float* sh = mod + (rows[b] >> 12) * 6144; const float* sc = sh + 1024;
#pragma unroll
        for (int j = 0; j < 4; ++j) { const int c = 4 * lane + 256 * j; y[b][j] = y[b][j] * rstd * *(const f32x4*)(gain + c) * (*(const f32x4*)(sc + c) + 1.0f) + *(const f32x4*)(sh + c); } }
}
template <int NB> __device__ __forceinline__ void rows_norm_pre(int lane, const int* rows, const float* gain, const float* mod, f32x4 (*y)[4]) {
    float ss[NB];
#pragma unroll
    for (int b = 0; b < NB; ++b) { ss[b] = 0.f;
#pragma unroll
        for (int j = 0; j < 4; ++j) ss[b] += y[b][j].x * y[b][j].x + y[b][j].y * y[b][j].y + y[b][j].z * y[b][j].z + y[b][j].w * y[b][j].w; }
#pragma unroll
    for (int b = 0; b < NB; ++b) ss[b] = wave_sum(ss[b], lane);
#pragma unroll
    for (int b = 0; b < NB; ++b) { const float rstd = rsqrtf(ss[b] * (1.0f / 1024.0f) + 1e-6f); const float* sh = mod + (rows[b] >> 12) * 6144; const float* sc = sh + 1024;
#pragma unroll
        for (int j = 0; j < 4; ++j) { const int c = 4 * lane + 256 * j; y[b][j] = y[b][j] * rstd * *(const f32x4*)(gain + c) * (*(const f32x4*)(sc + c) + 1.0f) + *(const f32x4*)(sh + c); } }
}
__device__ __forceinline__ void moe_route_pass(const Ctx& F, int layer) {
    PP P = getpp(); unsigned char* ws = P->ws;
    const float* gain = P->in[I_NFFN] + layer * 1024; const float* mod = (const float*)(ws + WS_MOD) + (size_t)layer * 9 * 6144 + 3072;
    const float* router = P->in[I_ROUTER];
    unsigned* cnt = (unsigned*)(ws + WS_CTL); int* route = (int*)(ws + WS_ROUTE);
    LAS float* rl = (LAS float*)F.lds;
    LAS unsigned* lc = (LAS unsigned*)(F.lds + 32768);
    for (int i = F.tid; i < 8192; i += NTHREADS) rl[(i & 7) * 1024 + (i >> 3)] = router[i];
    if (F.tid < 16) lc[F.tid] = 0u;
    __syncthreads();
    const int rpb = (RL + F.G - 1) / F.G, rpw = (rpb + 7) / 8;
    const int b0 = F.bid * rpb, b1 = (b0 + rpb < RL) ? b0 + rpb : RL;
    const int r0 = b0 + F.wave * rpw, r1 = (r0 + rpw < b1) ? r0 + rpw : b1;
    constexpr int NB = 2;
    f32x4 xr[NB][4];
#pragma unroll
    for (int b = 0; b < NB; ++b) { const int row = (r0 + b < r1) ? r0 + b : r1 - 1;
#pragma unroll
        for (int j = 0; j < 4; ++j) xr[b][j] = ldh4((const bf16_t*)(ws + D_H1) + (size_t)row * 1024 + 4 * F.lane + 256 * j); }
    for (int rb = r0; rb < r1; rb += NB) {
        int lane = F.lane; asm volatile("" : "+v"(lane));
        int rows[NB]; f32x4 y[NB][4];
#pragma unroll
        for (int b = 0; b < NB; ++b) { rows[b] = (rb + b < r1) ? rb + b : r1 - 1;
#pragma unroll
            for (int j = 0; j < 4; ++j) y[b][j] = xr[b][j]; }
        if (rb + NB < r1) {
#pragma unroll
            for (int b = 0; b < NB; ++b) { const int row = (rb + NB + b < r1) ? rb + NB + b : r1 - 1;
#pragma unroll
                for (int j = 0; j < 4; ++j) xr[b][j] = ldh4((const bf16_t*)(ws + D_H1) + (size_t)row * 1024 + 4 * lane + 256 * j); } }
        rows_norm_pre<NB>(lane, rows, gain, mod, y);
        float lg[NB][8];
#pragma unroll
        for (int b = 0; b < NB; ++b)
#pragma unroll
            for (int e = 0; e < 8; ++e) lg[b][e] = 0.f;
#pragma unroll
        for (int j = 0; j < 4; ++j)
#pragma unroll
            for (int e = 0; e < 8; ++e) { const f32x4 r4 = *(const LAS f32x4*)(rl + e * 1024 + 4 * lane + 256 * j);
#pragma unroll
                for (int b = 0; b < NB; ++b) lg[b][e] += y[b][j][0] * r4[0] + y[b][j][1] * r4[1] + y[b][j][2] * r4[2] + y[b][j][3] * r4[3]; }
#pragma unroll
        for (int b = 0; b < NB; ++b)
#pragma unroll
            for (int e = 0; e < 8; ++e) lg[b][e] = wave_sum(lg[b][e], lane);
        if (lane == 0) {
#pragma unroll
            for (int b = 0; b < NB; ++b) if (rb + b < r1) {
                int i0 = 0; float v0 = lg[b][0];
#pragma unroll
                for (int e = 1; e < 8; ++e) if (lg[b][e] > v0) { v0 = lg[b][e]; i0 = e; }
                int i1 = -1; float v1 = -3.0e38f;
#pragma unroll
                for (int e = 0; e < 8; ++e) if (e != i0 && lg[b][e] > v1) { v1 = lg[b][e]; i1 = e; }
                const float w0 = 1.0f / (1.0f + __expf(v1 - v0)), w1 = 1.0f - w0;
                const unsigned p0 = __hip_atomic_fetch_add(&lc[i0], 1u, __ATOMIC_RELAXED, __HIP_MEMORY_SCOPE_WORKGROUP), p1 = __hip_atomic_fetch_add(&lc[i1], 1u, __ATOMIC_RELAXED, __HIP_MEMORY_SCOPE_WORKGROUP);
                int* r = route + (size_t)rows[b] * 8; r[0] = i0; r[1] = i1; r[2] = __float_as_int(w0); r[3] = __float_as_int(w1); r[4] = (int)p0; r[5] = (int)p1;
            }
        }
    }
    __syncthreads();
    if (F.tid < 8) lc[8 + F.tid] = atomicAdd(&cnt[F.tid], lc[F.tid]);
    __syncthreads();
    for (int row = r0 + F.lane; row < r1; row += 64) { int* r = route + (size_t)row * 8; const int e0 = r[0], e1 = r[1], p0 = r[4], p1 = r[5]; r[4] = p0 + (int)lc[8 + e0]; r[5] = p1 + (int)lc[8 + e1]; }
    __syncthreads();
}
__device__ __forceinline__ void moe_gather_pass(const Ctx& F, int layer) {
    PP P = getpp(); unsigned char* ws = P->ws;
    const float* gain = P->in[I_NFFN] + layer * 1024; const float* mod = (const float*)(ws + WS_MOD) + (size_t)layer * 9 * 6144 + 3072;
    const unsigned* cnt = (const unsigned*)(ws + WS_CTL); const int* route = (const int*)(ws + WS_ROUTE);
    bf16_t* xlo = (bf16_t*)(ws + D_XG); bf16_t* xhi = xlo + (size_t)RG * 512;
    const MoeTiles T = moe_tiles(cnt);
    const int rpw = (RL + NGW(F) - 1) / NGW(F); const int r0 = GW(F) * rpw; const int r1 = (r0 + rpw < RL) ? r0 + rpw : RL;
    constexpr int NB = 2;
    f32x4 xr[NB][4]; int rt[NB][4];
#pragma unroll
    for (int b = 0; b < NB; ++b) { const int row = (r0 + b < r1) ? r0 + b : r1 - 1; const int* r = route + (size_t)row * 8; rt[b][0] = r[0]; rt[b][1] = r[1]; rt[b][2] = r[4]; rt[b][3] = r[5];
#pragma unroll
        for (int j = 0; j < 4; ++j) xr[b][j] = ldh4((const bf16_t*)(ws + D_H1) + (size_t)row * 1024 + 4 * F.lane + 256 * j); }
    for (int rb = r0; rb < r1; rb += NB) {
        int lane = F.lane; asm volatile("" : "+v"(lane));
        int rows[NB]; f32x4 y[NB][4]; int rc[NB][4];
#pragma unroll
        for (int b = 0; b < NB; ++b) { rows[b] = (rb + b < r1) ? rb + b : r1 - 1;
#pragma unroll
            for (int j = 0; j < 4; ++j) { y[b][j] = xr[b][j]; rc[b][j] = rt[b][j]; } }
        if (rb + NB < r1) {
#pragma unroll
            for (int b = 0; b < NB; ++b) { const int row = (rb + NB + b < r1) ? rb + NB + b : r1 - 1; const int* r = route + (size_t)row * 8; rt[b][0] = r[0]; rt[b][1] = r[1]; rt[b][2] = r[4]; rt[b][3] = r[5];
#pragma unroll
                for (int j = 0; j < 4; ++j) xr[b][j] = ldh4((const bf16_t*)(ws + D_H1) + (size_t)row * 1024 + 4 * lane + 256 * j); } }
        rows_norm_pre<NB>(lane, rows, gain, mod, y);
#pragma unroll
        for (int b = 0; b < NB; ++b) {
            const int e0 = rc[b][0], e1 = rc[b][1];
            int t0 = 0, t1 = 0;
#pragma unroll
            for (int e = 0; e < 8; ++e) { if (e == e0) t0 = T.tstart[e]; if (e == e1) t1 = T.tstart[e]; }
            const size_t s0 = (size_t)t0 * 256 + rc[b][2], s1 = (size_t)t1 * 256 + rc[b][3];
#pragma unroll
            for (int j = 0; j < 4; ++j) { const int c = 4 * lane + 256 * j; u32x2 o; o.x = pk2(y[b][j].x, y[b][j].y); o.y = pk2(y[b][j].z, y[b][j].w);
                bf16_t* bp = (c < 512) ? xlo + c : xhi + (c - 512);
                *(u32x2*)(bp + s0 * 512) = o; *(u32x2*)(bp + s1 * 512) = o; } }
    }
}
__device__ __forceinline__ void moe_final_pass(const Ctx& F, int layer) {
    PP P = getpp(); unsigned char* ws = P->ws;
    const float* mod = (const float*)(ws + WS_MOD) + (size_t)layer * 9 * 6144 + 5120;
    const unsigned* cnt = (const unsigned*)(ws + WS_CTL); const int* route = (const int*)(ws + WS_ROUTE);
    const bf16_t* ym = (const bf16_t*)(ws + D_XG); const float* fn = P->in[I_FNORM];
    const MoeTiles T = moe_tiles(cnt);
    const int rpw = (RL + NGW(F) - 1) / NGW(F); const int r0 = GW(F) * rpw; const int r1 = (r0 + rpw < RL) ? r0 + rpw : RL;
    constexpr int NB = 2;
    int rt[NB][6];
#pragma unroll
    for (int b = 0; b < NB; ++b) { const int row = (r0 + b < r1) ? r0 + b : r1 - 1; const int* r = route + (size_t)row * 8;
#pragma unroll
        for (int k = 0; k < 6; ++k) rt[b][k] = r[k]; }
    for (int rb = r0; rb < r1; rb += NB) {
        int lane = F.lane; asm volatile("" : "+v"(lane));
        f32x4 v[NB][4]; float ss[NB]; int rows[NB]; int rc[NB][6];
#pragma unroll
        for (int b = 0; b < NB; ++b)
#pragma unroll
            for (int k = 0; k < 6; ++k) rc[b][k] = rt[b][k];
        if (rb + NB < r1) {
#pragma unroll
            for (int b = 0; b < NB; ++b) { const int row = (rb + NB + b < r1) ? rb + NB + b : r1 - 1; const int* r = route + (size_t)row * 8;
#pragma unroll
                for (int k = 0; k < 6; ++k) rt[b][k] = r[k]; } }
#pragma unroll
        for (int b = 0; b < NB; ++b) { const int row = (rb + b < r1) ? rb + b : r1 - 1; rows[b] = row;
            const int e0 = rc[b][0], e1 = rc[b][1]; const float w0 = __int_as_float(rc[b][2]), w1 = __int_as_float(rc[b][3]);
            int t0 = 0, t1 = 0;
#pragma unroll
            for (int e = 0; e < 8; ++e) { if (e == e0) t0 = T.tstart[e]; if (e == e1) t1 = T.tstart[e]; }
            const size_t s0 = (size_t)t0 * 256 + rc[b][4], s1 = (size_t)t1 * 256 + rc[b][5];
            const float* g = mod + (row >> 12) * 6144; const bf16_t* hp = (const bf16_t*)(ws + D_H1) + (size_t)row * 1024; ss[b] = 0.f;
#pragma unroll
            for (int j = 0; j < 4; ++j) { const int c = 4 * lane + 256 * j; const u32x2 a = *(const u32x2*)(ym + s0 * 1024 + c), bq = *(const u32x2*)(ym + s1 * 1024 + c);
                const f32x4 ya = {bflo(a.x), bfhi(a.x), bflo(a.y), bfhi(a.y)}, yb = {bflo(bq.x), bfhi(bq.x), bflo(bq.y), bfhi(bq.y)};
                v[b][j] = ldh4(hp + c) + *(const f32x4*)(g + c) * (ya * w0 + yb * w1);
                ss[b] += v[b][j].x * v[b][j].x + v[b][j].y * v[b][j].y + v[b][j].z * v[b][j].z + v[b][j].w * v[b][j].w; } }
#pragma unroll
        for (int b = 0; b < NB; ++b) ss[b] = wave_sum(ss[b], lane);
#pragma unroll
        for (int b = 0; b < NB; ++b) { const float rstd = rsqrtf(ss[b] * (1.0f / 1024.0f) + 1e-6f); float* hp = P->out + (size_t)rows[b] * 1024;
#pragma unroll
            for (int j = 0; j < 4; ++j) { const int c = 4 * lane + 256 * j; *(f32x4*)(hp + c) = v[b][j] * rstd * *(const f32x4*)(fn + c); } }
    }
}

#define XB_TMO      128
#define XB_XCNT(j)  (256  + 64 * (j))
#define XB_XSUB(j)  (1280 + 64 * (j))
#define XB_XGEN(j)  (2304 + 64 * (j))
#define XB_TOP      3328
#define XB_TOPGEN   3392
#define XCD_BAR_WORDS 3456
#define XB_SPIN_CAP (1u << 18)
constexpr int CW_BAR = 4096;
constexpr int LDS_BARST = LDS_BYTES - 16;
__device__ __forceinline__ unsigned xb_ld(unsigned* p)              { return __hip_atomic_load(p, __ATOMIC_RELAXED, __HIP_MEMORY_SCOPE_AGENT); }
__device__ __forceinline__ unsigned xb_add(unsigned* p, unsigned v) { return __hip_atomic_fetch_add(p, v, __ATOMIC_RELAXED, __HIP_MEMORY_SCOPE_AGENT); }
__device__ __forceinline__ unsigned xb_xcc_id() { return (unsigned)__builtin_amdgcn_s_getreg((3 << 11) | 20) & 0xFu; }
#define XB_SPIN(cond, bar) do { unsigned _sp = 0; while (cond) { __builtin_amdgcn_s_sleep(1); \
    if ((++_sp & 255u) == 0u) { if (xb_ld(&(bar)[XB_TMO])) break; if (_sp > XB_SPIN_CAP) { atomicAdd(&(bar)[XB_TMO], 1u); break; } } } } while (0)
__device__ __forceinline__ void xcd_barrier_complete(unsigned* bar, unsigned x, unsigned& nloc, unsigned& nx) {
    const unsigned G = gridDim.x * gridDim.y * gridDim.z;
    unsigned sum, cnt, mine, sp = 0u;
    for (;;) {
        sum = 0u; cnt = 0u; mine = 0u;
#pragma unroll
        for (unsigned j = 0; j < 16; ++j) { const unsigned c = xb_ld(&bar[XB_XCNT(j)]); sum += c; cnt += (c > 0u) ? 1u : 0u; mine = (j == x) ? c : mine; }
        if (sum == G) break;
        __builtin_amdgcn_s_sleep(1);
        if ((++sp & 255u) == 0u) { if (xb_ld(&bar[XB_TMO])) break; if (sp > XB_SPIN_CAP) { atomicAdd(&bar[XB_TMO], 1u); break; } }
    }
    nloc = mine > 0u ? mine : 1u; nx = cnt > 0u ? cnt : 1u;
}
__device__ __forceinline__ void xcd_barrier(LAS unsigned char* lds) {
    asm volatile("s_waitcnt vmcnt(0)" ::: "memory");
    __syncthreads();
    if (threadIdx.x == 0) {
        unsigned* bar = (unsigned*)(getpp()->ws + WS_CTL) + CW_BAR;
        volatile LAS unsigned* st = (volatile LAS unsigned*)(lds + LDS_BARST);
        const unsigned x = xb_xcc_id();
        __builtin_amdgcn_s_waitcnt(0);
        unsigned nloc = st[0], nx = st[1];
        if (nloc == 0u) { xcd_barrier_complete(bar, x, nloc, nx); st[0] = nloc; st[1] = nx; }
        const unsigned old = xb_add(&bar[XB_XSUB(x)], 1u);
        const unsigned gen = old / nloc;
        if (old + 1u == (gen + 1u) * nloc) {
            __builtin_amdgcn_fence(__ATOMIC_RELEASE, "agent");
            asm volatile("s_waitcnt vmcnt(0)" ::: "memory");
            const unsigned og = xb_add(&bar[XB_TOP], 1u);
            const unsigned tg = og / nx;
            if (og + 1u == (tg + 1u) * nx) xb_add(&bar[XB_TOPGEN], 1u);
            else XB_SPIN(xb_ld(&bar[XB_TOPGEN]) == tg, bar);
            __builtin_amdgcn_fence(__ATOMIC_ACQUIRE, "agent");
            xb_add(&bar[XB_XGEN(x)], 1u);
            asm volatile("s_waitcnt vmcnt(0)" ::: "memory");
        } else {
            XB_SPIN(xb_ld(&bar[XB_XGEN(x)]) == gen, bar);
            __builtin_amdgcn_fence(__ATOMIC_ACQUIRE, "agent");
            asm volatile("s_waitcnt vmcnt(0)" ::: "memory");
        }
    }
    __syncthreads();
}
#define FRESH() do { int t_ = threadIdx.x; asm volatile("" : "+v"(t_)); F.tid = t_; F.lane = t_ & 63; F.wave = __builtin_amdgcn_readfirstlane(t_ >> 6); \
    int g_ = gridDim.x, b_ = blockIdx.x; asm volatile("" : "+s"(g_), "+s"(b_)); F.G = g_; F.bid = b_; } while (0)
#define PHASE_VARS FRESH(); const int G = F.G, c = F.bid; (void)G; (void)c; PP P = getpp(); unsigned char* ws = P->ws; const bool L0 = (layer == 0); \
    const float* hl = P->in[I_X]; const bf16_t* hb = L0 ? (const bf16_t*)nullptr : (const bf16_t*)h0_base(); (void)hb; const float* hcx = L0 ? P->in[I_CTX] : (const float*)(ws + WS_HC); float* hc = (float*)(ws + WS_HC); \
    const char* wl = (const char*)(ws + WS_W + (size_t)layer * WL_STRIDE); const float* mod = (const float*)(ws + WS_MOD) + (size_t)layer * 9 * 6144; \
    const int nMm = L0 ? RT / 256 : RL / 256; (void)hl; (void)hcx; (void)hc; (void)wl; (void)mod; (void)nMm;

template <int layer> __device__ __forceinline__ void layer_fwd(Ctx& F, cg::grid_group& grid) {

        { PHASE_VARS norm_pass(F, layer, 0, hl, hb, hcx, RT, (bf16_t*)(ws + D_XN1), (bf16_t*)(ws + D_XN1 + Y34), layer != 0); }
        xcd_barrier(F.lds);
        { PHASE_VARS SchedSplit2 S{(const char*)(ws + D_XN1), (const char*)(ws + D_XN1 + Y34), wl + WL_WINLO, wl + WL_WINHI, RT / 256, MIXP / 256, G, c, true};
          EpiInproj E{ws};
          pg8::gemm_phase<512, 512, true>(F.lds, S, E); }
        xcd_barrier(F.lds);
        FRESH(); ctx_krope_proj(F, layer);
        FRESH(); mla_stats_pass(F, 0, F.G * 8);
        FRESH(); ret_r1_phase(F, layer);
        xcd_barrier(F.lds);
        FRESH(); ret_r2(F, layer, 0, F.G);
        FRESH(); krope_pass(F, 0, layer);
        { PHASE_VARS SchedHalf S{(const char*)(ws + D_UMLA), wl + WL_WQ, (size_t)256 * MLC * 2, (size_t)256 * 384 * 2, 6, 3, 0, G, (c + G - 128 % G) % G};
          EpiQup E{(bf16_t*)(half_a_base(layer) + HA_Q), (const float*)(ws + WS_RSTD), (const float*)(ws + WS_ROPE_M), (const float*)(ws + WS_ROPE_M) + 4096 * 16, 1};
          pg8::gemm_phase<MLC, 384, false>(F.lds, S, E); }
        { PHASE_VARS SchedHalf S{(const char*)(ws + D_UMLA) + 384 * 2, wl + WL_WKV, (size_t)256 * MLC * 2, (size_t)256 * 256 * 2, 4, 4, 0, G, (c + G - 24 % G) % G};
          EpiKVup E{(bf16_t*)(half_a_base(layer) + HA_K), (bf16_t*)(half_a_base(layer) + HA_V), (const float*)(ws + WS_RSTD) + RT, 1};
          pg8::gemm_phase<MLC, 256, true>(F.lds, S, E); }
        xcd_barrier(F.lds);
        FRESH(); rw_phase(F, layer);
        xcd_barrier(F.lds);
        FRESH(); rwkv_post_phase(F, layer, layer == 0 ? RT : RL);
        xcd_barrier(F.lds);
        FRESH(); krope_pass(F, 1, layer);
        FRESH(); ret_r3_phase(F, layer);
        { PHASE_VARS SchedHalf S{(const char*)(ws + D_UMLA), wl + WL_WQ, (size_t)256 * MLC * 2, (size_t)256 * 384 * 2, 6, 3, 1, G, (c + G - 64 % G) % G};
          EpiQup E{(bf16_t*)(ws + D_Q), (const float*)(ws + WS_RSTD), (const float*)(ws + WS_ROPE_M), (const float*)(ws + WS_ROPE_M) + 4096 * 16, 0};
          pg8::gemm_phase<MLC, 384, false>(F.lds, S, E); }
        { PHASE_VARS SchedHalf S{(const char*)(ws + D_UMLA) + 384 * 2, wl + WL_WKV, (size_t)256 * MLC * 2, (size_t)256 * 256 * 2, 4, 4, 1, G, (c + G - 216 % G) % G};
          EpiKVup E{(bf16_t*)(ws + D_K), (bf16_t*)(ws + D_V), (const float*)(ws + WS_RSTD) + RT, 0};
          pg8::gemm_phase<MLC, 256, true>(F.lds, S, E); }
        xcd_barrier(F.lds);
        FRESH(); attn_phase(F, layer);
        xcd_barrier(F.lds);
        { PHASE_VARS SchedMerge S; S.XNlo = (const char*)(ws + D_XN1); S.XNhi = (const char*)(ws + D_XN1 + Y34); S.WgLo = wl + WL_WGLO; S.WgHi = wl + WL_WGHI;
          S.wsb = (const char*)ws; S.Wb = wl + WL_WB; S.nM = nMm; S.G = G; S.c = c; S.ctx3 = L0 && G > 64;
          EpiMerge E{(u32x4*)(ws + D_SCR + (size_t)c * 131072), (bf16_t*)(ws + D_M), (bf16_t*)(ws + D_P12)};
          pg8::gemm_phase<512, 512, true>(F.lds, S, E); }
        xcd_barrier(F.lds);
        if (layer == 0 && F.G > 64) { PHASE_VARS SchedWout0 S{(const char*)(ws + D_M), wl + WL_WO, (const char*)ws, G, c};
          EpiResid E{(const void*)hl, false, hcx, h0_base(), hc, mod, 2048, nullptr};
          pg8::gemm_phase<1024, 1024, true>(F.lds, S, E); }
        else { PHASE_VARS Sched1 S{(const char*)(ws + D_M), wl + WL_WO, (size_t)256 * 1024 * 2, (size_t)256 * 1024 * 2, 16, nMm, 4, G, c};
          EpiResid E{L0 ? (const void*)hl : (const void*)hb, !L0, hcx, L0 ? h0_base() : (bf16_t*)(ws + D_H1), hc, mod, 2048, nullptr};
          pg8::gemm_phase<1024, 1024, true>(F.lds, S, E); }
        xcd_barrier(F.lds);
        if (layer == 0) {
            { PHASE_VARS norm_pass(F, layer, 1, hl, h0_base(), hc, RT, (bf16_t*)(ws + D_XN2), (bf16_t*)(ws + D_XN2 + Y34)); }
            FRESH(); convert_ffn0(F);
            xcd_barrier(F.lds);
            { PHASE_VARS SchedSplit2 S{(const char*)(ws + D_XN2), (const char*)(ws + D_XN2 + Y34), (const char*)(ws + D_FFW), (const char*)(ws + D_FFW) + (size_t)5632 * 1024, RT / 256, 22, G, c, false};
              EpiSwiglu E{(bf16_t*)(ws + D_H), DFF};
              pg8::gemm_phase<512, 512, true>(F.lds, S, E); }
            xcd_barrier(F.lds);
            { PHASE_VARS SchedDown0 S{(const char*)(ws + D_H), (const char*)(ws + D_FFW) + (size_t)2 * 5632 * 1024, G, c};
              EpiResid E{(const void*)h0_base(), true, hc, h0_base(), hc, mod, 5120, (float*)(ws + D_PART)};
              pg8::gemm_phase<DFF, DFF, true>(F.lds, S, E); }
            xcd_barrier(F.lds);
        } else {
            FRESH(); moe_route_pass(F, layer);
            FRESH(); convert_moe(F);
            xcd_barrier(F.lds);
            FRESH(); moe_gather_pass(F, layer);
            xcd_barrier(F.lds);
            { PHASE_VARS const MoeTiles T = moe_tiles((const unsigned*)(ws + WS_CTL));
              SchedMoeUp S{(const char*)(ws + D_XG), (const char*)(ws + D_XG) + (size_t)RG * 1024, (const char*)(ws + D_MOEW), T, G, c};
              EpiSwiglu E{(bf16_t*)(ws + D_HM), DFE};
              pg8::gemm_phase<512, 512, true>(F.lds, S, E); }
            xcd_barrier(F.lds);
            { PHASE_VARS const MoeTiles T = moe_tiles((const unsigned*)(ws + WS_CTL));
              SchedMoeDown S{(const char*)(ws + D_HM), (const char*)(ws + D_MOEW), T, G, c};
              EpiBf16 E{(bf16_t*)(ws + D_XG), 1024};
              pg8::gemm_phase<DFE, DFE, true>(F.lds, S, E); }
            xcd_barrier(F.lds);
            FRESH(); moe_final_pass(F, layer);
        }
    }
#undef PHASE_VARS
#undef FRESH

__global__ void __launch_bounds__(NTHREADS, 2) mega_fwd(Params prm) {
    extern __shared__ __attribute__((aligned(16))) unsigned char lds_raw[];
    cg::grid_group grid = cg::this_grid();
    Ctx F; F.lds = (LAS unsigned char*)lds_raw; F.tid = threadIdx.x; F.lane = F.tid & 63; F.wave = __builtin_amdgcn_readfirstlane(F.tid >> 6); F.G = gridDim.x; F.bid = blockIdx.x;
    if (F.tid < 4) ((LAS unsigned*)(F.lds + LDS_BARST))[F.tid] = 0u;
    __syncthreads();
    if (F.tid == 0) (void)xb_add((unsigned*)(prm.ws + WS_CTL) + CW_BAR + XB_XCNT(xb_xcc_id()), 1u);
    phase0(F);
    grid.sync();
    layer_fwd<0>(F, grid);
    layer_fwd<1>(F, grid);
}

extern "C" void kernel_launch(void* const* d_in, const int* in_sizes, int n_in, void* d_out, int out_size, void* d_ws, size_t ws_size, hipStream_t stream) {
    static int grid_blocks = 0;
    if (grid_blocks == 0) {
        if (n_in != 37 || ws_size < WS_NEED) { fprintf(stderr, "kernel_launch: unexpected n_in %d / ws %zu\n", n_in, ws_size); grid_blocks = -1; return; }
        int dev = 0, cus = 0, per_cu = 0;
        hipGetDevice(&dev); hipDeviceGetAttribute(&cus, hipDeviceAttributeMultiprocessorCount, dev);
        hipFuncSetAttribute((const void*)mega_fwd, hipFuncAttributeMaxDynamicSharedMemorySize, LDS_BYTES);
        hipOccupancyMaxActiveBlocksPerMultiprocessor(&per_cu, (const void*)mega_fwd, NTHREADS, LDS_BYTES);
        if (per_cu < 1) { fprintf(stderr, "kernel_launch: occupancy query says %d blocks/CU\n", per_cu); per_cu = 1; }
        grid_blocks = cus;
        (void)hipGetLastError();
    }
    if (grid_blocks < 0) return;
    (void)hipMemsetAsync((char*)d_ws + WS_CTL, 0, 65536, stream);
    Params p{};
    for (int i = 0; i < 37; ++i) p.in[i] = (const float*)d_in[i];
    p.out = (float*)d_out; p.ws = (unsigned char*)d_ws;
    void* args[] = {&p};
    hipError_t e = hipLaunchCooperativeKernel((const void*)mega_fwd, dim3(grid_blocks), dim3(NTHREADS), args, LDS_BYTES, stream);
    if (e != hipSuccess) fprintf(stderr, "cooperative launch failed: %s (grid %d)\n", hipGetErrorString(e), grid_blocks);
}
```

```cpp
#include <hip/hip_runtime.h>
#include <hip/hip_cooperative_groups.h>
#include <cstdio>
#include <cstdint>
namespace cg = cooperative_groups;

#define LAS __attribute__((address_space(3)))
typedef unsigned short bf16_t;
typedef short bf16x8 __attribute__((ext_vector_type(8)));
typedef short s16x4 __attribute__((ext_vector_type(4)));
typedef float f32x4 __attribute__((ext_vector_type(4)));
typedef float f32x2 __attribute__((ext_vector_type(2)));
typedef float f32x16 __attribute__((ext_vector_type(16)));
typedef unsigned u32x4 __attribute__((ext_vector_type(4)));
typedef unsigned u32x2 __attribute__((ext_vector_type(2)));

constexpr int DM = 1024, NBATCH = 8, SEQ = 4096, CTXL = 256;
constexpr int RL = NBATCH * SEQ, RC = NBATCH * CTXL, RT = RL + RC;
constexpr int RWC = 1920, REC = 1536, MLC = 672, MIXC = 4128, MIXP = 4352, GATEC = 3072, NIN = 7200;
constexpr int DFF = 2816, NEXP = 8, DFE = 1408;
constexpr int RG = 2 * RL + NEXP * 256;
constexpr int NTHREADS = 512;
constexpr int LDS_BYTES = 147456;

constexpr size_t MiB = 1u << 20;
constexpr size_t WS_CTL = 0;
constexpr size_t WS_MOD = 1 * MiB;
constexpr size_t WS_ROPE_R = 3 * MiB / 2;
constexpr size_t WS_ROPE_M = 5 * MiB / 2;
constexpr size_t WS_RSTD = 3 * MiB;
constexpr size_t WS_BSC = 7 * MiB / 2;
constexpr size_t WS_ROUTE = 6 * MiB;
constexpr size_t WS_WG2 = 7 * MiB;
constexpr size_t WS_W2T = 15 * MiB / 2;
constexpr size_t WS_HC = 8 * MiB;
constexpr size_t WS_W = 16 * MiB;
constexpr size_t WL_WINLO = 0, WL_WINHI = 4456448, WL_WGLO = 8912896, WL_WGHI = 12058624, WL_WQ = 15204352, WL_WKV = 15794176, WL_WB = 16318464, WL_WO = 19464192, WL_STRIDE = 21 * MiB;
constexpr size_t WS_DYN = 58 * MiB;
constexpr size_t Y34 = 34 * MiB;
constexpr size_t D_URWKV = WS_DYN, D_URET = WS_DYN + 255 * MiB / 2, D_UMLA = D_URET + 102 * MiB, D_XN1 = D_UMLA + 357 * MiB / 8, D_OF = D_XN1 + 2 * Y34, D_OB = D_OF + Y34, D_END1 = D_OB + Y34;
constexpr size_t D_YRWKV = D_OF, D_YRET = D_OB;
constexpr size_t D_K = WS_DYN, D_V = D_K + 289 * MiB / 8, D_Q = D_V + Y34;
constexpr size_t D_YMLA = D_UMLA;
constexpr int HROWS = 4 * SEQ + 4 * CTXL;
constexpr size_t HA_K = 0, HA_V = HA_K + (size_t)HROWS * 544 * 2, HA_Q = HA_V + (size_t)HROWS * 512 * 2;
static_assert(HA_Q + (size_t)HROWS * 768 * 2 <= 64 * MiB, "half-A K/V/Q fit the first half of d_out");

constexpr size_t D_SCR = WS_DYN + 68 * MiB;
constexpr size_t D_P12 = WS_DYN + 100 * MiB;
constexpr size_t D_M = WS_DYN;
constexpr size_t D_FFW = D_END1;
constexpr size_t D_XN2 = WS_DYN + 17 * MiB;
constexpr size_t D_H = D_URET;
constexpr size_t D_H1 = WS_DYN + 380 * MiB;
constexpr size_t D_RMAP = WS_DYN + 444 * MiB;
constexpr size_t D_XR = WS_DYN;
constexpr size_t D_PART = WS_DYN + 17 * MiB;
constexpr size_t D_XG = WS_DYN;
constexpr size_t D_HM = WS_DYN + 132 * MiB;
constexpr size_t D_MOEW = D_HM + 363 * MiB / 2;
constexpr size_t WS_NEED = 512 * MiB;
static_assert(D_MOEW + 66 * MiB <= D_H1 && D_H1 + 64 * MiB <= D_RMAP && D_RMAP + 1 * MiB <= WS_NEED, "h1 / row map regions");
static_assert(D_END1 <= WS_NEED && D_MOEW + 66 * MiB <= WS_NEED && D_H + 187 * MiB <= WS_NEED && D_Q + 51 * MiB <= D_URET, "ws map");

struct Params { const float* in[37]; float* out; unsigned char* ws; };
enum { I_X = 0, I_C, I_CTX, I_CCTX, I_NMIX, I_NFFN, I_WMOD, I_BMOD, I_WIN, I_MU, I_W0, I_W2, I_A0, I_A2, I_G2, I_KK, I_KA, I_RK, I_LNG, I_LNB,
       I_RDEC, I_RLNG, I_RLNB, I_QN, I_QUP, I_KVN, I_KVUP, I_WBR, I_WOUT, I_FG, I_FU, I_FD, I_ROUTER, I_MG, I_MU2, I_MD, I_FNORM };

__device__ __forceinline__ unsigned f2bf(float f) { unsigned u = __builtin_bit_cast(unsigned, f); return (u + 0x7fffu + ((u >> 16) & 1u)) >> 16; }
typedef __bf16 bf16x2_t __attribute__((ext_vector_type(2)));
__device__ __forceinline__ unsigned pk2(float lo, float hi) { const f32x2 v = {lo, hi}; return __builtin_bit_cast(unsigned, __builtin_convertvector(v, bf16x2_t)); }
__device__ __forceinline__ float bf2f(unsigned short b) { return __builtin_bit_cast(float, (unsigned)b << 16); }
__device__ __forceinline__ float bflo(unsigned w) { return __builtin_bit_cast(float, w << 16); }
__device__ __forceinline__ float bfhi(unsigned w) { return __builtin_bit_cast(float, w & 0xffff0000u); }
__device__ __forceinline__ float shx(float v, int m, int lane) { return __int_as_float(__builtin_amdgcn_ds_bpermute((lane ^ m) << 2, __float_as_int(v))); }
__device__ __forceinline__ float wave_sum(float v, int lane) {
#pragma unroll
    for (int o = 1; o < 64; o <<= 1) v += shx(v, o, lane);
    return v;
}
__device__ __forceinline__ float sigmoidf_(float x) { return __builtin_amdgcn_rcpf(1.0f + __builtin_amdgcn_exp2f(-1.4426950408889634f * x)); }
__device__ __forceinline__ float siluf_(float x) { return x * __builtin_amdgcn_rcpf(1.0f + __builtin_amdgcn_exp2f(-1.4426950408889634f * x)); }
__device__ __forceinline__ void unpack8(u32x4 w, float* f) { f[0] = bflo(w.x); f[1] = bfhi(w.x); f[2] = bflo(w.y); f[3] = bfhi(w.y); f[4] = bflo(w.z); f[5] = bfhi(w.z); f[6] = bflo(w.w); f[7] = bfhi(w.w); }
__device__ __forceinline__ u32x4 pack8(const float* f) { u32x4 w; w.x = pk2(f[0], f[1]); w.y = pk2(f[2], f[3]); w.z = pk2(f[4], f[5]); w.w = pk2(f[6], f[7]); return w; }

namespace pg8 {
constexpr int BM = 256, BK = 64, HALF = 128, HTB = HALF * BK * 2, STAGE_BYTES = 8 * HTB, NXCD = 8, WGM = 4;
__host__ __device__ __forceinline__ int lds_byte(int r, int c) { const int st = (r >> 4) * 2 + (c >> 5), rr = r & 15, cc = c & 31, ob = rr * 64 + cc * 2; return st * 1024 + (ob ^ (((ob >> 9) & 1) << 5)); }
__host__ __device__ __forceinline__ void stage_rc(int b, int& R, int& C) { const int st = b / 1024, sb = b % 1024, swz = sb ^ (((sb >> 9) & 1) << 5); R = (st >> 1) * 16 + swz / 64; C = (st & 1) * 32 + (swz % 64) / 2; }
__host__ __device__ __forceinline__ int perm32(int rho) { const int n = rho >> 4, i = rho & 15; return 8 * (i >> 2) + 4 * n + (i & 3); }

struct Seg { const char* A; const char* B; int nt; int pm, pn, aux; bool first, last; };

__device__ __forceinline__ void tile_order(int L, int nM, int nN, int& pm, int& pn) {
    const int nwg = nM * nN; int wgid = L;
    { const int q = nwg / NXCD, r = nwg % NXCD, xcd = wgid % NXCD, off = wgid / NXCD; wgid = (xcd < r ? xcd * (q + 1) : r * (q + 1) + (xcd - r) * q) + off; }
    const int nig = WGM * nN, gid = wgid / nig, fm = gid * WGM, gsz = (nM - fm) < WGM ? (nM - fm) : WGM;
    pm = fm + ((wgid % nig) % gsz); pn = (wgid % nig) / gsz;
}

template <int LDA, int LDB, bool PERM, bool GATHER = false, class Sched, class Epi>
__device__ __forceinline__ void gemm_phase(LAS unsigned char* lds, const Sched& S, const Epi& E) {
    int tid_ = threadIdx.x; asm volatile("" : "+v"(tid_));
    const int tid = tid_, wid = __builtin_amdgcn_readfirstlane(tid >> 6), lane = tid & 63, wr = wid >> 2, wc = wid & 3, fr = lane & 15, fq = lane >> 4;
    unsigned vcur[2][2], vnxt[2][2], voffB[2]; int RA[2], CA[2];
    constexpr size_t kstep = (size_t)(BK * 2);
    constexpr size_t hstepA = (size_t)HALF * LDA * 2, hstepB = (size_t)HALF * LDB * 2;
#pragma unroll
    for (int i = 0; i < 2; ++i) { int R, C; stage_rc(tid * 16 + i * 8192, R, C); const int Rb = PERM ? ((R & ~31) + perm32(R & 31)) : R; RA[i] = R; CA[i] = C;
        vcur[0][i] = (unsigned)(R * LDA + C) * 2u; vcur[1][i] = vcur[0][i] + (unsigned)hstepA; voffB[i] = (unsigned)(Rb * LDB + C) * 2u; }
    if constexpr (GATHER) {
#pragma unroll
        for (int h = 0; h < 2; ++h)
#pragma unroll
            for (int i = 0; i < 2; ++i) vcur[h][i] = S.aoff(0, h * HALF + RA[i]) + (unsigned)CA[i] * 2u; }
#pragma unroll
    for (int h = 0; h < 2; ++h)
#pragma unroll
        for (int i = 0; i < 2; ++i) vnxt[h][i] = vcur[h][i];
    const unsigned ldsw = (unsigned)wid * 1024u;
    const int aoff = lds_byte(wr * 64 + fr, fq * 8), boff = lds_byte(wc * 32 + fr, fq * 8);
#define PG8_SA(b, h) (((b) * 2 + (h)) * HTB)
#define PG8_SB(b, h) ((4 + (b) * 2 + (h)) * HTB)
#define PG8_STAGE(bufoff, gbase, voff) do { _Pragma("unroll") for (int _i = 0; _i < 2; ++_i) \
        __builtin_amdgcn_global_load_lds((const unsigned*)((const char*)(gbase) + (voff)[_i]), (LAS unsigned*)(lds + (bufoff) + ldsw + _i * 8192), 16, 0, 0); } while (0)
#define PG8_LDA(dst, b, h) do { _Pragma("unroll") for (int m = 0; m < 4; ++m) _Pragma("unroll") for (int k = 0; k < 2; ++k) dst[m][k] = *(const LAS bf16x8*)(lds + PG8_SA(b, h) + aoff + m * 2048 + k * 1024); } while (0)
#define PG8_LDB(dst, b, h) do { _Pragma("unroll") for (int n = 0; n < 2; ++n) _Pragma("unroll") for (int k = 0; k < 2; ++k) dst[n][k] = *(const LAS bf16x8*)(lds + PG8_SB(b, h) + boff + n * 2048 + k * 1024); } while (0)
#define PG8_MMA(ai, bj, At, Bt) do { __builtin_amdgcn_s_setprio(1); _Pragma("unroll") for (int m = 0; m < 4; ++m) _Pragma("unroll") for (int n = 0; n < 2; ++n) _Pragma("unroll") for (int k = 0; k < 2; ++k) \
        acc[ai][bj][m][n] = __builtin_amdgcn_mfma_f32_16x16x32_bf16(Bt[n][k], At[m][k], acc[ai][bj][m][n], 0, 0, 0); __builtin_amdgcn_s_setprio(0); } while (0)
#define PG8_WAIT_V(n) asm volatile("s_waitcnt vmcnt(" #n ")" ::: "memory")
#define PG8_WAIT_L(n) asm volatile("s_waitcnt lgkmcnt(" #n ")" ::: "memory")
#define PG8_BAR __builtin_amdgcn_s_barrier()
#define PG8_SCHED __builtin_amdgcn_sched_barrier(0)
    Seg cur, nxt; int ui = 0;
    if (!S.next(0, cur)) return;
    f32x4 acc[2][2][4][2];
#pragma unroll
    for (int a = 0; a < 2; ++a)
#pragma unroll
        for (int b = 0; b < 2; ++b)
#pragma unroll
            for (int m = 0; m < 4; ++m)
#pragma unroll
                for (int n = 0; n < 2; ++n) acc[a][b][m][n] = (f32x4){0.f, 0.f, 0.f, 0.f};
    bf16x8 At[4][2], B0[2][2], B1[2][2];
    const char* cA = cur.A; const char* cB = cur.B;
    PG8_STAGE(PG8_SB(0, 0), cB, voffB); PG8_STAGE(PG8_SB(0, 1), cB + hstepB, voffB); PG8_STAGE(PG8_SA(0, 0), cA, vcur[0]); PG8_STAGE(PG8_SA(0, 1), cA, vcur[1]);
    if (wr == 1) PG8_BAR;
    PG8_WAIT_V(2); PG8_BAR;
    PG8_STAGE(PG8_SB(1, 0), cB + kstep, voffB); PG8_STAGE(PG8_SA(1, 0), cA + kstep, vcur[0]); PG8_STAGE(PG8_SB(1, 1), cB + hstepB + kstep, voffB);
    PG8_WAIT_V(6); PG8_BAR;
    for (;;) {
        const bool has_next = S.next(ui + 1, nxt);
        const char* nA = has_next ? nxt.A : cA; const char* nB = has_next ? nxt.B : cB;
        if constexpr (GATHER) {
#pragma unroll
            for (int h = 0; h < 2; ++h)
#pragma unroll
                for (int i = 0; i < 2; ++i) vnxt[h][i] = has_next ? S.aoff(ui + 1, h * HALF + RA[i]) + (unsigned)CA[i] * 2u : vcur[h][i]; }
        const int nt = cur.nt;
        for (int t = 0; t < nt; t += 2) {
            const bool last = (t == nt - 2);
            unsigned v2[2][2];
#pragma unroll
            for (int h = 0; h < 2; ++h)
#pragma unroll
                for (int i = 0; i < 2; ++i) v2[h][i] = (GATHER && last) ? vnxt[h][i] : vcur[h][i];
            const char* a1 = cA + (size_t)(t + 1) * kstep;
            const char* a2 = last ? nA : cA + (size_t)(t + 2) * kstep; const char* b2 = last ? nB : cB + (size_t)(t + 2) * kstep;
            const char* a3 = a2 + kstep; const char* b3 = b2 + kstep;
            PG8_LDB(B0, 0, 0); PG8_LDB(B1, 0, 1); PG8_SCHED; PG8_LDA(At, 0, 0); PG8_STAGE(PG8_SA(1, 1), a1, vcur[1]);
            PG8_WAIT_V(8); PG8_WAIT_L(0); PG8_BAR; PG8_MMA(0, 0, At, B0); PG8_MMA(0, 1, At, B1); PG8_BAR; PG8_SCHED;
            PG8_LDA(At, 0, 1); PG8_STAGE(PG8_SB(0, 0), b2, voffB); PG8_STAGE(PG8_SB(0, 1), b2 + hstepB, voffB); PG8_STAGE(PG8_SA(0, 0), a2, v2[0]);
            PG8_WAIT_V(8); PG8_WAIT_L(0); PG8_BAR; PG8_MMA(1, 0, At, B0); PG8_MMA(1, 1, At, B1); PG8_BAR; PG8_SCHED;
            PG8_LDB(B0, 1, 0); PG8_LDB(B1, 1, 1); PG8_SCHED; PG8_LDA(At, 1, 0); PG8_STAGE(PG8_SA(0, 1), a2, v2[1]);
            PG8_WAIT_V(8); PG8_WAIT_L(0); PG8_BAR; PG8_MMA(0, 0, At, B0); PG8_MMA(0, 1, At, B1); PG8_BAR; PG8_SCHED;
            PG8_LDA(At, 1, 1); PG8_STAGE(PG8_SB(1, 0), b3, voffB); PG8_STAGE(PG8_SB(1, 1), b3 + hstepB, voffB); PG8_STAGE(PG8_SA(1, 0), a3, v2[0]);
            PG8_WAIT_V(8); PG8_WAIT_L(0); PG8_BAR; PG8_MMA(1, 0, At, B0); PG8_MMA(1, 1, At, B1); PG8_BAR; PG8_SCHED;
        }
        const bool was_last = cur.last;
        if (was_last) { if (wr == 0) PG8_BAR; E(acc, cur, wr, wc, fr, fq); }
        if (!has_next) break;
        if (nxt.first) {
#pragma unroll
            for (int a = 0; a < 2; ++a)
#pragma unroll
                for (int b = 0; b < 2; ++b)
#pragma unroll
                    for (int m = 0; m < 4; ++m)
#pragma unroll
                        for (int n = 0; n < 2; ++n) acc[a][b][m][n] = (f32x4){0.f, 0.f, 0.f, 0.f};
        }
        cur = nxt; cA = nA; cB = nB; ++ui;
        if constexpr (GATHER) {
#pragma unroll
            for (int h = 0; h < 2; ++h)
#pragma unroll
                for (int i = 0; i < 2; ++i) vcur[h][i] = vnxt[h][i]; }
        if (was_last) { if (wr == 1) PG8_BAR; }
    }
    PG8_WAIT_V(0);
    PG8_BAR;
#undef PG8_SA
#undef PG8_SB
#undef PG8_STAGE
#undef PG8_LDA
#undef PG8_LDB
#undef PG8_MMA
#undef PG8_WAIT_V
#undef PG8_WAIT_L
#undef PG8_BAR
#undef PG8_SCHED
}
}
using pg8::Seg;

struct Ctx {
    LAS unsigned char* lds; int tid, lane, wave, G, bid;
};
typedef const __attribute__((address_space(4))) Params* PP;
__device__ __forceinline__ PP getpp() { PP p = (PP)__builtin_amdgcn_kernarg_segment_ptr(); asm volatile("" : "+s"(p)); return p; }
__device__ __forceinline__ unsigned char* half_a_base(int layer) { (void)layer; PP p = getpp(); return (unsigned char*)p->out; }
__device__ __forceinline__ bf16_t* h0_base() { PP p = getpp(); return (bf16_t*)((unsigned char*)p->out + 64 * MiB); }
__device__ __forceinline__ f32x4 ldh4(const bf16_t* p) { const u32x2 w = *(const u32x2*)p; return (f32x4){bflo(w.x), bfhi(w.x), bflo(w.y), bfhi(w.y)}; }
#define GW(F) ((F).bid * 8 + (F).wave)
#define NGW(F) ((F).G * 8)
#define LDS_WAIT() asm volatile("s_waitcnt lgkmcnt(0)" ::: "memory")

struct TrJob {
    const float* s0; const float* s1; int spitch; int K; int nd; int mode; int c0; int nvalid; const float* ks;
    bf16_t* dlo; bf16_t* dhi; int dpitch; int ksplit;
};
__device__ __forceinline__ void tr_load(const TrJob& J, int item, int lane, float* v, bool& valid) {
    const int nblk = J.nd / 32, kb = item / nblk, nb = item % nblk, k0 = 64 * kb, n0 = 32 * nb;
    const int np = n0 + (lane & 31);
    const float* src = J.s0; int col = 0; valid = true;
    if (J.mode == 0) { col = J.c0 + np; valid = np < J.nvalid; }
    else if (J.mode == 1) { if (np < 512) col = (np >> 6) * 128 + (np & 63); else col = ((np - 512) >> 6) * 128 + 64 + (np & 63); }
    else { const int tile = np >> 8, w = np & 255; if (w < 128) col = tile * 128 + w; else { col = tile * 128 + (w - 128); src = J.s1; } }
    if (!valid) col = J.c0;
    const float* sp = src + (size_t)(k0 + (lane >> 5)) * J.spitch + col;
#pragma unroll
    for (int i = 0; i < 32; ++i) v[i] = __builtin_nontemporal_load(sp + (size_t)(2 * i) * J.spitch);
    if (J.ks) {
#pragma unroll
        for (int i = 0; i < 32; ++i) v[i] *= J.ks[k0 + 2 * i + (lane >> 5)]; }
}
__device__ __forceinline__ void tr_store(const TrJob& J, LAS float* scr, int item, int lane, const float* v, bool valid) {
    const int nblk = J.nd / 32, kb = item / nblk, nb = item % nblk, k0 = 64 * kb, n0 = 32 * nb;
#pragma unroll
    for (int i = 0; i < 32; ++i) scr[(2 * i + (lane >> 5)) * 33 + (lane & 31)] = valid ? v[i] : 0.f;
    LDS_WAIT(); asm volatile("" ::: "memory");
    const int c = lane & 7;
    bf16_t* dst = (k0 < J.ksplit) ? J.dlo : J.dhi; const int kd = (k0 < J.ksplit) ? k0 : k0 - J.ksplit;
#pragma unroll
    for (int j = 0; j < 4; ++j) { const int n = (lane >> 3) + 8 * j; const LAS float* s = scr + (8 * c) * 33 + n;
        u32x4 o; o.x = pk2(s[0 * 33], s[1 * 33]); o.y = pk2(s[2 * 33], s[3 * 33]); o.z = pk2(s[4 * 33], s[5 * 33]); o.w = pk2(s[6 * 33], s[7 * 33]);
        *(u32x4*)(dst + (size_t)(n0 + n) * J.dpitch + kd + 8 * c) = o; }
    LDS_WAIT(); asm volatile("" ::: "memory");
}
__device__ __forceinline__ void tr_job_sub(const Ctx& F, const TrJob& J, int& rot, int b0, int nb) {
    LAS float* scr = (LAS float*)(F.lds + F.wave * 8704);
    const int nitems = (J.K / 64) * (J.nd / 32); const int ngw = nb * 8;
    int it = ((F.bid - b0) * 8 + F.wave - rot % ngw); if (it < 0) it += ngw;
    rot += nitems;
    if (F.bid < b0 || F.bid >= b0 + nb || it >= nitems) return;
    float v[32]; bool valid; tr_load(J, it, F.lane, v, valid);
    for (;;) {
        const int nx = it + ngw; const bool more = nx < nitems; float vn[32]; bool validn = false;
        if (more) tr_load(J, nx, F.lane, vn, validn);
        tr_store(J, scr, it, F.lane, v, valid);
        if (!more) break;
#pragma unroll
        for (int i = 0; i < 32; ++i) v[i] = vn[i];
        valid = validn; it = nx;
    }
}
__device__ __forceinline__ void tr_job(const Ctx& F, const TrJob& J, int& rot) { tr_job_sub(F, J, rot, 0, F.G); }
__device__ __forceinline__ TrJob mk_job(const float* s0, int spitch, int K, int nd, int c0, int nvalid, bf16_t* dst, int dpitch) {
    TrJob J; J.s0 = s0; J.s1 = nullptr; J.spitch = spitch; J.K = K; J.nd = nd; J.mode = 0; J.c0 = c0; J.nvalid = nvalid; J.ks = nullptr; J.dlo = dst; J.dhi = dst; J.dpitch = dpitch; J.ksplit = 1 << 30; return J;
}

__device__ __forceinline__ void layer_weights(const Ctx& F, int l, int& rot, int b0, int nb) {
    PP P = getpp(); unsigned char* ws = P->ws;
        unsigned char* wb = ws + WS_W + (size_t)l * WL_STRIDE;
        const float* win = P->in[I_WIN] + (size_t)l * 1024 * NIN;
        { TrJob J = mk_job(win, NIN, 1024, MIXP, 0, MIXC, (bf16_t*)(wb + WL_WINLO), 512); J.dhi = (bf16_t*)(wb + WL_WINHI); J.ksplit = 512; tr_job_sub(F, J, rot, b0, nb); }
        { TrJob J = mk_job(win, NIN, 1024, GATEC, MIXC, GATEC, (bf16_t*)(wb + WL_WGLO), 512); J.dhi = (bf16_t*)(wb + WL_WGHI); J.ksplit = 512; tr_job_sub(F, J, rot, b0, nb); }
        { TrJob J = mk_job(P->in[I_QUP] + (size_t)l * 384 * 768, 768, 384, 768, 0, 768, (bf16_t*)(wb + WL_WQ), 384); J.ks = P->in[I_QN] + l * 384; tr_job_sub(F, J, rot, b0, nb); }
        { TrJob J = mk_job(P->in[I_KVUP] + (size_t)l * 256 * 1024, 1024, 256, 1024, 0, 1024, (bf16_t*)(wb + WL_WKV), 256); J.mode = 1; J.ks = P->in[I_KVN] + l * 256; tr_job_sub(F, J, rot, b0, nb); }
        for (int n = 0; n < 3; ++n) { TrJob J = mk_job(P->in[I_WBR] + ((size_t)l * 3 + n) * 512 * 1024, 1024, 512, 1024, 0, 1024, (bf16_t*)(wb + WL_WB) + (size_t)n * 1024 * 512, 512); tr_job_sub(F, J, rot, b0, nb); }
        { TrJob J = mk_job(P->in[I_WOUT] + (size_t)l * 1024 * 1024, 1024, 1024, 1024, 0, 1024, (bf16_t*)(wb + WL_WO), 1024); tr_job_sub(F, J, rot, b0, nb); }
        { TrJob J = mk_job(P->in[I_G2] + (size_t)l * 128 * 512, 512, 128, 512, 0, 512, (bf16_t*)(ws + WS_WG2) + (size_t)l * 512 * 128, 128); tr_job_sub(F, J, rot, b0, nb); }
        for (int dd = 0; dd < 2; ++dd) {
            { TrJob J = mk_job(P->in[I_W2] + (size_t)(l * 2 + dd) * 64 * 512, 512, 64, 512, 0, 512, (bf16_t*)(ws + WS_W2T) + (size_t)((l * 2 + dd) * 2 + 0) * 512 * 64, 64); tr_job_sub(F, J, rot, b0, nb); }
            { TrJob J = mk_job(P->in[I_A2] + (size_t)(l * 2 + dd) * 64 * 512, 512, 64, 512, 0, 512, (bf16_t*)(ws + WS_W2T) + (size_t)((l * 2 + dd) * 2 + 1) * 512 * 64, 64); tr_job_sub(F, J, rot, b0, nb); }
        }
}
__device__ __forceinline__ void phase0(const Ctx& F) {
    PP P = getpp(); unsigned char* ws = P->ws;
    {
        float* cr = (float*)(ws + WS_ROPE_R); float* sr = cr + 4096 * 32; float* cm = (float*)(ws + WS_ROPE_M); float* sm = cm + 4096 * 16;
        for (int i = F.bid * NTHREADS + F.tid; i < 4096 * 48; i += F.G * NTHREADS) {
            const int t = i / 48, j = i % 48; const float row = (float)(t >> 6), colp = (float)(t & 63);
            if (j < 32) { const int f = j & 15; const float inv = powf(10000.0f, -(float)f / 16.0f); const float ang = (j < 16 ? row : colp) * inv; cr[t * 32 + j] = cosf(ang); sr[t * 32 + j] = sinf(ang); }
            else { const int jj = j - 32, f = jj & 7; const float inv = powf(10000.0f, -(float)f / 8.0f); const float ang = (jj < 8 ? row : colp) * inv; cm[t * 16 + jj] = cosf(ang); sm[t * 16 + jj] = sinf(ang); }
        }
        if (F.bid == 0 && F.tid < 64) ((unsigned*)(ws + WS_CTL))[F.tid] = 0u;
    }
    {
        LAS float* sc = (LAS float*)(F.lds + 70000);
        LAS float* red = (LAS float*)(F.lds + 70000 + 36864);
        for (int i = F.tid; i < 9 * 1024; i += NTHREADS) { const int v = i >> 10, k = i & 1023; const float x = v < 8 ? P->in[I_C][v * 1024 + k] : P->in[I_CCTX][k]; sc[i] = siluf_(x); }
        __syncthreads();
        for (int it = F.bid; it < 2 * 96; it += F.G) {
            const int l = it / 96, jc = F.tid & 63, j = (it % 96) * 64 + jc, ksl = F.tid >> 6;
            const float* w = P->in[I_WMOD] + (size_t)l * 1024 * 6144 + j + (size_t)(ksl * 128) * 6144;
            float a[9];
#pragma unroll
            for (int v = 0; v < 9; ++v) a[v] = 0.f;
#pragma unroll 1
            for (int k0 = 0; k0 < 128; k0 += 32) { float wv[32];
#pragma unroll
                for (int q = 0; q < 32; ++q) wv[q] = w[(size_t)(k0 + q) * 6144];
                __builtin_amdgcn_sched_barrier(0);
#pragma unroll
                for (int qh = 0; qh < 32; qh += 16) {
#pragma unroll
                    for (int q = qh; q < qh + 16; ++q)
#pragma unroll
                        for (int v = 0; v < 9; ++v) a[v] += sc[v * 1024 + ksl * 128 + k0 + q] * wv[q];
                    __builtin_amdgcn_sched_barrier(0); } }
#pragma unroll
            for (int v = 0; v < 9; ++v) red[(ksl * 64 + jc) * 9 + v] = a[v];
            __syncthreads();
            if (F.tid < 64) {
                float* mo = (float*)(ws + WS_MOD) + (size_t)l * 9 * 6144;
#pragma unroll
                for (int v = 0; v < 9; ++v) { float s = 0.f;
#pragma unroll
                    for (int q = 0; q < 8; ++q) s += red[(q * 64 + F.tid) * 9 + v];
                    mo[v * 6144 + j] = s + P->in[I_BMOD][l * 6144 + j]; }
            }
            __syncthreads();
        }
    }
    int rot = (192 * 8) % NGW(F);
    layer_weights(F, 0, rot, 0, F.G);
}
__device__ __forceinline__ void convert_ffn0(const Ctx& F, int b0, int nb) {
    PP P = getpp(); unsigned char* ws = P->ws;
    bf16_t* glo = (bf16_t*)(ws + D_FFW); bf16_t* ghi = glo + (size_t)5632 * 512; bf16_t* wd = ghi + (size_t)5632 * 512;
    int rot = 0;
    { TrJob J = mk_job(P->in[I_FG], DFF, 1024, 5632, 0, 5632, glo, 512); J.s1 = P->in[I_FU]; J.mode = 2; J.dhi = ghi; J.ksplit = 512; tr_job_sub(F, J, rot, b0, nb); }
    { TrJob J = mk_job(P->in[I_FD], 1024, DFF, 1024, 0, 1024, wd, DFF); tr_job_sub(F, J, rot, b0, nb); }
}
__device__ __forceinline__ void convert_moe(const Ctx& F) {
    PP P = getpp(); unsigned char* ws = P->ws;
    int rot = 0;
    for (int e = 0; e < NEXP; ++e) {
        bf16_t* glo = (bf16_t*)(ws + D_MOEW + (size_t)e * (33 * MiB / 4)); bf16_t* ghi = glo + (size_t)2816 * 512; bf16_t* wd = ghi + (size_t)2816 * 512;
        { TrJob J = mk_job(P->in[I_MG] + (size_t)e * 1024 * DFE, DFE, 1024, 2816, 0, 2816, glo, 512); J.s1 = P->in[I_MU2] + (size_t)e * 1024 * DFE; J.mode = 2; J.dhi = ghi; J.ksplit = 512; tr_job(F, J, rot); }
    }
}
__device__ __forceinline__ void convert_moe_down(const Ctx& F, int b0, int nb) {
    PP P = getpp(); unsigned char* ws = P->ws; int rot = 0;
    for (int e = 0; e < NEXP; ++e) {
        bf16_t* wd = (bf16_t*)(ws + D_MOEW + (size_t)e * (33 * MiB / 4)) + (size_t)2 * 2816 * 512;
        { TrJob J = mk_job(P->in[I_MD] + (size_t)e * DFE * 1024, 1024, DFE, 1024, 0, 1024, wd, DFE); tr_job_sub(F, J, rot, b0, nb); }
    }
}

__device__ __forceinline__ void norm_pass(const Ctx& F, int layer, int which, const float* hl, const bf16_t* hb, const float* hcx, int nrows, bf16_t* xlo, bf16_t* xhi, bool ctxpart = false) {
    PP P = getpp();
    const float* gain = P->in[which ? I_NFFN : I_NMIX] + layer * 1024;
    const float* mod = (const float*)(P->ws + WS_MOD) + (size_t)layer * 9 * 6144 + (which ? 3072 : 0);
    const float* part = (const float*)(P->ws + D_PART); const float* g2c = (const float*)(P->ws + WS_MOD) + 8 * 6144 + 5120;
    const int rpw = (nrows + NGW(F) - 1) / NGW(F); const int r0 = GW(F) * rpw; const int r1 = (r0 + rpw < nrows) ? r0 + rpw : nrows;
    const bool dealt = ctxpart && NGW(F) == 2048 && nrows == RT;
    int vprev = -1; f32x4 gs[4], sh4[4];
    constexpr int NB = 4;
#define NP_LOAD(X_, RWS_, rb_) do { _Pragma("unroll") for (int b = 0; b < NB; ++b) { const int v_ = ((rb_) + b < r1) ? (rb_) + b : r1 - 1; \
            const int row_ = dealt ? ((v_ % 17) < 16 ? (v_ / 17) * 16 + (v_ % 17) : RL + v_ / 17) : v_; RWS_[b] = row_; \
            if (hb != nullptr && row_ < RL) { _Pragma("unroll") for (int j = 0; j < 4; ++j) X_[b][j] = ldh4(hb + (size_t)row_ * 1024 + 4 * F.lane + 256 * j); } \
            else { const float* src_ = row_ < RL ? hl + (size_t)row_ * 1024 : hcx + (size_t)(row_ - RL) * 1024; \
                _Pragma("unroll") for (int j = 0; j < 4; ++j) X_[b][j] = *(const f32x4*)(src_ + 4 * F.lane + 256 * j); } \
            if (ctxpart && row_ >= RL) { \
                _Pragma("unroll") for (int j = 0; j < 4; ++j) { const int c_ = 4 * F.lane + 256 * j; const float* pp_ = part + (size_t)(row_ - RL) * 1024 + c_; \
                    const f32x4 s4_ = ((*(const f32x4*)pp_ + *(const f32x4*)(pp_ + (size_t)RC * 1024)) + *(const f32x4*)(pp_ + (size_t)2 * RC * 1024)) + *(const f32x4*)(pp_ + (size_t)3 * RC * 1024); \
                    X_[b][j] = X_[b][j] + *(const f32x4*)(g2c + c_) * s4_; } } } } while (0)
    f32x4 x[NB][4], xn[NB][4]; int rows[NB], rowsn[NB];
    if (r0 < r1) NP_LOAD(x, rows, r0);
    for (int rb = r0; rb < r1; rb += NB) {
        float ss[NB]; const bool more = rb + NB < r1;
        if (more) NP_LOAD(xn, rowsn, rb + NB);
#pragma unroll
        for (int b = 0; b < NB; ++b) { ss[b] = 0.f;
#pragma unroll
            for (int j = 0; j < 4; ++j) ss[b] += x[b][j].x * x[b][j].x + x[b][j].y * x[b][j].y + x[b][j].z * x[b][j].z + x[b][j].w * x[b][j].w; }
#pragma unroll
        for (int b = 0; b < NB; ++b) ss[b] = wave_sum(ss[b], F.lane);
#pragma unroll
        for (int b = 0; b < NB; ++b) { const int row = rows[b];
            const int v = row < RL ? (row >> 12) : 8;
            if (v != vprev) { const float* sh = mod + v * 6144; const float* sc = sh + 1024;
#pragma unroll
                for (int j = 0; j < 4; ++j) { const int c = 4 * F.lane + 256 * j; gs[j] = *(const f32x4*)(gain + c) * (*(const f32x4*)(sc + c) + 1.0f); sh4[j] = *(const f32x4*)(sh + c); }
                vprev = v; }
            const float rstd = rsqrtf(ss[b] * (1.0f / 1024.0f) + 1e-6f);
#pragma unroll
            for (int j = 0; j < 4; ++j) { const int c = 4 * F.lane + 256 * j;
                const f32x4 y = x[b][j] * rstd * gs[j] + sh4[j];
                u32x2 o; o.x = pk2(y.x, y.y); o.y = pk2(y.z, y.w);
                bf16_t* d = (c < 512) ? xlo + (size_t)row * 512 + c : xhi + (size_t)row * 512 + (c - 512);
                *(u32x2*)d = o; } }
        if (more) {
#pragma unroll
            for (int b = 0; b < NB; ++b) { rows[b] = rowsn[b];
#pragma unroll
                for (int j = 0; j < 4; ++j) x[b][j] = xn[b][j]; } }
    }
#undef NP_LOAD
}

struct SchedSplit2 {
    const char *Alo, *Ahi, *Blo, *Bhi; int nM, nN, G, c; bool skipc;
    __device__ __forceinline__ bool next(int i, Seg& s) const {
        const int iu = i >> 1, h = i & 1; const long L = (long)iu * G + c;
        const int nlat = skipc ? (nM - 8) * nN : nM * nN, ntot = skipc ? nlat + 8 * (nN - 1) : nlat;
        if (L >= (long)ntot) return false;
        int pm, pn;
        if (L < nlat) pg8::tile_order((int)L, skipc ? nM - 8 : nM, nN, pm, pn); else { pg8::tile_order((int)L - nlat, 8, nN - 1, pm, pn); pm += nM - 8; }
        s.A = (h ? Ahi : Alo) + (size_t)pm * 256 * 1024; s.B = (h ? Bhi : Blo) + (size_t)pn * 256 * 1024; s.nt = 8; s.pm = pm; s.pn = pn; s.aux = 0; s.first = (h == 0); s.last = (h == 1); return true;
    }
};
struct Sched1 {
    const char *A, *B; size_t astride, bstride; int nt, nM, nN, G, c;
    __device__ __forceinline__ bool next(int i, Seg& s) const {
        const long L = (long)i * G + c; if (L >= (long)nM * nN) return false;
        int pm, pn; pg8::tile_order((int)L, nM, nN, pm, pn);
        s.A = A + (size_t)pm * astride; s.B = B + (size_t)pn * bstride; s.nt = nt; s.pm = pm; s.pn = pn; s.aux = 0; s.first = true; s.last = true; return true;
    }
};
struct SchedDown0 {
    const char *A, *B; int G, c;
    __device__ __forceinline__ bool next(int i, Seg& s) const {
        const long L = (long)i * G + c; s.first = true; s.last = true;
        if (L < 512) { int pm, pn; pg8::tile_order((int)L, RL / 256, 4, pm, pn);
            s.A = A + (size_t)pm * 256 * DFF * 2; s.B = B + (size_t)pn * 256 * DFF * 2; s.nt = 44; s.pm = pm; s.pn = pn; s.aux = 0; return true; }
        const int q = (int)L - 512; if (q >= 128) return false;
        const int tile = q >> 2, sl = q & 3, pmc = tile & 7, pn = tile >> 3; const int k0 = sl < 2 ? 12 * sl : 24 + 10 * (sl - 2);
        s.A = A + (size_t)(RL / 256 + pmc) * 256 * DFF * 2 + (size_t)k0 * 128; s.B = B + (size_t)pn * 256 * DFF * 2 + (size_t)k0 * 128;
        s.nt = sl < 2 ? 12 : 10; s.pm = RL / 256 + pmc; s.pn = pn; s.aux = 1 + sl; return true;
    }
};
struct SchedHalf {
    const char *A, *B; size_t astride, bstride; int nt, nN, half, G, c;
    __device__ __forceinline__ bool next(int i, Seg& s) const {
        const long L = (long)i * G + c; if (L >= (long)68 * nN) return false;
        int mi, pn; pg8::tile_order((int)L, 68, nN, mi, pn);
        const int pm = mi < 64 ? 64 * half + mi : 128 + 4 * half + (mi - 64);
        s.A = A + (size_t)pm * astride; s.B = B + (size_t)pn * bstride; s.nt = nt; s.pm = pm; s.pn = pn; s.aux = 0; s.first = true; s.last = true; return true;
    }
};
struct SchedMerge {
    const char *XNlo, *XNhi, *WgLo, *WgHi, *wsb, *Wb; int nM, G, c; bool ctx3;
    __device__ __forceinline__ void fill(Seg& s, int pm, int pn, int n, int k, int ctxbit) const {
        s.pm = pm; s.pn = pn; s.nt = 8;
        if (k == 0) { s.A = XNlo + (size_t)pm * 256 * 1024; s.B = WgLo + (size_t)(n * 1024 + pn * 256) * 1024; s.first = true; s.last = false; s.aux = n * 2; }
        else if (k == 1) { s.A = XNhi + (size_t)pm * 256 * 1024; s.B = WgHi + (size_t)(n * 1024 + pn * 256) * 1024; s.first = false; s.last = true; s.aux = n * 2; }
        else { const size_t yo = (n == 0) ? D_YRWKV : ((n == 1) ? D_YRET : D_YMLA); s.A = wsb + yo + (size_t)pm * 256 * 1024; s.B = Wb + (size_t)(n * 1024 + pn * 256) * 1024; s.first = true; s.last = true; s.aux = n * 2 + 1 + ctxbit; }
    }
    __device__ __forceinline__ bool next(int i, Seg& s) const {
        const int nMl = ctx3 ? RL / 256 : nM; const int NL = nMl * 4;
        const int kmax = (NL - c + G - 1) / G;
        if (i < 9 * kmax) { const int su = i / 9, r = i % 9; const long L = (long)su * G + c; int pm, pn; pg8::tile_order((int)L, nMl, 4, pm, pn); fill(s, pm, pn, r / 3, r % 3, 0); return true; }
        if (!ctx3) return false;
        const int j = i - 9 * kmax, t = j / 3, k = j % 3; const long idx = (long)t * G + c; if (idx >= 96) return false;
        const int tile = (int)idx / 3, n = (int)idx % 3; fill(s, RL / 256 + (tile & 7), tile >> 3, n, k, 8); return true;
    }
};
struct SchedWout0 {
    const char *A, *B, *wsb; int G, c;
    __device__ __forceinline__ bool next(int i, Seg& s) const {
        if (c < 32) { if (i >= 3) return false; const int pmc = c & 7, pn = c >> 3;
            const size_t ao = (i == 0) ? D_M + (size_t)RL * 1024 * 2 : ((i == 1) ? D_P12 : D_P12 + (size_t)RC * 1024 * 2);
            s.A = wsb + ao + (size_t)pmc * 256 * 1024 * 2; s.B = B + (size_t)pn * 256 * 1024 * 2; s.nt = 16; s.pm = RL / 256 + pmc; s.pn = pn; s.aux = 0; s.first = (i == 0); s.last = (i == 2); return true; }
        const long L = (long)i * (G - 32) + (c - 32); if (L >= (RL / 256) * 4) return false;
        int pm, pn; pg8::tile_order((int)L, RL / 256, 4, pm, pn);
        s.A = A + (size_t)pm * 256 * 1024 * 2; s.B = B + (size_t)pn * 256 * 1024 * 2; s.nt = 16; s.pm = pm; s.pn = pn; s.aux = 0; s.first = true; s.last = true; return true;
    }
};
struct MoeTiles { int tstart[NEXP + 1]; };
__device__ __forceinline__ MoeTiles moe_tiles(const unsigned* cnt) {
    MoeTiles T; int a = 0;
#pragma unroll
    for (int e = 0; e < NEXP; ++e) { T.tstart[e] = a; a += (int)((__builtin_amdgcn_readfirstlane(cnt[e]) + 255u) >> 8); }
    T.tstart[NEXP] = a; return T;
}
__device__ __forceinline__ int moe_expert_of(const MoeTiles& T, int mt) { int e = 0;
#pragma unroll
    for (int k = 1; k < NEXP; ++k) e += (mt >= T.tstart[k]) ? 1 : 0;
    return e; }
struct SchedMoeUp {
    const char *Alo, *Ahi, *W; MoeTiles T; int G, c;
    __device__ __forceinline__ bool next(int i, Seg& s) const {
        const int iu = i >> 1, h = i & 1; const int nM = T.tstart[NEXP]; const long L = (long)iu * G + c; if (L >= (long)nM * 11) return false;
        int pm, pn; pg8::tile_order((int)L, nM, 11, pm, pn);
        const int e = moe_expert_of(T, pm); const char* we = W + (size_t)e * (33 * MiB / 4);
        s.A = (h ? Ahi : Alo) + (size_t)pm * 256 * 1024; s.B = we + (h ? (size_t)2816 * 1024 : 0) + (size_t)pn * 256 * 1024; s.nt = 8; s.pm = pm; s.pn = pn; s.aux = e; s.first = (h == 0); s.last = (h == 1); return true;
    }
};
struct SchedMoeUpG {
    const char *Alo, *Ahi, *W; MoeTiles T; int G, c; LAS const int* tab;
    __device__ __forceinline__ bool next(int i, Seg& s) const {
        const int iu = i >> 1, h = i & 1; const int nM = T.tstart[NEXP]; const long L = (long)iu * G + c; if (L >= (long)nM * 11) return false;
        int pm, pn; pg8::tile_order((int)L, nM, 11, pm, pn);
        const int e = moe_expert_of(T, pm); const char* we = W + (size_t)e * (33 * MiB / 4);
        s.A = (h ? Ahi : Alo); s.B = we + (h ? (size_t)2816 * 1024 : 0) + (size_t)pn * 256 * 1024; s.nt = 8; s.pm = pm; s.pn = pn; s.aux = e; s.first = (h == 0); s.last = (h == 1); return true;
    }
    __device__ __forceinline__ unsigned aoff(int i, int r) const { return (unsigned)tab[(i >> 1) * 256 + r] * 1024u; }
};
constexpr int MOE_TAB_UNITS = 15;
__device__ __forceinline__ void moe_rowtab(const Ctx& F, const MoeTiles& T, const unsigned* cnt, const int* rmap, LAS int* tab) {
    const int nM = T.tstart[NEXP];
    for (int iu = 0; iu < MOE_TAB_UNITS; ++iu) { const long L = (long)iu * F.G + F.bid; if (L >= (long)nM * 11) break;
        int pm, pn; pg8::tile_order((int)L, nM, 11, pm, pn);
        const int e = moe_expert_of(T, pm); int ts = 0;
#pragma unroll
        for (int k = 0; k < 8; ++k) if (k == e) ts = T.tstart[k];
        if (F.tid < 256) { const int pos = (pm - ts) * 256 + F.tid; tab[iu * 256 + F.tid] = (pos < (int)cnt[e]) ? rmap[(size_t)e * RL + pos] : 0; } }
    __syncthreads();
}
struct SchedMoeDown {
    const char *A, *W; MoeTiles T; int G, c;
    __device__ __forceinline__ bool next(int i, Seg& s) const {
        const int nM = T.tstart[NEXP]; const long L = (long)i * G + c; if (L >= (long)nM * 4) return false;
        int pm, pn; pg8::tile_order((int)L, nM, 4, pm, pn);
        const int e = moe_expert_of(T, pm); const char* we = W + (size_t)e * (33 * MiB / 4) + (size_t)2 * 2816 * 1024;
        s.A = A + (size_t)pm * 256 * DFE * 2; s.B = we + (size_t)pn * 256 * DFE * 2; s.nt = 22; s.pm = pm; s.pn = pn; s.aux = e; s.first = true; s.last = true; return true;
    }
};

typedef f32x4 Acc[2][2][4][2];
struct EpiInproj {
    unsigned char* ws;
    __device__ __forceinline__ void operator()(const Acc& acc, const Seg& u, int wr, int wc, int fr, int fq) const {
        const int row0 = u.pm * 256 + wr * 64 + fr;
#pragma unroll
        for (int bj = 0; bj < 2; ++bj) {
            const int c0 = u.pn * 256 + bj * 128 + wc * 32 + 8 * fq;
            const bool a = c0 < RWC, b = c0 < RWC + REC;
            const size_t boff = a ? D_URWKV : (b ? D_URET : D_UMLA); const int pitch = a ? RWC : (b ? REC : MLC); const int col = c0 - (a ? 0 : (b ? RWC : RWC + REC));
            bf16_t* base = (bf16_t*)(ws + boff);
            if (c0 < MIXC) {
#pragma unroll
                for (int ai = 0; ai < 2; ++ai)
#pragma unroll
                    for (int m = 0; m < 4; ++m) { const int row = row0 + ai * 128 + m * 16; const f32x4 v0 = acc[ai][bj][m][0], v1 = acc[ai][bj][m][1];
                        u32x4 w; w.x = pk2(v0[0], v0[1]); w.y = pk2(v0[2], v0[3]); w.z = pk2(v1[0], v1[1]); w.w = pk2(v1[2], v1[3]);
                        *(u32x4*)(base + (size_t)row * pitch + col) = w; }
            }
        }
    }
};
struct EpiQup {
    bf16_t* Q; const float* rstd; const float* cosm; const float* sinm; int compact;
    __device__ __forceinline__ void operator()(const Acc& acc, const Seg& u, int wr, int wc, int fr, int fq) const {
        const int row0 = u.pm * 256 + wr * 64 + fr; const bool lat = u.pm * 256 < RL;
        const int cbA = u.pn * 256 + wc * 32; const bool ropeA = lat && ((cbA % 96) == 64), ropeB = lat && (((cbA + 128) % 96) == 64);
        float rsv[8]; f32x4 cs[8], sn[8];
#pragma unroll
        for (int r = 0; r < 8; ++r) rsv[r] = rstd[row0 + (r >> 2) * 128 + (r & 3) * 16];
        if (ropeA || ropeB) {
#pragma unroll
            for (int r = 0; r < 8; ++r) { const int t = (row0 + (r >> 2) * 128 + (r & 3) * 16) & 4095; cs[r] = *(const f32x4*)(cosm + t * 16 + 4 * fq); sn[r] = *(const f32x4*)(sinm + t * 16 + 4 * fq); }
        } else {
#pragma unroll
            for (int r = 0; r < 8; ++r) { cs[r] = (f32x4){1.f, 1.f, 1.f, 1.f}; sn[r] = (f32x4){0.f, 0.f, 0.f, 0.f}; }
        }
        __builtin_amdgcn_sched_barrier(0);
#pragma unroll
        for (int ai = 0; ai < 2; ++ai)
#pragma unroll
            for (int m = 0; m < 4; ++m) { const int row = row0 + ai * 128 + m * 16; const float rs = rsv[ai * 4 + m];
#pragma unroll
                for (int bj = 0; bj < 2; ++bj) { const int cb = cbA + bj * 128; const bool rope = bj ? ropeB : ropeA;
                    f32x4 x1 = acc[ai][bj][m][0] * rs, x2 = acc[ai][bj][m][1] * rs;
                    if (rope) { const f32x4 o1 = x1 * cs[ai * 4 + m] - x2 * sn[ai * 4 + m], o2 = x1 * sn[ai * 4 + m] + x2 * cs[ai * 4 + m]; x1 = o1; x2 = o2; }
                    u32x2 a, b; a.x = pk2(x1[0], x1[1]); a.y = pk2(x1[2], x1[3]); b.x = pk2(x2[0], x2[1]); b.y = pk2(x2[2], x2[3]);
                    const int orow = compact ? (lat ? row : row - RL + 4 * SEQ) : row;
                    bf16_t* d = Q + (size_t)orow * 768 + cb + 4 * fq; *(u32x2*)d = a; *(u32x2*)(d + 16) = b; } }
    }
};
struct EpiKVup {
    bf16_t *Kb, *Vb; const float* rstd; int compact;
    __device__ __forceinline__ void operator()(const Acc& acc, const Seg& u, int wr, int wc, int fr, int fq) const {
        const int row0 = u.pm * 256 + wr * 64 + fr;
        float rsv[8];
#pragma unroll
        for (int r = 0; r < 8; ++r) rsv[r] = rstd[row0 + (r >> 2) * 128 + (r & 3) * 16];
        __builtin_amdgcn_sched_barrier(0);
#pragma unroll
        for (int ai = 0; ai < 2; ++ai)
#pragma unroll
            for (int m = 0; m < 4; ++m) { const int row = row0 + ai * 128 + m * 16; const float rs = rsv[ai * 4 + m];
#pragma unroll
                for (int bj = 0; bj < 2; ++bj) { const int c0 = u.pn * 256 + bj * 128 + wc * 32 + 8 * fq; const f32x4 v0 = acc[ai][bj][m][0] * rs, v1 = acc[ai][bj][m][1] * rs;
                    u32x4 w; w.x = pk2(v0[0], v0[1]); w.y = pk2(v0[2], v0[3]); w.z = pk2(v1[0], v1[1]); w.w = pk2(v1[2], v1[3]);
                    const int orow = compact ? (row < RL ? row : row - RL + 4 * SEQ) : row;
                    bf16_t* d = (u.pn < 2) ? Kb + (size_t)orow * 544 + c0 : Vb + (size_t)orow * 512 + (c0 - 512);
                    *(u32x4*)d = w; } }
    }
};
struct EpiMerge {
    u32x4* scr; bf16_t* M; bf16_t* P12;
    __device__ __forceinline__ void operator()(const Acc& acc, const Seg& u, int wr, int wc, int fr, int fq) const {
        int tid = threadIdx.x; asm volatile("" : "+v"(tid));
        if ((u.aux & 1) == 0) {
#pragma unroll
            for (int ai = 0; ai < 2; ++ai)
#pragma unroll
                for (int bj = 0; bj < 2; ++bj)
#pragma unroll
                    for (int m = 0; m < 4; ++m) { const f32x4 v0 = acc[ai][bj][m][0], v1 = acc[ai][bj][m][1];
                        u32x4 w; w.x = pk2(sigmoidf_(v0[0]), sigmoidf_(v0[1])); w.y = pk2(sigmoidf_(v0[2]), sigmoidf_(v0[3])); w.z = pk2(sigmoidf_(v1[0]), sigmoidf_(v1[1])); w.w = pk2(sigmoidf_(v1[2]), sigmoidf_(v1[3]));
                        scr[((ai * 2 + bj) * 4 + m) * 512 + tid] = w; }
        } else {
            const int n = (u.aux & 7) >> 1; const bool part = (u.aux & 8) != 0; const int row0 = u.pm * 256 + wr * 64 + fr; const bool accum = n > 0 && !part;
            u32x4 gq[2][4], pq[2][4];
#pragma unroll
            for (int k = 0; k < 5; ++k) {
                if (k < 4) { const int ai = k >> 1, bj = k & 1;
#pragma unroll
                    for (int m = 0; m < 4; ++m) { const int row = row0 + ai * 128 + m * 16; const int c0 = u.pn * 256 + bj * 128 + wc * 32 + 8 * fq;
                        gq[k & 1][m] = scr[((ai * 2 + bj) * 4 + m) * 512 + tid];
                        if (accum) pq[k & 1][m] = *(const u32x4*)(M + (size_t)row * 1024 + c0); else pq[k & 1][m] = (u32x4){0u, 0u, 0u, 0u}; } }
                if (k > 0) { const int kk = k - 1, ai = kk >> 1, bj = kk & 1;
#pragma unroll
                    for (int m = 0; m < 4; ++m) { const int row = row0 + ai * 128 + m * 16; const int c0 = u.pn * 256 + bj * 128 + wc * 32 + 8 * fq;
                        float gf[8], pf[8]; unpack8(gq[kk & 1][m], gf); unpack8(pq[kk & 1][m], pf);
                        const f32x4 v0 = acc[ai][bj][m][0], v1 = acc[ai][bj][m][1];
                        bf16_t* d = (part && n > 0) ? P12 + (size_t)(n - 1) * RC * 1024 + (size_t)(row - RL) * 1024 + c0 : M + (size_t)row * 1024 + c0;
#pragma unroll
                        for (int j = 0; j < 4; ++j) { pf[j] += gf[j] * v0[j]; pf[4 + j] += gf[4 + j] * v1[j]; }
                        *(u32x4*)d = pack8(pf); } }
            }
        }
    }
};
struct EpiResid {
    const void* srcl; bool srcbf; const float* srcc; bf16_t* dstl; float* dstc; const float* mod; int goff; float* part;
    __device__ __forceinline__ void operator()(const Acc& acc, const Seg& u, int wr, int wc, int fr, int fq) const {
        const int row0 = u.pm * 256 + wr * 64 + fr; const bool lat = u.pm * 256 < RL;
        const int cb0 = u.pn * 256 + wc * 32 + 8 * fq;
        if (u.aux != 0) {
            float* pb = part + (size_t)(u.aux - 1) * RC * 1024;
#pragma unroll
            for (int ai = 0; ai < 2; ++ai)
#pragma unroll
                for (int m = 0; m < 4; ++m) { float* d = pb + (size_t)(row0 + ai * 128 + m * 16 - RL) * 1024;
#pragma unroll
                    for (int bj = 0; bj < 2; ++bj)
#pragma unroll
                        for (int n = 0; n < 2; ++n) *(f32x4*)(d + cb0 + 128 * bj + 4 * n) = acc[ai][bj][m][n]; }
            return; }
        const float* g = mod + (lat ? ((u.pm * 256) >> 12) : 8) * 6144 + goff;
        f32x4 gv[2][2];
#pragma unroll
        for (int bj = 0; bj < 2; ++bj)
#pragma unroll
            for (int n = 0; n < 2; ++n) gv[bj][n] = *(const f32x4*)(g + cb0 + 128 * bj + 4 * n);
        if (lat && srcbf) {
            const bf16_t* sb = (const bf16_t*)srcl; u32x4 sv[2][2][2];
#pragma unroll
            for (int k = 0; k < 5; ++k) {
                if (k < 4) {
#pragma unroll
                    for (int mm = 0; mm < 2; ++mm) { const int row = row0 + (k >> 1) * 128 + ((k & 1) * 2 + mm) * 16;
#pragma unroll
                        for (int bj = 0; bj < 2; ++bj) sv[k & 1][mm][bj] = *(const u32x4*)(sb + (size_t)row * 1024 + cb0 + 128 * bj); } }
                if (k > 0) { const int kk = k - 1, ai = kk >> 1;
#pragma unroll
                    for (int mm = 0; mm < 2; ++mm) { const int m = (kk & 1) * 2 + mm; const int row = row0 + ai * 128 + m * 16;
#pragma unroll
                        for (int bj = 0; bj < 2; ++bj) { float s8[8]; unpack8(sv[kk & 1][mm][bj], s8);
#pragma unroll
                            for (int j = 0; j < 8; ++j) s8[j] += gv[bj][j >> 2][j & 3] * acc[ai][bj][m][j >> 2][j & 3];
                            *(u32x4*)(dstl + (size_t)row * 1024 + cb0 + 128 * bj) = pack8(s8); } } }
            }
        } else {
            const float* sb = lat ? (const float*)srcl : srcc; const size_t rsub = lat ? 0 : (size_t)RL; f32x4 sv[2][2][2];
#pragma unroll
            for (int k = 0; k < 9; ++k) {
                if (k < 8) { const int row = row0 + (k >> 2) * 128 + (k & 3) * 16; const float* s = sb + ((size_t)row - rsub) * 1024;
#pragma unroll
                    for (int bj = 0; bj < 2; ++bj)
#pragma unroll
                        for (int n = 0; n < 2; ++n) sv[k & 1][bj][n] = *(const f32x4*)(s + cb0 + 128 * bj + 4 * n); }
                if (k > 0) { const int kk = k - 1, ai = kk >> 2, m = kk & 3; const int row = row0 + ai * 128 + m * 16;
#pragma unroll
                    for (int bj = 0; bj < 2; ++bj) { const f32x4 o0 = sv[kk & 1][bj][0] + gv[bj][0] * acc[ai][bj][m][0], o1 = sv[kk & 1][bj][1] + gv[bj][1] * acc[ai][bj][m][1];
                        if (lat) { u32x4 w; w.x = pk2(o0[0], o0[1]); w.y = pk2(o0[2], o0[3]); w.z = pk2(o1[0], o1[1]); w.w = pk2(o1[2], o1[3]); *(u32x4*)(dstl + (size_t)row * 1024 + cb0 + 128 * bj) = w; }
                        else { float* d = dstc + ((size_t)row - RL) * 1024 + cb0 + 128 * bj; *(f32x4*)d = o0; *(f32x4*)(d + 4) = o1; } } }
            }
        }
    }
};
struct EpiSwiglu {
    bf16_t* H; int pitch;
    __device__ __forceinline__ void operator()(const Acc& acc, const Seg& u, int wr, int wc, int fr, int fq) const {
        const int row0 = u.pm * 256 + wr * 64 + fr; const int c0 = u.pn * 128 + wc * 32 + 8 * fq;
#pragma unroll
        for (int ai = 0; ai < 2; ++ai)
#pragma unroll
            for (int m = 0; m < 4; ++m) { const int row = row0 + ai * 128 + m * 16; float o[8];
#pragma unroll
                for (int n = 0; n < 2; ++n)
#pragma unroll
                    for (int j = 0; j < 4; ++j) o[4 * n + j] = siluf_(acc[ai][0][m][n][j]) * acc[ai][1][m][n][j];
                *(u32x4*)(H + (size_t)row * pitch + c0) = pack8(o); }
    }
};
struct EpiBf16 {
    bf16_t* O; int pitch;
    __device__ __forceinline__ void operator()(const Acc& acc, const Seg& u, int wr, int wc, int fr, int fq) const {
        const int row0 = u.pm * 256 + wr * 64 + fr;
#pragma unroll
        for (int ai = 0; ai < 2; ++ai)
#pragma unroll
            for (int m = 0; m < 4; ++m) { const int row = row0 + ai * 128 + m * 16;
#pragma unroll
                for (int bj = 0; bj < 2; ++bj) { const int c0 = u.pn * 256 + bj * 128 + wc * 32 + 8 * fq; const f32x4 v0 = acc[ai][bj][m][0], v1 = acc[ai][bj][m][1];
                    u32x4 w; w.x = pk2(v0[0], v0[1]); w.y = pk2(v0[2], v0[3]); w.z = pk2(v1[0], v1[1]); w.w = pk2(v1[2], v1[3]);
                    *(u32x4*)(O + (size_t)row * pitch + c0) = w; } }
    }
};

namespace attn {
constexpr float SCALE = 0.10206207261596577f;
constexpr float THR = 8.f;
constexpr int KP = 208;
constexpr int SHM_V = 8192, SHM_K = 64 * KP;
constexpr int OFF_V = 0, OFF_K = 2 * SHM_V, OFF_WS = OFF_K + 2 * SHM_K, SHM_TOTAL = OFF_WS + 8 * 64 * 4;
#define SBAR() __builtin_amdgcn_sched_barrier(0)
__device__ __forceinline__ int crow(int r, int hi) { return (r & 3) + 8 * (r >> 2) + 4 * hi; }
__device__ __forceinline__ unsigned cvtpk(float lo, float hi) { unsigned r; asm volatile("v_cvt_pk_bf16_f32 %0, %1, %2" : "=v"(r) : "v"(lo), "v"(hi)); return r; }
__device__ __forceinline__ void partialSM(f32x16& p0, f32x16& p1, float& m_reg, float& mn, float& alpha) {
    constexpr float C = SCALE * 1.4426950408889634f;
    float pmax = p0[0];
#pragma unroll
    for (int r = 1; r < 16; ++r) pmax = fmaxf(pmax, p0[r]);
#pragma unroll
    for (int r = 0; r < 16; ++r) pmax = fmaxf(pmax, p1[r]);
    { auto rr = __builtin_amdgcn_permlane32_swap(__float_as_uint(pmax), __float_as_uint(pmax), false, false); pmax = fmaxf(__uint_as_float(rr[0]), __uint_as_float(rr[1])); }
    if (__builtin_expect(__all(pmax - m_reg <= THR / SCALE), 1)) { mn = m_reg; alpha = 1.f; }
    else { mn = fmaxf(m_reg, pmax); alpha = __builtin_amdgcn_exp2f((m_reg - mn) * C); m_reg = mn; }
    const float mnC = -mn * C;
#pragma unroll
    for (int r = 0; r < 16; ++r) p0[r] = fmaf(p0[r], C, mnC);
#pragma unroll
    for (int r = 0; r < 16; ++r) p1[r] = fmaf(p1[r], C, mnC);
#pragma unroll
    for (int r = 0; r < 16; ++r) p0[r] = __builtin_amdgcn_exp2f(p0[r]);
}
__device__ __forceinline__ void finishSM(f32x16& p0, f32x16& p1, float alpha, float& l_reg, bf16x8& pa0, bf16x8& pa1, bf16x8& pa2, bf16x8& pa3) {
#pragma unroll
    for (int r = 0; r < 16; ++r) p1[r] = __builtin_amdgcn_exp2f(p1[r]);
    float ps = 0;
#pragma unroll
    for (int r = 0; r < 16; ++r) ps += p0[r];
#pragma unroll
    for (int r = 0; r < 16; ++r) ps += p1[r];
    { auto rr = __builtin_amdgcn_permlane32_swap(__float_as_uint(ps), __float_as_uint(ps), false, false); ps = __uint_as_float(rr[0]) + __uint_as_float(rr[1]); }
    l_reg = l_reg * alpha + ps;
#define PK4(P, BASE, OUT) do { unsigned a0 = cvtpk(P[BASE + 0], P[BASE + 1]), a1 = cvtpk(P[BASE + 2], P[BASE + 3]);   \
    unsigned b0 = cvtpk(P[BASE + 4], P[BASE + 5]), b1 = cvtpk(P[BASE + 6], P[BASE + 7]);                              \
    auto r0 = __builtin_amdgcn_permlane32_swap(a0, b0, false, false); auto r1 = __builtin_amdgcn_permlane32_swap(a1, b1, false, false); \
    u32x4 w = {r0[0], r1[0], r0[1], r1[1]}; OUT = __builtin_bit_cast(bf16x8, w); } while (0)
    PK4(p0, 0, pa0); PK4(p0, 8, pa1); PK4(p1, 0, pa2); PK4(p1, 8, pa3);
#undef PK4
}
__device__ __forceinline__ void qkt(f32x16& p0, f32x16& p1, const LAS unsigned char* Ks, const bf16x8* qr, int r32, int hi) {
    p0 = f32x16{}; p1 = f32x16{};
#pragma unroll
    for (int d0 = 0; d0 < 6; ++d0) { const int cb = (d0 * 16 + hi * 8) * 2;
        const bf16x8 b0 = *(const LAS bf16x8*)(Ks + r32 * KP + cb);
        const bf16x8 b1 = *(const LAS bf16x8*)(Ks + (32 + r32) * KP + cb);
        p0 = __builtin_amdgcn_mfma_f32_32x32x16_bf16(b0, qr[d0], p0, 0, 0, 0);
        p1 = __builtin_amdgcn_mfma_f32_32x32x16_bf16(b1, qr[d0], p1, 0, 0, 0); }
}
__device__ __forceinline__ int v_st(int k, int c) { const int kk = (k & ~0xC) | ((k & 4) << 1) | ((k & 8) >> 1); return ((kk >> 3) * 2 + (c >> 5)) * 512 + ((kk & 7) * 32 + (c & 31)) * 2; }
__device__ __forceinline__ int v_rd_base(int lane) { return ((lane & 3) << 3) | (((lane >> 2) & 3) << 6) | (((lane >> 4) & 1) << 5) | (((lane >> 5) & 1) << 8); }
constexpr int v_rd_off(int d0, int ks, int half) { return d0 * 512 + ks * 2048 + half * 1024; }
template <int OFF> __device__ __forceinline__ s16x4 tr_read(int vb) { s16x4 r; asm volatile("ds_read_b64_tr_b16 %0, %1 offset:%2" : "=&v"(r) : "v"(vb), "i"(OFF) : "memory"); return r; }
template <int D0> __device__ __forceinline__ void pv_one(f32x16& od, int vb, bf16x8 pa0, bf16x8 pa1, bf16x8 pa2, bf16x8 pa3) {
    const s16x4 l0 = tr_read<v_rd_off(D0, 0, 0)>(vb), h0 = tr_read<v_rd_off(D0, 0, 1)>(vb), l1 = tr_read<v_rd_off(D0, 1, 0)>(vb), h1 = tr_read<v_rd_off(D0, 1, 1)>(vb);
    const s16x4 l2 = tr_read<v_rd_off(D0, 2, 0)>(vb), h2 = tr_read<v_rd_off(D0, 2, 1)>(vb), l3 = tr_read<v_rd_off(D0, 3, 0)>(vb), h3 = tr_read<v_rd_off(D0, 3, 1)>(vb);
    asm volatile("s_waitcnt lgkmcnt(0)" ::: "memory"); SBAR();
#define PK(L, H) (bf16x8){L[0], L[1], L[2], L[3], H[0], H[1], H[2], H[3]}
    od = __builtin_amdgcn_mfma_f32_32x32x16_bf16(pa0, PK(l0, h0), od, 0, 0, 0);
    od = __builtin_amdgcn_mfma_f32_32x32x16_bf16(pa1, PK(l1, h1), od, 0, 0, 0);
    od = __builtin_amdgcn_mfma_f32_32x32x16_bf16(pa2, PK(l2, h2), od, 0, 0, 0);
    od = __builtin_amdgcn_mfma_f32_32x32x16_bf16(pa3, PK(l3, h3), od, 0, 0, 0);
#undef PK
}
__device__ __forceinline__ void pv_d0(f32x16* o, int vb, bf16x8 pa0, bf16x8 pa1, bf16x8 pa2, bf16x8 pa3) { pv_one<0>(o[0], vb, pa0, pa1, pa2, pa3); pv_one<1>(o[1], vb, pa0, pa1, pa2, pa3); }

__device__ __forceinline__ void attn_unit(const bf16_t* __restrict__ Qb, const bf16_t* __restrict__ Kn, const bf16_t* __restrict__ Kr, const bf16_t* __restrict__ Vh,
                                          bf16_t* __restrict__ Ob, long lat0, long ctx0, int nlat, int NT, LAS unsigned char* lds) {
    int tid_ = threadIdx.x; asm volatile("" : "+v"(tid_));
    const int tid = tid_, wid = tid >> 6, lane = tid & 63, r32 = lane & 31, hi = lane >> 5;
    LAS unsigned char* V_lds = lds + OFF_V; LAS unsigned char* K_lds = lds + OFF_K;
    LAS float* ws = (LAS float*)(lds + OFF_WS) + wid * 64; LAS float* li_l = ws; LAS float* al_l = ws + 32;
    float m_reg = -1e30f, l_reg = 0; f32x16 o[2] = {}; bf16x8 qr[6];
    const bf16_t* Qw = Qb + (long)(wid * 32 + r32) * 768 + hi * 8;
#pragma unroll
    for (int d0 = 0; d0 < 6; ++d0) qr[d0] = *(const bf16x8*)(Qw + d0 * 16);
    const int sr = tid >> 3, sc = (tid & 7) * 8, vst = v_st(sr, sc);
    const int kr_ = (tid & 255) >> 2, kc_ = (tid & 3) * 8;
    const int vb0 = (int)(uintptr_t)V_lds + v_rd_base(lane);
    struct { bf16x8 vs, kn, kp; } sr_[2];
#define KROW(j, kk) (((j) < nlat) ? (lat0 + (long)(j) * 64 + (kk)) : (ctx0 + (long)((j) - nlat) * 64 + (kk)))
#define SLOAD(i, j) do { const long r0_ = KROW(j, sr), r1_ = KROW(j, kr_); sr_[i].vs = *(const bf16x8*)(Vh + r0_ * 512 + sc); sr_[i].kn = *(const bf16x8*)(Kn + r0_ * 544 + sc); sr_[i].kp = *(const bf16x8*)(Kr + r1_ * 544 + kc_); } while (0)
#define SWRITE(b, i) do { *(LAS bf16x8*)(V_lds + (b) * SHM_V + vst) = sr_[i].vs; *(LAS bf16x8*)(K_lds + (b) * SHM_K + sr * KP + sc * 2) = sr_[i].kn; \
    *(LAS bf16x8*)(K_lds + (b) * SHM_K + kr_ * KP + 128 + kc_ * 2) = sr_[i].kp; } while (0)
#define SWAIT() asm volatile("s_waitcnt vmcnt(3)" ::: "memory")
#define RESC(a) do { if (__any((a) < 1.f)) { if (hi == 0) al_l[r32] = (a); asm volatile("s_waitcnt lgkmcnt(0)" ::: "memory"); \
    _Pragma("unroll") for (int d = 0; d < 2; ++d) _Pragma("unroll") for (int r = 0; r < 16; ++r) o[d][r] *= al_l[crow(r, hi)]; } } while (0)
    f32x16 pA0, pA1, pB0, pB1; float mnA, mnB, alA, alB; bf16x8 pa0, pa1, pa2, pa3;
    constexpr int SE = 0, SO = 1;
    SLOAD(SE, 0); asm volatile("s_waitcnt vmcnt(0)" ::: "memory"); SWRITE(0, SE); __syncthreads();
    qkt(pA0, pA1, K_lds, qr, r32, hi); partialSM(pA0, pA1, m_reg, mnA, alA);
    SLOAD(SO, 1); if (2 < NT) SLOAD(SE, 2);
    SWAIT(); SWRITE(1, SO); __syncthreads();
    for (int j = 1; j + 1 < NT; j += 2) {
        SBAR(); qkt(pB0, pB1, K_lds + SHM_K, qr, r32, hi);
        finishSM(pA0, pA1, alA, l_reg, pa0, pa1, pa2, pa3); SBAR();
        SLOAD(SO, j + 2); SBAR();
        pv_d0(o, vb0, pa0, pa1, pa2, pa3); partialSM(pB0, pB1, m_reg, mnB, alB);
        __syncthreads(); SWAIT(); SWRITE(0, SE);
        RESC(alB); __syncthreads();
        SBAR(); qkt(pA0, pA1, K_lds, qr, r32, hi);
        finishSM(pB0, pB1, alB, l_reg, pa0, pa1, pa2, pa3); SBAR();
        if (j + 3 < NT) SLOAD(SE, j + 3); SBAR();
        pv_d0(o, vb0 + SHM_V, pa0, pa1, pa2, pa3); partialSM(pA0, pA1, m_reg, mnA, alA);
        __syncthreads(); SWAIT(); SWRITE(1, SO);
        RESC(alA); __syncthreads();
    }
    SBAR(); qkt(pB0, pB1, K_lds + SHM_K, qr, r32, hi);
    finishSM(pA0, pA1, alA, l_reg, pa0, pa1, pa2, pa3); SBAR();
    pv_d0(o, vb0, pa0, pa1, pa2, pa3); partialSM(pB0, pB1, m_reg, mnB, alB);
    __syncthreads(); RESC(alB);
    finishSM(pB0, pB1, alB, l_reg, pa0, pa1, pa2, pa3); SBAR();
    pv_d0(o, vb0 + SHM_V, pa0, pa1, pa2, pa3);
    if (hi == 0) li_l[r32] = l_reg; asm volatile("s_waitcnt lgkmcnt(0)" ::: "memory");
    float rli[16];
#pragma unroll
    for (int r = 0; r < 16; ++r) rli[r] = __builtin_amdgcn_rcpf(li_l[crow(r, hi)]);
    bf16_t* Ow = Ob + (long)(wid * 32) * 512;
#pragma unroll
    for (int r = 0; r < 16; ++r) { const int orow = crow(r, hi);
#pragma unroll
        for (int d0 = 0; d0 < 2; ++d0) Ow[(long)orow * 512 + d0 * 32 + r32] = (bf16_t)f2bf(o[d0][r] * rli[r]); }
    __syncthreads();
#undef KROW
#undef SLOAD
#undef SWRITE
#undef SWAIT
#undef RESC
}
#undef SBAR
}

__device__ __forceinline__ void attn_latent_unit(const Ctx& F, unsigned char* ws, unsigned char* ha, int b, int h, int qb) {
    bf16_t* Y = (bf16_t*)(ws + D_YMLA); const long q0 = (long)b * SEQ + qb * 256;
    if (b < 4) { const bf16_t* Q = (const bf16_t*)(ha + HA_Q); const bf16_t* K = (const bf16_t*)(ha + HA_K); const bf16_t* V = (const bf16_t*)(ha + HA_V);
        attn::attn_unit(Q + q0 * 768 + h * 96, K + h * 64, K + 512, V + h * 64, Y + q0 * 512 + h * 64, (long)b * SEQ, (long)4 * SEQ + b * CTXL, 64, 68, F.lds); }
    else { const bf16_t* Q = (const bf16_t*)(ws + D_Q); const bf16_t* K = (const bf16_t*)(ws + D_K); const bf16_t* V = (const bf16_t*)(ws + D_V);
        attn::attn_unit(Q + q0 * 768 + h * 96, K + h * 64, K + 512, V + h * 64, Y + q0 * 512 + h * 64, (long)b * SEQ, (long)RL + b * CTXL, 64, 68, F.lds); }
}
__device__ __forceinline__ void attn_phase(const Ctx& F, int layer) {
    unsigned char* ws = getpp()->ws; unsigned char* ha = half_a_base(layer); const bool with_ctx_q = (layer == 0);
    const int vcu = (F.G % 8 == 0) ? (F.bid % 8) * (F.G / 8) + F.bid / 8 : F.bid;
    const int nlat_units = 4 * 8 * 16, nunits = nlat_units + (with_ctx_q ? NBATCH * 8 : 0);
    for (int u = vcu; u < nunits; u += F.G) {
        if (u < nlat_units) { const int bh = u >> 4, qb = u & 15; attn_latent_unit(F, ws, ha, 4 + (bh >> 3), bh & 7, qb); }
        else { const int bh = u - nlat_units, b = bh >> 3, h = bh & 7; bf16_t* Y = (bf16_t*)(ws + D_YMLA); const long yrow = (long)RL + b * CTXL;
            if (b < 4) { const bf16_t* Q = (const bf16_t*)(ha + HA_Q); const bf16_t* K = (const bf16_t*)(ha + HA_K); const bf16_t* V = (const bf16_t*)(ha + HA_V); const long q0 = (long)4 * SEQ + b * CTXL;
                attn::attn_unit(Q + q0 * 768 + h * 96, K + h * 64, K + 512, V + h * 64, Y + yrow * 512 + h * 64, 0, q0, 0, 4, F.lds); }
            else { const bf16_t* Q = (const bf16_t*)(ws + D_Q); const bf16_t* K = (const bf16_t*)(ws + D_K); const bf16_t* V = (const bf16_t*)(ws + D_V);
                attn::attn_unit(Q + yrow * 768 + h * 96, K + h * 64, K + 512, V + h * 64, Y + yrow * 512 + h * 64, 0, yrow, 0, 4, F.lds); } }
    }
}

__device__ __forceinline__ void load8_shift(const bf16_t* u, long row, int t, int T, int col, const float* mu, float* out) {
    float x[8], p[8], n[8];
    const bool hp = t > 0, hn = t < T - 1;
    const u32x4 wx = *(const u32x4*)(u + row * RWC + col), wp = *(const u32x4*)(u + (row - (hp ? 1 : 0)) * RWC + col), wn = *(const u32x4*)(u + (row + (hn ? 1 : 0)) * RWC + col);
    unpack8(wx, x); unpack8(wp, p); unpack8(wn, n);
    const float mp = hp ? 0.5f : 0.f, mn = hn ? 0.5f : 0.f;
    const f32x4 m0 = *(const f32x4*)(mu + col), m1 = *(const f32x4*)(mu + col + 4);
#pragma unroll
    for (int j = 0; j < 8; ++j) out[j] = x[j] + (j < 4 ? m0[j & 3] : m1[j & 3]) * (mp * p[j] + mn * n[j] - x[j]);
}
__device__ __forceinline__ void load8_shift_l(const bf16_t* u, long row, int t, int T, int col, const LAS float* mu8, float* out) {
    float x[8], p[8], n[8];
    const bool hp = t > 0, hn = t < T - 1;
    const u32x4 wx = *(const u32x4*)(u + row * RWC + col), wp = *(const u32x4*)(u + (row - (hp ? 1 : 0)) * RWC + col), wn = *(const u32x4*)(u + (row + (hn ? 1 : 0)) * RWC + col);
    unpack8(wx, x); unpack8(wp, p); unpack8(wn, n);
    const float mp = hp ? 0.5f : 0.f, mn = hn ? 0.5f : 0.f;
    const f32x4 m0 = *(const LAS f32x4*)(mu8), m1 = *(const LAS f32x4*)(mu8 + 4);
#pragma unroll
    for (int j = 0; j < 8; ++j) out[j] = x[j] + (j < 4 ? m0[j & 3] : m1[j & 3]) * (mp * p[j] + mn * n[j] - x[j]);
}
namespace rw2 {
constexpr int PT = 72;
constexpr int O_W2T = 0, O_A2T = 9216, O_ZL = 18432, O_AL = 34816, O_XWD = 51200, O_XAD = 60416, O_RING = 18432;
constexpr int O_TA = 69632, O_TB = O_TA + 9216, O_TK = O_TB + 9216, O_TR = O_TK + 9216, O_OUT = 69632;
constexpr int O_BH = 106496, O_KH = O_BH + 9216, O_V = O_KH + 9216, O_TOT = 134144, O_PL = 136192, O_PRM = 137216;
__device__ __forceinline__ s16x4 cv4(f32x4 v) { u32x2 w; w.x = pk2(v[0], v[1]); w.y = pk2(v[2], v[3]); return __builtin_bit_cast(s16x4, w); }
__device__ __forceinline__ f32x4 mm16(s16x4 a, s16x4 b, f32x4 c) { return __builtin_amdgcn_mfma_f32_16x16x16bf16_1k(a, b, c, 0, 0, 0); }
__device__ __forceinline__ f32x4 mm32(bf16x8 a, bf16x8 b, f32x4 c) { return __builtin_amdgcn_mfma_f32_16x16x32_bf16(a, b, c, 0, 0, 0); }
__device__ __forceinline__ f32x4 bf4_to_f(s16x4 s) { const u32x2 w = __builtin_bit_cast(u32x2, s); return (f32x4){bflo(w.x), bfhi(w.x), bflo(w.y), bfhi(w.y)}; }
typedef short v4i16_t __attribute__((ext_vector_type(4)));
__device__ __forceinline__ s16x4 trd(const LAS bf16_t* base, int row0, int col0, int lane) {
    const int g = lane >> 4, i = lane & 15, q = i >> 2, p = i & 3;
    return __builtin_bit_cast(s16x4, __builtin_amdgcn_ds_read_tr16_b64_v4i16((LAS v4i16_t*)(base + (row0 + 4 * g + q) * PT + col0 + 4 * p)));
}
__device__ __forceinline__ float fast_tanh(float x) { return 1.0f - 2.0f * __builtin_amdgcn_rcpf(__builtin_amdgcn_exp2f(2.8853900817779268f * x) + 1.0f); }
}
__device__ __forceinline__ void rwkv_chain2(const Ctx& F, int layer, int b, int h, int d) {
    using namespace rw2;
    PP P = getpp(); unsigned char* ws = P->ws;
    const bf16_t* u = (const bf16_t*)(ws + D_URWKV);
    bf16_t* od = (bf16_t*)(ws + (d ? D_OB : D_OF));
    float* bsc = (float*)(ws + WS_BSC) + (size_t)d * RT * 8;
    LAS unsigned char* L = F.lds;
    LAS bf16_t* w2t = (LAS bf16_t*)(L + O_W2T); LAS bf16_t* a2t = (LAS bf16_t*)(L + O_A2T);
    LAS float* Zl = (LAS float*)(L + O_ZL); LAS float* Al = (LAS float*)(L + O_AL);
    LAS bf16_t* Xwd = (LAS bf16_t*)(L + O_XWD); LAS bf16_t* Xad = (LAS bf16_t*)(L + O_XAD);
    LAS bf16_t* TA = (LAS bf16_t*)(L + O_TA); LAS bf16_t* TB = (LAS bf16_t*)(L + O_TB); LAS bf16_t* TK = (LAS bf16_t*)(L + O_TK); LAS bf16_t* TR = (LAS bf16_t*)(L + O_TR);
    LAS bf16_t* BH = (LAS bf16_t*)(L + O_BH); LAS bf16_t* KH = (LAS bf16_t*)(L + O_KH); LAS bf16_t* Vm = (LAS bf16_t*)(L + O_V);
    LAS float* tot = (LAS float*)(L + O_TOT); LAS float* pLs = (LAS float*)(L + O_PL); LAS float* Out = (LAS float*)(L + O_OUT);
    LAS float* prm = (LAS float*)(L + O_PRM);
    const int tid0 = F.tid, w = F.wave;
    {
        const int tid = tid0;
        const float* mu = P->in[I_MU] + layer * RWC;
        const float* w0 = P->in[I_W0] + (layer * 2 + d) * 512 + h * 64;
        const float* w2 = P->in[I_W2] + (size_t)(layer * 2 + d) * 64 * 512 + h * 64;
        const float* a0 = P->in[I_A0] + (layer * 2 + d) * 512 + h * 64;
        const float* a2 = P->in[I_A2] + (size_t)(layer * 2 + d) * 64 * 512 + h * 64;
        const float* k_k = P->in[I_KK] + layer * 512 + h * 64; const float* k_a = P->in[I_KA] + layer * 512 + h * 64; const float* r_k = P->in[I_RK] + layer * 512 + h * 64;
        for (int i = tid; i < 640; i += NTHREADS) { const int rr = i >> 6, cc = i & 63; float v;
            if (rr == 0) v = mu[h * 64 + cc]; else if (rr == 1) v = mu[512 + h * 64 + cc]; else if (rr == 2) v = mu[1024 + h * 64 + cc]; else if (rr == 3) v = mu[1536 + d * 64 + cc]; else if (rr == 4) v = mu[1664 + d * 64 + cc];
            else if (rr == 5) v = w0[cc]; else if (rr == 6) v = a0[cc]; else if (rr == 7) v = k_k[cc]; else if (rr == 8) v = k_a[cc]; else v = r_k[cc];
            prm[i] = v; }
        for (int i = tid; i < 4096; i += NTHREADS) { const int k = i >> 6, cc = i & 63; w2t[cc * PT + k] = (bf16_t)f2bf(w2[(size_t)k * 512 + cc]); a2t[cc * PT + k] = (bf16_t)f2bf(a2[(size_t)k * 512 + cc]); }
    }
    f32x4 Z[4];
#pragma unroll
    for (int j = 0; j < 4; ++j) Z[j] = (f32x4){0.f, 0.f, 0.f, 0.f};
    __syncthreads();
    for (int seq = 0; seq < 2; ++seq) {
        const int T = seq ? SEQ : CTXL; const long rbase = seq ? (long)b * SEQ : (long)RL + b * CTXL; const int nch = T / 64;
        for (int ci = 0; ci < nch; ++ci) {
            int tid = tid0; asm volatile("" : "+v"(tid));
            const int lane = tid & 63, fr = lane & 15, fq = lane >> 4, tt = tid >> 3, c8 = (tid & 7) * 8;
            const int tpos = d ? (T - 1 - (ci * 64 + tt)) : (ci * 64 + tt); const long row = rbase + tpos;
            float r[8], k[8], kk[8], av[8], kd[8], lw[8];
            {
                float v[8], x[8];
                load8_shift_l(u, row, tpos, T, h * 64 + c8, prm + c8, r);
                load8_shift_l(u, row, tpos, T, 512 + h * 64 + c8, prm + 64 + c8, k);
                load8_shift_l(u, row, tpos, T, 1024 + h * 64 + c8, prm + 128 + c8, v);
                *(LAS u32x4*)(Vm + tt * PT + c8) = pack8(v);
                load8_shift_l(u, row, tpos, T, 1536 + d * 64 + c8, prm + 192 + c8, x);
#pragma unroll
                for (int e = 0; e < 8; ++e) x[e] = fast_tanh(x[e]);
                *(LAS u32x4*)(Xwd + tt * PT + c8) = pack8(x);
                load8_shift_l(u, row, tpos, T, 1664 + d * 64 + c8, prm + 256 + c8, x);
                *(LAS u32x4*)(Xad + tt * PT + c8) = pack8(x);
            }
            __syncthreads();
            {
#pragma unroll
                for (int q = 0; q < 2; ++q) { const int id = 2 * w + q, tm = id >> 2, tn = id & 3;
                    f32x4 az = {0.f, 0.f, 0.f, 0.f}, aa = {0.f, 0.f, 0.f, 0.f};
#pragma unroll
                    for (int ks = 0; ks < 2; ++ks) {
                        az = mm32(*(const LAS bf16x8*)(Xwd + (16 * tm + fr) * PT + ks * 32 + fq * 8), *(const LAS bf16x8*)(w2t + (16 * tn + fr) * PT + ks * 32 + fq * 8), az);
                        aa = mm32(*(const LAS bf16x8*)(Xad + (16 * tm + fr) * PT + ks * 32 + fq * 8), *(const LAS bf16x8*)(a2t + (16 * tn + fr) * PT + ks * 32 + fq * 8), aa); }
#pragma unroll
                    for (int e = 0; e < 4; ++e) { Zl[(16 * tm + 4 * fq + e) * 64 + 16 * tn + fr] = az[e]; Al[(16 * tm + 4 * fq + e) * 64 + 16 * tn + fr] = aa[e]; } }
            }
            __syncthreads();
            {
                float ss = 0.f, bs = 0.f;
#pragma unroll
                for (int e = 0; e < 8; ++e) { kk[e] = k[e] * prm[448 + c8 + e]; ss += kk[e] * kk[e]; }
                ss += shx(ss, 1, lane); ss += shx(ss, 2, lane); ss += shx(ss, 4, lane);
                const float inv = __builtin_amdgcn_rsqf(fmaxf(ss, 1e-24f));
#pragma unroll
                for (int e = 0; e < 8; ++e) {
                    kk[e] *= inv;
                    const float z = Zl[tt * 64 + c8 + e] + prm[320 + c8 + e];
                    lw[e] = -sigmoidf_(z) * 0.8750612633917001f;
                    av[e] = sigmoidf_(Al[tt * 64 + c8 + e] + prm[384 + c8 + e]);
                    kd[e] = k[e] * (1.0f + (av[e] - 1.0f) * prm[512 + c8 + e]);
                    bs += r[e] * kd[e] * prm[576 + c8 + e];
                }
                bs += shx(bs, 1, lane); bs += shx(bs, 2, lane); bs += shx(bs, 4, lane);
                if ((tid & 7) == 0) bsc[(size_t)row * 8 + h] = bs;
            }
            float cum[8];
            {
#pragma unroll
                for (int e = 0; e < 8; ++e) cum[e] = lw[e];
#pragma unroll
                for (int off = 8; off < 64; off <<= 1) {
#pragma unroll
                    for (int e = 0; e < 8; ++e) { const float t = __int_as_float(__builtin_amdgcn_ds_bpermute(((lane - off) & 63) << 2, __float_as_int(cum[e]))); cum[e] += (lane >= off) ? t : 0.f; } }
                if (lane >= 56) {
#pragma unroll
                    for (int e = 0; e < 8; ++e) tot[w * 64 + c8 + e] = cum[e]; }
            }
            __syncthreads();
            {
                float ta[8], tb[8], tk[8], tr[8], bh[8], kh[8];
                const int w0i = (w & ~1) * 64 + c8;
#pragma unroll
                for (int e = 0; e < 8; ++e) {
                    const float t0 = tot[w0i + e], t1 = tot[w0i + 64 + e];
                    const float cm = cum[e] + ((w & 1) ? t0 : 0.f), cumL = t0 + t1;
                    const float e1 = __builtin_amdgcn_exp2f(cm - lw[e]), e2 = __builtin_amdgcn_exp2f(-cm), e3 = __builtin_amdgcn_exp2f(cm), e4 = __builtin_amdgcn_exp2f(cumL - cm);
                    const float ka = kk[e] * av[e];
                    ta[e] = -kk[e] * e1; tb[e] = ka * e2; tk[e] = kd[e] * e2; tr[e] = r[e] * e3; bh[e] = ka * e4; kh[e] = kd[e] * e4;
                    if ((tt & 15) == 15) pLs[(tt >> 4) * 64 + c8 + e] = e3;
                }
                *(LAS u32x4*)(TA + tt * PT + c8) = pack8(ta); *(LAS u32x4*)(TB + tt * PT + c8) = pack8(tb); *(LAS u32x4*)(TK + tt * PT + c8) = pack8(tk); *(LAS u32x4*)(TR + tt * PT + c8) = pack8(tr);
                *(LAS u32x4*)(BH + tt * PT + c8) = pack8(bh); *(LAS u32x4*)(KH + tt * PT + c8) = pack8(kh);
            }
            __syncthreads();
            if (w < 4) {
                const int s = w; const int rowf = (16 * s + fr) * PT;
                f32x4 Mab = {0.f, 0.f, 0.f, 0.f}, MabT = Mab, MakT = Mab, Mbr = Mab, Mkr = Mab;
#pragma unroll
                for (int ks = 0; ks < 2; ++ks) { const int o = rowf + ks * 32 + fq * 8;
                    const bf16x8 fa = *(const LAS bf16x8*)(TA + o), fb = *(const LAS bf16x8*)(TB + o), fk = *(const LAS bf16x8*)(TK + o), frr = *(const LAS bf16x8*)(TR + o);
                    Mab = mm32(fb, fa, Mab); MabT = mm32(fa, fb, MabT); MakT = mm32(fa, fk, MakT); Mbr = mm32(fb, frr, Mbr); Mkr = mm32(fk, frr, Mkr); }
                f32x4 Pm, Pt;
#pragma unroll
                for (int e = 0; e < 4; ++e) { const int m = 4 * fq + e, n = fr;
                    Mab[e] = (m < n) ? Mab[e] : 0.f; MabT[e] = (n < m) ? MabT[e] : 0.f; MakT[e] = (n < m) ? MakT[e] : 0.f; Mbr[e] = (m <= n) ? Mbr[e] : 0.f; Mkr[e] = (m <= n) ? Mkr[e] : 0.f;
                    const float id = (m == n) ? 1.f : 0.f; Pm[e] = Mab[e] + id; Pt[e] = MabT[e] + id; }
                f32x4 Nn = Mab, Nt = MabT; const f32x4 zero = {0.f, 0.f, 0.f, 0.f};
#pragma unroll
                for (int it = 0; it < 3; ++it) {
                    const s16x4 cn = cv4(Nn), cnt = cv4(Nt);
                    const f32x4 N2 = mm16(cnt, cn, zero), Nt2 = mm16(cn, cnt, zero);
                    const s16x4 cp = cv4(Pm), cpt = cv4(Pt), cn2 = cv4(N2);
                    const f32x4 Pn = mm16(cpt, cn2, Pm), Ptn = mm16(cn2, cpt, Pt);
                    Nn = N2; Nt = Nt2; Pm = Pn; Pt = Ptn; (void)cp;
                }
                const s16x4 cT = cv4(Pm), cMakT = cv4(MakT), cMbr = cv4(Mbr);
                const f32x4 Q1T = mm16(cT, cMakT, zero);
                const s16x4 cQ1T = cv4(Q1T);
                const f32x4 Hy = mm16(cQ1T, cMbr, Mkr);
                LAS unsigned char* ring = L + O_RING + s * 12800 + lane * 8;
                *(LAS s16x4*)(ring + 20 * 512) = cv4(Hy);
                s16x4 bhf[4];
#pragma unroll
                for (int jt = 0; jt < 4; ++jt) bhf[jt] = trd(BH, 16 * s, 16 * jt, lane);
#pragma unroll
                for (int jt = 0; jt < 4; ++jt) {
                    const s16x4 atf = trd(TA, 16 * s, 16 * jt, lane);
                    const f32x4 P1T = mm16(cT, atf, zero); const s16x4 cP1T = cv4(P1T);
                    const f32x4 rinit = bf4_to_f(*(const LAS s16x4*)(TR + (16 * s + fr) * PT + 16 * jt + 4 * fq));
                    const f32x4 Gy = mm16(cP1T, cMbr, rinit);
                    *(LAS s16x4*)(ring + jt * 512) = cv4(Gy);
#pragma unroll
                    for (int j2 = 0; j2 < 4; ++j2) { const f32x4 Gs = mm16(cP1T, bhf[j2], zero); *(LAS s16x4*)(ring + (4 + jt * 4 + j2) * 512) = cv4(Gs); }
                    const f32x4 kinit = bf4_to_f(trd(KH, 16 * s, 16 * jt, lane));
                    const f32x4 Hs = mm16(cQ1T, bhf[jt], kinit);
                    *(LAS s16x4*)(ring + (21 + jt) * 512) = cv4(Hs);
                }
            }
            __syncthreads();
            if (w < 4) {
                const int it = w;
#pragma unroll 1
                for (int s = 0; s < 4; ++s) {
                    const LAS unsigned char* ring = L + O_RING + s * 12800 + lane * 8;
                    const s16x4 vb = trd(Vm, 16 * s, 16 * it, lane);
                    s16x4 zb[4];
#pragma unroll
                    for (int jt = 0; jt < 4; ++jt) zb[jt] = cv4(Z[jt]);
                    f32x4 Yt = mm16(*(const LAS s16x4*)(ring + 20 * 512), vb, (f32x4){0.f, 0.f, 0.f, 0.f});
#pragma unroll
                    for (int jt = 0; jt < 4; ++jt) Yt = mm16(*(const LAS s16x4*)(ring + jt * 512), zb[jt], Yt);
#pragma unroll
                    for (int e = 0; e < 4; ++e) Out[(16 * s + 4 * fq + e) * 64 + 16 * it + fr] = Yt[e];
                    f32x4 Zn[4];
#pragma unroll
                    for (int j2 = 0; j2 < 4; ++j2) {
                        const f32x4 pv = *(const LAS f32x4*)(pLs + s * 64 + 16 * j2 + 4 * fq);
                        f32x4 zn = Z[j2] * pv;
                        zn = mm16(*(const LAS s16x4*)(ring + (21 + j2) * 512), vb, zn);
#pragma unroll
                        for (int jt = 0; jt < 4; ++jt) zn = mm16(*(const LAS s16x4*)(ring + (4 + jt * 4 + j2) * 512), zb[jt], zn);
                        Zn[j2] = zn;
                    }
#pragma unroll
                    for (int j2 = 0; j2 < 4; ++j2) Z[j2] = Zn[j2];
                }
            }
            __syncthreads();
            {
                float v[8];
#pragma unroll
                for (int e = 0; e < 8; ++e) v[e] = Out[tt * 64 + c8 + e];
                *(u32x4*)(od + (size_t)row * 512 + h * 64 + c8) = pack8(v);
            }
            __syncthreads();
        }
    }
}

namespace rw4 {
using namespace rw2;
constexpr int RGN = 16384, R_TA = 0, R_TB = 2304, R_TK = 4608, R_TR = 6912, R_BH = 9216, R_KH = 11520, R_V = 13824, R_PL = 16128;
constexpr int R_XWD = 0, R_XAD = 2304, R_ZL = 4608, R_AL = 8704;
constexpr int O_PRM4 = 8 * RGN;
}
__device__ __forceinline__ void rwkv_chain4(const Ctx& F, int layer, int b, int h, int d) {
    using namespace rw4;
    PP P = getpp(); unsigned char* ws = P->ws;
    const bf16_t* u = (const bf16_t*)(ws + D_URWKV);
    bf16_t* od = (bf16_t*)(ws + (d ? D_OB : D_OF));
    float* bsc = (float*)(ws + WS_BSC) + (size_t)d * RT * 8;
    const bf16_t* w2g = (const bf16_t*)(ws + WS_W2T) + (size_t)((layer * 2 + d) * 2 + 0) * 512 * 64 + (size_t)h * 64 * 64;
    const bf16_t* a2g = (const bf16_t*)(ws + WS_W2T) + (size_t)((layer * 2 + d) * 2 + 1) * 512 * 64 + (size_t)h * 64 * 64;
    LAS unsigned char* L = F.lds;
    LAS float* prm = (LAS float*)(L + O_PRM4);
    volatile LAS unsigned* rdy = (volatile LAS unsigned*)(L + O_PRM4 + 2560); LAS unsigned* dne = (LAS unsigned*)(L + O_PRM4 + 2560 + 64);
    unsigned gseq = 0;
    const int tid0 = F.tid, w = F.wave;
    {
        const float* mu = P->in[I_MU] + layer * RWC;
        const float* w0 = P->in[I_W0] + (layer * 2 + d) * 512 + h * 64; const float* a0 = P->in[I_A0] + (layer * 2 + d) * 512 + h * 64;
        const float* k_k = P->in[I_KK] + layer * 512 + h * 64; const float* k_a = P->in[I_KA] + layer * 512 + h * 64; const float* r_k = P->in[I_RK] + layer * 512 + h * 64;
        for (int i = tid0; i < 640; i += NTHREADS) { const int rr = i >> 6, cc = i & 63; float v;
            if (rr == 0) v = mu[h * 64 + cc]; else if (rr == 1) v = mu[512 + h * 64 + cc]; else if (rr == 2) v = mu[1024 + h * 64 + cc]; else if (rr == 3) v = mu[1536 + d * 64 + cc]; else if (rr == 4) v = mu[1664 + d * 64 + cc];
            else if (rr == 5) v = w0[cc]; else if (rr == 6) v = a0[cc]; else if (rr == 7) v = k_k[cc]; else if (rr == 8) v = k_a[cc]; else v = r_k[cc];
            prm[i] = v; }
        if (tid0 < 8) { rdy[tid0] = 0u; dne[tid0] = 0u; }
    }
    f32x4 Z[4];
#pragma unroll
    for (int j = 0; j < 4; ++j) Z[j] = (f32x4){0.f, 0.f, 0.f, 0.f};
    u32x4 raw[2][5][3];
#define RW4_PREFETCH(T_, rbase_, gi_) do { int t0_ = tid0; asm volatile("" : "+v"(t0_)); const int lane_ = t0_ & 63, tk_ = lane_ >> 2, cg_ = lane_ & 3; const int pi_ = (gi_) * 128 + 16 * w + tk_; const int tp_ = d ? ((T_) - 1 - pi_) : pi_; \
        const long row_ = (rbase_) + tp_; const long rp_ = row_ - (tp_ > 0 ? 1 : 0), rn_ = row_ + (tp_ < (T_) - 1 ? 1 : 0); \
        _Pragma("unroll") for (int q_ = 0; q_ < 2; ++q_) _Pragma("unroll") for (int g_ = 0; g_ < 5; ++g_) { \
            const int col_ = (g_ == 0 ? h * 64 : g_ == 1 ? 512 + h * 64 : g_ == 2 ? 1024 + h * 64 : g_ == 3 ? 1536 + d * 64 : 1664 + d * 64) + q_ * 32 + cg_ * 8; \
            raw[q_][g_][0] = *(const u32x4*)(u + row_ * RWC + col_); raw[q_][g_][1] = *(const u32x4*)(u + rp_ * RWC + col_); raw[q_][g_][2] = *(const u32x4*)(u + rn_ * RWC + col_); } } while (0)
    RW4_PREFETCH(CTXL, (long)RL + b * CTXL, 0);
    __syncthreads();
    for (int seq = 0; seq < 2; ++seq) {
        const int T = seq ? SEQ : CTXL; const long rbase = seq ? (long)b * SEQ : (long)RL + b * CTXL; const int ngr = T / 128;
        for (int gi = 0; gi < ngr; ++gi) {
            int tid = tid0; asm volatile("" : "+v"(tid));
            const int lane = tid & 63, fr = lane & 15, fq = lane >> 4, tk = lane >> 2, cg = lane & 3;
            LAS unsigned char* R = L + w * RGN;
            { unsigned sp = 0; while (*(volatile LAS unsigned*)(dne + w) != 4u * gseq) { __builtin_amdgcn_s_sleep(1); if (++sp > (1u << 24)) break; } }
            asm volatile("" ::: "memory");
            {
                const int pi = gi * 128 + 16 * w + tk; const int tpos = d ? (T - 1 - pi) : pi; const long row = rbase + tpos;
                float r[16], k[16], kk[16], av[16], kd[16], lw[16];
                {
                    const float mp = (tpos > 0) ? 0.5f : 0.f, mn = (tpos < T - 1) ? 0.5f : 0.f;
#pragma unroll
                    for (int q = 0; q < 2; ++q) { const int c8 = q * 32 + cg * 8;
#pragma unroll
                        for (int g5 = 0; g5 < 5; ++g5) {
                            float x[8], p[8], n[8], o[8];
                            unpack8(raw[q][g5][0], x); unpack8(raw[q][g5][1], p); unpack8(raw[q][g5][2], n);
                            const f32x4 m0 = *(const LAS f32x4*)(prm + g5 * 64 + c8), m1 = *(const LAS f32x4*)(prm + g5 * 64 + c8 + 4);
#pragma unroll
                            for (int j = 0; j < 8; ++j) o[j] = x[j] + (j < 4 ? m0[j & 3] : m1[j & 3]) * (mp * p[j] + mn * n[j] - x[j]);
                            if (g5 == 0) {
#pragma unroll
                                for (int j = 0; j < 8; ++j) r[8 * q + j] = o[j]; }
                            else if (g5 == 1) {
#pragma unroll
                                for (int j = 0; j < 8; ++j) k[8 * q + j] = o[j]; }
                            else if (g5 == 2) *(LAS u32x4*)(R + R_V + (tk * PT + c8) * 2) = pack8(o);
                            else if (g5 == 3) {
#pragma unroll
                                for (int j = 0; j < 8; ++j) o[j] = fast_tanh(o[j]);
                                *(LAS u32x4*)(R + R_XWD + (tk * PT + c8) * 2) = pack8(o); }
                            else *(LAS u32x4*)(R + R_XAD + (tk * PT + c8) * 2) = pack8(o);
                        } }
                }
                {
                    const LAS bf16_t* Xwd = (const LAS bf16_t*)(R + R_XWD); const LAS bf16_t* Xad = (const LAS bf16_t*)(R + R_XAD);
                    LAS float* Zl = (LAS float*)(R + R_ZL); LAS float* Al = (LAS float*)(R + R_AL);
                    bf16x8 fw[2], fa[2];
#pragma unroll
                    for (int ks = 0; ks < 2; ++ks) { fw[ks] = *(const LAS bf16x8*)(Xwd + fr * PT + ks * 32 + fq * 8); fa[ks] = *(const LAS bf16x8*)(Xad + fr * PT + ks * 32 + fq * 8); }
#pragma unroll
                    for (int tn = 0; tn < 4; ++tn) { f32x4 az = {0.f, 0.f, 0.f, 0.f}, aa = {0.f, 0.f, 0.f, 0.f};
#pragma unroll
                        for (int ks = 0; ks < 2; ++ks) { az = mm32(fw[ks], *(const bf16x8*)(w2g + (16 * tn + fr) * 64 + ks * 32 + fq * 8), az); aa = mm32(fa[ks], *(const bf16x8*)(a2g + (16 * tn + fr) * 64 + ks * 32 + fq * 8), aa); }
#pragma unroll
                        for (int e = 0; e < 4; ++e) { Zl[(4 * fq + e) * 64 + 16 * tn + fr] = az[e]; Al[(4 * fq + e) * 64 + 16 * tn + fr] = aa[e]; } }
                }
                {
                    const LAS float* Zl = (const LAS float*)(R + R_ZL); const LAS float* Al = (const LAS float*)(R + R_AL);
                    float ss = 0.f, bs = 0.f;
                    float pkk[16], pw0[16], pa0[16], pka[16], prk[16], zz[16], aa2[16];
#pragma unroll
                    for (int q = 0; q < 2; ++q) { const int c8 = q * 32 + cg * 8;
#pragma unroll
                        for (int hh = 0; hh < 2; ++hh) { const int o4 = c8 + 4 * hh, i4 = 8 * q + 4 * hh;
                            const f32x4 a = *(const LAS f32x4*)(prm + 448 + o4), b2 = *(const LAS f32x4*)(prm + 320 + o4), c = *(const LAS f32x4*)(prm + 384 + o4), d2 = *(const LAS f32x4*)(prm + 512 + o4), e2 = *(const LAS f32x4*)(prm + 576 + o4);
                            const f32x4 z4 = *(const LAS f32x4*)(Zl + tk * 64 + o4), a4 = *(const LAS f32x4*)(Al + tk * 64 + o4);
#pragma unroll
                            for (int j = 0; j < 4; ++j) { pkk[i4 + j] = a[j]; pw0[i4 + j] = b2[j]; pa0[i4 + j] = c[j]; pka[i4 + j] = d2[j]; prk[i4 + j] = e2[j]; zz[i4 + j] = z4[j]; aa2[i4 + j] = a4[j]; } } }
#pragma unroll
                    for (int i = 0; i < 16; ++i) { kk[i] = k[i] * pkk[i]; ss += kk[i] * kk[i]; }
                    ss += shx(ss, 1, lane); ss += shx(ss, 2, lane);
                    const float inv = __builtin_amdgcn_rsqf(fmaxf(ss, 1e-24f));
#pragma unroll
                    for (int i = 0; i < 16; ++i) {
                        kk[i] *= inv;
                        lw[i] = -sigmoidf_(zz[i] + pw0[i]) * 0.8750612633917001f;
                        av[i] = sigmoidf_(aa2[i] + pa0[i]);
                        kd[i] = k[i] * (1.0f + (av[i] - 1.0f) * pka[i]);
                        bs += r[i] * kd[i] * prk[i]; }
                    bs += shx(bs, 1, lane); bs += shx(bs, 2, lane);
                    if (cg == 0) bsc[(size_t)row * 8 + h] = bs;
                }
                float cum[16], cumL[16];
                {
                    LAS float* Sc = (LAS float*)(R + R_ZL);
#pragma unroll
                    for (int q = 0; q < 2; ++q) { *(LAS f32x4*)(Sc + tk * 64 + q * 32 + cg * 8) = (f32x4){lw[8 * q], lw[8 * q + 1], lw[8 * q + 2], lw[8 * q + 3]}; *(LAS f32x4*)(Sc + tk * 64 + q * 32 + cg * 8 + 4) = (f32x4){lw[8 * q + 4], lw[8 * q + 5], lw[8 * q + 6], lw[8 * q + 7]}; }
                    float a = 0.f;
#pragma unroll
                    for (int t = 0; t < 16; ++t) { a += Sc[t * 64 + lane]; Sc[t * 64 + lane] = a; }
#pragma unroll
                    for (int q = 0; q < 2; ++q) { const f32x4 c0 = *(const LAS f32x4*)(Sc + tk * 64 + q * 32 + cg * 8), c1 = *(const LAS f32x4*)(Sc + tk * 64 + q * 32 + cg * 8 + 4);
                        const f32x4 l0 = *(const LAS f32x4*)(Sc + 15 * 64 + q * 32 + cg * 8), l1 = *(const LAS f32x4*)(Sc + 15 * 64 + q * 32 + cg * 8 + 4);
#pragma unroll
                        for (int e = 0; e < 4; ++e) { cum[8 * q + e] = c0[e]; cum[8 * q + 4 + e] = c1[e]; cumL[8 * q + e] = l0[e]; cumL[8 * q + 4 + e] = l1[e]; } }
                }
                {
#pragma unroll
                    for (int q = 0; q < 2; ++q) { float ta[8], tb[8], tkk[8], tr[8], bh[8], kh[8], plv[8]; const int c8 = q * 32 + cg * 8;
#pragma unroll
                        for (int e = 0; e < 8; ++e) { const int i = 8 * q + e;
                            const float e3 = __builtin_amdgcn_exp2f(cum[i]), e2 = __builtin_amdgcn_rcpf(e3), e1 = __builtin_amdgcn_exp2f(cum[i] - lw[i]), e4 = __builtin_amdgcn_exp2f(cumL[i] - cum[i]);
                            const float ka = kk[i] * av[i];
                            ta[e] = -kk[i] * e1; tb[e] = ka * e2; tkk[e] = kd[i] * e2; tr[e] = r[i] * e3; bh[e] = ka * e4; kh[e] = kd[i] * e4;
                            plv[e] = e3; }
                        *(LAS u32x4*)(R + R_TA + (tk * PT + c8) * 2) = pack8(ta); *(LAS u32x4*)(R + R_TB + (tk * PT + c8) * 2) = pack8(tb); *(LAS u32x4*)(R + R_TK + (tk * PT + c8) * 2) = pack8(tkk);
                        *(LAS u32x4*)(R + R_TR + (tk * PT + c8) * 2) = pack8(tr); *(LAS u32x4*)(R + R_BH + (tk * PT + c8) * 2) = pack8(bh); *(LAS u32x4*)(R + R_KH + (tk * PT + c8) * 2) = pack8(kh);
                        if (tk == 15) { LAS float* pp = (LAS float*)(R + R_PL) + c8; *(LAS f32x4*)pp = (f32x4){plv[0], plv[1], plv[2], plv[3]}; *(LAS f32x4*)(pp + 4) = (f32x4){plv[4], plv[5], plv[6], plv[7]}; } }
                }
                {
                    const LAS bf16_t* TA = (const LAS bf16_t*)(R + R_TA); const LAS bf16_t* TB = (const LAS bf16_t*)(R + R_TB); const LAS bf16_t* TK = (const LAS bf16_t*)(R + R_TK);
                    const LAS bf16_t* TR = (const LAS bf16_t*)(R + R_TR); const LAS bf16_t* BH = (const LAS bf16_t*)(R + R_BH); const LAS bf16_t* KH = (const LAS bf16_t*)(R + R_KH);
                    f32x4 Mab = {0.f, 0.f, 0.f, 0.f}, MabT = Mab, MakT = Mab, Mbr = Mab, Mkr = Mab;
#pragma unroll
                    for (int ks = 0; ks < 2; ++ks) { const int o = fr * PT + ks * 32 + fq * 8;
                        const bf16x8 fa = *(const LAS bf16x8*)(TA + o), fb = *(const LAS bf16x8*)(TB + o), fk = *(const LAS bf16x8*)(TK + o), frr = *(const LAS bf16x8*)(TR + o);
                        Mab = mm32(fb, fa, Mab); MabT = mm32(fa, fb, MabT); MakT = mm32(fa, fk, MakT); Mbr = mm32(fb, frr, Mbr); Mkr = mm32(fk, frr, Mkr); }
                    s16x4 bhf[4], atf[4], rin[4], kin[4];
#pragma unroll
                    for (int jt = 0; jt < 4; ++jt) { bhf[jt] = trd(BH, 0, 16 * jt, lane); atf[jt] = trd(TA, 0, 16 * jt, lane); kin[jt] = trd(KH, 0, 16 * jt, lane); rin[jt] = *(const LAS s16x4*)(TR + fr * PT + 16 * jt + 4 * fq); }
                    f32x4 Pm, Pt;
#pragma unroll
                    for (int e = 0; e < 4; ++e) { const int m = 4 * fq + e, n = fr;
                        Mab[e] = (m < n) ? Mab[e] : 0.f; MabT[e] = (n < m) ? MabT[e] : 0.f; MakT[e] = (n < m) ? MakT[e] : 0.f; Mbr[e] = (m <= n) ? Mbr[e] : 0.f; Mkr[e] = (m <= n) ? Mkr[e] : 0.f;
                        const float id = (m == n) ? 1.f : 0.f; Pm[e] = Mab[e] + id; Pt[e] = MabT[e] + id; }
                    f32x4 Nn = Mab, Nt = MabT; const f32x4 zero = {0.f, 0.f, 0.f, 0.f};
#pragma unroll
                    for (int it = 0; it < 3; ++it) {
                        const s16x4 cn = cv4(Nn), cnt = cv4(Nt);
                        const f32x4 N2 = mm16(cnt, cn, zero), Nt2 = mm16(cn, cnt, zero);
                        const s16x4 cpt = cv4(Pt), cn2 = cv4(N2);
                        const f32x4 Pn = mm16(cpt, cn2, Pm), Ptn = mm16(cn2, cpt, Pt);
                        Nn = N2; Nt = Nt2; Pm = Pn; Pt = Ptn;
                    }
                    const s16x4 cT = cv4(Pm), cMakT = cv4(MakT), cMbr = cv4(Mbr);
                    const f32x4 Q1T = mm16(cT, cMakT, zero);
                    const s16x4 cQ1T = cv4(Q1T);
                    const f32x4 Hy = mm16(cQ1T, cMbr, Mkr);
                    asm volatile("s_waitcnt lgkmcnt(0)" ::: "memory");
                    LAS unsigned char* ring = R + lane * 8;
                    *(LAS s16x4*)(ring + 20 * 512) = cv4(Hy);
#pragma unroll
                    for (int jt = 0; jt < 4; ++jt) {
                        const f32x4 P1T = mm16(cT, atf[jt], zero); const s16x4 cP1T = cv4(P1T);
                        const f32x4 Gy = mm16(cP1T, cMbr, bf4_to_f(rin[jt]));
                        *(LAS s16x4*)(ring + jt * 512) = cv4(Gy);
#pragma unroll
                        for (int j2 = 0; j2 < 4; ++j2) { const f32x4 Gs = mm16(cP1T, bhf[j2], zero); *(LAS s16x4*)(ring + (4 + jt * 4 + j2) * 512) = cv4(Gs); }
                        const f32x4 Hs = mm16(cQ1T, bhf[jt], bf4_to_f(kin[jt]));
                        *(LAS s16x4*)(ring + (21 + jt) * 512) = cv4(Hs);
                    }
                }
            }
            {
                const bool more = gi + 1 < ngr; const bool nseq = !more && seq == 0;
                const int nT = nseq ? SEQ : T; const long nrb = nseq ? (long)b * SEQ : rbase; const int ngi = more ? gi + 1 : (nseq ? 0 : gi);
                RW4_PREFETCH(nT, nrb, ngi);
            }
            ++gseq;
            asm volatile("s_waitcnt lgkmcnt(0)" ::: "memory");
            if (lane == 0) rdy[w] = gseq;
            asm volatile("" ::: "memory");
            if (w < 4) {
                const int it = w;
#pragma unroll 1
                for (int s = 0; s < 8; ++s) {
                    { unsigned sp = 0; while (rdy[s] != gseq) { __builtin_amdgcn_s_sleep(1); if (++sp > (1u << 24)) break; } }
                    asm volatile("" ::: "memory");
                    const LAS unsigned char* Rs = L + s * RGN; const LAS unsigned char* ring = Rs + lane * 8;
                    const s16x4 vb = trd((const LAS bf16_t*)(Rs + R_V), 0, 16 * it, lane);
                    s16x4 zb[4];
#pragma unroll
                    for (int jt = 0; jt < 4; ++jt) zb[jt] = cv4(Z[jt]);
                    f32x4 Yt = mm16(*(const LAS s16x4*)(ring + 20 * 512), vb, (f32x4){0.f, 0.f, 0.f, 0.f});
#pragma unroll
                    for (int jt = 0; jt < 4; ++jt) Yt = mm16(*(const LAS s16x4*)(ring + jt * 512), zb[jt], Yt);
#pragma unroll
                    for (int e = 0; e < 4; ++e) { const int pi = gi * 128 + 16 * s + 4 * fq + e; const int tp = d ? (T - 1 - pi) : pi;
                        od[(size_t)(rbase + tp) * 512 + h * 64 + 16 * it + fr] = (bf16_t)f2bf(Yt[e]); }
                    f32x4 Zn[4];
#pragma unroll
                    for (int j2 = 0; j2 < 4; ++j2) {
                        const f32x4 pv = *(const LAS f32x4*)((const LAS float*)(Rs + R_PL) + 16 * j2 + 4 * fq);
                        f32x4 zn = Z[j2] * pv;
                        zn = mm16(*(const LAS s16x4*)(ring + (21 + j2) * 512), vb, zn);
#pragma unroll
                        for (int jt = 0; jt < 4; ++jt) zn = mm16(*(const LAS s16x4*)(ring + (4 + jt * 4 + j2) * 512), zb[jt], zn);
                        Zn[j2] = zn;
                    }
#pragma unroll
                    for (int j2 = 0; j2 < 4; ++j2) Z[j2] = Zn[j2];
                    asm volatile("s_waitcnt lgkmcnt(0)" ::: "memory");
                    if (lane == 0) (void)__hip_atomic_fetch_add(dne + s, 1u, __ATOMIC_RELAXED, __HIP_MEMORY_SCOPE_WORKGROUP);
                }
            }
        }
    }
#undef RW4_PREFETCH
}

__device__ __forceinline__ void rwkv_post_phase(const Ctx& F, int layer, int nrows_y) {
    PP P = getpp(); unsigned char* ws = P->ws;
    const bf16_t* u = (const bf16_t*)(ws + D_URWKV); const bf16_t* of = (const bf16_t*)(ws + D_OF); const bf16_t* ob = (const bf16_t*)(ws + D_OB);
    bf16_t* y = (bf16_t*)(ws + D_YRWKV);
    const float* bf_ = (const float*)(ws + WS_BSC); const float* bb_ = bf_ + (size_t)RT * 8;
    const float* mu = P->in[I_MU] + layer * RWC; const float* lng = P->in[I_LNG] + layer * 512; const float* lnb = P->in[I_LNB] + layer * 512;
    const bf16_t* wg2 = (const bf16_t*)(ws + WS_WG2) + (size_t)layer * 512 * 128;
    LAS bf16_t* sg = (LAS bf16_t*)F.lds;
    LAS bf16_t* gt = (LAS bf16_t*)(F.lds + 64 * 136 * 2);
    const int tid0 = F.tid, wave = F.wave; const int lane = F.lane;
    const int nunits = nrows_y / 64;
    for (int un = F.bid; un < nunits; un += F.G) {
        int tid = tid0; asm volatile("" : "+v"(tid)); const int lane = tid & 63;
        bf16x8 bfr[4][4];
#pragma unroll
        for (int tn = 0; tn < 4; ++tn)
#pragma unroll
            for (int k = 0; k < 4; ++k) bfr[tn][k] = *(const bf16x8*)(wg2 + (size_t)((wave * 4 + tn) * 16 + (lane & 15)) * 128 + k * 32 + (lane >> 4) * 8);
        const long r0 = (long)un * 64; const bool lat = r0 < RL; const int T = lat ? SEQ : CTXL; const int tbase = lat ? (int)(r0 & (SEQ - 1)) : (int)((r0 - RL) & (CTXL - 1));
        for (int it = tid; it < 1024; it += NTHREADS) { const int tk = it >> 4, q = it & 15; float v[8]; load8_shift(u, r0 + tk, tbase + tk, T, 1792 + q * 8, mu, v);
#pragma unroll
            for (int j = 0; j < 8; ++j) v[j] = sigmoidf_(v[j]);
            *(LAS u32x4*)(sg + tk * 136 + q * 8) = pack8(v); }
        __syncthreads();
        {
            const int fr = lane & 15, fq = lane >> 4;
#pragma unroll
            for (int tm = 0; tm < 4; ++tm) { bf16x8 af[4];
#pragma unroll
                for (int k = 0; k < 4; ++k) af[k] = *(const LAS bf16x8*)(sg + (tm * 16 + fr) * 136 + k * 32 + fq * 8);
                __builtin_amdgcn_sched_barrier(0);
#pragma unroll
                for (int tn = 0; tn < 4; ++tn) { const int cn = (wave * 4 + tn) * 16; f32x4 acc = {0.f, 0.f, 0.f, 0.f};
#pragma unroll
                    for (int k = 0; k < 4; ++k) acc = __builtin_amdgcn_mfma_f32_16x16x32_bf16(af[k], bfr[tn][k], acc, 0, 0, 0);
#pragma unroll
                    for (int j = 0; j < 4; ++j) gt[(tm * 16 + fq * 4 + j) * 520 + cn + fr] = (bf16_t)f2bf(acc[j]); } }
        }
        __syncthreads();
        {
            const int c8 = lane * 8, hh = lane >> 3;
            const f32x4 mu0 = *(const f32x4*)(mu + 1024 + c8), mu1 = *(const f32x4*)(mu + 1024 + c8 + 4), lg0 = *(const f32x4*)(lng + c8), lg1 = *(const f32x4*)(lng + c8 + 4), lb0 = *(const f32x4*)(lnb + c8), lb1 = *(const f32x4*)(lnb + c8 + 4);
            u32x4 ld[2][5]; float bs[2][2];
#define RP_LOAD(s_, it_) do { const int tk_ = wave * 8 + (it_); const long row_ = r0 + tk_; const int t_ = tbase + tk_; const bool hp_ = t_ > 0, hn_ = t_ < T - 1; \
                ld[s_][0] = *(const u32x4*)(of + row_ * 512 + c8); ld[s_][1] = *(const u32x4*)(ob + row_ * 512 + c8); \
                ld[s_][2] = *(const u32x4*)(u + row_ * RWC + 1024 + c8); ld[s_][3] = *(const u32x4*)(u + (row_ - (hp_ ? 1 : 0)) * RWC + 1024 + c8); ld[s_][4] = *(const u32x4*)(u + (row_ + (hn_ ? 1 : 0)) * RWC + 1024 + c8); \
                bs[s_][0] = bf_[row_ * 8 + hh]; bs[s_][1] = bb_[row_ * 8 + hh]; } while (0)
            RP_LOAD(0, 0);
#pragma unroll
            for (int it = 0; it < 8; ++it) { const int s = it & 1;
                if (it < 7) RP_LOAD((it + 1) & 1, it + 1);
                const int tk = wave * 8 + it; const long row = r0 + tk; const int t = tbase + tk; const float mp = (t > 0) ? 0.5f : 0.f, mn = (t < T - 1) ? 0.5f : 0.f;
                float a[8], c[8], x[8], p[8], n[8], g8[8], o[8], res[8];
                unpack8(ld[s][0], a); unpack8(ld[s][1], c); unpack8(ld[s][2], x); unpack8(ld[s][3], p); unpack8(ld[s][4], n);
                unpack8(*(const LAS u32x4*)(gt + tk * 520 + c8), g8);
                float sm = 0.f;
#pragma unroll
                for (int j = 0; j < 8; ++j) { o[j] = a[j] + c[j]; sm += o[j]; }
                sm += shx(sm, 1, lane); sm += shx(sm, 2, lane); sm += shx(sm, 4, lane);
                const float mean = sm * (1.0f / 64.0f); float vs = 0.f;
#pragma unroll
                for (int j = 0; j < 8; ++j) { const float dd = o[j] - mean; vs += dd * dd; }
                vs += shx(vs, 1, lane); vs += shx(vs, 2, lane); vs += shx(vs, 4, lane);
                const float rstd = rsqrtf(vs * (1.0f / 64.0f) + 64e-5f); const float bsum = bs[s][0] + bs[s][1];
#pragma unroll
                for (int j = 0; j < 8; ++j) { const float muj = j < 4 ? mu0[j & 3] : mu1[j & 3], lgj = j < 4 ? lg0[j & 3] : lg1[j & 3], lbj = j < 4 ? lb0[j & 3] : lb1[j & 3];
                    const float vv = x[j] + muj * (mp * p[j] + mn * n[j] - x[j]);
                    res[j] = ((o[j] - mean) * rstd * lgj + lbj + bsum * vv) * g8[j]; }
                *(u32x4*)(y + row * 512 + c8) = pack8(res); }
#undef RP_LOAD
        }
        __syncthreads();
    }
}
__device__ __forceinline__ void ctx_krope_proj(const Ctx& F, int layer) {
    unsigned char* ws = getpp()->ws;
    const bf16_t* xlo = (const bf16_t*)(ws + D_XN1); const bf16_t* xhi = (const bf16_t*)(ws + D_XN1 + Y34);
    const bf16_t* wlo = (const bf16_t*)(ws + WS_W + (size_t)layer * WL_STRIDE + WL_WINLO); const bf16_t* whi = (const bf16_t*)(ws + WS_W + (size_t)layer * WL_STRIDE + WL_WINHI);
    bf16_t* um = (bf16_t*)(ws + D_UMLA);
    LAS float* part = (LAS float*)F.lds;
    const int lane = F.lane, w = F.wave, fr = lane & 15, fq = lane >> 4;
    for (int task = (F.bid + F.G - 128 % F.G) % F.G; task < RC / 16; task += F.G) {
        const long r0 = (long)RL + task * 16;
        const bf16_t* xa = (w < 4 ? xlo : xhi) + (r0 + fr) * 512 + (w & 3) * 128 + fq * 8;
        const bf16_t* wb = (w < 4 ? wlo : whi) + (size_t)(4096 + fr) * 512 + (w & 3) * 128 + fq * 8;
        bf16x8 a[4], b0[4], b1[4];
#pragma unroll
        for (int ks = 0; ks < 4; ++ks) { a[ks] = *(const bf16x8*)(xa + ks * 32); b0[ks] = *(const bf16x8*)(wb + ks * 32); b1[ks] = *(const bf16x8*)(wb + 16 * 512 + ks * 32); }
        f32x4 c0 = {0.f, 0.f, 0.f, 0.f}, c1 = {0.f, 0.f, 0.f, 0.f};
#pragma unroll
        for (int ks = 0; ks < 4; ++ks) { c0 = __builtin_amdgcn_mfma_f32_16x16x32_bf16(a[ks], b0[ks], c0, 0, 0, 0); c1 = __builtin_amdgcn_mfma_f32_16x16x32_bf16(a[ks], b1[ks], c1, 0, 0, 0); }
#pragma unroll
        for (int j = 0; j < 4; ++j) { part[(w * 16 + 4 * fq + j) * 33 + fr] = c0[j]; part[(w * 16 + 4 * fq + j) * 33 + 16 + fr] = c1[j]; }
        __syncthreads();
        { const int row = F.tid >> 5, col = F.tid & 31; float s = 0.f;
#pragma unroll
          for (int ww = 0; ww < 8; ++ww) s += part[(ww * 16 + row) * 33 + col];
          um[(r0 + row) * MLC + 640 + col] = (bf16_t)f2bf(s); }
        __syncthreads();
    }
}
__device__ __forceinline__ void mla_stats_pass(const Ctx& F, int w0, int nw) {
    unsigned char* ws = getpp()->ws; const int lane = F.lane;
    const bf16_t* um = (const bf16_t*)(ws + D_UMLA); float* rq = (float*)(ws + WS_RSTD); float* rkv = rq + RT;
    constexpr int NBS = 6;
    for (int rb = GW(F) - w0; rb < RT; rb += nw * NBS) {
        u32x4 a[NBS], c[NBS];
#pragma unroll
        for (int b = 0; b < NBS; ++b) { const int row = (rb + b * nw < RT) ? rb + b * nw : rb; const bf16_t* ur = um + (size_t)row * MLC;
            a[b] = *(const u32x4*)(ur + lane * 8); c[b] = *(const u32x4*)(ur + 512 + (lane & 15) * 8); }
        __builtin_amdgcn_sched_barrier(0);
        float sq[NBS], skv[NBS];
#pragma unroll
        for (int b = 0; b < NBS; ++b) { float v[8], s = 0.f, s2 = 0.f; unpack8(a[b], v);
#pragma unroll
            for (int j = 0; j < 8; ++j) s += v[j] * v[j];
            unpack8(c[b], v);
#pragma unroll
            for (int j = 0; j < 8; ++j) s2 += v[j] * v[j];
            sq[b] = (lane < 48) ? s : 0.f; skv[b] = ((lane < 48) ? 0.f : s) + ((lane < 16) ? s2 : 0.f); }
#pragma unroll
        for (int b = 0; b < NBS; ++b) { sq[b] = wave_sum(sq[b], lane); skv[b] = wave_sum(skv[b], lane); }
#pragma unroll
        for (int b = 0; b < NBS; ++b) { const int row = rb + b * nw;
            if (lane == 0 && row < RT) { rq[row] = rsqrtf(sq[b] * (1.0f / 384.0f) + 1e-6f); rkv[row] = rsqrtf(skv[b] * (1.0f / 256.0f) + 1e-6f); } }
    }
}
__device__ __forceinline__ void krope_pass(const Ctx& F, int half, int layer) {
    unsigned char* ws = getpp()->ws; const int lane = F.lane;
    const bf16_t* um = (const bf16_t*)(ws + D_UMLA); bf16_t* Kb = half ? (bf16_t*)(ws + D_K) : (bf16_t*)(half_a_base(layer) + HA_K);
    const float* cm = (const float*)(ws + WS_ROPE_M); const float* sm = cm + 4096 * 16;
    for (int ci = GW(F) * 16 + (lane >> 2); ci < HROWS; ci += NGW(F) * 16) {
        const int row = ci < 4 * SEQ ? 4 * SEQ * half + ci : RL + 4 * CTXL * half + (ci - 4 * SEQ);
        const int orow = half ? row : ci; const int l4 = lane & 3;
        const bf16_t* ur = um + (size_t)row * MLC + 640 + 4 * l4;
        const u32x2 wa = *(const u32x2*)ur, wb = *(const u32x2*)(ur + 16);
        f32x4 x1 = {bflo(wa.x), bfhi(wa.x), bflo(wa.y), bfhi(wa.y)}, x2 = {bflo(wb.x), bfhi(wb.x), bflo(wb.y), bfhi(wb.y)};
        if (row < RL) { const int t = row & (SEQ - 1); const f32x4 cs = *(const f32x4*)(cm + t * 16 + 4 * l4), sn = *(const f32x4*)(sm + t * 16 + 4 * l4);
            const f32x4 o1 = x1 * cs - x2 * sn, o2 = x1 * sn + x2 * cs; x1 = o1; x2 = o2; }
        u32x2 oa, ob; oa.x = pk2(x1[0], x1[1]); oa.y = pk2(x1[2], x1[3]); ob.x = pk2(x2[0], x2[1]); ob.y = pk2(x2[2], x2[3]);
        bf16_t* kd = Kb + (size_t)orow * 544 + 512 + 4 * l4; *(u32x2*)kd = oa; *(u32x2*)(kd + 16) = ob;
    }
}

constexpr size_t D_KV = D_END1;
static_assert(D_FFW == D_KV, "layer-0 FFN weights overlay the retention-state region");
static_assert(D_KV + 34 * MiB <= WS_NEED, "retention state buffer");
namespace ret2 {
constexpr int QP = 72, VP = 136, NUNITS = NBATCH * 4 * 34;
typedef short v4i16_t __attribute__((ext_vector_type(4)));
__device__ __forceinline__ bf16x8 tr8(const LAS bf16_t* base, int pitch, int row0, int col0, int lane) {
    const int g = lane >> 4, i = lane & 15, q = i >> 2, p = i & 3;
    const LAS bf16_t* a = base + (row0 + 8 * g + q) * pitch + col0 + 4 * p;
    const s16x4 lo = __builtin_bit_cast(s16x4, __builtin_amdgcn_ds_read_tr16_b64_v4i16((LAS v4i16_t*)a));
    const s16x4 hi = __builtin_bit_cast(s16x4, __builtin_amdgcn_ds_read_tr16_b64_v4i16((LAS v4i16_t*)(a + 4 * pitch)));
    return (bf16x8){lo[0], lo[1], lo[2], lo[3], hi[0], hi[1], hi[2], hi[3]};
}
__device__ __forceinline__ f32x4 mm32(bf16x8 a, bf16x8 b, f32x4 c) { return __builtin_amdgcn_mfma_f32_16x16x32_bf16(a, b, c, 0, 0, 0); }
struct UnitPos { int b, h, cs; long rbase; bool isctx; int t0; };
__device__ __forceinline__ UnitPos unit_pos(int un) { UnitPos U; const int bh = un / 34; U.cs = un % 34; U.b = bh >> 2; U.h = bh & 3; U.isctx = U.cs < 2;
    U.t0 = U.isctx ? 0 : (U.cs - 2) * 128; U.rbase = U.isctx ? (long)RL + U.b * CTXL + U.cs * 128 : (long)U.b * SEQ + U.t0; return U; }
}
__device__ __forceinline__ void ret_r1_prefetch(const Ctx& F, int un, u32x4* pv, u32x4* pk) {
    using namespace ret2;
    const bf16_t* u = (const bf16_t*)(getpp()->ws + D_URET); const UnitPos U = unit_pos(un); int tid = F.tid; asm volatile("" : "+v"(tid));
#pragma unroll
    for (int k4 = 0; k4 < 4; ++k4) { const int it = tid + 512 * k4, tv = it >> 4, ch = it & 15; pv[k4] = *(const u32x4*)(u + (U.rbase + tv) * REC + 512 + U.h * 128 + ch * 8); }
    const int tk = tid >> 2, pc = tid & 3; const bf16_t* kp = u + (U.rbase + tk) * REC + 256 + U.h * 64 + pc * 8; pk[0] = *(const u32x4*)kp; pk[1] = *(const u32x4*)(kp + 32);
}
__device__ __forceinline__ void ret_r1_unit(const Ctx& F, int layer, int un, int nun, u32x4* pv, u32x4* pk) {
    using namespace ret2;
    PP P = getpp(); unsigned char* ws = P->ws;
    const bf16_t* u = (const bf16_t*)(ws + D_URET); bf16_t* kv = (bf16_t*)(ws + D_KV);
    const float* cr = (const float*)(ws + WS_ROPE_R); const float* sr = cr + 4096 * 32;
    const UnitPos U = unit_pos(un);
    const float lgf = -__expf(P->in[I_RDEC][(layer * 2 + 0) * 4 + U.h]) * 1.4426950408889634f, lgb = -__expf(P->in[I_RDEC][(layer * 2 + 1) * 4 + U.h]) * 1.4426950408889634f;
    LAS bf16_t* Vt = (LAS bf16_t*)F.lds; LAS bf16_t* kzf = Vt + 128 * VP; LAS bf16_t* kzb = kzf + 128 * QP; LAS bf16_t* St = kzb + 128 * QP;
    const int tid = F.tid, lane = F.lane, w = F.wave;
    {
        const int tk = tid >> 2, pc = tid & 3; float k1[8], k2[8], a[8], c[8];
        f32x4 rc[2], rs[2];
        { const int ro = (U.t0 + tk) * 32 + pc * 8; rc[0] = *(const f32x4*)(cr + ro); rc[1] = *(const f32x4*)(cr + ro + 4); rs[0] = *(const f32x4*)(sr + ro); rs[1] = *(const f32x4*)(sr + ro + 4); }
        __builtin_amdgcn_sched_barrier(0);
        unpack8(pk[0], k1); unpack8(pk[1], k2);
#pragma unroll
        for (int j = 0; j < 8; ++j) { const float cs = U.isctx ? 1.0f : rc[j >> 2][j & 3], sn = U.isctx ? 0.0f : rs[j >> 2][j & 3];
            const float ka_ = k1[j] * cs - k2[j] * sn, kb_ = k1[j] * sn + k2[j] * cs; k1[j] = ka_; k2[j] = kb_; }
        const float zf = 0.125f * __builtin_amdgcn_exp2f((float)(127 - tk) * lgf), zb = 0.125f * __builtin_amdgcn_exp2f((float)tk * lgb);
#pragma unroll
        for (int j = 0; j < 8; ++j) { a[j] = k1[j] * zf; c[j] = k2[j] * zf; }
        *(LAS u32x4*)(kzf + tk * QP + pc * 8) = pack8(a); *(LAS u32x4*)(kzf + tk * QP + 32 + pc * 8) = pack8(c);
#pragma unroll
        for (int j = 0; j < 8; ++j) { a[j] = k1[j] * zb; c[j] = k2[j] * zb; }
        *(LAS u32x4*)(kzb + tk * QP + pc * 8) = pack8(a); *(LAS u32x4*)(kzb + tk * QP + 32 + pc * 8) = pack8(c);
#pragma unroll
        for (int k4 = 0; k4 < 4; ++k4) { const int it = tid + 512 * k4, tv = it >> 4, ch = it & 15; *(LAS u32x4*)(Vt + tv * VP + ch * 8) = pv[k4]; }
    }
    if (nun >= 0) ret_r1_prefetch(F, nun, pv, pk);
    __syncthreads();
    {
        const int fr = lane & 15, fq = lane >> 4;
        f32x4 acc[2][4];
#pragma unroll
        for (int dd = 0; dd < 2; ++dd)
#pragma unroll
            for (int tj = 0; tj < 4; ++tj) acc[dd][tj] = (f32x4){0.f, 0.f, 0.f, 0.f};
#pragma unroll
        for (int ks = 0; ks < 4; ++ks) { const bf16x8 a = tr8(Vt, VP, 32 * ks, 16 * w, lane);
            bf16x8 bf_[4], bb_[4];
#pragma unroll
            for (int tj = 0; tj < 4; ++tj) { bf_[tj] = tr8(kzf, QP, 32 * ks, 16 * tj, lane); bb_[tj] = tr8(kzb, QP, 32 * ks, 16 * tj, lane); }
            __builtin_amdgcn_sched_barrier(0);
#pragma unroll
            for (int tj = 0; tj < 4; ++tj) { acc[0][tj] = mm32(a, bf_[tj], acc[0][tj]); acc[1][tj] = mm32(a, bb_[tj], acc[1][tj]); }
            __builtin_amdgcn_sched_barrier(0); }
#pragma unroll
        for (int dd = 0; dd < 2; ++dd)
#pragma unroll
            for (int tj = 0; tj < 4; ++tj)
#pragma unroll
                for (int j = 0; j < 4; ++j) St[dd * 128 * QP + (16 * w + 4 * fq + j) * QP + 16 * tj + fr] = (bf16_t)f2bf(acc[dd][tj][j]);
    }
    __syncthreads();
#pragma unroll
    for (int k4 = 0; k4 < 4; ++k4) { const int it = tid + 512 * k4, dd = it >> 10, e = (it >> 3) & 127, ch = it & 7;
        *(u32x4*)(kv + ((size_t)un * 2 + dd) * 8192 + e * 64 + ch * 8) = *(const LAS u32x4*)(St + dd * 128 * QP + e * QP + ch * 8); }
    __syncthreads();
}
__device__ __forceinline__ void ret_r2(const Ctx& F, int layer, int b0, int nb) {
    using namespace ret2;
    PP P = getpp(); bf16_t* kv = (bf16_t*)(P->ws + D_KV);
    for (int item = (F.bid - b0) * NTHREADS + F.tid; item < 65536; item += nb * NTHREADS) {
        const int bh = item >> 11, dd = (item >> 10) & 1, off = (item & 1023) * 8;
        const float g = __builtin_amdgcn_exp2f(-128.0f * __expf(P->in[I_RDEC][(layer * 2 + dd) * 4 + (bh & 3)]) * 1.4426950408889634f);
        float st[8];
#pragma unroll
        for (int j = 0; j < 8; ++j) st[j] = 0.f;
#pragma unroll
        for (int half = 0; half < 2; ++half) {
            asm volatile("" ::: "memory");
            u32x4 xv[17];
#pragma unroll
            for (int q = 0; q < 17; ++q) { const int i = half * 17 + q; const int cs = dd ? (i < 2 ? 1 - i : 35 - i) : i;
                xv[q] = *(const u32x4*)(kv + ((size_t)(bh * 34 + cs) * 2 + dd) * 8192 + off); }
#pragma unroll
            for (int q = 0; q < 17; ++q) { const int i = half * 17 + q; const int cs = dd ? (i < 2 ? 1 - i : 35 - i) : i;
                float x[8]; unpack8(xv[q], x);
                *(u32x4*)(kv + ((size_t)(bh * 34 + cs) * 2 + dd) * 8192 + off) = pack8(st);
#pragma unroll
                for (int j = 0; j < 8; ++j) st[j] = st[j] * g + x[j]; }
        }
    }
}
__device__ __forceinline__ void ret_r3_prefetch(const Ctx& F, int un, u32x4* pv, u32x4* pr, u32x4* pq, u32x4* pk) {
    using namespace ret2;
    unsigned char* ws = getpp()->ws; const bf16_t* u = (const bf16_t*)(ws + D_URET); const bf16_t* kv = (const bf16_t*)(ws + D_KV);
    const UnitPos U = unit_pos(un); int tid = F.tid; asm volatile("" : "+v"(tid));
#pragma unroll
    for (int k4 = 0; k4 < 4; ++k4) { const int it = tid + 512 * k4, tv = it >> 4, ch = it & 15; pv[k4] = *(const u32x4*)(u + (U.rbase + tv) * REC + 512 + U.h * 128 + ch * 8); }
#pragma unroll
    for (int k4 = 0; k4 < 4; ++k4) { const int it = tid + 512 * k4, dd = it >> 10, e = (it >> 3) & 127, ch = it & 7; pr[k4] = *(const u32x4*)(kv + ((size_t)un * 2 + dd) * 8192 + e * 64 + ch * 8); }
    const int tk = tid >> 2, pc = tid & 3; const bf16_t* qp = u + (U.rbase + tk) * REC + U.h * 64 + pc * 8;
    pq[0] = *(const u32x4*)qp; pq[1] = *(const u32x4*)(qp + 32); pk[0] = *(const u32x4*)(qp + 256); pk[1] = *(const u32x4*)(qp + 288);
}
__device__ __forceinline__ void ret_r3_unit(const Ctx& F, int layer, int un, int nun, u32x4* pv, u32x4* pr, u32x4* pq, u32x4* pk) {
    using namespace ret2;
    PP P = getpp(); unsigned char* ws = P->ws;
    const bf16_t* u = (const bf16_t*)(ws + D_URET); const bf16_t* kv = (const bf16_t*)(ws + D_KV); bf16_t* y = (bf16_t*)(ws + D_YRET);
    const float* cr = (const float*)(ws + WS_ROPE_R); const float* sr = cr + 4096 * 32;
    const UnitPos U = unit_pos(un);
    const float* lng = P->in[I_RLNG] + layer * 512 + U.h * 128; const float* lnb = P->in[I_RLNB] + layer * 512 + U.h * 128;
    const float lgf = -__expf(P->in[I_RDEC][(layer * 2 + 0) * 4 + U.h]) * 1.4426950408889634f, lgb = -__expf(P->in[I_RDEC][(layer * 2 + 1) * 4 + U.h]) * 1.4426950408889634f;
    LAS bf16_t* qf = (LAS bf16_t*)F.lds; LAS bf16_t* qb = qf + 128 * QP; LAS bf16_t* qn = qb + 128 * QP; LAS bf16_t* ks = qn + 128 * QP; LAS bf16_t* Sm = qn;
    LAS bf16_t* Vt = (LAS bf16_t*)(F.lds + 73728); LAS bf16_t* Rf = (LAS bf16_t*)(F.lds + 108544); LAS bf16_t* Rb = Rf + 128 * QP; LAS bf16_t* Yst = qf;
    const int tid = F.tid, lane = F.lane, w = F.wave, fr = lane & 15, fq = lane >> 4;
    const int n0 = 16 * w;
    u32x4 gq[4]; float lgv[8], lbv[8];
#pragma unroll
    for (int k4 = 0; k4 < 4; ++k4) { const int it = lane + 64 * k4, r = it >> 4, ch = it & 15; gq[k4] = *(const u32x4*)(u + (U.rbase + n0 + r) * REC + 1024 + U.h * 128 + ch * 8); }
#pragma unroll
    for (int te = 0; te < 8; ++te) { lgv[te] = lng[16 * te + fr]; lbv[te] = lnb[16 * te + fr]; }
    const int tk = tid >> 2, pc = tid & 3;
    f32x4 rc[2], rs[2];
    { const int ro = (U.t0 + tk) * 32 + pc * 8; rc[0] = *(const f32x4*)(cr + ro); rc[1] = *(const f32x4*)(cr + ro + 4); rs[0] = *(const f32x4*)(sr + ro); rs[1] = *(const f32x4*)(sr + ro + 4); }
    __builtin_amdgcn_sched_barrier(0);
    {
        float q1[8], q2[8], k1[8], k2[8], a[8], c[8];
        unpack8(pq[0], q1); unpack8(pq[1], q2); unpack8(pk[0], k1); unpack8(pk[1], k2);
#pragma unroll
        for (int j = 0; j < 8; ++j) { const float cs = U.isctx ? 1.0f : rc[j >> 2][j & 3], sn = U.isctx ? 0.0f : rs[j >> 2][j & 3];
            const float qa_ = q1[j] * cs - q2[j] * sn, qb_ = q1[j] * sn + q2[j] * cs, ka_ = k1[j] * cs - k2[j] * sn, kb_ = k1[j] * sn + k2[j] * cs;
            q1[j] = qa_; q2[j] = qb_; k1[j] = ka_; k2[j] = kb_; }
        *(LAS u32x4*)(qn + tk * QP + pc * 8) = pack8(q1); *(LAS u32x4*)(qn + tk * QP + 32 + pc * 8) = pack8(q2);
        const float xf = __builtin_amdgcn_exp2f((float)(tk + 1) * lgf), xb = __builtin_amdgcn_exp2f((float)(128 - tk) * lgb);
#pragma unroll
        for (int j = 0; j < 8; ++j) { a[j] = q1[j] * xf; c[j] = q2[j] * xf; }
        *(LAS u32x4*)(qf + tk * QP + pc * 8) = pack8(a); *(LAS u32x4*)(qf + tk * QP + 32 + pc * 8) = pack8(c);
#pragma unroll
        for (int j = 0; j < 8; ++j) { a[j] = q1[j] * xb; c[j] = q2[j] * xb; }
        *(LAS u32x4*)(qb + tk * QP + pc * 8) = pack8(a); *(LAS u32x4*)(qb + tk * QP + 32 + pc * 8) = pack8(c);
#pragma unroll
        for (int j = 0; j < 8; ++j) { a[j] = k1[j] * 0.125f; c[j] = k2[j] * 0.125f; }
        *(LAS u32x4*)(ks + tk * QP + pc * 8) = pack8(a); *(LAS u32x4*)(ks + tk * QP + 32 + pc * 8) = pack8(c);
#pragma unroll
        for (int k4 = 0; k4 < 4; ++k4) { const int it = tid + 512 * k4, tv = it >> 4, ch = it & 15; *(LAS u32x4*)(Vt + tv * VP + ch * 8) = pv[k4]; }
#pragma unroll
        for (int k4 = 0; k4 < 4; ++k4) { const int it = tid + 512 * k4, dd = it >> 10, e = (it >> 3) & 127, ch = it & 7; *(LAS u32x4*)((dd ? Rb : Rf) + e * QP + ch * 8) = pr[k4]; }
    }
    if (nun >= 0) ret_r3_prefetch(F, nun, pv, pr, pq, pk);
    __syncthreads();
    f32x4 ST[8];
    {
        bf16x8 qa[2];
#pragma unroll
        for (int k2 = 0; k2 < 2; ++k2) qa[k2] = *(const LAS bf16x8*)(qn + (n0 + fr) * QP + k2 * 32 + fq * 8);
#pragma unroll
        for (int th = 0; th < 4; ++th) {
            bf16x8 kf[2][2];
#pragma unroll
            for (int t2 = 0; t2 < 2; ++t2)
#pragma unroll
                for (int k2 = 0; k2 < 2; ++k2) kf[t2][k2] = *(const LAS bf16x8*)(ks + (16 * (2 * th + t2) + fr) * QP + k2 * 32 + fq * 8);
            __builtin_amdgcn_sched_barrier(0);
#pragma unroll
            for (int t2 = 0; t2 < 2; ++t2) { const int tm = 2 * th + t2; ST[tm] = mm32(kf[t2][0], qa[0], (f32x4){0.f, 0.f, 0.f, 0.f}); ST[tm] = mm32(kf[t2][1], qa[1], ST[tm]); }
            __builtin_amdgcn_sched_barrier(0); }
    }
    s16x4 cst[8];
#pragma unroll
    for (int tm = 0; tm < 8; ++tm) { f32x4 t;
#pragma unroll
        for (int j = 0; j < 4; ++j) { const int n = n0 + fr, m = 16 * tm + 4 * fq + j; const int dd = n - m;
            const float ex = __builtin_amdgcn_exp2f((float)(dd < 0 ? -dd : dd) * (dd > 0 ? lgf : lgb));
            t[j] = ST[tm][j] * ((dd == 0) ? 2.0f : ex); }
        u32x2 pw; pw.x = pk2(t[0], t[1]); pw.y = pk2(t[2], t[3]); cst[tm] = __builtin_bit_cast(s16x4, pw); }
    f32x4 Y[8];
#pragma unroll
    for (int te = 0; te < 8; ++te) Y[te] = (f32x4){0.f, 0.f, 0.f, 0.f};
    {
        const int g = lane >> 4, i = lane & 15, q = i >> 2, pp = i & 3;
#pragma unroll
        for (int p = 0; p < 4; ++p) { const bf16x8 a = (bf16x8){cst[2 * p][0], cst[2 * p][1], cst[2 * p][2], cst[2 * p][3], cst[2 * p + 1][0], cst[2 * p + 1][1], cst[2 * p + 1][2], cst[2 * p + 1][3]};
            s16x4 lo[8], hi[8];
#pragma unroll
            for (int te = 0; te < 8; ++te) { const LAS bf16_t* va = Vt + (32 * p + 4 * g + q) * VP + 16 * te + 4 * pp;
                lo[te] = __builtin_bit_cast(s16x4, __builtin_amdgcn_ds_read_tr16_b64_v4i16((LAS v4i16_t*)va));
                hi[te] = __builtin_bit_cast(s16x4, __builtin_amdgcn_ds_read_tr16_b64_v4i16((LAS v4i16_t*)(va + 16 * VP))); }
            __builtin_amdgcn_sched_barrier(0);
#pragma unroll
            for (int te = 0; te < 8; ++te) Y[te] = mm32(a, (bf16x8){lo[te][0], lo[te][1], lo[te][2], lo[te][3], hi[te][0], hi[te][1], hi[te][2], hi[te][3]}, Y[te]);
            __builtin_amdgcn_sched_barrier(0); }
    }
#pragma unroll
    for (int k2 = 0; k2 < 2; ++k2) { const bf16x8 af = *(const LAS bf16x8*)(qf + (n0 + fr) * QP + k2 * 32 + fq * 8), ab = *(const LAS bf16x8*)(qb + (n0 + fr) * QP + k2 * 32 + fq * 8);
#pragma unroll
        for (int th = 0; th < 2; ++th) {
            bf16x8 bfw[4], bbw[4];
#pragma unroll
            for (int t4 = 0; t4 < 4; ++t4) { const int te = 4 * th + t4; bfw[t4] = *(const LAS bf16x8*)(Rf + (16 * te + fr) * QP + k2 * 32 + fq * 8); bbw[t4] = *(const LAS bf16x8*)(Rb + (16 * te + fr) * QP + k2 * 32 + fq * 8); }
            __builtin_amdgcn_sched_barrier(0);
#pragma unroll
            for (int t4 = 0; t4 < 4; ++t4) { const int te = 4 * th + t4; Y[te] = mm32(af, bfw[t4], Y[te]); Y[te] = mm32(ab, bbw[t4], Y[te]); }
            __builtin_amdgcn_sched_barrier(0); } }
    __syncthreads();
    {
        float s4[4], v4[4], mean4[4], rstd4[4];
#pragma unroll
        for (int j = 0; j < 4; ++j) { s4[j] = 0.f;
#pragma unroll
            for (int te = 0; te < 8; ++te) s4[j] += Y[te][j]; }
#pragma unroll
        for (int m = 1; m < 16; m <<= 1) { float t4[4];
#pragma unroll
            for (int j = 0; j < 4; ++j) t4[j] = shx(s4[j], m, lane);
#pragma unroll
            for (int j = 0; j < 4; ++j) s4[j] += t4[j]; }
#pragma unroll
        for (int j = 0; j < 4; ++j) { mean4[j] = s4[j] * (1.0f / 128.0f); v4[j] = 0.f;
#pragma unroll
            for (int te = 0; te < 8; ++te) { const float dd = Y[te][j] - mean4[j]; v4[j] += dd * dd; } }
#pragma unroll
        for (int m = 1; m < 16; m <<= 1) { float t4[4];
#pragma unroll
            for (int j = 0; j < 4; ++j) t4[j] = shx(v4[j], m, lane);
#pragma unroll
            for (int j = 0; j < 4; ++j) v4[j] += t4[j]; }
#pragma unroll
        for (int j = 0; j < 4; ++j) { rstd4[j] = rsqrtf(v4[j] * (1.0f / 128.0f) + 1e-5f);
            const int r = 4 * fq + j; LAS bf16_t* yst = (r < 8 ? qf + n0 * QP + r * VP : qb + n0 * QP + (r - 8) * VP);
#pragma unroll
            for (int te = 0; te < 8; ++te) { const int e = 16 * te + fr; yst[e] = (bf16_t)f2bf((Y[te][j] - mean4[j]) * rstd4[j] * lgv[te] + lbv[te]); } }
    }
    __syncthreads();
#pragma unroll
    for (int k4 = 0; k4 < 4; ++k4) { const int it = lane + 64 * k4, r = it >> 4, ch = it & 15; const long row = U.rbase + n0 + r;
        const LAS bf16_t* yst = (r < 8 ? qf + n0 * QP + r * VP : qb + n0 * QP + (r - 8) * VP);
        float yv[8], gv[8]; unpack8(*(const LAS u32x4*)(yst + ch * 8), yv); unpack8(gq[k4], gv);
#pragma unroll
        for (int j = 0; j < 8; ++j) yv[j] *= siluf_(gv[j]);
        *(u32x4*)(y + row * 512 + U.h * 128 + ch * 8) = pack8(yv); }
    __syncthreads();
}
__device__ __forceinline__ void ret_r3_phase(const Ctx& F, int layer) {
    int un = F.bid; while (un < ret2::NUNITS && layer != 0 && (un % 34) < 2) un += F.G;
    if (un >= ret2::NUNITS) return;
    u32x4 pv[4], pr[4], pq[2], pk[2]; ret_r3_prefetch(F, un, pv, pr, pq, pk);
    while (un >= 0) { int nun = un + F.G; while (nun < ret2::NUNITS && layer != 0 && (nun % 34) < 2) nun += F.G;
        if (nun >= ret2::NUNITS) nun = -1;
        ret_r3_unit(F, layer, un, nun, pv, pr, pq, pk); un = nun; }
}
__device__ __forceinline__ void ret_r1_phase(const Ctx& F, int layer) {
    int un = F.bid; if (un >= ret2::NUNITS) return;
    u32x4 pv[4], pk[2]; ret_r1_prefetch(F, un, pv, pk);
    while (un >= 0) { const int nun = (un + F.G < ret2::NUNITS) ? un + F.G : -1; ret_r1_unit(F, layer, un, nun, pv, pk); un = nun; }
}
__device__ __forceinline__ void rw_phase(const Ctx& F, int layer) {
    unsigned char* ws = getpp()->ws;
    if (F.G >= 160) {
        if (F.bid < 128) rwkv_chain4(F, layer, F.bid >> 4, (F.bid >> 1) & 7, F.bid & 1);
        unsigned* ctr = (unsigned*)(ws + WS_CTL) + 192 + 64 * layer; LAS unsigned* bc = (LAS unsigned*)(F.lds + LDS_BYTES - 32);
        for (;;) {
            __syncthreads();
            if (F.tid == 0) *bc = __hip_atomic_fetch_add(ctr, 1u, __ATOMIC_RELAXED, __HIP_MEMORY_SCOPE_AGENT);
            __syncthreads();
            const unsigned u = *bc; if (u >= 512u) break;
            const int bh = (int)u >> 4; attn_latent_unit(F, ws, half_a_base(layer), bh >> 3, bh & 7, (int)u & 15);
        }
    } else {
        for (int un = F.bid; un < 128; un += F.G) { rwkv_chain4(F, layer, un >> 4, (un >> 1) & 7, un & 1); __syncthreads(); }
        for (int u = F.bid; u < 512; u += F.G) { const int bh = u >> 4; attn_latent_unit(F, ws, half_a_base(layer), bh >> 3, bh & 7, u & 15); }
    }
}

template <int NB> __device__ __forceinline__ void rows_norm(int lane, const float* hbase, const int* rows, const float* gain, const float* mod, f32x4 (*y)[4]) {
    float ss[NB];
#pragma unroll
    for (int b = 0; b < NB; ++b) { const float* src = hbase + (size_t)rows[b] * 1024; ss[b] = 0.f;
#pragma unroll
        for (int j = 0; j < 4; ++j) { y[b][j] = *(const f32x4*)(src + 4 * lane + 256 * j); ss[b] += y[b][j].x * y[b][j].x + y[b][j].y * y[b][j].y + y[b][j].z * y[b][j].z + y[b][j].w * y[b][j].w; } }
#pragma unroll
    for (int b = 0; b < NB; ++b) ss[b] = wave_sum(ss[b], lane);
#pragma unroll
    for (int b = 0; b < NB; ++b) { const float rstd = rsqrtf(ss[b] * (1.0f / 1024.0f) + 1e-6f); const float* sh = mod + (rows[b] >> 12) * 6144; const float* sc = sh + 1024;
#pragma unroll
        for (int j = 0; j < 4; ++j) { const int c = 4 * lane + 256 * j; y[b][j] = y[b][j] * rstd * *(const f32x4*)(gain + c) * (*(const f32x4*)(sc + c) + 1.0f) + *(const f32x4*)(sh + c); } }
}
template <int NB> __device__ __forceinline__ void rows_norm_pre(int lane, const int* rows, const float* gain, const float* mod, f32x4 (*y)[4]) {
    float ss[NB];
#pragma unroll
    for (int b = 0; b < NB; ++b) { ss[b] = 0.f;
#pragma unroll
        for (int j = 0; j < 4; ++j) ss[b] += y[b][j].x * y[b][j].x + y[b][j].y * y[b][j].y + y[b][j].z * y[b][j].z + y[b][j].w * y[b][j].w; }
#pragma unroll
    for (int b = 0; b < NB; ++b) ss[b] = wave_sum(ss[b], lane);
#pragma unroll
    for (int b = 0; b < NB; ++b) { const float rstd = rsqrtf(ss[b] * (1.0f / 1024.0f) + 1e-6f); const float* sh = mod + (rows[b] >> 12) * 6144; const float* sc = sh + 1024;
#pragma unroll
        for (int j = 0; j < 4; ++j) { const int c = 4 * lane + 256 * j; y[b][j] = y[b][j] * rstd * *(const f32x4*)(gain + c) * (*(const f32x4*)(sc + c) + 1.0f) + *(const f32x4*)(sh + c); } }
}
__device__ __forceinline__ void moe_route_pass(const Ctx& F, int layer) {
    PP P = getpp(); unsigned char* ws = P->ws;
    const float* gain = P->in[I_NFFN] + layer * 1024; const float* mod = (const float*)(ws + WS_MOD) + (size_t)layer * 9 * 6144 + 3072;
    const float* router = P->in[I_ROUTER];
    unsigned* cnt = (unsigned*)(ws + WS_CTL); int* route = (int*)(ws + WS_ROUTE);
    LAS float* rl = (LAS float*)F.lds;
    LAS unsigned* lc = (LAS unsigned*)(F.lds + 32768);
    for (int i = F.tid; i < 8192; i += NTHREADS) rl[(i & 7) * 1024 + (i >> 3)] = router[i];
    if (F.tid < 16) lc[F.tid] = 0u;
    __syncthreads();
    const int rpb = (RL + F.G - 1) / F.G, rpw = (rpb + 7) / 8;
    const int b0 = F.bid * rpb, b1 = (b0 + rpb < RL) ? b0 + rpb : RL;
    const int r0 = b0 + F.wave * rpw, r1 = (r0 + rpw < b1) ? r0 + rpw : b1;
    constexpr int NB = 2;
    f32x4 xr[NB][4];
#pragma unroll
    for (int b = 0; b < NB; ++b) { const int row = (r0 + b < r1) ? r0 + b : r1 - 1;
#pragma unroll
        for (int j = 0; j < 4; ++j) xr[b][j] = ldh4((const bf16_t*)(ws + D_H1) + (size_t)row * 1024 + 4 * F.lane + 256 * j); }
    for (int rb = r0; rb < r1; rb += NB) {
        int lane = F.lane; asm volatile("" : "+v"(lane));
        int rows[NB]; f32x4 y[NB][4];
#pragma unroll
        for (int b = 0; b < NB; ++b) { rows[b] = (rb + b < r1) ? rb + b : r1 - 1;
#pragma unroll
            for (int j = 0; j < 4; ++j) y[b][j] = xr[b][j]; }
        if (rb + NB < r1) {
#pragma unroll
            for (int b = 0; b < NB; ++b) { const int row = (rb + NB + b < r1) ? rb + NB + b : r1 - 1;
#pragma unroll
                for (int j = 0; j < 4; ++j) xr[b][j] = ldh4((const bf16_t*)(ws + D_H1) + (size_t)row * 1024 + 4 * lane + 256 * j); } }
        rows_norm_pre<NB>(lane, rows, gain, mod, y);
#pragma unroll
        for (int b = 0; b < NB; ++b)
#pragma unroll
            for (int j = 0; j < 4; ++j) { const int c = 4 * lane + 256 * j; u32x2 o; o.x = pk2(y[b][j].x, y[b][j].y); o.y = pk2(y[b][j].z, y[b][j].w);
                bf16_t* bp = (bf16_t*)(ws + D_XR) + ((c < 512) ? (size_t)c : (size_t)RL * 512 + (c - 512)); *(u32x2*)(bp + (size_t)rows[b] * 512) = o; }
        float lg[NB][8];
#pragma unroll
        for (int b = 0; b < NB; ++b)
#pragma unroll
            for (int e = 0; e < 8; ++e) lg[b][e] = 0.f;
#pragma unroll
        for (int j = 0; j < 4; ++j)
#pragma unroll
            for (int e = 0; e < 8; ++e) { const f32x4 r4 = *(const LAS f32x4*)(rl + e * 1024 + 4 * lane + 256 * j);
#pragma unroll
                for (int b = 0; b < NB; ++b) lg[b][e] += y[b][j][0] * r4[0] + y[b][j][1] * r4[1] + y[b][j][2] * r4[2] + y[b][j][3] * r4[3]; }
        {
            static_assert(NB == 2, "butterfly below is written for 16 values");
            const bool h5 = (lane & 32) != 0, h4 = (lane & 16) != 0, h3 = (lane & 8) != 0, h2 = (lane & 4) != 0;
            float w8[8], x4[4], y2[2];
#pragma unroll
            for (int i = 0; i < 8; ++i) { const float keep = h5 ? lg[1][i] : lg[0][i], send = h5 ? lg[0][i] : lg[1][i]; w8[i] = keep + shx(send, 32, lane); }
#pragma unroll
            for (int i = 0; i < 4; ++i) { const float keep = h4 ? w8[4 + i] : w8[i], send = h4 ? w8[i] : w8[4 + i]; x4[i] = keep + shx(send, 16, lane); }
#pragma unroll
            for (int i = 0; i < 2; ++i) { const float keep = h3 ? x4[2 + i] : x4[i], send = h3 ? x4[i] : x4[2 + i]; y2[i] = keep + shx(send, 8, lane); }
            float z = (h2 ? y2[1] : y2[0]) + shx(h2 ? y2[0] : y2[1], 4, lane);
            z += shx(z, 2, lane); z += shx(z, 1, lane);
#pragma unroll
            for (int b = 0; b < NB; ++b)
#pragma unroll
                for (int e = 0; e < 8; ++e) lg[b][e] = __builtin_bit_cast(float, __builtin_amdgcn_readlane(__builtin_bit_cast(int, z), (b * 8 + e) * 4));
        }
        if (lane == 0) {
#pragma unroll
            for (int b = 0; b < NB; ++b) if (rb + b < r1) {
                int i0 = 0; float v0 = lg[b][0];
#pragma unroll
                for (int e = 1; e < 8; ++e) if (lg[b][e] > v0) { v0 = lg[b][e]; i0 = e; }
                int i1 = -1; float v1 = -3.0e38f;
#pragma unroll
                for (int e = 0; e < 8; ++e) if (e != i0 && lg[b][e] > v1) { v1 = lg[b][e]; i1 = e; }
                const float w0 = 1.0f / (1.0f + __expf(v1 - v0)), w1 = 1.0f - w0;
                const unsigned p0 = __hip_atomic_fetch_add(&lc[i0], 1u, __ATOMIC_RELAXED, __HIP_MEMORY_SCOPE_WORKGROUP), p1 = __hip_atomic_fetch_add(&lc[i1], 1u, __ATOMIC_RELAXED, __HIP_MEMORY_SCOPE_WORKGROUP);
                int* r = route + (size_t)rows[b] * 8; r[0] = i0; r[1] = i1; r[2] = __float_as_int(w0); r[3] = __float_as_int(w1); r[4] = (int)p0; r[5] = (int)p1;
            }
        }
    }
    __syncthreads();
    if (F.tid < 8) lc[8 + F.tid] = atomicAdd(&cnt[F.tid], lc[F.tid]);
    __syncthreads();
    for (int row = r0 + F.lane; row < r1; row += 64) { int* r = route + (size_t)row * 8; const int e0 = r[0], e1 = r[1], p0 = r[4], p1 = r[5]; const int q0 = p0 + (int)lc[8 + e0], q1 = p1 + (int)lc[8 + e1]; r[4] = q0; r[5] = q1;
        int* rm = (int*)(ws + D_RMAP); rm[(size_t)e0 * RL + q0] = row; rm[(size_t)e1 * RL + q1] = row; }
    __syncthreads();
}
__device__ __forceinline__ void moe_gather_pass(const Ctx& F, int layer) {
    PP P = getpp(); unsigned char* ws = P->ws;
    const float* gain = P->in[I_NFFN] + layer * 1024; const float* mod = (const float*)(ws + WS_MOD) + (size_t)layer * 9 * 6144 + 3072;
    const unsigned* cnt = (const unsigned*)(ws + WS_CTL); const int* route = (const int*)(ws + WS_ROUTE);
    bf16_t* xlo = (bf16_t*)(ws + D_XG); bf16_t* xhi = xlo + (size_t)RG * 512;
    const MoeTiles T = moe_tiles(cnt);
    const int rpw = (RL + NGW(F) - 1) / NGW(F); const int r0 = GW(F) * rpw; const int r1 = (r0 + rpw < RL) ? r0 + rpw : RL;
    constexpr int NB = 2;
    f32x4 xr[NB][4]; int rt[NB][4];
#pragma unroll
    for (int b = 0; b < NB; ++b) { const int row = (r0 + b < r1) ? r0 + b : r1 - 1; const int* r = route + (size_t)row * 8; rt[b][0] = r[0]; rt[b][1] = r[1]; rt[b][2] = r[4]; rt[b][3] = r[5];
#pragma unroll
        for (int j = 0; j < 4; ++j) xr[b][j] = ldh4((const bf16_t*)(ws + D_H1) + (size_t)row * 1024 + 4 * F.lane + 256 * j); }
    for (int rb = r0; rb < r1; rb += NB) {
        int lane = F.lane; asm volatile("" : "+v"(lane));
        int rows[NB]; f32x4 y[NB][4]; int rc[NB][4];
#pragma unroll
        for (int b = 0; b < NB; ++b) { rows[b] = (rb + b < r1) ? rb + b : r1 - 1;
#pragma unroll
            for (int j = 0; j < 4; ++j) { y[b][j] = xr[b][j]; rc[b][j] = rt[b][j]; } }
        if (rb + NB < r1) {
#pragma unroll
            for (int b = 0; b < NB; ++b) { const int row = (rb + NB + b < r1) ? rb + NB + b : r1 - 1; const int* r = route + (size_t)row * 8; rt[b][0] = r[0]; rt[b][1] = r[1]; rt[b][2] = r[4]; rt[b][3] = r[5];
#pragma unroll
                for (int j = 0; j < 4; ++j) xr[b][j] = ldh4((const bf16_t*)(ws + D_H1) + (size_t)row * 1024 + 4 * lane + 256 * j); } }
        rows_norm_pre<NB>(lane, rows, gain, mod, y);
#pragma unroll
        for (int b = 0; b < NB; ++b) {
            const int e0 = rc[b][0], e1 = rc[b][1];
            int t0 = 0, t1 = 0;
#pragma unroll
            for (int e = 0; e < 8; ++e) { if (e == e0) t0 = T.tstart[e]; if (e == e1) t1 = T.tstart[e]; }
            const size_t s0 = (size_t)t0 * 256 + rc[b][2], s1 = (size_t)t1 * 256 + rc[b][3];
#pragma unroll
            for (int j = 0; j < 4; ++j) { const int c = 4 * lane + 256 * j; u32x2 o; o.x = pk2(y[b][j].x, y[b][j].y); o.y = pk2(y[b][j].z, y[b][j].w);
                bf16_t* bp = (c < 512) ? xlo + c : xhi + (c - 512);
                *(u32x2*)(bp + s0 * 512) = o; *(u32x2*)(bp + s1 * 512) = o; } }
    }
}
__device__ __forceinline__ void moe_final_pass(const Ctx& F, int layer) {
    PP P = getpp(); unsigned char* ws = P->ws;
    const float* mod = (const float*)(ws + WS_MOD) + (size_t)layer * 9 * 6144 + 5120;
    const unsigned* cnt = (const unsigned*)(ws + WS_CTL); const int* route = (const int*)(ws + WS_ROUTE);
    const bf16_t* ym = (const bf16_t*)(ws + D_XG); const float* fn = P->in[I_FNORM];
    const MoeTiles T = moe_tiles(cnt);
    const int rpw = (RL + NGW(F) - 1) / NGW(F); const int r0 = GW(F) * rpw; const int r1 = (r0 + rpw < RL) ? r0 + rpw : RL;
    constexpr int NB = 2;
    int rt[NB][6];
#pragma unroll
    for (int b = 0; b < NB; ++b) { const int row = (r0 + b < r1) ? r0 + b : r1 - 1; const int* r = route + (size_t)row * 8;
#pragma unroll
        for (int k = 0; k < 6; ++k) rt[b][k] = r[k]; }
    for (int rb = r0; rb < r1; rb += NB) {
        int lane = F.lane; asm volatile("" : "+v"(lane));
        f32x4 v[NB][4]; float ss[NB]; int rows[NB]; int rc[NB][6];
#pragma unroll
        for (int b = 0; b < NB; ++b)
#pragma unroll
            for (int k = 0; k < 6; ++k) rc[b][k] = rt[b][k];
        if (rb + NB < r1) {
#pragma unroll
            for (int b = 0; b < NB; ++b) { const int row = (rb + NB + b < r1) ? rb + NB + b : r1 - 1; const int* r = route + (size_t)row * 8;
#pragma unroll
                for (int k = 0; k < 6; ++k) rt[b][k] = r[k]; } }
#pragma unroll
        for (int b = 0; b < NB; ++b) { const int row = (rb + b < r1) ? rb + b : r1 - 1; rows[b] = row;
            const int e0 = rc[b][0], e1 = rc[b][1]; const float w0 = __int_as_float(rc[b][2]), w1 = __int_as_float(rc[b][3]);
            int t0 = 0, t1 = 0;
#pragma unroll
            for (int e = 0; e < 8; ++e) { if (e == e0) t0 = T.tstart[e]; if (e == e1) t1 = T.tstart[e]; }
            const size_t s0 = (size_t)t0 * 256 + rc[b][4], s1 = (size_t)t1 * 256 + rc[b][5];
            const float* g = mod + (row >> 12) * 6144; const bf16_t* hp = (const bf16_t*)(ws + D_H1) + (size_t)row * 1024; ss[b] = 0.f;
#pragma unroll
            for (int j = 0; j < 4; ++j) { const int c = 4 * lane + 256 * j; const u32x2 a = *(const u32x2*)(ym + s0 * 1024 + c), bq = *(const u32x2*)(ym + s1 * 1024 + c);
                const f32x4 ya = {bflo(a.x), bfhi(a.x), bflo(a.y), bfhi(a.y)}, yb = {bflo(bq.x), bfhi(bq.x), bflo(bq.y), bfhi(bq.y)};
                v[b][j] = ldh4(hp + c) + *(const f32x4*)(g + c) * (ya * w0 + yb * w1);
                ss[b] += v[b][j].x * v[b][j].x + v[b][j].y * v[b][j].y + v[b][j].z * v[b][j].z + v[b][j].w * v[b][j].w; } }
#pragma unroll
        for (int b = 0; b < NB; ++b) ss[b] = wave_sum(ss[b], lane);
#pragma unroll
        for (int b = 0; b < NB; ++b) { const float rstd = rsqrtf(ss[b] * (1.0f / 1024.0f) + 1e-6f); float* hp = P->out + (size_t)rows[b] * 1024;
#pragma unroll
            for (int j = 0; j < 4; ++j) { const int c = 4 * lane + 256 * j; *(f32x4*)(hp + c) = v[b][j] * rstd * *(const f32x4*)(fn + c); } }
    }
}

#define XB_TMO      128
#define XB_XCNT(j)  (256  + 64 * (j))
#define XB_XSUB(j)  (1280 + 64 * (j))
#define XB_XGEN(j)  (2304 + 64 * (j))
#define XB_TOP      3328
#define XB_TOPGEN   3392
#define XCD_BAR_WORDS 3456
#define XB_SPIN_CAP (1u << 18)
constexpr int CW_BAR = 4096;
constexpr int LDS_BARST = LDS_BYTES - 16;
__device__ __forceinline__ unsigned xb_ld(unsigned* p)              { return __hip_atomic_load(p, __ATOMIC_RELAXED, __HIP_MEMORY_SCOPE_AGENT); }
__device__ __forceinline__ unsigned xb_add(unsigned* p, unsigned v) { return __hip_atomic_fetch_add(p, v, __ATOMIC_RELAXED, __HIP_MEMORY_SCOPE_AGENT); }
__device__ __forceinline__ unsigned xb_xcc_id() { return (unsigned)__builtin_amdgcn_s_getreg((3 << 11) | 20) & 0xFu; }
#define XB_SPIN(cond, bar) do { unsigned _sp = 0; while (cond) { __builtin_amdgcn_s_sleep(1); \
    if ((++_sp & 255u) == 0u) { if (xb_ld(&(bar)[XB_TMO])) break; if (_sp > XB_SPIN_CAP) { atomicAdd(&(bar)[XB_TMO], 1u); break; } } } } while (0)
__device__ __forceinline__ void xcd_barrier_complete(unsigned* bar, unsigned x, unsigned& nloc, unsigned& nx) {
    const unsigned G = gridDim.x * gridDim.y * gridDim.z;
    unsigned sum, cnt, mine, sp = 0u;
    for (;;) {
        sum = 0u; cnt = 0u; mine = 0u;
#pragma unroll
        for (unsigned j = 0; j < 16; ++j) { const unsigned c = xb_ld(&bar[XB_XCNT(j)]); sum += c; cnt += (c > 0u) ? 1u : 0u; mine = (j == x) ? c : mine; }
        if (sum == G) break;
        __builtin_amdgcn_s_sleep(1);
        if ((++sp & 255u) == 0u) { if (xb_ld(&bar[XB_TMO])) break; if (sp > XB_SPIN_CAP) { atomicAdd(&bar[XB_TMO], 1u); break; } }
    }
    nloc = mine > 0u ? mine : 1u; nx = cnt > 0u ? cnt : 1u;
}
__device__ __forceinline__ void xcd_barrier(LAS unsigned char* lds) {
    asm volatile("s_waitcnt vmcnt(0)" ::: "memory");
    __syncthreads();
    if (threadIdx.x == 0) {
        unsigned* bar = (unsigned*)(getpp()->ws + WS_CTL) + CW_BAR;
        volatile LAS unsigned* st = (volatile LAS unsigned*)(lds + LDS_BARST);
        const unsigned x = xb_xcc_id();
        __builtin_amdgcn_s_waitcnt(0);
        unsigned nloc = st[0], nx = st[1];
        if (nloc == 0u) { xcd_barrier_complete(bar, x, nloc, nx); st[0] = nloc; st[1] = nx; }
        const unsigned old = xb_add(&bar[XB_XSUB(x)], 1u);
        const unsigned gen = old / nloc;
        if (old + 1u == (gen + 1u) * nloc) {
            __builtin_amdgcn_fence(__ATOMIC_RELEASE, "agent");
            asm volatile("s_waitcnt vmcnt(0)" ::: "memory");
            const unsigned og = xb_add(&bar[XB_TOP], 1u);
            const unsigned tg = og / nx;
            if (og + 1u == (tg + 1u) * nx) xb_add(&bar[XB_TOPGEN], 1u);
            else XB_SPIN(xb_ld(&bar[XB_TOPGEN]) == tg, bar);
            __builtin_amdgcn_fence(__ATOMIC_ACQUIRE, "agent");
            xb_add(&bar[XB_XGEN(x)], 1u);
            asm volatile("s_waitcnt vmcnt(0)" ::: "memory");
        } else {
            XB_SPIN(xb_ld(&bar[XB_XGEN(x)]) == gen, bar);
            __builtin_amdgcn_fence(__ATOMIC_ACQUIRE, "agent");
            asm volatile("s_waitcnt vmcnt(0)" ::: "memory");
        }
    }
    __syncthreads();
}
#define FRESH() do { int t_ = threadIdx.x; asm volatile("" : "+v"(t_)); F.tid = t_; F.lane = t_ & 63; F.wave = __builtin_amdgcn_readfirstlane(t_ >> 6); \
    int g_ = gridDim.x, b_ = blockIdx.x; asm volatile("" : "+s"(g_), "+s"(b_)); F.G = g_; F.bid = b_; } while (0)
#define PHASE_VARS FRESH(); const int G = F.G, c = F.bid; (void)G; (void)c; PP P = getpp(); unsigned char* ws = P->ws; const bool L0 = (layer == 0); \
    const float* hl = P->in[I_X]; const bf16_t* hb = L0 ? (const bf16_t*)nullptr : (const bf16_t*)h0_base(); (void)hb; const float* hcx = L0 ? P->in[I_CTX] : (const float*)(ws + WS_HC); float* hc = (float*)(ws + WS_HC); \
    const char* wl = (const char*)(ws + WS_W + (size_t)layer * WL_STRIDE); const float* mod = (const float*)(ws + WS_MOD) + (size_t)layer * 9 * 6144; \
    const int nMm = L0 ? RT / 256 : RL / 256; (void)hl; (void)hcx; (void)hc; (void)wl; (void)mod; (void)nMm;

template <int layer> __device__ __forceinline__ void layer_fwd(Ctx& F, cg::grid_group& grid) {

        { PHASE_VARS norm_pass(F, layer, 0, hl, hb, hcx, RT, (bf16_t*)(ws + D_XN1), (bf16_t*)(ws + D_XN1 + Y34), layer != 0); }
        xcd_barrier(F.lds);
        { PHASE_VARS SchedSplit2 S{(const char*)(ws + D_XN1), (const char*)(ws + D_XN1 + Y34), wl + WL_WINLO, wl + WL_WINHI, RT / 256, MIXP / 256, G, c, true};
          EpiInproj E{ws};
          pg8::gemm_phase<512, 512, true>(F.lds, S, E); }
        xcd_barrier(F.lds);
        FRESH(); ctx_krope_proj(F, layer);
        FRESH(); mla_stats_pass(F, 0, F.G * 8);
        FRESH(); ret_r1_phase(F, layer);
        xcd_barrier(F.lds);
        FRESH(); ret_r2(F, layer, 0, F.G);
        FRESH(); krope_pass(F, 0, layer);
        { PHASE_VARS SchedHalf S{(const char*)(ws + D_UMLA), wl + WL_WQ, (size_t)256 * MLC * 2, (size_t)256 * 384 * 2, 6, 3, 0, G, (c + G - 128 % G) % G};
          EpiQup E{(bf16_t*)(half_a_base(layer) + HA_Q), (const float*)(ws + WS_RSTD), (const float*)(ws + WS_ROPE_M), (const float*)(ws + WS_ROPE_M) + 4096 * 16, 1};
          pg8::gemm_phase<MLC, 384, false>(F.lds, S, E); }
        { PHASE_VARS SchedHalf S{(const char*)(ws + D_UMLA) + 384 * 2, wl + WL_WKV, (size_t)256 * MLC * 2, (size_t)256 * 256 * 2, 4, 4, 0, G, (c + G - 24 % G) % G};
          EpiKVup E{(bf16_t*)(half_a_base(layer) + HA_K), (bf16_t*)(half_a_base(layer) + HA_V), (const float*)(ws + WS_RSTD) + RT, 1};
          pg8::gemm_phase<MLC, 256, true>(F.lds, S, E); }
        xcd_barrier(F.lds);
        FRESH(); rw_phase(F, layer);
        xcd_barrier(F.lds);
        FRESH(); rwkv_post_phase(F, layer, layer == 0 ? RT : RL);
        xcd_barrier(F.lds);
        FRESH(); krope_pass(F, 1, layer);
        FRESH(); ret_r3_phase(F, layer);
        { PHASE_VARS SchedHalf S{(const char*)(ws + D_UMLA), wl + WL_WQ, (size_t)256 * MLC * 2, (size_t)256 * 384 * 2, 6, 3, 1, G, (c + G - 64 % G) % G};
          EpiQup E{(bf16_t*)(ws + D_Q), (const float*)(ws + WS_RSTD), (const float*)(ws + WS_ROPE_M), (const float*)(ws + WS_ROPE_M) + 4096 * 16, 0};
          pg8::gemm_phase<MLC, 384, false>(F.lds, S, E); }
        { PHASE_VARS SchedHalf S{(const char*)(ws + D_UMLA) + 384 * 2, wl + WL_WKV, (size_t)256 * MLC * 2, (size_t)256 * 256 * 2, 4, 4, 1, G, (c + G - 216 % G) % G};
          EpiKVup E{(bf16_t*)(ws + D_K), (bf16_t*)(ws + D_V), (const float*)(ws + WS_RSTD) + RT, 0};
          pg8::gemm_phase<MLC, 256, true>(F.lds, S, E); }
        xcd_barrier(F.lds);
        FRESH(); attn_phase(F, layer);
        xcd_barrier(F.lds);
        { PHASE_VARS SchedMerge S; S.XNlo = (const char*)(ws + D_XN1); S.XNhi = (const char*)(ws + D_XN1 + Y34); S.WgLo = wl + WL_WGLO; S.WgHi = wl + WL_WGHI;
          S.wsb = (const char*)ws; S.Wb = wl + WL_WB; S.nM = nMm; S.G = G; S.c = c; S.ctx3 = L0 && G > 64;
          EpiMerge E{(u32x4*)(ws + D_SCR + (size_t)c * 131072), (bf16_t*)(ws + D_M), (bf16_t*)(ws + D_P12)};
          pg8::gemm_phase<512, 512, true>(F.lds, S, E); }
        if (layer == 0) { FRESH(); int rot = 0; const int b0 = (F.G > 160) ? 96 : 0; layer_weights(F, 1, rot, b0, F.G - b0); FRESH(); convert_ffn0(F, b0, F.G - b0); }
        xcd_barrier(F.lds);
        if (layer == 0 && F.G > 64) { PHASE_VARS SchedWout0 S{(const char*)(ws + D_M), wl + WL_WO, (const char*)ws, G, c};
          EpiResid E{(const void*)hl, false, hcx, h0_base(), hc, mod, 2048, nullptr};
          pg8::gemm_phase<1024, 1024, true>(F.lds, S, E); }
        else { PHASE_VARS Sched1 S{(const char*)(ws + D_M), wl + WL_WO, (size_t)256 * 1024 * 2, (size_t)256 * 1024 * 2, 16, nMm, 4, G, c};
          EpiResid E{L0 ? (const void*)hl : (const void*)hb, !L0, hcx, L0 ? h0_base() : (bf16_t*)(ws + D_H1), hc, mod, 2048, nullptr};
          pg8::gemm_phase<1024, 1024, true>(F.lds, S, E); }
        xcd_barrier(F.lds);
        if (layer == 0) {
            { PHASE_VARS norm_pass(F, layer, 1, hl, h0_base(), hc, RT, (bf16_t*)(ws + D_XN2), (bf16_t*)(ws + D_XN2 + Y34)); }
            xcd_barrier(F.lds);
            { PHASE_VARS SchedSplit2 S{(const char*)(ws + D_XN2), (const char*)(ws + D_XN2 + Y34), (const char*)(ws + D_FFW), (const char*)(ws + D_FFW) + (size_t)5632 * 1024, RT / 256, 22, G, c, false};
              EpiSwiglu E{(bf16_t*)(ws + D_H), DFF};
              pg8::gemm_phase<512, 512, true>(F.lds, S, E); }
            xcd_barrier(F.lds);
            { PHASE_VARS SchedDown0 S{(const char*)(ws + D_H), (const char*)(ws + D_FFW) + (size_t)2 * 5632 * 1024, G, c};
              EpiResid E{(const void*)h0_base(), true, hc, h0_base(), hc, mod, 5120, (float*)(ws + D_PART)};
              pg8::gemm_phase<DFF, DFF, true>(F.lds, S, E); }
            xcd_barrier(F.lds);
        } else {
            FRESH(); moe_route_pass(F, layer);
            FRESH(); convert_moe(F);
            xcd_barrier(F.lds);
            bool gol; { PHASE_VARS const MoeTiles T = moe_tiles((const unsigned*)(ws + WS_CTL)); gol = (T.tstart[NEXP] * 11 + G - 1) / G <= MOE_TAB_UNITS; }
            if (gol) { PHASE_VARS const MoeTiles T = moe_tiles((const unsigned*)(ws + WS_CTL)); LAS int* tab = (LAS int*)(F.lds + 131072);
              moe_rowtab(F, T, (const unsigned*)(ws + WS_CTL), (const int*)(ws + D_RMAP), tab);
              SchedMoeUpG S{(const char*)(ws + D_XR), (const char*)(ws + D_XR) + (size_t)RL * 1024, (const char*)(ws + D_MOEW), T, G, c, tab};
              EpiSwiglu E{(bf16_t*)(ws + D_HM), DFE};
              pg8::gemm_phase<512, 512, true, true>(F.lds, S, E);
              { const int units = T.tstart[NEXP] * 11, rem = units % G; const int b0 = (rem > 0 && G - rem >= 32) ? rem : 0;
                FRESH(); convert_moe_down(F, b0, G - b0); } }
            else {
              FRESH(); moe_gather_pass(F, layer);
              xcd_barrier(F.lds);
              { PHASE_VARS const MoeTiles T = moe_tiles((const unsigned*)(ws + WS_CTL));
                SchedMoeUp S{(const char*)(ws + D_XG), (const char*)(ws + D_XG) + (size_t)RG * 1024, (const char*)(ws + D_MOEW), T, G, c};
                EpiSwiglu E{(bf16_t*)(ws + D_HM), DFE};
                pg8::gemm_phase<512, 512, true>(F.lds, S, E); }
              FRESH(); convert_moe_down(F, 0, F.G); }
            xcd_barrier(F.lds);
            { PHASE_VARS const MoeTiles T = moe_tiles((const unsigned*)(ws + WS_CTL));
              SchedMoeDown S{(const char*)(ws + D_HM), (const char*)(ws + D_MOEW), T, G, c};
              EpiBf16 E{(bf16_t*)(ws + D_XG), 1024};
              pg8::gemm_phase<DFE, DFE, true>(F.lds, S, E); }
            xcd_barrier(F.lds);
            FRESH(); moe_final_pass(F, layer);
        }
    }
#undef PHASE_VARS
#undef FRESH

__global__ void __launch_bounds__(NTHREADS, 2) mega_fwd(Params prm) {
    extern __shared__ __attribute__((aligned(16))) unsigned char lds_raw[];
    cg::grid_group grid = cg::this_grid();
    Ctx F; F.lds = (LAS unsigned char*)lds_raw; F.tid = threadIdx.x; F.lane = F.tid & 63; F.wave = __builtin_amdgcn_readfirstlane(F.tid >> 6); F.G = gridDim.x; F.bid = blockIdx.x;
    if (F.tid < 4) ((LAS unsigned*)(F.lds + LDS_BARST))[F.tid] = 0u;
    __syncthreads();
    if (F.tid == 0) (void)xb_add((unsigned*)(prm.ws + WS_CTL) + CW_BAR + XB_XCNT(xb_xcc_id()), 1u);
    phase0(F);
    if (prm.ws == nullptr) grid.sync();
    xcd_barrier(F.lds);
    layer_fwd<0>(F, grid);
    layer_fwd<1>(F, grid);
}

extern "C" void kernel_launch(void* const* d_in, const int* in_sizes, int n_in, void* d_out, int out_size, void* d_ws, size_t ws_size, hipStream_t stream) {
    static int grid_blocks = 0;
    if (grid_blocks == 0) {
        if (n_in != 37 || ws_size < WS_NEED) { fprintf(stderr, "kernel_launch: unexpected n_in %d / ws %zu\n", n_in, ws_size); grid_blocks = -1; return; }
        int dev = 0, cus = 0, per_cu = 0;
        hipGetDevice(&dev); hipDeviceGetAttribute(&cus, hipDeviceAttributeMultiprocessorCount, dev);
        hipFuncSetAttribute((const void*)mega_fwd, hipFuncAttributeMaxDynamicSharedMemorySize, LDS_BYTES);
        hipOccupancyMaxActiveBlocksPerMultiprocessor(&per_cu, (const void*)mega_fwd, NTHREADS, LDS_BYTES);
        if (per_cu < 1) { fprintf(stderr, "kernel_launch: occupancy query says %d blocks/CU\n", per_cu); per_cu = 1; }
        grid_blocks = cus;
        (void)hipGetLastError();
    }
    if (grid_blocks < 0) return;
    (void)hipMemsetAsync((char*)d_ws + WS_CTL, 0, 65536, stream);
    Params p{};
    for (int i = 0; i < 37; ++i) p.in[i] = (const float*)d_in[i];
    p.out = (float*)d_out; p.ws = (unsigned char*)d_ws;
    void* args[] = {&p};
    hipError_t e = hipLaunchCooperativeKernel((const void*)mega_fwd, dim3(grid_blocks), dim3(NTHREADS), args, LDS_BYTES, stream);
    if (e != hipSuccess) fprintf(stderr, "cooperative launch failed: %s (grid %d)\n", hipGetErrorString(e), grid_blocks);
}
```
